# Optimizing an MI355X kernel written in HIP

```python
import jax
import jax.numpy as jnp
from jax import lax
import numpy as np

D_MODEL = 1024
BATCH = 32
SEQ = 2048
DEPTH = 4

CHUNK = 64
RET_HEADS = 4
RET_HD = 64
RET_W = RET_HEADS * RET_HD
RWKV_HEADS = 6
RWKV_HD = 64
RWKV_W = RWKV_HEADS * RWKV_HD
MLSTM_HEADS = 4
MLSTM_HD = 96
MLSTM_W = MLSTM_HEADS * MLSTM_HD
D_MIX = RET_W + RWKV_W + MLSTM_W
RWKV_DECAY_LORA = 64
RWKV_ICL_LORA = 64
RWKV_GATE_LORA = 128
MLSTM_CONV = 4
D_FF = ((8 * D_MODEL + 3 * 256 - 1) // (3 * 256)) * 256
ROPE_BASE = 10000.0
RMS_EPS = 1e-6
GN_EPS = 1e-5

RET_SIZES = (RET_W, RET_W, RET_W, RET_W)
RWKV_SIZES = (RWKV_W, RWKV_W, RWKV_W, RWKV_DECAY_LORA, RWKV_ICL_LORA, RWKV_GATE_LORA)
MLSTM_SIZES = (2 * MLSTM_W, MLSTM_W, MLSTM_W, MLSTM_HEADS, MLSTM_HEADS)
RET_IN = sum(RET_SIZES)
RWKV_IN = sum(RWKV_SIZES)
MLSTM_IN = sum(MLSTM_SIZES)
D_IN = RET_IN + RWKV_IN + MLSTM_IN

kernel_name = 'hybrid_ret_rwkv7_mlstm_adaln_trunk'

F32 = jnp.float32


def _split(x, sizes):
    return jnp.split(x, [int(s) for s in np.cumsum(sizes)[:-1]], axis=-1)


def rms_norm(x, gain):
    xf = x.astype(F32)
    y = xf * lax.rsqrt(jnp.mean(xf * xf, axis=-1, keepdims=True) + RMS_EPS)
    return (y * gain.astype(F32)).astype(x.dtype)


def head_norm(x, gain, n_heads):
    b, t, w = x.shape
    xh = x.reshape(b, t, n_heads, w // n_heads)
    mu = jnp.mean(xh, axis=-1, keepdims=True)
    xc = xh - mu
    var = jnp.mean(xc * xc, axis=-1, keepdims=True)
    return (xc * lax.rsqrt(var + GN_EPS)).reshape(b, t, w) * gain.astype(F32)


def rotary(x):
    t, d = x.shape[1], x.shape[-1]
    inv = ROPE_BASE ** (-jnp.arange(0, d, 2, dtype=F32) / d)
    ang = jnp.arange(t, dtype=F32)[:, None] * inv[None, :]
    cos = jnp.cos(ang)[None, :, None, :]
    sin = jnp.sin(ang)[None, :, None, :]
    x1, x2 = jnp.split(x, 2, axis=-1)
    return jnp.concatenate([x1 * cos - x2 * sin, x1 * sin + x2 * cos], axis=-1)


def to_chunks(x):
    b, t, h = x.shape[:3]
    x = x.reshape((b, t // CHUNK, CHUNK, h) + x.shape[3:])
    return jnp.transpose(x, (1, 0, 3, 2) + tuple(range(4, x.ndim)))


def from_chunks(y):
    nc, b, h, l, d = y.shape
    return jnp.transpose(y, (1, 0, 3, 2, 4)).reshape(b, nc * l, h * d)


def token_shift(x, mu):
    xprev = jnp.pad(x, ((0, 0), (1, 0), (0, 0)))[:, :-1]
    return x + (xprev - x) * mu


def causal_conv(x, w, b):
    t = x.shape[1]
    xp = jnp.pad(x, ((0, 0), (MLSTM_CONV - 1, 0), (0, 0)))
    y = b + xp[:, 0:t] * w[0]
    for j in range(1, MLSTM_CONV):
        y = y + xp[:, j:j + t] * w[j]
    return y


def retention(q, k, v):
    b, t, h, d = q.shape
    log_g = jnp.log1p(-jnp.exp2(-5.0 - jnp.arange(h, dtype=F32)))
    idx = jnp.arange(CHUNK, dtype=F32)
    diff = idx[:, None] - idx[None, :]
    intra_decay = jnp.where(diff >= 0, jnp.exp(log_g[:, None, None] * jnp.maximum(diff, 0.0)), 0.0)
    q_decay = jnp.exp(log_g[:, None] * (idx + 1.0))[None, :, :, None]
    k_decay = jnp.exp(log_g[:, None] * (CHUNK - 1.0 - idx))[None, :, :, None]
    chunk_decay = jnp.exp(log_g * CHUNK)[None, :, None, None]
    k = k * (d ** -0.5)

    def step(state, inp):
        qc, kc, vc = inp
        s = jnp.einsum('bhld,bhmd->bhlm', qc, kc) * intra_decay
        y = jnp.einsum('bhlm,bhme->bhle', s, vc) + jnp.einsum('bhld,bhde->bhle', qc, state) * q_decay
        state = state * chunk_decay + jnp.einsum('bhld,bhle->bhde', kc * k_decay, vc)
        return state, y

    init = jnp.zeros((b, h, d, d), F32)
    _, y = lax.scan(step, init, (to_chunks(q), to_chunks(k), to_chunks(v)))
    return from_chunks(y)


def rwkv7_scan(r, decay, k, v, a, kk):
    b, t, h, n = r.shape

    def step(S, inp):
        r_t, w_t, k_t, v_t, a_t, kk_t = inp
        sa = jnp.einsum('bhij,bhj->bhi', S, -kk_t)
        S = S * w_t[:, :, None, :] + sa[..., None] * (kk_t * a_t)[:, :, None, :] + v_t[..., None] * k_t[:, :, None, :]
        return S, jnp.einsum('bhij,bhj->bhi', S, r_t)

    xs = tuple(jnp.moveaxis(z, 1, 0) for z in (r, decay, k, v, a, kk))
    _, y = lax.scan(step, jnp.zeros((b, h, n, n), F32), xs)
    return jnp.moveaxis(y, 0, 1)


def mlstm_chunkwise(q, k, v, i_pre, log_f):
    b, t, h, d = q.shape
    k = k * (d ** -0.5)
    causal = jnp.tril(jnp.ones((CHUNK, CHUNK), dtype=bool))

    def step(carry, inp):
        C, n, m = carry
        qc, kc, vc, ic, fc = inp
        bcum = jnp.cumsum(fc, axis=-1)
        a_inter = bcum + m[..., None]
        D = bcum[..., :, None] - bcum[..., None, :] + ic[..., None, :]
        D = jnp.where(causal, D, -jnp.inf)
        m_t = jnp.maximum(a_inter, jnp.max(D, axis=-1))
        inter_w = jnp.exp(a_inter - m_t)
        s = jnp.einsum('bhld,bhmd->bhlm', qc, kc) * jnp.exp(D - m_t[..., None])
        num = jnp.einsum('bhlm,bhme->bhle', s, vc) + inter_w[..., None] * jnp.einsum('bhld,bhde->bhle', qc, C)
        den = jnp.sum(s, axis=-1) + inter_w * jnp.einsum('bhld,bhd->bhl', qc, n)
        hc = num / jnp.maximum(jnp.abs(den), jnp.exp(-m_t))[..., None]
        b_last = bcum[..., -1]
        g_s = b_last[..., None] - bcum + ic
        m_new = jnp.maximum(b_last + m, jnp.max(g_s, axis=-1))
        ws = jnp.exp(g_s - m_new[..., None])[..., None]
        carry_decay = jnp.exp(b_last + m - m_new)
        C = carry_decay[..., None, None] * C + jnp.einsum('bhld,bhle->bhde', kc * ws, vc)
        n = carry_decay[..., None] * n + jnp.sum(kc * ws, axis=2)
        return (C, n, m_new), hc

    init = (jnp.zeros((b, h, d, d), F32), jnp.zeros((b, h, d), F32), jnp.zeros((b, h), F32))
    _, y = lax.scan(step, init, (to_chunks(q), to_chunks(k), to_chunks(v), to_chunks(i_pre), to_chunks(log_f)))
    return from_chunks(y)


def retention_group(cols, gain):
    b, t, _ = cols.shape
    q, k, v, g = _split(cols.astype(F32), RET_SIZES)
    heads = lambda z: z.reshape(b, t, RET_HEADS, RET_HD)
    y = retention(rotary(heads(q)), rotary(heads(k)), heads(v))
    return head_norm(y, gain, RET_HEADS) * jax.nn.silu(g)


def rwkv_group(cols, gain, mu, w0, w2, a0, a2, g2, k_k, k_a, r_k):
    b, t, _ = cols.shape
    cols = token_shift(cols.astype(F32), mu.astype(F32))
    r, k, v, wl, al, gl = _split(cols, RWKV_SIZES)
    log_w = jax.nn.log_sigmoid(w0.astype(F32) + jnp.tanh(wl) @ w2.astype(F32)) - 0.5
    decay = jnp.exp(-jnp.exp(log_w))
    a = jax.nn.sigmoid(a0.astype(F32) + al @ a2.astype(F32))
    g = jax.nn.sigmoid(gl) @ g2.astype(F32)
    heads = lambda z: z.reshape(b, t, RWKV_HEADS, RWKV_HD)
    r, k, v, decay, a = heads(r), heads(k), heads(v), heads(decay), heads(a)
    kk = k * k_k.astype(F32).reshape(RWKV_HEADS, RWKV_HD)
    kk = kk / jnp.maximum(jnp.sqrt(jnp.sum(kk * kk, axis=-1, keepdims=True)), 1e-12)
    k = k * (1.0 + (a - 1.0) * k_a.astype(F32).reshape(RWKV_HEADS, RWKV_HD))
    y = rwkv7_scan(r, decay, k, v, a, kk).reshape(b, t, RWKV_W)
    bonus = (jnp.sum(r * k * r_k.astype(F32), axis=-1, keepdims=True) * v).reshape(b, t, RWKV_W)
    return (head_norm(y, gain, RWKV_HEADS) + bonus) * g


def mlstm_group(cols, gain, conv_w, conv_b, i_b, f_b):
    b, t, _ = cols.shape
    qk, v, o, i_pre, f_pre = _split(cols.astype(F32), MLSTM_SIZES)
    qk = jax.nn.silu(causal_conv(qk, conv_w.astype(F32), conv_b.astype(F32)))
    q, k = jnp.split(qk, 2, axis=-1)
    heads = lambda z: z.reshape(b, t, MLSTM_HEADS, MLSTM_HD)
    h = mlstm_chunkwise(heads(q), heads(k), heads(v), i_pre + i_b.astype(F32),
                        jax.nn.log_sigmoid(f_pre + f_b.astype(F32)))
    return head_norm(h, gain, MLSTM_HEADS) * jax.nn.sigmoid(o)


def setup_inputs(seed: int = 0) -> dict:
    key = jax.random.key(seed)
    ks = jax.random.split(key, 26)
    nrm = lambda k, shape, scale: jax.random.normal(k, shape, F32) * scale
    L, D = DEPTH, D_MODEL
    return {
        'x': nrm(ks[0], (BATCH, SEQ, D), 1.0),
        'c': nrm(ks[1], (BATCH, D), 1.0),
        'ada_w': nrm(ks[2], (L, D, 6 * D), 0.5 * D ** -0.5),
        'ada_b': nrm(ks[3], (L, 6 * D), 0.02),
        'norm_mix': 1.0 + nrm(ks[4], (L, D), 0.02),
        'norm_ffn': 1.0 + nrm(ks[5], (L, D), 0.02),
        'w_in': nrm(ks[6], (L, D, D_IN), D ** -0.5),
        'mix_gn': 1.0 + nrm(ks[7], (L, D_MIX), 0.02),
        'rwkv_mu': jax.random.uniform(ks[8], (L, RWKV_IN), F32, 0.0, 1.0),
        'rwkv_w0': jnp.linspace(-6.0, -1.0, RWKV_W, dtype=F32)[None, :] + nrm(ks[9], (L, RWKV_W), 0.1),
        'rwkv_w2': nrm(ks[10], (L, RWKV_DECAY_LORA, RWKV_W), 0.5 * RWKV_DECAY_LORA ** -0.5),
        'rwkv_a0': nrm(ks[11], (L, RWKV_W), 0.1),
        'rwkv_a2': nrm(ks[12], (L, RWKV_ICL_LORA, RWKV_W), 0.5 * RWKV_ICL_LORA ** -0.5),
        'rwkv_g2': nrm(ks[13], (L, RWKV_GATE_LORA, RWKV_W), RWKV_GATE_LORA ** -0.5),
        'rwkv_k_k': 1.0 + nrm(ks[14], (L, RWKV_W), 0.05),
        'rwkv_k_a': 1.0 + nrm(ks[15], (L, RWKV_W), 0.05),
        'rwkv_r_k': nrm(ks[16], (L, RWKV_HEADS, RWKV_HD), 0.1),
        'mlstm_conv_w': nrm(ks[17], (L, MLSTM_CONV, 2 * MLSTM_W), MLSTM_CONV ** -0.5),
        'mlstm_conv_b': nrm(ks[18], (L, 2 * MLSTM_W), 0.02),
        'mlstm_i_b': nrm(ks[19], (L, MLSTM_HEADS), 0.1),
        'mlstm_f_b': jnp.linspace(3.0, 6.0, MLSTM_HEADS, dtype=F32)[None, :] + nrm(ks[20], (L, MLSTM_HEADS), 0.1),
        'w_out': nrm(ks[21], (L, D_MIX, D), D_MIX ** -0.5),
        'ffn_w_in': nrm(ks[22], (L, D, 2 * D_FF), D ** -0.5),
        'ffn_w_out': nrm(ks[23], (L, D_FF, D), D_FF ** -0.5),
        'final_norm': 1.0 + nrm(ks[24], (D,), 0.02),
    }


def reference(x, c, ada_w, ada_b, norm_mix, norm_ffn, w_in, mix_gn, rwkv_mu, rwkv_w0, rwkv_w2,
              rwkv_a0, rwkv_a2, rwkv_g2, rwkv_k_k, rwkv_k_a, rwkv_r_k, mlstm_conv_w, mlstm_conv_b,
              mlstm_i_b, mlstm_f_b, w_out, ffn_w_in, ffn_w_out, final_norm):
    cond = jax.nn.silu(c)
    for l in range(DEPTH):
        mod = cond @ ada_w[l] + ada_b[l]
        sh_m, sc_m, g_m, sh_f, sc_f, g_f = [z[:, None, :] for z in jnp.split(mod, 6, axis=-1)]
        h = rms_norm(x, norm_mix[l]) * (1.0 + sc_m) + sh_m
        proj = h @ w_in[l]
        ret_cols, rwkv_cols, mlstm_cols = _split(proj, (RET_IN, RWKV_IN, MLSTM_IN))
        gn_ret, gn_rwkv, gn_mlstm = _split(mix_gn[l], (RET_W, RWKV_W, MLSTM_W))
        y_ret = retention_group(ret_cols, gn_ret)
        y_rwkv = rwkv_group(rwkv_cols, gn_rwkv, rwkv_mu[l], rwkv_w0[l], rwkv_w2[l], rwkv_a0[l], rwkv_a2[l],
                            rwkv_g2[l], rwkv_k_k[l], rwkv_k_a[l], rwkv_r_k[l])
        y_mlstm = mlstm_group(mlstm_cols, gn_mlstm, mlstm_conv_w[l], mlstm_conv_b[l], mlstm_i_b[l], mlstm_f_b[l])
        mixed = jnp.concatenate([y_ret, y_rwkv, y_mlstm], axis=-1).astype(x.dtype)
        x = x + g_m * (mixed @ w_out[l])
        h = rms_norm(x, norm_ffn[l]) * (1.0 + sc_f) + sh_f
        gate, up = jnp.split(h @ ffn_w_in[l], 2, axis=-1)
        x = x + g_f * ((jax.nn.silu(gate) * up) @ ffn_w_out[l])
    return rms_norm(x, final_norm)
```

```cpp
#include <hip/hip_runtime.h>
#include <cstdio>
#include <cstdint>
__device__ __forceinline__ int lane_id_opq() { int l = (int)__builtin_amdgcn_mbcnt_hi(~0u, __builtin_amdgcn_mbcnt_lo(~0u, 0u)); asm volatile("" : "+v"(l)); return l; }

namespace pg8 {
#define PG8_LAS __attribute__((address_space(3)))
typedef unsigned short bf16_t;
typedef short bf16x8 __attribute__((ext_vector_type(8)));
typedef float f32x4 __attribute__((ext_vector_type(4)));
typedef unsigned u32x4 __attribute__((ext_vector_type(4)));
constexpr int BM = 256, BK = 64, HALF = 128, HTB = HALF * BK * 2  , STAGE_BYTES = 8 * HTB, NXCD = 8, WGM = 8;

__host__ __device__ __forceinline__ int lds_byte(int r, int c) { const int st = (r >> 4) * 2 + (c >> 5), rr = r & 15, cc = c & 31, ob = rr * 64 + cc * 2; return st * 1024 + (ob ^ (((ob >> 9) & 1) << 5)); }
__host__ __device__ __forceinline__ void stage_rc(int b, int& R, int& C) { const int st = b / 1024, sb = b % 1024, swz = sb ^ (((sb >> 9) & 1) << 5); R = (st >> 1) * 16 + swz / 64; C = (st & 1) * 32 + (swz % 64) / 2; }
__host__ __device__ __forceinline__ int perm32(int rho) { const int n = rho >> 4, i = rho & 15; return 8 * (i >> 2) + 4 * n + (i & 3); }

struct Unit { int pm, pn; };
struct Gemm { const bf16_t* A; const bf16_t* Bt; int M, N, K; };

struct StaticOrder {
    int nM, nN, nwg, G, c;
    __host__ __device__ void init(int M, int N, int G_, int c_) { nM = M / BM; nN = N / BM; nwg = nM * nN; G = G_; c = c_; }
    __host__ __device__ bool next(int i, Unit& u) const {
        const long L = (long)i * G + c; if (L >= nwg) return false;
        int wgid = (int)L; { const int q = nwg / NXCD, r = nwg % NXCD, xcd = wgid % NXCD, off = wgid / NXCD; wgid = (xcd < r ? xcd * (q + 1) : r * (q + 1) + (xcd - r) * q) + off; }
        const int nig = WGM * nN, gid = wgid / nig, fm = gid * WGM, gsz = (nM - fm) < WGM ? (nM - fm) : WGM;
        u.pm = fm + ((wgid % nig) % gsz); u.pn = (wgid % nig) / gsz; return true;
    }
    __device__ __forceinline__ void a_ready(const Unit&) const {}
    __device__ __forceinline__ void done(const Unit&) const {}
};

__device__ __forceinline__ unsigned cvt_pk_bf16(float lo, float hi) { unsigned r; asm volatile("v_cvt_pk_bf16_f32 %0, %1, %2" : "=v"(r) : "v"(lo), "v"(hi)); return r; }
typedef float f32x2 __attribute__((ext_vector_type(2)));

__device__ __forceinline__ float silu_f(float x) { return x * __builtin_amdgcn_rcpf(1.0f + __expf(-x)); }
struct EpiBf16Plain {
    static constexpr bool PERM = true, AFTER_DRAIN = false;
    bf16_t* O; int ldc;
    __device__ __forceinline__ void operator()(const f32x4 (&acc)[2][2][4][2], const Unit& u, int wr, int wc, int fr, int fq) const {
        const int row0 = u.pm * BM + wr * 64 + fr, col0 = u.pn * BM + wc * 32 + 8 * fq;
#pragma unroll
        for (int ai = 0; ai < 2; ++ai)
#pragma unroll
            for (int m = 0; m < 4; ++m) { bf16_t* rowp = O + (size_t)(row0 + ai * HALF + m * 16) * ldc + col0;
#pragma unroll
                for (int bj = 0; bj < 2; ++bj) { const f32x4 v0 = acc[ai][bj][m][0], v1 = acc[ai][bj][m][1];
                    u32x4 w; w.x = cvt_pk_bf16(v0[0], v0[1]); w.y = cvt_pk_bf16(v0[2], v0[3]); w.z = cvt_pk_bf16(v1[0], v1[1]); w.w = cvt_pk_bf16(v1[2], v1[3]);
                    *(u32x4*)(rowp + bj * HALF) = w; } }
    }
};
struct EpiSwiGLU {
    static constexpr bool PERM = true, AFTER_DRAIN = false;
    bf16_t* O; int ldc;
    __device__ __forceinline__ void operator()(const f32x4 (&acc)[2][2][4][2], const Unit& u, int wr, int wc, int fr, int fq) const {
        const int row0 = u.pm * BM + wr * 64 + fr, col0 = u.pn * HALF + wc * 32 + 8 * fq;
#pragma unroll
        for (int ai = 0; ai < 2; ++ai)
#pragma unroll
            for (int m = 0; m < 4; ++m) { bf16_t* rowp = O + (size_t)(row0 + ai * HALF + m * 16) * ldc + col0;
                const f32x4 g0 = acc[ai][0][m][0], g1 = acc[ai][0][m][1], u0 = acc[ai][1][m][0], u1 = acc[ai][1][m][1];
                u32x4 w; w.x = cvt_pk_bf16(silu_f(g0[0]) * u0[0], silu_f(g0[1]) * u0[1]); w.y = cvt_pk_bf16(silu_f(g0[2]) * u0[2], silu_f(g0[3]) * u0[3]);
                w.z = cvt_pk_bf16(silu_f(g1[0]) * u1[0], silu_f(g1[1]) * u1[1]); w.w = cvt_pk_bf16(silu_f(g1[2]) * u1[2], silu_f(g1[3]) * u1[3]);
                *(u32x4*)rowp = w; }
    }
};
struct EpiResGate {
    static constexpr bool PERM = false, AFTER_DRAIN = false;
    const float* xin; float* xout; int ldc; const float* gate; int gpitch;
    __device__ __forceinline__ void operator()(const f32x4 (&acc)[2][2][4][2], const Unit& u, int wr, int wc, int fr, int fq) const {
        const int row0 = u.pm * BM + wr * 64 + fr, col0 = u.pn * BM + wc * 32 + 4 * fq;
        const float* gp = gate + (size_t)(u.pm >> 3) * gpitch + col0;
        f32x4 gv[2][2];
#pragma unroll
        for (int bj = 0; bj < 2; ++bj)
#pragma unroll
            for (int n = 0; n < 2; ++n) gv[bj][n] = *(const f32x4*)(gp + bj * HALF + n * 16);
#pragma unroll
        for (int ai = 0; ai < 2; ++ai)
#pragma unroll
            for (int m = 0; m < 4; ++m) { const size_t off = (size_t)(row0 + ai * HALF + m * 16) * ldc + col0;
#pragma unroll
                for (int bj = 0; bj < 2; ++bj)
#pragma unroll
                    for (int n = 0; n < 2; ++n) { const f32x4 xi = *(const f32x4*)(xin + off + bj * HALF + n * 16);
                        *(f32x4*)(xout + off + bj * HALF + n * 16) = xi + gv[bj][n] * acc[ai][bj][m][n]; }
                asm volatile("" ::: "memory"); }
    }
};

template <class Epi, class Sched, bool ALIGN_EPI = false, bool SP2 = false>
__device__ __forceinline__ void gemm_phase(PG8_LAS unsigned char* lds, const Gemm g, const Sched& S, const Epi& E, const int wid_in) {
    const int wid = wid_in, lane = lane_id_opq(), tid = wid * 64 + lane, wr = wid >> 2, wc = wid & 3, fr = lane & 15, fq = lane >> 4;
    const int K = g.K, nt = K / BK;
    unsigned voffA[2], voffB[2];
#pragma unroll
    for (int i = 0; i < 2; ++i) { int R, C; stage_rc(tid * 16 + i * 8192, R, C); const int Rb = Epi::PERM ? ((R & ~31) + perm32(R & 31)) : R;
        voffA[i] = (unsigned)(R * K + C) * 2u; voffB[i] = (unsigned)(Rb * K + C) * 2u; }
    const size_t kstep = (size_t)(BK * 2);
    const size_t hstep = (size_t)HALF * K * 2;
    const size_t tstep = 2 * hstep;
    const unsigned ldsw = (unsigned)wid * 1024u;
    const int aoff = lds_byte(wr * 64 + fr, fq * 8), boff = lds_byte(wc * 32 + fr, fq * 8);
#define PG8_SA(b, h) (((b) * 2 + (h)) * HTB)
#define PG8_SB(b, h) ((4 + (b) * 2 + (h)) * HTB)
#define PG8_STAGE(bufoff, gbase, voff) do { _Pragma("unroll") for (int _i = 0; _i < 2; ++_i) \
        __builtin_amdgcn_global_load_lds((const unsigned*)((const char*)(gbase) + (voff)[_i]), (PG8_LAS unsigned*)(lds + (bufoff) + ldsw + _i * 8192), 16, 0, 0); } while (0)
#define PG8_LDA(dst, b, h) do { _Pragma("unroll") for (int m = 0; m < 4; ++m) _Pragma("unroll") for (int k = 0; k < 2; ++k) dst[m][k] = *(const PG8_LAS bf16x8*)(lds + PG8_SA(b, h) + aoff + m * 2048 + k * 1024); } while (0)
#define PG8_LDB(dst, b, h) do { _Pragma("unroll") for (int n = 0; n < 2; ++n) _Pragma("unroll") for (int k = 0; k < 2; ++k) dst[n][k] = *(const PG8_LAS bf16x8*)(lds + PG8_SB(b, h) + boff + n * 2048 + k * 1024); } while (0)
#define PG8_MMA(ai, bj, At, Bt) do { __builtin_amdgcn_s_setprio(1); _Pragma("unroll") for (int m = 0; m < 4; ++m) _Pragma("unroll") for (int n = 0; n < 2; ++n) _Pragma("unroll") for (int k = 0; k < 2; ++k) \
        acc[ai][bj][m][n] = __builtin_amdgcn_mfma_f32_16x16x32_bf16(Bt[n][k], At[m][k], acc[ai][bj][m][n], 0, 0, 0); __builtin_amdgcn_s_setprio(0); } while (0)
#define PG8_WAIT_V(n) asm volatile("s_waitcnt vmcnt(" #n ")" ::: "memory")
#define PG8_WAIT_L(n) asm volatile("s_waitcnt lgkmcnt(" #n ")" ::: "memory")
#define PG8_BAR __builtin_amdgcn_s_barrier()
#define PG8_SCHED __builtin_amdgcn_sched_barrier(0)
    Unit cur, nxt; int ui = 0;
    if (!S.next(0, cur)) return;
    f32x4 acc[2][2][4][2];
#pragma unroll
    for (int a = 0; a < 2; ++a)
#pragma unroll
        for (int b = 0; b < 2; ++b)
#pragma unroll
            for (int m = 0; m < 4; ++m)
#pragma unroll
                for (int n = 0; n < 2; ++n) acc[a][b][m][n] = (f32x4){0.f, 0.f, 0.f, 0.f};
    bf16x8 At[4][2], B0[2][2], B1[2][2];
    const char* cA = (const char*)g.A + (size_t)cur.pm * tstep; const char* cB = (const char*)g.Bt + (size_t)cur.pn * tstep;
    S.a_ready(cur);
    if constexpr (SP2) {
        PG8_STAGE(PG8_SB(0, 0), cB, voffB); PG8_STAGE(PG8_SB(0, 1), cB + hstep, voffB); PG8_STAGE(PG8_SA(0, 0), cA, voffA); PG8_STAGE(PG8_SA(0, 1), cA + hstep, voffA);
        if (wr == 1) PG8_BAR;
        PG8_WAIT_V(2); PG8_BAR;
        PG8_STAGE(PG8_SB(1, 0), cB + kstep, voffB); PG8_STAGE(PG8_SA(1, 0), cA + kstep, voffA); PG8_STAGE(PG8_SB(1, 1), cB + hstep + kstep, voffB);
        PG8_WAIT_V(6); PG8_BAR;
    } else {
        PG8_STAGE(PG8_SB(0, 0), cB, voffB); PG8_STAGE(PG8_SA(0, 0), cA, voffA); PG8_STAGE(PG8_SB(0, 1), cB + hstep, voffB); PG8_STAGE(PG8_SA(0, 1), cA + hstep, voffA);
        if (wr == 1) PG8_BAR;
        PG8_WAIT_V(4); PG8_BAR;
        PG8_STAGE(PG8_SB(1, 0), cB + kstep, voffB); PG8_STAGE(PG8_SA(1, 0), cA + kstep, voffA); PG8_STAGE(PG8_SB(1, 1), cB + hstep + kstep, voffB);
        PG8_WAIT_V(6); PG8_BAR;
    }
    for (;;) {
        const bool has_next = S.next(ui + 1, nxt);
        const char* nA = has_next ? (const char*)g.A + (size_t)nxt.pm * tstep : cA; const char* nB = has_next ? (const char*)g.Bt + (size_t)nxt.pn * tstep : cB;
        for (int t = 0; t < nt; t += 2) {
            const bool last = (t == nt - 2);
            const char* a1 = cA + (size_t)(t + 1) * kstep;
            const char* a2 = last ? nA : cA + (size_t)(t + 2) * kstep; const char* b2 = last ? nB : cB + (size_t)(t + 2) * kstep;
            const char* a3 = a2 + kstep; const char* b3 = b2 + kstep;
            if (last && has_next) S.a_ready(nxt);
            if constexpr (SP2) {
            PG8_LDB(B0, 0, 0); PG8_LDB(B1, 0, 1); PG8_SCHED; PG8_LDA(At, 0, 0); PG8_STAGE(PG8_SA(1, 1), a1 + hstep, voffA);
            PG8_WAIT_V(8); PG8_WAIT_L(0); PG8_BAR; PG8_MMA(0, 0, At, B0); PG8_MMA(0, 1, At, B1); PG8_BAR; PG8_SCHED;
            PG8_LDA(At, 0, 1); PG8_STAGE(PG8_SB(0, 0), b2, voffB); PG8_STAGE(PG8_SB(0, 1), b2 + hstep, voffB); PG8_STAGE(PG8_SA(0, 0), a2, voffA);
            PG8_WAIT_V(8); PG8_WAIT_L(0); PG8_BAR; PG8_MMA(1, 0, At, B0); PG8_MMA(1, 1, At, B1); PG8_BAR; PG8_SCHED;
            PG8_LDB(B0, 1, 0); PG8_LDB(B1, 1, 1); PG8_SCHED; PG8_LDA(At, 1, 0); PG8_STAGE(PG8_SA(0, 1), a2 + hstep, voffA);
            PG8_WAIT_V(8); PG8_WAIT_L(0); PG8_BAR; PG8_MMA(0, 0, At, B0); PG8_MMA(0, 1, At, B1); PG8_BAR; PG8_SCHED;
            PG8_LDA(At, 1, 1); PG8_STAGE(PG8_SB(1, 0), b3, voffB); PG8_STAGE(PG8_SB(1, 1), b3 + hstep, voffB); PG8_STAGE(PG8_SA(1, 0), a3, voffA);
            PG8_WAIT_V(8); PG8_WAIT_L(0); PG8_BAR; PG8_MMA(1, 0, At, B0); PG8_MMA(1, 1, At, B1); PG8_BAR; PG8_SCHED;
            } else {
            PG8_LDB(B0, 0, 0); PG8_SCHED; PG8_LDA(At, 0, 0); PG8_STAGE(PG8_SA(1, 1), a1 + hstep, voffA);
            PG8_WAIT_L(8); PG8_BAR; PG8_WAIT_L(0); PG8_MMA(0, 0, At, B0); PG8_BAR; PG8_SCHED;
            PG8_LDB(B1, 0, 1); PG8_STAGE(PG8_SB(0, 0), b2, voffB);
            PG8_BAR; PG8_WAIT_L(0); PG8_MMA(0, 1, At, B1); PG8_BAR;
            PG8_LDA(At, 0, 1); PG8_STAGE(PG8_SA(0, 0), a2, voffA);
            PG8_BAR; PG8_WAIT_L(0); PG8_MMA(1, 0, At, B0); PG8_BAR; PG8_SCHED;
            PG8_STAGE(PG8_SB(0, 1), b2 + hstep, voffB);
            PG8_WAIT_V(6); PG8_BAR; PG8_MMA(1, 1, At, B1); PG8_BAR;
            PG8_LDB(B0, 1, 0); PG8_SCHED; PG8_LDA(At, 1, 0); PG8_STAGE(PG8_SA(0, 1), a2 + hstep, voffA);
            PG8_WAIT_L(8); PG8_BAR; PG8_WAIT_L(0); PG8_MMA(0, 0, At, B0); PG8_BAR; PG8_SCHED;
            PG8_LDB(B1, 1, 1); PG8_STAGE(PG8_SB(1, 0), b3, voffB);
            PG8_BAR; PG8_WAIT_L(0); PG8_MMA(0, 1, At, B1); PG8_BAR;
            PG8_LDA(At, 1, 1); PG8_STAGE(PG8_SA(1, 0), a3, voffA);
            PG8_BAR; PG8_WAIT_L(0); PG8_MMA(1, 0, At, B0); PG8_BAR; PG8_SCHED;
            PG8_STAGE(PG8_SB(1, 1), b3 + hstep, voffB);
            PG8_WAIT_V(6); PG8_BAR; PG8_MMA(1, 1, At, B1); PG8_BAR;
            }
        }
        if constexpr (ALIGN_EPI) { if (wr == 0) PG8_BAR; }
        if constexpr (!Epi::AFTER_DRAIN) { E(acc, cur, wr, wc, fr, fq); S.done(cur); }
        if (!has_next) break;
#pragma unroll
        for (int a = 0; a < 2; ++a)
#pragma unroll
            for (int b = 0; b < 2; ++b)
#pragma unroll
                for (int m = 0; m < 4; ++m)
#pragma unroll
                    for (int n = 0; n < 2; ++n) acc[a][b][m][n] = (f32x4){0.f, 0.f, 0.f, 0.f};
        cur = nxt; cA = nA; cB = nB; ++ui;
        if constexpr (ALIGN_EPI) { if (wr == 1) PG8_BAR; }
    }
    PG8_WAIT_V(0);
    if constexpr (!ALIGN_EPI) { if (wr == 0) PG8_BAR; }
    PG8_BAR;
    if constexpr (Epi::AFTER_DRAIN) { E.fused(acc, cur, wr, wc, fr, fq, lds, wid, lane); S.done(cur); }
#undef PG8_SA
#undef PG8_SB
#undef PG8_STAGE
#undef PG8_LDA
#undef PG8_LDB
#undef PG8_MMA
#undef PG8_WAIT_V
#undef PG8_WAIT_L
#undef PG8_BAR
#undef PG8_SCHED
}
}

#ifndef MK_PER_PHASE
#define MK_PER_PHASE 0
#endif
constexpr int NWAVES = 8;
constexpr int DM = 1024, NB = 32, SEQ = 2048, NL = 4, MT = NB * SEQ;
constexpr int D_IN = 3976, NPI = 4096, DFF = 2816, NF1 = 2 * DFF;
constexpr int RW_B = 1024, ML_B = 2432;
constexpr int RWKV_IN = 1408;
constexpr float RMS_EPS = 1e-6f, GN_EPS = 1e-5f;
constexpr int MODP = 6 * DM;
constexpr size_t MiB = 1u << 20;
constexpr size_t WS_CTL = 0, CTL_ZERO_BYTES = 1 * MiB;
constexpr size_t WS_MOD = 1 * MiB;
constexpr size_t WS_WIN = 8 * MiB, WS_WOUT = 40 * MiB, WS_WF1 = 48 * MiB, WS_WF2 = 92 * MiB;
constexpr size_t WS_H = 128 * MiB;
constexpr size_t WS_PROJ = 256 * MiB;
constexpr size_t WS_DEC = 768 * MiB, WS_AA = 864 * MiB, WS_GG = 912 * MiB;
constexpr size_t WS_END = 960 * MiB;
constexpr int CW_BAR = 4096;
constexpr int N_PHASES = 2 + 9 * NL;
static_assert((CW_BAR + (MK_PER_PHASE ? 1 : 1) * 3456) * 4 <= (int)CTL_ZERO_BYTES, "ctl");
constexpr int RING_BYTES = 131072, LDSCTL_OFF = RING_BYTES, MISC_OFF = LDSCTL_OFF + 320, LDS_BYTES = 147456;

#define GAS __attribute__((address_space(1)))
#define LAS __attribute__((address_space(3)))
typedef unsigned short bf16;
typedef unsigned v4u __attribute__((ext_vector_type(4)));
typedef unsigned v2u __attribute__((ext_vector_type(2)));
typedef float f32x4 __attribute__((ext_vector_type(4)));
#define LDS_WAIT() asm volatile("s_waitcnt lgkmcnt(0)" ::: "memory")
__device__ __forceinline__ unsigned f2bf(float f) { unsigned u = __builtin_bit_cast(unsigned, f); return (u + 0x7fffu + ((u >> 16) & 1u)) >> 16; }
__device__ __forceinline__ unsigned pk2(float lo, float hi) { return f2bf(lo) | (f2bf(hi) << 16); }
__device__ __forceinline__ float bf2f(bf16 v) { return __uint_as_float(((unsigned)v) << 16); }
__device__ __forceinline__ float wave_sum(float v) {
#pragma unroll
    for (int o = 1; o < 64; o <<= 1) v += __shfl_xor(v, o);
    return v;
}
__device__ __forceinline__ float sigmoid_f(float x) { return 1.0f / (1.0f + expf(-x)); }
__device__ __forceinline__ float logsigmoid_f(float x) { return fminf(x, 0.f) - log1pf(expf(-fabsf(x))); }
template <class T> __device__ __forceinline__ T* opq(T* p) { asm volatile("" : "+s"(p)); return p; }

#define XB_TMO      128
#define XB_XCNT(j)  (256  + 64 * (j))
#define XB_XSUB(j)  (1280 + 64 * (j))
#define XB_XGEN(j)  (2304 + 64 * (j))
#define XB_TOP      3328
#define XB_TOPGEN   3392
#define XCD_BAR_WORDS 3456
#define XB_SPIN_CAP (1u << 22)

__device__ __forceinline__ unsigned xb_ld(unsigned* p)              { return __hip_atomic_load(p, __ATOMIC_RELAXED, __HIP_MEMORY_SCOPE_AGENT); }
__device__ __forceinline__ unsigned xb_add(unsigned* p, unsigned v) { return __hip_atomic_fetch_add(p, v, __ATOMIC_RELAXED, __HIP_MEMORY_SCOPE_AGENT); }
__device__ __forceinline__ unsigned xb_xcc_id() { return (unsigned)__builtin_amdgcn_s_getreg((3 << 11) | 20) & 0xFu; }
#define XB_SPIN(cond, bar) do { unsigned _sp = 0; while (cond) { __builtin_amdgcn_s_sleep(1); \
    if ((++_sp & 255u) == 0u) { if (xb_ld(&(bar)[XB_TMO])) break; if (_sp > XB_SPIN_CAP) { atomicAdd(&(bar)[XB_TMO], 1u); break; } } } } while (0)

struct XcdBarrier {
    unsigned* bar; unsigned x;
    volatile LAS unsigned* st;
};

__device__ __forceinline__ XcdBarrier xcd_barrier_post(unsigned* bar, volatile LAS unsigned* st) {
    XcdBarrier b; b.bar = bar; b.x = xb_xcc_id(); b.st = st;
    if (threadIdx.x == 0) (void)xb_add(&bar[XB_XCNT(b.x)], 1u);
    return b;
}
__device__ __forceinline__ void xcd_barrier_complete(unsigned* bar, unsigned x, unsigned& nloc, unsigned& nx) {
    const unsigned G = gridDim.x * gridDim.y * gridDim.z;
    unsigned sum, cnt, mine, sp = 0u;
    for (;;) {
        sum = 0u; cnt = 0u; mine = 0u;
#pragma unroll
        for (unsigned j = 0; j < 16; ++j) { const unsigned c = xb_ld(&bar[XB_XCNT(j)]); sum += c; cnt += (c > 0u) ? 1u : 0u; mine = (j == x) ? c : mine; }
        if (sum == G) break;
        __builtin_amdgcn_s_sleep(1);
        if ((++sp & 255u) == 0u) { if (xb_ld(&bar[XB_TMO])) break; if (sp > XB_SPIN_CAP) { atomicAdd(&bar[XB_TMO], 1u); break; } }
    }
    nloc = mine > 0u ? mine : 1u; nx = cnt > 0u ? cnt : 1u;
}

__device__ __forceinline__ void xcd_barrier(const XcdBarrier& b) {
    asm volatile("s_waitcnt vmcnt(0)" ::: "memory");
    __syncthreads();
    if (threadIdx.x == 0) {
        unsigned* bar = b.bar;
        __builtin_amdgcn_s_waitcnt(0);
        unsigned nloc = b.st[0], nx = b.st[1];
        if (nloc == 0u) { xcd_barrier_complete(bar, b.x, nloc, nx); b.st[0] = nloc; b.st[1] = nx; }
        const unsigned old = xb_add(&bar[XB_XSUB(b.x)], 1u);
        const unsigned gen = old / nloc;
        if (old + 1u == (gen + 1u) * nloc) {
            __builtin_amdgcn_fence(__ATOMIC_RELEASE, "agent");
            asm volatile("s_waitcnt vmcnt(0)" ::: "memory");
            const unsigned og = xb_add(&bar[XB_TOP], 1u);
            const unsigned tg = og / nx;
            if (og + 1u == (tg + 1u) * nx) xb_add(&bar[XB_TOPGEN], 1u);
            else XB_SPIN(xb_ld(&bar[XB_TOPGEN]) == tg, bar);
            __builtin_amdgcn_fence(__ATOMIC_ACQUIRE, "agent");
            xb_add(&bar[XB_XGEN(b.x)], 1u);
            asm volatile("s_waitcnt vmcnt(0)" ::: "memory");
        } else {
            XB_SPIN(xb_ld(&bar[XB_XGEN(b.x)]) == gen, bar);
            __builtin_amdgcn_fence(__ATOMIC_ACQUIRE, "agent");
            asm volatile("s_waitcnt vmcnt(0)" ::: "memory");
        }
    }
    __syncthreads();
}


__device__ __forceinline__ void p0_mod(const float* c, const float* ada_w, const float* ada_b, float* mod, LAS unsigned char* lds, int tid, int lane, int wave) {
    LAS float* condT = (LAS float*)lds;
    for (int e = tid; e < NB * DM; e += NWAVES * 64) { const int k = e >> 5, b = e & 31; const float v = c[b * DM + k]; condT[e] = v / (1.0f + expf(-v)); }
    __syncthreads();
    for (int item = blockIdx.x; item < NL * 96; item += gridDim.x) {
        const int l = item / 96, g = item % 96, n = g * 64 + lane;
        const float* W = ada_w + (size_t)l * DM * MODP + n;
        float a0 = 0.f, a1 = 0.f, a2 = 0.f, a3 = 0.f;
        for (int k = 0; k < DM; k += 8) {
            float w[8];
#pragma unroll
            for (int u = 0; u < 8; ++u) w[u] = W[(size_t)(k + u) * MODP];
#pragma unroll
            for (int u = 0; u < 8; ++u) { const f32x4 cv = *(const LAS f32x4*)(condT + (k + u) * 32 + wave * 4); a0 += cv.x * w[u]; a1 += cv.y * w[u]; a2 += cv.z * w[u]; a3 += cv.w * w[u]; }
        }
        const float bb = ada_b[l * MODP + n]; float* o = mod + ((size_t)l * NB + wave * 4) * MODP + n;
        o[0] = a0 + bb; o[MODP] = a1 + bb; o[2 * MODP] = a2 + bb; o[3 * MODP] = a3 + bb;
    }
    __syncthreads();
}
template <int MODE>
__device__ __forceinline__ void transpose_item(const float* W, int K, int N, int nblk, bf16* WT, LAS float* scr, int item, int lane) {
    const int kb = item / nblk, nb = item % nblk, k0 = 64 * kb, n0 = 32 * nb;
    const int nn = n0 + (lane & 31); const bool ok = nn < N;
#pragma unroll 8
    for (int i = 0; i < 32; ++i) { const int kk = 2 * i + (lane >> 5); scr[kk * 33 + (lane & 31)] = ok ? W[(size_t)(k0 + kk) * N + nn] : 0.f; }
    LDS_WAIT();
    const int c = lane & 7;
#pragma unroll
    for (int j = 0; j < 4; ++j) { const int n = (lane >> 3) + 8 * j; const LAS float* s = scr + (8 * c) * 33 + n;
        v4u o; o.x = pk2(s[0 * 33], s[1 * 33]); o.y = pk2(s[2 * 33], s[3 * 33]); o.z = pk2(s[4 * 33], s[5 * 33]); o.w = pk2(s[6 * 33], s[7 * 33]);
        int row = n0 + n;
        if (MODE == 1) { const int up = row >= DFF ? 1 : 0, jj = row - up * DFF; row = (jj >> 7) * 256 + up * 128 + (jj & 127); }
        *(v4u*)(WT + (size_t)row * K + k0 + 8 * c) = o; }
    LDS_WAIT();
}
__device__ __forceinline__ void p0_weights(const float* w_in, const float* w_out, const float* f1, const float* f2, unsigned char* ws, LAS unsigned char* lds, int gw, int ngw, int wave, int lane) {
    LAS float* scr = (LAS float*)(lds + wave * 16384);
    constexpr int I_IN = (DM / 64) * (NPI / 32), I_OUT = (DM / 64) * (DM / 32), I_F1 = (DM / 64) * (NF1 / 32), I_F2 = (DFF / 64) * (DM / 32), I_L = I_IN + I_OUT + I_F1 + I_F2;
    for (int it = gw; it < NL * I_L; it += ngw) {
        const int l = it / I_L; int r = it % I_L;
        if (r < I_IN) { transpose_item<0>(w_in + (size_t)l * DM * D_IN, DM, D_IN, NPI / 32, (bf16*)(ws + WS_WIN) + (size_t)l * NPI * DM, scr, r, lane); continue; } r -= I_IN;
        if (r < I_OUT) { transpose_item<0>(w_out + (size_t)l * DM * DM, DM, DM, DM / 32, (bf16*)(ws + WS_WOUT) + (size_t)l * DM * DM, scr, r, lane); continue; } r -= I_OUT;
        if (r < I_F1) { transpose_item<1>(f1 + (size_t)l * DM * NF1, DM, NF1, NF1 / 32, (bf16*)(ws + WS_WF1) + (size_t)l * NF1 * DM, scr, r, lane); continue; } r -= I_F1;
        transpose_item<0>(f2 + (size_t)l * DFF * DM, DFF, DM, DM / 32, (bf16*)(ws + WS_WF2) + (size_t)l * DM * DFF, scr, r, lane);
    }
}
__device__ __forceinline__ void norm_mod_phase(const float* xin, const float* gain, const float* modl, int sh_off, int sc_off, bf16* out, int gw, int ngw, int lane) {
    for (int ci = gw; ci < MT / 32; ci += ngw) {
        const int b = ci >> 6; const float* mb = modl + (size_t)b * MODP;
        f32x4 gs[4], sh[4];
#pragma unroll
        for (int j = 0; j < 4; ++j) { const int col = 4 * lane + 256 * j; const f32x4 g = *(const f32x4*)(gain + col), s = *(const f32x4*)(mb + sc_off + col); gs[j] = g * (s + 1.0f); sh[j] = *(const f32x4*)(mb + sh_off + col); }
        for (int r = 0; r < 32; ++r) {
            const size_t row = (size_t)ci * 32 + r; const f32x4* xr = (const f32x4*)(xin + row * DM) + lane;
            f32x4 v[4]; float ss = 0.f;
#pragma unroll
            for (int j = 0; j < 4; ++j) { v[j] = xr[64 * j]; ss += (v[j].x * v[j].x + v[j].y * v[j].y) + (v[j].z * v[j].z + v[j].w * v[j].w); }
            const float rstd = 1.0f / sqrtf(wave_sum(ss) * (1.0f / DM) + RMS_EPS);
            v2u* o8 = (v2u*)(out + row * DM) + lane;
#pragma unroll
            for (int j = 0; j < 4; ++j) { const f32x4 y = v[j] * rstd * gs[j] + sh[j]; v2u w; w.x = pk2(y.x, y.y); w.y = pk2(y.z, y.w); o8[64 * j] = w; }
        }
    }
}
__device__ __forceinline__ void final_norm_phase(float* x, const float* gain, int gw, int ngw, int lane) {
    f32x4 g[4];
#pragma unroll
    for (int j = 0; j < 4; ++j) g[j] = *(const f32x4*)(gain + 4 * lane + 256 * j);
    for (int row = gw; row < MT; row += ngw) {
        f32x4* xr = (f32x4*)(x + (size_t)row * DM) + lane; f32x4 v[4]; float ss = 0.f;
#pragma unroll
        for (int j = 0; j < 4; ++j) { v[j] = xr[64 * j]; ss += (v[j].x * v[j].x + v[j].y * v[j].y) + (v[j].z * v[j].z + v[j].w * v[j].w); }
        const float rstd = 1.0f / sqrtf(wave_sum(ss) * (1.0f / DM) + RMS_EPS);
#pragma unroll
        for (int j = 0; j < 4; ++j) xr[64 * j] = v[j] * rstd * g[j];
    }
}
__device__ __forceinline__ void rwkv_prep_phase(const bf16* proj, const float* mu, const float* w0, const float* w2, const float* a0, const float* a2, const float* g2,
                                                float* DEC, bf16* AA, bf16* GG, LAS unsigned char* lds, int tid) {
    LAS float* act = (LAS float*)lds;
    for (int item = blockIdx.x; item < MT / 64; item += gridDim.x) {
        const size_t m0 = (size_t)item * 64; const int t0 = (int)(m0 % SEQ);
        w2 = opq(w2); a2 = opq(a2); g2 = opq(g2); proj = opq(proj); DEC = opq(DEC); AA = opq(AA); GG = opq(GG);
        for (int i = 0; i < 32; ++i) { const int idx = tid + i * 512, tt = idx >> 8, ic = idx & 255;
            const bf16* pp = proj + (m0 + tt) * NPI + RW_B + 1152 + ic;
            const float p = bf2f(pp[0]), q = (t0 + tt == 0) ? 0.f : bf2f(*(pp - NPI));
            const float x = p + (q - p) * mu[1152 + ic];
            act[idx] = ic < 64 ? tanhf(x) : (ic < 128 ? x : sigmoid_f(x)); }
        __syncthreads();
        if (tid < 384) { const int j = tid;
            { float Wr[64];
#pragma unroll
              for (int i = 0; i < 64; ++i) Wr[i] = w2[i * 384 + j];
              const float w0j = w0[j];
#pragma unroll 1
              for (int tt = 0; tt < 64; ++tt) { float s = 0.f;
#pragma unroll
                  for (int i4 = 0; i4 < 16; ++i4) { const f32x4 a = *(const LAS f32x4*)(act + tt * 256 + 4 * i4); s += a.x * Wr[4 * i4] + a.y * Wr[4 * i4 + 1] + a.z * Wr[4 * i4 + 2] + a.w * Wr[4 * i4 + 3]; if ((i4 & 3) == 3) asm volatile("" ::: "memory"); }
                  const float lw = logsigmoid_f(w0j + s) - 0.5f; DEC[(m0 + tt) * 384 + j] = expf(-expf(lw)); } }
            { float Wr[64];
#pragma unroll
              for (int i = 0; i < 64; ++i) Wr[i] = a2[i * 384 + j];
              const float a0j = a0[j];
#pragma unroll 1
              for (int tt = 0; tt < 64; ++tt) { float s = 0.f;
#pragma unroll
                  for (int i4 = 0; i4 < 16; ++i4) { const f32x4 a = *(const LAS f32x4*)(act + tt * 256 + 64 + 4 * i4); s += a.x * Wr[4 * i4] + a.y * Wr[4 * i4 + 1] + a.z * Wr[4 * i4 + 2] + a.w * Wr[4 * i4 + 3]; if ((i4 & 3) == 3) asm volatile("" ::: "memory"); }
                  AA[(m0 + tt) * 384 + j] = (bf16)f2bf(sigmoid_f(a0j + s)); } }
            { float Wr[128];
#pragma unroll
              for (int i = 0; i < 128; ++i) Wr[i] = g2[i * 384 + j];
#pragma unroll 1
              for (int tt = 0; tt < 64; ++tt) { float s = 0.f;
#pragma unroll
                  for (int i4 = 0; i4 < 32; ++i4) { const f32x4 a = *(const LAS f32x4*)(act + tt * 256 + 128 + 4 * i4); s += a.x * Wr[4 * i4] + a.y * Wr[4 * i4 + 1] + a.z * Wr[4 * i4 + 2] + a.w * Wr[4 * i4 + 3]; if ((i4 & 3) == 3) asm volatile("" ::: "memory"); }
                  GG[(m0 + tt) * 384 + j] = (bf16)f2bf(s); } }
        }
        __syncthreads();
    }
}
__device__ __forceinline__ void rwkv_scan_v1(int b, int h, const bf16* proj, const float* DEC, const bf16* AA, const bf16* GG, const float* mu, const float* k_k, const float* k_a, const float* r_k,
                                             const float* gn, bf16* mixed, LAS float* scr, LAS float* st, int lane) {
    const int c = h * 64 + lane;
    const float mu_r = mu[c], mu_k = mu[384 + c], mu_v = mu[768 + c], kkc = k_k[c], kac = k_a[c], rkc = r_k[c], gain = gn[256 + c];
    for (int j = 0; j < 64; ++j) st[j * 64 + lane] = 0.f;
    float pr = 0.f, pk = 0.f, pv = 0.f;
    const size_t m0 = (size_t)b * SEQ;
#pragma unroll 1
    for (int t = 0; t < SEQ; ++t) {
        const bf16* P = opq(proj + (m0 + t) * NPI + RW_B); const size_t mc = (m0 + t) * 384 + c;
        const float cr = bf2f(P[c]), ck = bf2f(P[384 + c]), cv = bf2f(P[768 + c]), dec = DEC[mc], a = bf2f(AA[mc]), g = bf2f(GG[mc]);
        const float r = cr + (pr - cr) * mu_r, k = ck + (pk - ck) * mu_k, v = cv + (pv - cv) * mu_v; pr = cr; pk = ck; pv = cv;
        float kk = k * kkc; const float nrm = sqrtf(wave_sum(kk * kk)); kk = kk / fmaxf(nrm, 1e-12f);
        const float kmod = k * (1.0f + (a - 1.0f) * kac), kka = kk * a;
        const float bon = wave_sum(r * kmod * rkc);
        asm volatile("s_waitcnt lgkmcnt(0)" ::: "memory");
        scr[lane] = dec; scr[64 + lane] = -kk; scr[128 + lane] = kka; scr[192 + lane] = kmod; scr[256 + lane] = r;
        asm volatile("s_waitcnt lgkmcnt(0)" ::: "memory");
        float sa = 0.f;
#pragma unroll 4
        for (int j = 0; j < 64; ++j) sa += st[j * 64 + lane] * scr[64 + j];
        float y = 0.f;
#pragma unroll 4
        for (int j = 0; j < 64; ++j) { const float sn = st[j * 64 + lane] * scr[j] + sa * scr[128 + j] + v * scr[192 + j]; st[j * 64 + lane] = sn; y += sn * scr[256 + j]; }
        const float mean = wave_sum(y) * (1.0f / 64.0f), d = y - mean, var = wave_sum(d * d) * (1.0f / 64.0f);
        const float yn = d * (1.0f / sqrtf(var + GN_EPS)) * gain;
        mixed[(m0 + t) * DM + 256 + c] = (bf16)f2bf((yn + bon * v) * g);
    }
}
__device__ __forceinline__ void ret_scan_v1(int b, int h, const bf16* proj, const float* gn, bf16* mixed, LAS float* scr, LAS float* st, int lane) {
    const int c = h * 64 + lane, fi = lane & 31;
    const float gain = gn[c], gamma = 1.0f - exp2f(-5.0f - (float)h);
    const float inv = powf(10000.0f, -(float)(2 * fi) / 64.0f);
    for (int j = 0; j < 64; ++j) st[j * 64 + lane] = 0.f;
    const size_t m0 = (size_t)b * SEQ;
#pragma unroll 1
    for (int t = 0; t < SEQ; ++t) {
        const bf16* P = opq(proj + (m0 + t) * NPI);
        const float q = bf2f(P[c]), k = bf2f(P[256 + c]), v = bf2f(P[512 + c]), g = bf2f(P[768 + c]);
        float sn, cs; sincosf((float)t * inv, &sn, &cs);
        const float qp = __shfl_xor(q, 32), kp = __shfl_xor(k, 32);
        const float qr = lane < 32 ? q * cs - qp * sn : qp * sn + q * cs;
        const float kr = (lane < 32 ? k * cs - kp * sn : kp * sn + k * cs) * 0.125f;
        asm volatile("s_waitcnt lgkmcnt(0)" ::: "memory");
        scr[lane] = qr; scr[64 + lane] = kr;
        asm volatile("s_waitcnt lgkmcnt(0)" ::: "memory");
        float y = 0.f;
#pragma unroll 4
        for (int j = 0; j < 64; ++j) { const float s2 = st[j * 64 + lane] * gamma + scr[64 + j] * v; st[j * 64 + lane] = s2; y += s2 * scr[j]; }
        const float mean = wave_sum(y) * (1.0f / 64.0f), d = y - mean, var = wave_sum(d * d) * (1.0f / 64.0f);
        mixed[(m0 + t) * DM + c] = (bf16)f2bf(d * (1.0f / sqrtf(var + GN_EPS)) * gain * (g * sigmoid_f(g)));
    }
}
__device__ __forceinline__ void mlstm_scan_v1(int b, int h, int half, const bf16* proj, const float* conv_w, const float* conv_b, const float* i_b, const float* f_b, bf16* mixed, LAS float* scr, LAS float* st, int lane) {
    const int d0 = lane, d1 = 64 + (lane & 31);
    const int cq0 = h * 96 + d0, cq1 = h * 96 + d1, ck0 = 384 + cq0, ck1 = 384 + cq1;
    float wq0[4], wq1[4], wk0[4], wk1[4];
#pragma unroll
    for (int j = 0; j < 4; ++j) { wq0[j] = conv_w[j * 768 + cq0]; wq1[j] = conv_w[j * 768 + cq1]; wk0[j] = conv_w[j * 768 + ck0]; wk1[j] = conv_w[j * 768 + ck1]; }
    const float bq0 = conv_b[cq0], bq1 = conv_b[cq1], bk0 = conv_b[ck0], bk1 = conv_b[ck1];
    const float ib = i_b[h], fb = f_b[h];
    const int e = 48 * half + (lane < 48 ? lane : 0);
    float hq0[3] = {0.f, 0.f, 0.f}, hq1[3] = {0.f, 0.f, 0.f}, hk0[3] = {0.f, 0.f, 0.f}, hk1[3] = {0.f, 0.f, 0.f};
    for (int j = 0; j < 96; ++j) st[j * 64 + lane] = 0.f;
    float n0 = 0.f, n1 = 0.f, mst = 0.f;
    const size_t m0 = (size_t)b * SEQ;
#pragma unroll 1
    for (int t = 0; t < SEQ; ++t) {
        const bf16* P = opq(proj + (m0 + t) * NPI + ML_B);
        const float cq0v = bf2f(P[cq0]), cq1v = bf2f(P[cq1]), ck0v = bf2f(P[ck0]), ck1v = bf2f(P[ck1]), v = bf2f(P[768 + h * 96 + e]), ipre = bf2f(P[1536 + h]), fpre = bf2f(P[1540 + h]);
        float q0 = bq0 + hq0[0] * wq0[0] + hq0[1] * wq0[1] + hq0[2] * wq0[2] + cq0v * wq0[3]; hq0[0] = hq0[1]; hq0[1] = hq0[2]; hq0[2] = cq0v;
        float q1 = bq1 + hq1[0] * wq1[0] + hq1[1] * wq1[1] + hq1[2] * wq1[2] + cq1v * wq1[3]; hq1[0] = hq1[1]; hq1[1] = hq1[2]; hq1[2] = cq1v;
        float k0 = bk0 + hk0[0] * wk0[0] + hk0[1] * wk0[1] + hk0[2] * wk0[2] + ck0v * wk0[3]; hk0[0] = hk0[1]; hk0[1] = hk0[2]; hk0[2] = ck0v;
        float k1 = bk1 + hk1[0] * wk1[0] + hk1[1] * wk1[1] + hk1[2] * wk1[2] + ck1v * wk1[3]; hk1[0] = hk1[1]; hk1[1] = hk1[2]; hk1[2] = ck1v;
        const float ksc = 0.10206207261596577f;
        q0 = q0 * sigmoid_f(q0); q1 = q1 * sigmoid_f(q1); k0 = k0 * sigmoid_f(k0) * ksc; k1 = k1 * sigmoid_f(k1) * ksc;
        const float ip = ipre + ib, lf = logsigmoid_f(fpre + fb);
        const float mnew = fmaxf(lf + mst, ip), fdec = expf(lf + mst - mnew), iw = expf(ip - mnew); mst = mnew;
        n0 = fdec * n0 + iw * k0; n1 = fdec * n1 + iw * k1;
        const float den = wave_sum(q0 * n0 + (lane < 32 ? q1 * n1 : 0.f));
        asm volatile("s_waitcnt lgkmcnt(0)" ::: "memory");
        scr[d0] = q0; scr[96 + d0] = k0; if (lane < 32) { scr[d1] = q1; scr[96 + d1] = k1; }
        asm volatile("s_waitcnt lgkmcnt(0)" ::: "memory");
        const float iv = iw * v; float num = 0.f;
#pragma unroll 4
        for (int j = 0; j < 96; ++j) { const float cn = st[j * 64 + lane] * fdec + scr[96 + j] * iv; st[j * 64 + lane] = cn; num += cn * scr[j]; }
        const float hv = num / fmaxf(fabsf(den), expf(-mnew));
        if (lane < 48) mixed[(m0 + t) * DM + 640 + h * 96 + e] = (bf16)f2bf(hv);
    }
}
__device__ __forceinline__ float sum16(float v) { v += __shfl_xor(v, 1); v += __shfl_xor(v, 2); v += __shfl_xor(v, 4); v += __shfl_xor(v, 8); return v; }
__device__ __forceinline__ void mlstm_fix_phase(const bf16* proj, const float* gn, bf16* mixed, int gw, int ngw, int lane) {
    const float g0 = gn[640 + 6 * lane], g1 = gn[641 + 6 * lane], g2 = gn[642 + 6 * lane], g3 = gn[643 + 6 * lane], g4 = gn[644 + 6 * lane], g5 = gn[645 + 6 * lane];
    for (int row = gw; row < MT; row += ngw) {
        unsigned* mr = (unsigned*)(mixed + (size_t)row * DM + 640) + 3 * lane; const unsigned* orow = (const unsigned*)(proj + (size_t)row * NPI + ML_B + 1152) + 3 * lane;
        const unsigned a0 = mr[0], a1 = mr[1], a2 = mr[2], o0 = orow[0], o1 = orow[1], o2 = orow[2];
        const float v0 = __uint_as_float(a0 << 16), v1 = __uint_as_float(a0 & 0xffff0000u), v2 = __uint_as_float(a1 << 16), v3 = __uint_as_float(a1 & 0xffff0000u), v4 = __uint_as_float(a2 << 16), v5 = __uint_as_float(a2 & 0xffff0000u);
        const float mean = sum16((v0 + v1) + (v2 + v3) + (v4 + v5)) * (1.0f / 96.0f);
        const float d0 = v0 - mean, d1 = v1 - mean, d2 = v2 - mean, d3 = v3 - mean, d4 = v4 - mean, d5 = v5 - mean;
        const float rs = 1.0f / sqrtf(sum16((d0 * d0 + d1 * d1) + (d2 * d2 + d3 * d3) + (d4 * d4 + d5 * d5)) * (1.0f / 96.0f) + GN_EPS);
        const float r0 = d0 * rs * g0 * sigmoid_f(__uint_as_float(o0 << 16)), r1 = d1 * rs * g1 * sigmoid_f(__uint_as_float(o0 & 0xffff0000u));
        const float r2 = d2 * rs * g2 * sigmoid_f(__uint_as_float(o1 << 16)), r3 = d3 * rs * g3 * sigmoid_f(__uint_as_float(o1 & 0xffff0000u));
        const float r4 = d4 * rs * g4 * sigmoid_f(__uint_as_float(o2 << 16)), r5 = d5 * rs * g5 * sigmoid_f(__uint_as_float(o2 & 0xffff0000u));
        mr[0] = pk2(r0, r1); mr[1] = pk2(r2, r3); mr[2] = pk2(r4, r5);
    }
}

struct Args { const float* in[25]; float* out; unsigned char* ws; int ph_lo, ph_hi, li, pad; };
typedef const __attribute__((address_space(4))) Args* KArgs;
__device__ __forceinline__ KArgs kargs() { KArgs p = (KArgs)__builtin_amdgcn_kernarg_segment_ptr(); asm volatile("" : "+s"(p)); return p; }
#ifndef DBG_MASK
#define DBG_MASK 0xFFFF
#endif
#define EN(bit) ((DBG_MASK >> (bit)) & 1)
__global__ void __launch_bounds__(NWAVES * 64, 2) mk_fwd(Args args_unused) {
    extern __shared__ __attribute__((aligned(16))) unsigned char lds_raw[];
    LAS unsigned char* lds = (LAS unsigned char*)lds_raw;
    volatile LAS unsigned* MISC = (volatile LAS unsigned*)(lds + MISC_OFF);
    const int wave = __builtin_amdgcn_readfirstlane((int)threadIdx.x >> 6);
    const int G = gridDim.x, gw = blockIdx.x * NWAVES + wave, ngw = G * NWAVES;
    for (int u = threadIdx.x; u < (LDS_BYTES - LDSCTL_OFF) / 4; u += NWAVES * 64) ((LAS unsigned*)(lds + LDSCTL_OFF))[u] = 0u;
    __syncthreads();
    XcdBarrier bar; int lo, hi;
    { KArgs A = kargs(); bar = xcd_barrier_post((unsigned*)(A->ws + WS_CTL) + CW_BAR + (MK_PER_PHASE ? 0 : A->li) * XCD_BAR_WORDS, MISC + 8); lo = A->ph_lo; hi = A->ph_hi; }
#define IN(k) (lo <= (k) && (k) < hi)
#define SEAM(k) do { if (IN(k) && IN((k) + 1)) xcd_barrier(bar); } while (0)
#define LANE_TID() const int lane_o = lane_id_opq(), tid_o = wave * 64 + lane_o; (void)tid_o

    if (EN(0) && IN(0)) {
        KArgs A = kargs(); unsigned char* ws = A->ws; LANE_TID();
        p0_mod(A->in[1], A->in[2], A->in[3], (float*)(ws + WS_MOD), lds, tid_o, lane_o, wave);
        p0_weights(A->in[6], A->in[21], A->in[22], A->in[23], ws, lds, gw, ngw, wave, lane_o);
    }
    SEAM(0);
#pragma unroll 1
    for (int l = 0; l < NL; ++l) {
        const int pb = 1 + 9 * l;
        if (EN(1) && IN(pb + 0)) { KArgs A = kargs(); unsigned char* ws = A->ws; LANE_TID();
            norm_mod_phase(l == 0 ? A->in[0] : A->out, A->in[4] + l * DM, (const float*)(ws + WS_MOD) + (size_t)l * NB * MODP, 0, DM, (bf16*)(ws + WS_H), gw, ngw, lane_o); }
        SEAM(pb + 0);
        if (EN(2) && IN(pb + 1)) { KArgs A = kargs(); unsigned char* ws = A->ws; LANE_TID();
            pg8::Gemm g{(const bf16*)(ws + WS_H), (const bf16*)(ws + WS_WIN) + (size_t)l * NPI * DM, MT, NPI, DM}; pg8::StaticOrder S; S.init(MT, NPI, G, (int)blockIdx.x);
            pg8::EpiBf16Plain E{(bf16*)(ws + WS_PROJ), NPI};
            pg8::gemm_phase<pg8::EpiBf16Plain, pg8::StaticOrder, true, true>(lds, g, S, E, wave);
        }
        SEAM(pb + 1);
        if (EN(3) && IN(pb + 2)) { KArgs A = kargs(); unsigned char* ws = A->ws; LANE_TID();
            rwkv_prep_phase((const bf16*)(ws + WS_PROJ), A->in[8] + l * RWKV_IN, A->in[9] + l * 384, A->in[10] + (size_t)l * 64 * 384, A->in[11] + l * 384, A->in[12] + (size_t)l * 64 * 384,
                            A->in[13] + (size_t)l * 128 * 384, (float*)(ws + WS_DEC), (bf16*)(ws + WS_AA), (bf16*)(ws + WS_GG), lds, tid_o); }
        SEAM(pb + 2);
        if (EN(4) && IN(pb + 3)) { KArgs A = kargs(); unsigned char* ws = A->ws; LANE_TID();
            const int task = wave * G + (int)blockIdx.x;
            LAS float* scr = (LAS float*)(lds + wave * 40960); LAS float* st = scr + 512;
            const float* gn = A->in[7] + l * DM; const bf16* PROJ = (const bf16*)(ws + WS_PROJ); bf16* Hb = (bf16*)(ws + WS_H);
            if (task < 192) rwkv_scan_v1(task / 6, task % 6, PROJ, (const float*)(ws + WS_DEC), (const bf16*)(ws + WS_AA), (const bf16*)(ws + WS_GG), A->in[8] + l * RWKV_IN, A->in[14] + l * 384, A->in[15] + l * 384, A->in[16] + l * 384, gn, Hb, scr, st, lane_o);
            else if (task < 448) { const int q = task - 192; mlstm_scan_v1(q >> 3, (q >> 1) & 3, q & 1, PROJ, A->in[17] + (size_t)l * 4 * 768, A->in[18] + l * 768, A->in[19] + l * 4, A->in[20] + l * 4, Hb, scr, st, lane_o); }
            else if (task < 576) { const int q = task - 448; ret_scan_v1(q >> 2, q & 3, PROJ, gn, Hb, scr, st, lane_o); }
        }
        SEAM(pb + 3);
        if (EN(5) && IN(pb + 4)) { KArgs A = kargs(); unsigned char* ws = A->ws; LANE_TID(); mlstm_fix_phase((const bf16*)(ws + WS_PROJ), A->in[7] + l * DM, (bf16*)(ws + WS_H), gw, ngw, lane_o); }
        SEAM(pb + 4);
        if (EN(6) && IN(pb + 5)) { KArgs A = kargs(); unsigned char* ws = A->ws; LANE_TID();
            pg8::Gemm g{(const bf16*)(ws + WS_H), (const bf16*)(ws + WS_WOUT) + (size_t)l * DM * DM, MT, DM, DM}; pg8::StaticOrder S; S.init(MT, DM, G, (int)blockIdx.x);
            pg8::EpiResGate E{l == 0 ? A->in[0] : A->out, A->out, DM, (const float*)(ws + WS_MOD) + (size_t)l * NB * MODP + 2 * DM, MODP};
            pg8::gemm_phase<pg8::EpiResGate, pg8::StaticOrder, true, true>(lds, g, S, E, wave);
        }
        SEAM(pb + 5);
        if (EN(1) && IN(pb + 6)) { KArgs A = kargs(); unsigned char* ws = A->ws; LANE_TID();
            norm_mod_phase(A->out, A->in[5] + l * DM, (const float*)(ws + WS_MOD) + (size_t)l * NB * MODP, 3 * DM, 4 * DM, (bf16*)(ws + WS_H), gw, ngw, lane_o); }
        SEAM(pb + 6);
        if (EN(7) && IN(pb + 7)) { KArgs A = kargs(); unsigned char* ws = A->ws; LANE_TID();
            pg8::Gemm g{(const bf16*)(ws + WS_H), (const bf16*)(ws + WS_WF1) + (size_t)l * NF1 * DM, MT, NF1, DM}; pg8::StaticOrder S; S.init(MT, NF1, G, (int)blockIdx.x);
            pg8::EpiSwiGLU E{(bf16*)(ws + WS_PROJ), DFF};
            pg8::gemm_phase<pg8::EpiSwiGLU, pg8::StaticOrder, true, true>(lds, g, S, E, wave);
        }
        SEAM(pb + 7);
        if (EN(8) && IN(pb + 8)) { KArgs A = kargs(); unsigned char* ws = A->ws; LANE_TID();
            pg8::Gemm g{(const bf16*)(ws + WS_PROJ), (const bf16*)(ws + WS_WF2) + (size_t)l * DM * DFF, MT, DM, DFF}; pg8::StaticOrder S; S.init(MT, DM, G, (int)blockIdx.x);
            pg8::EpiResGate E{A->out, A->out, DM, (const float*)(ws + WS_MOD) + (size_t)l * NB * MODP + 5 * DM, MODP};
            pg8::gemm_phase<pg8::EpiResGate, pg8::StaticOrder, true, true>(lds, g, S, E, wave);
        }
        SEAM(pb + 8);
    }
    if (EN(9) && IN(N_PHASES - 1)) { KArgs A = kargs(); final_norm_phase(A->out, A->in[24], gw, ngw, lane_id_opq()); }
#undef IN
#undef SEAM
}

extern "C" void kernel_launch(void* const* d_in, const int* in_sizes, int n_in, void* d_out, int out_size, void* d_ws, size_t ws_size, hipStream_t stream) {
    static int grid = 0;
    if (grid == 0) {
        if (n_in != 25 || in_sizes[0] != MT * DM || out_size != MT * DM || ws_size < WS_END) { fprintf(stderr, "kernel_launch: shape/workspace mismatch (n_in %d, in0 %d, out %d, ws %zu)\n", n_in, n_in > 0 ? in_sizes[0] : -1, out_size, ws_size); grid = -1; return; }
        int dev = 0, cus = 0, per_cu = 0;
        if (hipGetDevice(&dev) != hipSuccess || hipDeviceGetAttribute(&cus, hipDeviceAttributeMultiprocessorCount, dev) != hipSuccess) { grid = -1; return; }
        if (hipFuncSetAttribute((const void*)mk_fwd, hipFuncAttributeMaxDynamicSharedMemorySize, LDS_BYTES) != hipSuccess) { fprintf(stderr, "kernel_launch: hipFuncSetAttribute failed\n"); grid = -1; return; }
        if (hipOccupancyMaxActiveBlocksPerMultiprocessor(&per_cu, (const void*)mk_fwd, NWAVES * 64, LDS_BYTES) != hipSuccess || per_cu < 1) { fprintf(stderr, "kernel_launch: occupancy query says %d\n", per_cu); }
        (void)hipGetLastError();
        grid = cus;
    }
    if (grid < 0) return;
    if (hipMemsetAsync((char*)d_ws + WS_CTL, 0, CTL_ZERO_BYTES, stream) != hipSuccess) return;
    Args a{};
    for (int i = 0; i < 25; ++i) a.in[i] = (const float*)d_in[i];
    a.out = (float*)d_out; a.ws = (unsigned char*)d_ws;
#if MK_PER_PHASE
    for (int p = 0; p < N_PHASES; ++p) { a.ph_lo = p; a.ph_hi = p + 1; a.li = 0; hipLaunchKernelGGL(mk_fwd, dim3(grid), dim3(NWAVES * 64), LDS_BYTES, stream, a); }
#else
    a.ph_lo = 0; a.ph_hi = N_PHASES; a.li = 0;
    hipLaunchKernelGGL(mk_fwd, dim3(grid), dim3(NWAVES * 64), LDS_BYTES, stream, a);
#endif
}
```

```cpp
#include <hip/hip_runtime.h>
#include <cstdio>
#include <cstdint>
__device__ __forceinline__ int lane_id_opq() { int l = (int)__builtin_amdgcn_mbcnt_hi(~0u, __builtin_amdgcn_mbcnt_lo(~0u, 0u)); asm volatile("" : "+v"(l)); return l; }

namespace pg8 {
#define PG8_LAS __attribute__((address_space(3)))
typedef unsigned short bf16_t;
typedef short bf16x8 __attribute__((ext_vector_type(8)));
typedef float f32x4 __attribute__((ext_vector_type(4)));
typedef unsigned u32x4 __attribute__((ext_vector_type(4)));
constexpr int BM = 256, BK = 64, HALF = 128, HTB = HALF * BK * 2  , STAGE_BYTES = 8 * HTB, NXCD = 8, WGM = 8;

__host__ __device__ __forceinline__ int lds_byte(int r, int c) { const int st = (r >> 4) * 2 + (c >> 5), rr = r & 15, cc = c & 31, ob = rr * 64 + cc * 2; return st * 1024 + (ob ^ (((ob >> 9) & 1) << 5)); }
__host__ __device__ __forceinline__ void stage_rc(int b, int& R, int& C) { const int st = b / 1024, sb = b % 1024, swz = sb ^ (((sb >> 9) & 1) << 5); R = (st >> 1) * 16 + swz / 64; C = (st & 1) * 32 + (swz % 64) / 2; }
__host__ __device__ __forceinline__ int perm32(int rho) { const int n = rho >> 4, i = rho & 15; return 8 * (i >> 2) + 4 * n + (i & 3); }

struct Unit { int pm, pn; };
struct Gemm { const bf16_t* A; const bf16_t* Bt; int M, N, K; };

struct StaticOrder {
    int nM, nN, nwg, G, c;
    __host__ __device__ void init(int M, int N, int G_, int c_) { nM = M / BM; nN = N / BM; nwg = nM * nN; G = G_; c = c_; }
    __host__ __device__ bool next(int i, Unit& u) const {
        const long L = (long)i * G + c; if (L >= nwg) return false;
        int wgid = (int)L; { const int q = nwg / NXCD, r = nwg % NXCD, xcd = wgid % NXCD, off = wgid / NXCD; wgid = (xcd < r ? xcd * (q + 1) : r * (q + 1) + (xcd - r) * q) + off; }
        const int nig = WGM * nN, gid = wgid / nig, fm = gid * WGM, gsz = (nM - fm) < WGM ? (nM - fm) : WGM;
        u.pm = fm + ((wgid % nig) % gsz); u.pn = (wgid % nig) / gsz; return true;
    }
    __device__ __forceinline__ void a_ready(const Unit&) const {}
    __device__ __forceinline__ void done(const Unit&) const {}
};

__device__ __forceinline__ unsigned cvt_pk_bf16(float lo, float hi) { unsigned r; asm volatile("v_cvt_pk_bf16_f32 %0, %1, %2" : "=v"(r) : "v"(lo), "v"(hi)); return r; }
typedef float f32x2 __attribute__((ext_vector_type(2)));

__device__ __forceinline__ float silu_f(float x) { return x * __builtin_amdgcn_rcpf(1.0f + __expf(-x)); }
struct EpiBf16Plain {
    static constexpr bool PERM = true, AFTER_DRAIN = false;
    bf16_t* O; int ldc;
    __device__ __forceinline__ void operator()(const f32x4 (&acc)[2][2][4][2], const Unit& u, int wr, int wc, int fr, int fq) const {
        const int row0 = u.pm * BM + wr * 64 + fr, col0 = u.pn * BM + wc * 32 + 8 * fq;
#pragma unroll
        for (int ai = 0; ai < 2; ++ai)
#pragma unroll
            for (int m = 0; m < 4; ++m) { bf16_t* rowp = O + (size_t)(row0 + ai * HALF + m * 16) * ldc + col0;
#pragma unroll
                for (int bj = 0; bj < 2; ++bj) { const f32x4 v0 = acc[ai][bj][m][0], v1 = acc[ai][bj][m][1];
                    u32x4 w; w.x = cvt_pk_bf16(v0[0], v0[1]); w.y = cvt_pk_bf16(v0[2], v0[3]); w.z = cvt_pk_bf16(v1[0], v1[1]); w.w = cvt_pk_bf16(v1[2], v1[3]);
                    *(u32x4*)(rowp + bj * HALF) = w; } }
    }
};
struct EpiSwiGLU {
    static constexpr bool PERM = true, AFTER_DRAIN = false;
    bf16_t* O; int ldc;
    __device__ __forceinline__ void operator()(const f32x4 (&acc)[2][2][4][2], const Unit& u, int wr, int wc, int fr, int fq) const {
        const int row0 = u.pm * BM + wr * 64 + fr, col0 = u.pn * HALF + wc * 32 + 8 * fq;
#pragma unroll
        for (int ai = 0; ai < 2; ++ai)
#pragma unroll
            for (int m = 0; m < 4; ++m) { bf16_t* rowp = O + (size_t)(row0 + ai * HALF + m * 16) * ldc + col0;
                const f32x4 g0 = acc[ai][0][m][0], g1 = acc[ai][0][m][1], u0 = acc[ai][1][m][0], u1 = acc[ai][1][m][1];
                u32x4 w; w.x = cvt_pk_bf16(silu_f(g0[0]) * u0[0], silu_f(g0[1]) * u0[1]); w.y = cvt_pk_bf16(silu_f(g0[2]) * u0[2], silu_f(g0[3]) * u0[3]);
                w.z = cvt_pk_bf16(silu_f(g1[0]) * u1[0], silu_f(g1[1]) * u1[1]); w.w = cvt_pk_bf16(silu_f(g1[2]) * u1[2], silu_f(g1[3]) * u1[3]);
                *(u32x4*)rowp = w; }
    }
};
struct EpiResGate {
    static constexpr bool PERM = false, AFTER_DRAIN = false;
    const float* xin; float* xout; int ldc; const float* gate; int gpitch;
    __device__ __forceinline__ void operator()(const f32x4 (&acc)[2][2][4][2], const Unit& u, int wr, int wc, int fr, int fq) const {
        const int row0 = u.pm * BM + wr * 64 + fr, col0 = u.pn * BM + wc * 32 + 4 * fq;
        const float* gp = gate + (size_t)(u.pm >> 3) * gpitch + col0;
        f32x4 gv[2][2];
#pragma unroll
        for (int bj = 0; bj < 2; ++bj)
#pragma unroll
            for (int n = 0; n < 2; ++n) gv[bj][n] = *(const f32x4*)(gp + bj * HALF + n * 16);
#pragma unroll
        for (int ai = 0; ai < 2; ++ai)
#pragma unroll
            for (int m = 0; m < 4; ++m) { const size_t off = (size_t)(row0 + ai * HALF + m * 16) * ldc + col0;
#pragma unroll
                for (int bj = 0; bj < 2; ++bj)
#pragma unroll
                    for (int n = 0; n < 2; ++n) { const f32x4 xi = *(const f32x4*)(xin + off + bj * HALF + n * 16);
                        *(f32x4*)(xout + off + bj * HALF + n * 16) = xi + gv[bj][n] * acc[ai][bj][m][n]; }
                asm volatile("" ::: "memory"); }
    }
};

template <class Epi, class Sched, bool ALIGN_EPI = false, bool SP2 = false>
__device__ __forceinline__ void gemm_phase(PG8_LAS unsigned char* lds, const Gemm g, const Sched& S, const Epi& E, const int wid_in) {
    const int wid = wid_in, lane = lane_id_opq(), tid = wid * 64 + lane, wr = wid >> 2, wc = wid & 3, fr = lane & 15, fq = lane >> 4;
    const int K = g.K, nt = K / BK;
    unsigned voffA[2], voffB[2];
#pragma unroll
    for (int i = 0; i < 2; ++i) { int R, C; stage_rc(tid * 16 + i * 8192, R, C); const int Rb = Epi::PERM ? ((R & ~31) + perm32(R & 31)) : R;
        voffA[i] = (unsigned)(R * K + C) * 2u; voffB[i] = (unsigned)(Rb * K + C) * 2u; }
    const size_t kstep = (size_t)(BK * 2);
    const size_t hstep = (size_t)HALF * K * 2;
    const size_t tstep = 2 * hstep;
    const unsigned ldsw = (unsigned)wid * 1024u;
    const int aoff = lds_byte(wr * 64 + fr, fq * 8), boff = lds_byte(wc * 32 + fr, fq * 8);
#define PG8_SA(b, h) (((b) * 2 + (h)) * HTB)
#define PG8_SB(b, h) ((4 + (b) * 2 + (h)) * HTB)
#define PG8_STAGE(bufoff, gbase, voff) do { _Pragma("unroll") for (int _i = 0; _i < 2; ++_i) \
        __builtin_amdgcn_global_load_lds((const unsigned*)((const char*)(gbase) + (voff)[_i]), (PG8_LAS unsigned*)(lds + (bufoff) + ldsw + _i * 8192), 16, 0, 0); } while (0)
#define PG8_LDA(dst, b, h) do { _Pragma("unroll") for (int m = 0; m < 4; ++m) _Pragma("unroll") for (int k = 0; k < 2; ++k) dst[m][k] = *(const PG8_LAS bf16x8*)(lds + PG8_SA(b, h) + aoff + m * 2048 + k * 1024); } while (0)
#define PG8_LDB(dst, b, h) do { _Pragma("unroll") for (int n = 0; n < 2; ++n) _Pragma("unroll") for (int k = 0; k < 2; ++k) dst[n][k] = *(const PG8_LAS bf16x8*)(lds + PG8_SB(b, h) + boff + n * 2048 + k * 1024); } while (0)
#define PG8_MMA(ai, bj, At, Bt) do { __builtin_amdgcn_s_setprio(1); _Pragma("unroll") for (int m = 0; m < 4; ++m) _Pragma("unroll") for (int n = 0; n < 2; ++n) _Pragma("unroll") for (int k = 0; k < 2; ++k) \
        acc[ai][bj][m][n] = __builtin_amdgcn_mfma_f32_16x16x32_bf16(Bt[n][k], At[m][k], acc[ai][bj][m][n], 0, 0, 0); __builtin_amdgcn_s_setprio(0); } while (0)
#define PG8_WAIT_V(n) asm volatile("s_waitcnt vmcnt(" #n ")" ::: "memory")
#define PG8_WAIT_L(n) asm volatile("s_waitcnt lgkmcnt(" #n ")" ::: "memory")
#define PG8_BAR __builtin_amdgcn_s_barrier()
#define PG8_SCHED __builtin_amdgcn_sched_barrier(0)
    Unit cur, nxt; int ui = 0;
    if (!S.next(0, cur)) return;
    f32x4 acc[2][2][4][2];
#pragma unroll
    for (int a = 0; a < 2; ++a)
#pragma unroll
        for (int b = 0; b < 2; ++b)
#pragma unroll
            for (int m = 0; m < 4; ++m)
#pragma unroll
                for (int n = 0; n < 2; ++n) acc[a][b][m][n] = (f32x4){0.f, 0.f, 0.f, 0.f};
    bf16x8 At[4][2], B0[2][2], B1[2][2];
    const char* cA = (const char*)g.A + (size_t)cur.pm * tstep; const char* cB = (const char*)g.Bt + (size_t)cur.pn * tstep;
    S.a_ready(cur);
    if constexpr (SP2) {
        PG8_STAGE(PG8_SB(0, 0), cB, voffB); PG8_STAGE(PG8_SB(0, 1), cB + hstep, voffB); PG8_STAGE(PG8_SA(0, 0), cA, voffA); PG8_STAGE(PG8_SA(0, 1), cA + hstep, voffA);
        if (wr == 1) PG8_BAR;
        PG8_WAIT_V(2); PG8_BAR;
        PG8_STAGE(PG8_SB(1, 0), cB + kstep, voffB); PG8_STAGE(PG8_SA(1, 0), cA + kstep, voffA); PG8_STAGE(PG8_SB(1, 1), cB + hstep + kstep, voffB);
        PG8_WAIT_V(6); PG8_BAR;
    } else {
        PG8_STAGE(PG8_SB(0, 0), cB, voffB); PG8_STAGE(PG8_SA(0, 0), cA, voffA); PG8_STAGE(PG8_SB(0, 1), cB + hstep, voffB); PG8_STAGE(PG8_SA(0, 1), cA + hstep, voffA);
        if (wr == 1) PG8_BAR;
        PG8_WAIT_V(4); PG8_BAR;
        PG8_STAGE(PG8_SB(1, 0), cB + kstep, voffB); PG8_STAGE(PG8_SA(1, 0), cA + kstep, voffA); PG8_STAGE(PG8_SB(1, 1), cB + hstep + kstep, voffB);
        PG8_WAIT_V(6); PG8_BAR;
    }
    for (;;) {
        const bool has_next = S.next(ui + 1, nxt);
        const char* nA = has_next ? (const char*)g.A + (size_t)nxt.pm * tstep : cA; const char* nB = has_next ? (const char*)g.Bt + (size_t)nxt.pn * tstep : cB;
        for (int t = 0; t < nt; t += 2) {
            const bool last = (t == nt - 2);
            const char* a1 = cA + (size_t)(t + 1) * kstep;
            const char* a2 = last ? nA : cA + (size_t)(t + 2) * kstep; const char* b2 = last ? nB : cB + (size_t)(t + 2) * kstep;
            const char* a3 = a2 + kstep; const char* b3 = b2 + kstep;
            if (last && has_next) S.a_ready(nxt);
            if constexpr (SP2) {
            PG8_LDB(B0, 0, 0); PG8_LDB(B1, 0, 1); PG8_SCHED; PG8_LDA(At, 0, 0); PG8_STAGE(PG8_SA(1, 1), a1 + hstep, voffA);
            PG8_WAIT_V(8); PG8_WAIT_L(0); PG8_BAR; PG8_MMA(0, 0, At, B0); PG8_MMA(0, 1, At, B1); PG8_BAR; PG8_SCHED;
            PG8_LDA(At, 0, 1); PG8_STAGE(PG8_SB(0, 0), b2, voffB); PG8_STAGE(PG8_SB(0, 1), b2 + hstep, voffB); PG8_STAGE(PG8_SA(0, 0), a2, voffA);
            PG8_WAIT_V(8); PG8_WAIT_L(0); PG8_BAR; PG8_MMA(1, 0, At, B0); PG8_MMA(1, 1, At, B1); PG8_BAR; PG8_SCHED;
            PG8_LDB(B0, 1, 0); PG8_LDB(B1, 1, 1); PG8_SCHED; PG8_LDA(At, 1, 0); PG8_STAGE(PG8_SA(0, 1), a2 + hstep, voffA);
            PG8_WAIT_V(8); PG8_WAIT_L(0); PG8_BAR; PG8_MMA(0, 0, At, B0); PG8_MMA(0, 1, At, B1); PG8_BAR; PG8_SCHED;
            PG8_LDA(At, 1, 1); PG8_STAGE(PG8_SB(1, 0), b3, voffB); PG8_STAGE(PG8_SB(1, 1), b3 + hstep, voffB); PG8_STAGE(PG8_SA(1, 0), a3, voffA);
            PG8_WAIT_V(8); PG8_WAIT_L(0); PG8_BAR; PG8_MMA(1, 0, At, B0); PG8_MMA(1, 1, At, B1); PG8_BAR; PG8_SCHED;
            } else {
            PG8_LDB(B0, 0, 0); PG8_SCHED; PG8_LDA(At, 0, 0); PG8_STAGE(PG8_SA(1, 1), a1 + hstep, voffA);
            PG8_WAIT_L(8); PG8_BAR; PG8_WAIT_L(0); PG8_MMA(0, 0, At, B0); PG8_BAR; PG8_SCHED;
            PG8_LDB(B1, 0, 1); PG8_STAGE(PG8_SB(0, 0), b2, voffB);
            PG8_BAR; PG8_WAIT_L(0); PG8_MMA(0, 1, At, B1); PG8_BAR;
            PG8_LDA(At, 0, 1); PG8_STAGE(PG8_SA(0, 0), a2, voffA);
            PG8_BAR; PG8_WAIT_L(0); PG8_MMA(1, 0, At, B0); PG8_BAR; PG8_SCHED;
            PG8_STAGE(PG8_SB(0, 1), b2 + hstep, voffB);
            PG8_WAIT_V(6); PG8_BAR; PG8_MMA(1, 1, At, B1); PG8_BAR;
            PG8_LDB(B0, 1, 0); PG8_SCHED; PG8_LDA(At, 1, 0); PG8_STAGE(PG8_SA(0, 1), a2 + hstep, voffA);
            PG8_WAIT_L(8); PG8_BAR; PG8_WAIT_L(0); PG8_MMA(0, 0, At, B0); PG8_BAR; PG8_SCHED;
            PG8_LDB(B1, 1, 1); PG8_STAGE(PG8_SB(1, 0), b3, voffB);
            PG8_BAR; PG8_WAIT_L(0); PG8_MMA(0, 1, At, B1); PG8_BAR;
            PG8_LDA(At, 1, 1); PG8_STAGE(PG8_SA(1, 0), a3, voffA);
            PG8_BAR; PG8_WAIT_L(0); PG8_MMA(1, 0, At, B0); PG8_BAR; PG8_SCHED;
            PG8_STAGE(PG8_SB(1, 1), b3 + hstep, voffB);
            PG8_WAIT_V(6); PG8_BAR; PG8_MMA(1, 1, At, B1); PG8_BAR;
            }
        }
        if constexpr (ALIGN_EPI) { if (wr == 0) PG8_BAR; }
        if constexpr (!Epi::AFTER_DRAIN) { E(acc, cur, wr, wc, fr, fq); S.done(cur); }
        if (!has_next) break;
#pragma unroll
        for (int a = 0; a < 2; ++a)
#pragma unroll
            for (int b = 0; b < 2; ++b)
#pragma unroll
                for (int m = 0; m < 4; ++m)
#pragma unroll
                    for (int n = 0; n < 2; ++n) acc[a][b][m][n] = (f32x4){0.f, 0.f, 0.f, 0.f};
        cur = nxt; cA = nA; cB = nB; ++ui;
        if constexpr (ALIGN_EPI) { if (wr == 1) PG8_BAR; }
    }
    PG8_WAIT_V(0);
    if constexpr (!ALIGN_EPI) { if (wr == 0) PG8_BAR; }
    PG8_BAR;
    if constexpr (Epi::AFTER_DRAIN) { E.fused(acc, cur, wr, wc, fr, fq, lds, wid, lane); S.done(cur); }
#undef PG8_SA
#undef PG8_SB
#undef PG8_STAGE
#undef PG8_LDA
#undef PG8_LDB
#undef PG8_MMA
#undef PG8_WAIT_V
#undef PG8_WAIT_L
#undef PG8_BAR
#undef PG8_SCHED
}
}

#ifndef MK_PER_PHASE
#define MK_PER_PHASE 0
#endif
constexpr int NWAVES = 8;
constexpr int DM = 1024, NB = 32, SEQ = 2048, NL = 4, MT = NB * SEQ;
constexpr int D_IN = 3976, NPI = 4096, DFF = 2816, NF1 = 2 * DFF;
constexpr int RW_B = 1024, ML_B = 2432;
constexpr int RWKV_IN = 1408;
constexpr float RMS_EPS = 1e-6f, GN_EPS = 1e-5f;
constexpr int MODP = 6 * DM;
constexpr size_t MiB = 1u << 20;
constexpr size_t WS_CTL = 0, CTL_ZERO_BYTES = 1 * MiB;
constexpr size_t WS_MOD = 1 * MiB;
constexpr size_t WS_WIN = 8 * MiB, WS_WOUT = 40 * MiB, WS_WF1 = 48 * MiB, WS_WF2 = 92 * MiB;
constexpr size_t WS_H = 128 * MiB;
constexpr size_t WS_PROJ = 256 * MiB;
constexpr size_t WS_DEC = 768 * MiB, WS_AA = 864 * MiB, WS_GG = 912 * MiB;
constexpr size_t WS_END = 960 * MiB;
constexpr int CW_BAR = 4096;
constexpr int N_PHASES = 2 + 8 * NL;
static_assert((CW_BAR + (MK_PER_PHASE ? 1 : 1) * 3456) * 4 <= (int)CTL_ZERO_BYTES, "ctl");
constexpr int RING_BYTES = 131072, LDSCTL_OFF = RING_BYTES, MISC_OFF = LDSCTL_OFF + 320, LDS_BYTES = 147456;

#define GAS __attribute__((address_space(1)))
#define LAS __attribute__((address_space(3)))
typedef unsigned short bf16;
typedef unsigned v4u __attribute__((ext_vector_type(4)));
typedef unsigned v2u __attribute__((ext_vector_type(2)));
typedef float f32x4 __attribute__((ext_vector_type(4)));
#define LDS_WAIT() asm volatile("s_waitcnt lgkmcnt(0)" ::: "memory")
__device__ __forceinline__ unsigned f2bf(float f) { unsigned u = __builtin_bit_cast(unsigned, f); return (u + 0x7fffu + ((u >> 16) & 1u)) >> 16; }
__device__ __forceinline__ unsigned pk2(float lo, float hi) { return f2bf(lo) | (f2bf(hi) << 16); }
__device__ __forceinline__ float bf2f(bf16 v) { return __uint_as_float(((unsigned)v) << 16); }
__device__ __forceinline__ float wave_sum(float v) {
#pragma unroll
    for (int o = 1; o < 64; o <<= 1) v += __shfl_xor(v, o);
    return v;
}
__device__ __forceinline__ float sigmoid_f(float x) { return 1.0f / (1.0f + expf(-x)); }
__device__ __forceinline__ float logsigmoid_f(float x) { return fminf(x, 0.f) - log1pf(expf(-fabsf(x))); }
template <class T> __device__ __forceinline__ T* opq(T* p) { asm volatile("" : "+s"(p)); return p; }

#define XB_TMO      128
#define XB_XCNT(j)  (256  + 64 * (j))
#define XB_XSUB(j)  (1280 + 64 * (j))
#define XB_XGEN(j)  (2304 + 64 * (j))
#define XB_TOP      3328
#define XB_TOPGEN   3392
#define XCD_BAR_WORDS 3456
#define XB_SPIN_CAP (1u << 22)

__device__ __forceinline__ unsigned xb_ld(unsigned* p)              { return __hip_atomic_load(p, __ATOMIC_RELAXED, __HIP_MEMORY_SCOPE_AGENT); }
__device__ __forceinline__ unsigned xb_add(unsigned* p, unsigned v) { return __hip_atomic_fetch_add(p, v, __ATOMIC_RELAXED, __HIP_MEMORY_SCOPE_AGENT); }
__device__ __forceinline__ unsigned xb_xcc_id() { return (unsigned)__builtin_amdgcn_s_getreg((3 << 11) | 20) & 0xFu; }
#define XB_SPIN(cond, bar) do { unsigned _sp = 0; while (cond) { __builtin_amdgcn_s_sleep(1); \
    if ((++_sp & 255u) == 0u) { if (xb_ld(&(bar)[XB_TMO])) break; if (_sp > XB_SPIN_CAP) { atomicAdd(&(bar)[XB_TMO], 1u); break; } } } } while (0)

struct XcdBarrier {
    unsigned* bar; unsigned x; unsigned w0;
    volatile LAS unsigned* st;
};

__device__ __forceinline__ XcdBarrier xcd_barrier_post(unsigned* bar, volatile LAS unsigned* st) {
    XcdBarrier b; b.bar = bar; b.x = xb_xcc_id(); b.st = st; b.w0 = (__builtin_amdgcn_readfirstlane((int)threadIdx.x >> 6) == 0) ? 1u : 0u;
    if (threadIdx.x == 0) (void)xb_add(&bar[XB_XCNT(b.x)], 1u);
    return b;
}
__device__ __forceinline__ void xcd_barrier_complete(unsigned* bar, unsigned x, unsigned& nloc, unsigned& nx) {
    const unsigned G = gridDim.x * gridDim.y * gridDim.z;
    unsigned sum, cnt, mine, sp = 0u;
    for (;;) {
        sum = 0u; cnt = 0u; mine = 0u;
#pragma unroll
        for (unsigned j = 0; j < 16; ++j) { const unsigned c = xb_ld(&bar[XB_XCNT(j)]); sum += c; cnt += (c > 0u) ? 1u : 0u; mine = (j == x) ? c : mine; }
        if (sum == G) break;
        __builtin_amdgcn_s_sleep(1);
        if ((++sp & 255u) == 0u) { if (xb_ld(&bar[XB_TMO])) break; if (sp > XB_SPIN_CAP) { atomicAdd(&bar[XB_TMO], 1u); break; } }
    }
    nloc = mine > 0u ? mine : 1u; nx = cnt > 0u ? cnt : 1u;
}

__device__ __forceinline__ void xcd_barrier(const XcdBarrier& b) {
    asm volatile("s_waitcnt vmcnt(0)" ::: "memory");
    __syncthreads();
    if (b.w0 != 0u && lane_id_opq() == 0) {
        unsigned* bar = b.bar;
        __builtin_amdgcn_s_waitcnt(0);
        unsigned nloc = b.st[0], nx = b.st[1];
        if (nloc == 0u) { xcd_barrier_complete(bar, b.x, nloc, nx); b.st[0] = nloc; b.st[1] = nx; }
        const unsigned old = xb_add(&bar[XB_XSUB(b.x)], 1u);
        const unsigned gen = old / nloc;
        if (old + 1u == (gen + 1u) * nloc) {
            __builtin_amdgcn_fence(__ATOMIC_RELEASE, "agent");
            asm volatile("s_waitcnt vmcnt(0)" ::: "memory");
            const unsigned og = xb_add(&bar[XB_TOP], 1u);
            const unsigned tg = og / nx;
            if (og + 1u == (tg + 1u) * nx) xb_add(&bar[XB_TOPGEN], 1u);
            else XB_SPIN(xb_ld(&bar[XB_TOPGEN]) == tg, bar);
            __builtin_amdgcn_fence(__ATOMIC_ACQUIRE, "agent");
            xb_add(&bar[XB_XGEN(b.x)], 1u);
            asm volatile("s_waitcnt vmcnt(0)" ::: "memory");
        } else {
            XB_SPIN(xb_ld(&bar[XB_XGEN(b.x)]) == gen, bar);
            __builtin_amdgcn_fence(__ATOMIC_ACQUIRE, "agent");
            asm volatile("s_waitcnt vmcnt(0)" ::: "memory");
        }
    }
    __syncthreads();
}


__device__ __forceinline__ void p0_mod(const float* c, const float* ada_w, const float* ada_b, float* mod, LAS unsigned char* lds, int tid, int lane, int wave) {
    LAS float* condT = (LAS float*)lds;
    for (int e = tid; e < NB * DM; e += NWAVES * 64) { const int k = e >> 5, b = e & 31; const float v = c[b * DM + k]; condT[e] = v / (1.0f + expf(-v)); }
    __syncthreads();
    for (int item = blockIdx.x; item < NL * 96; item += gridDim.x) {
        const int l = item / 96, g = item % 96, n = g * 64 + lane;
        const float* W = ada_w + (size_t)l * DM * MODP + n;
        float a0 = 0.f, a1 = 0.f, a2 = 0.f, a3 = 0.f;
        for (int k = 0; k < DM; k += 8) {
            float w[8];
#pragma unroll
            for (int u = 0; u < 8; ++u) w[u] = W[(size_t)(k + u) * MODP];
#pragma unroll
            for (int u = 0; u < 8; ++u) { const f32x4 cv = *(const LAS f32x4*)(condT + (k + u) * 32 + wave * 4); a0 += cv.x * w[u]; a1 += cv.y * w[u]; a2 += cv.z * w[u]; a3 += cv.w * w[u]; }
        }
        const float bb = ada_b[l * MODP + n]; float* o = mod + ((size_t)l * NB + wave * 4) * MODP + n;
        o[0] = a0 + bb; o[MODP] = a1 + bb; o[2 * MODP] = a2 + bb; o[3 * MODP] = a3 + bb;
    }
    __syncthreads();
}
template <int MODE>
__device__ __forceinline__ void transpose_item(const float* W, int K, int N, int nblk, bf16* WT, LAS float* scr, int item, int lane) {
    const int kb = item / nblk, nb = item % nblk, k0 = 64 * kb, n0 = 32 * nb;
    const int nn = n0 + (lane & 31); const bool ok = nn < N;
#pragma unroll 8
    for (int i = 0; i < 32; ++i) { const int kk = 2 * i + (lane >> 5); scr[kk * 33 + (lane & 31)] = ok ? W[(size_t)(k0 + kk) * N + nn] : 0.f; }
    LDS_WAIT();
    const int c = lane & 7;
#pragma unroll
    for (int j = 0; j < 4; ++j) { const int n = (lane >> 3) + 8 * j; const LAS float* s = scr + (8 * c) * 33 + n;
        v4u o; o.x = pk2(s[0 * 33], s[1 * 33]); o.y = pk2(s[2 * 33], s[3 * 33]); o.z = pk2(s[4 * 33], s[5 * 33]); o.w = pk2(s[6 * 33], s[7 * 33]);
        int row = n0 + n;
        if (MODE == 1) { const int up = row >= DFF ? 1 : 0, jj = row - up * DFF; row = (jj >> 7) * 256 + up * 128 + (jj & 127); }
        *(v4u*)(WT + (size_t)row * K + k0 + 8 * c) = o; }
    LDS_WAIT();
}
__device__ __forceinline__ void p0_weights(const float* w_in, const float* w_out, const float* f1, const float* f2, unsigned char* ws, LAS unsigned char* lds, int gw, int ngw, int wave, int lane) {
    LAS float* scr = (LAS float*)(lds + wave * 16384);
    constexpr int I_IN = (DM / 64) * (NPI / 32), I_OUT = (DM / 64) * (DM / 32), I_F1 = (DM / 64) * (NF1 / 32), I_F2 = (DFF / 64) * (DM / 32), I_L = I_IN + I_OUT + I_F1 + I_F2;
    for (int it = gw; it < NL * I_L; it += ngw) {
        const int l = it / I_L; int r = it % I_L;
        if (r < I_IN) { transpose_item<0>(w_in + (size_t)l * DM * D_IN, DM, D_IN, NPI / 32, (bf16*)(ws + WS_WIN) + (size_t)l * NPI * DM, scr, r, lane); continue; } r -= I_IN;
        if (r < I_OUT) { transpose_item<0>(w_out + (size_t)l * DM * DM, DM, DM, DM / 32, (bf16*)(ws + WS_WOUT) + (size_t)l * DM * DM, scr, r, lane); continue; } r -= I_OUT;
        if (r < I_F1) { transpose_item<1>(f1 + (size_t)l * DM * NF1, DM, NF1, NF1 / 32, (bf16*)(ws + WS_WF1) + (size_t)l * NF1 * DM, scr, r, lane); continue; } r -= I_F1;
        transpose_item<0>(f2 + (size_t)l * DFF * DM, DFF, DM, DM / 32, (bf16*)(ws + WS_WF2) + (size_t)l * DM * DFF, scr, r, lane);
    }
}
__device__ __forceinline__ void norm_mod_phase(const float* xin, const float* gain, const float* modl, int sh_off, int sc_off, bf16* out, int gw, int ngw, int lane) {
    for (int ci = gw; ci < MT / 32; ci += ngw) {
        const int b = ci >> 6; const float* mb = modl + (size_t)b * MODP;
        f32x4 gs[4], sh[4];
#pragma unroll
        for (int j = 0; j < 4; ++j) { const int col = 4 * lane + 256 * j; const f32x4 g = *(const f32x4*)(gain + col), s = *(const f32x4*)(mb + sc_off + col); gs[j] = g * (s + 1.0f); sh[j] = *(const f32x4*)(mb + sh_off + col); }
        for (int r = 0; r < 32; ++r) {
            const size_t row = (size_t)ci * 32 + r; const f32x4* xr = (const f32x4*)(xin + row * DM) + lane;
            f32x4 v[4]; float ss = 0.f;
#pragma unroll
            for (int j = 0; j < 4; ++j) { v[j] = xr[64 * j]; ss += (v[j].x * v[j].x + v[j].y * v[j].y) + (v[j].z * v[j].z + v[j].w * v[j].w); }
            const float rstd = 1.0f / sqrtf(wave_sum(ss) * (1.0f / DM) + RMS_EPS);
            v2u* o8 = (v2u*)(out + row * DM) + lane;
#pragma unroll
            for (int j = 0; j < 4; ++j) { const f32x4 y = v[j] * rstd * gs[j] + sh[j]; v2u w; w.x = pk2(y.x, y.y); w.y = pk2(y.z, y.w); o8[64 * j] = w; }
        }
    }
}
__device__ __forceinline__ void final_norm_phase(float* x, const float* gain, int gw, int ngw, int lane) {
    f32x4 g[4];
#pragma unroll
    for (int j = 0; j < 4; ++j) g[j] = *(const f32x4*)(gain + 4 * lane + 256 * j);
    for (int row = gw; row < MT; row += ngw) {
        f32x4* xr = (f32x4*)(x + (size_t)row * DM) + lane; f32x4 v[4]; float ss = 0.f;
#pragma unroll
        for (int j = 0; j < 4; ++j) { v[j] = xr[64 * j]; ss += (v[j].x * v[j].x + v[j].y * v[j].y) + (v[j].z * v[j].z + v[j].w * v[j].w); }
        const float rstd = 1.0f / sqrtf(wave_sum(ss) * (1.0f / DM) + RMS_EPS);
#pragma unroll
        for (int j = 0; j < 4; ++j) xr[64 * j] = v[j] * rstd * g[j];
    }
}
__device__ __forceinline__ void rwkv_prep_phase(const bf16* proj, const float* mu, const float* w0, const float* w2, const float* a0, const float* a2, const float* g2,
                                                float* DEC, bf16* AA, bf16* GG, LAS unsigned char* lds, int tid) {
    LAS float* act = (LAS float*)lds;
    for (int item = blockIdx.x; item < MT / 64; item += gridDim.x) {
        const size_t m0 = (size_t)item * 64; const int t0 = (int)(m0 % SEQ);
        w2 = opq(w2); a2 = opq(a2); g2 = opq(g2); proj = opq(proj); DEC = opq(DEC); AA = opq(AA); GG = opq(GG);
        for (int i = 0; i < 32; ++i) { const int idx = tid + i * 512, tt = idx >> 8, ic = idx & 255;
            const bf16* pp = proj + (m0 + tt) * NPI + RW_B + 1152 + ic;
            const float p = bf2f(pp[0]), q = (t0 + tt == 0) ? 0.f : bf2f(*(pp - NPI));
            const float x = p + (q - p) * mu[1152 + ic];
            act[idx] = ic < 64 ? tanhf(x) : (ic < 128 ? x : sigmoid_f(x)); }
        __syncthreads();
        if (tid < 384) { const int j = tid;
            { float Wr[64];
#pragma unroll
              for (int i = 0; i < 64; ++i) Wr[i] = w2[i * 384 + j];
              const float w0j = w0[j]; float cum = 0.f;
#pragma unroll 1
              for (int tt = 0; tt < 64; ++tt) { float s = 0.f;
#pragma unroll
                  for (int i4 = 0; i4 < 16; ++i4) { const f32x4 a = *(const LAS f32x4*)(act + tt * 256 + 4 * i4); s += a.x * Wr[4 * i4] + a.y * Wr[4 * i4 + 1] + a.z * Wr[4 * i4 + 2] + a.w * Wr[4 * i4 + 3]; if ((i4 & 3) == 3) asm volatile("" ::: "memory"); }
                  const float lw = logsigmoid_f(w0j + s) - 0.5f; cum -= expf(lw); DEC[(m0 + tt) * 384 + j] = cum; } }
            { float Wr[64];
#pragma unroll
              for (int i = 0; i < 64; ++i) Wr[i] = a2[i * 384 + j];
              const float a0j = a0[j];
#pragma unroll 1
              for (int tt = 0; tt < 64; ++tt) { float s = 0.f;
#pragma unroll
                  for (int i4 = 0; i4 < 16; ++i4) { const f32x4 a = *(const LAS f32x4*)(act + tt * 256 + 64 + 4 * i4); s += a.x * Wr[4 * i4] + a.y * Wr[4 * i4 + 1] + a.z * Wr[4 * i4 + 2] + a.w * Wr[4 * i4 + 3]; if ((i4 & 3) == 3) asm volatile("" ::: "memory"); }
                  AA[(m0 + tt) * 384 + j] = (bf16)f2bf(sigmoid_f(a0j + s)); } }
            { float Wr[128];
#pragma unroll
              for (int i = 0; i < 128; ++i) Wr[i] = g2[i * 384 + j];
#pragma unroll 1
              for (int tt = 0; tt < 64; ++tt) { float s = 0.f;
#pragma unroll
                  for (int i4 = 0; i4 < 32; ++i4) { const f32x4 a = *(const LAS f32x4*)(act + tt * 256 + 128 + 4 * i4); s += a.x * Wr[4 * i4] + a.y * Wr[4 * i4 + 1] + a.z * Wr[4 * i4 + 2] + a.w * Wr[4 * i4 + 3]; if ((i4 & 3) == 3) asm volatile("" ::: "memory"); }
                  GG[(m0 + tt) * 384 + j] = (bf16)f2bf(s); } }
        }
        __syncthreads();
    }
}
typedef short bf16x8_t __attribute__((ext_vector_type(8)));
#define WG_BAR() do { asm volatile("s_waitcnt vmcnt(0) lgkmcnt(0)" ::: "memory"); __builtin_amdgcn_s_barrier(); asm volatile("" ::: "memory"); } while (0)
#define WG_BAR_L() do { asm volatile("s_waitcnt lgkmcnt(0)" ::: "memory"); __builtin_amdgcn_s_barrier(); asm volatile("" ::: "memory"); } while (0)
template <int KS>
__device__ __forceinline__ f32x4 mm_tile(const LAS bf16* A, const LAS bf16* B, f32x4 acc) {
#pragma unroll
    for (int ks = 0; ks < KS; ++ks) {
        const bf16x8_t a = *(const LAS bf16x8_t*)(A + ks * 32), b = *(const LAS bf16x8_t*)(B + ks * 32);
        acc = __builtin_amdgcn_mfma_f32_16x16x32_bf16(a, b, acc, 0, 0, 0);
    }
    return acc;
}
__device__ __forceinline__ float sum16(float v) { v += __shfl_xor(v, 1); v += __shfl_xor(v, 2); v += __shfl_xor(v, 4); v += __shfl_xor(v, 8); return v; }
__device__ __forceinline__ unsigned short f2bf16(float f) { return (unsigned short)f2bf(f); }
constexpr int LP = 72;
constexpr int LPM = 104;

__device__ __forceinline__ void ret_unit(int b, int h, const bf16* proj, const float* gn, bf16* mixed, LAS unsigned char* lds, int wave, int lane0) {
    LAS bf16* Qs = (LAS bf16*)lds; LAS bf16* Ks = Qs + 64 * LP; LAS bf16* Kdt = Ks + 64 * LP; LAS bf16* Vt = Kdt + 64 * LP; LAS bf16* Ps = Vt + 64 * LP; LAS bf16* Stt = Ps + 64 * LP; LAS bf16* Gs = Stt + 64 * LP;
    const int lane = lane0, q4 = lane >> 4, lc = lane & 15;
    const float inv = powf(10000.0f, -(float)(2 * (lane & 31)) / 64.0f);
    float cs[8], sn[8];
#pragma unroll
    for (int i = 0; i < 8; ++i) sincosf((float)(8 * wave + i) * inv, &sn[i], &cs[i]);
    float c64, s64; sincosf(64.0f * inv, &s64, &c64);
    const float lg2 = log2f(1.0f - exp2f(-5.0f - (float)h));
    float kdec[8];
#pragma unroll
    for (int i = 0; i < 8; ++i) kdec[i] = exp2f((float)(63 - (8 * wave + i)) * lg2);
    const float cd = exp2f(64.0f * lg2);
    f32x4 st[4];
#pragma unroll
    for (int i = 0; i < 4; ++i) st[i] = (f32x4){0.f, 0.f, 0.f, 0.f};
    for (int i = wave * 64 + lane; i < 64 * LP / 2; i += 512) ((LAS unsigned*)Stt)[i] = 0u;
    const size_t m0 = (size_t)b * SEQ;
    const bf16* P0 = proj + m0 * NPI + h * 64;
    unsigned short rq[8], rk[8], rv[8], rg[8];
#pragma unroll
    for (int i = 0; i < 8; ++i) { const bf16* p = P0 + (size_t)(8 * wave + i) * NPI; rq[i] = p[lane]; rk[i] = p[256 + lane]; rv[i] = p[512 + lane]; rg[i] = p[768 + lane]; }
    float gain4[4];
#pragma unroll
    for (int ct = 0; ct < 4; ++ct) gain4[ct] = gn[h * 64 + 16 * ct + lc];
#pragma unroll 1
    for (int c = 0; c < SEQ / 64; ++c) {
        const int lane = lane_id_opq(), q4 = lane >> 4, lc = lane & 15, o72 = lc * LP + 8 * q4;
        { unsigned short kd[8];
#pragma unroll
          for (int i = 0; i < 8; ++i) { const int tt = 8 * wave + i;
              const float q = bf2f(rq[i]), k = bf2f(rk[i]); const float qp = __shfl_xor(q, 32), kp = __shfl_xor(k, 32);
              const float qr = lane < 32 ? q * cs[i] - qp * sn[i] : qp * sn[i] + q * cs[i];
              const float kr = (lane < 32 ? k * cs[i] - kp * sn[i] : kp * sn[i] + k * cs[i]) * 0.125f;
              Qs[tt * LP + lane] = f2bf16(qr); Ks[tt * LP + lane] = f2bf16(kr); Gs[tt * LP + lane] = rg[i]; kd[i] = f2bf16(kr * kdec[i]);
              const float cn = cs[i] * c64 - sn[i] * s64, snn = sn[i] * c64 + cs[i] * s64; cs[i] = cn; sn[i] = snn; }
          v4u w; w.x = kd[0] | ((unsigned)kd[1] << 16); w.y = kd[2] | ((unsigned)kd[3] << 16); w.z = kd[4] | ((unsigned)kd[5] << 16); w.w = kd[6] | ((unsigned)kd[7] << 16);
          *(LAS v4u*)(Kdt + lane * LP + 8 * wave) = w;
          w.x = rv[0] | ((unsigned)rv[1] << 16); w.y = rv[2] | ((unsigned)rv[3] << 16); w.z = rv[4] | ((unsigned)rv[5] << 16); w.w = rv[6] | ((unsigned)rv[7] << 16);
          *(LAS v4u*)(Vt + lane * LP + 8 * wave) = w; }
        WG_BAR_L();
        if (c + 1 < SEQ / 64) {
#pragma unroll
            for (int i = 0; i < 8; ++i) { const bf16* p = P0 + (size_t)(64 * (c + 1) + 8 * wave + i) * NPI; rq[i] = p[lane]; rk[i] = p[256 + lane]; rv[i] = p[512 + lane]; rg[i] = p[768 + lane]; } }
        { const int rt = wave >> 1;
#pragma unroll
          for (int u = 0; u < 2; ++u) { const int ct = 2 * (wave & 1) + u;
              f32x4 s = (f32x4){0.f, 0.f, 0.f, 0.f};
              if (ct <= rt) s = mm_tile<2>(Qs + 16 * rt * LP + o72, Ks + 16 * ct * LP + o72, s);
#pragma unroll
              for (int r = 0; r < 4; ++r) { const int l = 16 * rt + 4 * q4 + r, m = 16 * ct + lc; const float val = (l >= m) ? s[r] * exp2f((float)(l - m) * lg2) : 0.f; Ps[l * LP + m] = f2bf16(val); } } }
        f32x4 inter[4];
        if (wave < 4) {
#pragma unroll
            for (int ct = 0; ct < 4; ++ct) inter[ct] = mm_tile<2>(Qs + 16 * wave * LP + o72, Stt + 16 * ct * LP + o72, (f32x4){0.f, 0.f, 0.f, 0.f}); }
        WG_BAR_L();
        if (wave < 4) {
            f32x4 y[4];
#pragma unroll
            for (int ct = 0; ct < 4; ++ct) y[ct] = mm_tile<2>(Ps + 16 * wave * LP + o72, Vt + 16 * ct * LP + o72, (f32x4){0.f, 0.f, 0.f, 0.f});
#pragma unroll
            for (int r = 0; r < 4; ++r) { const int l = 16 * wave + 4 * q4 + r; const float qd = exp2f((float)(l + 1) * lg2);
                float s = 0.f;
#pragma unroll
                for (int ct = 0; ct < 4; ++ct) { y[ct][r] += qd * inter[ct][r]; s += y[ct][r]; }
                const float mean = sum16(s) * (1.0f / 64.0f); float qv = 0.f;
#pragma unroll
                for (int ct = 0; ct < 4; ++ct) { const float dd = y[ct][r] - mean; qv += dd * dd; }
                const float rstd = 1.0f / sqrtf(sum16(qv) * (1.0f / 64.0f) + GN_EPS);
                bf16* orow = mixed + (m0 + 64 * c + l) * DM + h * 64 + lc;
#pragma unroll
                for (int ct = 0; ct < 4; ++ct) { const float g = bf2f(Gs[l * LP + 16 * ct + lc]); orow[16 * ct] = f2bf16((y[ct][r] - mean) * rstd * gain4[ct] * (g * sigmoid_f(g))); } }
        } else {
            const int dt = wave - 4;
#pragma unroll
            for (int ct = 0; ct < 4; ++ct) { st[ct] = mm_tile<2>(Kdt + 16 * dt * LP + o72, Vt + 16 * ct * LP + o72, st[ct] * cd);
                v2u w; w.x = pk2(st[ct][0], st[ct][1]); w.y = pk2(st[ct][2], st[ct][3]);
                *(LAS v2u*)(Stt + (16 * ct + lc) * LP + 16 * dt + 4 * q4) = w; }
        }
        WG_BAR();
    }
}

__device__ __forceinline__ void mlstm_unit(int b, int h, const bf16* proj, const float* conv_w, const float* conv_b, const float* i_b, const float* f_b, const float* gn, bf16* mixed,
                                           LAS unsigned char* lds, int wave, int lane0) {
    LAS bf16* Qs = (LAS bf16*)lds; LAS bf16* Ks = Qs + 64 * LPM; LAS bf16* Kdt = Ks + 64 * LPM; LAS bf16* Vt = Kdt + 96 * LP; LAS bf16* Ps = Vt + 112 * LP; LAS bf16* Stt = Ps + 64 * LP; LAS bf16* Os = Stt + 112 * LPM;
    LAS float* ev = (LAS float*)(Os + 64 * LPM); LAS float* pmv = ev + 64; LAS float* flv = pmv + 64;
    const int lane = lane0, lc = lane & 15;
    float wq0[4], wq1[4], wk0[4], wk1[4], bq0, bq1, bk0, bk1;
    { const int cq0 = h * 96 + lane, cq1 = h * 96 + 64 + (lane & 31), ck0 = 384 + cq0, ck1 = 384 + cq1;
#pragma unroll
    for (int j = 0; j < 4; ++j) { wq0[j] = conv_w[j * 768 + cq0]; wq1[j] = conv_w[j * 768 + cq1]; wk0[j] = conv_w[j * 768 + ck0]; wk1[j] = conv_w[j * 768 + ck1]; }
    bq0 = conv_b[cq0]; bq1 = conv_b[cq1]; bk0 = conv_b[ck0]; bk1 = conv_b[ck1]; }
    const float ib = i_b[h], fb = f_b[h];
    const float ksc = 0.10206207261596577f;
    f32x4 st[11];
#pragma unroll
    for (int i = 0; i < 11; ++i) st[i] = (f32x4){0.f, 0.f, 0.f, 0.f};
    for (int i = wave * 64 + lane; i < 112 * LPM / 2; i += 512) ((LAS unsigned*)Stt)[i] = 0u;
    for (int i = wave * 64 + lane; i < 16 * LP / 2; i += 512) ((LAS unsigned*)(Vt + 96 * LP))[i] = (i < LP / 2) ? 0x3f803f80u : 0u;
    float mprev = 0.f;
    const size_t m0 = (size_t)b * SEQ;
    const bf16* PB = proj + m0 * NPI + ML_B;
    float gain6[6];
#pragma unroll
    for (int ct = 0; ct < 6; ++ct) gain6[ct] = gn[640 + h * 96 + 16 * ct + lc];
#pragma unroll 1
    for (int c = 0; c < SEQ / 64; ++c) {
        const int lane = lane_id_opq(), q4 = lane >> 4, lc = lane & 15, o72 = lc * LP + 8 * q4, o104 = lc * LPM + 8 * q4;
        const int d0 = lane, d1 = 64 + (lane & 31); const bool has1 = lane < 32;
        const int cq0 = h * 96 + d0, cq1 = h * 96 + d1, ck0 = 384 + cq0, ck1 = 384 + cq1;
        const int tb = 64 * c + 8 * wave;
        { float xq0[11], xk0[11], xq1[11], xk1[11];
#pragma unroll
          for (int i = 0; i < 11; ++i) { const int t = tb - 3 + i; const bool ok = t >= 0; const bf16* p = PB + (size_t)(ok ? t : 0) * NPI;
              xq0[i] = ok ? bf2f(p[cq0]) : 0.f; xk0[i] = ok ? bf2f(p[ck0]) : 0.f; xq1[i] = (ok && has1) ? bf2f(p[cq1]) : 0.f; xk1[i] = (ok && has1) ? bf2f(p[ck1]) : 0.f; }
          unsigned short kd0[8], kd1[8];
#pragma unroll
          for (int i = 0; i < 8; ++i) { const int tt = 8 * wave + i;
              float q0 = bq0 + xq0[i] * wq0[0] + xq0[i + 1] * wq0[1] + xq0[i + 2] * wq0[2] + xq0[i + 3] * wq0[3];
              float k0 = bk0 + xk0[i] * wk0[0] + xk0[i + 1] * wk0[1] + xk0[i + 2] * wk0[2] + xk0[i + 3] * wk0[3];
              float q1 = bq1 + xq1[i] * wq1[0] + xq1[i + 1] * wq1[1] + xq1[i + 2] * wq1[2] + xq1[i + 3] * wq1[3];
              float k1 = bk1 + xk1[i] * wk1[0] + xk1[i + 1] * wk1[1] + xk1[i + 2] * wk1[2] + xk1[i + 3] * wk1[3];
              q0 = q0 * sigmoid_f(q0); k0 = k0 * sigmoid_f(k0) * ksc; q1 = q1 * sigmoid_f(q1); k1 = k1 * sigmoid_f(k1) * ksc;
              Qs[tt * LPM + d0] = f2bf16(q0); Ks[tt * LPM + d0] = f2bf16(k0); kd0[i] = f2bf16(k0); kd1[i] = f2bf16(k1);
              if (has1) { Qs[tt * LPM + d1] = f2bf16(q1); Ks[tt * LPM + d1] = f2bf16(k1); } }
          v4u w; w.x = kd0[0] | ((unsigned)kd0[1] << 16); w.y = kd0[2] | ((unsigned)kd0[3] << 16); w.z = kd0[4] | ((unsigned)kd0[5] << 16); w.w = kd0[6] | ((unsigned)kd0[7] << 16);
          *(LAS v4u*)(Kdt + d0 * LP + 8 * wave) = w;
          if (has1) { w.x = kd1[0] | ((unsigned)kd1[1] << 16); w.y = kd1[2] | ((unsigned)kd1[3] << 16); w.z = kd1[4] | ((unsigned)kd1[5] << 16); w.w = kd1[6] | ((unsigned)kd1[7] << 16);
              *(LAS v4u*)(Kdt + d1 * LP + 8 * wave) = w; }
          unsigned short v0[8], v1[8];
#pragma unroll
          for (int i = 0; i < 8; ++i) { const bf16* p = PB + (size_t)(tb + i) * NPI; v0[i] = p[768 + h * 96 + d0]; v1[i] = has1 ? p[768 + h * 96 + d1] : (unsigned short)0;
              Os[(8 * wave + i) * LPM + d0] = p[1152 + h * 96 + d0]; if (has1) Os[(8 * wave + i) * LPM + d1] = p[1152 + h * 96 + d1]; }
          w.x = v0[0] | ((unsigned)v0[1] << 16); w.y = v0[2] | ((unsigned)v0[3] << 16); w.z = v0[4] | ((unsigned)v0[5] << 16); w.w = v0[6] | ((unsigned)v0[7] << 16);
          *(LAS v4u*)(Vt + d0 * LP + 8 * wave) = w;
          if (has1) { w.x = v1[0] | ((unsigned)v1[1] << 16); w.y = v1[2] | ((unsigned)v1[3] << 16); w.z = v1[4] | ((unsigned)v1[5] << 16); w.w = v1[6] | ((unsigned)v1[7] << 16);
              *(LAS v4u*)(Vt + d1 * LP + 8 * wave) = w; } }
        float pm63, carry; const float mold = mprev;
        { const bf16* p = PB + (size_t)(64 * c + lane) * NPI; const float ic = bf2f(p[1536 + h]) + ib, lf = logsigmoid_f(bf2f(p[1540 + h]) + fb);
          float bc = lf;
#pragma unroll
          for (int o = 1; o < 64; o <<= 1) { const float t = __shfl_up(bc, o); if (lane >= o) bc += t; }
          const float e = ic - bc; float pm = e;
#pragma unroll
          for (int o = 1; o < 64; o <<= 1) { const float t = __shfl_up(pm, o); if (lane >= o) pm = fmaxf(pm, t); }
          pm = fmaxf(pm, mprev);
          pm63 = __shfl(pm, 63); carry = expf(mprev - pm63);
          if (wave == 0) { ev[lane] = e; pmv[lane] = pm; flv[lane] = expf(-(bc + pm)); }
          mprev = __shfl(bc, 63) + pm63; }
        WG_BAR();
        { const int rt = wave >> 1;
#pragma unroll
          for (int u = 0; u < 2; ++u) { const int ct = 2 * (wave & 1) + u;
              f32x4 s = (f32x4){0.f, 0.f, 0.f, 0.f};
              if (ct <= rt) s = mm_tile<3>(Qs + 16 * rt * LPM + o104, Ks + 16 * ct * LPM + o104, s);
              const float em = ev[16 * ct + lc];
#pragma unroll
              for (int r = 0; r < 4; ++r) { const int l = 16 * rt + 4 * q4 + r, m = 16 * ct + lc; const float val = (l >= m) ? s[r] * expf(em - pmv[l]) : 0.f; Ps[l * LP + m] = f2bf16(val); } } }
        {
#pragma unroll
          for (int i = 0; i < 12; ++i) { const int idx = (wave * 64 + lane) + 512 * i, dd = idx >> 6, m = idx & 63; Kdt[dd * LP + m] = f2bf16(bf2f(Kdt[dd * LP + m]) * expf(ev[m] - pm63)); } }
        f32x4 inter[7];
        if (wave < 4) {
#pragma unroll
            for (int ct = 0; ct < 7; ++ct) inter[ct] = mm_tile<3>(Qs + 16 * wave * LPM + o104, Stt + 16 * ct * LPM + o104, (f32x4){0.f, 0.f, 0.f, 0.f}); }
        WG_BAR_L();
        if (wave < 4) {
            f32x4 y[7];
#pragma unroll
            for (int ct = 0; ct < 7; ++ct) y[ct] = mm_tile<2>(Ps + 16 * wave * LP + o72, Vt + 16 * ct * LP + o72, (f32x4){0.f, 0.f, 0.f, 0.f});
#pragma unroll
            for (int r = 0; r < 4; ++r) { const int l = 16 * wave + 4 * q4 + r; const float iw = expf(mold - pmv[l]);
#pragma unroll
                for (int ct = 0; ct < 7; ++ct) y[ct][r] += iw * inter[ct][r];
                const float den = __shfl(y[6][r], lane & 48);
                const float dn = 1.0f / fmaxf(fabsf(den), flv[l]);
                float s = 0.f;
#pragma unroll
                for (int ct = 0; ct < 6; ++ct) { y[ct][r] *= dn; s += y[ct][r]; }
                const float mean = sum16(s) * (1.0f / 96.0f); float qv = 0.f;
#pragma unroll
                for (int ct = 0; ct < 6; ++ct) { const float dd = y[ct][r] - mean; qv += dd * dd; }
                const float rstd = 1.0f / sqrtf(sum16(qv) * (1.0f / 96.0f) + GN_EPS);
                bf16* orow = mixed + (m0 + 64 * c + l) * DM + 640 + h * 96 + lc;
#pragma unroll
                for (int ct = 0; ct < 6; ++ct) { const float o = bf2f(Os[l * LPM + 16 * ct + lc]); orow[16 * ct] = f2bf16((y[ct][r] - mean) * rstd * gain6[ct] * sigmoid_f(o)); } }
        } else {
#pragma unroll
            for (int i = 0; i < 11; ++i) { const int t = (wave - 4) + 4 * i;
                if (t < 42) { const int dt = t / 7, et = t % 7;
                    st[i] = mm_tile<2>(Kdt + 16 * dt * LP + o72, Vt + 16 * et * LP + o72, st[i] * carry);
                    v2u w; w.x = pk2(st[i][0], st[i][1]); w.y = pk2(st[i][2], st[i][3]);
                    *(LAS v2u*)(Stt + (16 * et + lc) * LPM + 16 * dt + 4 * q4) = w; } }
        }
        WG_BAR();
    }
}
#ifndef RW_DBG
#define RW_DBG 0xFF
#endif
__device__ __forceinline__ void rwkv_unit(int b, int h, const bf16* proj, const float* CUM, const bf16* AA, const bf16* GG, const float* mu, const float* k_k, const float* k_a, const float* r_k,
                                          const float* gn, bf16* mixed, LAS unsigned char* lds, int wave, int lane0) {
    constexpr int SLOT = 64 * LP;
    LAS bf16* KH = (LAS bf16*)lds; LAS bf16* BH = KH + SLOT; LAS bf16* KT = BH + SLOT; LAS bf16* RT = KT + SLOT; LAS bf16* KHgt = RT + SLOT; LAS bf16* BHgtn = KHgt + SLOT;
    LAS bf16* Vt = BHgtn + SLOT; LAS bf16* AkT = Vt + SLOT; LAS bf16* BbTn = AkT + SLOT; LAS bf16* BkT = BbTn + SLOT; LAS bf16* S0b = BkT + SLOT; LAS bf16* Loffb = S0b + SLOT;
    LAS float* RHS = (LAS float*)KH; LAS bf16* Ut = KT;
    LAS float* LTd = (LAS float*)(Loffb + SLOT);
    LAS float* XS = LTd + 64 * 20;
    LAS float* GCv = XS + 16 * 64; LAS float* bonv = GCv + 64;
    float mu_r, mu_k, mu_v, kkc, kac, rkc;
    { const int c0 = h * 64 + lane0; mu_r = mu[c0]; mu_k = mu[384 + c0]; mu_v = mu[768 + c0]; kkc = k_k[c0]; kac = k_a[c0]; rkc = r_k[c0]; }
    for (int i = wave * 64 + lane0; i < 5 * SLOT / 2; i += 512) ((LAS unsigned*)AkT)[i] = 0u;
    f32x4 sacc[4];
#pragma unroll
    for (int i = 0; i < 4; ++i) sacc[i] = (f32x4){0.f, 0.f, 0.f, 0.f};
    const size_t m0 = (size_t)b * SEQ;
    const bf16* PU = proj + m0 * NPI + RW_B + h * 64;
    const float* CU = CUM + m0 * 384 + h * 64; const bf16* AU = AA + m0 * 384 + h * 64; const bf16* GU = GG + m0 * 384 + h * 64;
    unsigned short rr[9], rk[9], rv[9], ra[8]; float rc[9], rc63;
#define RWKV_LOAD(cc) do { const int tb_ = 64 * (cc) + 8 * wave; \
        _Pragma("unroll") for (int i = 0; i < 9; ++i) { const int t_ = tb_ - 1 + i; const bool ok_ = t_ >= 0; const bf16* p_ = PU + (size_t)(ok_ ? t_ : 0) * NPI; \
            rr[i] = ok_ ? p_[lane] : (unsigned short)0; rk[i] = ok_ ? p_[384 + lane] : (unsigned short)0; rv[i] = ok_ ? p_[768 + lane] : (unsigned short)0; \
            rc[i] = (i > 0 || wave > 0) ? CU[(size_t)(ok_ ? t_ : 0) * 384 + lane] : 0.f; if (i > 0) ra[i - 1] = AU[(size_t)t_ * 384 + lane]; } \
        rc63 = CU[(size_t)(64 * (cc) + 63) * 384 + lane]; } while (0)
    { const int lane = lane0; RWKV_LOAD(0); }
#pragma unroll 1
    for (int c = 0; c < SEQ / 64; ++c) {
        const int lane = lane_id_opq(), q4 = lane >> 4, lc = lane & 15, o72 = lc * LP + 8 * q4;
        if (RW_DBG & 1) { unsigned short khg[8], bhg[8];
#pragma unroll
          for (int i = 0; i < 8; ++i) { const int tt = 8 * wave + i;
              const float cr = bf2f(rr[i + 1]), ck = bf2f(rk[i + 1]);
              const float r = cr + (bf2f(rr[i]) - cr) * mu_r, k = ck + (bf2f(rk[i]) - ck) * mu_k, a = bf2f(ra[i]);
              float kk = k * kkc; const float nrm = sqrtf(wave_sum(kk * kk)); kk = kk / fmaxf(nrm, 1e-12f);
              const float kmod = k * (1.0f + (a - 1.0f) * kac), beta = kk * a;
              const float bon = wave_sum(r * kmod * rkc); if (lane == 0) bonv[tt] = bon;
              const float cm = rc[i + 1], cp = rc[i];
              const float em = expf(-cm), eg = expf(rc63 - cm);
              KH[tt * LP + lane] = f2bf16(kmod * em); BH[tt * LP + lane] = f2bf16(beta * em); KT[tt * LP + lane] = f2bf16(kk * expf(cp)); RT[tt * LP + lane] = f2bf16(r * expf(cm));
              khg[i] = f2bf16(kmod * eg); bhg[i] = f2bf16(-beta * eg); }
          v4u w; w.x = khg[0] | ((unsigned)khg[1] << 16); w.y = khg[2] | ((unsigned)khg[3] << 16); w.z = khg[4] | ((unsigned)khg[5] << 16); w.w = khg[6] | ((unsigned)khg[7] << 16);
          *(LAS v4u*)(KHgt + lane * LP + 8 * wave) = w;
          w.x = bhg[0] | ((unsigned)bhg[1] << 16); w.y = bhg[2] | ((unsigned)bhg[3] << 16); w.z = bhg[4] | ((unsigned)bhg[5] << 16); w.w = bhg[6] | ((unsigned)bhg[7] << 16);
          *(LAS v4u*)(BHgtn + lane * LP + 8 * wave) = w;
          unsigned short vs[8];
#pragma unroll
          for (int i = 0; i < 8; ++i) { const float cv = bf2f(rv[i + 1]); vs[i] = f2bf16(cv + (bf2f(rv[i]) - cv) * mu_v); }
          w.x = vs[0] | ((unsigned)vs[1] << 16); w.y = vs[2] | ((unsigned)vs[3] << 16); w.z = vs[4] | ((unsigned)vs[5] << 16); w.w = vs[6] | ((unsigned)vs[7] << 16);
          *(LAS v4u*)(Vt + lane * LP + 8 * wave) = w;
          if (wave == 0) GCv[lane] = expf(rc63); }
        WG_BAR_L();
#pragma unroll
        for (int it = 0; it < ((RW_DBG & 2) ? 5 : 0); ++it) { const int item = wave + 8 * it, prod = item / 10, pair = item % 10;
            const int rt = pair >= 6 ? 3 : (pair >= 3 ? 2 : (pair >= 1 ? 1 : 0)), ct = pair - (rt * (rt + 1)) / 2;
            const LAS bf16* Ab = (prod < 2 ? KT : RT) + 16 * rt * LP + o72; const LAS bf16* Bb = ((prod == 0 || prod == 2) ? BH : KH) + 16 * ct * LP + o72;
            const f32x4 g = mm_tile<2>(Ab, Bb, (f32x4){0.f, 0.f, 0.f, 0.f});
            const int s = 16 * ct + lc;
#pragma unroll
            for (int r = 0; r < 4; ++r) { const int t = 16 * rt + 4 * q4 + r;
                if (prod == 0) { if (ct < rt) Loffb[t * LP + s] = f2bf16(g[r]); else LTd[s * 20 + (t - 16 * rt)] = (s < t) ? g[r] : 0.f; }
                else if (prod == 1) AkT[t * LP + s] = f2bf16((s < t) ? g[r] : 0.f);
                else if (prod == 2) BbTn[t * LP + s] = f2bf16((s <= t) ? -g[r] : 0.f);
                else BkT[t * LP + s] = f2bf16((s <= t) ? g[r] : 0.f); } }
        WG_BAR_L();
#pragma unroll
        for (int u = 0; u < ((RW_DBG & 4) ? 2 : 0); ++u) { const int rt = wave >> 1, ct = 2 * (wave & 1) + u;
            f32x4 g = mm_tile<2>(KT + 16 * rt * LP + o72, S0b + 16 * ct * LP + o72, (f32x4){0.f, 0.f, 0.f, 0.f});
            g = mm_tile<2>(AkT + 16 * rt * LP + o72, Vt + 16 * ct * LP + o72, g);
#pragma unroll
            for (int r = 0; r < 4; ++r) RHS[(16 * rt + 4 * q4 + r) * 64 + 16 * ct + lc] = g[r]; }
        WG_BAR_L();
        f32x4 y[4];
        if ((RW_DBG & 8) && wave == 0) {
#pragma unroll
            for (int a = 0; a < 4; ++a) {
                if (a > 0) {
#pragma unroll
                    for (int it = 0; it < 4; ++it) { f32x4 cr = (f32x4){0.f, 0.f, 0.f, 0.f};
                        if (a == 3) cr = mm_tile<2>(Loffb + 16 * a * LP + o72, Ut + 16 * it * LP + o72, cr); else cr = mm_tile<1>(Loffb + 16 * a * LP + o72, Ut + 16 * it * LP + o72, cr);
#pragma unroll
                        for (int r = 0; r < 4; ++r) XS[(4 * q4 + r) * 64 + 16 * it + lc] = cr[r]; }
                    asm volatile("s_waitcnt lgkmcnt(0)" ::: "memory");
                }
                float acc[16];
#pragma unroll
                for (int t = 0; t < 16; ++t) acc[t] = RHS[(16 * a + t) * 64 + lane] - (a > 0 ? XS[t * 64 + lane] : 0.f);
                const LAS float* Ld = LTd + 16 * a * 20; asm volatile("" : "+v"(Ld));
#pragma unroll
                for (int s2 = 0; s2 < 15; ++s2) { const float us = acc[s2];
#pragma unroll
                    for (int t4 = (s2 + 1) / 4; t4 < 4; ++t4) { const f32x4 l4 = *(const LAS f32x4*)(Ld + s2 * 20 + 4 * t4);
                        acc[4 * t4] -= l4.x * us; acc[4 * t4 + 1] -= l4.y * us; acc[4 * t4 + 2] -= l4.z * us; acc[4 * t4 + 3] -= l4.w * us; }
                    if (s2 == 3 || s2 == 7) asm volatile("" : "+v"(Ld) : "v"(acc[s2 + 1])); }
                v4u w; w.x = pk2(acc[0], acc[1]); w.y = pk2(acc[2], acc[3]); w.z = pk2(acc[4], acc[5]); w.w = pk2(acc[6], acc[7]);
                *(LAS v4u*)(Ut + lane * LP + 16 * a) = w;
                w.x = pk2(acc[8], acc[9]); w.y = pk2(acc[10], acc[11]); w.z = pk2(acc[12], acc[13]); w.w = pk2(acc[14], acc[15]);
                *(LAS v4u*)(Ut + lane * LP + 16 * a + 8) = w;
                asm volatile("s_waitcnt lgkmcnt(0)" ::: "memory");
            }
        }
        if (c + 1 < SEQ / 64) RWKV_LOAD(c + 1);
        if (wave < 4) {
#pragma unroll
            for (int ct = 0; ct < 4; ++ct) { y[ct] = mm_tile<2>(RT + 16 * wave * LP + o72, S0b + 16 * ct * LP + o72, (f32x4){0.f, 0.f, 0.f, 0.f}); y[ct] = mm_tile<2>(BkT + 16 * wave * LP + o72, Vt + 16 * ct * LP + o72, y[ct]); }
        } else {
#pragma unroll
            for (int jt = 0; jt < 4; ++jt) { const float gc = GCv[16 * jt + lc]; sacc[jt] = mm_tile<2>(Vt + 16 * (wave - 4) * LP + o72, KHgt + 16 * jt * LP + o72, sacc[jt] * gc); }
        }
        WG_BAR_L();
        if (wave < 4) {
#pragma unroll
            for (int ct = 0; ct < 4; ++ct) y[ct] = mm_tile<2>(BbTn + 16 * wave * LP + o72, Ut + 16 * ct * LP + o72, y[ct]);
#pragma unroll
            for (int r = 0; r < 4; ++r) { const int t = 16 * wave + 4 * q4 + r; const size_t row = m0 + 64 * c + t;
                float s = 0.f;
#pragma unroll
                for (int ct = 0; ct < 4; ++ct) s += y[ct][r];
                const float mean = sum16(s) * (1.0f / 64.0f); float qv = 0.f;
#pragma unroll
                for (int ct = 0; ct < 4; ++ct) { const float dd = y[ct][r] - mean; qv += dd * dd; }
                const float rstd = 1.0f / sqrtf(sum16(qv) * (1.0f / 64.0f) + GN_EPS);
                const float bon = bonv[t]; const bool hasp = (64 * c + t) > 0;
                const bf16* vrow = proj + row * NPI + RW_B + 768 + h * 64 + lc; const bf16* grow = GG + row * 384 + h * 64 + lc; bf16* orow = mixed + row * DM + 256 + h * 64 + lc;
#pragma unroll
                for (int ct = 0; ct < 4; ++ct) { const int i = h * 64 + 16 * ct + lc;
                    const float cv = bf2f(vrow[16 * ct]), pv = hasp ? bf2f(*(vrow + 16 * ct - NPI)) : 0.f; const float v = cv + (pv - cv) * mu[768 + i];
                    orow[16 * ct] = f2bf16(((y[ct][r] - mean) * rstd * gn[256 + i] + bon * v) * bf2f(grow[16 * ct])); } }
        } else {
#pragma unroll
            for (int jt = 0; jt < 4; ++jt) { sacc[jt] = mm_tile<2>(Ut + 16 * (wave - 4) * LP + o72, BHgtn + 16 * jt * LP + o72, sacc[jt]);
#pragma unroll
                for (int r = 0; r < 4; ++r) S0b[(16 * (wave - 4) + 4 * q4 + r) * LP + 16 * jt + lc] = f2bf16(sacc[jt][r]); }
        }
        WG_BAR();
    }
#undef RWKV_LOAD
}

struct Args { const float* in[25]; float* out; unsigned char* ws; int ph_lo, ph_hi, li, pad; };
typedef const __attribute__((address_space(4))) Args* KArgs;
__device__ __forceinline__ KArgs kargs() { KArgs p = (KArgs)__builtin_amdgcn_kernarg_segment_ptr(); asm volatile("" : "+s"(p)); return p; }
#ifndef DBG_MASK
#define DBG_MASK 0xFFFF
#endif
#define EN(bit) ((DBG_MASK >> (bit)) & 1)
__global__ void __launch_bounds__(NWAVES * 64, 2) mk_fwd(Args args_unused) {
    extern __shared__ __attribute__((aligned(16))) unsigned char lds_raw[];
    LAS unsigned char* lds = (LAS unsigned char*)lds_raw;
    volatile LAS unsigned* MISC = (volatile LAS unsigned*)(lds + MISC_OFF);
    const int wave = __builtin_amdgcn_readfirstlane((int)threadIdx.x >> 6);
    const int G = gridDim.x, gw = blockIdx.x * NWAVES + wave, ngw = G * NWAVES;
    for (int u = threadIdx.x; u < (LDS_BYTES - LDSCTL_OFF) / 4; u += NWAVES * 64) ((LAS unsigned*)(lds + LDSCTL_OFF))[u] = 0u;
    __syncthreads();
    XcdBarrier bar; int lo, hi;
    { KArgs A = kargs(); bar = xcd_barrier_post((unsigned*)(A->ws + WS_CTL) + CW_BAR + (MK_PER_PHASE ? 0 : A->li) * XCD_BAR_WORDS, MISC + 8); lo = A->ph_lo; hi = A->ph_hi; }
#define IN(k) (lo <= (k) && (k) < hi)
#define SEAM(k) do { if (IN(k) && IN((k) + 1)) xcd_barrier(bar); } while (0)
#define LANE_TID() int wave_o = wave, gw_o = gw; asm volatile("" : "+s"(wave_o), "+s"(gw_o)); (void)gw_o; const int lane_o = lane_id_opq(), tid_o = wave_o * 64 + lane_o; (void)tid_o

    if (EN(0) && IN(0)) {
        KArgs A = kargs(); unsigned char* ws = A->ws; LANE_TID();
        p0_mod(A->in[1], A->in[2], A->in[3], (float*)(ws + WS_MOD), lds, tid_o, lane_o, wave_o);
        p0_weights(A->in[6], A->in[21], A->in[22], A->in[23], ws, lds, gw_o, ngw, wave_o, lane_o);
    }
    SEAM(0);
#pragma unroll 1
    for (int l = 0; l < NL; ++l) {
        const int pb = 1 + 8 * l;
        if (EN(1) && IN(pb + 0)) { KArgs A = kargs(); unsigned char* ws = A->ws; LANE_TID();
            norm_mod_phase(l == 0 ? A->in[0] : A->out, A->in[4] + l * DM, (const float*)(ws + WS_MOD) + (size_t)l * NB * MODP, 0, DM, (bf16*)(ws + WS_H), gw_o, ngw, lane_o); }
        SEAM(pb + 0);
        if (EN(2) && IN(pb + 1)) { KArgs A = kargs(); unsigned char* ws = A->ws; LANE_TID();
            pg8::Gemm g{(const bf16*)(ws + WS_H), (const bf16*)(ws + WS_WIN) + (size_t)l * NPI * DM, MT, NPI, DM}; pg8::StaticOrder S; S.init(MT, NPI, G, (int)blockIdx.x);
            pg8::EpiBf16Plain E{(bf16*)(ws + WS_PROJ), NPI};
            pg8::gemm_phase<pg8::EpiBf16Plain, pg8::StaticOrder, true, true>(lds, g, S, E, wave_o);
        }
        SEAM(pb + 1);
        if (EN(3) && IN(pb + 2)) { KArgs A = kargs(); unsigned char* ws = A->ws; LANE_TID();
            rwkv_prep_phase((const bf16*)(ws + WS_PROJ), A->in[8] + l * RWKV_IN, A->in[9] + l * 384, A->in[10] + (size_t)l * 64 * 384, A->in[11] + l * 384, A->in[12] + (size_t)l * 64 * 384,
                            A->in[13] + (size_t)l * 128 * 384, (float*)(ws + WS_DEC), (bf16*)(ws + WS_AA), (bf16*)(ws + WS_GG), lds, tid_o); }
        SEAM(pb + 2);
        if (EN(4) && IN(pb + 3)) { KArgs A = kargs(); unsigned char* ws = A->ws; LANE_TID();
            const float* gn = A->in[7] + l * DM; const bf16* PROJ = (const bf16*)(ws + WS_PROJ); bf16* Hb = (bf16*)(ws + WS_H);
            int u = (int)blockIdx.x; asm volatile("" : "+s"(u));
            if (u < 192) rwkv_unit(u / 6, u % 6, PROJ, (const float*)(ws + WS_DEC), (const bf16*)(ws + WS_AA), (const bf16*)(ws + WS_GG), A->in[8] + l * RWKV_IN, A->in[14] + l * 384, A->in[15] + l * 384, A->in[16] + l * 384, gn, Hb, lds, wave_o, lane_o);
            else if (u < 256) { const int q = u - 192; ret_unit(q >> 2, q & 3, PROJ, gn, Hb, lds, wave_o, lane_o); }
            if (u < 128) mlstm_unit(u >> 2, u & 3, PROJ, A->in[17] + (size_t)l * 4 * 768, A->in[18] + l * 768, A->in[19] + l * 4, A->in[20] + l * 4, gn, Hb, lds, wave_o, lane_o);
            else if (u < 192) { const int q = 64 + (u - 128); ret_unit(q >> 2, q & 3, PROJ, gn, Hb, lds, wave_o, lane_o); }
        }
        SEAM(pb + 3);
        if (EN(6) && IN(pb + 4)) { KArgs A = kargs(); unsigned char* ws = A->ws; LANE_TID();
            pg8::Gemm g{(const bf16*)(ws + WS_H), (const bf16*)(ws + WS_WOUT) + (size_t)l * DM * DM, MT, DM, DM}; pg8::StaticOrder S; S.init(MT, DM, G, (int)blockIdx.x);
            pg8::EpiResGate E{l == 0 ? A->in[0] : A->out, A->out, DM, (const float*)(ws + WS_MOD) + (size_t)l * NB * MODP + 2 * DM, MODP};
            pg8::gemm_phase<pg8::EpiResGate, pg8::StaticOrder, true, true>(lds, g, S, E, wave_o);
        }
        SEAM(pb + 4);
        if (EN(1) && IN(pb + 5)) { KArgs A = kargs(); unsigned char* ws = A->ws; LANE_TID();
            norm_mod_phase(A->out, A->in[5] + l * DM, (const float*)(ws + WS_MOD) + (size_t)l * NB * MODP, 3 * DM, 4 * DM, (bf16*)(ws + WS_H), gw_o, ngw, lane_o); }
        SEAM(pb + 5);
        if (EN(7) && IN(pb + 6)) { KArgs A = kargs(); unsigned char* ws = A->ws; LANE_TID();
            pg8::Gemm g{(const bf16*)(ws + WS_H), (const bf16*)(ws + WS_WF1) + (size_t)l * NF1 * DM, MT, NF1, DM}; pg8::StaticOrder S; S.init(MT, NF1, G, (int)blockIdx.x);
            pg8::EpiSwiGLU E{(bf16*)(ws + WS_PROJ), DFF};
            pg8::gemm_phase<pg8::EpiSwiGLU, pg8::StaticOrder, true, true>(lds, g, S, E, wave_o);
        }
        SEAM(pb + 6);
        if (EN(8) && IN(pb + 7)) { KArgs A = kargs(); unsigned char* ws = A->ws; LANE_TID();
            pg8::Gemm g{(const bf16*)(ws + WS_PROJ), (const bf16*)(ws + WS_WF2) + (size_t)l * DM * DFF, MT, DM, DFF}; pg8::StaticOrder S; S.init(MT, DM, G, (int)blockIdx.x);
            pg8::EpiResGate E{A->out, A->out, DM, (const float*)(ws + WS_MOD) + (size_t)l * NB * MODP + 5 * DM, MODP};
            pg8::gemm_phase<pg8::EpiResGate, pg8::StaticOrder, true, true>(lds, g, S, E, wave_o);
        }
        SEAM(pb + 7);
    }
    if (EN(9) && IN(N_PHASES - 1)) { KArgs A = kargs(); int gw_o = gw; asm volatile("" : "+s"(gw_o)); final_norm_phase(A->out, A->in[24], gw_o, ngw, lane_id_opq()); }
#undef IN
#undef SEAM
}

extern "C" void kernel_launch(void* const* d_in, const int* in_sizes, int n_in, void* d_out, int out_size, void* d_ws, size_t ws_size, hipStream_t stream) {
    static int grid = 0;
    if (grid == 0) {
        if (n_in != 25 || in_sizes[0] != MT * DM || out_size != MT * DM || ws_size < WS_END) { fprintf(stderr, "kernel_launch: shape/workspace mismatch (n_in %d, in0 %d, out %d, ws %zu)\n", n_in, n_in > 0 ? in_sizes[0] : -1, out_size, ws_size); grid = -1; return; }
        int dev = 0, cus = 0, per_cu = 0;
        if (hipGetDevice(&dev) != hipSuccess || hipDeviceGetAttribute(&cus, hipDeviceAttributeMultiprocessorCount, dev) != hipSuccess) { grid = -1; return; }
        if (hipFuncSetAttribute((const void*)mk_fwd, hipFuncAttributeMaxDynamicSharedMemorySize, LDS_BYTES) != hipSuccess) { fprintf(stderr, "kernel_launch: hipFuncSetAttribute failed\n"); grid = -1; return; }
        if (hipOccupancyMaxActiveBlocksPerMultiprocessor(&per_cu, (const void*)mk_fwd, NWAVES * 64, LDS_BYTES) != hipSuccess || per_cu < 1) { fprintf(stderr, "kernel_launch: occupancy query says %d\n", per_cu); }
        (void)hipGetLastError();
        grid = cus;
    }
    if (grid < 0) return;
    if (hipMemsetAsync((char*)d_ws + WS_CTL, 0, CTL_ZERO_BYTES, stream) != hipSuccess) return;
    Args a{};
    for (int i = 0; i < 25; ++i) a.in[i] = (const float*)d_in[i];
    a.out = (float*)d_out; a.ws = (unsigned char*)d_ws;
#if MK_PER_PHASE
    for (int p = 0; p < N_PHASES; ++p) { a.ph_lo = p; a.ph_hi = p + 1; a.li = 0; hipLaunchKernelGGL(mk_fwd, dim3(grid), dim3(NWAVES * 64), LDS_BYTES, stream, a); }
#else
    a.ph_lo = 0; a.ph_hi = N_PHASES; a.li = 0;
    hipLaunchKernelGGL(mk_fwd, dim3(grid), dim3(NWAVES * 64), LDS_BYTES, stream, a);
#endif
}
```

```cpp
#include <hip/hip_runtime.h>
#include <cstdio>
#include <cstdint>
__device__ __forceinline__ int lane_id_opq() { int l = (int)__builtin_amdgcn_mbcnt_hi(~0u, __builtin_amdgcn_mbcnt_lo(~0u, 0u)); asm volatile("" : "+v"(l)); return l; }

namespace pg8 {
#define PG8_LAS __attribute__((address_space(3)))
typedef unsigned short bf16_t;
typedef short bf16x8 __attribute__((ext_vector_type(8)));
typedef float f32x4 __attribute__((ext_vector_type(4)));
typedef unsigned u32x4 __attribute__((ext_vector_type(4)));
constexpr int BM = 256, BK = 64, HALF = 128, HTB = HALF * BK * 2  , STAGE_BYTES = 8 * HTB, NXCD = 8, WGM = 8;

__host__ __device__ __forceinline__ int lds_byte(int r, int c) { const int st = (r >> 4) * 2 + (c >> 5), rr = r & 15, cc = c & 31, ob = rr * 64 + cc * 2; return st * 1024 + (ob ^ (((ob >> 9) & 1) << 5)); }
__host__ __device__ __forceinline__ void stage_rc(int b, int& R, int& C) { const int st = b / 1024, sb = b % 1024, swz = sb ^ (((sb >> 9) & 1) << 5); R = (st >> 1) * 16 + swz / 64; C = (st & 1) * 32 + (swz % 64) / 2; }
__host__ __device__ __forceinline__ int perm32(int rho) { const int n = rho >> 4, i = rho & 15; return 8 * (i >> 2) + 4 * n + (i & 3); }

struct Unit { int pm, pn; };
struct Gemm { const bf16_t* A; const bf16_t* Bt; int M, N, K; };

struct StaticOrder {
    int nM, nN, nwg, G, c;
    __host__ __device__ void init(int M, int N, int G_, int c_) { nM = M / BM; nN = N / BM; nwg = nM * nN; G = G_; c = c_; }
    __host__ __device__ bool next(int i, Unit& u) const {
        const long L = (long)i * G + c; if (L >= nwg) return false;
        int wgid = (int)L; { const int q = nwg / NXCD, r = nwg % NXCD, xcd = wgid % NXCD, off = wgid / NXCD; wgid = (xcd < r ? xcd * (q + 1) : r * (q + 1) + (xcd - r) * q) + off; }
        const int nig = WGM * nN, gid = wgid / nig, fm = gid * WGM, gsz = (nM - fm) < WGM ? (nM - fm) : WGM;
        u.pm = fm + ((wgid % nig) % gsz); u.pn = (wgid % nig) / gsz; return true;
    }
    __device__ __forceinline__ void a_ready(const Unit&) const {}
    __device__ __forceinline__ void done(const Unit&) const {}
};

__device__ __forceinline__ unsigned cvt_pk_bf16(float lo, float hi) { unsigned r; asm volatile("v_cvt_pk_bf16_f32 %0, %1, %2" : "=v"(r) : "v"(lo), "v"(hi)); return r; }
typedef float f32x2 __attribute__((ext_vector_type(2)));

typedef float f32x2e __attribute__((ext_vector_type(2)));
typedef __bf16 bf16x2e __attribute__((ext_vector_type(2)));
__device__ __forceinline__ unsigned cvt_pk(float lo, float hi) { const f32x2e v = {lo, hi}; return __builtin_bit_cast(unsigned, __builtin_convertvector(v, bf16x2e)); }
__device__ __forceinline__ float silu_f(float x) { return x * __builtin_amdgcn_rcpf(1.0f + __expf(-x)); }
struct EpiBf16Plain {
    static constexpr bool PERM = true, AFTER_DRAIN = false;
    bf16_t* O; int ldc;
    __device__ __forceinline__ void operator()(const f32x4 (&acc)[2][2][4][2], const Unit& u, int wr, int wc, int fr, int fq) const {
        const int row0 = u.pm * BM + wr * 64 + fr, col0 = u.pn * BM + wc * 32 + 8 * fq;
#pragma unroll
        for (int ai = 0; ai < 2; ++ai)
#pragma unroll
            for (int m = 0; m < 4; ++m) { bf16_t* rowp = O + (size_t)(row0 + ai * HALF + m * 16) * ldc + col0;
#pragma unroll
                for (int bj = 0; bj < 2; ++bj) { const f32x4 v0 = acc[ai][bj][m][0], v1 = acc[ai][bj][m][1];
                    u32x4 w; w.x = cvt_pk(v0[0], v0[1]); w.y = cvt_pk(v0[2], v0[3]); w.z = cvt_pk(v1[0], v1[1]); w.w = cvt_pk(v1[2], v1[3]);
                    *(u32x4*)(rowp + bj * HALF) = w; } }
    }
};
struct EpiSwiGLU {
    static constexpr bool PERM = true, AFTER_DRAIN = false;
    bf16_t* O; int ldc;
    __device__ __forceinline__ void operator()(const f32x4 (&acc)[2][2][4][2], const Unit& u, int wr, int wc, int fr, int fq) const {
        const int row0 = u.pm * BM + wr * 64 + fr, col0 = u.pn * HALF + wc * 32 + 8 * fq;
#pragma unroll
        for (int ai = 0; ai < 2; ++ai)
#pragma unroll
            for (int m = 0; m < 4; ++m) { bf16_t* rowp = O + (size_t)(row0 + ai * HALF + m * 16) * ldc + col0;
                const f32x4 g0 = acc[ai][0][m][0], g1 = acc[ai][0][m][1], u0 = acc[ai][1][m][0], u1 = acc[ai][1][m][1];
                u32x4 w; w.x = cvt_pk(silu_f(g0[0]) * u0[0], silu_f(g0[1]) * u0[1]); w.y = cvt_pk(silu_f(g0[2]) * u0[2], silu_f(g0[3]) * u0[3]);
                w.z = cvt_pk(silu_f(g1[0]) * u1[0], silu_f(g1[1]) * u1[1]); w.w = cvt_pk(silu_f(g1[2]) * u1[2], silu_f(g1[3]) * u1[3]);
                *(u32x4*)rowp = w; }
    }
};
struct EpiResGate {
    static constexpr bool PERM = false, AFTER_DRAIN = false;
    const float* xin; float* xout; int ldc; const float* gate; int gpitch;
    __device__ __forceinline__ void operator()(const f32x4 (&acc)[2][2][4][2], const Unit& u, int wr, int wc, int fr, int fq) const {
        const int row0 = u.pm * BM + wr * 64 + fr, col0 = u.pn * BM + wc * 32 + 4 * fq;
        const float* gp = gate + (size_t)(u.pm >> 3) * gpitch + col0;
        f32x4 gv[2][2];
#pragma unroll
        for (int bj = 0; bj < 2; ++bj)
#pragma unroll
            for (int n = 0; n < 2; ++n) gv[bj][n] = *(const f32x4*)(gp + bj * HALF + n * 16);
#pragma unroll
        for (int ai = 0; ai < 2; ++ai)
#pragma unroll
            for (int m = 0; m < 4; ++m) { const size_t off = (size_t)(row0 + ai * HALF + m * 16) * ldc + col0;
#pragma unroll
                for (int bj = 0; bj < 2; ++bj)
#pragma unroll
                    for (int n = 0; n < 2; ++n) { const f32x4 xi = *(const f32x4*)(xin + off + bj * HALF + n * 16);
                        *(f32x4*)(xout + off + bj * HALF + n * 16) = xi + gv[bj][n] * acc[ai][bj][m][n]; }
                asm volatile("" ::: "memory"); }
    }
};

template <class Epi, class Sched, bool ALIGN_EPI = false, bool SP2 = false>
__device__ __forceinline__ void gemm_phase(PG8_LAS unsigned char* lds, const Gemm g, const Sched& S, const Epi& E, const int wid_in) {
    const int wid = wid_in, lane = lane_id_opq(), tid = wid * 64 + lane, wr = wid >> 2, wc = wid & 3, fr = lane & 15, fq = lane >> 4;
    const int K = g.K, nt = K / BK;
    unsigned voffA[2], voffB[2];
#pragma unroll
    for (int i = 0; i < 2; ++i) { int R, C; stage_rc(tid * 16 + i * 8192, R, C); const int Rb = Epi::PERM ? ((R & ~31) + perm32(R & 31)) : R;
        voffA[i] = (unsigned)(R * K + C) * 2u; voffB[i] = (unsigned)(Rb * K + C) * 2u; }
    const size_t kstep = (size_t)(BK * 2);
    const size_t hstep = (size_t)HALF * K * 2;
    const size_t tstep = 2 * hstep;
    const unsigned ldsw = (unsigned)wid * 1024u;
    const int aoff = lds_byte(wr * 64 + fr, fq * 8), boff = lds_byte(wc * 32 + fr, fq * 8);
#define PG8_SA(b, h) (((b) * 2 + (h)) * HTB)
#define PG8_SB(b, h) ((4 + (b) * 2 + (h)) * HTB)
#define PG8_STAGE(bufoff, gbase, voff) do { _Pragma("unroll") for (int _i = 0; _i < 2; ++_i) \
        __builtin_amdgcn_global_load_lds((const unsigned*)((const char*)(gbase) + (voff)[_i]), (PG8_LAS unsigned*)(lds + (bufoff) + ldsw + _i * 8192), 16, 0, 0); } while (0)
#define PG8_LDA(dst, b, h) do { _Pragma("unroll") for (int m = 0; m < 4; ++m) _Pragma("unroll") for (int k = 0; k < 2; ++k) dst[m][k] = *(const PG8_LAS bf16x8*)(lds + PG8_SA(b, h) + aoff + m * 2048 + k * 1024); } while (0)
#define PG8_LDB(dst, b, h) do { _Pragma("unroll") for (int n = 0; n < 2; ++n) _Pragma("unroll") for (int k = 0; k < 2; ++k) dst[n][k] = *(const PG8_LAS bf16x8*)(lds + PG8_SB(b, h) + boff + n * 2048 + k * 1024); } while (0)
#define PG8_MMA(ai, bj, At, Bt) do { __builtin_amdgcn_s_setprio(1); _Pragma("unroll") for (int m = 0; m < 4; ++m) _Pragma("unroll") for (int n = 0; n < 2; ++n) _Pragma("unroll") for (int k = 0; k < 2; ++k) \
        acc[ai][bj][m][n] = __builtin_amdgcn_mfma_f32_16x16x32_bf16(Bt[n][k], At[m][k], acc[ai][bj][m][n], 0, 0, 0); __builtin_amdgcn_s_setprio(0); } while (0)
#define PG8_WAIT_V(n) asm volatile("s_waitcnt vmcnt(" #n ")" ::: "memory")
#define PG8_WAIT_L(n) asm volatile("s_waitcnt lgkmcnt(" #n ")" ::: "memory")
#define PG8_BAR __builtin_amdgcn_s_barrier()
#define PG8_SCHED __builtin_amdgcn_sched_barrier(0)
    Unit cur, nxt; int ui = 0;
    if (!S.next(0, cur)) return;
    f32x4 acc[2][2][4][2];
#pragma unroll
    for (int a = 0; a < 2; ++a)
#pragma unroll
        for (int b = 0; b < 2; ++b)
#pragma unroll
            for (int m = 0; m < 4; ++m)
#pragma unroll
                for (int n = 0; n < 2; ++n) acc[a][b][m][n] = (f32x4){0.f, 0.f, 0.f, 0.f};
    bf16x8 At[4][2], B0[2][2], B1[2][2];
    const char* cA = (const char*)g.A + (size_t)cur.pm * tstep; const char* cB = (const char*)g.Bt + (size_t)cur.pn * tstep;
    S.a_ready(cur);
    if constexpr (SP2) {
        PG8_STAGE(PG8_SB(0, 0), cB, voffB); PG8_STAGE(PG8_SB(0, 1), cB + hstep, voffB); PG8_STAGE(PG8_SA(0, 0), cA, voffA); PG8_STAGE(PG8_SA(0, 1), cA + hstep, voffA);
        if (wr == 1) PG8_BAR;
        PG8_WAIT_V(2); PG8_BAR;
        PG8_STAGE(PG8_SB(1, 0), cB + kstep, voffB); PG8_STAGE(PG8_SA(1, 0), cA + kstep, voffA); PG8_STAGE(PG8_SB(1, 1), cB + hstep + kstep, voffB);
        PG8_WAIT_V(6); PG8_BAR;
    } else {
        PG8_STAGE(PG8_SB(0, 0), cB, voffB); PG8_STAGE(PG8_SA(0, 0), cA, voffA); PG8_STAGE(PG8_SB(0, 1), cB + hstep, voffB); PG8_STAGE(PG8_SA(0, 1), cA + hstep, voffA);
        if (wr == 1) PG8_BAR;
        PG8_WAIT_V(4); PG8_BAR;
        PG8_STAGE(PG8_SB(1, 0), cB + kstep, voffB); PG8_STAGE(PG8_SA(1, 0), cA + kstep, voffA); PG8_STAGE(PG8_SB(1, 1), cB + hstep + kstep, voffB);
        PG8_WAIT_V(6); PG8_BAR;
    }
    for (;;) {
        const bool has_next = S.next(ui + 1, nxt);
        const char* nA = has_next ? (const char*)g.A + (size_t)nxt.pm * tstep : cA; const char* nB = has_next ? (const char*)g.Bt + (size_t)nxt.pn * tstep : cB;
        for (int t = 0; t < nt; t += 2) {
            const bool last = (t == nt - 2);
            const char* a1 = cA + (size_t)(t + 1) * kstep;
            const char* a2 = last ? nA : cA + (size_t)(t + 2) * kstep; const char* b2 = last ? nB : cB + (size_t)(t + 2) * kstep;
            const char* a3 = a2 + kstep; const char* b3 = b2 + kstep;
            if (last && has_next) S.a_ready(nxt);
            if constexpr (SP2) {
            PG8_LDB(B0, 0, 0); PG8_LDB(B1, 0, 1); PG8_SCHED; PG8_LDA(At, 0, 0); PG8_STAGE(PG8_SA(1, 1), a1 + hstep, voffA);
            PG8_WAIT_V(8); PG8_WAIT_L(0); PG8_BAR; PG8_MMA(0, 0, At, B0); PG8_MMA(0, 1, At, B1); PG8_BAR; PG8_SCHED;
            PG8_LDA(At, 0, 1); PG8_STAGE(PG8_SB(0, 0), b2, voffB); PG8_STAGE(PG8_SB(0, 1), b2 + hstep, voffB); PG8_STAGE(PG8_SA(0, 0), a2, voffA);
            PG8_WAIT_V(8); PG8_WAIT_L(0); PG8_BAR; PG8_MMA(1, 0, At, B0); PG8_MMA(1, 1, At, B1); PG8_BAR; PG8_SCHED;
            PG8_LDB(B0, 1, 0); PG8_LDB(B1, 1, 1); PG8_SCHED; PG8_LDA(At, 1, 0); PG8_STAGE(PG8_SA(0, 1), a2 + hstep, voffA);
            PG8_WAIT_V(8); PG8_WAIT_L(0); PG8_BAR; PG8_MMA(0, 0, At, B0); PG8_MMA(0, 1, At, B1); PG8_BAR; PG8_SCHED;
            PG8_LDA(At, 1, 1); PG8_STAGE(PG8_SB(1, 0), b3, voffB); PG8_STAGE(PG8_SB(1, 1), b3 + hstep, voffB); PG8_STAGE(PG8_SA(1, 0), a3, voffA);
            PG8_WAIT_V(8); PG8_WAIT_L(0); PG8_BAR; PG8_MMA(1, 0, At, B0); PG8_MMA(1, 1, At, B1); PG8_BAR; PG8_SCHED;
            } else {
            PG8_LDB(B0, 0, 0); PG8_SCHED; PG8_LDA(At, 0, 0); PG8_STAGE(PG8_SA(1, 1), a1 + hstep, voffA);
            PG8_WAIT_L(8); PG8_BAR; PG8_WAIT_L(0); PG8_MMA(0, 0, At, B0); PG8_BAR; PG8_SCHED;
            PG8_LDB(B1, 0, 1); PG8_STAGE(PG8_SB(0, 0), b2, voffB);
            PG8_BAR; PG8_WAIT_L(0); PG8_MMA(0, 1, At, B1); PG8_BAR;
            PG8_LDA(At, 0, 1); PG8_STAGE(PG8_SA(0, 0), a2, voffA);
            PG8_BAR; PG8_WAIT_L(0); PG8_MMA(1, 0, At, B0); PG8_BAR; PG8_SCHED;
            PG8_STAGE(PG8_SB(0, 1), b2 + hstep, voffB);
            PG8_WAIT_V(6); PG8_BAR; PG8_MMA(1, 1, At, B1); PG8_BAR;
            PG8_LDB(B0, 1, 0); PG8_SCHED; PG8_LDA(At, 1, 0); PG8_STAGE(PG8_SA(0, 1), a2 + hstep, voffA);
            PG8_WAIT_L(8); PG8_BAR; PG8_WAIT_L(0); PG8_MMA(0, 0, At, B0); PG8_BAR; PG8_SCHED;
            PG8_LDB(B1, 1, 1); PG8_STAGE(PG8_SB(1, 0), b3, voffB);
            PG8_BAR; PG8_WAIT_L(0); PG8_MMA(0, 1, At, B1); PG8_BAR;
            PG8_LDA(At, 1, 1); PG8_STAGE(PG8_SA(1, 0), a3, voffA);
            PG8_BAR; PG8_WAIT_L(0); PG8_MMA(1, 0, At, B0); PG8_BAR; PG8_SCHED;
            PG8_STAGE(PG8_SB(1, 1), b3 + hstep, voffB);
            PG8_WAIT_V(6); PG8_BAR; PG8_MMA(1, 1, At, B1); PG8_BAR;
            }
        }
        if constexpr (ALIGN_EPI) { if (wr == 0) PG8_BAR; }
        if constexpr (!Epi::AFTER_DRAIN) { E(acc, cur, wr, wc, fr, fq); S.done(cur); }
        if (!has_next) break;
#pragma unroll
        for (int a = 0; a < 2; ++a)
#pragma unroll
            for (int b = 0; b < 2; ++b)
#pragma unroll
                for (int m = 0; m < 4; ++m)
#pragma unroll
                    for (int n = 0; n < 2; ++n) acc[a][b][m][n] = (f32x4){0.f, 0.f, 0.f, 0.f};
        cur = nxt; cA = nA; cB = nB; ++ui;
        if constexpr (ALIGN_EPI) { if (wr == 1) PG8_BAR; }
    }
    PG8_WAIT_V(0);
    if constexpr (!ALIGN_EPI) { if (wr == 0) PG8_BAR; }
    PG8_BAR;
    if constexpr (Epi::AFTER_DRAIN) { E.fused(acc, cur, wr, wc, fr, fq, lds, wid, lane); S.done(cur); }
#undef PG8_SA
#undef PG8_SB
#undef PG8_STAGE
#undef PG8_LDA
#undef PG8_LDB
#undef PG8_MMA
#undef PG8_WAIT_V
#undef PG8_WAIT_L
#undef PG8_BAR
#undef PG8_SCHED
}
}

#ifndef MK_PER_PHASE
#define MK_PER_PHASE 0
#endif
constexpr int NWAVES = 8;
constexpr int DM = 1024, NB = 32, SEQ = 2048, NL = 4, MT = NB * SEQ;
constexpr int D_IN = 3976, NPI = 4096, DFF = 2816, NF1 = 2 * DFF;
constexpr int RW_B = 1024, ML_B = 2432;
constexpr int RWKV_IN = 1408;
constexpr float RMS_EPS = 1e-6f, GN_EPS = 1e-5f;
constexpr int MODP = 6 * DM;
constexpr size_t MiB = 1u << 20;
constexpr size_t WS_CTL = 0, CTL_ZERO_BYTES = 1 * MiB;
constexpr size_t WS_WL = 5 * MiB;
constexpr size_t WS_MOD = 1 * MiB;
constexpr size_t WS_WIN = 8 * MiB, WS_WOUT = 40 * MiB, WS_WF1 = 48 * MiB, WS_WF2 = 92 * MiB;
constexpr size_t WS_H = 128 * MiB;
constexpr size_t WS_PROJ = 256 * MiB;
constexpr size_t WS_DEC = 768 * MiB, WS_AA = 864 * MiB, WS_GG = 912 * MiB;
constexpr size_t WS_END = 960 * MiB;
constexpr int CW_BAR = 4096;
constexpr int N_PHASES = 2 + 8 * NL;
static_assert((CW_BAR + (MK_PER_PHASE ? 1 : 1) * 3456) * 4 <= (int)CTL_ZERO_BYTES, "ctl");
constexpr int RING_BYTES = 131072, LDSCTL_OFF = RING_BYTES, MISC_OFF = LDSCTL_OFF + 320, LDS_BYTES = 147456;

#define GAS __attribute__((address_space(1)))
#define LAS __attribute__((address_space(3)))
typedef unsigned short bf16;
typedef unsigned v4u __attribute__((ext_vector_type(4)));
typedef unsigned v2u __attribute__((ext_vector_type(2)));
typedef float f32x4 __attribute__((ext_vector_type(4)));
#define LDS_WAIT() asm volatile("s_waitcnt lgkmcnt(0)" ::: "memory")
typedef float f32x2c __attribute__((ext_vector_type(2)));
typedef __bf16 bf16x2c __attribute__((ext_vector_type(2)));
__device__ __forceinline__ unsigned f2bf(float f) { unsigned u = __builtin_bit_cast(unsigned, f); return (u + 0x7fffu + ((u >> 16) & 1u)) >> 16; }
__device__ __forceinline__ unsigned pk2(float lo, float hi) { return f2bf(lo) | (f2bf(hi) << 16); }
__device__ __forceinline__ float bf2f(bf16 v) { return __uint_as_float(((unsigned)v) << 16); }
template <int CTRL, int ROWMASK> __device__ __forceinline__ float dppf(float v) { return __builtin_bit_cast(float, __builtin_amdgcn_update_dpp(0, __builtin_bit_cast(int, v), CTRL, ROWMASK, 0xf, false)); }
__device__ __forceinline__ float sum16(float v) { v += dppf<0xB1, 0xf>(v); v += dppf<0x4E, 0xf>(v); v += dppf<0x141, 0xf>(v); v += dppf<0x140, 0xf>(v); return v; }
__device__ __forceinline__ float wave_sum(float v) { v = sum16(v); v += dppf<0x142, 0xa>(v); v += dppf<0x143, 0xc>(v); return __builtin_bit_cast(float, __builtin_amdgcn_readlane(__builtin_bit_cast(int, v), 63)); }
__device__ __forceinline__ float fexp(float x) { return __expf(x); }
__device__ __forceinline__ float fsigmoid(float x) { return __builtin_amdgcn_rcpf(1.0f + __expf(-x)); }
__device__ __forceinline__ float sigmoid_f(float x) { return 1.0f / (1.0f + expf(-x)); }
__device__ __forceinline__ float logsigmoid_f(float x) { return fminf(x, 0.f) - log1pf(expf(-fabsf(x))); }
template <class T> __device__ __forceinline__ T* opq(T* p) { asm volatile("" : "+s"(p)); return p; }

#define XB_TMO      128
#define XB_XCNT(j)  (256  + 64 * (j))
#define XB_XSUB(j)  (1280 + 64 * (j))
#define XB_XGEN(j)  (2304 + 64 * (j))
#define XB_TOP      3328
#define XB_TOPGEN   3392
#define XCD_BAR_WORDS 3456
#define XB_SPIN_CAP (1u << 22)

__device__ __forceinline__ unsigned xb_ld(unsigned* p)              { return __hip_atomic_load(p, __ATOMIC_RELAXED, __HIP_MEMORY_SCOPE_AGENT); }
__device__ __forceinline__ unsigned xb_add(unsigned* p, unsigned v) { return __hip_atomic_fetch_add(p, v, __ATOMIC_RELAXED, __HIP_MEMORY_SCOPE_AGENT); }
__device__ __forceinline__ unsigned xb_xcc_id() { return (unsigned)__builtin_amdgcn_s_getreg((3 << 11) | 20) & 0xFu; }
#define XB_SPIN(cond, bar) do { unsigned _sp = 0; while (cond) { __builtin_amdgcn_s_sleep(1); \
    if ((++_sp & 255u) == 0u) { if (xb_ld(&(bar)[XB_TMO])) break; if (_sp > XB_SPIN_CAP) { atomicAdd(&(bar)[XB_TMO], 1u); break; } } } } while (0)

struct XcdBarrier {
    unsigned* bar; unsigned x; unsigned w0;
    volatile LAS unsigned* st;
};

__device__ __forceinline__ XcdBarrier xcd_barrier_post(unsigned* bar, volatile LAS unsigned* st) {
    XcdBarrier b; b.bar = bar; b.x = xb_xcc_id(); b.st = st; b.w0 = (__builtin_amdgcn_readfirstlane((int)threadIdx.x >> 6) == 0) ? 1u : 0u;
    if (threadIdx.x == 0) (void)xb_add(&bar[XB_XCNT(b.x)], 1u);
    return b;
}
__device__ __forceinline__ void xcd_barrier_complete(unsigned* bar, unsigned x, unsigned& nloc, unsigned& nx) {
    const unsigned G = gridDim.x * gridDim.y * gridDim.z;
    unsigned sum, cnt, mine, sp = 0u;
    for (;;) {
        sum = 0u; cnt = 0u; mine = 0u;
#pragma unroll
        for (unsigned j = 0; j < 16; ++j) { const unsigned c = xb_ld(&bar[XB_XCNT(j)]); sum += c; cnt += (c > 0u) ? 1u : 0u; mine = (j == x) ? c : mine; }
        if (sum == G) break;
        __builtin_amdgcn_s_sleep(1);
        if ((++sp & 255u) == 0u) { if (xb_ld(&bar[XB_TMO])) break; if (sp > XB_SPIN_CAP) { atomicAdd(&bar[XB_TMO], 1u); break; } }
    }
    nloc = mine > 0u ? mine : 1u; nx = cnt > 0u ? cnt : 1u;
}

__device__ __forceinline__ void xcd_barrier(const XcdBarrier& b) {
    asm volatile("s_waitcnt vmcnt(0)" ::: "memory");
    __syncthreads();
    if (b.w0 != 0u && lane_id_opq() == 0) {
        unsigned* bar = b.bar;
        __builtin_amdgcn_s_waitcnt(0);
        unsigned nloc = b.st[0], nx = b.st[1];
        if (nloc == 0u) { xcd_barrier_complete(bar, b.x, nloc, nx); b.st[0] = nloc; b.st[1] = nx; }
        const unsigned old = xb_add(&bar[XB_XSUB(b.x)], 1u);
        const unsigned gen = old / nloc;
        if (old + 1u == (gen + 1u) * nloc) {
            __builtin_amdgcn_fence(__ATOMIC_RELEASE, "agent");
            asm volatile("s_waitcnt vmcnt(0)" ::: "memory");
            const unsigned og = xb_add(&bar[XB_TOP], 1u);
            const unsigned tg = og / nx;
            if (og + 1u == (tg + 1u) * nx) xb_add(&bar[XB_TOPGEN], 1u);
            else XB_SPIN(xb_ld(&bar[XB_TOPGEN]) == tg, bar);
            __builtin_amdgcn_fence(__ATOMIC_ACQUIRE, "agent");
            xb_add(&bar[XB_XGEN(b.x)], 1u);
            asm volatile("s_waitcnt vmcnt(0)" ::: "memory");
        } else {
            XB_SPIN(xb_ld(&bar[XB_XGEN(b.x)]) == gen, bar);
            __builtin_amdgcn_fence(__ATOMIC_ACQUIRE, "agent");
            asm volatile("s_waitcnt vmcnt(0)" ::: "memory");
        }
    }
    __syncthreads();
}


__device__ __forceinline__ void p0_mod(const float* c, const float* ada_w, const float* ada_b, float* mod, LAS unsigned char* lds, int tid, int lane, int wave) {
    LAS float* condT = (LAS float*)lds;
    for (int e = tid; e < NB * DM; e += NWAVES * 64) { const int k = e >> 5, b = e & 31; const float v = c[b * DM + k]; condT[e] = v / (1.0f + expf(-v)); }
    __syncthreads();
    for (int item = blockIdx.x; item < NL * 96; item += gridDim.x) {
        const int l = item / 96, g = item % 96, n = g * 64 + lane;
        const float* W = ada_w + (size_t)l * DM * MODP + n;
        float a0 = 0.f, a1 = 0.f, a2 = 0.f, a3 = 0.f;
        for (int k = 0; k < DM; k += 8) {
            float w[8];
#pragma unroll
            for (int u = 0; u < 8; ++u) w[u] = W[(size_t)(k + u) * MODP];
#pragma unroll
            for (int u = 0; u < 8; ++u) { const f32x4 cv = *(const LAS f32x4*)(condT + (k + u) * 32 + wave * 4); a0 += cv.x * w[u]; a1 += cv.y * w[u]; a2 += cv.z * w[u]; a3 += cv.w * w[u]; }
        }
        const float bb = ada_b[l * MODP + n]; float* o = mod + ((size_t)l * NB + wave * 4) * MODP + n;
        o[0] = a0 + bb; o[MODP] = a1 + bb; o[2 * MODP] = a2 + bb; o[3 * MODP] = a3 + bb;
    }
    __syncthreads();
}
template <int MODE>
__device__ __forceinline__ void transpose_item(const float* W, int K, int N, int nblk, bf16* WT, int ldw, LAS float* scr, int item, int lane) {
    const int kb = item / nblk, nb = item % nblk, k0 = 64 * kb, n0 = 32 * nb;
    const int nn = n0 + (lane & 31); const bool ok = nn < N;
#pragma unroll 8
    for (int i = 0; i < 32; ++i) { const int kk = 2 * i + (lane >> 5); scr[kk * 33 + (lane & 31)] = ok ? W[(size_t)(k0 + kk) * N + nn] : 0.f; }
    LDS_WAIT();
    const int c = lane & 7;
#pragma unroll
    for (int j = 0; j < 4; ++j) { const int n = (lane >> 3) + 8 * j; const LAS float* s = scr + (8 * c) * 33 + n;
        v4u o; o.x = pk2(s[0 * 33], s[1 * 33]); o.y = pk2(s[2 * 33], s[3 * 33]); o.z = pk2(s[4 * 33], s[5 * 33]); o.w = pk2(s[6 * 33], s[7 * 33]);
        int row = n0 + n;
        if (MODE == 1) { const int up = row >= DFF ? 1 : 0, jj = row - up * DFF; row = (jj >> 7) * 256 + up * 128 + (jj & 127); }
        *(v4u*)(WT + (size_t)row * ldw + k0 + 8 * c) = o; }
    LDS_WAIT();
}
__device__ __forceinline__ void p0_weights(const float* w_in, const float* w_out, const float* f1, const float* f2, const float* lw2, const float* la2, const float* lg2, unsigned char* ws, LAS unsigned char* lds, int gw, int ngw, int wave, int lane) {
    LAS float* scr = (LAS float*)(lds + wave * 16384);
    constexpr int I_IN = (DM / 64) * (NPI / 32), I_OUT = (DM / 64) * (DM / 32), I_F1 = (DM / 64) * (NF1 / 32), I_F2 = (DFF / 64) * (DM / 32), I_L = I_IN + I_OUT + I_F1 + I_F2 + 48;
    for (int it = gw; it < NL * I_L; it += ngw) {
        const int l = it / I_L; int r = it % I_L;
        if (r < I_IN) { transpose_item<0>(w_in + (size_t)l * DM * D_IN, DM, D_IN, NPI / 32, (bf16*)(ws + WS_WIN) + (size_t)l * NPI * DM, DM, scr, r, lane); continue; } r -= I_IN;
        if (r < I_OUT) { transpose_item<0>(w_out + (size_t)l * DM * DM, DM, DM, DM / 32, (bf16*)(ws + WS_WOUT) + (size_t)l * DM * DM, DM, scr, r, lane); continue; } r -= I_OUT;
        if (r < I_F1) { transpose_item<1>(f1 + (size_t)l * DM * NF1, DM, NF1, NF1 / 32, (bf16*)(ws + WS_WF1) + (size_t)l * NF1 * DM, DM, scr, r, lane); continue; } r -= I_F1;
        if (r < I_F2) { transpose_item<0>(f2 + (size_t)l * DFF * DM, DFF, DM, DM / 32, (bf16*)(ws + WS_WF2) + (size_t)l * DM * DFF, DFF, scr, r, lane); continue; } r -= I_F2;
        bf16* wl = (bf16*)(ws + WS_WL) + (size_t)l * 384 * 256;
        if (r < 12) { transpose_item<0>(lw2 + (size_t)l * 64 * 384, 64, 384, 12, wl, 256, scr, r, lane); continue; } r -= 12;
        if (r < 12) { transpose_item<0>(la2 + (size_t)l * 64 * 384, 64, 384, 12, wl + 64, 256, scr, r, lane); continue; } r -= 12;
        transpose_item<0>(lg2 + (size_t)l * 128 * 384, 128, 384, 12, wl + 128, 256, scr, r, lane);
    }
}
__device__ __forceinline__ void norm_mod_phase(const float* xin, const float* gain, const float* modl, int sh_off, int sc_off, bf16* out, int gw, int ngw, int lane) {
    for (int ci = gw; ci < MT / 32; ci += ngw) {
        const int b = ci >> 6; const float* mb = modl + (size_t)b * MODP;
        f32x4 gs[4], sh[4];
#pragma unroll
        for (int j = 0; j < 4; ++j) { const int col = 4 * lane + 256 * j; const f32x4 g = *(const f32x4*)(gain + col), s = *(const f32x4*)(mb + sc_off + col); gs[j] = g * (s + 1.0f); sh[j] = *(const f32x4*)(mb + sh_off + col); }
        for (int r = 0; r < 32; ++r) {
            const size_t row = (size_t)ci * 32 + r; const f32x4* xr = (const f32x4*)(xin + row * DM) + lane;
            f32x4 v[4]; float ss = 0.f;
#pragma unroll
            for (int j = 0; j < 4; ++j) { v[j] = xr[64 * j]; ss += (v[j].x * v[j].x + v[j].y * v[j].y) + (v[j].z * v[j].z + v[j].w * v[j].w); }
            const float rstd = 1.0f / sqrtf(wave_sum(ss) * (1.0f / DM) + RMS_EPS);
            v2u* o8 = (v2u*)(out + row * DM) + lane;
#pragma unroll
            for (int j = 0; j < 4; ++j) { const f32x4 y = v[j] * rstd * gs[j] + sh[j]; v2u w; w.x = pk2(y.x, y.y); w.y = pk2(y.z, y.w); o8[64 * j] = w; }
        }
    }
}
__device__ __forceinline__ void final_norm_phase(float* x, const float* gain, int gw, int ngw, int lane) {
    f32x4 g[4];
#pragma unroll
    for (int j = 0; j < 4; ++j) g[j] = *(const f32x4*)(gain + 4 * lane + 256 * j);
    for (int row = gw; row < MT; row += ngw) {
        f32x4* xr = (f32x4*)(x + (size_t)row * DM) + lane; f32x4 v[4]; float ss = 0.f;
#pragma unroll
        for (int j = 0; j < 4; ++j) { v[j] = xr[64 * j]; ss += (v[j].x * v[j].x + v[j].y * v[j].y) + (v[j].z * v[j].z + v[j].w * v[j].w); }
        const float rstd = 1.0f / sqrtf(wave_sum(ss) * (1.0f / DM) + RMS_EPS);
#pragma unroll
        for (int j = 0; j < 4; ++j) xr[64 * j] = v[j] * rstd * g[j];
    }
}
#define WG_BAR() do { asm volatile("s_waitcnt vmcnt(0) lgkmcnt(0)" ::: "memory"); __builtin_amdgcn_s_barrier(); asm volatile("" ::: "memory"); } while (0)
#define WG_BAR_L() do { asm volatile("s_waitcnt lgkmcnt(0)" ::: "memory"); __builtin_amdgcn_s_barrier(); asm volatile("" ::: "memory"); } while (0)
typedef short bf16x8p __attribute__((ext_vector_type(8)));
__device__ __forceinline__ void rwkv_prep_mfma(const bf16* proj, const float* mu, const float* w0, const float* a0, const bf16* WL, float* DEC, bf16* AA, bf16* GG, LAS unsigned char* lds, int wave) {
    constexpr int AP = 264;
    LAS bf16* act = (LAS bf16*)lds;
#pragma unroll 1
    for (int item = blockIdx.x; item < MT / 64; item += gridDim.x) {
        const int lane = lane_id_opq(), tid = wave * 64 + lane, q4 = lane >> 4, lc = lane & 15;
        const size_t m0 = (size_t)item * 64; const int t0 = (int)(m0 % SEQ);
        { const int tt = tid >> 3, cg = tid & 7; const bf16* p = proj + (m0 + tt) * NPI + RW_B + 1152 + 32 * cg; const bool hp = (t0 + tt) > 0; const float* mup = mu + 1152 + 32 * cg;
#pragma unroll
          for (int v = 0; v < 4; ++v) { const v4u cur = *(const v4u*)(p + 8 * v); v4u prv = (v4u){0u, 0u, 0u, 0u}; if (hp) prv = *(const v4u*)(p - NPI + 8 * v);
              const f32x4 m0v = *(const f32x4*)(mup + 8 * v), m1v = *(const f32x4*)(mup + 8 * v + 4);
              float x[8];
#pragma unroll
              for (int e = 0; e < 4; ++e) { const unsigned cw = cur[e], pw = prv[e]; const float c0 = __uint_as_float(cw << 16), c1 = __uint_as_float(cw & 0xffff0000u), p0 = __uint_as_float(pw << 16), p1 = __uint_as_float(pw & 0xffff0000u);
                  const float mu0 = e < 2 ? m0v[2 * e] : m1v[2 * e - 4], mu1 = e < 2 ? m0v[2 * e + 1] : m1v[2 * e - 3];
                  x[2 * e] = c0 + (p0 - c0) * mu0; x[2 * e + 1] = c1 + (p1 - c1) * mu1; }
              if (cg < 2) {
#pragma unroll
                  for (int e = 0; e < 8; ++e) x[e] = 2.0f * fsigmoid(2.0f * x[e]) - 1.0f;
              } else if (cg >= 4) {
#pragma unroll
                  for (int e = 0; e < 8; ++e) x[e] = fsigmoid(x[e]);
              }
              v4u o; o.x = pk2(x[0], x[1]); o.y = pk2(x[2], x[3]); o.z = pk2(x[4], x[5]); o.w = pk2(x[6], x[7]);
              *(LAS v4u*)(act + tt * AP + 32 * cg + 8 * v) = o; } }
        WG_BAR_L();
        const LAS bf16* afr = act + lc * AP + 8 * q4;
        const bf16* bfr = WL + (size_t)(48 * wave + lc) * 256 + 8 * q4;
        { f32x4 acc[4][3];
#pragma unroll
          for (int mt = 0; mt < 4; ++mt)
#pragma unroll
              for (int nt = 0; nt < 3; ++nt) acc[mt][nt] = (f32x4){0.f, 0.f, 0.f, 0.f};
#pragma unroll
          for (int ks = 0; ks < 2; ++ks) { bf16x8p bq[3];
#pragma unroll
              for (int nt = 0; nt < 3; ++nt) bq[nt] = *(const bf16x8p*)(bfr + 16 * nt * 256 + 32 * ks);
#pragma unroll
              for (int mt = 0; mt < 4; ++mt) { const bf16x8p aq = *(const LAS bf16x8p*)(afr + 16 * mt * AP + 32 * ks);
#pragma unroll
                  for (int nt = 0; nt < 3; ++nt) acc[mt][nt] = __builtin_amdgcn_mfma_f32_16x16x32_bf16(aq, bq[nt], acc[mt][nt], 0, 0, 0); } }
#pragma unroll
          for (int nt = 0; nt < 3; ++nt) { const int n = 48 * wave + 16 * nt + lc; const float w0n = w0[n]; float carry = 0.f;
#pragma unroll
              for (int mt = 0; mt < 4; ++mt) { float pr[4];
#pragma unroll
                  for (int r = 0; r < 4; ++r) { const float ld = -0.60653066f * fsigmoid(w0n + acc[mt][nt][r]); pr[r] = r ? pr[r - 1] + ld : ld; }
                  const float tot = pr[3]; float s1 = tot; { const float u = __shfl_up(s1, 16); if (q4 >= 1) s1 += u; } { const float u = __shfl_up(s1, 32); if (q4 >= 2) s1 += u; }
                  const float excl = carry + (s1 - tot), tile_tot = __shfl(s1, 48 + lc);
                  float* dp = DEC + (m0 + 16 * mt + 4 * q4) * 384 + n;
#pragma unroll
                  for (int r = 0; r < 4; ++r) dp[r * 384] = excl + pr[r];
                  carry += tile_tot; } } }
        { f32x4 acc[4][3];
#pragma unroll
          for (int mt = 0; mt < 4; ++mt)
#pragma unroll
              for (int nt = 0; nt < 3; ++nt) acc[mt][nt] = (f32x4){0.f, 0.f, 0.f, 0.f};
#pragma unroll
          for (int ks = 0; ks < 2; ++ks) { bf16x8p bq[3];
#pragma unroll
              for (int nt = 0; nt < 3; ++nt) bq[nt] = *(const bf16x8p*)(bfr + 16 * nt * 256 + 64 + 32 * ks);
#pragma unroll
              for (int mt = 0; mt < 4; ++mt) { const bf16x8p aq = *(const LAS bf16x8p*)(afr + 16 * mt * AP + 64 + 32 * ks);
#pragma unroll
                  for (int nt = 0; nt < 3; ++nt) acc[mt][nt] = __builtin_amdgcn_mfma_f32_16x16x32_bf16(aq, bq[nt], acc[mt][nt], 0, 0, 0); } }
#pragma unroll
          for (int nt = 0; nt < 3; ++nt) { const int n = 48 * wave + 16 * nt + lc; const float a0n = a0[n];
#pragma unroll
              for (int mt = 0; mt < 4; ++mt) { bf16* dp = AA + (m0 + 16 * mt + 4 * q4) * 384 + n;
#pragma unroll
                  for (int r = 0; r < 4; ++r) dp[r * 384] = (bf16)f2bf(fsigmoid(a0n + acc[mt][nt][r])); } } }
        { f32x4 acc[4][3];
#pragma unroll
          for (int mt = 0; mt < 4; ++mt)
#pragma unroll
              for (int nt = 0; nt < 3; ++nt) acc[mt][nt] = (f32x4){0.f, 0.f, 0.f, 0.f};
#pragma unroll
          for (int ks = 0; ks < 4; ++ks) { bf16x8p bq[3];
#pragma unroll
              for (int nt = 0; nt < 3; ++nt) bq[nt] = *(const bf16x8p*)(bfr + 16 * nt * 256 + 128 + 32 * ks);
#pragma unroll
              for (int mt = 0; mt < 4; ++mt) { const bf16x8p aq = *(const LAS bf16x8p*)(afr + 16 * mt * AP + 128 + 32 * ks);
#pragma unroll
                  for (int nt = 0; nt < 3; ++nt) acc[mt][nt] = __builtin_amdgcn_mfma_f32_16x16x32_bf16(aq, bq[nt], acc[mt][nt], 0, 0, 0); } }
#pragma unroll
          for (int nt = 0; nt < 3; ++nt) { const int n = 48 * wave + 16 * nt + lc;
#pragma unroll
              for (int mt = 0; mt < 4; ++mt) { bf16* dp = GG + (m0 + 16 * mt + 4 * q4) * 384 + n;
#pragma unroll
                  for (int r = 0; r < 4; ++r) dp[r * 384] = (bf16)f2bf(acc[mt][nt][r]); } } }
        WG_BAR_L();
    }
}
typedef short bf16x8_t __attribute__((ext_vector_type(8)));
template <int KS>
__device__ __forceinline__ f32x4 mm_tile(const LAS bf16* A, const LAS bf16* B, f32x4 acc) {
#pragma unroll
    for (int ks = 0; ks < KS; ++ks) {
        const bf16x8_t a = *(const LAS bf16x8_t*)(A + ks * 32), b = *(const LAS bf16x8_t*)(B + ks * 32);
        acc = __builtin_amdgcn_mfma_f32_16x16x32_bf16(a, b, acc, 0, 0, 0);
    }
    return acc;
}
__device__ __forceinline__ unsigned short f2bf16(float f) { return (unsigned short)f2bf(f); }
constexpr int LP = 72;
constexpr int LPM = 104;

__device__ __forceinline__ void ret_unit(int b, int h, const bf16* proj, const float* gn, bf16* mixed, LAS unsigned char* lds, int wave, int lane0) {
    LAS bf16* Qs = (LAS bf16*)lds; LAS bf16* Ks = Qs + 64 * LP; LAS bf16* Kdt = Ks + 64 * LP; LAS bf16* Vt = Kdt + 64 * LP; LAS bf16* Ps = Vt + 64 * LP; LAS bf16* Stt = Ps + 64 * LP; LAS bf16* Gs = Stt + 64 * LP;
    const int lane = lane0, q4 = lane >> 4, lc = lane & 15;
    const float inv = powf(10000.0f, -(float)(2 * (lane & 31)) / 64.0f);
    float cs[8], sn[8];
#pragma unroll
    for (int i = 0; i < 8; ++i) sincosf((float)(8 * wave + i) * inv, &sn[i], &cs[i]);
    float c64, s64; sincosf(64.0f * inv, &s64, &c64);
    const float lg2 = log2f(1.0f - exp2f(-5.0f - (float)h));
    float kdec[8];
#pragma unroll
    for (int i = 0; i < 8; ++i) kdec[i] = exp2f((float)(63 - (8 * wave + i)) * lg2);
    const float cd = exp2f(64.0f * lg2);
    f32x4 st[4];
#pragma unroll
    for (int i = 0; i < 4; ++i) st[i] = (f32x4){0.f, 0.f, 0.f, 0.f};
    for (int i = wave * 64 + lane; i < 64 * LP / 2; i += 512) ((LAS unsigned*)Stt)[i] = 0u;
    const size_t m0 = (size_t)b * SEQ;
    const bf16* P0 = proj + m0 * NPI + h * 64;
    unsigned short rq[8], rk[8], rv[8], rg[8];
#pragma unroll
    for (int i = 0; i < 8; ++i) { const bf16* p = P0 + (size_t)(8 * wave + i) * NPI; rq[i] = p[lane]; rk[i] = p[256 + lane]; rv[i] = p[512 + lane]; rg[i] = p[768 + lane]; }
    float gain4[4];
#pragma unroll
    for (int ct = 0; ct < 4; ++ct) gain4[ct] = gn[h * 64 + 16 * ct + lc];
#pragma unroll 1
    for (int c = 0; c < SEQ / 64; ++c) {
        const int lane = lane_id_opq(), q4 = lane >> 4, lc = lane & 15, o72 = lc * LP + 8 * q4;
        { unsigned short kd[8];
#pragma unroll
          for (int i = 0; i < 8; ++i) { const int tt = 8 * wave + i;
              const float q = bf2f(rq[i]), k = bf2f(rk[i]); const float qp = __shfl_xor(q, 32), kp = __shfl_xor(k, 32);
              const float qr = lane < 32 ? q * cs[i] - qp * sn[i] : qp * sn[i] + q * cs[i];
              const float kr = (lane < 32 ? k * cs[i] - kp * sn[i] : kp * sn[i] + k * cs[i]) * 0.125f;
              Qs[tt * LP + lane] = f2bf16(qr); Ks[tt * LP + lane] = f2bf16(kr); Gs[tt * LP + lane] = rg[i]; kd[i] = f2bf16(kr * kdec[i]);
              const float cn = cs[i] * c64 - sn[i] * s64, snn = sn[i] * c64 + cs[i] * s64; cs[i] = cn; sn[i] = snn; }
          v4u w; w.x = kd[0] | ((unsigned)kd[1] << 16); w.y = kd[2] | ((unsigned)kd[3] << 16); w.z = kd[4] | ((unsigned)kd[5] << 16); w.w = kd[6] | ((unsigned)kd[7] << 16);
          *(LAS v4u*)(Kdt + lane * LP + 8 * wave) = w;
          w.x = rv[0] | ((unsigned)rv[1] << 16); w.y = rv[2] | ((unsigned)rv[3] << 16); w.z = rv[4] | ((unsigned)rv[5] << 16); w.w = rv[6] | ((unsigned)rv[7] << 16);
          *(LAS v4u*)(Vt + lane * LP + 8 * wave) = w; }
        WG_BAR_L();
        if (c + 1 < SEQ / 64) {
#pragma unroll
            for (int i = 0; i < 8; ++i) { const bf16* p = P0 + (size_t)(64 * (c + 1) + 8 * wave + i) * NPI; rq[i] = p[lane]; rk[i] = p[256 + lane]; rv[i] = p[512 + lane]; rg[i] = p[768 + lane]; } }
        { const int rt = wave >> 1;
#pragma unroll
          for (int u = 0; u < 2; ++u) { const int ct = 2 * (wave & 1) + u;
              f32x4 s = (f32x4){0.f, 0.f, 0.f, 0.f};
              if (ct <= rt) s = mm_tile<2>(Qs + 16 * rt * LP + o72, Ks + 16 * ct * LP + o72, s);
#pragma unroll
              for (int r = 0; r < 4; ++r) { const int l = 16 * rt + 4 * q4 + r, m = 16 * ct + lc; const float val = (l >= m) ? s[r] * exp2f((float)(l - m) * lg2) : 0.f; Ps[l * LP + m] = f2bf16(val); } } }
        f32x4 inter[4];
        if (wave < 4) {
#pragma unroll
            for (int ct = 0; ct < 4; ++ct) inter[ct] = mm_tile<2>(Qs + 16 * wave * LP + o72, Stt + 16 * ct * LP + o72, (f32x4){0.f, 0.f, 0.f, 0.f}); }
        WG_BAR_L();
        if (wave < 4) {
            f32x4 y[4];
#pragma unroll
            for (int ct = 0; ct < 4; ++ct) y[ct] = mm_tile<2>(Ps + 16 * wave * LP + o72, Vt + 16 * ct * LP + o72, (f32x4){0.f, 0.f, 0.f, 0.f});
#pragma unroll
            for (int r = 0; r < 4; ++r) { const int l = 16 * wave + 4 * q4 + r; const float qd = exp2f((float)(l + 1) * lg2);
                float s = 0.f;
#pragma unroll
                for (int ct = 0; ct < 4; ++ct) { y[ct][r] += qd * inter[ct][r]; s += y[ct][r]; }
                const float mean = sum16(s) * (1.0f / 64.0f); float qv = 0.f;
#pragma unroll
                for (int ct = 0; ct < 4; ++ct) { const float dd = y[ct][r] - mean; qv += dd * dd; }
                const float rstd = 1.0f / sqrtf(sum16(qv) * (1.0f / 64.0f) + GN_EPS);
                bf16* orow = mixed + (m0 + 64 * c + l) * DM + h * 64 + lc;
#pragma unroll
                for (int ct = 0; ct < 4; ++ct) { const float g = bf2f(Gs[l * LP + 16 * ct + lc]); orow[16 * ct] = f2bf16((y[ct][r] - mean) * rstd * gain4[ct] * (g * fsigmoid(g))); } }
        } else {
            const int dt = wave - 4;
#pragma unroll
            for (int ct = 0; ct < 4; ++ct) { st[ct] = mm_tile<2>(Kdt + 16 * dt * LP + o72, Vt + 16 * ct * LP + o72, st[ct] * cd);
                v2u w; w.x = pk2(st[ct][0], st[ct][1]); w.y = pk2(st[ct][2], st[ct][3]);
                *(LAS v2u*)(Stt + (16 * ct + lc) * LP + 16 * dt + 4 * q4) = w; }
        }
        WG_BAR_L();
    }
}

__device__ __forceinline__ void mlstm_unit(int b, int h, const bf16* proj, const float* conv_w, const float* conv_b, const float* i_b, const float* f_b, const float* gn, bf16* mixed,
                                           LAS unsigned char* lds, int wave, int lane0) {
    LAS bf16* Qs = (LAS bf16*)lds; LAS bf16* Ks = Qs + 64 * LPM; LAS bf16* Kdt = Ks + 64 * LPM; LAS bf16* Vt = Kdt + 96 * LP; LAS bf16* Ps = Vt + 112 * LP; LAS bf16* Stt = Ps + 64 * LP; LAS bf16* Os = Stt + 112 * LPM;
    LAS float* ev = (LAS float*)(Os + 64 * LPM); LAS float* pmv = ev + 64; LAS float* flv = pmv + 64;
    const int lane = lane0, lc = lane & 15;
    float wq0[4], wq1[4], wk0[4], wk1[4], bq0, bq1, bk0, bk1;
    { const int cq0 = h * 96 + lane, cq1 = h * 96 + 64 + (lane & 31), ck0 = 384 + cq0, ck1 = 384 + cq1;
#pragma unroll
    for (int j = 0; j < 4; ++j) { wq0[j] = conv_w[j * 768 + cq0]; wq1[j] = conv_w[j * 768 + cq1]; wk0[j] = conv_w[j * 768 + ck0]; wk1[j] = conv_w[j * 768 + ck1]; }
    bq0 = conv_b[cq0]; bq1 = conv_b[cq1]; bk0 = conv_b[ck0]; bk1 = conv_b[ck1]; }
    const float ib = i_b[h], fb = f_b[h];
    const float ksc = 0.10206207261596577f;
    f32x4 st[11];
#pragma unroll
    for (int i = 0; i < 11; ++i) st[i] = (f32x4){0.f, 0.f, 0.f, 0.f};
    for (int i = wave * 64 + lane; i < 112 * LPM / 2; i += 512) ((LAS unsigned*)Stt)[i] = 0u;
    for (int i = wave * 64 + lane; i < 16 * LP / 2; i += 512) ((LAS unsigned*)(Vt + 96 * LP))[i] = (i < LP / 2) ? 0x3f803f80u : 0u;
    float mprev = 0.f;
    const size_t m0 = (size_t)b * SEQ;
    const bf16* PB = proj + m0 * NPI + ML_B;
    float gain6[6];
#pragma unroll
    for (int ct = 0; ct < 6; ++ct) gain6[ct] = gn[640 + h * 96 + 16 * ct + lc];
#pragma unroll 1
    for (int c = 0; c < SEQ / 64; ++c) {
        const int lane = lane_id_opq(), q4 = lane >> 4, lc = lane & 15, o72 = lc * LP + 8 * q4, o104 = lc * LPM + 8 * q4;
        const int d0 = lane, d1 = 64 + (lane & 31); const bool has1 = lane < 32;
        const int cq0 = h * 96 + d0, cq1 = h * 96 + d1, ck0 = 384 + cq0, ck1 = 384 + cq1;
        const int tb = 64 * c + 8 * wave;
        { float xq0[11], xk0[11], xq1[11], xk1[11];
#pragma unroll
          for (int i = 0; i < 11; ++i) { const int t = tb - 3 + i; const bool ok = t >= 0; const bf16* p = PB + (size_t)(ok ? t : 0) * NPI;
              xq0[i] = ok ? bf2f(p[cq0]) : 0.f; xk0[i] = ok ? bf2f(p[ck0]) : 0.f; xq1[i] = (ok && has1) ? bf2f(p[cq1]) : 0.f; xk1[i] = (ok && has1) ? bf2f(p[ck1]) : 0.f; }
          unsigned short kd0[8], kd1[8];
#pragma unroll
          for (int i = 0; i < 8; ++i) { const int tt = 8 * wave + i;
              float q0 = bq0 + xq0[i] * wq0[0] + xq0[i + 1] * wq0[1] + xq0[i + 2] * wq0[2] + xq0[i + 3] * wq0[3];
              float k0 = bk0 + xk0[i] * wk0[0] + xk0[i + 1] * wk0[1] + xk0[i + 2] * wk0[2] + xk0[i + 3] * wk0[3];
              float q1 = bq1 + xq1[i] * wq1[0] + xq1[i + 1] * wq1[1] + xq1[i + 2] * wq1[2] + xq1[i + 3] * wq1[3];
              float k1 = bk1 + xk1[i] * wk1[0] + xk1[i + 1] * wk1[1] + xk1[i + 2] * wk1[2] + xk1[i + 3] * wk1[3];
              q0 = q0 * fsigmoid(q0); k0 = k0 * fsigmoid(k0) * ksc; q1 = q1 * fsigmoid(q1); k1 = k1 * fsigmoid(k1) * ksc;
              Qs[tt * LPM + d0] = f2bf16(q0); Ks[tt * LPM + d0] = f2bf16(k0); kd0[i] = f2bf16(k0); kd1[i] = f2bf16(k1);
              if (has1) { Qs[tt * LPM + d1] = f2bf16(q1); Ks[tt * LPM + d1] = f2bf16(k1); } }
          v4u w; w.x = kd0[0] | ((unsigned)kd0[1] << 16); w.y = kd0[2] | ((unsigned)kd0[3] << 16); w.z = kd0[4] | ((unsigned)kd0[5] << 16); w.w = kd0[6] | ((unsigned)kd0[7] << 16);
          *(LAS v4u*)(Kdt + d0 * LP + 8 * wave) = w;
          if (has1) { w.x = kd1[0] | ((unsigned)kd1[1] << 16); w.y = kd1[2] | ((unsigned)kd1[3] << 16); w.z = kd1[4] | ((unsigned)kd1[5] << 16); w.w = kd1[6] | ((unsigned)kd1[7] << 16);
              *(LAS v4u*)(Kdt + d1 * LP + 8 * wave) = w; }
          unsigned short v0[8], v1[8];
#pragma unroll
          for (int i = 0; i < 8; ++i) { const bf16* p = PB + (size_t)(tb + i) * NPI; v0[i] = p[768 + h * 96 + d0]; v1[i] = has1 ? p[768 + h * 96 + d1] : (unsigned short)0;
              Os[(8 * wave + i) * LPM + d0] = p[1152 + h * 96 + d0]; if (has1) Os[(8 * wave + i) * LPM + d1] = p[1152 + h * 96 + d1]; }
          w.x = v0[0] | ((unsigned)v0[1] << 16); w.y = v0[2] | ((unsigned)v0[3] << 16); w.z = v0[4] | ((unsigned)v0[5] << 16); w.w = v0[6] | ((unsigned)v0[7] << 16);
          *(LAS v4u*)(Vt + d0 * LP + 8 * wave) = w;
          if (has1) { w.x = v1[0] | ((unsigned)v1[1] << 16); w.y = v1[2] | ((unsigned)v1[3] << 16); w.z = v1[4] | ((unsigned)v1[5] << 16); w.w = v1[6] | ((unsigned)v1[7] << 16);
              *(LAS v4u*)(Vt + d1 * LP + 8 * wave) = w; } }
        float pm63, carry; const float mold = mprev;
        { const bf16* p = PB + (size_t)(64 * c + lane) * NPI; const float ic = bf2f(p[1536 + h]) + ib, lf = logsigmoid_f(bf2f(p[1540 + h]) + fb);
          float bc = lf;
#pragma unroll
          for (int o = 1; o < 64; o <<= 1) { const float t = __shfl_up(bc, o); if (lane >= o) bc += t; }
          const float e = ic - bc; float pm = e;
#pragma unroll
          for (int o = 1; o < 64; o <<= 1) { const float t = __shfl_up(pm, o); if (lane >= o) pm = fmaxf(pm, t); }
          pm = fmaxf(pm, mprev);
          pm63 = __shfl(pm, 63); carry = expf(mprev - pm63);
          if (wave == 0) { ev[lane] = e; pmv[lane] = pm; flv[lane] = expf(-(bc + pm)); }
          mprev = __shfl(bc, 63) + pm63; }
        WG_BAR();
        { const int rt = wave >> 1;
#pragma unroll
          for (int u = 0; u < 2; ++u) { const int ct = 2 * (wave & 1) + u;
              f32x4 s = (f32x4){0.f, 0.f, 0.f, 0.f};
              if (ct <= rt) s = mm_tile<3>(Qs + 16 * rt * LPM + o104, Ks + 16 * ct * LPM + o104, s);
              const float em = ev[16 * ct + lc];
#pragma unroll
              for (int r = 0; r < 4; ++r) { const int l = 16 * rt + 4 * q4 + r, m = 16 * ct + lc; const float val = (l >= m) ? s[r] * fexp(em - pmv[l]) : 0.f; Ps[l * LP + m] = f2bf16(val); } } }
        {
#pragma unroll
          for (int i = 0; i < 12; ++i) { const int idx = (wave * 64 + lane) + 512 * i, dd = idx >> 6, m = idx & 63; Kdt[dd * LP + m] = f2bf16(bf2f(Kdt[dd * LP + m]) * fexp(ev[m] - pm63)); } }
        f32x4 inter[7];
        if (wave < 4) {
#pragma unroll
            for (int ct = 0; ct < 7; ++ct) inter[ct] = mm_tile<3>(Qs + 16 * wave * LPM + o104, Stt + 16 * ct * LPM + o104, (f32x4){0.f, 0.f, 0.f, 0.f}); }
        WG_BAR_L();
        if (wave < 4) {
            f32x4 y[7];
#pragma unroll
            for (int ct = 0; ct < 7; ++ct) y[ct] = mm_tile<2>(Ps + 16 * wave * LP + o72, Vt + 16 * ct * LP + o72, (f32x4){0.f, 0.f, 0.f, 0.f});
#pragma unroll
            for (int r = 0; r < 4; ++r) { const int l = 16 * wave + 4 * q4 + r; const float iw = fexp(mold - pmv[l]);
#pragma unroll
                for (int ct = 0; ct < 7; ++ct) y[ct][r] += iw * inter[ct][r];
                const float den = __shfl(y[6][r], lane & 48);
                const float dn = 1.0f / fmaxf(fabsf(den), flv[l]);
                float s = 0.f;
#pragma unroll
                for (int ct = 0; ct < 6; ++ct) { y[ct][r] *= dn; s += y[ct][r]; }
                const float mean = sum16(s) * (1.0f / 96.0f); float qv = 0.f;
#pragma unroll
                for (int ct = 0; ct < 6; ++ct) { const float dd = y[ct][r] - mean; qv += dd * dd; }
                const float rstd = 1.0f / sqrtf(sum16(qv) * (1.0f / 96.0f) + GN_EPS);
                bf16* orow = mixed + (m0 + 64 * c + l) * DM + 640 + h * 96 + lc;
#pragma unroll
                for (int ct = 0; ct < 6; ++ct) { const float o = bf2f(Os[l * LPM + 16 * ct + lc]); orow[16 * ct] = f2bf16((y[ct][r] - mean) * rstd * gain6[ct] * fsigmoid(o)); } }
        } else {
#pragma unroll
            for (int i = 0; i < 11; ++i) { const int t = (wave - 4) + 4 * i;
                if (t < 42) { const int dt = t / 7, et = t % 7;
                    st[i] = mm_tile<2>(Kdt + 16 * dt * LP + o72, Vt + 16 * et * LP + o72, st[i] * carry);
                    v2u w; w.x = pk2(st[i][0], st[i][1]); w.y = pk2(st[i][2], st[i][3]);
                    *(LAS v2u*)(Stt + (16 * et + lc) * LPM + 16 * dt + 4 * q4) = w; } }
        }
        WG_BAR_L();
    }
}
#ifndef RW_DBG
#define RW_DBG 0xFF
#endif
__device__ __forceinline__ void rwkv_unit(int b, int h, const bf16* proj, const float* CUM, const bf16* AA, const bf16* GG, const float* mu, const float* k_k, const float* k_a, const float* r_k,
                                          const float* gn, bf16* mixed, LAS unsigned char* lds, int wave, int lane0) {
    constexpr int SLOT = 64 * LP;
    LAS bf16* KH = (LAS bf16*)lds; LAS bf16* BH = KH + SLOT; LAS bf16* KT = BH + SLOT; LAS bf16* RT = KT + SLOT; LAS bf16* KHgt = RT + SLOT; LAS bf16* BHgtn = KHgt + SLOT;
    LAS bf16* Vt = BHgtn + SLOT; LAS bf16* AkT = Vt + SLOT; LAS bf16* BbTn = AkT + SLOT; LAS bf16* BkT = BbTn + SLOT; LAS bf16* S0b = BkT + SLOT; LAS bf16* Loffb = S0b + SLOT;
    LAS float* RHS = (LAS float*)KH; LAS bf16* Ut = KT;
    LAS float* LTd = (LAS float*)(Loffb + SLOT);
    LAS float* XS = LTd + 64 * 20;
    LAS float* GCv = XS + 16 * 64; LAS float* bonv = GCv + 64;
    float mu_r, mu_k, mu_v, kkc, kac, rkc;
    { const int c0 = h * 64 + lane0; mu_r = mu[c0]; mu_k = mu[384 + c0]; mu_v = mu[768 + c0]; kkc = k_k[c0]; kac = k_a[c0]; rkc = r_k[c0]; }
    for (int i = wave * 64 + lane0; i < 5 * SLOT / 2; i += 512) ((LAS unsigned*)AkT)[i] = 0u;
    f32x4 sacc[4];
#pragma unroll
    for (int i = 0; i < 4; ++i) sacc[i] = (f32x4){0.f, 0.f, 0.f, 0.f};
    const size_t m0 = (size_t)b * SEQ;
    const bf16* PU = proj + m0 * NPI + RW_B + h * 64;
    const float* CU = CUM + m0 * 384 + h * 64; const bf16* AU = AA + m0 * 384 + h * 64; const bf16* GU = GG + m0 * 384 + h * 64;
    unsigned short rr[9], rk[9], rv[9], ra[8]; float rc[9], rc63;
#define RWKV_LOAD(cc) do { const int tb_ = 64 * (cc) + 8 * wave; \
        _Pragma("unroll") for (int i = 0; i < 9; ++i) { const int t_ = tb_ - 1 + i; const bool ok_ = t_ >= 0; const bf16* p_ = PU + (size_t)(ok_ ? t_ : 0) * NPI; \
            rr[i] = ok_ ? p_[lane] : (unsigned short)0; rk[i] = ok_ ? p_[384 + lane] : (unsigned short)0; rv[i] = ok_ ? p_[768 + lane] : (unsigned short)0; \
            rc[i] = (i > 0 || wave > 0) ? CU[(size_t)(ok_ ? t_ : 0) * 384 + lane] : 0.f; if (i > 0) ra[i - 1] = AU[(size_t)t_ * 384 + lane]; } \
        rc63 = CU[(size_t)(64 * (cc) + 63) * 384 + lane]; } while (0)
    { const int lane = lane0; RWKV_LOAD(0); }
#pragma unroll 1
    for (int c = 0; c < SEQ / 64; ++c) {
        const int lane = lane_id_opq(), q4 = lane >> 4, lc = lane & 15, o72 = lc * LP + 8 * q4;
        if (RW_DBG & 1) { unsigned short khg[8], bhg[8]; const float gc63 = fexp(rc63);
#pragma unroll
          for (int i = 0; i < 8; ++i) { const int tt = 8 * wave + i;
              const float cr = bf2f(rr[i + 1]), ck = bf2f(rk[i + 1]);
              const float r = cr + (bf2f(rr[i]) - cr) * mu_r, k = ck + (bf2f(rk[i]) - ck) * mu_k, a = bf2f(ra[i]);
              float kk = k * kkc; const float nrm = sqrtf(wave_sum(kk * kk)); kk = kk / fmaxf(nrm, 1e-12f);
              const float kmod = k * (1.0f + (a - 1.0f) * kac), beta = kk * a;
              const float bon = wave_sum(r * kmod * rkc); if (lane == 0) bonv[tt] = bon;
              const float cm = rc[i + 1], cp = rc[i];
              const float em = fexp(-cm), eg = gc63 * em;
              KH[tt * LP + lane] = f2bf16(kmod * em); BH[tt * LP + lane] = f2bf16(beta * em); KT[tt * LP + lane] = f2bf16(kk * fexp(cp)); RT[tt * LP + lane] = f2bf16(r * fexp(cm));
              khg[i] = f2bf16(kmod * eg); bhg[i] = f2bf16(-beta * eg); }
          v4u w; w.x = khg[0] | ((unsigned)khg[1] << 16); w.y = khg[2] | ((unsigned)khg[3] << 16); w.z = khg[4] | ((unsigned)khg[5] << 16); w.w = khg[6] | ((unsigned)khg[7] << 16);
          *(LAS v4u*)(KHgt + lane * LP + 8 * wave) = w;
          w.x = bhg[0] | ((unsigned)bhg[1] << 16); w.y = bhg[2] | ((unsigned)bhg[3] << 16); w.z = bhg[4] | ((unsigned)bhg[5] << 16); w.w = bhg[6] | ((unsigned)bhg[7] << 16);
          *(LAS v4u*)(BHgtn + lane * LP + 8 * wave) = w;
          unsigned short vs[8];
#pragma unroll
          for (int i = 0; i < 8; ++i) { const float cv = bf2f(rv[i + 1]); vs[i] = f2bf16(cv + (bf2f(rv[i]) - cv) * mu_v); }
          w.x = vs[0] | ((unsigned)vs[1] << 16); w.y = vs[2] | ((unsigned)vs[3] << 16); w.z = vs[4] | ((unsigned)vs[5] << 16); w.w = vs[6] | ((unsigned)vs[7] << 16);
          *(LAS v4u*)(Vt + lane * LP + 8 * wave) = w;
          if (wave == 0) GCv[lane] = gc63; }
        WG_BAR_L();
#pragma unroll
        for (int it = 0; it < ((RW_DBG & 2) ? 5 : 0); ++it) { const int item = wave + 8 * it, prod = item / 10, pair = item % 10;
            const int rt = pair >= 6 ? 3 : (pair >= 3 ? 2 : (pair >= 1 ? 1 : 0)), ct = pair - (rt * (rt + 1)) / 2;
            const LAS bf16* Ab = (prod < 2 ? KT : RT) + 16 * rt * LP + o72; const LAS bf16* Bb = ((prod == 0 || prod == 2) ? BH : KH) + 16 * ct * LP + o72;
            const f32x4 g = mm_tile<2>(Ab, Bb, (f32x4){0.f, 0.f, 0.f, 0.f});
            const int s = 16 * ct + lc;
#pragma unroll
            for (int r = 0; r < 4; ++r) { const int t = 16 * rt + 4 * q4 + r;
                if (prod == 0) { if (ct < rt) Loffb[t * LP + s] = f2bf16(g[r]); else LTd[s * 20 + (t - 16 * rt)] = (s < t) ? g[r] : 0.f; }
                else if (prod == 1) AkT[t * LP + s] = f2bf16((s < t) ? g[r] : 0.f);
                else if (prod == 2) BbTn[t * LP + s] = f2bf16((s <= t) ? -g[r] : 0.f);
                else BkT[t * LP + s] = f2bf16((s <= t) ? g[r] : 0.f); } }
        WG_BAR_L();
#pragma unroll
        for (int u = 0; u < ((RW_DBG & 4) ? 2 : 0); ++u) { const int rt = wave >> 1, ct = 2 * (wave & 1) + u;
            f32x4 g = mm_tile<2>(KT + 16 * rt * LP + o72, S0b + 16 * ct * LP + o72, (f32x4){0.f, 0.f, 0.f, 0.f});
            g = mm_tile<2>(AkT + 16 * rt * LP + o72, Vt + 16 * ct * LP + o72, g);
#pragma unroll
            for (int r = 0; r < 4; ++r) RHS[(16 * rt + 4 * q4 + r) * 64 + 16 * ct + lc] = g[r]; }
        WG_BAR_L();
        f32x4 y[4];
        if ((RW_DBG & 8) && wave == 0) {
#pragma unroll
            for (int a = 0; a < 4; ++a) {
                if (a > 0) {
#pragma unroll
                    for (int it = 0; it < 4; ++it) { f32x4 cr = (f32x4){0.f, 0.f, 0.f, 0.f};
                        if (a == 3) cr = mm_tile<2>(Loffb + 16 * a * LP + o72, Ut + 16 * it * LP + o72, cr); else cr = mm_tile<1>(Loffb + 16 * a * LP + o72, Ut + 16 * it * LP + o72, cr);
#pragma unroll
                        for (int r = 0; r < 4; ++r) XS[(4 * q4 + r) * 64 + 16 * it + lc] = cr[r]; }
                    asm volatile("s_waitcnt lgkmcnt(0)" ::: "memory");
                }
                float acc[16];
#pragma unroll
                for (int t = 0; t < 16; ++t) acc[t] = RHS[(16 * a + t) * 64 + lane] - (a > 0 ? XS[t * 64 + lane] : 0.f);
                const LAS float* Ld = LTd + 16 * a * 20; asm volatile("" : "+v"(Ld));
#pragma unroll
                for (int s2 = 0; s2 < 15; ++s2) { const float us = acc[s2];
#pragma unroll
                    for (int t4 = (s2 + 1) / 4; t4 < 4; ++t4) { const f32x4 l4 = *(const LAS f32x4*)(Ld + s2 * 20 + 4 * t4);
                        acc[4 * t4] -= l4.x * us; acc[4 * t4 + 1] -= l4.y * us; acc[4 * t4 + 2] -= l4.z * us; acc[4 * t4 + 3] -= l4.w * us; }
                    if (s2 == 3 || s2 == 7) asm volatile("" : "+v"(Ld) : "v"(acc[s2 + 1])); }
                v4u w; w.x = pk2(acc[0], acc[1]); w.y = pk2(acc[2], acc[3]); w.z = pk2(acc[4], acc[5]); w.w = pk2(acc[6], acc[7]);
                *(LAS v4u*)(Ut + lane * LP + 16 * a) = w;
                w.x = pk2(acc[8], acc[9]); w.y = pk2(acc[10], acc[11]); w.z = pk2(acc[12], acc[13]); w.w = pk2(acc[14], acc[15]);
                *(LAS v4u*)(Ut + lane * LP + 16 * a + 8) = w;
                asm volatile("s_waitcnt lgkmcnt(0)" ::: "memory");
            }
        }
        if (c + 1 < SEQ / 64) RWKV_LOAD(c + 1);
        if (wave < 4) {
#pragma unroll
            for (int ct = 0; ct < 4; ++ct) { y[ct] = mm_tile<2>(RT + 16 * wave * LP + o72, S0b + 16 * ct * LP + o72, (f32x4){0.f, 0.f, 0.f, 0.f}); y[ct] = mm_tile<2>(BkT + 16 * wave * LP + o72, Vt + 16 * ct * LP + o72, y[ct]); }
        } else {
#pragma unroll
            for (int jt = 0; jt < 4; ++jt) { const float gc = GCv[16 * jt + lc]; sacc[jt] = mm_tile<2>(Vt + 16 * (wave - 4) * LP + o72, KHgt + 16 * jt * LP + o72, sacc[jt] * gc); }
        }
        WG_BAR_L();
        if (wave < 4) {
#pragma unroll
            for (int ct = 0; ct < 4; ++ct) y[ct] = mm_tile<2>(BbTn + 16 * wave * LP + o72, Ut + 16 * ct * LP + o72, y[ct]);
#pragma unroll
            for (int r = 0; r < 4; ++r) { const int t = 16 * wave + 4 * q4 + r; const size_t row = m0 + 64 * c + t;
                float s = 0.f;
#pragma unroll
                for (int ct = 0; ct < 4; ++ct) s += y[ct][r];
                const float mean = sum16(s) * (1.0f / 64.0f); float qv = 0.f;
#pragma unroll
                for (int ct = 0; ct < 4; ++ct) { const float dd = y[ct][r] - mean; qv += dd * dd; }
                const float rstd = 1.0f / sqrtf(sum16(qv) * (1.0f / 64.0f) + GN_EPS);
                const float bon = bonv[t]; const bool hasp = (64 * c + t) > 0;
                const bf16* vrow = proj + row * NPI + RW_B + 768 + h * 64 + lc; const bf16* grow = GG + row * 384 + h * 64 + lc; bf16* orow = mixed + row * DM + 256 + h * 64 + lc;
#pragma unroll
                for (int ct = 0; ct < 4; ++ct) { const int i = h * 64 + 16 * ct + lc;
                    const float cv = bf2f(vrow[16 * ct]), pv = hasp ? bf2f(*(vrow + 16 * ct - NPI)) : 0.f; const float v = cv + (pv - cv) * mu[768 + i];
                    orow[16 * ct] = f2bf16(((y[ct][r] - mean) * rstd * gn[256 + i] + bon * v) * bf2f(grow[16 * ct])); } }
        } else {
#pragma unroll
            for (int jt = 0; jt < 4; ++jt) { sacc[jt] = mm_tile<2>(Ut + 16 * (wave - 4) * LP + o72, BHgtn + 16 * jt * LP + o72, sacc[jt]);
#pragma unroll
                for (int r = 0; r < 4; ++r) S0b[(16 * (wave - 4) + 4 * q4 + r) * LP + 16 * jt + lc] = f2bf16(sacc[jt][r]); }
        }
        WG_BAR_L();
    }
#undef RWKV_LOAD
}

struct Args { const float* in[25]; float* out; unsigned char* ws; int ph_lo, ph_hi, li, pad; };
typedef const __attribute__((address_space(4))) Args* KArgs;
__device__ __forceinline__ KArgs kargs() { KArgs p = (KArgs)__builtin_amdgcn_kernarg_segment_ptr(); asm volatile("" : "+s"(p)); return p; }
#ifndef DBG_MASK
#define DBG_MASK 0xFFFF
#endif
#define EN(bit) ((DBG_MASK >> (bit)) & 1)
#ifndef PROBE_DUP
#define PROBE_DUP 0
#endif
#define REP(bit) for (int rep_ = 0; rep_ < (((PROBE_DUP >> (bit)) & 1) ? 2 : 1); ++rep_)
__global__ void __launch_bounds__(NWAVES * 64, 2) mk_fwd(Args args_unused) {
    extern __shared__ __attribute__((aligned(16))) unsigned char lds_raw[];
    LAS unsigned char* lds = (LAS unsigned char*)lds_raw;
    volatile LAS unsigned* MISC = (volatile LAS unsigned*)(lds + MISC_OFF);
    const int wave = __builtin_amdgcn_readfirstlane((int)threadIdx.x >> 6);
    const int G = gridDim.x, gw = blockIdx.x * NWAVES + wave, ngw = G * NWAVES;
    for (int u = threadIdx.x; u < (LDS_BYTES - LDSCTL_OFF) / 4; u += NWAVES * 64) ((LAS unsigned*)(lds + LDSCTL_OFF))[u] = 0u;
    __syncthreads();
    XcdBarrier bar; int lo, hi;
    { KArgs A = kargs(); bar = xcd_barrier_post((unsigned*)(A->ws + WS_CTL) + CW_BAR + (MK_PER_PHASE ? 0 : A->li) * XCD_BAR_WORDS, MISC + 8); lo = A->ph_lo; hi = A->ph_hi; }
#define IN(k) (lo <= (k) && (k) < hi)
#define SEAM(k) do { if (IN(k) && IN((k) + 1)) xcd_barrier(bar); } while (0)
#define LANE_TID() int wave_o = wave, gw_o = gw; asm volatile("" : "+s"(wave_o), "+s"(gw_o)); (void)gw_o; const int lane_o = lane_id_opq(), tid_o = wave_o * 64 + lane_o; (void)tid_o

    if (EN(0) && IN(0)) {
        KArgs A = kargs(); unsigned char* ws = A->ws; LANE_TID();
        p0_mod(A->in[1], A->in[2], A->in[3], (float*)(ws + WS_MOD), lds, tid_o, lane_o, wave_o);
        p0_weights(A->in[6], A->in[21], A->in[22], A->in[23], A->in[10], A->in[12], A->in[13], ws, lds, gw_o, ngw, wave_o, lane_o);
    }
    SEAM(0);
#pragma unroll 1
    for (int l = 0; l < NL; ++l) {
        const int pb = 1 + 8 * l;
        REP(2) if (EN(1) && IN(pb + 0)) { KArgs A = kargs(); unsigned char* ws = A->ws; LANE_TID();
            norm_mod_phase(l == 0 ? A->in[0] : A->out, A->in[4] + l * DM, (const float*)(ws + WS_MOD) + (size_t)l * NB * MODP, 0, DM, (bf16*)(ws + WS_H), gw_o, ngw, lane_o); }
        SEAM(pb + 0);
        REP(3) if (EN(2) && IN(pb + 1)) { KArgs A = kargs(); unsigned char* ws = A->ws; LANE_TID();
            pg8::Gemm g{(const bf16*)(ws + WS_H), (const bf16*)(ws + WS_WIN) + (size_t)l * NPI * DM, MT, NPI, DM}; pg8::StaticOrder S; S.init(MT, NPI, G, (int)blockIdx.x);
            pg8::EpiBf16Plain E{(bf16*)(ws + WS_PROJ), NPI};
            pg8::gemm_phase<pg8::EpiBf16Plain, pg8::StaticOrder, true, true>(lds, g, S, E, wave_o);
        }
        SEAM(pb + 1);
        REP(1) if (EN(3) && IN(pb + 2)) { KArgs A = kargs(); unsigned char* ws = A->ws; LANE_TID();
            rwkv_prep_mfma((const bf16*)(ws + WS_PROJ), A->in[8] + l * RWKV_IN, A->in[9] + l * 384, A->in[11] + l * 384, (const bf16*)(ws + WS_WL) + (size_t)l * 384 * 256,
                           (float*)(ws + WS_DEC), (bf16*)(ws + WS_AA), (bf16*)(ws + WS_GG), lds, wave_o); }
        SEAM(pb + 2);
        REP(0) if (EN(4) && IN(pb + 3)) { KArgs A = kargs(); unsigned char* ws = A->ws; LANE_TID();
            const float* gn = A->in[7] + l * DM; const bf16* PROJ = (const bf16*)(ws + WS_PROJ); bf16* Hb = (bf16*)(ws + WS_H);
            int u = (int)blockIdx.x; asm volatile("" : "+s"(u));
            if (u < 128) {
                mlstm_unit(u >> 2, u & 3, PROJ, A->in[17] + (size_t)l * 4 * 768, A->in[18] + l * 768, A->in[19] + l * 4, A->in[20] + l * 4, gn, Hb, lds, wave_o, lane_o);
                ret_unit(u >> 2, u & 3, PROJ, gn, Hb, lds, wave_o, lane_o);
            } else {
                const int v0 = u - 128, nrep = v0 < 64 ? 2 : 1;
#pragma unroll 1
                for (int rep = 0; rep < nrep; ++rep) { const int q = v0 + 128 * rep;
                    rwkv_unit(q / 6, q % 6, PROJ, (const float*)(ws + WS_DEC), (const bf16*)(ws + WS_AA), (const bf16*)(ws + WS_GG), A->in[8] + l * RWKV_IN, A->in[14] + l * 384, A->in[15] + l * 384, A->in[16] + l * 384, gn, Hb, lds, wave_o, lane_o); }
            }
        }
        SEAM(pb + 3);
        if (EN(6) && IN(pb + 4)) { KArgs A = kargs(); unsigned char* ws = A->ws; LANE_TID();
            pg8::Gemm g{(const bf16*)(ws + WS_H), (const bf16*)(ws + WS_WOUT) + (size_t)l * DM * DM, MT, DM, DM}; pg8::StaticOrder S; S.init(MT, DM, G, (int)blockIdx.x);
            pg8::EpiResGate E{l == 0 ? A->in[0] : A->out, A->out, DM, (const float*)(ws + WS_MOD) + (size_t)l * NB * MODP + 2 * DM, MODP};
            pg8::gemm_phase<pg8::EpiResGate, pg8::StaticOrder, true, true>(lds, g, S, E, wave_o);
        }
        SEAM(pb + 4);
        REP(2) if (EN(1) && IN(pb + 5)) { KArgs A = kargs(); unsigned char* ws = A->ws; LANE_TID();
            norm_mod_phase(A->out, A->in[5] + l * DM, (const float*)(ws + WS_MOD) + (size_t)l * NB * MODP, 3 * DM, 4 * DM, (bf16*)(ws + WS_H), gw_o, ngw, lane_o); }
        SEAM(pb + 5);
        REP(4) if (EN(7) && IN(pb + 6)) { KArgs A = kargs(); unsigned char* ws = A->ws; LANE_TID();
            pg8::Gemm g{(const bf16*)(ws + WS_H), (const bf16*)(ws + WS_WF1) + (size_t)l * NF1 * DM, MT, NF1, DM}; pg8::StaticOrder S; S.init(MT, NF1, G, (int)blockIdx.x);
            pg8::EpiSwiGLU E{(bf16*)(ws + WS_PROJ), DFF};
            pg8::gemm_phase<pg8::EpiSwiGLU, pg8::StaticOrder, true, true>(lds, g, S, E, wave_o);
        }
        SEAM(pb + 6);
        if (EN(8) && IN(pb + 7)) { KArgs A = kargs(); unsigned char* ws = A->ws; LANE_TID();
            pg8::Gemm g{(const bf16*)(ws + WS_PROJ), (const bf16*)(ws + WS_WF2) + (size_t)l * DM * DFF, MT, DM, DFF}; pg8::StaticOrder S; S.init(MT, DM, G, (int)blockIdx.x);
            pg8::EpiResGate E{A->out, A->out, DM, (const float*)(ws + WS_MOD) + (size_t)l * NB * MODP + 5 * DM, MODP};
            pg8::gemm_phase<pg8::EpiResGate, pg8::StaticOrder, true, true>(lds, g, S, E, wave_o);
        }
        SEAM(pb + 7);
    }
    if (EN(9) && IN(N_PHASES - 1)) { KArgs A = kargs(); int gw_o = gw; asm volatile("" : "+s"(gw_o)); final_norm_phase(A->out, A->in[24], gw_o, ngw, lane_id_opq()); }
#undef IN
#undef SEAM
}

extern "C" void kernel_launch(void* const* d_in, const int* in_sizes, int n_in, void* d_out, int out_size, void* d_ws, size_t ws_size, hipStream_t stream) {
    static int grid = 0;
    if (grid == 0) {
        if (n_in != 25 || in_sizes[0] != MT * DM || out_size != MT * DM || ws_size < WS_END) { fprintf(stderr, "kernel_launch: shape/workspace mismatch (n_in %d, in0 %d, out %d, ws %zu)\n", n_in, n_in > 0 ? in_sizes[0] : -1, out_size, ws_size); grid = -1; return; }
        int dev = 0, cus = 0, per_cu = 0;
        if (hipGetDevice(&dev) != hipSuccess || hipDeviceGetAttribute(&cus, hipDeviceAttributeMultiprocessorCount, dev) != hipSuccess) { grid = -1; return; }
        if (hipFuncSetAttribute((const void*)mk_fwd, hipFuncAttributeMaxDynamicSharedMemorySize, LDS_BYTES) != hipSuccess) { fprintf(stderr, "kernel_launch: hipFuncSetAttribute failed\n"); grid = -1; return; }
        if (hipOccupancyMaxActiveBlocksPerMultiprocessor(&per_cu, (const void*)mk_fwd, NWAVES * 64, LDS_BYTES) != hipSuccess || per_cu < 1) { fprintf(stderr, "kernel_launch: occupancy query says %d\n", per_cu); }
        (void)hipGetLastError();
        grid = cus;
    }
    if (grid < 0) return;
    if (hipMemsetAsync((char*)d_ws + WS_CTL, 0, CTL_ZERO_BYTES, stream) != hipSuccess) return;
    Args a{};
    for (int i = 0; i < 25; ++i) a.in[i] = (const float*)d_in[i];
    a.out = (float*)d_out; a.ws = (unsigned char*)d_ws;
#if MK_PER_PHASE
    for (int p = 0; p < N_PHASES; ++p) { a.ph_lo = p; a.ph_hi = p + 1; a.li = 0; hipLaunchKernelGGL(mk_fwd, dim3(grid), dim3(NWAVES * 64), LDS_BYTES, stream, a); }
#else
    a.ph_lo = 0; a.ph_hi = N_PHASES; a.li = 0;
    hipLaunchKernelGGL(mk_fwd, dim3(grid), dim3(NWAVES * 64), LDS_BYTES, stream, a);
#endif
}
```

```cpp
#include <hip/hip_runtime.h>
#include <cstdio>
#include <cstdint>
__device__ __forceinline__ int lane_id_opq() { int l = (int)__builtin_amdgcn_mbcnt_hi(~0u, __builtin_amdgcn_mbcnt_lo(~0u, 0u)); asm volatile("" : "+v"(l)); return l; }

namespace pg8 {
#define PG8_LAS __attribute__((address_space(3)))
typedef unsigned short bf16_t;
typedef short bf16x8 __attribute__((ext_vector_type(8)));
typedef float f32x4 __attribute__((ext_vector_type(4)));
typedef unsigned u32x4 __attribute__((ext_vector_type(4)));
constexpr int BM = 256, BK = 64, HALF = 128, HTB = HALF * BK * 2  , STAGE_BYTES = 8 * HTB, NXCD = 8, WGM = 8;

__host__ __device__ __forceinline__ int lds_byte(int r, int c) { const int st = (r >> 4) * 2 + (c >> 5), rr = r & 15, cc = c & 31, ob = rr * 64 + cc * 2; return st * 1024 + (ob ^ (((ob >> 9) & 1) << 5)); }
__host__ __device__ __forceinline__ void stage_rc(int b, int& R, int& C) { const int st = b / 1024, sb = b % 1024, swz = sb ^ (((sb >> 9) & 1) << 5); R = (st >> 1) * 16 + swz / 64; C = (st & 1) * 32 + (swz % 64) / 2; }
__host__ __device__ __forceinline__ int perm32(int rho) { const int n = rho >> 4, i = rho & 15; return 8 * (i >> 2) + 4 * n + (i & 3); }

struct Unit { int pm, pn; };
struct Gemm { const bf16_t* A; const bf16_t* Bt; int M, N, K; };

struct StaticOrder {
    int nM, nN, nwg, G, c;
    __host__ __device__ void init(int M, int N, int G_, int c_) { nM = M / BM; nN = N / BM; nwg = nM * nN; G = G_; c = c_; }
    __host__ __device__ bool next(int i, Unit& u) const {
        const long L = (long)i * G + c; if (L >= nwg) return false;
        int wgid = (int)L; { const int q = nwg / NXCD, r = nwg % NXCD, xcd = wgid % NXCD, off = wgid / NXCD; wgid = (xcd < r ? xcd * (q + 1) : r * (q + 1) + (xcd - r) * q) + off; }
        const int nig = WGM * nN, gid = wgid / nig, fm = gid * WGM, gsz = (nM - fm) < WGM ? (nM - fm) : WGM;
        u.pm = fm + ((wgid % nig) % gsz); u.pn = (wgid % nig) / gsz; return true;
    }
    __device__ __forceinline__ void a_ready(const Unit&) const {}
    __device__ __forceinline__ void done(const Unit&) const {}
};

__device__ __forceinline__ unsigned cvt_pk_bf16(float lo, float hi) { unsigned r; asm volatile("v_cvt_pk_bf16_f32 %0, %1, %2" : "=v"(r) : "v"(lo), "v"(hi)); return r; }
typedef float f32x2 __attribute__((ext_vector_type(2)));

typedef float f32x2e __attribute__((ext_vector_type(2)));
typedef __bf16 bf16x2e __attribute__((ext_vector_type(2)));
__device__ __forceinline__ unsigned cvt_pk(float lo, float hi) { const f32x2e v = {lo, hi}; return __builtin_bit_cast(unsigned, __builtin_convertvector(v, bf16x2e)); }
__device__ __forceinline__ float silu_f(float x) { return x * __builtin_amdgcn_rcpf(1.0f + __expf(-x)); }
struct EpiBf16Plain {
    static constexpr bool PERM = true, AFTER_DRAIN = false;
    bf16_t* O; int ldc;
    __device__ __forceinline__ void operator()(const f32x4 (&acc)[2][2][4][2], const Unit& u, int wr, int wc, int fr, int fq) const {
        const int row0 = u.pm * BM + wr * 64 + fr, col0 = u.pn * BM + wc * 32 + 8 * fq;
#pragma unroll
        for (int ai = 0; ai < 2; ++ai)
#pragma unroll
            for (int m = 0; m < 4; ++m) { bf16_t* rowp = O + (size_t)(row0 + ai * HALF + m * 16) * ldc + col0;
#pragma unroll
                for (int bj = 0; bj < 2; ++bj) { const f32x4 v0 = acc[ai][bj][m][0], v1 = acc[ai][bj][m][1];
                    u32x4 w; w.x = cvt_pk(v0[0], v0[1]); w.y = cvt_pk(v0[2], v0[3]); w.z = cvt_pk(v1[0], v1[1]); w.w = cvt_pk(v1[2], v1[3]);
                    *(u32x4*)(rowp + bj * HALF) = w; } }
    }
};
struct EpiSwiGLU {
    static constexpr bool PERM = true, AFTER_DRAIN = false;
    bf16_t* O; int ldc;
    __device__ __forceinline__ void operator()(const f32x4 (&acc)[2][2][4][2], const Unit& u, int wr, int wc, int fr, int fq) const {
        const int row0 = u.pm * BM + wr * 64 + fr, col0 = u.pn * HALF + wc * 32 + 8 * fq;
#pragma unroll
        for (int ai = 0; ai < 2; ++ai)
#pragma unroll
            for (int m = 0; m < 4; ++m) { bf16_t* rowp = O + (size_t)(row0 + ai * HALF + m * 16) * ldc + col0;
                const f32x4 g0 = acc[ai][0][m][0], g1 = acc[ai][0][m][1], u0 = acc[ai][1][m][0], u1 = acc[ai][1][m][1];
                u32x4 w; w.x = cvt_pk(silu_f(g0[0]) * u0[0], silu_f(g0[1]) * u0[1]); w.y = cvt_pk(silu_f(g0[2]) * u0[2], silu_f(g0[3]) * u0[3]);
                w.z = cvt_pk(silu_f(g1[0]) * u1[0], silu_f(g1[1]) * u1[1]); w.w = cvt_pk(silu_f(g1[2]) * u1[2], silu_f(g1[3]) * u1[3]);
                *(u32x4*)rowp = w; }
    }
};
struct EpiResGate {
    static constexpr bool PERM = false, AFTER_DRAIN = false;
    const float* xin; float* xout; int ldc; const float* gate; int gpitch;
    __device__ __forceinline__ void operator()(const f32x4 (&acc)[2][2][4][2], const Unit& u, int wr, int wc, int fr, int fq) const {
        const int row0 = u.pm * BM + wr * 64 + fr, col0 = u.pn * BM + wc * 32 + 4 * fq;
        const float* gp = gate + (size_t)(u.pm >> 3) * gpitch + col0;
        f32x4 gv[2][2];
#pragma unroll
        for (int bj = 0; bj < 2; ++bj)
#pragma unroll
            for (int n = 0; n < 2; ++n) gv[bj][n] = *(const f32x4*)(gp + bj * HALF + n * 16);
#pragma unroll
        for (int ai = 0; ai < 2; ++ai)
#pragma unroll
            for (int m = 0; m < 4; ++m) { const size_t off = (size_t)(row0 + ai * HALF + m * 16) * ldc + col0;
#pragma unroll
                for (int bj = 0; bj < 2; ++bj)
#pragma unroll
                    for (int n = 0; n < 2; ++n) { const f32x4 xi = *(const f32x4*)(xin + off + bj * HALF + n * 16);
                        *(f32x4*)(xout + off + bj * HALF + n * 16) = xi + gv[bj][n] * acc[ai][bj][m][n]; }
                asm volatile("" ::: "memory"); }
    }
};

template <class Epi, class Sched, bool ALIGN_EPI = false, bool SP2 = false>
__device__ __forceinline__ void gemm_phase(PG8_LAS unsigned char* lds, const Gemm g, const Sched& S, const Epi& E, const int wid_in) {
    const int wid = wid_in, lane = lane_id_opq(), tid = wid * 64 + lane, wr = wid >> 2, wc = wid & 3, fr = lane & 15, fq = lane >> 4;
    const int K = g.K, nt = K / BK;
    unsigned voffA[2], voffB[2];
#pragma unroll
    for (int i = 0; i < 2; ++i) { int R, C; stage_rc(tid * 16 + i * 8192, R, C); const int Rb = Epi::PERM ? ((R & ~31) + perm32(R & 31)) : R;
        voffA[i] = (unsigned)(R * K + C) * 2u; voffB[i] = (unsigned)(Rb * K + C) * 2u; }
    const size_t kstep = (size_t)(BK * 2);
    const size_t hstep = (size_t)HALF * K * 2;
    const size_t tstep = 2 * hstep;
    const unsigned ldsw = (unsigned)wid * 1024u;
    const int aoff = lds_byte(wr * 64 + fr, fq * 8), boff = lds_byte(wc * 32 + fr, fq * 8);
#define PG8_SA(b, h) (((b) * 2 + (h)) * HTB)
#define PG8_SB(b, h) ((4 + (b) * 2 + (h)) * HTB)
#define PG8_STAGE(bufoff, gbase, voff) do { _Pragma("unroll") for (int _i = 0; _i < 2; ++_i) \
        __builtin_amdgcn_global_load_lds((const unsigned*)((const char*)(gbase) + (voff)[_i]), (PG8_LAS unsigned*)(lds + (bufoff) + ldsw + _i * 8192), 16, 0, 0); } while (0)
#define PG8_LDA(dst, b, h) do { _Pragma("unroll") for (int m = 0; m < 4; ++m) _Pragma("unroll") for (int k = 0; k < 2; ++k) dst[m][k] = *(const PG8_LAS bf16x8*)(lds + PG8_SA(b, h) + aoff + m * 2048 + k * 1024); } while (0)
#define PG8_LDB(dst, b, h) do { _Pragma("unroll") for (int n = 0; n < 2; ++n) _Pragma("unroll") for (int k = 0; k < 2; ++k) dst[n][k] = *(const PG8_LAS bf16x8*)(lds + PG8_SB(b, h) + boff + n * 2048 + k * 1024); } while (0)
#define PG8_MMA(ai, bj, At, Bt) do { __builtin_amdgcn_s_setprio(1); _Pragma("unroll") for (int m = 0; m < 4; ++m) _Pragma("unroll") for (int n = 0; n < 2; ++n) _Pragma("unroll") for (int k = 0; k < 2; ++k) \
        acc[ai][bj][m][n] = __builtin_amdgcn_mfma_f32_16x16x32_bf16(Bt[n][k], At[m][k], acc[ai][bj][m][n], 0, 0, 0); __builtin_amdgcn_s_setprio(0); } while (0)
#define PG8_WAIT_V(n) asm volatile("s_waitcnt vmcnt(" #n ")" ::: "memory")
#define PG8_WAIT_L(n) asm volatile("s_waitcnt lgkmcnt(" #n ")" ::: "memory")
#define PG8_BAR __builtin_amdgcn_s_barrier()
#define PG8_SCHED __builtin_amdgcn_sched_barrier(0)
    Unit cur, nxt; int ui = 0;
    if (!S.next(0, cur)) return;
    f32x4 acc[2][2][4][2];
#pragma unroll
    for (int a = 0; a < 2; ++a)
#pragma unroll
        for (int b = 0; b < 2; ++b)
#pragma unroll
            for (int m = 0; m < 4; ++m)
#pragma unroll
                for (int n = 0; n < 2; ++n) acc[a][b][m][n] = (f32x4){0.f, 0.f, 0.f, 0.f};
    bf16x8 At[4][2], B0[2][2], B1[2][2];
    const char* cA = (const char*)g.A + (size_t)cur.pm * tstep; const char* cB = (const char*)g.Bt + (size_t)cur.pn * tstep;
    S.a_ready(cur);
    if constexpr (SP2) {
        PG8_STAGE(PG8_SB(0, 0), cB, voffB); PG8_STAGE(PG8_SB(0, 1), cB + hstep, voffB); PG8_STAGE(PG8_SA(0, 0), cA, voffA); PG8_STAGE(PG8_SA(0, 1), cA + hstep, voffA);
        if (wr == 1) PG8_BAR;
        PG8_WAIT_V(2); PG8_BAR;
        PG8_STAGE(PG8_SB(1, 0), cB + kstep, voffB); PG8_STAGE(PG8_SA(1, 0), cA + kstep, voffA); PG8_STAGE(PG8_SB(1, 1), cB + hstep + kstep, voffB);
        PG8_WAIT_V(6); PG8_BAR;
    } else {
        PG8_STAGE(PG8_SB(0, 0), cB, voffB); PG8_STAGE(PG8_SA(0, 0), cA, voffA); PG8_STAGE(PG8_SB(0, 1), cB + hstep, voffB); PG8_STAGE(PG8_SA(0, 1), cA + hstep, voffA);
        if (wr == 1) PG8_BAR;
        PG8_WAIT_V(4); PG8_BAR;
        PG8_STAGE(PG8_SB(1, 0), cB + kstep, voffB); PG8_STAGE(PG8_SA(1, 0), cA + kstep, voffA); PG8_STAGE(PG8_SB(1, 1), cB + hstep + kstep, voffB);
        PG8_WAIT_V(6); PG8_BAR;
    }
    for (;;) {
        const bool has_next = S.next(ui + 1, nxt);
        const char* nA = has_next ? (const char*)g.A + (size_t)nxt.pm * tstep : cA; const char* nB = has_next ? (const char*)g.Bt + (size_t)nxt.pn * tstep : cB;
        for (int t = 0; t < nt; t += 2) {
            const bool last = (t == nt - 2);
            const char* a1 = cA + (size_t)(t + 1) * kstep;
            const char* a2 = last ? nA : cA + (size_t)(t + 2) * kstep; const char* b2 = last ? nB : cB + (size_t)(t + 2) * kstep;
            const char* a3 = a2 + kstep; const char* b3 = b2 + kstep;
            if (last && has_next) S.a_ready(nxt);
            if constexpr (SP2) {
            PG8_LDB(B0, 0, 0); PG8_LDB(B1, 0, 1); PG8_SCHED; PG8_LDA(At, 0, 0); PG8_STAGE(PG8_SA(1, 1), a1 + hstep, voffA);
            PG8_WAIT_V(8); PG8_WAIT_L(0); PG8_BAR; PG8_MMA(0, 0, At, B0); PG8_MMA(0, 1, At, B1); PG8_BAR; PG8_SCHED;
            PG8_LDA(At, 0, 1); PG8_STAGE(PG8_SB(0, 0), b2, voffB); PG8_STAGE(PG8_SB(0, 1), b2 + hstep, voffB); PG8_STAGE(PG8_SA(0, 0), a2, voffA);
            PG8_WAIT_V(8); PG8_WAIT_L(0); PG8_BAR; PG8_MMA(1, 0, At, B0); PG8_MMA(1, 1, At, B1); PG8_BAR; PG8_SCHED;
            PG8_LDB(B0, 1, 0); PG8_LDB(B1, 1, 1); PG8_SCHED; PG8_LDA(At, 1, 0); PG8_STAGE(PG8_SA(0, 1), a2 + hstep, voffA);
            PG8_WAIT_V(8); PG8_WAIT_L(0); PG8_BAR; PG8_MMA(0, 0, At, B0); PG8_MMA(0, 1, At, B1); PG8_BAR; PG8_SCHED;
            PG8_LDA(At, 1, 1); PG8_STAGE(PG8_SB(1, 0), b3, voffB); PG8_STAGE(PG8_SB(1, 1), b3 + hstep, voffB); PG8_STAGE(PG8_SA(1, 0), a3, voffA);
            PG8_WAIT_V(8); PG8_WAIT_L(0); PG8_BAR; PG8_MMA(1, 0, At, B0); PG8_MMA(1, 1, At, B1); PG8_BAR; PG8_SCHED;
            } else {
            PG8_LDB(B0, 0, 0); PG8_SCHED; PG8_LDA(At, 0, 0); PG8_STAGE(PG8_SA(1, 1), a1 + hstep, voffA);
            PG8_WAIT_L(8); PG8_BAR; PG8_WAIT_L(0); PG8_MMA(0, 0, At, B0); PG8_BAR; PG8_SCHED;
            PG8_LDB(B1, 0, 1); PG8_STAGE(PG8_SB(0, 0), b2, voffB);
            PG8_BAR; PG8_WAIT_L(0); PG8_MMA(0, 1, At, B1); PG8_BAR;
            PG8_LDA(At, 0, 1); PG8_STAGE(PG8_SA(0, 0), a2, voffA);
            PG8_BAR; PG8_WAIT_L(0); PG8_MMA(1, 0, At, B0); PG8_BAR; PG8_SCHED;
            PG8_STAGE(PG8_SB(0, 1), b2 + hstep, voffB);
            PG8_WAIT_V(6); PG8_BAR; PG8_MMA(1, 1, At, B1); PG8_BAR;
            PG8_LDB(B0, 1, 0); PG8_SCHED; PG8_LDA(At, 1, 0); PG8_STAGE(PG8_SA(0, 1), a2 + hstep, voffA);
            PG8_WAIT_L(8); PG8_BAR; PG8_WAIT_L(0); PG8_MMA(0, 0, At, B0); PG8_BAR; PG8_SCHED;
            PG8_LDB(B1, 1, 1); PG8_STAGE(PG8_SB(1, 0), b3, voffB);
            PG8_BAR; PG8_WAIT_L(0); PG8_MMA(0, 1, At, B1); PG8_BAR;
            PG8_LDA(At, 1, 1); PG8_STAGE(PG8_SA(1, 0), a3, voffA);
            PG8_BAR; PG8_WAIT_L(0); PG8_MMA(1, 0, At, B0); PG8_BAR; PG8_SCHED;
            PG8_STAGE(PG8_SB(1, 1), b3 + hstep, voffB);
            PG8_WAIT_V(6); PG8_BAR; PG8_MMA(1, 1, At, B1); PG8_BAR;
            }
        }
        if constexpr (ALIGN_EPI) { if (wr == 0) PG8_BAR; }
        if constexpr (!Epi::AFTER_DRAIN) { E(acc, cur, wr, wc, fr, fq); S.done(cur); }
        if (!has_next) break;
#pragma unroll
        for (int a = 0; a < 2; ++a)
#pragma unroll
            for (int b = 0; b < 2; ++b)
#pragma unroll
                for (int m = 0; m < 4; ++m)
#pragma unroll
                    for (int n = 0; n < 2; ++n) acc[a][b][m][n] = (f32x4){0.f, 0.f, 0.f, 0.f};
        cur = nxt; cA = nA; cB = nB; ++ui;
        if constexpr (ALIGN_EPI) { if (wr == 1) PG8_BAR; }
    }
    PG8_WAIT_V(0);
    if constexpr (!ALIGN_EPI) { if (wr == 0) PG8_BAR; }
    PG8_BAR;
    if constexpr (Epi::AFTER_DRAIN) { E.fused(acc, cur, wr, wc, fr, fq, lds, wid, lane); S.done(cur); }
#undef PG8_SA
#undef PG8_SB
#undef PG8_STAGE
#undef PG8_LDA
#undef PG8_LDB
#undef PG8_MMA
#undef PG8_WAIT_V
#undef PG8_WAIT_L
#undef PG8_BAR
#undef PG8_SCHED
}
}

#ifndef MK_PER_PHASE
#define MK_PER_PHASE 0
#endif
constexpr int NWAVES = 8;
constexpr int DM = 1024, NB = 32, SEQ = 2048, NL = 4, MT = NB * SEQ;
constexpr int D_IN = 3976, NPI = 4096, DFF = 2816, NF1 = 2 * DFF;
constexpr int RW_B = 1024, ML_B = 2432;
constexpr int RWKV_IN = 1408;
constexpr float RMS_EPS = 1e-6f, GN_EPS = 1e-5f;
constexpr int MODP = 6 * DM;
constexpr size_t MiB = 1u << 20;
constexpr size_t WS_CTL = 0, CTL_ZERO_BYTES = 1 * MiB;
constexpr size_t WS_HS = 116 * MiB;
constexpr int CW_FLAG = 16384;
constexpr size_t WS_WL = 5 * MiB;
constexpr size_t WS_MOD = 1 * MiB;
constexpr size_t WS_WIN = 8 * MiB, WS_WOUT = 40 * MiB, WS_WF1 = 48 * MiB, WS_WF2 = 92 * MiB;
constexpr size_t WS_H = 128 * MiB;
constexpr size_t WS_PROJ = 256 * MiB;
constexpr size_t WS_DEC = 768 * MiB, WS_AA = 864 * MiB, WS_GG = 912 * MiB;
constexpr size_t WS_END = 960 * MiB;
constexpr int CW_BAR = 4096;
constexpr int N_PHASES = 2 + 8 * NL;
static_assert((CW_BAR + (MK_PER_PHASE ? 1 : 1) * 3456) * 4 <= (int)CTL_ZERO_BYTES, "ctl");
constexpr int RING_BYTES = 131072, LDS_BYTES = 163840, LDSCTL_OFF = LDS_BYTES - 1024, MISC_OFF = LDSCTL_OFF + 320;

#define GAS __attribute__((address_space(1)))
#define LAS __attribute__((address_space(3)))
typedef unsigned short bf16;
typedef unsigned v4u __attribute__((ext_vector_type(4)));
typedef unsigned v2u __attribute__((ext_vector_type(2)));
typedef float f32x4 __attribute__((ext_vector_type(4)));
#define LDS_WAIT() asm volatile("s_waitcnt lgkmcnt(0)" ::: "memory")
typedef float f32x2c __attribute__((ext_vector_type(2)));
typedef __bf16 bf16x2c __attribute__((ext_vector_type(2)));
__device__ __forceinline__ unsigned f2bf(float f) { return (__builtin_bit_cast(unsigned, f) + 0x8000u) >> 16; }
__device__ __forceinline__ unsigned pk2(float lo, float hi) { return __builtin_amdgcn_perm(__builtin_bit_cast(unsigned, hi) + 0x8000u, __builtin_bit_cast(unsigned, lo) + 0x8000u, 0x07060302u); }
__device__ __forceinline__ float bf2f(bf16 v) { return __uint_as_float(((unsigned)v) << 16); }
template <int CTRL, int ROWMASK> __device__ __forceinline__ float dppf(float v) { return __builtin_bit_cast(float, __builtin_amdgcn_update_dpp(0, __builtin_bit_cast(int, v), CTRL, ROWMASK, 0xf, false)); }
__device__ __forceinline__ float sum16(float v) { v += dppf<0xB1, 0xf>(v); v += dppf<0x4E, 0xf>(v); v += dppf<0x141, 0xf>(v); v += dppf<0x140, 0xf>(v); return v; }
__device__ __forceinline__ float wave_sum(float v) { v = sum16(v); v += dppf<0x142, 0xa>(v); v += dppf<0x143, 0xc>(v); return __builtin_bit_cast(float, __builtin_amdgcn_readlane(__builtin_bit_cast(int, v), 63)); }
template <int CTRL, int ROWMASK> __device__ __forceinline__ float dppo(float v, float old) { return __builtin_bit_cast(float, __builtin_amdgcn_update_dpp(__builtin_bit_cast(int, old), __builtin_bit_cast(int, v), CTRL, ROWMASK, 0xf, false)); }
__device__ __forceinline__ float wave_prefix_sum(float v) { v += dppo<0x111, 0xf>(v, 0.f); v += dppo<0x112, 0xf>(v, 0.f); v += dppo<0x114, 0xf>(v, 0.f); v += dppo<0x118, 0xf>(v, 0.f); v += dppo<0x142, 0xa>(v, 0.f); v += dppo<0x143, 0xc>(v, 0.f); return v; }
__device__ __forceinline__ float wave_prefix_max(float v) { const float ni = -__builtin_inff(); v = fmaxf(v, dppo<0x111, 0xf>(v, ni)); v = fmaxf(v, dppo<0x112, 0xf>(v, ni)); v = fmaxf(v, dppo<0x114, 0xf>(v, ni)); v = fmaxf(v, dppo<0x118, 0xf>(v, ni));
    v = fmaxf(v, dppo<0x142, 0xa>(v, ni)); v = fmaxf(v, dppo<0x143, 0xc>(v, ni)); return v; }
__device__ __forceinline__ float flogsigmoid(float x) { return fminf(x, 0.f) - __logf(1.0f + __expf(-fabsf(x))); }
__device__ __forceinline__ float fexp(float x) { return __expf(x); }
__device__ __forceinline__ float fsigmoid(float x) { return __builtin_amdgcn_rcpf(1.0f + __expf(-x)); }
__device__ __forceinline__ float sigmoid_f(float x) { return 1.0f / (1.0f + expf(-x)); }
__device__ __forceinline__ float logsigmoid_f(float x) { return fminf(x, 0.f) - log1pf(expf(-fabsf(x))); }
template <class T> __device__ __forceinline__ T* opq(T* p) { asm volatile("" : "+s"(p)); return p; }

#define XB_TMO      128
#define XB_XCNT(j)  (256  + 64 * (j))
#define XB_XSUB(j)  (1280 + 64 * (j))
#define XB_XGEN(j)  (2304 + 64 * (j))
#define XB_TOP      3328
#define XB_TOPGEN   3392
#define XCD_BAR_WORDS 3456
#define XB_SPIN_CAP (1u << 22)

__device__ __forceinline__ unsigned xb_ld(unsigned* p)              { return __hip_atomic_load(p, __ATOMIC_RELAXED, __HIP_MEMORY_SCOPE_AGENT); }
__device__ __forceinline__ unsigned xb_add(unsigned* p, unsigned v) { return __hip_atomic_fetch_add(p, v, __ATOMIC_RELAXED, __HIP_MEMORY_SCOPE_AGENT); }
__device__ __forceinline__ unsigned xb_xcc_id() { return (unsigned)__builtin_amdgcn_s_getreg((3 << 11) | 20) & 0xFu; }
#define XB_SPIN(cond, bar) do { unsigned _sp = 0; while (cond) { __builtin_amdgcn_s_sleep(1); \
    if ((++_sp & 255u) == 0u) { if (xb_ld(&(bar)[XB_TMO])) break; if (_sp > XB_SPIN_CAP) { atomicAdd(&(bar)[XB_TMO], 1u); break; } } } } while (0)

struct XcdBarrier {
    unsigned* bar; unsigned x; unsigned w0;
    volatile LAS unsigned* st;
};

__device__ __forceinline__ XcdBarrier xcd_barrier_post(unsigned* bar, volatile LAS unsigned* st) {
    XcdBarrier b; b.bar = bar; b.x = xb_xcc_id(); b.st = st; b.w0 = (__builtin_amdgcn_readfirstlane((int)threadIdx.x >> 6) == 0) ? 1u : 0u;
    if (threadIdx.x == 0) (void)xb_add(&bar[XB_XCNT(b.x)], 1u);
    return b;
}
__device__ __forceinline__ void xcd_barrier_complete(unsigned* bar, unsigned x, unsigned& nloc, unsigned& nx) {
    const unsigned G = gridDim.x * gridDim.y * gridDim.z;
    unsigned sum, cnt, mine, sp = 0u;
    for (;;) {
        sum = 0u; cnt = 0u; mine = 0u;
#pragma unroll
        for (unsigned j = 0; j < 16; ++j) { const unsigned c = xb_ld(&bar[XB_XCNT(j)]); sum += c; cnt += (c > 0u) ? 1u : 0u; mine = (j == x) ? c : mine; }
        if (sum == G) break;
        __builtin_amdgcn_s_sleep(1);
        if ((++sp & 255u) == 0u) { if (xb_ld(&bar[XB_TMO])) break; if (sp > XB_SPIN_CAP) { atomicAdd(&bar[XB_TMO], 1u); break; } }
    }
    nloc = mine > 0u ? mine : 1u; nx = cnt > 0u ? cnt : 1u;
}

__device__ __forceinline__ void xcd_barrier(const XcdBarrier& b) {
    asm volatile("s_waitcnt vmcnt(0)" ::: "memory");
    __syncthreads();
    if (b.w0 != 0u && lane_id_opq() == 0) {
        unsigned* bar = b.bar;
        __builtin_amdgcn_s_waitcnt(0);
        unsigned nloc = b.st[0], nx = b.st[1];
        if (nloc == 0u) { xcd_barrier_complete(bar, b.x, nloc, nx); b.st[0] = nloc; b.st[1] = nx; }
        const unsigned old = xb_add(&bar[XB_XSUB(b.x)], 1u);
        const unsigned gen = old / nloc;
        if (old + 1u == (gen + 1u) * nloc) {
            __builtin_amdgcn_fence(__ATOMIC_RELEASE, "agent");
            asm volatile("s_waitcnt vmcnt(0)" ::: "memory");
            const unsigned og = xb_add(&bar[XB_TOP], 1u);
            const unsigned tg = og / nx;
            if (og + 1u == (tg + 1u) * nx) xb_add(&bar[XB_TOPGEN], 1u);
            else XB_SPIN(xb_ld(&bar[XB_TOPGEN]) == tg, bar);
            __builtin_amdgcn_fence(__ATOMIC_ACQUIRE, "agent");
            xb_add(&bar[XB_XGEN(b.x)], 1u);
            asm volatile("s_waitcnt vmcnt(0)" ::: "memory");
        } else {
            XB_SPIN(xb_ld(&bar[XB_XGEN(b.x)]) == gen, bar);
            __builtin_amdgcn_fence(__ATOMIC_ACQUIRE, "agent");
            asm volatile("s_waitcnt vmcnt(0)" ::: "memory");
        }
    }
    __syncthreads();
}


__device__ __forceinline__ void p0_mod(const float* c, const float* ada_w, const float* ada_b, float* mod, LAS unsigned char* lds, int tid, int lane, int wave) {
    LAS float* condT = (LAS float*)lds;
    for (int e = tid; e < NB * DM; e += NWAVES * 64) { const int k = e >> 5, b = e & 31; const float v = c[b * DM + k]; condT[e] = v / (1.0f + expf(-v)); }
    __syncthreads();
    for (int item = blockIdx.x; item < NL * 96; item += gridDim.x) {
        const int l = item / 96, g = item % 96, n = g * 64 + lane;
        const float* W = ada_w + (size_t)l * DM * MODP + n;
        float a0 = 0.f, a1 = 0.f, a2 = 0.f, a3 = 0.f;
        for (int k = 0; k < DM; k += 8) {
            float w[8];
#pragma unroll
            for (int u = 0; u < 8; ++u) w[u] = W[(size_t)(k + u) * MODP];
#pragma unroll
            for (int u = 0; u < 8; ++u) { const f32x4 cv = *(const LAS f32x4*)(condT + (k + u) * 32 + wave * 4); a0 += cv.x * w[u]; a1 += cv.y * w[u]; a2 += cv.z * w[u]; a3 += cv.w * w[u]; }
        }
        const float bb = ada_b[l * MODP + n]; float* o = mod + ((size_t)l * NB + wave * 4) * MODP + n;
        o[0] = a0 + bb; o[MODP] = a1 + bb; o[2 * MODP] = a2 + bb; o[3 * MODP] = a3 + bb;
    }
    __syncthreads();
}
template <int MODE>
__device__ __forceinline__ void transpose_item(const float* W, int K, int N, int nblk, bf16* WT, int ldw, LAS float* scr, int item, int lane) {
    const int kb = item / nblk, nb = item % nblk, k0 = 64 * kb, n0 = 32 * nb;
    const int nn = n0 + (lane & 31); const bool ok = nn < N;
#pragma unroll 8
    for (int i = 0; i < 32; ++i) { const int kk = 2 * i + (lane >> 5); scr[kk * 33 + (lane & 31)] = ok ? W[(size_t)(k0 + kk) * N + nn] : 0.f; }
    LDS_WAIT();
    const int c = lane & 7;
#pragma unroll
    for (int j = 0; j < 4; ++j) { const int n = (lane >> 3) + 8 * j; const LAS float* s = scr + (8 * c) * 33 + n;
        v4u o; o.x = pk2(s[0 * 33], s[1 * 33]); o.y = pk2(s[2 * 33], s[3 * 33]); o.z = pk2(s[4 * 33], s[5 * 33]); o.w = pk2(s[6 * 33], s[7 * 33]);
        int row = n0 + n;
        if (MODE == 1) { const int up = row >= DFF ? 1 : 0, jj = row - up * DFF; row = (jj >> 7) * 256 + up * 128 + (jj & 127); }
        *(v4u*)(WT + (size_t)row * ldw + k0 + 8 * c) = o; }
    LDS_WAIT();
}
__device__ __forceinline__ void p0_weights(const float* w_in, const float* w_out, const float* f1, const float* f2, const float* lw2, const float* la2, const float* lg2, unsigned char* ws, LAS unsigned char* lds, int gw, int ngw, int wave, int lane) {
    LAS float* scr = (LAS float*)(lds + wave * 16384);
    constexpr int I_IN = (DM / 64) * (NPI / 32), I_OUT = (DM / 64) * (DM / 32), I_F1 = (DM / 64) * (NF1 / 32), I_F2 = (DFF / 64) * (DM / 32), I_L = I_IN + I_OUT + I_F1 + I_F2 + 48;
    for (int it = gw; it < NL * I_L; it += ngw) {
        const int l = it / I_L; int r = it % I_L;
        if (r < I_IN) { transpose_item<0>(w_in + (size_t)l * DM * D_IN, DM, D_IN, NPI / 32, (bf16*)(ws + WS_WIN) + (size_t)l * NPI * DM, DM, scr, r, lane); continue; } r -= I_IN;
        if (r < I_OUT) { transpose_item<0>(w_out + (size_t)l * DM * DM, DM, DM, DM / 32, (bf16*)(ws + WS_WOUT) + (size_t)l * DM * DM, DM, scr, r, lane); continue; } r -= I_OUT;
        if (r < I_F1) { transpose_item<1>(f1 + (size_t)l * DM * NF1, DM, NF1, NF1 / 32, (bf16*)(ws + WS_WF1) + (size_t)l * NF1 * DM, DM, scr, r, lane); continue; } r -= I_F1;
        if (r < I_F2) { transpose_item<0>(f2 + (size_t)l * DFF * DM, DFF, DM, DM / 32, (bf16*)(ws + WS_WF2) + (size_t)l * DM * DFF, DFF, scr, r, lane); continue; } r -= I_F2;
        bf16* wl = (bf16*)(ws + WS_WL) + (size_t)l * 384 * 256;
        if (r < 12) { transpose_item<0>(lw2 + (size_t)l * 64 * 384, 64, 384, 12, wl, 256, scr, r, lane); continue; } r -= 12;
        if (r < 12) { transpose_item<0>(la2 + (size_t)l * 64 * 384, 64, 384, 12, wl + 64, 256, scr, r, lane); continue; } r -= 12;
        transpose_item<0>(lg2 + (size_t)l * 128 * 384, 128, 384, 12, wl + 128, 256, scr, r, lane);
    }
}
__device__ __forceinline__ void norm_mod_phase(const float* xin, const float* gain, const float* modl, int sh_off, int sc_off, bf16* out, int gw, int ngw, int lane) {
    for (int ci = gw; ci < MT / 32; ci += ngw) {
        const int b = ci >> 6; const float* mb = modl + (size_t)b * MODP;
        f32x4 gs[4], sh[4];
#pragma unroll
        for (int j = 0; j < 4; ++j) { const int col = 4 * lane + 256 * j; const f32x4 g = *(const f32x4*)(gain + col), s = *(const f32x4*)(mb + sc_off + col); gs[j] = g * (s + 1.0f); sh[j] = *(const f32x4*)(mb + sh_off + col); }
        for (int r = 0; r < 32; ++r) {
            const size_t row = (size_t)ci * 32 + r; const f32x4* xr = (const f32x4*)(xin + row * DM) + lane;
            f32x4 v[4]; float ss = 0.f;
#pragma unroll
            for (int j = 0; j < 4; ++j) { v[j] = xr[64 * j]; ss += (v[j].x * v[j].x + v[j].y * v[j].y) + (v[j].z * v[j].z + v[j].w * v[j].w); }
            const float rstd = 1.0f / sqrtf(wave_sum(ss) * (1.0f / DM) + RMS_EPS);
            v2u* o8 = (v2u*)(out + row * DM) + lane;
#pragma unroll
            for (int j = 0; j < 4; ++j) { const f32x4 y = v[j] * rstd * gs[j] + sh[j]; v2u w; w.x = pk2(y.x, y.y); w.y = pk2(y.z, y.w); o8[64 * j] = w; }
        }
    }
}
__device__ __forceinline__ void final_norm_phase(float* x, const float* gain, int gw, int ngw, int lane) {
    f32x4 g[4];
#pragma unroll
    for (int j = 0; j < 4; ++j) g[j] = *(const f32x4*)(gain + 4 * lane + 256 * j);
    for (int row = gw; row < MT; row += ngw) {
        f32x4* xr = (f32x4*)(x + (size_t)row * DM) + lane; f32x4 v[4]; float ss = 0.f;
#pragma unroll
        for (int j = 0; j < 4; ++j) { v[j] = xr[64 * j]; ss += (v[j].x * v[j].x + v[j].y * v[j].y) + (v[j].z * v[j].z + v[j].w * v[j].w); }
        const float rstd = 1.0f / sqrtf(wave_sum(ss) * (1.0f / DM) + RMS_EPS);
#pragma unroll
        for (int j = 0; j < 4; ++j) xr[64 * j] = v[j] * rstd * g[j];
    }
}
#define WG_BAR() do { asm volatile("s_waitcnt vmcnt(0) lgkmcnt(0)" ::: "memory"); __builtin_amdgcn_s_barrier(); asm volatile("" ::: "memory"); } while (0)
#define WG_BAR_L() do { asm volatile("s_waitcnt lgkmcnt(0)" ::: "memory"); __builtin_amdgcn_s_barrier(); asm volatile("" ::: "memory"); } while (0)
typedef short bf16x8p __attribute__((ext_vector_type(8)));
__device__ __forceinline__ void rwkv_prep_mfma(const bf16* proj, const float* mu, const float* w0, const float* a0, const bf16* WL, float* DEC, bf16* AA, bf16* GG, LAS unsigned char* lds, int wave) {
    constexpr int AP = 264;
    LAS bf16* act = (LAS bf16*)lds;
#pragma unroll 1
    for (int item = blockIdx.x; item < MT / 64; item += gridDim.x) {
        const int lane = lane_id_opq(), tid = wave * 64 + lane, q4 = lane >> 4, lc = lane & 15;
        const size_t m0 = (size_t)item * 64; const int t0 = (int)(m0 % SEQ);
        { const int tt = tid >> 3, cg = tid & 7; const bf16* p = proj + (m0 + tt) * NPI + RW_B + 1152 + 32 * cg; const bool hp = (t0 + tt) > 0; const float* mup = mu + 1152 + 32 * cg;
#pragma unroll
          for (int v = 0; v < 4; ++v) { const v4u cur = *(const v4u*)(p + 8 * v); v4u prv = (v4u){0u, 0u, 0u, 0u}; if (hp) prv = *(const v4u*)(p - NPI + 8 * v);
              const f32x4 m0v = *(const f32x4*)(mup + 8 * v), m1v = *(const f32x4*)(mup + 8 * v + 4);
              float x[8];
#pragma unroll
              for (int e = 0; e < 4; ++e) { const unsigned cw = cur[e], pw = prv[e]; const float c0 = __uint_as_float(cw << 16), c1 = __uint_as_float(cw & 0xffff0000u), p0 = __uint_as_float(pw << 16), p1 = __uint_as_float(pw & 0xffff0000u);
                  const float mu0 = e < 2 ? m0v[2 * e] : m1v[2 * e - 4], mu1 = e < 2 ? m0v[2 * e + 1] : m1v[2 * e - 3];
                  x[2 * e] = c0 + (p0 - c0) * mu0; x[2 * e + 1] = c1 + (p1 - c1) * mu1; }
              if (cg < 2) {
#pragma unroll
                  for (int e = 0; e < 8; ++e) x[e] = 2.0f * fsigmoid(2.0f * x[e]) - 1.0f;
              } else if (cg >= 4) {
#pragma unroll
                  for (int e = 0; e < 8; ++e) x[e] = fsigmoid(x[e]);
              }
              v4u o; o.x = pk2(x[0], x[1]); o.y = pk2(x[2], x[3]); o.z = pk2(x[4], x[5]); o.w = pk2(x[6], x[7]);
              *(LAS v4u*)(act + tt * AP + 32 * cg + 8 * v) = o; } }
        WG_BAR_L();
        const LAS bf16* afr = act + lc * AP + 8 * q4;
        const bf16* bfr = WL + (size_t)(48 * wave + lc) * 256 + 8 * q4;
        { f32x4 acc[4][3];
#pragma unroll
          for (int mt = 0; mt < 4; ++mt)
#pragma unroll
              for (int nt = 0; nt < 3; ++nt) acc[mt][nt] = (f32x4){0.f, 0.f, 0.f, 0.f};
#pragma unroll
          for (int ks = 0; ks < 2; ++ks) { bf16x8p bq[3];
#pragma unroll
              for (int nt = 0; nt < 3; ++nt) bq[nt] = *(const bf16x8p*)(bfr + 16 * nt * 256 + 32 * ks);
#pragma unroll
              for (int mt = 0; mt < 4; ++mt) { const bf16x8p aq = *(const LAS bf16x8p*)(afr + 16 * mt * AP + 32 * ks);
#pragma unroll
                  for (int nt = 0; nt < 3; ++nt) acc[mt][nt] = __builtin_amdgcn_mfma_f32_16x16x32_bf16(aq, bq[nt], acc[mt][nt], 0, 0, 0); } }
#pragma unroll
          for (int nt = 0; nt < 3; ++nt) { const int n = 48 * wave + 16 * nt + lc; const float w0n = w0[n]; float carry = 0.f;
#pragma unroll
              for (int mt = 0; mt < 4; ++mt) { float pr[4];
#pragma unroll
                  for (int r = 0; r < 4; ++r) { const float ld = -0.60653066f * fsigmoid(w0n + acc[mt][nt][r]); pr[r] = r ? pr[r - 1] + ld : ld; }
                  const float tot = pr[3]; float s1 = tot; { const float u = __shfl_up(s1, 16); if (q4 >= 1) s1 += u; } { const float u = __shfl_up(s1, 32); if (q4 >= 2) s1 += u; }
                  const float excl = carry + (s1 - tot), tile_tot = __shfl(s1, 48 + lc);
                  float* dp = DEC + (m0 + 16 * mt + 4 * q4) * 384 + n;
#pragma unroll
                  for (int r = 0; r < 4; ++r) dp[r * 384] = excl + pr[r];
                  carry += tile_tot; } } }
        { f32x4 acc[4][3];
#pragma unroll
          for (int mt = 0; mt < 4; ++mt)
#pragma unroll
              for (int nt = 0; nt < 3; ++nt) acc[mt][nt] = (f32x4){0.f, 0.f, 0.f, 0.f};
#pragma unroll
          for (int ks = 0; ks < 2; ++ks) { bf16x8p bq[3];
#pragma unroll
              for (int nt = 0; nt < 3; ++nt) bq[nt] = *(const bf16x8p*)(bfr + 16 * nt * 256 + 64 + 32 * ks);
#pragma unroll
              for (int mt = 0; mt < 4; ++mt) { const bf16x8p aq = *(const LAS bf16x8p*)(afr + 16 * mt * AP + 64 + 32 * ks);
#pragma unroll
                  for (int nt = 0; nt < 3; ++nt) acc[mt][nt] = __builtin_amdgcn_mfma_f32_16x16x32_bf16(aq, bq[nt], acc[mt][nt], 0, 0, 0); } }
#pragma unroll
          for (int nt = 0; nt < 3; ++nt) { const int n = 48 * wave + 16 * nt + lc; const float a0n = a0[n];
#pragma unroll
              for (int mt = 0; mt < 4; ++mt) { bf16* dp = AA + (m0 + 16 * mt + 4 * q4) * 384 + n;
#pragma unroll
                  for (int r = 0; r < 4; ++r) dp[r * 384] = (bf16)f2bf(fsigmoid(a0n + acc[mt][nt][r])); } } }
        { f32x4 acc[4][3];
#pragma unroll
          for (int mt = 0; mt < 4; ++mt)
#pragma unroll
              for (int nt = 0; nt < 3; ++nt) acc[mt][nt] = (f32x4){0.f, 0.f, 0.f, 0.f};
#pragma unroll
          for (int ks = 0; ks < 4; ++ks) { bf16x8p bq[3];
#pragma unroll
              for (int nt = 0; nt < 3; ++nt) bq[nt] = *(const bf16x8p*)(bfr + 16 * nt * 256 + 128 + 32 * ks);
#pragma unroll
              for (int mt = 0; mt < 4; ++mt) { const bf16x8p aq = *(const LAS bf16x8p*)(afr + 16 * mt * AP + 128 + 32 * ks);
#pragma unroll
                  for (int nt = 0; nt < 3; ++nt) acc[mt][nt] = __builtin_amdgcn_mfma_f32_16x16x32_bf16(aq, bq[nt], acc[mt][nt], 0, 0, 0); } }
#pragma unroll
          for (int nt = 0; nt < 3; ++nt) { const int n = 48 * wave + 16 * nt + lc;
#pragma unroll
              for (int mt = 0; mt < 4; ++mt) { bf16* dp = GG + (m0 + 16 * mt + 4 * q4) * 384 + n;
#pragma unroll
                  for (int r = 0; r < 4; ++r) dp[r * 384] = (bf16)f2bf(acc[mt][nt][r]); } } }
        WG_BAR_L();
    }
}
typedef short bf16x8_t __attribute__((ext_vector_type(8)));
template <int KS>
__device__ __forceinline__ f32x4 mm_tile(const LAS bf16* A, const LAS bf16* B, f32x4 acc) {
#pragma unroll
    for (int ks = 0; ks < KS; ++ks) {
        const bf16x8_t a = *(const LAS bf16x8_t*)(A + ks * 32), b = *(const LAS bf16x8_t*)(B + ks * 32);
        acc = __builtin_amdgcn_mfma_f32_16x16x32_bf16(a, b, acc, 0, 0, 0);
    }
    return acc;
}
__device__ __forceinline__ unsigned short f2bf16(float f) { return (unsigned short)f2bf(f); }
constexpr int LP = 72;
constexpr int LPM = 104;

__device__ __forceinline__ void ret_unit(int b, int h, const bf16* proj, const float* gn, bf16* mixed, LAS unsigned char* lds, int wave, int lane0) {
    LAS bf16* Qs = (LAS bf16*)lds; LAS bf16* Ks = Qs + 64 * LP; LAS bf16* Kdt = Ks + 64 * LP; LAS bf16* Vt = Kdt + 64 * LP; LAS bf16* Ps = Vt + 64 * LP; LAS bf16* Stt = Ps + 64 * LP; LAS bf16* Gs = Stt + 64 * LP;
    const int lane = lane0, q4 = lane >> 4, lc = lane & 15;
    const float inv = powf(10000.0f, -(float)(2 * (lane & 31)) / 64.0f);
    float cs[8], sn[8];
#pragma unroll
    for (int i = 0; i < 8; ++i) sincosf((float)(8 * wave + i) * inv, &sn[i], &cs[i]);
    float c64, s64; sincosf(64.0f * inv, &s64, &c64);
    const float lg2 = log2f(1.0f - exp2f(-5.0f - (float)h));
    float kdec[8];
#pragma unroll
    for (int i = 0; i < 8; ++i) kdec[i] = exp2f((float)(63 - (8 * wave + i)) * lg2);
    const float cd = exp2f(64.0f * lg2);
    f32x4 st[4];
#pragma unroll
    for (int i = 0; i < 4; ++i) st[i] = (f32x4){0.f, 0.f, 0.f, 0.f};
    for (int i = wave * 64 + lane; i < 64 * LP / 2; i += 512) ((LAS unsigned*)Stt)[i] = 0u;
    const size_t m0 = (size_t)b * SEQ;
    const bf16* P0 = proj + m0 * NPI + h * 64;
    unsigned short rq[8], rk[8], rv[8], rg[8];
#pragma unroll
    for (int i = 0; i < 8; ++i) { const bf16* p = P0 + (size_t)(8 * wave + i) * NPI; rq[i] = p[lane]; rk[i] = p[256 + lane]; rv[i] = p[512 + lane]; rg[i] = p[768 + lane]; }
    float gain4[4];
#pragma unroll
    for (int ct = 0; ct < 4; ++ct) gain4[ct] = gn[h * 64 + 16 * ct + lc];
#pragma unroll 1
    for (int c = 0; c < SEQ / 64; ++c) {
        const int lane = lane_id_opq(), q4 = lane >> 4, lc = lane & 15, o72 = lc * LP + 8 * q4;
        { unsigned short kd[8];
#pragma unroll
          for (int i = 0; i < 8; ++i) { const int tt = 8 * wave + i;
              const float q = bf2f(rq[i]), k = bf2f(rk[i]); const float qp = __shfl_xor(q, 32), kp = __shfl_xor(k, 32);
              const float qr = lane < 32 ? q * cs[i] - qp * sn[i] : qp * sn[i] + q * cs[i];
              const float kr = (lane < 32 ? k * cs[i] - kp * sn[i] : kp * sn[i] + k * cs[i]) * 0.125f;
              Qs[tt * LP + lane] = f2bf16(qr); Ks[tt * LP + lane] = f2bf16(kr); Gs[tt * LP + lane] = rg[i]; kd[i] = f2bf16(kr * kdec[i]);
              const float cn = cs[i] * c64 - sn[i] * s64, snn = sn[i] * c64 + cs[i] * s64; cs[i] = cn; sn[i] = snn; }
          v4u w; w.x = kd[0] | ((unsigned)kd[1] << 16); w.y = kd[2] | ((unsigned)kd[3] << 16); w.z = kd[4] | ((unsigned)kd[5] << 16); w.w = kd[6] | ((unsigned)kd[7] << 16);
          *(LAS v4u*)(Kdt + lane * LP + 8 * wave) = w;
          w.x = rv[0] | ((unsigned)rv[1] << 16); w.y = rv[2] | ((unsigned)rv[3] << 16); w.z = rv[4] | ((unsigned)rv[5] << 16); w.w = rv[6] | ((unsigned)rv[7] << 16);
          *(LAS v4u*)(Vt + lane * LP + 8 * wave) = w; }
        WG_BAR_L();
        if (c + 1 < SEQ / 64) {
#pragma unroll
            for (int i = 0; i < 8; ++i) { const bf16* p = P0 + (size_t)(64 * (c + 1) + 8 * wave + i) * NPI; rq[i] = p[lane]; rk[i] = p[256 + lane]; rv[i] = p[512 + lane]; rg[i] = p[768 + lane]; } }
        { const int rt = wave >> 1;
#pragma unroll
          for (int u = 0; u < 2; ++u) { const int ct = 2 * (wave & 1) + u;
              f32x4 s = (f32x4){0.f, 0.f, 0.f, 0.f};
              if (ct <= rt) s = mm_tile<2>(Qs + 16 * rt * LP + o72, Ks + 16 * ct * LP + o72, s);
#pragma unroll
              for (int r = 0; r < 4; ++r) { const int l = 16 * rt + 4 * q4 + r, m = 16 * ct + lc; const float val = (l >= m) ? s[r] * exp2f((float)(l - m) * lg2) : 0.f; Ps[l * LP + m] = f2bf16(val); } } }
        f32x4 inter[4];
        if (wave < 4) {
#pragma unroll
            for (int ct = 0; ct < 4; ++ct) inter[ct] = mm_tile<2>(Qs + 16 * wave * LP + o72, Stt + 16 * ct * LP + o72, (f32x4){0.f, 0.f, 0.f, 0.f}); }
        WG_BAR_L();
        if (wave < 4) {
            f32x4 y[4];
#pragma unroll
            for (int ct = 0; ct < 4; ++ct) y[ct] = mm_tile<2>(Ps + 16 * wave * LP + o72, Vt + 16 * ct * LP + o72, (f32x4){0.f, 0.f, 0.f, 0.f});
#pragma unroll
            for (int r = 0; r < 4; ++r) { const int l = 16 * wave + 4 * q4 + r; const float qd = exp2f((float)(l + 1) * lg2);
                float s = 0.f;
#pragma unroll
                for (int ct = 0; ct < 4; ++ct) { y[ct][r] += qd * inter[ct][r]; s += y[ct][r]; }
                const float mean = sum16(s) * (1.0f / 64.0f); float qv = 0.f;
#pragma unroll
                for (int ct = 0; ct < 4; ++ct) { const float dd = y[ct][r] - mean; qv += dd * dd; }
                const float rstd = 1.0f / sqrtf(sum16(qv) * (1.0f / 64.0f) + GN_EPS);
                bf16* orow = mixed + (m0 + 64 * c + l) * DM + h * 64 + lc;
#pragma unroll
                for (int ct = 0; ct < 4; ++ct) { const float g = bf2f(Gs[l * LP + 16 * ct + lc]); orow[16 * ct] = f2bf16((y[ct][r] - mean) * rstd * gain4[ct] * (g * fsigmoid(g))); } }
        } else {
            const int dt = wave - 4;
#pragma unroll
            for (int ct = 0; ct < 4; ++ct) { st[ct] = mm_tile<2>(Kdt + 16 * dt * LP + o72, Vt + 16 * ct * LP + o72, st[ct] * cd);
                v2u w; w.x = pk2(st[ct][0], st[ct][1]); w.y = pk2(st[ct][2], st[ct][3]);
                *(LAS v2u*)(Stt + (16 * ct + lc) * LP + 16 * dt + 4 * q4) = w; }
        }
        WG_BAR_L();
    }
}

__device__ __forceinline__ void mlstm_unit(int b, int h, const bf16* proj, const float* conv_w, const float* conv_b, const float* i_b, const float* f_b, const float* gn, bf16* mixed,
                                           LAS unsigned char* lds, int wave, int lane0) {
    LAS bf16* Qs = (LAS bf16*)lds; LAS bf16* Ks = Qs + 64 * LPM; LAS bf16* Kdt = Ks + 64 * LPM; LAS bf16* Vt = Kdt + 96 * LP; LAS bf16* Ps = Vt + 112 * LP; LAS bf16* Stt = Ps + 64 * LP; LAS bf16* Os = Stt + 112 * LPM;
    LAS float* ev = (LAS float*)(Os + 64 * LPM); LAS float* pmv = ev + 64; LAS float* flv = pmv + 64;
    const int lane = lane0, lc = lane & 15;
    float wq0[4], wq1[4], wk0[4], wk1[4], bq0, bq1, bk0, bk1;
    { const int cq0 = h * 96 + lane, cq1 = h * 96 + 64 + (lane & 31), ck0 = 384 + cq0, ck1 = 384 + cq1;
#pragma unroll
    for (int j = 0; j < 4; ++j) { wq0[j] = conv_w[j * 768 + cq0]; wq1[j] = conv_w[j * 768 + cq1]; wk0[j] = conv_w[j * 768 + ck0]; wk1[j] = conv_w[j * 768 + ck1]; }
    bq0 = conv_b[cq0]; bq1 = conv_b[cq1]; bk0 = conv_b[ck0]; bk1 = conv_b[ck1]; }
    const float ib = i_b[h], fb = f_b[h];
    const float ksc = 0.10206207261596577f;
    f32x4 st[11];
#pragma unroll
    for (int i = 0; i < 11; ++i) st[i] = (f32x4){0.f, 0.f, 0.f, 0.f};
    for (int i = wave * 64 + lane; i < 112 * LPM / 2; i += 512) ((LAS unsigned*)Stt)[i] = 0u;
    for (int i = wave * 64 + lane; i < 16 * LP / 2; i += 512) ((LAS unsigned*)(Vt + 96 * LP))[i] = (i < LP / 2) ? 0x3f803f80u : 0u;
    float mprev = 0.f;
    const size_t m0 = (size_t)b * SEQ;
    const bf16* PB = proj + m0 * NPI + ML_B;
    float gain6[6];
#pragma unroll
    for (int ct = 0; ct < 6; ++ct) gain6[ct] = gn[640 + h * 96 + 16 * ct + lc];
    unsigned xq[11], xk[11], vv[8], gg;
#define ML_LOAD(cc) do { const int tb_ = 64 * (cc) + 8 * wave; \
        _Pragma("unroll") for (int i = 0; i < 11; ++i) { const int t_ = tb_ - 3 + i; const bool ok_ = t_ >= 0; const bf16* p_ = PB + (size_t)(ok_ ? t_ : 0) * NPI; \
            const unsigned a0_ = ok_ ? p_[cq0] : 0u, a1_ = (ok_ && has1) ? p_[cq1] : 0u, b0_ = ok_ ? p_[ck0] : 0u, b1_ = (ok_ && has1) ? p_[ck1] : 0u; xq[i] = a0_ | (a1_ << 16); xk[i] = b0_ | (b1_ << 16); } \
        _Pragma("unroll") for (int i = 0; i < 8; ++i) { const bf16* p_ = PB + (size_t)(tb_ + i) * NPI + 768 + h * 96; const unsigned a0_ = p_[d0], a1_ = has1 ? p_[d1] : 0u; vv[i] = a0_ | (a1_ << 16); } \
        { const bf16* p_ = PB + (size_t)(64 * (cc) + lane) * NPI; const unsigned a0_ = p_[1536 + h], a1_ = p_[1540 + h]; gg = a0_ | (a1_ << 16); } } while (0)
    { const int d0 = lane, d1 = 64 + (lane & 31); const bool has1 = lane < 32; const int cq0 = h * 96 + d0, cq1 = h * 96 + d1, ck0 = 384 + cq0, ck1 = 384 + cq1; ML_LOAD(0); }
#pragma unroll 1
    for (int c = 0; c < SEQ / 64; ++c) {
        const int lane = lane_id_opq(), q4 = lane >> 4, lc = lane & 15, o72 = lc * LP + 8 * q4, o104 = lc * LPM + 8 * q4;
        const int d0 = lane, d1 = 64 + (lane & 31); const bool has1 = lane < 32;
        const int cq0 = h * 96 + d0, cq1 = h * 96 + d1, ck0 = 384 + cq0, ck1 = 384 + cq1;
        const int tb = 64 * c + 8 * wave;
        float pm63, carry, ev_l; const float mold = mprev;
        { const float ic = __uint_as_float(gg << 16) + ib, lf = flogsigmoid(__uint_as_float(gg & 0xffff0000u) + fb);
          const float bc = wave_prefix_sum(lf), e = ic - bc; const float pm = fmaxf(wave_prefix_max(e), mprev);
          pm63 = __builtin_bit_cast(float, __builtin_amdgcn_readlane(__builtin_bit_cast(int, pm), 63)); carry = fexp(mprev - pm63); ev_l = e;
          if (wave == 0) { ev[lane] = e; pmv[lane] = pm; flv[lane] = fexp(-(bc + pm)); }
          mprev = __builtin_bit_cast(float, __builtin_amdgcn_readlane(__builtin_bit_cast(int, bc), 63)) + pm63; }
        { unsigned short kd0[8], kd1[8];
#pragma unroll
          for (int i = 0; i < 8; ++i) { const int tt = 8 * wave + i;
#define LO_(w) __uint_as_float((w) << 16)
#define HI_(w) __uint_as_float((w) & 0xffff0000u)
              float q0 = bq0 + LO_(xq[i]) * wq0[0] + LO_(xq[i + 1]) * wq0[1] + LO_(xq[i + 2]) * wq0[2] + LO_(xq[i + 3]) * wq0[3];
              float k0 = bk0 + LO_(xk[i]) * wk0[0] + LO_(xk[i + 1]) * wk0[1] + LO_(xk[i + 2]) * wk0[2] + LO_(xk[i + 3]) * wk0[3];
              float q1 = bq1 + HI_(xq[i]) * wq1[0] + HI_(xq[i + 1]) * wq1[1] + HI_(xq[i + 2]) * wq1[2] + HI_(xq[i + 3]) * wq1[3];
              float k1 = bk1 + HI_(xk[i]) * wk1[0] + HI_(xk[i + 1]) * wk1[1] + HI_(xk[i + 2]) * wk1[2] + HI_(xk[i + 3]) * wk1[3];
#undef LO_
#undef HI_
              q0 = q0 * fsigmoid(q0); k0 = k0 * fsigmoid(k0) * ksc; q1 = q1 * fsigmoid(q1); k1 = k1 * fsigmoid(k1) * ksc;
              const float wsi = fexp(__builtin_bit_cast(float, __builtin_amdgcn_readlane(__builtin_bit_cast(int, ev_l), tt)) - pm63);
              Qs[tt * LPM + d0] = f2bf16(q0); Ks[tt * LPM + d0] = f2bf16(k0); kd0[i] = f2bf16(k0 * wsi); kd1[i] = f2bf16(k1 * wsi);
              if (has1) { Qs[tt * LPM + d1] = f2bf16(q1); Ks[tt * LPM + d1] = f2bf16(k1); } }
          v4u w; w.x = kd0[0] | ((unsigned)kd0[1] << 16); w.y = kd0[2] | ((unsigned)kd0[3] << 16); w.z = kd0[4] | ((unsigned)kd0[5] << 16); w.w = kd0[6] | ((unsigned)kd0[7] << 16);
          *(LAS v4u*)(Kdt + d0 * LP + 8 * wave) = w;
          if (has1) { w.x = kd1[0] | ((unsigned)kd1[1] << 16); w.y = kd1[2] | ((unsigned)kd1[3] << 16); w.z = kd1[4] | ((unsigned)kd1[5] << 16); w.w = kd1[6] | ((unsigned)kd1[7] << 16);
              *(LAS v4u*)(Kdt + d1 * LP + 8 * wave) = w; }
          w.x = (vv[0] & 0xffffu) | (vv[1] << 16); w.y = (vv[2] & 0xffffu) | (vv[3] << 16); w.z = (vv[4] & 0xffffu) | (vv[5] << 16); w.w = (vv[6] & 0xffffu) | (vv[7] << 16);
          *(LAS v4u*)(Vt + d0 * LP + 8 * wave) = w;
          if (has1) { w.x = (vv[0] >> 16) | (vv[1] & 0xffff0000u); w.y = (vv[2] >> 16) | (vv[3] & 0xffff0000u); w.z = (vv[4] >> 16) | (vv[5] & 0xffff0000u); w.w = (vv[6] >> 16) | (vv[7] & 0xffff0000u);
              *(LAS v4u*)(Vt + d1 * LP + 8 * wave) = w; } }
        WG_BAR_L();
        unsigned og[8];
#pragma unroll
        for (int i = 0; i < 8; ++i) { const bf16* p = PB + (size_t)(tb + i) * NPI + 1152 + h * 96; const unsigned a0_ = p[d0], a1_ = has1 ? p[d1] : 0u; og[i] = a0_ | (a1_ << 16); }
        if (c + 1 < SEQ / 64) ML_LOAD(c + 1);
        { const int rt = wave >> 1;
#pragma unroll
          for (int u = 0; u < 2; ++u) { const int ct = 2 * (wave & 1) + u;
              f32x4 s = (f32x4){0.f, 0.f, 0.f, 0.f};
              if (ct <= rt) s = mm_tile<3>(Qs + 16 * rt * LPM + o104, Ks + 16 * ct * LPM + o104, s);
              const float em = ev[16 * ct + lc];
#pragma unroll
              for (int r = 0; r < 4; ++r) { const int l = 16 * rt + 4 * q4 + r, m = 16 * ct + lc; const float val = (l >= m) ? s[r] * fexp(em - pmv[l]) : 0.f; Ps[l * LP + m] = f2bf16(val); } } }
        f32x4 inter[7];
        if (wave < 4) {
#pragma unroll
            for (int ct = 0; ct < 7; ++ct) inter[ct] = mm_tile<3>(Qs + 16 * wave * LPM + o104, Stt + 16 * ct * LPM + o104, (f32x4){0.f, 0.f, 0.f, 0.f}); }
#pragma unroll
        for (int i = 0; i < 8; ++i) { Os[(8 * wave + i) * LPM + d0] = (unsigned short)(og[i] & 0xffffu); if (has1) Os[(8 * wave + i) * LPM + d1] = (unsigned short)(og[i] >> 16); }
        WG_BAR_L();
        if (wave < 4) {
            f32x4 y[7];
#pragma unroll
            for (int ct = 0; ct < 7; ++ct) y[ct] = mm_tile<2>(Ps + 16 * wave * LP + o72, Vt + 16 * ct * LP + o72, (f32x4){0.f, 0.f, 0.f, 0.f});
#pragma unroll
            for (int r = 0; r < 4; ++r) { const int l = 16 * wave + 4 * q4 + r; const float iw = fexp(mold - pmv[l]);
#pragma unroll
                for (int ct = 0; ct < 7; ++ct) y[ct][r] += iw * inter[ct][r];
                const float den = __shfl(y[6][r], lane & 48);
                const float dn = 1.0f / fmaxf(fabsf(den), flv[l]);
                float s = 0.f;
#pragma unroll
                for (int ct = 0; ct < 6; ++ct) { y[ct][r] *= dn; s += y[ct][r]; }
                const float mean = sum16(s) * (1.0f / 96.0f); float qv = 0.f;
#pragma unroll
                for (int ct = 0; ct < 6; ++ct) { const float dd = y[ct][r] - mean; qv += dd * dd; }
                const float rstd = 1.0f / sqrtf(sum16(qv) * (1.0f / 96.0f) + GN_EPS);
                bf16* orow = mixed + (m0 + 64 * c + l) * DM + 640 + h * 96 + lc;
#pragma unroll
                for (int ct = 0; ct < 6; ++ct) { const float o = bf2f(Os[l * LPM + 16 * ct + lc]); orow[16 * ct] = f2bf16((y[ct][r] - mean) * rstd * gain6[ct] * fsigmoid(o)); } }
        } else {
#pragma unroll
            for (int i = 0; i < 11; ++i) { const int t = (wave - 4) + 4 * i;
                if (t < 42) { const int dt = t / 7, et = t % 7;
                    st[i] = mm_tile<2>(Kdt + 16 * dt * LP + o72, Vt + 16 * et * LP + o72, st[i] * carry);
                    v2u w; w.x = pk2(st[i][0], st[i][1]); w.y = pk2(st[i][2], st[i][3]);
                    *(LAS v2u*)(Stt + (16 * et + lc) * LPM + 16 * dt + 4 * q4) = w; } }
        }
        WG_BAR_L();
    }
#undef ML_LOAD
}
#ifndef RW_DBG
#define RW_DBG 0xFF
#endif
__device__ __forceinline__ void rwkv_unit(int b, int h, const bf16* proj, const float* CUM, const bf16* AA, const bf16* GG, const float* mu, const float* k_k, const float* k_a, const float* r_k,
                                          const float* gn, bf16* mixed, LAS unsigned char* lds, int wave, int lane0,
                                          int cb, int ce, const float* hs_in, unsigned* flag_in, float* hs_out, unsigned* flag_out) {
    constexpr int SLOT = 64 * LP;
    LAS bf16* KH = (LAS bf16*)lds; LAS bf16* BH = KH + SLOT; LAS bf16* KT = BH + SLOT; LAS bf16* RT = KT + SLOT; LAS bf16* KHgt = RT + SLOT; LAS bf16* BHgtn = KHgt + SLOT;
    LAS bf16* Vt = BHgtn + SLOT; LAS bf16* AkT = Vt + SLOT; LAS bf16* BbTn = AkT + SLOT; LAS bf16* BkT = BbTn + SLOT; LAS bf16* S0b = BkT + SLOT; LAS bf16* Loffb = S0b + SLOT; LAS bf16* Vr = Loffb + SLOT; LAS bf16* Gr = Vr + SLOT;
    LAS float* RHS = (LAS float*)KH; LAS bf16* Ut = KT;
    LAS float* LTd = (LAS float*)(Gr + SLOT);
    LAS float* XS = LTd + 64 * 20;
    LAS float* GCv = XS + 16 * 64; LAS float* bonv = GCv + 64;
    float mu_r, mu_k, mu_v, kkc, kac, rkc;
    { const int c0 = h * 64 + lane0; mu_r = mu[c0]; mu_k = mu[384 + c0]; mu_v = mu[768 + c0]; kkc = k_k[c0]; kac = k_a[c0]; rkc = r_k[c0]; }
    for (int i = wave * 64 + lane0; i < 5 * SLOT / 2; i += 512) ((LAS unsigned*)AkT)[i] = 0u;
    float gain4[4];
#pragma unroll
    for (int ct = 0; ct < 4; ++ct) gain4[ct] = gn[256 + h * 64 + 16 * ct + (lane0 & 15)];
    f32x4 sacc[4];
#pragma unroll
    for (int i = 0; i < 4; ++i) sacc[i] = (f32x4){0.f, 0.f, 0.f, 0.f};
    if (hs_in) {
        if (wave == 0) { unsigned spins = 0u;
            while (__hip_atomic_load(flag_in, __ATOMIC_RELAXED, __HIP_MEMORY_SCOPE_AGENT) == 0u) { __builtin_amdgcn_s_sleep(4); if (++spins > (1u << 22)) break; }
            __builtin_amdgcn_fence(__ATOMIC_ACQUIRE, "agent"); asm volatile("s_waitcnt vmcnt(0)" ::: "memory"); }
        WG_BAR();
        if (wave >= 4) {
#pragma unroll
            for (int jt = 0; jt < 4; ++jt) {
#pragma unroll
                for (int r = 0; r < 4; ++r) { sacc[jt][r] = hs_in[((wave - 4) * 4 + jt) * 256 + r * 64 + lane0];
                    S0b[(16 * (wave - 4) + 4 * (lane0 >> 4) + r) * LP + 16 * jt + (lane0 & 15)] = f2bf16(sacc[jt][r]); } } }
    }
    const size_t m0 = (size_t)b * SEQ;
    const bf16* PU = proj + m0 * NPI + RW_B + h * 64;
    const float* CU = CUM + m0 * 384 + h * 64; const bf16* AU = AA + m0 * 384 + h * 64; const bf16* GU = GG + m0 * 384 + h * 64;
    unsigned short rr[9], rk[9], rv[9], ra[8], rg[8]; float rc[9], rc63;
#define RWKV_LOAD(cc) do { const int tb_ = 64 * (cc) + 8 * wave; \
        _Pragma("unroll") for (int i = 0; i < 9; ++i) { const int t_ = tb_ - 1 + i; const bool ok_ = t_ >= 0; const bf16* p_ = PU + (size_t)(ok_ ? t_ : 0) * NPI; \
            rr[i] = ok_ ? p_[lane] : (unsigned short)0; rk[i] = ok_ ? p_[384 + lane] : (unsigned short)0; rv[i] = ok_ ? p_[768 + lane] : (unsigned short)0; \
            rc[i] = (i > 0 || wave > 0) ? CU[(size_t)(ok_ ? t_ : 0) * 384 + lane] : 0.f; if (i > 0) { ra[i - 1] = AU[(size_t)t_ * 384 + lane]; rg[i - 1] = GU[(size_t)t_ * 384 + lane]; } } \
        rc63 = CU[(size_t)(64 * (cc) + 63) * 384 + lane]; } while (0)
    { const int lane = lane0; RWKV_LOAD(cb); }
#pragma unroll 1
    for (int c = cb; c < ce; ++c) {
        const int lane = lane_id_opq(), q4 = lane >> 4, lc = lane & 15, o72 = lc * LP + 8 * q4;
        if (RW_DBG & 1) { unsigned short khg[8], bhg[8]; const float gc63 = fexp(rc63); float ecp = fexp(rc[0]);
#pragma unroll
          for (int i = 0; i < 8; ++i) { const int tt = 8 * wave + i;
              const float cr = bf2f(rr[i + 1]), ck = bf2f(rk[i + 1]);
              const float r = cr + (bf2f(rr[i]) - cr) * mu_r, k = ck + (bf2f(rk[i]) - ck) * mu_k, a = bf2f(ra[i]);
              float kk = k * kkc; kk = kk * __builtin_amdgcn_rsqf(fmaxf(wave_sum(kk * kk), 1e-24f));
              const float kmod = k * (1.0f + (a - 1.0f) * kac), beta = kk * a;
              const float bon = wave_sum(r * kmod * rkc); if (lane == 0) bonv[tt] = bon;
              const float cm = rc[i + 1], cp = rc[i];
              const float em = fexp(-cm), eg = gc63 * em, ec = __builtin_amdgcn_rcpf(em);
              KH[tt * LP + lane] = f2bf16(kmod * em); BH[tt * LP + lane] = f2bf16(beta * em); KT[tt * LP + lane] = f2bf16(kk * ecp); RT[tt * LP + lane] = f2bf16(r * ec); ecp = ec;
              khg[i] = f2bf16(kmod * eg); bhg[i] = f2bf16(-beta * eg); }
          v4u w; w.x = khg[0] | ((unsigned)khg[1] << 16); w.y = khg[2] | ((unsigned)khg[3] << 16); w.z = khg[4] | ((unsigned)khg[5] << 16); w.w = khg[6] | ((unsigned)khg[7] << 16);
          *(LAS v4u*)(KHgt + lane * LP + 8 * wave) = w;
          w.x = bhg[0] | ((unsigned)bhg[1] << 16); w.y = bhg[2] | ((unsigned)bhg[3] << 16); w.z = bhg[4] | ((unsigned)bhg[5] << 16); w.w = bhg[6] | ((unsigned)bhg[7] << 16);
          *(LAS v4u*)(BHgtn + lane * LP + 8 * wave) = w;
          unsigned short vs[8];
#pragma unroll
          for (int i = 0; i < 8; ++i) { const float cv = bf2f(rv[i + 1]); vs[i] = f2bf16(cv + (bf2f(rv[i]) - cv) * mu_v); Vr[(8 * wave + i) * LP + lane] = vs[i]; Gr[(8 * wave + i) * LP + lane] = rg[i]; }
          w.x = vs[0] | ((unsigned)vs[1] << 16); w.y = vs[2] | ((unsigned)vs[3] << 16); w.z = vs[4] | ((unsigned)vs[5] << 16); w.w = vs[6] | ((unsigned)vs[7] << 16);
          *(LAS v4u*)(Vt + lane * LP + 8 * wave) = w;
          if (wave == 0) GCv[lane] = gc63; }
        WG_BAR_L();
#pragma unroll
        for (int u2 = 0; u2 < 2; ++u2) { const int idx = 2 * wave + u2, rt = idx >> 2, ct = idx & 3;
            if (ct <= rt) {
                const int s = 16 * ct + lc; const LAS bf16* kt = KT + 16 * rt * LP + o72; const LAS bf16* rtp = RT + 16 * rt * LP + o72; const LAS bf16* bh = BH + 16 * ct * LP + o72; const LAS bf16* kh = KH + 16 * ct * LP + o72;
                const f32x4 z = (f32x4){0.f, 0.f, 0.f, 0.f};
                const f32x4 g0 = mm_tile<2>(kt, bh, z), g1 = mm_tile<2>(kt, kh, z), g2 = mm_tile<2>(rtp, bh, z), g3 = mm_tile<2>(rtp, kh, z);
#pragma unroll
                for (int r = 0; r < 4; ++r) { const int t = 16 * rt + 4 * q4 + r;
                    if (ct < rt) Loffb[t * LP + s] = f2bf16(g0[r]); else LTd[s * 20 + (t - 16 * rt)] = (s < t) ? g0[r] : 0.f;
                    AkT[t * LP + s] = f2bf16((s < t) ? g1[r] : 0.f);
                    BbTn[t * LP + s] = f2bf16((s <= t) ? -g2[r] : 0.f);
                    BkT[t * LP + s] = f2bf16((s <= t) ? g3[r] : 0.f); } } }
        WG_BAR_L();
#pragma unroll
        for (int u = 0; u < ((RW_DBG & 4) ? 2 : 0); ++u) { const int rt = wave >> 1, ct = 2 * (wave & 1) + u;
            f32x4 g = mm_tile<2>(KT + 16 * rt * LP + o72, S0b + 16 * ct * LP + o72, (f32x4){0.f, 0.f, 0.f, 0.f});
            g = mm_tile<2>(AkT + 16 * rt * LP + o72, Vt + 16 * ct * LP + o72, g);
#pragma unroll
            for (int r = 0; r < 4; ++r) RHS[(16 * rt + 4 * q4 + r) * 64 + 16 * ct + lc] = g[r]; }
        WG_BAR_L();
        f32x4 y[4];
        if ((RW_DBG & 8) && wave == 0) {
#pragma unroll
            for (int a = 0; a < 4; ++a) {
                if (a > 0) {
#pragma unroll
                    for (int it = 0; it < 4; ++it) { f32x4 cr = (f32x4){0.f, 0.f, 0.f, 0.f};
                        if (a == 3) cr = mm_tile<2>(Loffb + 16 * a * LP + o72, Ut + 16 * it * LP + o72, cr); else cr = mm_tile<1>(Loffb + 16 * a * LP + o72, Ut + 16 * it * LP + o72, cr);
#pragma unroll
                        for (int r = 0; r < 4; ++r) XS[(4 * q4 + r) * 64 + 16 * it + lc] = cr[r]; }
                    asm volatile("s_waitcnt lgkmcnt(0)" ::: "memory");
                }
                f32x2c acc2[8];
#pragma unroll
                for (int t = 0; t < 16; ++t) acc2[t >> 1][t & 1] = RHS[(16 * a + t) * 64 + lane] - (a > 0 ? XS[t * 64 + lane] : 0.f);
                const LAS float* Ld = LTd + 16 * a * 20; asm volatile("" : "+v"(Ld));
#pragma unroll
                for (int s2 = 0; s2 < 15; ++s2) { const float us = acc2[s2 >> 1][s2 & 1]; const f32x2c us2 = {us, us};
#pragma unroll
                    for (int t4 = (s2 + 1) / 4; t4 < 4; ++t4) { const f32x4 l4 = *(const LAS f32x4*)(Ld + s2 * 20 + 4 * t4);
                        acc2[2 * t4] -= (f32x2c){l4.x, l4.y} * us2; acc2[2 * t4 + 1] -= (f32x2c){l4.z, l4.w} * us2; }
                    if (s2 == 3 || s2 == 7) asm volatile("" : "+v"(Ld) : "v"(acc2[(s2 + 1) >> 1]));
                }
                v4u w; w.x = pk2(acc2[0][0], acc2[0][1]); w.y = pk2(acc2[1][0], acc2[1][1]); w.z = pk2(acc2[2][0], acc2[2][1]); w.w = pk2(acc2[3][0], acc2[3][1]);
                *(LAS v4u*)(Ut + lane * LP + 16 * a) = w;
                w.x = pk2(acc2[4][0], acc2[4][1]); w.y = pk2(acc2[5][0], acc2[5][1]); w.z = pk2(acc2[6][0], acc2[6][1]); w.w = pk2(acc2[7][0], acc2[7][1]);
                *(LAS v4u*)(Ut + lane * LP + 16 * a + 8) = w;
                asm volatile("s_waitcnt lgkmcnt(0)" ::: "memory");
            }
        }
        if (c + 1 < ce) RWKV_LOAD(c + 1);
        if (wave < 4) {
#pragma unroll
            for (int ct = 0; ct < 4; ++ct) { y[ct] = mm_tile<2>(RT + 16 * wave * LP + o72, S0b + 16 * ct * LP + o72, (f32x4){0.f, 0.f, 0.f, 0.f}); y[ct] = mm_tile<2>(BkT + 16 * wave * LP + o72, Vt + 16 * ct * LP + o72, y[ct]); }
        } else {
#pragma unroll
            for (int jt = 0; jt < 4; ++jt) { const float gc = GCv[16 * jt + lc]; sacc[jt] = mm_tile<2>(Vt + 16 * (wave - 4) * LP + o72, KHgt + 16 * jt * LP + o72, sacc[jt] * gc); }
        }
        WG_BAR_L();
        if (wave < 4) {
#pragma unroll
            for (int ct = 0; ct < 4; ++ct) y[ct] = mm_tile<2>(BbTn + 16 * wave * LP + o72, Ut + 16 * ct * LP + o72, y[ct]);
#pragma unroll
            for (int r = 0; r < 4; ++r) { const int t = 16 * wave + 4 * q4 + r; const size_t row = m0 + 64 * c + t;
                float s = 0.f;
#pragma unroll
                for (int ct = 0; ct < 4; ++ct) s += y[ct][r];
                const float mean = sum16(s) * (1.0f / 64.0f); float qv = 0.f;
#pragma unroll
                for (int ct = 0; ct < 4; ++ct) { const float dd = y[ct][r] - mean; qv += dd * dd; }
                const float rstd = 1.0f / sqrtf(sum16(qv) * (1.0f / 64.0f) + GN_EPS);
                const float bon = bonv[t]; bf16* orow = mixed + row * DM + 256 + h * 64 + lc;
#pragma unroll
                for (int ct = 0; ct < 4; ++ct) orow[16 * ct] = f2bf16(((y[ct][r] - mean) * rstd * gain4[ct] + bon * bf2f(Vr[t * LP + 16 * ct + lc])) * bf2f(Gr[t * LP + 16 * ct + lc])); }
        } else {
#pragma unroll
            for (int jt = 0; jt < 4; ++jt) { sacc[jt] = mm_tile<2>(Ut + 16 * (wave - 4) * LP + o72, BHgtn + 16 * jt * LP + o72, sacc[jt]);
#pragma unroll
                for (int r = 0; r < 4; ++r) S0b[(16 * (wave - 4) + 4 * q4 + r) * LP + 16 * jt + lc] = f2bf16(sacc[jt][r]); }
        }
        WG_BAR_L();
    }
    if (hs_out) {
        if (wave >= 4) {
#pragma unroll
            for (int jt = 0; jt < 4; ++jt)
#pragma unroll
                for (int r = 0; r < 4; ++r) __hip_atomic_store(hs_out + ((wave - 4) * 4 + jt) * 256 + r * 64 + lane0, sacc[jt][r], __ATOMIC_RELAXED, __HIP_MEMORY_SCOPE_AGENT);
        }
        WG_BAR();
        if (wave == 4 && lane0 == 0) __hip_atomic_store(flag_out, 1u, __ATOMIC_RELAXED, __HIP_MEMORY_SCOPE_AGENT);
    }
#undef RWKV_LOAD
}

struct Args { const float* in[25]; float* out; unsigned char* ws; int ph_lo, ph_hi, li, pad; };
typedef const __attribute__((address_space(4))) Args* KArgs;
__device__ __forceinline__ KArgs kargs() { KArgs p = (KArgs)__builtin_amdgcn_kernarg_segment_ptr(); asm volatile("" : "+s"(p)); return p; }
#ifndef DBG_MASK
#define DBG_MASK 0xFFFF
#endif
#define EN(bit) ((DBG_MASK >> (bit)) & 1)
#ifndef PROBE_DUP
#define PROBE_DUP 0
#endif
#define REP(bit) for (int rep_ = 0; rep_ < (((PROBE_DUP >> (bit)) & 1) ? 2 : 1); ++rep_)
__global__ void __launch_bounds__(NWAVES * 64, 2) mk_fwd(Args args_unused) {
    extern __shared__ __attribute__((aligned(16))) unsigned char lds_raw[];
    LAS unsigned char* lds = (LAS unsigned char*)lds_raw;
    volatile LAS unsigned* MISC = (volatile LAS unsigned*)(lds + MISC_OFF);
    const int wave = __builtin_amdgcn_readfirstlane((int)threadIdx.x >> 6);
    const int G = gridDim.x, gw = blockIdx.x * NWAVES + wave, ngw = G * NWAVES;
    for (int u = threadIdx.x; u < (LDS_BYTES - LDSCTL_OFF) / 4; u += NWAVES * 64) ((LAS unsigned*)(lds + LDSCTL_OFF))[u] = 0u;
    __syncthreads();
    XcdBarrier bar; int lo, hi;
    { KArgs A = kargs(); bar = xcd_barrier_post((unsigned*)(A->ws + WS_CTL) + CW_BAR + (MK_PER_PHASE ? 0 : A->li) * XCD_BAR_WORDS, MISC + 8); lo = A->ph_lo; hi = A->ph_hi; }
#define IN(k) (lo <= (k) && (k) < hi)
#define SEAM(k) do { if (IN(k) && IN((k) + 1)) xcd_barrier(bar); } while (0)
#define LANE_TID() int wave_o = wave, gw_o = gw; asm volatile("" : "+s"(wave_o), "+s"(gw_o)); (void)gw_o; const int lane_o = lane_id_opq(), tid_o = wave_o * 64 + lane_o; (void)tid_o

    if (EN(0) && IN(0)) {
        KArgs A = kargs(); unsigned char* ws = A->ws; LANE_TID();
        p0_mod(A->in[1], A->in[2], A->in[3], (float*)(ws + WS_MOD), lds, tid_o, lane_o, wave_o);
        p0_weights(A->in[6], A->in[21], A->in[22], A->in[23], A->in[10], A->in[12], A->in[13], ws, lds, gw_o, ngw, wave_o, lane_o);
    }
    SEAM(0);
#pragma unroll 1
    for (int l = 0; l < NL; ++l) {
        const int pb = 1 + 8 * l;
        REP(2) if (EN(1) && IN(pb + 0)) { KArgs A = kargs(); unsigned char* ws = A->ws; LANE_TID();
            norm_mod_phase(l == 0 ? A->in[0] : A->out, A->in[4] + l * DM, (const float*)(ws + WS_MOD) + (size_t)l * NB * MODP, 0, DM, (bf16*)(ws + WS_H), gw_o, ngw, lane_o); }
        SEAM(pb + 0);
        REP(3) if (EN(2) && IN(pb + 1)) { KArgs A = kargs(); unsigned char* ws = A->ws; LANE_TID();
            pg8::Gemm g{(const bf16*)(ws + WS_H), (const bf16*)(ws + WS_WIN) + (size_t)l * NPI * DM, MT, NPI, DM}; pg8::StaticOrder S; S.init(MT, NPI, G, (int)blockIdx.x);
            pg8::EpiBf16Plain E{(bf16*)(ws + WS_PROJ), NPI};
            pg8::gemm_phase<pg8::EpiBf16Plain, pg8::StaticOrder, true, true>(lds, g, S, E, wave_o);
        }
        SEAM(pb + 1);
        REP(1) if (EN(3) && IN(pb + 2)) { KArgs A = kargs(); unsigned char* ws = A->ws; LANE_TID();
            rwkv_prep_mfma((const bf16*)(ws + WS_PROJ), A->in[8] + l * RWKV_IN, A->in[9] + l * 384, A->in[11] + l * 384, (const bf16*)(ws + WS_WL) + (size_t)l * 384 * 256,
                           (float*)(ws + WS_DEC), (bf16*)(ws + WS_AA), (bf16*)(ws + WS_GG), lds, wave_o); }
        SEAM(pb + 2);
        REP(0) if (EN(4) && IN(pb + 3)) { KArgs A = kargs(); unsigned char* ws = A->ws; LANE_TID();
            const float* gn = A->in[7] + l * DM; const bf16* PROJ = (const bf16*)(ws + WS_PROJ); bf16* Hb = (bf16*)(ws + WS_H);
            int u = (int)blockIdx.x; asm volatile("" : "+s"(u));
            float* HS = (float*)(ws + WS_HS) + (size_t)l * 64 * 4096; unsigned* FL = (unsigned*)(ws + WS_CTL) + CW_FLAG + l * 64 * 64;
            const float* DECp = (const float*)(ws + WS_DEC); const bf16* AAp = (const bf16*)(ws + WS_AA); const bf16* GGp = (const bf16*)(ws + WS_GG);
            if (u < 128) {
                mlstm_unit(u >> 2, u & 3, PROJ, A->in[17] + (size_t)l * 4 * 768, A->in[18] + l * 768, A->in[19] + l * 4, A->in[20] + l * 4, gn, Hb, lds, wave_o, lane_o);
            } else {
                const int v0 = u - 128, k = v0 & 63; const bool dgrp = v0 >= 64;
#pragma unroll 1
                for (int rep = 0; rep < 2; ++rep) { const bool half = (rep == 0) == dgrp; const int q = half ? 128 + k : v0;
                    const int cb = (half && !dgrp) ? 16 : 0, ce = (half && dgrp) ? 16 : 32;
                    rwkv_unit(q / 6, q % 6, PROJ, DECp, AAp, GGp, A->in[8] + l * RWKV_IN, A->in[14] + l * 384, A->in[15] + l * 384, A->in[16] + l * 384, gn, Hb, lds, wave_o, lane_o,
                              cb, ce, (half && !dgrp) ? HS + (size_t)k * 4096 : nullptr, (half && !dgrp) ? FL + k * 64 : nullptr, (half && dgrp) ? HS + (size_t)k * 4096 : nullptr, (half && dgrp) ? FL + k * 64 : nullptr); }
                ret_unit(v0 >> 2, v0 & 3, PROJ, gn, Hb, lds, wave_o, lane_o);
            }
        }
        SEAM(pb + 3);
        if (EN(6) && IN(pb + 4)) { KArgs A = kargs(); unsigned char* ws = A->ws; LANE_TID();
            pg8::Gemm g{(const bf16*)(ws + WS_H), (const bf16*)(ws + WS_WOUT) + (size_t)l * DM * DM, MT, DM, DM}; pg8::StaticOrder S; S.init(MT, DM, G, (int)blockIdx.x);
            pg8::EpiResGate E{l == 0 ? A->in[0] : A->out, A->out, DM, (const float*)(ws + WS_MOD) + (size_t)l * NB * MODP + 2 * DM, MODP};
            pg8::gemm_phase<pg8::EpiResGate, pg8::StaticOrder, true, true>(lds, g, S, E, wave_o);
        }
        SEAM(pb + 4);
        REP(2) if (EN(1) && IN(pb + 5)) { KArgs A = kargs(); unsigned char* ws = A->ws; LANE_TID();
            norm_mod_phase(A->out, A->in[5] + l * DM, (const float*)(ws + WS_MOD) + (size_t)l * NB * MODP, 3 * DM, 4 * DM, (bf16*)(ws + WS_H), gw_o, ngw, lane_o); }
        SEAM(pb + 5);
        REP(4) if (EN(7) && IN(pb + 6)) { KArgs A = kargs(); unsigned char* ws = A->ws; LANE_TID();
            pg8::Gemm g{(const bf16*)(ws + WS_H), (const bf16*)(ws + WS_WF1) + (size_t)l * NF1 * DM, MT, NF1, DM}; pg8::StaticOrder S; S.init(MT, NF1, G, (int)blockIdx.x);
            pg8::EpiSwiGLU E{(bf16*)(ws + WS_PROJ), DFF};
            pg8::gemm_phase<pg8::EpiSwiGLU, pg8::StaticOrder, true, true>(lds, g, S, E, wave_o);
        }
        SEAM(pb + 6);
        if (EN(8) && IN(pb + 7)) { KArgs A = kargs(); unsigned char* ws = A->ws; LANE_TID();
            pg8::Gemm g{(const bf16*)(ws + WS_PROJ), (const bf16*)(ws + WS_WF2) + (size_t)l * DM * DFF, MT, DM, DFF}; pg8::StaticOrder S; S.init(MT, DM, G, (int)blockIdx.x);
            pg8::EpiResGate E{A->out, A->out, DM, (const float*)(ws + WS_MOD) + (size_t)l * NB * MODP + 5 * DM, MODP};
            pg8::gemm_phase<pg8::EpiResGate, pg8::StaticOrder, true, true>(lds, g, S, E, wave_o);
        }
        SEAM(pb + 7);
    }
    if (EN(9) && IN(N_PHASES - 1)) { KArgs A = kargs(); int gw_o = gw; asm volatile("" : "+s"(gw_o)); final_norm_phase(A->out, A->in[24], gw_o, ngw, lane_id_opq()); }
#undef IN
#undef SEAM
}

extern "C" void kernel_launch(void* const* d_in, const int* in_sizes, int n_in, void* d_out, int out_size, void* d_ws, size_t ws_size, hipStream_t stream) {
    static int grid = 0;
    if (grid == 0) {
        if (n_in != 25 || in_sizes[0] != MT * DM || out_size != MT * DM || ws_size < WS_END) { fprintf(stderr, "kernel_launch: shape/workspace mismatch (n_in %d, in0 %d, out %d, ws %zu)\n", n_in, n_in > 0 ? in_sizes[0] : -1, out_size, ws_size); grid = -1; return; }
        int dev = 0, cus = 0, per_cu = 0;
        if (hipGetDevice(&dev) != hipSuccess || hipDeviceGetAttribute(&cus, hipDeviceAttributeMultiprocessorCount, dev) != hipSuccess) { grid = -1; return; }
        if (hipFuncSetAttribute((const void*)mk_fwd, hipFuncAttributeMaxDynamicSharedMemorySize, LDS_BYTES) != hipSuccess) { fprintf(stderr, "kernel_launch: hipFuncSetAttribute failed\n"); grid = -1; return; }
        if (hipOccupancyMaxActiveBlocksPerMultiprocessor(&per_cu, (const void*)mk_fwd, NWAVES * 64, LDS_BYTES) != hipSuccess || per_cu < 1) { fprintf(stderr, "kernel_launch: occupancy query says %d\n", per_cu); }
        (void)hipGetLastError();
        grid = cus;
    }
    if (grid < 0) return;
    if (hipMemsetAsync((char*)d_ws + WS_CTL, 0, CTL_ZERO_BYTES, stream) != hipSuccess) return;
    Args a{};
    for (int i = 0; i < 25; ++i) a.in[i] = (const float*)d_in[i];
    a.out = (float*)d_out; a.ws = (unsigned char*)d_ws;
#if MK_PER_PHASE
    for (int p = 0; p < N_PHASES; ++p) { a.ph_lo = p; a.ph_hi = p + 1; a.li = 0; hipLaunchKernelGGL(mk_fwd, dim3(grid), dim3(NWAVES * 64), LDS_BYTES, stream, a); }
#else
    a.ph_lo = 0; a.ph_hi = N_PHASES; a.li = 0;
    hipLaunchKernelGGL(mk_fwd, dim3(grid), dim3(NWAVES * 64), LDS_BYTES, stream, a);
#endif
}
```

```cpp
#include <hip/hip_runtime.h>
#include <cstdio>
#include <cstdint>
__device__ __forceinline__ int lane_id_opq() { int l = (int)__builtin_amdgcn_mbcnt_hi(~0u, __builtin_amdgcn_mbcnt_lo(~0u, 0u)); asm volatile("" : "+v"(l)); return l; }

namespace pg8 {
#define PG8_LAS __attribute__((address_space(3)))
typedef unsigned short bf16_t;
typedef short bf16x8 __attribute__((ext_vector_type(8)));
typedef float f32x4 __attribute__((ext_vector_type(4)));
typedef unsigned u32x4 __attribute__((ext_vector_type(4)));
constexpr int BM = 256, BK = 64, HALF = 128, HTB = HALF * BK * 2  , STAGE_BYTES = 8 * HTB, NXCD = 8, WGM = 8;

__host__ __device__ __forceinline__ int lds_byte(int r, int c) { const int st = (r >> 4) * 2 + (c >> 5), rr = r & 15, cc = c & 31, ob = rr * 64 + cc * 2; return st * 1024 + (ob ^ (((ob >> 9) & 1) << 5)); }
__host__ __device__ __forceinline__ void stage_rc(int b, int& R, int& C) { const int st = b / 1024, sb = b % 1024, swz = sb ^ (((sb >> 9) & 1) << 5); R = (st >> 1) * 16 + swz / 64; C = (st & 1) * 32 + (swz % 64) / 2; }
__host__ __device__ __forceinline__ int perm32(int rho) { const int n = rho >> 4, i = rho & 15; return 8 * (i >> 2) + 4 * n + (i & 3); }

struct Unit { int pm, pn; };
struct Gemm { const bf16_t* A; const bf16_t* Bt; int M, N, K; };

struct StaticOrder {
    int nM, nN, nwg, G, c;
    __host__ __device__ void init(int M, int N, int G_, int c_) { nM = M / BM; nN = N / BM; nwg = nM * nN; G = G_; c = c_; }
    __host__ __device__ bool next(int i, Unit& u) const {
        const long L = (long)i * G + c; if (L >= nwg) return false;
        int wgid = (int)L; { const int q = nwg / NXCD, r = nwg % NXCD, xcd = wgid % NXCD, off = wgid / NXCD; wgid = (xcd < r ? xcd * (q + 1) : r * (q + 1) + (xcd - r) * q) + off; }
        const int nig = WGM * nN, gid = wgid / nig, fm = gid * WGM, gsz = (nM - fm) < WGM ? (nM - fm) : WGM;
        u.pm = fm + ((wgid % nig) % gsz); u.pn = (wgid % nig) / gsz; return true;
    }
    __device__ __forceinline__ void a_ready(const Unit&) const {}
    __device__ __forceinline__ void done(const Unit&) const {}
};

__device__ __forceinline__ unsigned cvt_pk_bf16(float lo, float hi) { unsigned r; asm volatile("v_cvt_pk_bf16_f32 %0, %1, %2" : "=v"(r) : "v"(lo), "v"(hi)); return r; }
typedef float f32x2 __attribute__((ext_vector_type(2)));

typedef float f32x2e __attribute__((ext_vector_type(2)));
typedef __bf16 bf16x2e __attribute__((ext_vector_type(2)));
__device__ __forceinline__ unsigned cvt_pk(float lo, float hi) { const f32x2e v = {lo, hi}; return __builtin_bit_cast(unsigned, __builtin_convertvector(v, bf16x2e)); }
__device__ __forceinline__ float silu_f(float x) { return x * __builtin_amdgcn_rcpf(1.0f + __expf(-x)); }
struct EpiBf16Plain {
    static constexpr bool PERM = true, AFTER_DRAIN = false;
    bf16_t* O; int ldc;
    __device__ __forceinline__ void operator()(const f32x4 (&acc)[2][2][4][2], const Unit& u, int wr, int wc, int fr, int fq) const {
        const int row0 = u.pm * BM + wr * 64 + fr, col0 = u.pn * BM + wc * 32 + 8 * fq;
#pragma unroll
        for (int ai = 0; ai < 2; ++ai)
#pragma unroll
            for (int m = 0; m < 4; ++m) { bf16_t* rowp = O + (size_t)(row0 + ai * HALF + m * 16) * ldc + col0;
#pragma unroll
                for (int bj = 0; bj < 2; ++bj) { const f32x4 v0 = acc[ai][bj][m][0], v1 = acc[ai][bj][m][1];
                    u32x4 w; w.x = cvt_pk(v0[0], v0[1]); w.y = cvt_pk(v0[2], v0[3]); w.z = cvt_pk(v1[0], v1[1]); w.w = cvt_pk(v1[2], v1[3]);
                    *(u32x4*)(rowp + bj * HALF) = w; } }
    }
};
struct EpiSwiGLU {
    static constexpr bool PERM = true, AFTER_DRAIN = false;
    bf16_t* O; int ldc;
    __device__ __forceinline__ void operator()(const f32x4 (&acc)[2][2][4][2], const Unit& u, int wr, int wc, int fr, int fq) const {
        const int row0 = u.pm * BM + wr * 64 + fr, col0 = u.pn * HALF + wc * 32 + 8 * fq;
#pragma unroll
        for (int ai = 0; ai < 2; ++ai)
#pragma unroll
            for (int m = 0; m < 4; ++m) { bf16_t* rowp = O + (size_t)(row0 + ai * HALF + m * 16) * ldc + col0;
                const f32x4 g0 = acc[ai][0][m][0], g1 = acc[ai][0][m][1], u0 = acc[ai][1][m][0], u1 = acc[ai][1][m][1];
                u32x4 w; w.x = cvt_pk(silu_f(g0[0]) * u0[0], silu_f(g0[1]) * u0[1]); w.y = cvt_pk(silu_f(g0[2]) * u0[2], silu_f(g0[3]) * u0[3]);
                w.z = cvt_pk(silu_f(g1[0]) * u1[0], silu_f(g1[1]) * u1[1]); w.w = cvt_pk(silu_f(g1[2]) * u1[2], silu_f(g1[3]) * u1[3]);
                *(u32x4*)rowp = w; }
    }
};
struct EpiResGate {
    static constexpr bool PERM = false, AFTER_DRAIN = false;
    const float* xin; float* xout; int ldc; const float* gate; int gpitch;
    __device__ __forceinline__ void operator()(const f32x4 (&acc)[2][2][4][2], const Unit& u, int wr, int wc, int fr, int fq) const {
        const int row0 = u.pm * BM + wr * 64 + fr, col0 = u.pn * BM + wc * 32 + 4 * fq;
        const float* gp = gate + (size_t)(u.pm >> 3) * gpitch + col0;
        f32x4 gv[2][2];
#pragma unroll
        for (int bj = 0; bj < 2; ++bj)
#pragma unroll
            for (int n = 0; n < 2; ++n) gv[bj][n] = *(const f32x4*)(gp + bj * HALF + n * 16);
#pragma unroll
        for (int ai = 0; ai < 2; ++ai)
#pragma unroll
            for (int m = 0; m < 4; ++m) { const size_t off = (size_t)(row0 + ai * HALF + m * 16) * ldc + col0;
#pragma unroll
                for (int bj = 0; bj < 2; ++bj)
#pragma unroll
                    for (int n = 0; n < 2; ++n) { const f32x4 xi = *(const f32x4*)(xin + off + bj * HALF + n * 16);
                        *(f32x4*)(xout + off + bj * HALF + n * 16) = xi + gv[bj][n] * acc[ai][bj][m][n]; }
                asm volatile("" ::: "memory"); }
    }
};

template <class Epi, class Sched, bool ALIGN_EPI = false, bool SP2 = false>
__device__ __forceinline__ void gemm_phase(PG8_LAS unsigned char* lds, const Gemm g, const Sched& S, const Epi& E, const int wid_in) {
    const int wid = wid_in, lane = lane_id_opq(), tid = wid * 64 + lane, wr = wid >> 2, wc = wid & 3, fr = lane & 15, fq = lane >> 4;
    const int K = g.K, nt = K / BK;
    unsigned voffA[2], voffB[2];
#pragma unroll
    for (int i = 0; i < 2; ++i) { int R, C; stage_rc(tid * 16 + i * 8192, R, C); const int Rb = Epi::PERM ? ((R & ~31) + perm32(R & 31)) : R;
        voffA[i] = (unsigned)(R * K + C) * 2u; voffB[i] = (unsigned)(Rb * K + C) * 2u; }
    const size_t kstep = (size_t)(BK * 2);
    const size_t hstep = (size_t)HALF * K * 2;
    const size_t tstep = 2 * hstep;
    const unsigned ldsw = (unsigned)wid * 1024u;
    const int aoff = lds_byte(wr * 64 + fr, fq * 8), boff = lds_byte(wc * 32 + fr, fq * 8);
#define PG8_SA(b, h) (((b) * 2 + (h)) * HTB)
#define PG8_SB(b, h) ((4 + (b) * 2 + (h)) * HTB)
#define PG8_STAGE(bufoff, gbase, voff) do { _Pragma("unroll") for (int _i = 0; _i < 2; ++_i) \
        __builtin_amdgcn_global_load_lds((const unsigned*)((const char*)(gbase) + (voff)[_i]), (PG8_LAS unsigned*)(lds + (bufoff) + ldsw + _i * 8192), 16, 0, 0); } while (0)
#define PG8_LDA(dst, b, h) do { _Pragma("unroll") for (int m = 0; m < 4; ++m) _Pragma("unroll") for (int k = 0; k < 2; ++k) dst[m][k] = *(const PG8_LAS bf16x8*)(lds + PG8_SA(b, h) + aoff + m * 2048 + k * 1024); } while (0)
#define PG8_LDB(dst, b, h) do { _Pragma("unroll") for (int n = 0; n < 2; ++n) _Pragma("unroll") for (int k = 0; k < 2; ++k) dst[n][k] = *(const PG8_LAS bf16x8*)(lds + PG8_SB(b, h) + boff + n * 2048 + k * 1024); } while (0)
#define PG8_MMA(ai, bj, At, Bt) do { __builtin_amdgcn_s_setprio(1); _Pragma("unroll") for (int m = 0; m < 4; ++m) _Pragma("unroll") for (int n = 0; n < 2; ++n) _Pragma("unroll") for (int k = 0; k < 2; ++k) \
        acc[ai][bj][m][n] = __builtin_amdgcn_mfma_f32_16x16x32_bf16(Bt[n][k], At[m][k], acc[ai][bj][m][n], 0, 0, 0); __builtin_amdgcn_s_setprio(0); } while (0)
#define PG8_WAIT_V(n) asm volatile("s_waitcnt vmcnt(" #n ")" ::: "memory")
#define PG8_WAIT_L(n) asm volatile("s_waitcnt lgkmcnt(" #n ")" ::: "memory")
#define PG8_BAR __builtin_amdgcn_s_barrier()
#define PG8_SCHED __builtin_amdgcn_sched_barrier(0)
    Unit cur, nxt; int ui = 0;
    if (!S.next(0, cur)) return;
    f32x4 acc[2][2][4][2];
#pragma unroll
    for (int a = 0; a < 2; ++a)
#pragma unroll
        for (int b = 0; b < 2; ++b)
#pragma unroll
            for (int m = 0; m < 4; ++m)
#pragma unroll
                for (int n = 0; n < 2; ++n) acc[a][b][m][n] = (f32x4){0.f, 0.f, 0.f, 0.f};
    bf16x8 At[4][2], B0[2][2], B1[2][2];
    const char* cA = (const char*)g.A + (size_t)cur.pm * tstep; const char* cB = (const char*)g.Bt + (size_t)cur.pn * tstep;
    S.a_ready(cur);
    if constexpr (SP2) {
        PG8_STAGE(PG8_SB(0, 0), cB, voffB); PG8_STAGE(PG8_SB(0, 1), cB + hstep, voffB); PG8_STAGE(PG8_SA(0, 0), cA, voffA); PG8_STAGE(PG8_SA(0, 1), cA + hstep, voffA);
        if (wr == 1) PG8_BAR;
        PG8_WAIT_V(2); PG8_BAR;
        PG8_STAGE(PG8_SB(1, 0), cB + kstep, voffB); PG8_STAGE(PG8_SA(1, 0), cA + kstep, voffA); PG8_STAGE(PG8_SB(1, 1), cB + hstep + kstep, voffB);
        PG8_WAIT_V(6); PG8_BAR;
    } else {
        PG8_STAGE(PG8_SB(0, 0), cB, voffB); PG8_STAGE(PG8_SA(0, 0), cA, voffA); PG8_STAGE(PG8_SB(0, 1), cB + hstep, voffB); PG8_STAGE(PG8_SA(0, 1), cA + hstep, voffA);
        if (wr == 1) PG8_BAR;
        PG8_WAIT_V(4); PG8_BAR;
        PG8_STAGE(PG8_SB(1, 0), cB + kstep, voffB); PG8_STAGE(PG8_SA(1, 0), cA + kstep, voffA); PG8_STAGE(PG8_SB(1, 1), cB + hstep + kstep, voffB);
        PG8_WAIT_V(6); PG8_BAR;
    }
    for (;;) {
        const bool has_next = S.next(ui + 1, nxt);
        const char* nA = has_next ? (const char*)g.A + (size_t)nxt.pm * tstep : cA; const char* nB = has_next ? (const char*)g.Bt + (size_t)nxt.pn * tstep : cB;
        for (int t = 0; t < nt; t += 2) {
            const bool last = (t == nt - 2);
            const char* a1 = cA + (size_t)(t + 1) * kstep;
            const char* a2 = last ? nA : cA + (size_t)(t + 2) * kstep; const char* b2 = last ? nB : cB + (size_t)(t + 2) * kstep;
            const char* a3 = a2 + kstep; const char* b3 = b2 + kstep;
            if (last && has_next) S.a_ready(nxt);
            if constexpr (SP2) {
            PG8_LDB(B0, 0, 0); PG8_LDB(B1, 0, 1); PG8_SCHED; PG8_LDA(At, 0, 0); PG8_STAGE(PG8_SA(1, 1), a1 + hstep, voffA);
            PG8_WAIT_V(8); PG8_WAIT_L(0); PG8_BAR; PG8_MMA(0, 0, At, B0); PG8_MMA(0, 1, At, B1); PG8_BAR; PG8_SCHED;
            PG8_LDA(At, 0, 1); PG8_STAGE(PG8_SB(0, 0), b2, voffB); PG8_STAGE(PG8_SB(0, 1), b2 + hstep, voffB); PG8_STAGE(PG8_SA(0, 0), a2, voffA);
            PG8_WAIT_V(8); PG8_WAIT_L(0); PG8_BAR; PG8_MMA(1, 0, At, B0); PG8_MMA(1, 1, At, B1); PG8_BAR; PG8_SCHED;
            PG8_LDB(B0, 1, 0); PG8_LDB(B1, 1, 1); PG8_SCHED; PG8_LDA(At, 1, 0); PG8_STAGE(PG8_SA(0, 1), a2 + hstep, voffA);
            PG8_WAIT_V(8); PG8_WAIT_L(0); PG8_BAR; PG8_MMA(0, 0, At, B0); PG8_MMA(0, 1, At, B1); PG8_BAR; PG8_SCHED;
            PG8_LDA(At, 1, 1); PG8_STAGE(PG8_SB(1, 0), b3, voffB); PG8_STAGE(PG8_SB(1, 1), b3 + hstep, voffB); PG8_STAGE(PG8_SA(1, 0), a3, voffA);
            PG8_WAIT_V(8); PG8_WAIT_L(0); PG8_BAR; PG8_MMA(1, 0, At, B0); PG8_MMA(1, 1, At, B1); PG8_BAR; PG8_SCHED;
            } else {
            PG8_LDB(B0, 0, 0); PG8_SCHED; PG8_LDA(At, 0, 0); PG8_STAGE(PG8_SA(1, 1), a1 + hstep, voffA);
            PG8_WAIT_L(8); PG8_BAR; PG8_WAIT_L(0); PG8_MMA(0, 0, At, B0); PG8_BAR; PG8_SCHED;
            PG8_LDB(B1, 0, 1); PG8_STAGE(PG8_SB(0, 0), b2, voffB);
            PG8_BAR; PG8_WAIT_L(0); PG8_MMA(0, 1, At, B1); PG8_BAR;
            PG8_LDA(At, 0, 1); PG8_STAGE(PG8_SA(0, 0), a2, voffA);
            PG8_BAR; PG8_WAIT_L(0); PG8_MMA(1, 0, At, B0); PG8_BAR; PG8_SCHED;
            PG8_STAGE(PG8_SB(0, 1), b2 + hstep, voffB);
            PG8_WAIT_V(6); PG8_BAR; PG8_MMA(1, 1, At, B1); PG8_BAR;
            PG8_LDB(B0, 1, 0); PG8_SCHED; PG8_LDA(At, 1, 0); PG8_STAGE(PG8_SA(0, 1), a2 + hstep, voffA);
            PG8_WAIT_L(8); PG8_BAR; PG8_WAIT_L(0); PG8_MMA(0, 0, At, B0); PG8_BAR; PG8_SCHED;
            PG8_LDB(B1, 1, 1); PG8_STAGE(PG8_SB(1, 0), b3, voffB);
            PG8_BAR; PG8_WAIT_L(0); PG8_MMA(0, 1, At, B1); PG8_BAR;
            PG8_LDA(At, 1, 1); PG8_STAGE(PG8_SA(1, 0), a3, voffA);
            PG8_BAR; PG8_WAIT_L(0); PG8_MMA(1, 0, At, B0); PG8_BAR; PG8_SCHED;
            PG8_STAGE(PG8_SB(1, 1), b3 + hstep, voffB);
            PG8_WAIT_V(6); PG8_BAR; PG8_MMA(1, 1, At, B1); PG8_BAR;
            }
        }
        if constexpr (ALIGN_EPI) { if (wr == 0) PG8_BAR; }
        if constexpr (!Epi::AFTER_DRAIN) { E(acc, cur, wr, wc, fr, fq); S.done(cur); }
        if (!has_next) break;
#pragma unroll
        for (int a = 0; a < 2; ++a)
#pragma unroll
            for (int b = 0; b < 2; ++b)
#pragma unroll
                for (int m = 0; m < 4; ++m)
#pragma unroll
                    for (int n = 0; n < 2; ++n) acc[a][b][m][n] = (f32x4){0.f, 0.f, 0.f, 0.f};
        cur = nxt; cA = nA; cB = nB; ++ui;
        if constexpr (ALIGN_EPI) { if (wr == 1) PG8_BAR; }
    }
    PG8_WAIT_V(0);
    if constexpr (!ALIGN_EPI) { if (wr == 0) PG8_BAR; }
    PG8_BAR;
    if constexpr (Epi::AFTER_DRAIN) { E.fused(acc, cur, wr, wc, fr, fq, lds, wid, lane); S.done(cur); }
#undef PG8_SA
#undef PG8_SB
#undef PG8_STAGE
#undef PG8_LDA
#undef PG8_LDB
#undef PG8_MMA
#undef PG8_WAIT_V
#undef PG8_WAIT_L
#undef PG8_BAR
#undef PG8_SCHED
}
}

#ifndef MK_PER_PHASE
#define MK_PER_PHASE 0
#endif
constexpr int NWAVES = 8;
constexpr int DM = 1024, NB = 32, SEQ = 2048, NL = 4, MT = NB * SEQ;
constexpr int D_IN = 3976, NPI = 4096, DFF = 2816, NF1 = 2 * DFF;
constexpr int RW_B = 1024, ML_B = 2432;
constexpr int RWKV_IN = 1408;
constexpr float RMS_EPS = 1e-6f, GN_EPS = 1e-5f;
constexpr int MODP = 6 * DM;
constexpr size_t MiB = 1u << 20;
constexpr size_t WS_CTL = 0, CTL_ZERO_BYTES = 1 * MiB;
constexpr size_t WS_HS = 116 * MiB;
constexpr int CW_FLAG = 16384;
constexpr size_t WS_WL = 5 * MiB;
constexpr size_t WS_MOD = 1 * MiB;
constexpr size_t WS_WIN = 8 * MiB, WS_WOUT = 40 * MiB, WS_WF1 = 48 * MiB, WS_WF2 = 92 * MiB;
constexpr size_t WS_H = 128 * MiB;
constexpr size_t WS_PROJ = 256 * MiB;
constexpr size_t WS_DEC = 768 * MiB, WS_AA = 864 * MiB, WS_GG = 912 * MiB;
constexpr size_t WS_END = 960 * MiB;
constexpr int CW_BAR = 4096;
constexpr int N_PHASES = 2 + 8 * NL;
static_assert((CW_BAR + (MK_PER_PHASE ? 1 : 1) * 3456) * 4 <= (int)CTL_ZERO_BYTES, "ctl");
constexpr int RING_BYTES = 131072, LDS_BYTES = 163840, LDSCTL_OFF = LDS_BYTES - 1024, MISC_OFF = LDSCTL_OFF + 320;

#define GAS __attribute__((address_space(1)))
#define LAS __attribute__((address_space(3)))
typedef unsigned short bf16;
typedef unsigned v4u __attribute__((ext_vector_type(4)));
typedef unsigned v2u __attribute__((ext_vector_type(2)));
typedef float f32x4 __attribute__((ext_vector_type(4)));
#define LDS_WAIT() asm volatile("s_waitcnt lgkmcnt(0)" ::: "memory")
typedef float f32x2c __attribute__((ext_vector_type(2)));
typedef __bf16 bf16x2c __attribute__((ext_vector_type(2)));
__device__ __forceinline__ unsigned f2bf(float f) { return (__builtin_bit_cast(unsigned, f) + 0x8000u) >> 16; }
__device__ __forceinline__ unsigned pk2(float lo, float hi) { return __builtin_amdgcn_perm(__builtin_bit_cast(unsigned, hi) + 0x8000u, __builtin_bit_cast(unsigned, lo) + 0x8000u, 0x07060302u); }
__device__ __forceinline__ float bf2f(bf16 v) { return __uint_as_float(((unsigned)v) << 16); }
template <int CTRL, int ROWMASK> __device__ __forceinline__ float dppf(float v) { return __builtin_bit_cast(float, __builtin_amdgcn_update_dpp(0, __builtin_bit_cast(int, v), CTRL, ROWMASK, 0xf, false)); }
__device__ __forceinline__ float sum16(float v) { v += dppf<0xB1, 0xf>(v); v += dppf<0x4E, 0xf>(v); v += dppf<0x141, 0xf>(v); v += dppf<0x140, 0xf>(v); return v; }
__device__ __forceinline__ float wave_sum(float v) { v = sum16(v); v += dppf<0x142, 0xa>(v); v += dppf<0x143, 0xc>(v); return __builtin_bit_cast(float, __builtin_amdgcn_readlane(__builtin_bit_cast(int, v), 63)); }
template <int CTRL, int ROWMASK> __device__ __forceinline__ float dppo(float v, float old) { return __builtin_bit_cast(float, __builtin_amdgcn_update_dpp(__builtin_bit_cast(int, old), __builtin_bit_cast(int, v), CTRL, ROWMASK, 0xf, false)); }
__device__ __forceinline__ float wave_prefix_sum(float v) { v += dppo<0x111, 0xf>(v, 0.f); v += dppo<0x112, 0xf>(v, 0.f); v += dppo<0x114, 0xf>(v, 0.f); v += dppo<0x118, 0xf>(v, 0.f); v += dppo<0x142, 0xa>(v, 0.f); v += dppo<0x143, 0xc>(v, 0.f); return v; }
__device__ __forceinline__ float wave_prefix_max(float v) { const float ni = -__builtin_inff(); v = fmaxf(v, dppo<0x111, 0xf>(v, ni)); v = fmaxf(v, dppo<0x112, 0xf>(v, ni)); v = fmaxf(v, dppo<0x114, 0xf>(v, ni)); v = fmaxf(v, dppo<0x118, 0xf>(v, ni));
    v = fmaxf(v, dppo<0x142, 0xa>(v, ni)); v = fmaxf(v, dppo<0x143, 0xc>(v, ni)); return v; }
__device__ __forceinline__ float flogsigmoid(float x) { return fminf(x, 0.f) - __logf(1.0f + __expf(-fabsf(x))); }
__device__ __forceinline__ float fexp(float x) { return __expf(x); }
__device__ __forceinline__ float fsigmoid(float x) { return __builtin_amdgcn_rcpf(1.0f + __expf(-x)); }
__device__ __forceinline__ float sigmoid_f(float x) { return 1.0f / (1.0f + expf(-x)); }
__device__ __forceinline__ float logsigmoid_f(float x) { return fminf(x, 0.f) - log1pf(expf(-fabsf(x))); }
template <class T> __device__ __forceinline__ T* opq(T* p) { asm volatile("" : "+s"(p)); return p; }

#define XB_TMO      128
#define XB_XCNT(j)  (256  + 64 * (j))
#define XB_XSUB(j)  (1280 + 64 * (j))
#define XB_XGEN(j)  (2304 + 64 * (j))
#define XB_TOP      3328
#define XB_TOPGEN   3392
#define XCD_BAR_WORDS 3456
#define XB_SPIN_CAP (1u << 22)

__device__ __forceinline__ unsigned xb_ld(unsigned* p)              { return __hip_atomic_load(p, __ATOMIC_RELAXED, __HIP_MEMORY_SCOPE_AGENT); }
__device__ __forceinline__ unsigned xb_add(unsigned* p, unsigned v) { return __hip_atomic_fetch_add(p, v, __ATOMIC_RELAXED, __HIP_MEMORY_SCOPE_AGENT); }
__device__ __forceinline__ unsigned xb_xcc_id() { return (unsigned)__builtin_amdgcn_s_getreg((3 << 11) | 20) & 0xFu; }
#define XB_SPIN(cond, bar) do { unsigned _sp = 0; while (cond) { __builtin_amdgcn_s_sleep(1); \
    if ((++_sp & 255u) == 0u) { if (xb_ld(&(bar)[XB_TMO])) break; if (_sp > XB_SPIN_CAP) { atomicAdd(&(bar)[XB_TMO], 1u); break; } } } } while (0)

struct XcdBarrier {
    unsigned* bar; unsigned x; unsigned w0;
    volatile LAS unsigned* st;
};

__device__ __forceinline__ XcdBarrier xcd_barrier_post(unsigned* bar, volatile LAS unsigned* st) {
    XcdBarrier b; b.bar = bar; b.x = xb_xcc_id(); b.st = st; b.w0 = (__builtin_amdgcn_readfirstlane((int)threadIdx.x >> 6) == 0) ? 1u : 0u;
    if (threadIdx.x == 0) (void)xb_add(&bar[XB_XCNT(b.x)], 1u);
    return b;
}
__device__ __forceinline__ void xcd_barrier_complete(unsigned* bar, unsigned x, unsigned& nloc, unsigned& nx) {
    const unsigned G = gridDim.x * gridDim.y * gridDim.z;
    unsigned sum, cnt, mine, sp = 0u;
    for (;;) {
        sum = 0u; cnt = 0u; mine = 0u;
#pragma unroll
        for (unsigned j = 0; j < 16; ++j) { const unsigned c = xb_ld(&bar[XB_XCNT(j)]); sum += c; cnt += (c > 0u) ? 1u : 0u; mine = (j == x) ? c : mine; }
        if (sum == G) break;
        __builtin_amdgcn_s_sleep(1);
        if ((++sp & 255u) == 0u) { if (xb_ld(&bar[XB_TMO])) break; if (sp > XB_SPIN_CAP) { atomicAdd(&bar[XB_TMO], 1u); break; } }
    }
    nloc = mine > 0u ? mine : 1u; nx = cnt > 0u ? cnt : 1u;
}

__device__ __forceinline__ void xcd_barrier(const XcdBarrier& b) {
    asm volatile("s_waitcnt vmcnt(0)" ::: "memory");
    __syncthreads();
    if (b.w0 != 0u && lane_id_opq() == 0) {
        unsigned* bar = b.bar;
        __builtin_amdgcn_s_waitcnt(0);
        unsigned nloc = b.st[0], nx = b.st[1];
        if (nloc == 0u) { xcd_barrier_complete(bar, b.x, nloc, nx); b.st[0] = nloc; b.st[1] = nx; }
        const unsigned old = xb_add(&bar[XB_XSUB(b.x)], 1u);
        const unsigned gen = old / nloc;
        if (old + 1u == (gen + 1u) * nloc) {
            __builtin_amdgcn_fence(__ATOMIC_RELEASE, "agent");
            asm volatile("s_waitcnt vmcnt(0)" ::: "memory");
            const unsigned og = xb_add(&bar[XB_TOP], 1u);
            const unsigned tg = og / nx;
            if (og + 1u == (tg + 1u) * nx) xb_add(&bar[XB_TOPGEN], 1u);
            else XB_SPIN(xb_ld(&bar[XB_TOPGEN]) == tg, bar);
            __builtin_amdgcn_fence(__ATOMIC_ACQUIRE, "agent");
            xb_add(&bar[XB_XGEN(b.x)], 1u);
            asm volatile("s_waitcnt vmcnt(0)" ::: "memory");
        } else {
            XB_SPIN(xb_ld(&bar[XB_XGEN(b.x)]) == gen, bar);
            __builtin_amdgcn_fence(__ATOMIC_ACQUIRE, "agent");
            asm volatile("s_waitcnt vmcnt(0)" ::: "memory");
        }
    }
    __syncthreads();
}


__device__ __forceinline__ void b32_gemv(const float* Wcol  , bool ok, int N, LAS float* vT, float (&res)[4], int wave, int lane) {
    float acc[32];
#pragma unroll
    for (int b = 0; b < 32; ++b) acc[b] = 0.f;
    const float* wp = Wcol + (size_t)(128 * wave) * N; const LAS float* vp = vT + 128 * wave * 32;
#pragma unroll 1
    for (int kk = 0; kk < 128; kk += 8) {
        float w[8];
#pragma unroll
        for (int u = 0; u < 8; ++u) w[u] = ok ? wp[(size_t)u * N] : 0.f;
        wp += (size_t)8 * N;
#pragma unroll
        for (int u = 0; u < 8; ++u) {
#pragma unroll
            for (int b4 = 0; b4 < 8; ++b4) { const f32x4 cv = *(const LAS f32x4*)(vp + u * 32 + 4 * b4);
                acc[4 * b4] += cv.x * w[u]; acc[4 * b4 + 1] += cv.y * w[u]; acc[4 * b4 + 2] += cv.z * w[u]; acc[4 * b4 + 3] += cv.w * w[u]; }
            asm volatile("" ::: "memory"); }
        vp += 8 * 32;
    }
    __syncthreads();
#pragma unroll
    for (int b = 0; b < 32; ++b) vT[(wave * 32 + b) * 64 + lane] = acc[b];
    __syncthreads();
#pragma unroll
    for (int q = 0; q < 4; ++q) { float s = 0.f;
#pragma unroll
        for (int w2 = 0; w2 < 8; ++w2) s += vT[(w2 * 32 + 4 * wave + q) * 64 + lane];
        res[q] = s; }
    __syncthreads();
}
__device__ __forceinline__ void p0_mod(const float* c, const float* ada_w, const float* ada_b, float* mod, LAS unsigned char* lds, int tid, int lane, int wave) {
    LAS float* condT = (LAS float*)lds;
    for (int item = blockIdx.x; item < NL * 96; item += gridDim.x) {
        __syncthreads();
        for (int e = tid; e < NB * DM; e += NWAVES * 64) { const int k = e >> 5, b = e & 31; const float v = c[b * DM + k]; condT[e] = v / (1.0f + expf(-v)); }
        __syncthreads();
        const int l = item / 96, g = item % 96, n = g * 64 + lane;
        float res[4]; b32_gemv(ada_w + (size_t)l * DM * MODP + n, true, MODP, condT, res, wave, lane);
        const float bb = ada_b[l * MODP + n]; float* o = mod + ((size_t)l * NB + wave * 4) * MODP + n;
        o[0] = res[0] + bb; o[MODP] = res[1] + bb; o[2 * MODP] = res[2] + bb; o[3 * MODP] = res[3] + bb;
    }
    __syncthreads();
}
template <int MODE>
__device__ __forceinline__ void transpose_item(const float* W, int K, int N, int nblk, bf16* WT, int ldw, LAS float* scr, int item, int lane) {
    const int kb = item / nblk, nb = item % nblk, k0 = 64 * kb, n0 = 32 * nb;
    const int nn = n0 + (lane & 31); const bool ok = nn < N;
#pragma unroll 8
    for (int i = 0; i < 32; ++i) { const int kk = 2 * i + (lane >> 5); scr[kk * 33 + (lane & 31)] = ok ? W[(size_t)(k0 + kk) * N + nn] : 0.f; }
    LDS_WAIT();
    const int c = lane & 7;
#pragma unroll
    for (int j = 0; j < 4; ++j) { const int n = (lane >> 3) + 8 * j; const LAS float* s = scr + (8 * c) * 33 + n;
        v4u o; o.x = pk2(s[0 * 33], s[1 * 33]); o.y = pk2(s[2 * 33], s[3 * 33]); o.z = pk2(s[4 * 33], s[5 * 33]); o.w = pk2(s[6 * 33], s[7 * 33]);
        int row = n0 + n;
        if (MODE == 1) { const int up = row >= DFF ? 1 : 0, jj = row - up * DFF; row = (jj >> 7) * 256 + up * 128 + (jj & 127); }
        *(v4u*)(WT + (size_t)row * ldw + k0 + 8 * c) = o; }
    LDS_WAIT();
}
__device__ __forceinline__ void p0_weights(const float* w_in, const float* w_out, const float* f1, const float* f2, const float* lw2, const float* la2, const float* lg2, unsigned char* ws, LAS unsigned char* lds, int gw, int ngw, int wave, int lane) {
    LAS float* scr = (LAS float*)(lds + wave * 16384);
    constexpr int I_IN = (DM / 64) * (NPI / 32), I_OUT = (DM / 64) * (DM / 32), I_F1 = (DM / 64) * (NF1 / 32), I_F2 = (DFF / 64) * (DM / 32), I_L = I_IN + I_OUT + I_F1 + I_F2 + 48;
    for (int it = gw; it < NL * I_L; it += ngw) {
        const int l = it / I_L; int r = it % I_L;
        if (r < I_IN) { transpose_item<0>(w_in + (size_t)l * DM * D_IN, DM, D_IN, NPI / 32, (bf16*)(ws + WS_WIN) + (size_t)l * NPI * DM, DM, scr, r, lane); continue; } r -= I_IN;
        if (r < I_OUT) { transpose_item<0>(w_out + (size_t)l * DM * DM, DM, DM, DM / 32, (bf16*)(ws + WS_WOUT) + (size_t)l * DM * DM, DM, scr, r, lane); continue; } r -= I_OUT;
        if (r < I_F1) { transpose_item<1>(f1 + (size_t)l * DM * NF1, DM, NF1, NF1 / 32, (bf16*)(ws + WS_WF1) + (size_t)l * NF1 * DM, DM, scr, r, lane); continue; } r -= I_F1;
        if (r < I_F2) { transpose_item<0>(f2 + (size_t)l * DFF * DM, DFF, DM, DM / 32, (bf16*)(ws + WS_WF2) + (size_t)l * DM * DFF, DFF, scr, r, lane); continue; } r -= I_F2;
        bf16* wl = (bf16*)(ws + WS_WL) + (size_t)l * 384 * 256;
        if (r < 12) { transpose_item<0>(lw2 + (size_t)l * 64 * 384, 64, 384, 12, wl, 256, scr, r, lane); continue; } r -= 12;
        if (r < 12) { transpose_item<0>(la2 + (size_t)l * 64 * 384, 64, 384, 12, wl + 64, 256, scr, r, lane); continue; } r -= 12;
        transpose_item<0>(lg2 + (size_t)l * 128 * 384, 128, 384, 12, wl + 128, 256, scr, r, lane);
    }
}
__device__ __forceinline__ void norm_mod_phase(const float* xin, const float* gain, const float* modl, int sh_off, int sc_off, bf16* out, int gw, int ngw, int lane) {
    for (int ci = gw; ci < MT / 32; ci += ngw) {
        const int b = ci >> 6; const float* mb = modl + (size_t)b * MODP;
        f32x4 gs[4], sh[4];
#pragma unroll
        for (int j = 0; j < 4; ++j) { const int col = 4 * lane + 256 * j; const f32x4 g = *(const f32x4*)(gain + col), s = *(const f32x4*)(mb + sc_off + col); gs[j] = g * (s + 1.0f); sh[j] = *(const f32x4*)(mb + sh_off + col); }
        for (int r = 0; r < 32; ++r) {
            const size_t row = (size_t)ci * 32 + r; const f32x4* xr = (const f32x4*)(xin + row * DM) + lane;
            f32x4 v[4]; float ss = 0.f;
#pragma unroll
            for (int j = 0; j < 4; ++j) { v[j] = xr[64 * j]; ss += (v[j].x * v[j].x + v[j].y * v[j].y) + (v[j].z * v[j].z + v[j].w * v[j].w); }
            const float rstd = 1.0f / sqrtf(wave_sum(ss) * (1.0f / DM) + RMS_EPS);
            v2u* o8 = (v2u*)(out + row * DM) + lane;
#pragma unroll
            for (int j = 0; j < 4; ++j) { const f32x4 y = v[j] * rstd * gs[j] + sh[j]; v2u w; w.x = pk2(y.x, y.y); w.y = pk2(y.z, y.w); o8[64 * j] = w; }
        }
    }
}
__device__ __forceinline__ void final_norm_phase(float* x, const float* gain, int gw, int ngw, int lane) {
    f32x4 g[4];
#pragma unroll
    for (int j = 0; j < 4; ++j) g[j] = *(const f32x4*)(gain + 4 * lane + 256 * j);
    for (int row = gw; row < MT; row += ngw) {
        f32x4* xr = (f32x4*)(x + (size_t)row * DM) + lane; f32x4 v[4]; float ss = 0.f;
#pragma unroll
        for (int j = 0; j < 4; ++j) { v[j] = xr[64 * j]; ss += (v[j].x * v[j].x + v[j].y * v[j].y) + (v[j].z * v[j].z + v[j].w * v[j].w); }
        const float rstd = 1.0f / sqrtf(wave_sum(ss) * (1.0f / DM) + RMS_EPS);
#pragma unroll
        for (int j = 0; j < 4; ++j) xr[64 * j] = v[j] * rstd * g[j];
    }
}
#define WG_BAR() do { asm volatile("s_waitcnt vmcnt(0) lgkmcnt(0)" ::: "memory"); __builtin_amdgcn_s_barrier(); asm volatile("" ::: "memory"); } while (0)
#define WG_BAR_L() do { asm volatile("s_waitcnt lgkmcnt(0)" ::: "memory"); __builtin_amdgcn_s_barrier(); asm volatile("" ::: "memory"); } while (0)
typedef short bf16x8p __attribute__((ext_vector_type(8)));
__device__ __forceinline__ void rwkv_prep_mfma(const bf16* proj, const float* mu, const float* w0, const float* a0, const bf16* WL, float* DEC, bf16* AA, bf16* GG, LAS unsigned char* lds, int wave) {
    constexpr int AP = 264;
    LAS bf16* act = (LAS bf16*)lds;
#pragma unroll 1
    for (int item = blockIdx.x; item < MT / 64; item += gridDim.x) {
        const int lane = lane_id_opq(), tid = wave * 64 + lane, q4 = lane >> 4, lc = lane & 15;
        const size_t m0 = (size_t)item * 64; const int t0 = (int)(m0 % SEQ);
        { const int tt = tid >> 3, cg = tid & 7; const bf16* p = proj + (m0 + tt) * NPI + RW_B + 1152 + 32 * cg; const bool hp = (t0 + tt) > 0; const float* mup = mu + 1152 + 32 * cg;
#pragma unroll
          for (int v = 0; v < 4; ++v) { const v4u cur = *(const v4u*)(p + 8 * v); v4u prv = (v4u){0u, 0u, 0u, 0u}; if (hp) prv = *(const v4u*)(p - NPI + 8 * v);
              const f32x4 m0v = *(const f32x4*)(mup + 8 * v), m1v = *(const f32x4*)(mup + 8 * v + 4);
              float x[8];
#pragma unroll
              for (int e = 0; e < 4; ++e) { const unsigned cw = cur[e], pw = prv[e]; const float c0 = __uint_as_float(cw << 16), c1 = __uint_as_float(cw & 0xffff0000u), p0 = __uint_as_float(pw << 16), p1 = __uint_as_float(pw & 0xffff0000u);
                  const float mu0 = e < 2 ? m0v[2 * e] : m1v[2 * e - 4], mu1 = e < 2 ? m0v[2 * e + 1] : m1v[2 * e - 3];
                  x[2 * e] = c0 + (p0 - c0) * mu0; x[2 * e + 1] = c1 + (p1 - c1) * mu1; }
              if (cg < 2) {
#pragma unroll
                  for (int e = 0; e < 8; ++e) x[e] = 2.0f * fsigmoid(2.0f * x[e]) - 1.0f;
              } else if (cg >= 4) {
#pragma unroll
                  for (int e = 0; e < 8; ++e) x[e] = fsigmoid(x[e]);
              }
              v4u o; o.x = pk2(x[0], x[1]); o.y = pk2(x[2], x[3]); o.z = pk2(x[4], x[5]); o.w = pk2(x[6], x[7]);
              *(LAS v4u*)(act + tt * AP + 32 * cg + 8 * v) = o; } }
        WG_BAR_L();
        const LAS bf16* afr = act + lc * AP + 8 * q4;
        const bf16* bfr = WL + (size_t)(48 * wave + lc) * 256 + 8 * q4;
        { f32x4 acc[4][3];
#pragma unroll
          for (int mt = 0; mt < 4; ++mt)
#pragma unroll
              for (int nt = 0; nt < 3; ++nt) acc[mt][nt] = (f32x4){0.f, 0.f, 0.f, 0.f};
#pragma unroll
          for (int ks = 0; ks < 2; ++ks) { bf16x8p bq[3];
#pragma unroll
              for (int nt = 0; nt < 3; ++nt) bq[nt] = *(const bf16x8p*)(bfr + 16 * nt * 256 + 32 * ks);
#pragma unroll
              for (int mt = 0; mt < 4; ++mt) { const bf16x8p aq = *(const LAS bf16x8p*)(afr + 16 * mt * AP + 32 * ks);
#pragma unroll
                  for (int nt = 0; nt < 3; ++nt) acc[mt][nt] = __builtin_amdgcn_mfma_f32_16x16x32_bf16(aq, bq[nt], acc[mt][nt], 0, 0, 0); } }
#pragma unroll
          for (int nt = 0; nt < 3; ++nt) { const int n = 48 * wave + 16 * nt + lc; const float w0n = w0[n]; float carry = 0.f;
#pragma unroll
              for (int mt = 0; mt < 4; ++mt) { float pr[4];
#pragma unroll
                  for (int r = 0; r < 4; ++r) { const float ld = -0.60653066f * fsigmoid(w0n + acc[mt][nt][r]); pr[r] = r ? pr[r - 1] + ld : ld; }
                  const float tot = pr[3]; float s1 = tot; { const float u = __shfl_up(s1, 16); if (q4 >= 1) s1 += u; } { const float u = __shfl_up(s1, 32); if (q4 >= 2) s1 += u; }
                  const float excl = carry + (s1 - tot), tile_tot = __shfl(s1, 48 + lc);
                  float* dp = DEC + (m0 + 16 * mt + 4 * q4) * 384 + n;
#pragma unroll
                  for (int r = 0; r < 4; ++r) dp[r * 384] = excl + pr[r];
                  carry += tile_tot; } } }
        { f32x4 acc[4][3];
#pragma unroll
          for (int mt = 0; mt < 4; ++mt)
#pragma unroll
              for (int nt = 0; nt < 3; ++nt) acc[mt][nt] = (f32x4){0.f, 0.f, 0.f, 0.f};
#pragma unroll
          for (int ks = 0; ks < 2; ++ks) { bf16x8p bq[3];
#pragma unroll
              for (int nt = 0; nt < 3; ++nt) bq[nt] = *(const bf16x8p*)(bfr + 16 * nt * 256 + 64 + 32 * ks);
#pragma unroll
              for (int mt = 0; mt < 4; ++mt) { const bf16x8p aq = *(const LAS bf16x8p*)(afr + 16 * mt * AP + 64 + 32 * ks);
#pragma unroll
                  for (int nt = 0; nt < 3; ++nt) acc[mt][nt] = __builtin_amdgcn_mfma_f32_16x16x32_bf16(aq, bq[nt], acc[mt][nt], 0, 0, 0); } }
#pragma unroll
          for (int nt = 0; nt < 3; ++nt) { const int n = 48 * wave + 16 * nt + lc; const float a0n = a0[n];
#pragma unroll
              for (int mt = 0; mt < 4; ++mt) { bf16* dp = AA + (m0 + 16 * mt + 4 * q4) * 384 + n;
#pragma unroll
                  for (int r = 0; r < 4; ++r) dp[r * 384] = (bf16)f2bf(fsigmoid(a0n + acc[mt][nt][r])); } } }
        { f32x4 acc[4][3];
#pragma unroll
          for (int mt = 0; mt < 4; ++mt)
#pragma unroll
              for (int nt = 0; nt < 3; ++nt) acc[mt][nt] = (f32x4){0.f, 0.f, 0.f, 0.f};
#pragma unroll
          for (int ks = 0; ks < 4; ++ks) { bf16x8p bq[3];
#pragma unroll
              for (int nt = 0; nt < 3; ++nt) bq[nt] = *(const bf16x8p*)(bfr + 16 * nt * 256 + 128 + 32 * ks);
#pragma unroll
              for (int mt = 0; mt < 4; ++mt) { const bf16x8p aq = *(const LAS bf16x8p*)(afr + 16 * mt * AP + 128 + 32 * ks);
#pragma unroll
                  for (int nt = 0; nt < 3; ++nt) acc[mt][nt] = __builtin_amdgcn_mfma_f32_16x16x32_bf16(aq, bq[nt], acc[mt][nt], 0, 0, 0); } }
#pragma unroll
          for (int nt = 0; nt < 3; ++nt) { const int n = 48 * wave + 16 * nt + lc;
#pragma unroll
              for (int mt = 0; mt < 4; ++mt) { bf16* dp = GG + (m0 + 16 * mt + 4 * q4) * 384 + n;
#pragma unroll
                  for (int r = 0; r < 4; ++r) dp[r * 384] = (bf16)f2bf(acc[mt][nt][r]); } } }
        WG_BAR_L();
    }
}
typedef short bf16x8_t __attribute__((ext_vector_type(8)));
template <int KS>
__device__ __forceinline__ f32x4 mm_tile(const LAS bf16* A, const LAS bf16* B, f32x4 acc) {
#pragma unroll
    for (int ks = 0; ks < KS; ++ks) {
        const bf16x8_t a = *(const LAS bf16x8_t*)(A + ks * 32), b = *(const LAS bf16x8_t*)(B + ks * 32);
        acc = __builtin_amdgcn_mfma_f32_16x16x32_bf16(a, b, acc, 0, 0, 0);
    }
    return acc;
}
__device__ __forceinline__ unsigned short f2bf16(float f) { return (unsigned short)f2bf(f); }
constexpr int LP = 72;
constexpr int LPM = 104;

__device__ __forceinline__ void ret_unit(int b, int h, const bf16* proj, const float* gn, bf16* mixed, LAS unsigned char* lds, int wave, int lane0) {
    LAS bf16* Qs = (LAS bf16*)lds; LAS bf16* Ks = Qs + 64 * LP; LAS bf16* Kdt = Ks + 64 * LP; LAS bf16* Vt = Kdt + 64 * LP; LAS bf16* Ps = Vt + 64 * LP; LAS bf16* Stt = Ps + 64 * LP; LAS bf16* Gs = Stt + 64 * LP;
    const int lane = lane0, q4 = lane >> 4, lc = lane & 15;
    const float inv = powf(10000.0f, -(float)(2 * (lane & 31)) / 64.0f);
    float cs[8], sn[8];
#pragma unroll
    for (int i = 0; i < 8; ++i) sincosf((float)(8 * wave + i) * inv, &sn[i], &cs[i]);
    float c64, s64; sincosf(64.0f * inv, &s64, &c64);
    const float lg2 = log2f(1.0f - exp2f(-5.0f - (float)h));
    float kdec[8];
#pragma unroll
    for (int i = 0; i < 8; ++i) kdec[i] = exp2f((float)(63 - (8 * wave + i)) * lg2);
    const float cd = exp2f(64.0f * lg2);
    f32x4 st[4];
#pragma unroll
    for (int i = 0; i < 4; ++i) st[i] = (f32x4){0.f, 0.f, 0.f, 0.f};
    for (int i = wave * 64 + lane; i < 64 * LP / 2; i += 512) ((LAS unsigned*)Stt)[i] = 0u;
    const size_t m0 = (size_t)b * SEQ;
    const bf16* P0 = proj + m0 * NPI + h * 64;
    unsigned short rq[8], rk[8], rv[8], rg[8];
#pragma unroll
    for (int i = 0; i < 8; ++i) { const bf16* p = P0 + (size_t)(8 * wave + i) * NPI; rq[i] = p[lane]; rk[i] = p[256 + lane]; rv[i] = p[512 + lane]; rg[i] = p[768 + lane]; }
    float gain4[4];
#pragma unroll
    for (int ct = 0; ct < 4; ++ct) gain4[ct] = gn[h * 64 + 16 * ct + lc];
#pragma unroll 1
    for (int c = 0; c < SEQ / 64; ++c) {
        const int lane = lane_id_opq(), q4 = lane >> 4, lc = lane & 15, o72 = lc * LP + 8 * q4;
        { unsigned short kd[8];
#pragma unroll
          for (int i = 0; i < 8; ++i) { const int tt = 8 * wave + i;
              const float q = bf2f(rq[i]), k = bf2f(rk[i]); const float qp = __shfl_xor(q, 32), kp = __shfl_xor(k, 32);
              const float qr = lane < 32 ? q * cs[i] - qp * sn[i] : qp * sn[i] + q * cs[i];
              const float kr = (lane < 32 ? k * cs[i] - kp * sn[i] : kp * sn[i] + k * cs[i]) * 0.125f;
              Qs[tt * LP + lane] = f2bf16(qr); Ks[tt * LP + lane] = f2bf16(kr); Gs[tt * LP + lane] = rg[i]; kd[i] = f2bf16(kr * kdec[i]);
              const float cn = cs[i] * c64 - sn[i] * s64, snn = sn[i] * c64 + cs[i] * s64; cs[i] = cn; sn[i] = snn; }
          v4u w; w.x = kd[0] | ((unsigned)kd[1] << 16); w.y = kd[2] | ((unsigned)kd[3] << 16); w.z = kd[4] | ((unsigned)kd[5] << 16); w.w = kd[6] | ((unsigned)kd[7] << 16);
          *(LAS v4u*)(Kdt + lane * LP + 8 * wave) = w;
          w.x = rv[0] | ((unsigned)rv[1] << 16); w.y = rv[2] | ((unsigned)rv[3] << 16); w.z = rv[4] | ((unsigned)rv[5] << 16); w.w = rv[6] | ((unsigned)rv[7] << 16);
          *(LAS v4u*)(Vt + lane * LP + 8 * wave) = w; }
        WG_BAR_L();
        if (c + 1 < SEQ / 64) {
#pragma unroll
            for (int i = 0; i < 8; ++i) { const bf16* p = P0 + (size_t)(64 * (c + 1) + 8 * wave + i) * NPI; rq[i] = p[lane]; rk[i] = p[256 + lane]; rv[i] = p[512 + lane]; rg[i] = p[768 + lane]; } }
        { const int rt = wave >> 1;
#pragma unroll
          for (int u = 0; u < 2; ++u) { const int ct = 2 * (wave & 1) + u;
              f32x4 s = (f32x4){0.f, 0.f, 0.f, 0.f};
              if (ct <= rt) s = mm_tile<2>(Qs + 16 * rt * LP + o72, Ks + 16 * ct * LP + o72, s);
#pragma unroll
              for (int r = 0; r < 4; ++r) { const int l = 16 * rt + 4 * q4 + r, m = 16 * ct + lc; const float val = (l >= m) ? s[r] * exp2f((float)(l - m) * lg2) : 0.f; Ps[l * LP + m] = f2bf16(val); } } }
        f32x4 inter[4];
        if (wave < 4) {
#pragma unroll
            for (int ct = 0; ct < 4; ++ct) inter[ct] = mm_tile<2>(Qs + 16 * wave * LP + o72, Stt + 16 * ct * LP + o72, (f32x4){0.f, 0.f, 0.f, 0.f}); }
        WG_BAR_L();
        if (wave < 4) {
            f32x4 y[4];
#pragma unroll
            for (int ct = 0; ct < 4; ++ct) y[ct] = mm_tile<2>(Ps + 16 * wave * LP + o72, Vt + 16 * ct * LP + o72, (f32x4){0.f, 0.f, 0.f, 0.f});
#pragma unroll
            for (int r = 0; r < 4; ++r) { const int l = 16 * wave + 4 * q4 + r; const float qd = exp2f((float)(l + 1) * lg2);
                float s = 0.f;
#pragma unroll
                for (int ct = 0; ct < 4; ++ct) { y[ct][r] += qd * inter[ct][r]; s += y[ct][r]; }
                const float mean = sum16(s) * (1.0f / 64.0f); float qv = 0.f;
#pragma unroll
                for (int ct = 0; ct < 4; ++ct) { const float dd = y[ct][r] - mean; qv += dd * dd; }
                const float rstd = 1.0f / sqrtf(sum16(qv) * (1.0f / 64.0f) + GN_EPS);
                bf16* orow = mixed + (m0 + 64 * c + l) * DM + h * 64 + lc;
#pragma unroll
                for (int ct = 0; ct < 4; ++ct) { const float g = bf2f(Gs[l * LP + 16 * ct + lc]); orow[16 * ct] = f2bf16((y[ct][r] - mean) * rstd * gain4[ct] * (g * fsigmoid(g))); } }
        } else {
            const int dt = wave - 4;
#pragma unroll
            for (int ct = 0; ct < 4; ++ct) { st[ct] = mm_tile<2>(Kdt + 16 * dt * LP + o72, Vt + 16 * ct * LP + o72, st[ct] * cd);
                v2u w; w.x = pk2(st[ct][0], st[ct][1]); w.y = pk2(st[ct][2], st[ct][3]);
                *(LAS v2u*)(Stt + (16 * ct + lc) * LP + 16 * dt + 4 * q4) = w; }
        }
        WG_BAR_L();
    }
}

__device__ __forceinline__ void mlstm_unit(int b, int h, const bf16* proj, const float* conv_w, const float* conv_b, const float* i_b, const float* f_b, const float* gn, bf16* mixed,
                                           LAS unsigned char* lds, int wave, int lane0) {
    LAS bf16* Qs = (LAS bf16*)lds; LAS bf16* Ks = Qs + 64 * LPM; LAS bf16* Kdt = Ks + 64 * LPM; LAS bf16* Vt = Kdt + 96 * LP; LAS bf16* Ps = Vt + 112 * LP; LAS bf16* Stt = Ps + 64 * LP; LAS bf16* Os = Stt + 112 * LPM;
    LAS float* ev = (LAS float*)(Os + 64 * LPM); LAS float* pmv = ev + 64; LAS float* flv = pmv + 64;
    const int lane = lane0, lc = lane & 15;
    float wq0[4], wq1[4], wk0[4], wk1[4], bq0, bq1, bk0, bk1;
    { const int cq0 = h * 96 + lane, cq1 = h * 96 + 64 + (lane & 31), ck0 = 384 + cq0, ck1 = 384 + cq1;
#pragma unroll
    for (int j = 0; j < 4; ++j) { wq0[j] = conv_w[j * 768 + cq0]; wq1[j] = conv_w[j * 768 + cq1]; wk0[j] = conv_w[j * 768 + ck0]; wk1[j] = conv_w[j * 768 + ck1]; }
    bq0 = conv_b[cq0]; bq1 = conv_b[cq1]; bk0 = conv_b[ck0]; bk1 = conv_b[ck1]; }
    const float ib = i_b[h], fb = f_b[h];
    const float ksc = 0.10206207261596577f;
    f32x4 st[11];
#pragma unroll
    for (int i = 0; i < 11; ++i) st[i] = (f32x4){0.f, 0.f, 0.f, 0.f};
    for (int i = wave * 64 + lane; i < 112 * LPM / 2; i += 512) ((LAS unsigned*)Stt)[i] = 0u;
    for (int i = wave * 64 + lane; i < 16 * LP / 2; i += 512) ((LAS unsigned*)(Vt + 96 * LP))[i] = (i < LP / 2) ? 0x3f803f80u : 0u;
    float mprev = 0.f;
    const size_t m0 = (size_t)b * SEQ;
    const bf16* PB = proj + m0 * NPI + ML_B;
    float gain6[6];
#pragma unroll
    for (int ct = 0; ct < 6; ++ct) gain6[ct] = gn[640 + h * 96 + 16 * ct + lc];
    unsigned xq[11], xk[11], vv[8], gg;
#define ML_LOAD(cc) do { const int tb_ = 64 * (cc) + 8 * wave; \
        _Pragma("unroll") for (int i = 0; i < 11; ++i) { const int t_ = tb_ - 3 + i; const bool ok_ = t_ >= 0; const bf16* p_ = PB + (size_t)(ok_ ? t_ : 0) * NPI; \
            const unsigned a0_ = ok_ ? p_[cq0] : 0u, a1_ = (ok_ && has1) ? p_[cq1] : 0u, b0_ = ok_ ? p_[ck0] : 0u, b1_ = (ok_ && has1) ? p_[ck1] : 0u; xq[i] = a0_ | (a1_ << 16); xk[i] = b0_ | (b1_ << 16); } \
        _Pragma("unroll") for (int i = 0; i < 8; ++i) { const bf16* p_ = PB + (size_t)(tb_ + i) * NPI + 768 + h * 96; const unsigned a0_ = p_[d0], a1_ = has1 ? p_[d1] : 0u; vv[i] = a0_ | (a1_ << 16); } \
        { const bf16* p_ = PB + (size_t)(64 * (cc) + lane) * NPI; const unsigned a0_ = p_[1536 + h], a1_ = p_[1540 + h]; gg = a0_ | (a1_ << 16); } } while (0)
    { const int d0 = lane, d1 = 64 + (lane & 31); const bool has1 = lane < 32; const int cq0 = h * 96 + d0, cq1 = h * 96 + d1, ck0 = 384 + cq0, ck1 = 384 + cq1; ML_LOAD(0); }
#pragma unroll 1
    for (int c = 0; c < SEQ / 64; ++c) {
        const int lane = lane_id_opq(), q4 = lane >> 4, lc = lane & 15, o72 = lc * LP + 8 * q4, o104 = lc * LPM + 8 * q4;
        const int d0 = lane, d1 = 64 + (lane & 31); const bool has1 = lane < 32;
        const int cq0 = h * 96 + d0, cq1 = h * 96 + d1, ck0 = 384 + cq0, ck1 = 384 + cq1;
        const int tb = 64 * c + 8 * wave;
        float pm63, carry, ev_l; const float mold = mprev;
        { const float ic = __uint_as_float(gg << 16) + ib, lf = flogsigmoid(__uint_as_float(gg & 0xffff0000u) + fb);
          const float bc = wave_prefix_sum(lf), e = ic - bc; const float pm = fmaxf(wave_prefix_max(e), mprev);
          pm63 = __builtin_bit_cast(float, __builtin_amdgcn_readlane(__builtin_bit_cast(int, pm), 63)); carry = fexp(mprev - pm63); ev_l = e;
          if (wave == 0) { ev[lane] = e; pmv[lane] = pm; flv[lane] = fexp(-(bc + pm)); }
          mprev = __builtin_bit_cast(float, __builtin_amdgcn_readlane(__builtin_bit_cast(int, bc), 63)) + pm63; }
        { unsigned short kd0[8], kd1[8];
#pragma unroll
          for (int i = 0; i < 8; ++i) { const int tt = 8 * wave + i;
#define LO_(w) __uint_as_float((w) << 16)
#define HI_(w) __uint_as_float((w) & 0xffff0000u)
              float q0 = bq0 + LO_(xq[i]) * wq0[0] + LO_(xq[i + 1]) * wq0[1] + LO_(xq[i + 2]) * wq0[2] + LO_(xq[i + 3]) * wq0[3];
              float k0 = bk0 + LO_(xk[i]) * wk0[0] + LO_(xk[i + 1]) * wk0[1] + LO_(xk[i + 2]) * wk0[2] + LO_(xk[i + 3]) * wk0[3];
              float q1 = bq1 + HI_(xq[i]) * wq1[0] + HI_(xq[i + 1]) * wq1[1] + HI_(xq[i + 2]) * wq1[2] + HI_(xq[i + 3]) * wq1[3];
              float k1 = bk1 + HI_(xk[i]) * wk1[0] + HI_(xk[i + 1]) * wk1[1] + HI_(xk[i + 2]) * wk1[2] + HI_(xk[i + 3]) * wk1[3];
#undef LO_
#undef HI_
              q0 = q0 * fsigmoid(q0); k0 = k0 * fsigmoid(k0) * ksc; q1 = q1 * fsigmoid(q1); k1 = k1 * fsigmoid(k1) * ksc;
              const float wsi = fexp(__builtin_bit_cast(float, __builtin_amdgcn_readlane(__builtin_bit_cast(int, ev_l), tt)) - pm63);
              Qs[tt * LPM + d0] = f2bf16(q0); Ks[tt * LPM + d0] = f2bf16(k0); kd0[i] = f2bf16(k0 * wsi); kd1[i] = f2bf16(k1 * wsi);
              if (has1) { Qs[tt * LPM + d1] = f2bf16(q1); Ks[tt * LPM + d1] = f2bf16(k1); } }
          v4u w; w.x = kd0[0] | ((unsigned)kd0[1] << 16); w.y = kd0[2] | ((unsigned)kd0[3] << 16); w.z = kd0[4] | ((unsigned)kd0[5] << 16); w.w = kd0[6] | ((unsigned)kd0[7] << 16);
          *(LAS v4u*)(Kdt + d0 * LP + 8 * wave) = w;
          if (has1) { w.x = kd1[0] | ((unsigned)kd1[1] << 16); w.y = kd1[2] | ((unsigned)kd1[3] << 16); w.z = kd1[4] | ((unsigned)kd1[5] << 16); w.w = kd1[6] | ((unsigned)kd1[7] << 16);
              *(LAS v4u*)(Kdt + d1 * LP + 8 * wave) = w; }
          w.x = (vv[0] & 0xffffu) | (vv[1] << 16); w.y = (vv[2] & 0xffffu) | (vv[3] << 16); w.z = (vv[4] & 0xffffu) | (vv[5] << 16); w.w = (vv[6] & 0xffffu) | (vv[7] << 16);
          *(LAS v4u*)(Vt + d0 * LP + 8 * wave) = w;
          if (has1) { w.x = (vv[0] >> 16) | (vv[1] & 0xffff0000u); w.y = (vv[2] >> 16) | (vv[3] & 0xffff0000u); w.z = (vv[4] >> 16) | (vv[5] & 0xffff0000u); w.w = (vv[6] >> 16) | (vv[7] & 0xffff0000u);
              *(LAS v4u*)(Vt + d1 * LP + 8 * wave) = w; } }
        WG_BAR_L();
        unsigned og[8];
#pragma unroll
        for (int i = 0; i < 8; ++i) { const bf16* p = PB + (size_t)(tb + i) * NPI + 1152 + h * 96; const unsigned a0_ = p[d0], a1_ = has1 ? p[d1] : 0u; og[i] = a0_ | (a1_ << 16); }
        if (c + 1 < SEQ / 64) ML_LOAD(c + 1);
        { const int rt = wave >> 1;
#pragma unroll
          for (int u = 0; u < 2; ++u) { const int ct = 2 * (wave & 1) + u;
              f32x4 s = (f32x4){0.f, 0.f, 0.f, 0.f};
              if (ct <= rt) s = mm_tile<3>(Qs + 16 * rt * LPM + o104, Ks + 16 * ct * LPM + o104, s);
              const float em = ev[16 * ct + lc];
#pragma unroll
              for (int r = 0; r < 4; ++r) { const int l = 16 * rt + 4 * q4 + r, m = 16 * ct + lc; const float val = (l >= m) ? s[r] * fexp(em - pmv[l]) : 0.f; Ps[l * LP + m] = f2bf16(val); } } }
        f32x4 inter[7];
        if (wave < 4) {
#pragma unroll
            for (int ct = 0; ct < 7; ++ct) inter[ct] = mm_tile<3>(Qs + 16 * wave * LPM + o104, Stt + 16 * ct * LPM + o104, (f32x4){0.f, 0.f, 0.f, 0.f}); }
#pragma unroll
        for (int i = 0; i < 8; ++i) { Os[(8 * wave + i) * LPM + d0] = (unsigned short)(og[i] & 0xffffu); if (has1) Os[(8 * wave + i) * LPM + d1] = (unsigned short)(og[i] >> 16); }
        WG_BAR_L();
        if (wave < 4) {
            f32x4 y[7];
#pragma unroll
            for (int ct = 0; ct < 7; ++ct) y[ct] = mm_tile<2>(Ps + 16 * wave * LP + o72, Vt + 16 * ct * LP + o72, (f32x4){0.f, 0.f, 0.f, 0.f});
#pragma unroll
            for (int r = 0; r < 4; ++r) { const int l = 16 * wave + 4 * q4 + r; const float iw = fexp(mold - pmv[l]);
#pragma unroll
                for (int ct = 0; ct < 7; ++ct) y[ct][r] += iw * inter[ct][r];
                const float den = __shfl(y[6][r], lane & 48);
                const float dn = 1.0f / fmaxf(fabsf(den), flv[l]);
                float s = 0.f;
#pragma unroll
                for (int ct = 0; ct < 6; ++ct) { y[ct][r] *= dn; s += y[ct][r]; }
                const float mean = sum16(s) * (1.0f / 96.0f); float qv = 0.f;
#pragma unroll
                for (int ct = 0; ct < 6; ++ct) { const float dd = y[ct][r] - mean; qv += dd * dd; }
                const float rstd = 1.0f / sqrtf(sum16(qv) * (1.0f / 96.0f) + GN_EPS);
                bf16* orow = mixed + (m0 + 64 * c + l) * DM + 640 + h * 96 + lc;
#pragma unroll
                for (int ct = 0; ct < 6; ++ct) { const float o = bf2f(Os[l * LPM + 16 * ct + lc]); orow[16 * ct] = f2bf16((y[ct][r] - mean) * rstd * gain6[ct] * fsigmoid(o)); } }
        } else {
#pragma unroll
            for (int i = 0; i < 11; ++i) { const int t = (wave - 4) + 4 * i;
                if (t < 42) { const int dt = t / 7, et = t % 7;
                    st[i] = mm_tile<2>(Kdt + 16 * dt * LP + o72, Vt + 16 * et * LP + o72, st[i] * carry);
                    v2u w; w.x = pk2(st[i][0], st[i][1]); w.y = pk2(st[i][2], st[i][3]);
                    *(LAS v2u*)(Stt + (16 * et + lc) * LPM + 16 * dt + 4 * q4) = w; } }
        }
        WG_BAR_L();
    }
#undef ML_LOAD
}
#ifndef RW_DBG
#define RW_DBG 0xFF
#endif
__device__ __forceinline__ void rwkv_unit(int b, int h, const bf16* proj, const float* CUM, const bf16* AA, const bf16* GG, const float* mu, const float* k_k, const float* k_a, const float* r_k,
                                          const float* gn, bf16* mixed, LAS unsigned char* lds, int wave, int lane0,
                                          int cb, int ce, const float* hs_in, unsigned* flag_in, float* hs_out, unsigned* flag_out) {
    constexpr int SLOT = 64 * LP;
    LAS bf16* KH = (LAS bf16*)lds; LAS bf16* BH = KH + SLOT; LAS bf16* KT = BH + SLOT; LAS bf16* RT = KT + SLOT; LAS bf16* KHgt = RT + SLOT; LAS bf16* BHgtn = KHgt + SLOT;
    LAS bf16* Vt = BHgtn + SLOT; LAS bf16* AkT = Vt + SLOT; LAS bf16* BbTn = AkT + SLOT; LAS bf16* BkT = BbTn + SLOT; LAS bf16* S0b = BkT + SLOT; LAS bf16* Loffb = S0b + SLOT; LAS bf16* Vr = Loffb + SLOT; LAS bf16* Gr = Vr + SLOT;
    LAS float* RHS = (LAS float*)KH; LAS bf16* Ut = KT;
    LAS float* LTd = (LAS float*)(Gr + SLOT);
    LAS float* XS = LTd + 64 * 20;
    LAS float* GCv = XS + 16 * 64; LAS float* bonv = GCv + 64;
    float mu_r, mu_k, mu_v, kkc, kac, rkc;
    { const int c0 = h * 64 + lane0; mu_r = mu[c0]; mu_k = mu[384 + c0]; mu_v = mu[768 + c0]; kkc = k_k[c0]; kac = k_a[c0]; rkc = r_k[c0]; }
    for (int i = wave * 64 + lane0; i < 5 * SLOT / 2; i += 512) ((LAS unsigned*)AkT)[i] = 0u;
    float gain4[4];
#pragma unroll
    for (int ct = 0; ct < 4; ++ct) gain4[ct] = gn[256 + h * 64 + 16 * ct + (lane0 & 15)];
    f32x4 sacc[4];
#pragma unroll
    for (int i = 0; i < 4; ++i) sacc[i] = (f32x4){0.f, 0.f, 0.f, 0.f};
    if (hs_in) {
        if (wave == 0) { unsigned spins = 0u;
            while (__hip_atomic_load(flag_in, __ATOMIC_RELAXED, __HIP_MEMORY_SCOPE_AGENT) == 0u) { __builtin_amdgcn_s_sleep(4); if (++spins > (1u << 22)) break; }
            __builtin_amdgcn_fence(__ATOMIC_ACQUIRE, "agent"); asm volatile("s_waitcnt vmcnt(0)" ::: "memory"); }
        WG_BAR();
        if (wave >= 4) {
#pragma unroll
            for (int jt = 0; jt < 4; ++jt) {
#pragma unroll
                for (int r = 0; r < 4; ++r) { sacc[jt][r] = hs_in[((wave - 4) * 4 + jt) * 256 + r * 64 + lane0];
                    S0b[(16 * (wave - 4) + 4 * (lane0 >> 4) + r) * LP + 16 * jt + (lane0 & 15)] = f2bf16(sacc[jt][r]); } } }
    }
    const size_t m0 = (size_t)b * SEQ;
    const bf16* PU = proj + m0 * NPI + RW_B + h * 64;
    const float* CU = CUM + m0 * 384 + h * 64; const bf16* AU = AA + m0 * 384 + h * 64; const bf16* GU = GG + m0 * 384 + h * 64;
    unsigned short rr[9], rk[9], rv[9], ra[8], rg[8]; float rc[9], rc63;
#define RWKV_LOAD(cc) do { const int tb_ = 64 * (cc) + 8 * wave; \
        _Pragma("unroll") for (int i = 0; i < 9; ++i) { const int t_ = tb_ - 1 + i; const bool ok_ = t_ >= 0; const bf16* p_ = PU + (size_t)(ok_ ? t_ : 0) * NPI; \
            rr[i] = ok_ ? p_[lane] : (unsigned short)0; rk[i] = ok_ ? p_[384 + lane] : (unsigned short)0; rv[i] = ok_ ? p_[768 + lane] : (unsigned short)0; \
            rc[i] = (i > 0 || wave > 0) ? CU[(size_t)(ok_ ? t_ : 0) * 384 + lane] : 0.f; if (i > 0) { ra[i - 1] = AU[(size_t)t_ * 384 + lane]; rg[i - 1] = GU[(size_t)t_ * 384 + lane]; } } \
        rc63 = CU[(size_t)(64 * (cc) + 63) * 384 + lane]; } while (0)
    { const int lane = lane0; RWKV_LOAD(cb); }
#pragma unroll 1
    for (int c = cb; c < ce; ++c) {
        const int lane = lane_id_opq(), q4 = lane >> 4, lc = lane & 15, o72 = lc * LP + 8 * q4;
        if (RW_DBG & 1) { unsigned short khg[8], bhg[8]; const float gc63 = fexp(rc63); float ecp = fexp(rc[0]);
#pragma unroll
          for (int i = 0; i < 8; ++i) { const int tt = 8 * wave + i;
              const float cr = bf2f(rr[i + 1]), ck = bf2f(rk[i + 1]);
              const float r = cr + (bf2f(rr[i]) - cr) * mu_r, k = ck + (bf2f(rk[i]) - ck) * mu_k, a = bf2f(ra[i]);
              float kk = k * kkc; kk = kk * __builtin_amdgcn_rsqf(fmaxf(wave_sum(kk * kk), 1e-24f));
              const float kmod = k * (1.0f + (a - 1.0f) * kac), beta = kk * a;
              const float bon = wave_sum(r * kmod * rkc); if (lane == 0) bonv[tt] = bon;
              const float cm = rc[i + 1], cp = rc[i];
              const float em = fexp(-cm), eg = gc63 * em, ec = __builtin_amdgcn_rcpf(em);
              KH[tt * LP + lane] = f2bf16(kmod * em); BH[tt * LP + lane] = f2bf16(beta * em); KT[tt * LP + lane] = f2bf16(kk * ecp); RT[tt * LP + lane] = f2bf16(r * ec); ecp = ec;
              khg[i] = f2bf16(kmod * eg); bhg[i] = f2bf16(-beta * eg); }
          v4u w; w.x = khg[0] | ((unsigned)khg[1] << 16); w.y = khg[2] | ((unsigned)khg[3] << 16); w.z = khg[4] | ((unsigned)khg[5] << 16); w.w = khg[6] | ((unsigned)khg[7] << 16);
          *(LAS v4u*)(KHgt + lane * LP + 8 * wave) = w;
          w.x = bhg[0] | ((unsigned)bhg[1] << 16); w.y = bhg[2] | ((unsigned)bhg[3] << 16); w.z = bhg[4] | ((unsigned)bhg[5] << 16); w.w = bhg[6] | ((unsigned)bhg[7] << 16);
          *(LAS v4u*)(BHgtn + lane * LP + 8 * wave) = w;
          unsigned short vs[8];
#pragma unroll
          for (int i = 0; i < 8; ++i) { const float cv = bf2f(rv[i + 1]); vs[i] = f2bf16(cv + (bf2f(rv[i]) - cv) * mu_v); Vr[(8 * wave + i) * LP + lane] = vs[i]; Gr[(8 * wave + i) * LP + lane] = rg[i]; }
          w.x = vs[0] | ((unsigned)vs[1] << 16); w.y = vs[2] | ((unsigned)vs[3] << 16); w.z = vs[4] | ((unsigned)vs[5] << 16); w.w = vs[6] | ((unsigned)vs[7] << 16);
          *(LAS v4u*)(Vt + lane * LP + 8 * wave) = w;
          if (wave == 0) GCv[lane] = gc63; }
        WG_BAR_L();
#pragma unroll
        for (int u2 = 0; u2 < 2; ++u2) { const int idx = 2 * wave + u2, rt = idx >> 2, ct = idx & 3;
            if (ct <= rt) {
                const int s = 16 * ct + lc; const LAS bf16* kt = KT + 16 * rt * LP + o72; const LAS bf16* rtp = RT + 16 * rt * LP + o72; const LAS bf16* bh = BH + 16 * ct * LP + o72; const LAS bf16* kh = KH + 16 * ct * LP + o72;
                const f32x4 z = (f32x4){0.f, 0.f, 0.f, 0.f};
                const f32x4 g0 = mm_tile<2>(kt, bh, z), g1 = mm_tile<2>(kt, kh, z), g2 = mm_tile<2>(rtp, bh, z), g3 = mm_tile<2>(rtp, kh, z);
#pragma unroll
                for (int r = 0; r < 4; ++r) { const int t = 16 * rt + 4 * q4 + r;
                    if (ct < rt) Loffb[t * LP + s] = f2bf16(g0[r]); else LTd[s * 20 + (t - 16 * rt)] = (s < t) ? g0[r] : 0.f;
                    AkT[t * LP + s] = f2bf16((s < t) ? g1[r] : 0.f);
                    BbTn[t * LP + s] = f2bf16((s <= t) ? -g2[r] : 0.f);
                    BkT[t * LP + s] = f2bf16((s <= t) ? g3[r] : 0.f); } } }
        WG_BAR_L();
#pragma unroll
        for (int u = 0; u < ((RW_DBG & 4) ? 2 : 0); ++u) { const int rt = wave >> 1, ct = 2 * (wave & 1) + u;
            f32x4 g = mm_tile<2>(KT + 16 * rt * LP + o72, S0b + 16 * ct * LP + o72, (f32x4){0.f, 0.f, 0.f, 0.f});
            g = mm_tile<2>(AkT + 16 * rt * LP + o72, Vt + 16 * ct * LP + o72, g);
#pragma unroll
            for (int r = 0; r < 4; ++r) RHS[(16 * rt + 4 * q4 + r) * 64 + 16 * ct + lc] = g[r]; }
        WG_BAR_L();
        f32x4 y[4];
        if ((RW_DBG & 8) && wave == 0) {
#pragma unroll
            for (int a = 0; a < 4; ++a) {
                if (a > 0) {
#pragma unroll
                    for (int it = 0; it < 4; ++it) { f32x4 cr = (f32x4){0.f, 0.f, 0.f, 0.f};
                        if (a == 3) cr = mm_tile<2>(Loffb + 16 * a * LP + o72, Ut + 16 * it * LP + o72, cr); else cr = mm_tile<1>(Loffb + 16 * a * LP + o72, Ut + 16 * it * LP + o72, cr);
#pragma unroll
                        for (int r = 0; r < 4; ++r) XS[(4 * q4 + r) * 64 + 16 * it + lc] = cr[r]; }
                    asm volatile("s_waitcnt lgkmcnt(0)" ::: "memory");
                }
                float acc[16];
#pragma unroll
                for (int t = 0; t < 16; ++t) acc[t] = RHS[(16 * a + t) * 64 + lane] - (a > 0 ? XS[t * 64 + lane] : 0.f);
                const LAS float* Ld = LTd + 16 * a * 20; asm volatile("" : "+v"(Ld));
#pragma unroll
                for (int s2 = 0; s2 < 15; ++s2) { const float us = acc[s2];
#pragma unroll
                    for (int t4 = (s2 + 1) / 4; t4 < 4; ++t4) { const f32x4 l4 = *(const LAS f32x4*)(Ld + s2 * 20 + 4 * t4);
                        acc[4 * t4] -= l4.x * us; acc[4 * t4 + 1] -= l4.y * us; acc[4 * t4 + 2] -= l4.z * us; acc[4 * t4 + 3] -= l4.w * us; }
                    if (s2 == 3 || s2 == 7) asm volatile("" : "+v"(Ld) : "v"(acc[s2 + 1])); }
                v4u w; w.x = pk2(acc[0], acc[1]); w.y = pk2(acc[2], acc[3]); w.z = pk2(acc[4], acc[5]); w.w = pk2(acc[6], acc[7]);
                *(LAS v4u*)(Ut + lane * LP + 16 * a) = w;
                w.x = pk2(acc[8], acc[9]); w.y = pk2(acc[10], acc[11]); w.z = pk2(acc[12], acc[13]); w.w = pk2(acc[14], acc[15]);
                *(LAS v4u*)(Ut + lane * LP + 16 * a + 8) = w;
                asm volatile("s_waitcnt lgkmcnt(0)" ::: "memory");
            }
        }
        if (c + 1 < ce) RWKV_LOAD(c + 1);
        if (wave < 4) {
#pragma unroll
            for (int ct = 0; ct < 4; ++ct) { y[ct] = mm_tile<2>(RT + 16 * wave * LP + o72, S0b + 16 * ct * LP + o72, (f32x4){0.f, 0.f, 0.f, 0.f}); y[ct] = mm_tile<2>(BkT + 16 * wave * LP + o72, Vt + 16 * ct * LP + o72, y[ct]); }
        } else {
#pragma unroll
            for (int jt = 0; jt < 4; ++jt) { const float gc = GCv[16 * jt + lc]; sacc[jt] = mm_tile<2>(Vt + 16 * (wave - 4) * LP + o72, KHgt + 16 * jt * LP + o72, sacc[jt] * gc); }
        }
        WG_BAR_L();
        if (wave < 4) {
#pragma unroll
            for (int ct = 0; ct < 4; ++ct) y[ct] = mm_tile<2>(BbTn + 16 * wave * LP + o72, Ut + 16 * ct * LP + o72, y[ct]);
#pragma unroll
            for (int r = 0; r < 4; ++r) { const int t = 16 * wave + 4 * q4 + r; const size_t row = m0 + 64 * c + t;
                float s = 0.f;
#pragma unroll
                for (int ct = 0; ct < 4; ++ct) s += y[ct][r];
                const float mean = sum16(s) * (1.0f / 64.0f); float qv = 0.f;
#pragma unroll
                for (int ct = 0; ct < 4; ++ct) { const float dd = y[ct][r] - mean; qv += dd * dd; }
                const float rstd = 1.0f / sqrtf(sum16(qv) * (1.0f / 64.0f) + GN_EPS);
                const float bon = bonv[t]; bf16* orow = mixed + row * DM + 256 + h * 64 + lc;
#pragma unroll
                for (int ct = 0; ct < 4; ++ct) orow[16 * ct] = f2bf16(((y[ct][r] - mean) * rstd * gain4[ct] + bon * bf2f(Vr[t * LP + 16 * ct + lc])) * bf2f(Gr[t * LP + 16 * ct + lc])); }
        } else {
#pragma unroll
            for (int jt = 0; jt < 4; ++jt) { sacc[jt] = mm_tile<2>(Ut + 16 * (wave - 4) * LP + o72, BHgtn + 16 * jt * LP + o72, sacc[jt]);
#pragma unroll
                for (int r = 0; r < 4; ++r) S0b[(16 * (wave - 4) + 4 * q4 + r) * LP + 16 * jt + lc] = f2bf16(sacc[jt][r]); }
        }
        WG_BAR_L();
    }
    if (hs_out) {
        if (wave >= 4) {
#pragma unroll
            for (int jt = 0; jt < 4; ++jt)
#pragma unroll
                for (int r = 0; r < 4; ++r) __hip_atomic_store(hs_out + ((wave - 4) * 4 + jt) * 256 + r * 64 + lane0, sacc[jt][r], __ATOMIC_RELAXED, __HIP_MEMORY_SCOPE_AGENT);
        }
        WG_BAR();
        if (wave == 4 && lane0 == 0) __hip_atomic_store(flag_out, 1u, __ATOMIC_RELAXED, __HIP_MEMORY_SCOPE_AGENT);
    }
#undef RWKV_LOAD
}

struct Args { const float* in[25]; float* out; unsigned char* ws; int ph_lo, ph_hi, li, pad; };
typedef const __attribute__((address_space(4))) Args* KArgs;
__device__ __forceinline__ KArgs kargs() { KArgs p = (KArgs)__builtin_amdgcn_kernarg_segment_ptr(); asm volatile("" : "+s"(p)); return p; }
#ifndef DBG_MASK
#define DBG_MASK 0xFFFF
#endif
#define EN(bit) ((DBG_MASK >> (bit)) & 1)
#ifndef PROBE_DUP
#define PROBE_DUP 0
#endif
#define REP(bit) for (int rep_ = 0; rep_ < (((PROBE_DUP >> (bit)) & 1) ? 2 : 1); ++rep_)
__global__ void __launch_bounds__(NWAVES * 64, 2) mk_fwd(Args args_unused) {
    extern __shared__ __attribute__((aligned(16))) unsigned char lds_raw[];
    LAS unsigned char* lds = (LAS unsigned char*)lds_raw;
    volatile LAS unsigned* MISC = (volatile LAS unsigned*)(lds + MISC_OFF);
    const int wave = __builtin_amdgcn_readfirstlane((int)threadIdx.x >> 6);
    const int G = gridDim.x, gw = blockIdx.x * NWAVES + wave, ngw = G * NWAVES;
    for (int u = threadIdx.x; u < (LDS_BYTES - LDSCTL_OFF) / 4; u += NWAVES * 64) ((LAS unsigned*)(lds + LDSCTL_OFF))[u] = 0u;
    __syncthreads();
    XcdBarrier bar; int lo, hi;
    { KArgs A = kargs(); bar = xcd_barrier_post((unsigned*)(A->ws + WS_CTL) + CW_BAR + (MK_PER_PHASE ? 0 : A->li) * XCD_BAR_WORDS, MISC + 8); lo = A->ph_lo; hi = A->ph_hi; }
#define IN(k) (lo <= (k) && (k) < hi)
#define SEAM(k) do { if (IN(k) && IN((k) + 1)) xcd_barrier(bar); } while (0)
#define LANE_TID() int wave_o = wave, gw_o = gw; asm volatile("" : "+s"(wave_o), "+s"(gw_o)); (void)gw_o; const int lane_o = lane_id_opq(), tid_o = wave_o * 64 + lane_o; (void)tid_o

    if (EN(0) && IN(0)) {
        KArgs A = kargs(); unsigned char* ws = A->ws; LANE_TID();
        p0_mod(A->in[1], A->in[2], A->in[3], (float*)(ws + WS_MOD), lds, tid_o, lane_o, wave_o);
        p0_weights(A->in[6], A->in[21], A->in[22], A->in[23], A->in[10], A->in[12], A->in[13], ws, lds, gw_o, ngw, wave_o, lane_o);
    }
    SEAM(0);
#pragma unroll 1
    for (int l = 0; l < NL; ++l) {
        const int pb = 1 + 8 * l;
        REP(2) if (EN(1) && IN(pb + 0)) { KArgs A = kargs(); unsigned char* ws = A->ws; LANE_TID();
            norm_mod_phase(l == 0 ? A->in[0] : A->out, A->in[4] + l * DM, (const float*)(ws + WS_MOD) + (size_t)l * NB * MODP, 0, DM, (bf16*)(ws + WS_H), gw_o, ngw, lane_o); }
        SEAM(pb + 0);
        REP(3) if (EN(2) && IN(pb + 1)) { KArgs A = kargs(); unsigned char* ws = A->ws; LANE_TID();
            pg8::Gemm g{(const bf16*)(ws + WS_H), (const bf16*)(ws + WS_WIN) + (size_t)l * NPI * DM, MT, NPI, DM}; pg8::StaticOrder S; S.init(MT, NPI, G, (int)blockIdx.x);
            pg8::EpiBf16Plain E{(bf16*)(ws + WS_PROJ), NPI};
            pg8::gemm_phase<pg8::EpiBf16Plain, pg8::StaticOrder, true, true>(lds, g, S, E, wave_o);
        }
        SEAM(pb + 1);
        REP(1) if (EN(3) && IN(pb + 2)) { KArgs A = kargs(); unsigned char* ws = A->ws; LANE_TID();
            rwkv_prep_mfma((const bf16*)(ws + WS_PROJ), A->in[8] + l * RWKV_IN, A->in[9] + l * 384, A->in[11] + l * 384, (const bf16*)(ws + WS_WL) + (size_t)l * 384 * 256,
                           (float*)(ws + WS_DEC), (bf16*)(ws + WS_AA), (bf16*)(ws + WS_GG), lds, wave_o); }
        SEAM(pb + 2);
        REP(0) if (EN(4) && IN(pb + 3)) { KArgs A = kargs(); unsigned char* ws = A->ws; LANE_TID();
            const float* gn = A->in[7] + l * DM; const bf16* PROJ = (const bf16*)(ws + WS_PROJ); bf16* Hb = (bf16*)(ws + WS_H);
            int u = (int)blockIdx.x; asm volatile("" : "+s"(u));
            float* HS = (float*)(ws + WS_HS) + (size_t)l * 64 * 4096; unsigned* FL = (unsigned*)(ws + WS_CTL) + CW_FLAG + l * 64 * 64;
            const float* DECp = (const float*)(ws + WS_DEC); const bf16* AAp = (const bf16*)(ws + WS_AA); const bf16* GGp = (const bf16*)(ws + WS_GG);
            if (u < 128) {
                mlstm_unit(u >> 2, u & 3, PROJ, A->in[17] + (size_t)l * 4 * 768, A->in[18] + l * 768, A->in[19] + l * 4, A->in[20] + l * 4, gn, Hb, lds, wave_o, lane_o);
            } else {
                const int v0 = u - 128, k = v0 & 63; const bool dgrp = v0 >= 64;
#pragma unroll 1
                for (int rep = 0; rep < 2; ++rep) { const bool half = (rep == 0) == dgrp; const int q = half ? 128 + k : v0;
                    const int cb = (half && !dgrp) ? 16 : 0, ce = (half && dgrp) ? 16 : 32;
                    rwkv_unit(q / 6, q % 6, PROJ, DECp, AAp, GGp, A->in[8] + l * RWKV_IN, A->in[14] + l * 384, A->in[15] + l * 384, A->in[16] + l * 384, gn, Hb, lds, wave_o, lane_o,
                              cb, ce, (half && !dgrp) ? HS + (size_t)k * 4096 : nullptr, (half && !dgrp) ? FL + k * 64 : nullptr, (half && dgrp) ? HS + (size_t)k * 4096 : nullptr, (half && dgrp) ? FL + k * 64 : nullptr); }
                ret_unit(v0 >> 2, v0 & 3, PROJ, gn, Hb, lds, wave_o, lane_o);
            }
        }
        SEAM(pb + 3);
        if (EN(6) && IN(pb + 4)) { KArgs A = kargs(); unsigned char* ws = A->ws; LANE_TID();
            pg8::Gemm g{(const bf16*)(ws + WS_H), (const bf16*)(ws + WS_WOUT) + (size_t)l * DM * DM, MT, DM, DM}; pg8::StaticOrder S; S.init(MT, DM, G, (int)blockIdx.x);
            pg8::EpiResGate E{l == 0 ? A->in[0] : A->out, A->out, DM, (const float*)(ws + WS_MOD) + (size_t)l * NB * MODP + 2 * DM, MODP};
            pg8::gemm_phase<pg8::EpiResGate, pg8::StaticOrder, true, true>(lds, g, S, E, wave_o);
        }
        SEAM(pb + 4);
        REP(2) if (EN(1) && IN(pb + 5)) { KArgs A = kargs(); unsigned char* ws = A->ws; LANE_TID();
            norm_mod_phase(A->out, A->in[5] + l * DM, (const float*)(ws + WS_MOD) + (size_t)l * NB * MODP, 3 * DM, 4 * DM, (bf16*)(ws + WS_H), gw_o, ngw, lane_o); }
        SEAM(pb + 5);
        REP(4) if (EN(7) && IN(pb + 6)) { KArgs A = kargs(); unsigned char* ws = A->ws; LANE_TID();
            pg8::Gemm g{(const bf16*)(ws + WS_H), (const bf16*)(ws + WS_WF1) + (size_t)l * NF1 * DM, MT, NF1, DM}; pg8::StaticOrder S; S.init(MT, NF1, G, (int)blockIdx.x);
            pg8::EpiSwiGLU E{(bf16*)(ws + WS_PROJ), DFF};
            pg8::gemm_phase<pg8::EpiSwiGLU, pg8::StaticOrder, true, true>(lds, g, S, E, wave_o);
        }
        SEAM(pb + 6);
        if (EN(8) && IN(pb + 7)) { KArgs A = kargs(); unsigned char* ws = A->ws; LANE_TID();
            pg8::Gemm g{(const bf16*)(ws + WS_PROJ), (const bf16*)(ws + WS_WF2) + (size_t)l * DM * DFF, MT, DM, DFF}; pg8::StaticOrder S; S.init(MT, DM, G, (int)blockIdx.x);
            pg8::EpiResGate E{A->out, A->out, DM, (const float*)(ws + WS_MOD) + (size_t)l * NB * MODP + 5 * DM, MODP};
            pg8::gemm_phase<pg8::EpiResGate, pg8::StaticOrder, true, true>(lds, g, S, E, wave_o);
        }
        SEAM(pb + 7);
    }
    if (EN(9) && IN(N_PHASES - 1)) { KArgs A = kargs(); int gw_o = gw; asm volatile("" : "+s"(gw_o)); final_norm_phase(A->out, A->in[24], gw_o, ngw, lane_id_opq()); }
#undef IN
#undef SEAM
}

extern "C" void kernel_launch(void* const* d_in, const int* in_sizes, int n_in, void* d_out, int out_size, void* d_ws, size_t ws_size, hipStream_t stream) {
    static int grid = 0;
    if (grid == 0) {
        if (n_in != 25 || in_sizes[0] != MT * DM || out_size != MT * DM || ws_size < WS_END) { fprintf(stderr, "kernel_launch: shape/workspace mismatch (n_in %d, in0 %d, out %d, ws %zu)\n", n_in, n_in > 0 ? in_sizes[0] : -1, out_size, ws_size); grid = -1; return; }
        int dev = 0, cus = 0, per_cu = 0;
        if (hipGetDevice(&dev) != hipSuccess || hipDeviceGetAttribute(&cus, hipDeviceAttributeMultiprocessorCount, dev) != hipSuccess) { grid = -1; return; }
        if (hipFuncSetAttribute((const void*)mk_fwd, hipFuncAttributeMaxDynamicSharedMemorySize, LDS_BYTES) != hipSuccess) { fprintf(stderr, "kernel_launch: hipFuncSetAttribute failed\n"); grid = -1; return; }
        if (hipOccupancyMaxActiveBlocksPerMultiprocessor(&per_cu, (const void*)mk_fwd, NWAVES * 64, LDS_BYTES) != hipSuccess || per_cu < 1) { fprintf(stderr, "kernel_launch: occupancy query says %d\n", per_cu); }
        (void)hipGetLastError();
        grid = cus;
    }
    if (grid < 0) return;
    if (hipMemsetAsync((char*)d_ws + WS_CTL, 0, CTL_ZERO_BYTES, stream) != hipSuccess) return;
    Args a{};
    for (int i = 0; i < 25; ++i) a.in[i] = (const float*)d_in[i];
    a.out = (float*)d_out; a.ws = (unsigned char*)d_ws;
#if MK_PER_PHASE
    for (int p = 0; p < N_PHASES; ++p) { a.ph_lo = p; a.ph_hi = p + 1; a.li = 0; hipLaunchKernelGGL(mk_fwd, dim3(grid), dim3(NWAVES * 64), LDS_BYTES, stream, a); }
#else
    a.ph_lo = 0; a.ph_hi = N_PHASES; a.li = 0;
    hipLaunchKernelGGL(mk_fwd, dim3(grid), dim3(NWAVES * 64), LDS_BYTES, stream, a);
#endif
}
```

```cpp
#include <hip/hip_runtime.h>
#include <cstdio>
#include <cstdint>
__device__ __forceinline__ int lane_id_opq() { int l = (int)__builtin_amdgcn_mbcnt_hi(~0u, __builtin_amdgcn_mbcnt_lo(~0u, 0u)); asm volatile("" : "+v"(l)); return l; }

namespace pg8 {
#define PG8_LAS __attribute__((address_space(3)))
typedef unsigned short bf16_t;
typedef short bf16x8 __attribute__((ext_vector_type(8)));
typedef float f32x4 __attribute__((ext_vector_type(4)));
typedef unsigned u32x4 __attribute__((ext_vector_type(4)));
constexpr int BM = 256, BK = 64, HALF = 128, HTB = HALF * BK * 2  , STAGE_BYTES = 8 * HTB, NXCD = 8, WGM = 8;

__host__ __device__ __forceinline__ int lds_byte(int r, int c) { const int st = (r >> 4) * 2 + (c >> 5), rr = r & 15, cc = c & 31, ob = rr * 64 + cc * 2; return st * 1024 + (ob ^ (((ob >> 9) & 1) << 5)); }
__host__ __device__ __forceinline__ void stage_rc(int b, int& R, int& C) { const int st = b / 1024, sb = b % 1024, swz = sb ^ (((sb >> 9) & 1) << 5); R = (st >> 1) * 16 + swz / 64; C = (st & 1) * 32 + (swz % 64) / 2; }
__host__ __device__ __forceinline__ int perm32(int rho) { const int n = rho >> 4, i = rho & 15; return 8 * (i >> 2) + 4 * n + (i & 3); }

struct Unit { int pm, pn; };
struct Gemm { const bf16_t* A; const bf16_t* Bt; int M, N, K; };

struct StaticOrder {
    int nM, nN, nwg, G, c;
    __host__ __device__ void init(int M, int N, int G_, int c_) { nM = M / BM; nN = N / BM; nwg = nM * nN; G = G_; c = c_; }
    __host__ __device__ bool next(int i, Unit& u) const {
        const long L = (long)i * G + c; if (L >= nwg) return false;
        int wgid = (int)L; { const int q = nwg / NXCD, r = nwg % NXCD, xcd = wgid % NXCD, off = wgid / NXCD; wgid = (xcd < r ? xcd * (q + 1) : r * (q + 1) + (xcd - r) * q) + off; }
        const int nig = WGM * nN, gid = wgid / nig, fm = gid * WGM, gsz = (nM - fm) < WGM ? (nM - fm) : WGM;
        u.pm = fm + ((wgid % nig) % gsz); u.pn = (wgid % nig) / gsz; return true;
    }
    __device__ __forceinline__ void a_ready(const Unit&) const {}
    __device__ __forceinline__ void done(const Unit&) const {}
};

__device__ __forceinline__ unsigned cvt_pk_bf16(float lo, float hi) { unsigned r; asm volatile("v_cvt_pk_bf16_f32 %0, %1, %2" : "=v"(r) : "v"(lo), "v"(hi)); return r; }
typedef float f32x2 __attribute__((ext_vector_type(2)));

typedef float f32x2e __attribute__((ext_vector_type(2)));
typedef __bf16 bf16x2e __attribute__((ext_vector_type(2)));
__device__ __forceinline__ unsigned cvt_pk(float lo, float hi) { const f32x2e v = {lo, hi}; return __builtin_bit_cast(unsigned, __builtin_convertvector(v, bf16x2e)); }
__device__ __forceinline__ float silu_f(float x) { return x * __builtin_amdgcn_rcpf(1.0f + __expf(-x)); }
struct EpiBf16Plain {
    static constexpr bool PERM = true, AFTER_DRAIN = false;
    bf16_t* O; int ldc;
    __device__ __forceinline__ void operator()(const f32x4 (&acc)[2][2][4][2], const Unit& u, int wr, int wc, int fr, int fq) const {
        const int row0 = u.pm * BM + wr * 64 + fr, col0 = u.pn * BM + wc * 32 + 8 * fq;
#pragma unroll
        for (int ai = 0; ai < 2; ++ai)
#pragma unroll
            for (int m = 0; m < 4; ++m) { bf16_t* rowp = O + (size_t)(row0 + ai * HALF + m * 16) * ldc + col0;
#pragma unroll
                for (int bj = 0; bj < 2; ++bj) { const f32x4 v0 = acc[ai][bj][m][0], v1 = acc[ai][bj][m][1];
                    u32x4 w; w.x = cvt_pk(v0[0], v0[1]); w.y = cvt_pk(v0[2], v0[3]); w.z = cvt_pk(v1[0], v1[1]); w.w = cvt_pk(v1[2], v1[3]);
                    *(u32x4*)(rowp + bj * HALF) = w; } }
    }
};
struct EpiSwiGLU {
    static constexpr bool PERM = true, AFTER_DRAIN = false;
    bf16_t* O; int ldc;
    __device__ __forceinline__ void operator()(const f32x4 (&acc)[2][2][4][2], const Unit& u, int wr, int wc, int fr, int fq) const {
        const int row0 = u.pm * BM + wr * 64 + fr, col0 = u.pn * HALF + wc * 32 + 8 * fq;
#pragma unroll
        for (int ai = 0; ai < 2; ++ai)
#pragma unroll
            for (int m = 0; m < 4; ++m) { bf16_t* rowp = O + (size_t)(row0 + ai * HALF + m * 16) * ldc + col0;
                const f32x4 g0 = acc[ai][0][m][0], g1 = acc[ai][0][m][1], u0 = acc[ai][1][m][0], u1 = acc[ai][1][m][1];
                u32x4 w; w.x = cvt_pk(silu_f(g0[0]) * u0[0], silu_f(g0[1]) * u0[1]); w.y = cvt_pk(silu_f(g0[2]) * u0[2], silu_f(g0[3]) * u0[3]);
                w.z = cvt_pk(silu_f(g1[0]) * u1[0], silu_f(g1[1]) * u1[1]); w.w = cvt_pk(silu_f(g1[2]) * u1[2], silu_f(g1[3]) * u1[3]);
                *(u32x4*)rowp = w; }
    }
};
struct EpiResGate {
    static constexpr bool PERM = false, AFTER_DRAIN = false;
    const float* xin32; const bf16_t* xsin; bf16_t* xs; int ldc; const float* gate; int gpitch;
    __device__ __forceinline__ void operator()(const f32x4 (&acc)[2][2][4][2], const Unit& u, int wr, int wc, int fr, int fq) const {
        typedef unsigned u32x2 __attribute__((ext_vector_type(2)));
        const int row0 = u.pm * BM + wr * 64 + fr, col0 = u.pn * BM + wc * 32 + 4 * fq;
        const float* gp = gate + (size_t)(u.pm >> 3) * gpitch + col0;
        f32x4 gv[2][2];
#pragma unroll
        for (int bj = 0; bj < 2; ++bj)
#pragma unroll
            for (int n = 0; n < 2; ++n) gv[bj][n] = *(const f32x4*)(gp + bj * HALF + n * 16);
#pragma unroll
        for (int ai = 0; ai < 2; ++ai)
#pragma unroll
            for (int m = 0; m < 4; ++m) { const size_t off = (size_t)(row0 + ai * HALF + m * 16) * ldc + col0;
#pragma unroll
                for (int bj = 0; bj < 2; ++bj)
#pragma unroll
                    for (int n = 0; n < 2; ++n) { f32x4 xi;
                        if (xin32) xi = *(const f32x4*)(xin32 + off + bj * HALF + n * 16);
                        else { const u32x2 w = *(const u32x2*)(xsin + off + bj * HALF + n * 16); xi = (f32x4){__uint_as_float(w.x << 16), __uint_as_float(w.x & 0xffff0000u), __uint_as_float(w.y << 16), __uint_as_float(w.y & 0xffff0000u)}; }
                        const f32x4 xo = xi + gv[bj][n] * acc[ai][bj][m][n];
                        u32x2 o; o.x = cvt_pk(xo[0], xo[1]); o.y = cvt_pk(xo[2], xo[3]); *(u32x2*)(xs + off + bj * HALF + n * 16) = o; }
                asm volatile("" ::: "memory"); }
    }
};

template <class Epi, class Sched, bool ALIGN_EPI = false, bool SP2 = false>
__device__ __forceinline__ void gemm_phase(PG8_LAS unsigned char* lds, const Gemm g, const Sched& S, const Epi& E, const int wid_in) {
    const int wid = wid_in, lane = lane_id_opq(), tid = wid * 64 + lane, wr = wid >> 2, wc = wid & 3, fr = lane & 15, fq = lane >> 4;
    const int K = g.K, nt = K / BK;
    unsigned voffA[2], voffB[2];
#pragma unroll
    for (int i = 0; i < 2; ++i) { int R, C; stage_rc(tid * 16 + i * 8192, R, C); const int Rb = Epi::PERM ? ((R & ~31) + perm32(R & 31)) : R;
        voffA[i] = (unsigned)(R * K + C) * 2u; voffB[i] = (unsigned)(Rb * K + C) * 2u; }
    const size_t kstep = (size_t)(BK * 2);
    const size_t hstep = (size_t)HALF * K * 2;
    const size_t tstep = 2 * hstep;
    const unsigned ldsw = (unsigned)wid * 1024u;
    const int aoff = lds_byte(wr * 64 + fr, fq * 8), boff = lds_byte(wc * 32 + fr, fq * 8);
#define PG8_SA(b, h) (((b) * 2 + (h)) * HTB)
#define PG8_SB(b, h) ((4 + (b) * 2 + (h)) * HTB)
#define PG8_STAGE(bufoff, gbase, voff) do { _Pragma("unroll") for (int _i = 0; _i < 2; ++_i) \
        __builtin_amdgcn_global_load_lds((const unsigned*)((const char*)(gbase) + (voff)[_i]), (PG8_LAS unsigned*)(lds + (bufoff) + ldsw + _i * 8192), 16, 0, 0); } while (0)
#define PG8_LDA(dst, b, h) do { _Pragma("unroll") for (int m = 0; m < 4; ++m) _Pragma("unroll") for (int k = 0; k < 2; ++k) dst[m][k] = *(const PG8_LAS bf16x8*)(lds + PG8_SA(b, h) + aoff + m * 2048 + k * 1024); } while (0)
#define PG8_LDB(dst, b, h) do { _Pragma("unroll") for (int n = 0; n < 2; ++n) _Pragma("unroll") for (int k = 0; k < 2; ++k) dst[n][k] = *(const PG8_LAS bf16x8*)(lds + PG8_SB(b, h) + boff + n * 2048 + k * 1024); } while (0)
#define PG8_MMA(ai, bj, At, Bt) do { __builtin_amdgcn_s_setprio(1); _Pragma("unroll") for (int m = 0; m < 4; ++m) _Pragma("unroll") for (int n = 0; n < 2; ++n) _Pragma("unroll") for (int k = 0; k < 2; ++k) \
        acc[ai][bj][m][n] = __builtin_amdgcn_mfma_f32_16x16x32_bf16(Bt[n][k], At[m][k], acc[ai][bj][m][n], 0, 0, 0); __builtin_amdgcn_s_setprio(0); } while (0)
#define PG8_WAIT_V(n) asm volatile("s_waitcnt vmcnt(" #n ")" ::: "memory")
#define PG8_WAIT_L(n) asm volatile("s_waitcnt lgkmcnt(" #n ")" ::: "memory")
#define PG8_BAR __builtin_amdgcn_s_barrier()
#define PG8_SCHED __builtin_amdgcn_sched_barrier(0)
    Unit cur, nxt; int ui = 0;
    if (!S.next(0, cur)) return;
    f32x4 acc[2][2][4][2];
#pragma unroll
    for (int a = 0; a < 2; ++a)
#pragma unroll
        for (int b = 0; b < 2; ++b)
#pragma unroll
            for (int m = 0; m < 4; ++m)
#pragma unroll
                for (int n = 0; n < 2; ++n) acc[a][b][m][n] = (f32x4){0.f, 0.f, 0.f, 0.f};
    bf16x8 At[4][2], B0[2][2], B1[2][2];
    const char* cA = (const char*)g.A + (size_t)cur.pm * tstep; const char* cB = (const char*)g.Bt + (size_t)cur.pn * tstep;
    S.a_ready(cur);
    if constexpr (SP2) {
        PG8_STAGE(PG8_SB(0, 0), cB, voffB); PG8_STAGE(PG8_SB(0, 1), cB + hstep, voffB); PG8_STAGE(PG8_SA(0, 0), cA, voffA); PG8_STAGE(PG8_SA(0, 1), cA + hstep, voffA);
        if (wr == 1) PG8_BAR;
        PG8_WAIT_V(2); PG8_BAR;
        PG8_STAGE(PG8_SB(1, 0), cB + kstep, voffB); PG8_STAGE(PG8_SA(1, 0), cA + kstep, voffA); PG8_STAGE(PG8_SB(1, 1), cB + hstep + kstep, voffB);
        PG8_WAIT_V(6); PG8_BAR;
    } else {
        PG8_STAGE(PG8_SB(0, 0), cB, voffB); PG8_STAGE(PG8_SA(0, 0), cA, voffA); PG8_STAGE(PG8_SB(0, 1), cB + hstep, voffB); PG8_STAGE(PG8_SA(0, 1), cA + hstep, voffA);
        if (wr == 1) PG8_BAR;
        PG8_WAIT_V(4); PG8_BAR;
        PG8_STAGE(PG8_SB(1, 0), cB + kstep, voffB); PG8_STAGE(PG8_SA(1, 0), cA + kstep, voffA); PG8_STAGE(PG8_SB(1, 1), cB + hstep + kstep, voffB);
        PG8_WAIT_V(6); PG8_BAR;
    }
    for (;;) {
        const bool has_next = S.next(ui + 1, nxt);
        const char* nA = has_next ? (const char*)g.A + (size_t)nxt.pm * tstep : cA; const char* nB = has_next ? (const char*)g.Bt + (size_t)nxt.pn * tstep : cB;
        for (int t = 0; t < nt; t += 2) {
            const bool last = (t == nt - 2);
            const char* a1 = cA + (size_t)(t + 1) * kstep;
            const char* a2 = last ? nA : cA + (size_t)(t + 2) * kstep; const char* b2 = last ? nB : cB + (size_t)(t + 2) * kstep;
            const char* a3 = a2 + kstep; const char* b3 = b2 + kstep;
            if (last && has_next) S.a_ready(nxt);
            if constexpr (SP2) {
            PG8_LDB(B0, 0, 0); PG8_LDB(B1, 0, 1); PG8_SCHED; PG8_LDA(At, 0, 0); PG8_STAGE(PG8_SA(1, 1), a1 + hstep, voffA);
            PG8_WAIT_V(8); PG8_WAIT_L(0); PG8_BAR; PG8_MMA(0, 0, At, B0); PG8_MMA(0, 1, At, B1); PG8_BAR; PG8_SCHED;
            PG8_LDA(At, 0, 1); PG8_STAGE(PG8_SB(0, 0), b2, voffB); PG8_STAGE(PG8_SB(0, 1), b2 + hstep, voffB); PG8_STAGE(PG8_SA(0, 0), a2, voffA);
            PG8_WAIT_V(8); PG8_WAIT_L(0); PG8_BAR; PG8_MMA(1, 0, At, B0); PG8_MMA(1, 1, At, B1); PG8_BAR; PG8_SCHED;
            PG8_LDB(B0, 1, 0); PG8_LDB(B1, 1, 1); PG8_SCHED; PG8_LDA(At, 1, 0); PG8_STAGE(PG8_SA(0, 1), a2 + hstep, voffA);
            PG8_WAIT_V(8); PG8_WAIT_L(0); PG8_BAR; PG8_MMA(0, 0, At, B0); PG8_MMA(0, 1, At, B1); PG8_BAR; PG8_SCHED;
            PG8_LDA(At, 1, 1); PG8_STAGE(PG8_SB(1, 0), b3, voffB); PG8_STAGE(PG8_SB(1, 1), b3 + hstep, voffB); PG8_STAGE(PG8_SA(1, 0), a3, voffA);
            PG8_WAIT_V(8); PG8_WAIT_L(0); PG8_BAR; PG8_MMA(1, 0, At, B0); PG8_MMA(1, 1, At, B1); PG8_BAR; PG8_SCHED;
            } else {
            PG8_LDB(B0, 0, 0); PG8_SCHED; PG8_LDA(At, 0, 0); PG8_STAGE(PG8_SA(1, 1), a1 + hstep, voffA);
            PG8_WAIT_L(8); PG8_BAR; PG8_WAIT_L(0); PG8_MMA(0, 0, At, B0); PG8_BAR; PG8_SCHED;
            PG8_LDB(B1, 0, 1); PG8_STAGE(PG8_SB(0, 0), b2, voffB);
            PG8_BAR; PG8_WAIT_L(0); PG8_MMA(0, 1, At, B1); PG8_BAR;
            PG8_LDA(At, 0, 1); PG8_STAGE(PG8_SA(0, 0), a2, voffA);
            PG8_BAR; PG8_WAIT_L(0); PG8_MMA(1, 0, At, B0); PG8_BAR; PG8_SCHED;
            PG8_STAGE(PG8_SB(0, 1), b2 + hstep, voffB);
            PG8_WAIT_V(6); PG8_BAR; PG8_MMA(1, 1, At, B1); PG8_BAR;
            PG8_LDB(B0, 1, 0); PG8_SCHED; PG8_LDA(At, 1, 0); PG8_STAGE(PG8_SA(0, 1), a2 + hstep, voffA);
            PG8_WAIT_L(8); PG8_BAR; PG8_WAIT_L(0); PG8_MMA(0, 0, At, B0); PG8_BAR; PG8_SCHED;
            PG8_LDB(B1, 1, 1); PG8_STAGE(PG8_SB(1, 0), b3, voffB);
            PG8_BAR; PG8_WAIT_L(0); PG8_MMA(0, 1, At, B1); PG8_BAR;
            PG8_LDA(At, 1, 1); PG8_STAGE(PG8_SA(1, 0), a3, voffA);
            PG8_BAR; PG8_WAIT_L(0); PG8_MMA(1, 0, At, B0); PG8_BAR; PG8_SCHED;
            PG8_STAGE(PG8_SB(1, 1), b3 + hstep, voffB);
            PG8_WAIT_V(6); PG8_BAR; PG8_MMA(1, 1, At, B1); PG8_BAR;
            }
        }
        if constexpr (ALIGN_EPI) { if (wr == 0) PG8_BAR; }
        if constexpr (!Epi::AFTER_DRAIN) { E(acc, cur, wr, wc, fr, fq); S.done(cur); }
        if (!has_next) break;
#pragma unroll
        for (int a = 0; a < 2; ++a)
#pragma unroll
            for (int b = 0; b < 2; ++b)
#pragma unroll
                for (int m = 0; m < 4; ++m)
#pragma unroll
                    for (int n = 0; n < 2; ++n) acc[a][b][m][n] = (f32x4){0.f, 0.f, 0.f, 0.f};
        cur = nxt; cA = nA; cB = nB; ++ui;
        if constexpr (ALIGN_EPI) { if (wr == 1) PG8_BAR; }
    }
    PG8_WAIT_V(0);
    if constexpr (!ALIGN_EPI) { if (wr == 0) PG8_BAR; }
    PG8_BAR;
    if constexpr (Epi::AFTER_DRAIN) { E.fused(acc, cur, wr, wc, fr, fq, lds, wid, lane); S.done(cur); }
#undef PG8_SA
#undef PG8_SB
#undef PG8_STAGE
#undef PG8_LDA
#undef PG8_LDB
#undef PG8_MMA
#undef PG8_WAIT_V
#undef PG8_WAIT_L
#undef PG8_BAR
#undef PG8_SCHED
}
}

#ifndef MK_PER_PHASE
#define MK_PER_PHASE 0
#endif
constexpr int NWAVES = 8;
constexpr int DM = 1024, NB = 32, SEQ = 2048, NL = 4, MT = NB * SEQ;
constexpr int D_IN = 3976, NPI = 4096, DFF = 2816, NF1 = 2 * DFF;
constexpr int RW_B = 1024, ML_B = 2432;
constexpr int RWKV_IN = 1408;
constexpr float RMS_EPS = 1e-6f, GN_EPS = 1e-5f;
constexpr int MODP = 6 * DM;
constexpr size_t MiB = 1u << 20;
constexpr size_t WS_CTL = 0, CTL_ZERO_BYTES = 1 * MiB;
constexpr size_t WS_HS = 116 * MiB;
constexpr int CW_FLAG = 16384;
constexpr size_t WS_WL = 5 * MiB;
constexpr size_t WS_MOD = 1 * MiB;
constexpr size_t WS_WIN = 8 * MiB, WS_WOUT = 40 * MiB, WS_WF1 = 48 * MiB, WS_WF2 = 92 * MiB;
constexpr size_t WS_H = 128 * MiB;
constexpr size_t WS_PROJ = 256 * MiB;
constexpr size_t WS_XFIN = (256 + 352) * MiB;
constexpr size_t WS_DEC = 768 * MiB, WS_AA = 864 * MiB, WS_GG = 912 * MiB;
constexpr size_t WS_END = 960 * MiB;
constexpr int CW_BAR = 4096;
constexpr int N_PHASES = 2 + 8 * NL;
static_assert((CW_BAR + (MK_PER_PHASE ? 1 : 1) * 3456) * 4 <= (int)CTL_ZERO_BYTES, "ctl");
constexpr int RING_BYTES = 131072, LDS_BYTES = 163840, LDSCTL_OFF = LDS_BYTES - 1024, MISC_OFF = LDSCTL_OFF + 320;

#define GAS __attribute__((address_space(1)))
#define LAS __attribute__((address_space(3)))
typedef unsigned short bf16;
typedef unsigned v4u __attribute__((ext_vector_type(4)));
typedef unsigned v2u __attribute__((ext_vector_type(2)));
typedef float f32x4 __attribute__((ext_vector_type(4)));
#define LDS_WAIT() asm volatile("s_waitcnt lgkmcnt(0)" ::: "memory")
typedef float f32x2c __attribute__((ext_vector_type(2)));
typedef __bf16 bf16x2c __attribute__((ext_vector_type(2)));
__device__ __forceinline__ unsigned f2bf(float f) { return (__builtin_bit_cast(unsigned, f) + 0x8000u) >> 16; }
__device__ __forceinline__ unsigned pk2(float lo, float hi) { return __builtin_amdgcn_perm(__builtin_bit_cast(unsigned, hi) + 0x8000u, __builtin_bit_cast(unsigned, lo) + 0x8000u, 0x07060302u); }
__device__ __forceinline__ float bf2f(bf16 v) { return __uint_as_float(((unsigned)v) << 16); }
template <int CTRL, int ROWMASK> __device__ __forceinline__ float dppf(float v) { return __builtin_bit_cast(float, __builtin_amdgcn_update_dpp(0, __builtin_bit_cast(int, v), CTRL, ROWMASK, 0xf, false)); }
__device__ __forceinline__ float sum16(float v) { v += dppf<0xB1, 0xf>(v); v += dppf<0x4E, 0xf>(v); v += dppf<0x141, 0xf>(v); v += dppf<0x140, 0xf>(v); return v; }
__device__ __forceinline__ float wave_sum(float v) { v = sum16(v); v += dppf<0x142, 0xa>(v); v += dppf<0x143, 0xc>(v); return __builtin_bit_cast(float, __builtin_amdgcn_readlane(__builtin_bit_cast(int, v), 63)); }
template <int CTRL, int ROWMASK> __device__ __forceinline__ float dppo(float v, float old) { return __builtin_bit_cast(float, __builtin_amdgcn_update_dpp(__builtin_bit_cast(int, old), __builtin_bit_cast(int, v), CTRL, ROWMASK, 0xf, false)); }
__device__ __forceinline__ float wave_prefix_sum(float v) { v += dppo<0x111, 0xf>(v, 0.f); v += dppo<0x112, 0xf>(v, 0.f); v += dppo<0x114, 0xf>(v, 0.f); v += dppo<0x118, 0xf>(v, 0.f); v += dppo<0x142, 0xa>(v, 0.f); v += dppo<0x143, 0xc>(v, 0.f); return v; }
__device__ __forceinline__ float wave_prefix_max(float v) { const float ni = -__builtin_inff(); v = fmaxf(v, dppo<0x111, 0xf>(v, ni)); v = fmaxf(v, dppo<0x112, 0xf>(v, ni)); v = fmaxf(v, dppo<0x114, 0xf>(v, ni)); v = fmaxf(v, dppo<0x118, 0xf>(v, ni));
    v = fmaxf(v, dppo<0x142, 0xa>(v, ni)); v = fmaxf(v, dppo<0x143, 0xc>(v, ni)); return v; }
__device__ __forceinline__ float flogsigmoid(float x) { return fminf(x, 0.f) - __logf(1.0f + __expf(-fabsf(x))); }
__device__ __forceinline__ float fexp(float x) { return __expf(x); }
__device__ __forceinline__ float fsigmoid(float x) { return __builtin_amdgcn_rcpf(1.0f + __expf(-x)); }
__device__ __forceinline__ float sigmoid_f(float x) { return 1.0f / (1.0f + expf(-x)); }
__device__ __forceinline__ float logsigmoid_f(float x) { return fminf(x, 0.f) - log1pf(expf(-fabsf(x))); }
template <class T> __device__ __forceinline__ T* opq(T* p) { asm volatile("" : "+s"(p)); return p; }

#define XB_TMO      128
#define XB_XCNT(j)  (256  + 64 * (j))
#define XB_XSUB(j)  (1280 + 64 * (j))
#define XB_XGEN(j)  (2304 + 64 * (j))
#define XB_TOP      3328
#define XB_TOPGEN   3392
#define XCD_BAR_WORDS 3456
#define XB_SPIN_CAP (1u << 22)

__device__ __forceinline__ unsigned xb_ld(unsigned* p)              { return __hip_atomic_load(p, __ATOMIC_RELAXED, __HIP_MEMORY_SCOPE_AGENT); }
__device__ __forceinline__ unsigned xb_add(unsigned* p, unsigned v) { return __hip_atomic_fetch_add(p, v, __ATOMIC_RELAXED, __HIP_MEMORY_SCOPE_AGENT); }
__device__ __forceinline__ unsigned xb_xcc_id() { return (unsigned)__builtin_amdgcn_s_getreg((3 << 11) | 20) & 0xFu; }
#define XB_SPIN(cond, bar) do { unsigned _sp = 0; while (cond) { __builtin_amdgcn_s_sleep(1); \
    if ((++_sp & 255u) == 0u) { if (xb_ld(&(bar)[XB_TMO])) break; if (_sp > XB_SPIN_CAP) { atomicAdd(&(bar)[XB_TMO], 1u); break; } } } } while (0)

struct XcdBarrier {
    unsigned* bar; unsigned x; unsigned w0;
    volatile LAS unsigned* st;
};

__device__ __forceinline__ XcdBarrier xcd_barrier_post(unsigned* bar, volatile LAS unsigned* st) {
    XcdBarrier b; b.bar = bar; b.x = xb_xcc_id(); b.st = st; b.w0 = (__builtin_amdgcn_readfirstlane((int)threadIdx.x >> 6) == 0) ? 1u : 0u;
    if (threadIdx.x == 0) (void)xb_add(&bar[XB_XCNT(b.x)], 1u);
    return b;
}
__device__ __forceinline__ void xcd_barrier_complete(unsigned* bar, unsigned x, unsigned& nloc, unsigned& nx) {
    const unsigned G = gridDim.x * gridDim.y * gridDim.z;
    unsigned sum, cnt, mine, sp = 0u;
    for (;;) {
        sum = 0u; cnt = 0u; mine = 0u;
#pragma unroll
        for (unsigned j = 0; j < 16; ++j) { const unsigned c = xb_ld(&bar[XB_XCNT(j)]); sum += c; cnt += (c > 0u) ? 1u : 0u; mine = (j == x) ? c : mine; }
        if (sum == G) break;
        __builtin_amdgcn_s_sleep(1);
        if ((++sp & 255u) == 0u) { if (xb_ld(&bar[XB_TMO])) break; if (sp > XB_SPIN_CAP) { atomicAdd(&bar[XB_TMO], 1u); break; } }
    }
    nloc = mine > 0u ? mine : 1u; nx = cnt > 0u ? cnt : 1u;
}

__device__ __forceinline__ void xcd_barrier(const XcdBarrier& b) {
    asm volatile("s_waitcnt vmcnt(0)" ::: "memory");
    __syncthreads();
    if (b.w0 != 0u && lane_id_opq() == 0) {
        unsigned* bar = b.bar;
        __builtin_amdgcn_s_waitcnt(0);
        unsigned nloc = b.st[0], nx = b.st[1];
        if (nloc == 0u) { xcd_barrier_complete(bar, b.x, nloc, nx); b.st[0] = nloc; b.st[1] = nx; }
        const unsigned old = xb_add(&bar[XB_XSUB(b.x)], 1u);
        const unsigned gen = old / nloc;
        if (old + 1u == (gen + 1u) * nloc) {
            __builtin_amdgcn_fence(__ATOMIC_RELEASE, "agent");
            asm volatile("s_waitcnt vmcnt(0)" ::: "memory");
            const unsigned og = xb_add(&bar[XB_TOP], 1u);
            const unsigned tg = og / nx;
            if (og + 1u == (tg + 1u) * nx) xb_add(&bar[XB_TOPGEN], 1u);
            else XB_SPIN(xb_ld(&bar[XB_TOPGEN]) == tg, bar);
            __builtin_amdgcn_fence(__ATOMIC_ACQUIRE, "agent");
            xb_add(&bar[XB_XGEN(b.x)], 1u);
            asm volatile("s_waitcnt vmcnt(0)" ::: "memory");
        } else {
            XB_SPIN(xb_ld(&bar[XB_XGEN(b.x)]) == gen, bar);
            __builtin_amdgcn_fence(__ATOMIC_ACQUIRE, "agent");
            asm volatile("s_waitcnt vmcnt(0)" ::: "memory");
        }
    }
    __syncthreads();
}


__device__ __forceinline__ void b32_gemv(const float* Wcol  , bool ok, int N, LAS float* vT, float (&res)[4], int wave, int lane) {
    float acc[32];
#pragma unroll
    for (int b = 0; b < 32; ++b) acc[b] = 0.f;
    const float* wp = Wcol + (size_t)(128 * wave) * N; const LAS float* vp = vT + 128 * wave * 32;
#pragma unroll 1
    for (int kk = 0; kk < 128; kk += 8) {
        float w[8];
#pragma unroll
        for (int u = 0; u < 8; ++u) w[u] = ok ? wp[(size_t)u * N] : 0.f;
        wp += (size_t)8 * N;
#pragma unroll
        for (int u = 0; u < 8; ++u) {
#pragma unroll
            for (int b4 = 0; b4 < 8; ++b4) { const f32x4 cv = *(const LAS f32x4*)(vp + u * 32 + 4 * b4);
                acc[4 * b4] += cv.x * w[u]; acc[4 * b4 + 1] += cv.y * w[u]; acc[4 * b4 + 2] += cv.z * w[u]; acc[4 * b4 + 3] += cv.w * w[u]; }
            asm volatile("" ::: "memory"); }
        vp += 8 * 32;
    }
    __syncthreads();
#pragma unroll
    for (int b = 0; b < 32; ++b) vT[(wave * 32 + b) * 64 + lane] = acc[b];
    __syncthreads();
#pragma unroll
    for (int q = 0; q < 4; ++q) { float s = 0.f;
#pragma unroll
        for (int w2 = 0; w2 < 8; ++w2) s += vT[(w2 * 32 + 4 * wave + q) * 64 + lane];
        res[q] = s; }
    __syncthreads();
}
__device__ __forceinline__ void p0_mod(const float* c, const float* ada_w, const float* ada_b, float* mod, LAS unsigned char* lds, int tid, int lane, int wave) {
    LAS float* condT = (LAS float*)lds;
    for (int item = blockIdx.x; item < NL * 96; item += gridDim.x) {
        __syncthreads();
        for (int e = tid; e < NB * DM; e += NWAVES * 64) { const int k = e >> 5, b = e & 31; const float v = c[b * DM + k]; condT[e] = v / (1.0f + expf(-v)); }
        __syncthreads();
        const int l = item / 96, g = item % 96, n = g * 64 + lane;
        float res[4]; b32_gemv(ada_w + (size_t)l * DM * MODP + n, true, MODP, condT, res, wave, lane);
        const float bb = ada_b[l * MODP + n]; float* o = mod + ((size_t)l * NB + wave * 4) * MODP + n;
        o[0] = res[0] + bb; o[MODP] = res[1] + bb; o[2 * MODP] = res[2] + bb; o[3 * MODP] = res[3] + bb;
    }
    __syncthreads();
}
template <int MODE>
__device__ __forceinline__ void transpose_item(const float* W, int K, int N, int nblk, bf16* WT, int ldw, LAS float* scr, int item, int lane) {
    const int kb = item / nblk, nb = item % nblk, k0 = 64 * kb, n0 = 32 * nb;
    const int nn = n0 + (lane & 31); const bool ok = nn < N;
#pragma unroll 8
    for (int i = 0; i < 32; ++i) { const int kk = 2 * i + (lane >> 5); scr[kk * 33 + (lane & 31)] = ok ? W[(size_t)(k0 + kk) * N + nn] : 0.f; }
    LDS_WAIT();
    const int c = lane & 7;
#pragma unroll
    for (int j = 0; j < 4; ++j) { const int n = (lane >> 3) + 8 * j; const LAS float* s = scr + (8 * c) * 33 + n;
        v4u o; o.x = pk2(s[0 * 33], s[1 * 33]); o.y = pk2(s[2 * 33], s[3 * 33]); o.z = pk2(s[4 * 33], s[5 * 33]); o.w = pk2(s[6 * 33], s[7 * 33]);
        int row = n0 + n;
        if (MODE == 1) { const int up = row >= DFF ? 1 : 0, jj = row - up * DFF; row = (jj >> 7) * 256 + up * 128 + (jj & 127); }
        *(v4u*)(WT + (size_t)row * ldw + k0 + 8 * c) = o; }
    LDS_WAIT();
}
__device__ __forceinline__ void p0_weights(const float* w_in, const float* w_out, const float* f1, const float* f2, const float* lw2, const float* la2, const float* lg2, unsigned char* ws, LAS unsigned char* lds, int gw, int ngw, int wave, int lane) {
    LAS float* scr = (LAS float*)(lds + wave * 16384);
    constexpr int I_IN = (DM / 64) * (NPI / 32), I_OUT = (DM / 64) * (DM / 32), I_F1 = (DM / 64) * (NF1 / 32), I_F2 = (DFF / 64) * (DM / 32), I_L = I_IN + I_OUT + I_F1 + I_F2 + 48;
    for (int it = gw; it < NL * I_L; it += ngw) {
        const int l = it / I_L; int r = it % I_L;
        if (r < I_IN) { transpose_item<0>(w_in + (size_t)l * DM * D_IN, DM, D_IN, NPI / 32, (bf16*)(ws + WS_WIN) + (size_t)l * NPI * DM, DM, scr, r, lane); continue; } r -= I_IN;
        if (r < I_OUT) { transpose_item<0>(w_out + (size_t)l * DM * DM, DM, DM, DM / 32, (bf16*)(ws + WS_WOUT) + (size_t)l * DM * DM, DM, scr, r, lane); continue; } r -= I_OUT;
        if (r < I_F1) { transpose_item<1>(f1 + (size_t)l * DM * NF1, DM, NF1, NF1 / 32, (bf16*)(ws + WS_WF1) + (size_t)l * NF1 * DM, DM, scr, r, lane); continue; } r -= I_F1;
        if (r < I_F2) { transpose_item<0>(f2 + (size_t)l * DFF * DM, DFF, DM, DM / 32, (bf16*)(ws + WS_WF2) + (size_t)l * DM * DFF, DFF, scr, r, lane); continue; } r -= I_F2;
        bf16* wl = (bf16*)(ws + WS_WL) + (size_t)l * 384 * 256;
        if (r < 12) { transpose_item<0>(lw2 + (size_t)l * 64 * 384, 64, 384, 12, wl, 256, scr, r, lane); continue; } r -= 12;
        if (r < 12) { transpose_item<0>(la2 + (size_t)l * 64 * 384, 64, 384, 12, wl + 64, 256, scr, r, lane); continue; } r -= 12;
        transpose_item<0>(lg2 + (size_t)l * 128 * 384, 128, 384, 12, wl + 128, 256, scr, r, lane);
    }
}
__device__ __forceinline__ void norm_mod_phase(const float* xin32, const bf16* xs, const float* gain, const float* modl, int sh_off, int sc_off, bf16* out, int gw, int ngw, int lane) {
    for (int ci = gw; ci < MT / 32; ci += ngw) {
        const int b = ci >> 6; const float* mb = modl + (size_t)b * MODP;
        f32x4 gs[4], sh[4];
#pragma unroll
        for (int j = 0; j < 4; ++j) { const int col = 4 * lane + 256 * j; const f32x4 g = *(const f32x4*)(gain + col), s = *(const f32x4*)(mb + sc_off + col); gs[j] = g * (s + 1.0f); sh[j] = *(const f32x4*)(mb + sh_off + col); }
        for (int r = 0; r < 32; ++r) {
            const size_t row = (size_t)ci * 32 + r;
            f32x4 v[4]; float ss = 0.f;
            if (xin32) { const f32x4* xr = (const f32x4*)(xin32 + row * DM) + lane;
#pragma unroll
                for (int j = 0; j < 4; ++j) v[j] = xr[64 * j];
            } else { const v2u* xr = (const v2u*)(xs + row * DM) + lane;
#pragma unroll
                for (int j = 0; j < 4; ++j) { const v2u w = xr[64 * j]; v[j] = (f32x4){__uint_as_float(w.x << 16), __uint_as_float(w.x & 0xffff0000u), __uint_as_float(w.y << 16), __uint_as_float(w.y & 0xffff0000u)}; } }
#pragma unroll
            for (int j = 0; j < 4; ++j) ss += (v[j].x * v[j].x + v[j].y * v[j].y) + (v[j].z * v[j].z + v[j].w * v[j].w);
            const float rstd = 1.0f / sqrtf(wave_sum(ss) * (1.0f / DM) + RMS_EPS);
            v2u* o8 = (v2u*)(out + row * DM) + lane;
#pragma unroll
            for (int j = 0; j < 4; ++j) { const f32x4 y = v[j] * rstd * gs[j] + sh[j]; v2u w; w.x = pk2(y.x, y.y); w.y = pk2(y.z, y.w); o8[64 * j] = w; }
        }
    }
}
__device__ __forceinline__ void final_norm_phase(const bf16* xs, float* out, const float* gain, int gw, int ngw, int lane) {
    f32x4 g[4];
#pragma unroll
    for (int j = 0; j < 4; ++j) g[j] = *(const f32x4*)(gain + 4 * lane + 256 * j);
    for (int row = gw; row < MT; row += ngw) {
        const v2u* xr = (const v2u*)(xs + (size_t)row * DM) + lane; f32x4 v[4]; float ss = 0.f;
#pragma unroll
        for (int j = 0; j < 4; ++j) { const v2u w = xr[64 * j]; v[j] = (f32x4){__uint_as_float(w.x << 16), __uint_as_float(w.x & 0xffff0000u), __uint_as_float(w.y << 16), __uint_as_float(w.y & 0xffff0000u)};
            ss += (v[j].x * v[j].x + v[j].y * v[j].y) + (v[j].z * v[j].z + v[j].w * v[j].w); }
        const float rstd = 1.0f / sqrtf(wave_sum(ss) * (1.0f / DM) + RMS_EPS);
        f32x4* o = (f32x4*)(out + (size_t)row * DM) + lane;
#pragma unroll
        for (int j = 0; j < 4; ++j) o[64 * j] = v[j] * rstd * g[j];
    }
}
#define WG_BAR() do { asm volatile("s_waitcnt vmcnt(0) lgkmcnt(0)" ::: "memory"); __builtin_amdgcn_s_barrier(); asm volatile("" ::: "memory"); } while (0)
#define WG_BAR_L() do { asm volatile("s_waitcnt lgkmcnt(0)" ::: "memory"); __builtin_amdgcn_s_barrier(); asm volatile("" ::: "memory"); } while (0)
typedef short bf16x8p __attribute__((ext_vector_type(8)));
__device__ __forceinline__ void rwkv_prep_mfma(const bf16* proj, const float* mu, const float* w0, const float* a0, const bf16* WL, float* DEC, bf16* AA, bf16* GG, LAS unsigned char* lds, int wave) {
    constexpr int AP = 264;
    LAS bf16* act = (LAS bf16*)lds;
#pragma unroll 1
    for (int item = blockIdx.x; item < MT / 64; item += gridDim.x) {
        const int lane = lane_id_opq(), tid = wave * 64 + lane, q4 = lane >> 4, lc = lane & 15;
        const size_t m0 = (size_t)item * 64; const int t0 = (int)(m0 % SEQ);
        { const int tt = tid >> 3, cg = tid & 7; const bf16* p = proj + (m0 + tt) * NPI + RW_B + 1152 + 32 * cg; const bool hp = (t0 + tt) > 0; const float* mup = mu + 1152 + 32 * cg;
#pragma unroll
          for (int v = 0; v < 4; ++v) { const v4u cur = *(const v4u*)(p + 8 * v); v4u prv = (v4u){0u, 0u, 0u, 0u}; if (hp) prv = *(const v4u*)(p - NPI + 8 * v);
              const f32x4 m0v = *(const f32x4*)(mup + 8 * v), m1v = *(const f32x4*)(mup + 8 * v + 4);
              float x[8];
#pragma unroll
              for (int e = 0; e < 4; ++e) { const unsigned cw = cur[e], pw = prv[e]; const float c0 = __uint_as_float(cw << 16), c1 = __uint_as_float(cw & 0xffff0000u), p0 = __uint_as_float(pw << 16), p1 = __uint_as_float(pw & 0xffff0000u);
                  const float mu0 = e < 2 ? m0v[2 * e] : m1v[2 * e - 4], mu1 = e < 2 ? m0v[2 * e + 1] : m1v[2 * e - 3];
                  x[2 * e] = c0 + (p0 - c0) * mu0; x[2 * e + 1] = c1 + (p1 - c1) * mu1; }
              if (cg < 2) {
#pragma unroll
                  for (int e = 0; e < 8; ++e) x[e] = 2.0f * fsigmoid(2.0f * x[e]) - 1.0f;
              } else if (cg >= 4) {
#pragma unroll
                  for (int e = 0; e < 8; ++e) x[e] = fsigmoid(x[e]);
              }
              v4u o; o.x = pk2(x[0], x[1]); o.y = pk2(x[2], x[3]); o.z = pk2(x[4], x[5]); o.w = pk2(x[6], x[7]);
              *(LAS v4u*)(act + tt * AP + 32 * cg + 8 * v) = o; } }
        WG_BAR_L();
        const LAS bf16* afr = act + lc * AP + 8 * q4;
        const bf16* bfr = WL + (size_t)(48 * wave + lc) * 256 + 8 * q4;
        { f32x4 acc[4][3];
#pragma unroll
          for (int mt = 0; mt < 4; ++mt)
#pragma unroll
              for (int nt = 0; nt < 3; ++nt) acc[mt][nt] = (f32x4){0.f, 0.f, 0.f, 0.f};
#pragma unroll
          for (int ks = 0; ks < 2; ++ks) { bf16x8p bq[3];
#pragma unroll
              for (int nt = 0; nt < 3; ++nt) bq[nt] = *(const bf16x8p*)(bfr + 16 * nt * 256 + 32 * ks);
#pragma unroll
              for (int mt = 0; mt < 4; ++mt) { const bf16x8p aq = *(const LAS bf16x8p*)(afr + 16 * mt * AP + 32 * ks);
#pragma unroll
                  for (int nt = 0; nt < 3; ++nt) acc[mt][nt] = __builtin_amdgcn_mfma_f32_16x16x32_bf16(aq, bq[nt], acc[mt][nt], 0, 0, 0); } }
#pragma unroll
          for (int nt = 0; nt < 3; ++nt) { const int n = 48 * wave + 16 * nt + lc; const float w0n = w0[n]; float carry = 0.f;
#pragma unroll
              for (int mt = 0; mt < 4; ++mt) { float pr[4];
#pragma unroll
                  for (int r = 0; r < 4; ++r) { const float ld = -0.60653066f * fsigmoid(w0n + acc[mt][nt][r]); pr[r] = r ? pr[r - 1] + ld : ld; }
                  const float tot = pr[3]; float s1 = tot; { const float u = __shfl_up(s1, 16); if (q4 >= 1) s1 += u; } { const float u = __shfl_up(s1, 32); if (q4 >= 2) s1 += u; }
                  const float excl = carry + (s1 - tot), tile_tot = __shfl(s1, 48 + lc);
                  float* dp = DEC + (m0 + 16 * mt + 4 * q4) * 384 + n;
#pragma unroll
                  for (int r = 0; r < 4; ++r) dp[r * 384] = excl + pr[r];
                  carry += tile_tot; } } }
        { f32x4 acc[4][3];
#pragma unroll
          for (int mt = 0; mt < 4; ++mt)
#pragma unroll
              for (int nt = 0; nt < 3; ++nt) acc[mt][nt] = (f32x4){0.f, 0.f, 0.f, 0.f};
#pragma unroll
          for (int ks = 0; ks < 2; ++ks) { bf16x8p bq[3];
#pragma unroll
              for (int nt = 0; nt < 3; ++nt) bq[nt] = *(const bf16x8p*)(bfr + 16 * nt * 256 + 64 + 32 * ks);
#pragma unroll
              for (int mt = 0; mt < 4; ++mt) { const bf16x8p aq = *(const LAS bf16x8p*)(afr + 16 * mt * AP + 64 + 32 * ks);
#pragma unroll
                  for (int nt = 0; nt < 3; ++nt) acc[mt][nt] = __builtin_amdgcn_mfma_f32_16x16x32_bf16(aq, bq[nt], acc[mt][nt], 0, 0, 0); } }
#pragma unroll
          for (int nt = 0; nt < 3; ++nt) { const int n = 48 * wave + 16 * nt + lc; const float a0n = a0[n];
#pragma unroll
              for (int mt = 0; mt < 4; ++mt) { bf16* dp = AA + (m0 + 16 * mt + 4 * q4) * 384 + n;
#pragma unroll
                  for (int r = 0; r < 4; ++r) dp[r * 384] = (bf16)f2bf(fsigmoid(a0n + acc[mt][nt][r])); } } }
        { f32x4 acc[4][3];
#pragma unroll
          for (int mt = 0; mt < 4; ++mt)
#pragma unroll
              for (int nt = 0; nt < 3; ++nt) acc[mt][nt] = (f32x4){0.f, 0.f, 0.f, 0.f};
#pragma unroll
          for (int ks = 0; ks < 4; ++ks) { bf16x8p bq[3];
#pragma unroll
              for (int nt = 0; nt < 3; ++nt) bq[nt] = *(const bf16x8p*)(bfr + 16 * nt * 256 + 128 + 32 * ks);
#pragma unroll
              for (int mt = 0; mt < 4; ++mt) { const bf16x8p aq = *(const LAS bf16x8p*)(afr + 16 * mt * AP + 128 + 32 * ks);
#pragma unroll
                  for (int nt = 0; nt < 3; ++nt) acc[mt][nt] = __builtin_amdgcn_mfma_f32_16x16x32_bf16(aq, bq[nt], acc[mt][nt], 0, 0, 0); } }
#pragma unroll
          for (int nt = 0; nt < 3; ++nt) { const int n = 48 * wave + 16 * nt + lc;
#pragma unroll
              for (int mt = 0; mt < 4; ++mt) { bf16* dp = GG + (m0 + 16 * mt + 4 * q4) * 384 + n;
#pragma unroll
                  for (int r = 0; r < 4; ++r) dp[r * 384] = (bf16)f2bf(acc[mt][nt][r]); } } }
        WG_BAR_L();
    }
}
typedef short bf16x8_t __attribute__((ext_vector_type(8)));
template <int KS>
__device__ __forceinline__ f32x4 mm_tile(const LAS bf16* A, const LAS bf16* B, f32x4 acc) {
#pragma unroll
    for (int ks = 0; ks < KS; ++ks) {
        const bf16x8_t a = *(const LAS bf16x8_t*)(A + ks * 32), b = *(const LAS bf16x8_t*)(B + ks * 32);
        acc = __builtin_amdgcn_mfma_f32_16x16x32_bf16(a, b, acc, 0, 0, 0);
    }
    return acc;
}
__device__ __forceinline__ unsigned short f2bf16(float f) { return (unsigned short)f2bf(f); }
constexpr int LP = 72;
constexpr int LPM = 104;

__device__ __forceinline__ void ret_unit(int b, int h, const bf16* proj, const float* gn, bf16* mixed, LAS unsigned char* lds, int wave, int lane0) {
    LAS bf16* Qs = (LAS bf16*)lds; LAS bf16* Ks = Qs + 64 * LP; LAS bf16* Kdt = Ks + 64 * LP; LAS bf16* Vt = Kdt + 64 * LP; LAS bf16* Ps = Vt + 64 * LP; LAS bf16* Stt = Ps + 64 * LP; LAS bf16* Gs = Stt + 64 * LP;
    const int lane = lane0, q4 = lane >> 4, lc = lane & 15;
    const float inv = powf(10000.0f, -(float)(2 * (lane & 31)) / 64.0f);
    float cs[8], sn[8];
#pragma unroll
    for (int i = 0; i < 8; ++i) sincosf((float)(8 * wave + i) * inv, &sn[i], &cs[i]);
    float c64, s64; sincosf(64.0f * inv, &s64, &c64);
    const float lg2 = log2f(1.0f - exp2f(-5.0f - (float)h));
    float kdec[8];
#pragma unroll
    for (int i = 0; i < 8; ++i) kdec[i] = exp2f((float)(63 - (8 * wave + i)) * lg2);
    const float cd = exp2f(64.0f * lg2);
    f32x4 st[4];
#pragma unroll
    for (int i = 0; i < 4; ++i) st[i] = (f32x4){0.f, 0.f, 0.f, 0.f};
    for (int i = wave * 64 + lane; i < 64 * LP / 2; i += 512) ((LAS unsigned*)Stt)[i] = 0u;
    const size_t m0 = (size_t)b * SEQ;
    const bf16* P0 = proj + m0 * NPI + h * 64;
    unsigned short rq[8], rk[8], rv[8], rg[8];
#pragma unroll
    for (int i = 0; i < 8; ++i) { const bf16* p = P0 + (size_t)(8 * wave + i) * NPI; rq[i] = p[lane]; rk[i] = p[256 + lane]; rv[i] = p[512 + lane]; rg[i] = p[768 + lane]; }
    float gain4[4];
#pragma unroll
    for (int ct = 0; ct < 4; ++ct) gain4[ct] = gn[h * 64 + 16 * ct + lc];
#pragma unroll 1
    for (int c = 0; c < SEQ / 64; ++c) {
        const int lane = lane_id_opq(), q4 = lane >> 4, lc = lane & 15, o72 = lc * LP + 8 * q4;
        { unsigned short kd[8];
#pragma unroll
          for (int i = 0; i < 8; ++i) { const int tt = 8 * wave + i;
              const float q = bf2f(rq[i]), k = bf2f(rk[i]); const float qp = __shfl_xor(q, 32), kp = __shfl_xor(k, 32);
              const float qr = lane < 32 ? q * cs[i] - qp * sn[i] : qp * sn[i] + q * cs[i];
              const float kr = (lane < 32 ? k * cs[i] - kp * sn[i] : kp * sn[i] + k * cs[i]) * 0.125f;
              Qs[tt * LP + lane] = f2bf16(qr); Ks[tt * LP + lane] = f2bf16(kr); Gs[tt * LP + lane] = rg[i]; kd[i] = f2bf16(kr * kdec[i]);
              const float cn = cs[i] * c64 - sn[i] * s64, snn = sn[i] * c64 + cs[i] * s64; cs[i] = cn; sn[i] = snn; }
          v4u w; w.x = kd[0] | ((unsigned)kd[1] << 16); w.y = kd[2] | ((unsigned)kd[3] << 16); w.z = kd[4] | ((unsigned)kd[5] << 16); w.w = kd[6] | ((unsigned)kd[7] << 16);
          *(LAS v4u*)(Kdt + lane * LP + 8 * wave) = w;
          w.x = rv[0] | ((unsigned)rv[1] << 16); w.y = rv[2] | ((unsigned)rv[3] << 16); w.z = rv[4] | ((unsigned)rv[5] << 16); w.w = rv[6] | ((unsigned)rv[7] << 16);
          *(LAS v4u*)(Vt + lane * LP + 8 * wave) = w; }
        WG_BAR_L();
        if (c + 1 < SEQ / 64) {
#pragma unroll
            for (int i = 0; i < 8; ++i) { const bf16* p = P0 + (size_t)(64 * (c + 1) + 8 * wave + i) * NPI; rq[i] = p[lane]; rk[i] = p[256 + lane]; rv[i] = p[512 + lane]; rg[i] = p[768 + lane]; } }
        { const int rt = wave >> 1;
#pragma unroll
          for (int u = 0; u < 2; ++u) { const int ct = 2 * (wave & 1) + u;
              f32x4 s = (f32x4){0.f, 0.f, 0.f, 0.f};
              if (ct <= rt) s = mm_tile<2>(Qs + 16 * rt * LP + o72, Ks + 16 * ct * LP + o72, s);
#pragma unroll
              for (int r = 0; r < 4; ++r) { const int l = 16 * rt + 4 * q4 + r, m = 16 * ct + lc; const float val = (l >= m) ? s[r] * exp2f((float)(l - m) * lg2) : 0.f; Ps[l * LP + m] = f2bf16(val); } } }
        f32x4 inter[4];
        if (wave < 4) {
#pragma unroll
            for (int ct = 0; ct < 4; ++ct) inter[ct] = mm_tile<2>(Qs + 16 * wave * LP + o72, Stt + 16 * ct * LP + o72, (f32x4){0.f, 0.f, 0.f, 0.f}); }
        WG_BAR_L();
        if (wave < 4) {
            f32x4 y[4];
#pragma unroll
            for (int ct = 0; ct < 4; ++ct) y[ct] = mm_tile<2>(Ps + 16 * wave * LP + o72, Vt + 16 * ct * LP + o72, (f32x4){0.f, 0.f, 0.f, 0.f});
#pragma unroll
            for (int r = 0; r < 4; ++r) { const int l = 16 * wave + 4 * q4 + r; const float qd = exp2f((float)(l + 1) * lg2);
                float s = 0.f;
#pragma unroll
                for (int ct = 0; ct < 4; ++ct) { y[ct][r] += qd * inter[ct][r]; s += y[ct][r]; }
                const float mean = sum16(s) * (1.0f / 64.0f); float qv = 0.f;
#pragma unroll
                for (int ct = 0; ct < 4; ++ct) { const float dd = y[ct][r] - mean; qv += dd * dd; }
                const float rstd = 1.0f / sqrtf(sum16(qv) * (1.0f / 64.0f) + GN_EPS);
                bf16* orow = mixed + (m0 + 64 * c + l) * DM + h * 64 + lc;
#pragma unroll
                for (int ct = 0; ct < 4; ++ct) { const float g = bf2f(Gs[l * LP + 16 * ct + lc]); orow[16 * ct] = f2bf16((y[ct][r] - mean) * rstd * gain4[ct] * (g * fsigmoid(g))); } }
        } else {
            const int dt = wave - 4;
#pragma unroll
            for (int ct = 0; ct < 4; ++ct) { st[ct] = mm_tile<2>(Kdt + 16 * dt * LP + o72, Vt + 16 * ct * LP + o72, st[ct] * cd);
                v2u w; w.x = pk2(st[ct][0], st[ct][1]); w.y = pk2(st[ct][2], st[ct][3]);
                *(LAS v2u*)(Stt + (16 * ct + lc) * LP + 16 * dt + 4 * q4) = w; }
        }
        WG_BAR_L();
    }
}

__device__ __forceinline__ void mlstm_unit(int b, int h, const bf16* proj, const float* conv_w, const float* conv_b, const float* i_b, const float* f_b, const float* gn, bf16* mixed,
                                           LAS unsigned char* lds, int wave, int lane0) {
    LAS bf16* Qs = (LAS bf16*)lds; LAS bf16* Ks = Qs + 64 * LPM; LAS bf16* Kdt = Ks + 64 * LPM; LAS bf16* Vt = Kdt + 96 * LP; LAS bf16* Ps = Vt + 112 * LP; LAS bf16* Stt = Ps + 64 * LP; LAS bf16* Os = Stt + 112 * LPM;
    LAS float* ev = (LAS float*)(Os + 64 * LPM); LAS float* pmv = ev + 64; LAS float* flv = pmv + 64;
    const int lane = lane0, lc = lane & 15;
    float wq0[4], wq1[4], wk0[4], wk1[4], bq0, bq1, bk0, bk1;
    { const int cq0 = h * 96 + lane, cq1 = h * 96 + 64 + (lane & 31), ck0 = 384 + cq0, ck1 = 384 + cq1;
#pragma unroll
    for (int j = 0; j < 4; ++j) { wq0[j] = conv_w[j * 768 + cq0]; wq1[j] = conv_w[j * 768 + cq1]; wk0[j] = conv_w[j * 768 + ck0]; wk1[j] = conv_w[j * 768 + ck1]; }
    bq0 = conv_b[cq0]; bq1 = conv_b[cq1]; bk0 = conv_b[ck0]; bk1 = conv_b[ck1]; }
    const float ib = i_b[h], fb = f_b[h];
    const float ksc = 0.10206207261596577f;
    f32x4 st[11];
#pragma unroll
    for (int i = 0; i < 11; ++i) st[i] = (f32x4){0.f, 0.f, 0.f, 0.f};
    for (int i = wave * 64 + lane; i < 112 * LPM / 2; i += 512) ((LAS unsigned*)Stt)[i] = 0u;
    for (int i = wave * 64 + lane; i < 16 * LP / 2; i += 512) ((LAS unsigned*)(Vt + 96 * LP))[i] = (i < LP / 2) ? 0x3f803f80u : 0u;
    float mprev = 0.f;
    const size_t m0 = (size_t)b * SEQ;
    const bf16* PB = proj + m0 * NPI + ML_B;
    float gain6[6];
#pragma unroll
    for (int ct = 0; ct < 6; ++ct) gain6[ct] = gn[640 + h * 96 + 16 * ct + lc];
    unsigned xq[11], xk[11], vv[8], gg;
#define ML_LOAD(cc) do { const int tb_ = 64 * (cc) + 8 * wave; \
        _Pragma("unroll") for (int i = 0; i < 11; ++i) { const int t_ = tb_ - 3 + i; const bool ok_ = t_ >= 0; const bf16* p_ = PB + (size_t)(ok_ ? t_ : 0) * NPI; \
            const unsigned a0_ = ok_ ? p_[cq0] : 0u, a1_ = (ok_ && has1) ? p_[cq1] : 0u, b0_ = ok_ ? p_[ck0] : 0u, b1_ = (ok_ && has1) ? p_[ck1] : 0u; xq[i] = a0_ | (a1_ << 16); xk[i] = b0_ | (b1_ << 16); } \
        _Pragma("unroll") for (int i = 0; i < 8; ++i) { const bf16* p_ = PB + (size_t)(tb_ + i) * NPI + 768 + h * 96; const unsigned a0_ = p_[d0], a1_ = has1 ? p_[d1] : 0u; vv[i] = a0_ | (a1_ << 16); } \
        { const bf16* p_ = PB + (size_t)(64 * (cc) + lane) * NPI; const unsigned a0_ = p_[1536 + h], a1_ = p_[1540 + h]; gg = a0_ | (a1_ << 16); } } while (0)
    { const int d0 = lane, d1 = 64 + (lane & 31); const bool has1 = lane < 32; const int cq0 = h * 96 + d0, cq1 = h * 96 + d1, ck0 = 384 + cq0, ck1 = 384 + cq1; ML_LOAD(0); }
#pragma unroll 1
    for (int c = 0; c < SEQ / 64; ++c) {
        const int lane = lane_id_opq(), q4 = lane >> 4, lc = lane & 15, o72 = lc * LP + 8 * q4, o104 = lc * LPM + 8 * q4;
        const int d0 = lane, d1 = 64 + (lane & 31); const bool has1 = lane < 32;
        const int cq0 = h * 96 + d0, cq1 = h * 96 + d1, ck0 = 384 + cq0, ck1 = 384 + cq1;
        const int tb = 64 * c + 8 * wave;
        float pm63, carry, ev_l; const float mold = mprev;
        { const float ic = __uint_as_float(gg << 16) + ib, lf = flogsigmoid(__uint_as_float(gg & 0xffff0000u) + fb);
          const float bc = wave_prefix_sum(lf), e = ic - bc; const float pm = fmaxf(wave_prefix_max(e), mprev);
          pm63 = __builtin_bit_cast(float, __builtin_amdgcn_readlane(__builtin_bit_cast(int, pm), 63)); carry = fexp(mprev - pm63); ev_l = e;
          if (wave == 0) { ev[lane] = e; pmv[lane] = pm; flv[lane] = fexp(-(bc + pm)); }
          mprev = __builtin_bit_cast(float, __builtin_amdgcn_readlane(__builtin_bit_cast(int, bc), 63)) + pm63; }
        { unsigned short kd0[8], kd1[8];
#pragma unroll
          for (int i = 0; i < 8; ++i) { const int tt = 8 * wave + i;
#define LO_(w) __uint_as_float((w) << 16)
#define HI_(w) __uint_as_float((w) & 0xffff0000u)
              float q0 = bq0 + LO_(xq[i]) * wq0[0] + LO_(xq[i + 1]) * wq0[1] + LO_(xq[i + 2]) * wq0[2] + LO_(xq[i + 3]) * wq0[3];
              float k0 = bk0 + LO_(xk[i]) * wk0[0] + LO_(xk[i + 1]) * wk0[1] + LO_(xk[i + 2]) * wk0[2] + LO_(xk[i + 3]) * wk0[3];
              float q1 = bq1 + HI_(xq[i]) * wq1[0] + HI_(xq[i + 1]) * wq1[1] + HI_(xq[i + 2]) * wq1[2] + HI_(xq[i + 3]) * wq1[3];
              float k1 = bk1 + HI_(xk[i]) * wk1[0] + HI_(xk[i + 1]) * wk1[1] + HI_(xk[i + 2]) * wk1[2] + HI_(xk[i + 3]) * wk1[3];
#undef LO_
#undef HI_
              q0 = q0 * fsigmoid(q0); k0 = k0 * fsigmoid(k0) * ksc; q1 = q1 * fsigmoid(q1); k1 = k1 * fsigmoid(k1) * ksc;
              const float wsi = fexp(__builtin_bit_cast(float, __builtin_amdgcn_readlane(__builtin_bit_cast(int, ev_l), tt)) - pm63);
              Qs[tt * LPM + d0] = f2bf16(q0); Ks[tt * LPM + d0] = f2bf16(k0); kd0[i] = f2bf16(k0 * wsi); kd1[i] = f2bf16(k1 * wsi);
              if (has1) { Qs[tt * LPM + d1] = f2bf16(q1); Ks[tt * LPM + d1] = f2bf16(k1); } }
          v4u w; w.x = kd0[0] | ((unsigned)kd0[1] << 16); w.y = kd0[2] | ((unsigned)kd0[3] << 16); w.z = kd0[4] | ((unsigned)kd0[5] << 16); w.w = kd0[6] | ((unsigned)kd0[7] << 16);
          *(LAS v4u*)(Kdt + d0 * LP + 8 * wave) = w;
          if (has1) { w.x = kd1[0] | ((unsigned)kd1[1] << 16); w.y = kd1[2] | ((unsigned)kd1[3] << 16); w.z = kd1[4] | ((unsigned)kd1[5] << 16); w.w = kd1[6] | ((unsigned)kd1[7] << 16);
              *(LAS v4u*)(Kdt + d1 * LP + 8 * wave) = w; }
          w.x = (vv[0] & 0xffffu) | (vv[1] << 16); w.y = (vv[2] & 0xffffu) | (vv[3] << 16); w.z = (vv[4] & 0xffffu) | (vv[5] << 16); w.w = (vv[6] & 0xffffu) | (vv[7] << 16);
          *(LAS v4u*)(Vt + d0 * LP + 8 * wave) = w;
          if (has1) { w.x = (vv[0] >> 16) | (vv[1] & 0xffff0000u); w.y = (vv[2] >> 16) | (vv[3] & 0xffff0000u); w.z = (vv[4] >> 16) | (vv[5] & 0xffff0000u); w.w = (vv[6] >> 16) | (vv[7] & 0xffff0000u);
              *(LAS v4u*)(Vt + d1 * LP + 8 * wave) = w; } }
        WG_BAR_L();
        unsigned og[8];
#pragma unroll
        for (int i = 0; i < 8; ++i) { const bf16* p = PB + (size_t)(tb + i) * NPI + 1152 + h * 96; const unsigned a0_ = p[d0], a1_ = has1 ? p[d1] : 0u; og[i] = a0_ | (a1_ << 16); }
        if (c + 1 < SEQ / 64) ML_LOAD(c + 1);
        { const int rt = wave >> 1;
#pragma unroll
          for (int u = 0; u < 2; ++u) { const int ct = 2 * (wave & 1) + u;
              f32x4 s = (f32x4){0.f, 0.f, 0.f, 0.f};
              if (ct <= rt) s = mm_tile<3>(Qs + 16 * rt * LPM + o104, Ks + 16 * ct * LPM + o104, s);
              const float em = ev[16 * ct + lc];
#pragma unroll
              for (int r = 0; r < 4; ++r) { const int l = 16 * rt + 4 * q4 + r, m = 16 * ct + lc; const float val = (l >= m) ? s[r] * fexp(em - pmv[l]) : 0.f; Ps[l * LP + m] = f2bf16(val); } } }
        f32x4 inter[7];
        if (wave < 4) {
#pragma unroll
            for (int ct = 0; ct < 7; ++ct) inter[ct] = mm_tile<3>(Qs + 16 * wave * LPM + o104, Stt + 16 * ct * LPM + o104, (f32x4){0.f, 0.f, 0.f, 0.f}); }
#pragma unroll
        for (int i = 0; i < 8; ++i) { Os[(8 * wave + i) * LPM + d0] = (unsigned short)(og[i] & 0xffffu); if (has1) Os[(8 * wave + i) * LPM + d1] = (unsigned short)(og[i] >> 16); }
        WG_BAR_L();
        if (wave < 4) {
            f32x4 y[7];
#pragma unroll
            for (int ct = 0; ct < 7; ++ct) y[ct] = mm_tile<2>(Ps + 16 * wave * LP + o72, Vt + 16 * ct * LP + o72, (f32x4){0.f, 0.f, 0.f, 0.f});
#pragma unroll
            for (int r = 0; r < 4; ++r) { const int l = 16 * wave + 4 * q4 + r; const float iw = fexp(mold - pmv[l]);
#pragma unroll
                for (int ct = 0; ct < 7; ++ct) y[ct][r] += iw * inter[ct][r];
                const float den = __shfl(y[6][r], lane & 48);
                const float dn = 1.0f / fmaxf(fabsf(den), flv[l]);
                float s = 0.f;
#pragma unroll
                for (int ct = 0; ct < 6; ++ct) { y[ct][r] *= dn; s += y[ct][r]; }
                const float mean = sum16(s) * (1.0f / 96.0f); float qv = 0.f;
#pragma unroll
                for (int ct = 0; ct < 6; ++ct) { const float dd = y[ct][r] - mean; qv += dd * dd; }
                const float rstd = 1.0f / sqrtf(sum16(qv) * (1.0f / 96.0f) + GN_EPS);
                bf16* orow = mixed + (m0 + 64 * c + l) * DM + 640 + h * 96 + lc;
#pragma unroll
                for (int ct = 0; ct < 6; ++ct) { const float o = bf2f(Os[l * LPM + 16 * ct + lc]); orow[16 * ct] = f2bf16((y[ct][r] - mean) * rstd * gain6[ct] * fsigmoid(o)); } }
        } else {
#pragma unroll
            for (int i = 0; i < 11; ++i) { const int t = (wave - 4) + 4 * i;
                if (t < 42) { const int dt = t / 7, et = t % 7;
                    st[i] = mm_tile<2>(Kdt + 16 * dt * LP + o72, Vt + 16 * et * LP + o72, st[i] * carry);
                    v2u w; w.x = pk2(st[i][0], st[i][1]); w.y = pk2(st[i][2], st[i][3]);
                    *(LAS v2u*)(Stt + (16 * et + lc) * LPM + 16 * dt + 4 * q4) = w; } }
        }
        WG_BAR_L();
    }
#undef ML_LOAD
}
#ifndef RW_DBG
#define RW_DBG 0xFF
#endif
__device__ __forceinline__ void rwkv_unit(int b, int h, const bf16* proj, const float* CUM, const bf16* AA, const bf16* GG, const float* mu, const float* k_k, const float* k_a, const float* r_k,
                                          const float* gn, bf16* mixed, LAS unsigned char* lds, int wave, int lane0,
                                          int cb, int ce, const float* hs_in, unsigned* flag_in, float* hs_out, unsigned* flag_out) {
    constexpr int SLOT = 64 * LP;
    LAS bf16* KH = (LAS bf16*)lds; LAS bf16* BH = KH + SLOT; LAS bf16* KT = BH + SLOT; LAS bf16* RT = KT + SLOT; LAS bf16* KHgt = RT + SLOT; LAS bf16* BHgtn = KHgt + SLOT;
    LAS bf16* Vt = BHgtn + SLOT; LAS bf16* AkT = Vt + SLOT; LAS bf16* BbTn = AkT + SLOT; LAS bf16* BkT = BbTn + SLOT; LAS bf16* S0b = BkT + SLOT; LAS bf16* Loffb = S0b + SLOT; LAS bf16* Vr = Loffb + SLOT; LAS bf16* Gr = Vr + SLOT;
    LAS float* RHS = (LAS float*)KH; LAS bf16* Ut = KT;
    LAS float* LTd = (LAS float*)(Gr + SLOT);
    LAS float* XS = LTd + 64 * 20;
    LAS float* GCv = XS + 16 * 64; LAS float* bonv = GCv + 64;
    float mu_r, mu_k, mu_v, kkc, kac, rkc;
    { const int c0 = h * 64 + lane0; mu_r = mu[c0]; mu_k = mu[384 + c0]; mu_v = mu[768 + c0]; kkc = k_k[c0]; kac = k_a[c0]; rkc = r_k[c0]; }
    for (int i = wave * 64 + lane0; i < 5 * SLOT / 2; i += 512) ((LAS unsigned*)AkT)[i] = 0u;
    float gain4[4];
#pragma unroll
    for (int ct = 0; ct < 4; ++ct) gain4[ct] = gn[256 + h * 64 + 16 * ct + (lane0 & 15)];
    f32x4 sacc[4];
#pragma unroll
    for (int i = 0; i < 4; ++i) sacc[i] = (f32x4){0.f, 0.f, 0.f, 0.f};
    if (hs_in) {
        if (wave == 0) { unsigned spins = 0u;
            while (__hip_atomic_load(flag_in, __ATOMIC_RELAXED, __HIP_MEMORY_SCOPE_AGENT) == 0u) { __builtin_amdgcn_s_sleep(4); if (++spins > (1u << 22)) break; }
            __builtin_amdgcn_fence(__ATOMIC_ACQUIRE, "agent"); asm volatile("s_waitcnt vmcnt(0)" ::: "memory"); }
        WG_BAR();
        if (wave >= 4) {
#pragma unroll
            for (int jt = 0; jt < 4; ++jt) {
#pragma unroll
                for (int r = 0; r < 4; ++r) { sacc[jt][r] = hs_in[((wave - 4) * 4 + jt) * 256 + r * 64 + lane0];
                    S0b[(16 * (wave - 4) + 4 * (lane0 >> 4) + r) * LP + 16 * jt + (lane0 & 15)] = f2bf16(sacc[jt][r]); } } }
    }
    const size_t m0 = (size_t)b * SEQ;
    const bf16* PU = proj + m0 * NPI + RW_B + h * 64;
    const float* CU = CUM + m0 * 384 + h * 64; const bf16* AU = AA + m0 * 384 + h * 64; const bf16* GU = GG + m0 * 384 + h * 64;
    unsigned short rr[9], rk[9], rv[9], ra[8], rg[8]; float rc[9], rc63;
#define RWKV_LOAD(cc) do { const int tb_ = 64 * (cc) + 8 * wave; \
        _Pragma("unroll") for (int i = 0; i < 9; ++i) { const int t_ = tb_ - 1 + i; const bool ok_ = t_ >= 0; const bf16* p_ = PU + (size_t)(ok_ ? t_ : 0) * NPI; \
            rr[i] = ok_ ? p_[lane] : (unsigned short)0; rk[i] = ok_ ? p_[384 + lane] : (unsigned short)0; rv[i] = ok_ ? p_[768 + lane] : (unsigned short)0; \
            rc[i] = (i > 0 || wave > 0) ? CU[(size_t)(ok_ ? t_ : 0) * 384 + lane] : 0.f; if (i > 0) { ra[i - 1] = AU[(size_t)t_ * 384 + lane]; rg[i - 1] = GU[(size_t)t_ * 384 + lane]; } } \
        rc63 = CU[(size_t)(64 * (cc) + 63) * 384 + lane]; } while (0)
    { const int lane = lane0; RWKV_LOAD(cb); }
#pragma unroll 1
    for (int c = cb; c < ce; ++c) {
        const int lane = lane_id_opq(), q4 = lane >> 4, lc = lane & 15, o72 = lc * LP + 8 * q4;
        if (RW_DBG & 1) { unsigned short khg[8], bhg[8]; const float gc63 = fexp(rc63); float ecp = fexp(rc[0]);
#pragma unroll
          for (int i = 0; i < 8; ++i) { const int tt = 8 * wave + i;
              const float cr = bf2f(rr[i + 1]), ck = bf2f(rk[i + 1]);
              const float r = cr + (bf2f(rr[i]) - cr) * mu_r, k = ck + (bf2f(rk[i]) - ck) * mu_k, a = bf2f(ra[i]);
              float kk = k * kkc; kk = kk * __builtin_amdgcn_rsqf(fmaxf(wave_sum(kk * kk), 1e-24f));
              const float kmod = k * (1.0f + (a - 1.0f) * kac), beta = kk * a;
              const float bon = wave_sum(r * kmod * rkc); if (lane == 0) bonv[tt] = bon;
              const float cm = rc[i + 1], cp = rc[i];
              const float em = fexp(-cm), eg = gc63 * em, ec = __builtin_amdgcn_rcpf(em);
              KH[tt * LP + lane] = f2bf16(kmod * em); BH[tt * LP + lane] = f2bf16(beta * em); KT[tt * LP + lane] = f2bf16(kk * ecp); RT[tt * LP + lane] = f2bf16(r * ec); ecp = ec;
              khg[i] = f2bf16(kmod * eg); bhg[i] = f2bf16(-beta * eg); }
          v4u w; w.x = khg[0] | ((unsigned)khg[1] << 16); w.y = khg[2] | ((unsigned)khg[3] << 16); w.z = khg[4] | ((unsigned)khg[5] << 16); w.w = khg[6] | ((unsigned)khg[7] << 16);
          *(LAS v4u*)(KHgt + lane * LP + 8 * wave) = w;
          w.x = bhg[0] | ((unsigned)bhg[1] << 16); w.y = bhg[2] | ((unsigned)bhg[3] << 16); w.z = bhg[4] | ((unsigned)bhg[5] << 16); w.w = bhg[6] | ((unsigned)bhg[7] << 16);
          *(LAS v4u*)(BHgtn + lane * LP + 8 * wave) = w;
          unsigned short vs[8];
#pragma unroll
          for (int i = 0; i < 8; ++i) { const float cv = bf2f(rv[i + 1]); vs[i] = f2bf16(cv + (bf2f(rv[i]) - cv) * mu_v); Vr[(8 * wave + i) * LP + lane] = vs[i]; Gr[(8 * wave + i) * LP + lane] = rg[i]; }
          w.x = vs[0] | ((unsigned)vs[1] << 16); w.y = vs[2] | ((unsigned)vs[3] << 16); w.z = vs[4] | ((unsigned)vs[5] << 16); w.w = vs[6] | ((unsigned)vs[7] << 16);
          *(LAS v4u*)(Vt + lane * LP + 8 * wave) = w;
          if (wave == 0) GCv[lane] = gc63; }
        WG_BAR_L();
#pragma unroll
        for (int u2 = 0; u2 < 2; ++u2) { const int idx = 2 * wave + u2, rt = idx >> 2, ct = idx & 3;
            if (ct <= rt) {
                const int s = 16 * ct + lc; const LAS bf16* kt = KT + 16 * rt * LP + o72; const LAS bf16* rtp = RT + 16 * rt * LP + o72; const LAS bf16* bh = BH + 16 * ct * LP + o72; const LAS bf16* kh = KH + 16 * ct * LP + o72;
                const f32x4 z = (f32x4){0.f, 0.f, 0.f, 0.f};
                const f32x4 g0 = mm_tile<2>(kt, bh, z), g1 = mm_tile<2>(kt, kh, z), g2 = mm_tile<2>(rtp, bh, z), g3 = mm_tile<2>(rtp, kh, z);
#pragma unroll
                for (int r = 0; r < 4; ++r) { const int t = 16 * rt + 4 * q4 + r;
                    if (ct < rt) Loffb[t * LP + s] = f2bf16(g0[r]); else LTd[s * 20 + (t - 16 * rt)] = (s < t) ? g0[r] : 0.f;
                    AkT[t * LP + s] = f2bf16((s < t) ? g1[r] : 0.f);
                    BbTn[t * LP + s] = f2bf16((s <= t) ? -g2[r] : 0.f);
                    BkT[t * LP + s] = f2bf16((s <= t) ? g3[r] : 0.f); } } }
        WG_BAR_L();
#pragma unroll
        for (int u = 0; u < ((RW_DBG & 4) ? 2 : 0); ++u) { const int rt = wave >> 1, ct = 2 * (wave & 1) + u;
            f32x4 g = mm_tile<2>(KT + 16 * rt * LP + o72, S0b + 16 * ct * LP + o72, (f32x4){0.f, 0.f, 0.f, 0.f});
            g = mm_tile<2>(AkT + 16 * rt * LP + o72, Vt + 16 * ct * LP + o72, g);
#pragma unroll
            for (int r = 0; r < 4; ++r) RHS[(16 * rt + 4 * q4 + r) * 64 + 16 * ct + lc] = g[r]; }
        WG_BAR_L();
        f32x4 y[4];
        if ((RW_DBG & 8) && wave == 0) {
#pragma unroll
            for (int a = 0; a < 4; ++a) {
                if (a > 0) {
#pragma unroll
                    for (int it = 0; it < 4; ++it) { f32x4 cr = (f32x4){0.f, 0.f, 0.f, 0.f};
                        if (a == 3) cr = mm_tile<2>(Loffb + 16 * a * LP + o72, Ut + 16 * it * LP + o72, cr); else cr = mm_tile<1>(Loffb + 16 * a * LP + o72, Ut + 16 * it * LP + o72, cr);
#pragma unroll
                        for (int r = 0; r < 4; ++r) XS[(4 * q4 + r) * 64 + 16 * it + lc] = cr[r]; }
                    asm volatile("s_waitcnt lgkmcnt(0)" ::: "memory");
                }
                float acc[16];
#pragma unroll
                for (int t = 0; t < 16; ++t) acc[t] = RHS[(16 * a + t) * 64 + lane] - (a > 0 ? XS[t * 64 + lane] : 0.f);
                const LAS float* Ld = LTd + 16 * a * 20; asm volatile("" : "+v"(Ld));
#pragma unroll
                for (int s2 = 0; s2 < 15; ++s2) { const float us = acc[s2];
#pragma unroll
                    for (int t4 = (s2 + 1) / 4; t4 < 4; ++t4) { const f32x4 l4 = *(const LAS f32x4*)(Ld + s2 * 20 + 4 * t4);
                        acc[4 * t4] -= l4.x * us; acc[4 * t4 + 1] -= l4.y * us; acc[4 * t4 + 2] -= l4.z * us; acc[4 * t4 + 3] -= l4.w * us; }
                    if (s2 == 3 || s2 == 7) asm volatile("" : "+v"(Ld) : "v"(acc[s2 + 1])); }
                v4u w; w.x = pk2(acc[0], acc[1]); w.y = pk2(acc[2], acc[3]); w.z = pk2(acc[4], acc[5]); w.w = pk2(acc[6], acc[7]);
                *(LAS v4u*)(Ut + lane * LP + 16 * a) = w;
                w.x = pk2(acc[8], acc[9]); w.y = pk2(acc[10], acc[11]); w.z = pk2(acc[12], acc[13]); w.w = pk2(acc[14], acc[15]);
                *(LAS v4u*)(Ut + lane * LP + 16 * a + 8) = w;
                asm volatile("s_waitcnt lgkmcnt(0)" ::: "memory");
            }
        }
        if (c + 1 < ce) RWKV_LOAD(c + 1);
        if (wave < 4) {
#pragma unroll
            for (int ct = 0; ct < 4; ++ct) { y[ct] = mm_tile<2>(RT + 16 * wave * LP + o72, S0b + 16 * ct * LP + o72, (f32x4){0.f, 0.f, 0.f, 0.f}); y[ct] = mm_tile<2>(BkT + 16 * wave * LP + o72, Vt + 16 * ct * LP + o72, y[ct]); }
        } else {
#pragma unroll
            for (int jt = 0; jt < 4; ++jt) { const float gc = GCv[16 * jt + lc]; sacc[jt] = mm_tile<2>(Vt + 16 * (wave - 4) * LP + o72, KHgt + 16 * jt * LP + o72, sacc[jt] * gc); }
        }
        WG_BAR_L();
        if (wave < 4) {
#pragma unroll
            for (int ct = 0; ct < 4; ++ct) y[ct] = mm_tile<2>(BbTn + 16 * wave * LP + o72, Ut + 16 * ct * LP + o72, y[ct]);
#pragma unroll
            for (int r = 0; r < 4; ++r) { const int t = 16 * wave + 4 * q4 + r; const size_t row = m0 + 64 * c + t;
                float s = 0.f;
#pragma unroll
                for (int ct = 0; ct < 4; ++ct) s += y[ct][r];
                const float mean = sum16(s) * (1.0f / 64.0f); float qv = 0.f;
#pragma unroll
                for (int ct = 0; ct < 4; ++ct) { const float dd = y[ct][r] - mean; qv += dd * dd; }
                const float rstd = 1.0f / sqrtf(sum16(qv) * (1.0f / 64.0f) + GN_EPS);
                const float bon = bonv[t]; bf16* orow = mixed + row * DM + 256 + h * 64 + lc;
#pragma unroll
                for (int ct = 0; ct < 4; ++ct) orow[16 * ct] = f2bf16(((y[ct][r] - mean) * rstd * gain4[ct] + bon * bf2f(Vr[t * LP + 16 * ct + lc])) * bf2f(Gr[t * LP + 16 * ct + lc])); }
        } else {
#pragma unroll
            for (int jt = 0; jt < 4; ++jt) { sacc[jt] = mm_tile<2>(Ut + 16 * (wave - 4) * LP + o72, BHgtn + 16 * jt * LP + o72, sacc[jt]);
#pragma unroll
                for (int r = 0; r < 4; ++r) S0b[(16 * (wave - 4) + 4 * q4 + r) * LP + 16 * jt + lc] = f2bf16(sacc[jt][r]); }
        }
        WG_BAR_L();
    }
    if (hs_out) {
        if (wave >= 4) {
#pragma unroll
            for (int jt = 0; jt < 4; ++jt)
#pragma unroll
                for (int r = 0; r < 4; ++r) __hip_atomic_store(hs_out + ((wave - 4) * 4 + jt) * 256 + r * 64 + lane0, sacc[jt][r], __ATOMIC_RELAXED, __HIP_MEMORY_SCOPE_AGENT);
        }
        WG_BAR();
        if (wave == 4 && lane0 == 0) __hip_atomic_store(flag_out, 1u, __ATOMIC_RELAXED, __HIP_MEMORY_SCOPE_AGENT);
    }
#undef RWKV_LOAD
}

struct Args { const float* in[25]; float* out; unsigned char* ws; int ph_lo, ph_hi, li, pad; };
typedef const __attribute__((address_space(4))) Args* KArgs;
__device__ __forceinline__ KArgs kargs() { KArgs p = (KArgs)__builtin_amdgcn_kernarg_segment_ptr(); asm volatile("" : "+s"(p)); return p; }
#ifndef DBG_MASK
#define DBG_MASK 0xFFFF
#endif
#define EN(bit) ((DBG_MASK >> (bit)) & 1)
#ifndef PROBE_DUP
#define PROBE_DUP 0
#endif
#define REP(bit) for (int rep_ = 0; rep_ < (((PROBE_DUP >> (bit)) & 1) ? 2 : 1); ++rep_)
__global__ void __launch_bounds__(NWAVES * 64, 2) mk_fwd(Args args_unused) {
    extern __shared__ __attribute__((aligned(16))) unsigned char lds_raw[];
    LAS unsigned char* lds = (LAS unsigned char*)lds_raw;
    volatile LAS unsigned* MISC = (volatile LAS unsigned*)(lds + MISC_OFF);
    const int wave = __builtin_amdgcn_readfirstlane((int)threadIdx.x >> 6);
    const int G = gridDim.x, gw = blockIdx.x * NWAVES + wave, ngw = G * NWAVES;
    for (int u = threadIdx.x; u < (LDS_BYTES - LDSCTL_OFF) / 4; u += NWAVES * 64) ((LAS unsigned*)(lds + LDSCTL_OFF))[u] = 0u;
    __syncthreads();
    XcdBarrier bar; int lo, hi;
    { KArgs A = kargs(); bar = xcd_barrier_post((unsigned*)(A->ws + WS_CTL) + CW_BAR + (MK_PER_PHASE ? 0 : A->li) * XCD_BAR_WORDS, MISC + 8); lo = A->ph_lo; hi = A->ph_hi; }
#define IN(k) (lo <= (k) && (k) < hi)
#define SEAM(k) do { if (IN(k) && IN((k) + 1)) xcd_barrier(bar); } while (0)
#define LANE_TID() int wave_o = wave, gw_o = gw; asm volatile("" : "+s"(wave_o), "+s"(gw_o)); (void)gw_o; const int lane_o = lane_id_opq(), tid_o = wave_o * 64 + lane_o; (void)tid_o

    if (EN(0) && IN(0)) {
        KArgs A = kargs(); unsigned char* ws = A->ws; LANE_TID();
        p0_mod(A->in[1], A->in[2], A->in[3], (float*)(ws + WS_MOD), lds, tid_o, lane_o, wave_o);
        p0_weights(A->in[6], A->in[21], A->in[22], A->in[23], A->in[10], A->in[12], A->in[13], ws, lds, gw_o, ngw, wave_o, lane_o);
    }
    SEAM(0);
#pragma unroll 1
    for (int l = 0; l < NL; ++l) {
        const int pb = 1 + 8 * l;
        REP(2) if (EN(1) && IN(pb + 0)) { KArgs A = kargs(); unsigned char* ws = A->ws; LANE_TID();
            norm_mod_phase(l == 0 ? A->in[0] : (const float*)nullptr, (const bf16*)A->out, A->in[4] + l * DM, (const float*)(ws + WS_MOD) + (size_t)l * NB * MODP, 0, DM, (bf16*)(ws + WS_H), gw_o, ngw, lane_o); }
        SEAM(pb + 0);
        REP(3) if (EN(2) && IN(pb + 1)) { KArgs A = kargs(); unsigned char* ws = A->ws; LANE_TID();
            pg8::Gemm g{(const bf16*)(ws + WS_H), (const bf16*)(ws + WS_WIN) + (size_t)l * NPI * DM, MT, NPI, DM}; pg8::StaticOrder S; S.init(MT, NPI, G, (int)blockIdx.x);
            pg8::EpiBf16Plain E{(bf16*)(ws + WS_PROJ), NPI};
            pg8::gemm_phase<pg8::EpiBf16Plain, pg8::StaticOrder, true, true>(lds, g, S, E, wave_o);
        }
        SEAM(pb + 1);
        REP(1) if (EN(3) && IN(pb + 2)) { KArgs A = kargs(); unsigned char* ws = A->ws; LANE_TID();
            rwkv_prep_mfma((const bf16*)(ws + WS_PROJ), A->in[8] + l * RWKV_IN, A->in[9] + l * 384, A->in[11] + l * 384, (const bf16*)(ws + WS_WL) + (size_t)l * 384 * 256,
                           (float*)(ws + WS_DEC), (bf16*)(ws + WS_AA), (bf16*)(ws + WS_GG), lds, wave_o); }
        SEAM(pb + 2);
        REP(0) if (EN(4) && IN(pb + 3)) { KArgs A = kargs(); unsigned char* ws = A->ws; LANE_TID();
            const float* gn = A->in[7] + l * DM; const bf16* PROJ = (const bf16*)(ws + WS_PROJ); bf16* Hb = (bf16*)(ws + WS_H);
            int u = (int)blockIdx.x; asm volatile("" : "+s"(u));
            float* HS = (float*)(ws + WS_HS) + (size_t)l * 64 * 4096; unsigned* FL = (unsigned*)(ws + WS_CTL) + CW_FLAG + l * 64 * 64;
            const float* DECp = (const float*)(ws + WS_DEC); const bf16* AAp = (const bf16*)(ws + WS_AA); const bf16* GGp = (const bf16*)(ws + WS_GG);
            if (u < 128) {
                mlstm_unit(u >> 2, u & 3, PROJ, A->in[17] + (size_t)l * 4 * 768, A->in[18] + l * 768, A->in[19] + l * 4, A->in[20] + l * 4, gn, Hb, lds, wave_o, lane_o);
            } else {
                const int v0 = u - 128, k = v0 & 63; const bool dgrp = v0 >= 64;
#pragma unroll 1
                for (int rep = 0; rep < 2; ++rep) { const bool half = (rep == 0) == dgrp; const int q = half ? 128 + k : v0;
                    const int cb = (half && !dgrp) ? 16 : 0, ce = (half && dgrp) ? 16 : 32;
                    rwkv_unit(q / 6, q % 6, PROJ, DECp, AAp, GGp, A->in[8] + l * RWKV_IN, A->in[14] + l * 384, A->in[15] + l * 384, A->in[16] + l * 384, gn, Hb, lds, wave_o, lane_o,
                              cb, ce, (half && !dgrp) ? HS + (size_t)k * 4096 : nullptr, (half && !dgrp) ? FL + k * 64 : nullptr, (half && dgrp) ? HS + (size_t)k * 4096 : nullptr, (half && dgrp) ? FL + k * 64 : nullptr); }
                ret_unit(v0 >> 2, v0 & 3, PROJ, gn, Hb, lds, wave_o, lane_o);
            }
        }
        SEAM(pb + 3);
        if (EN(6) && IN(pb + 4)) { KArgs A = kargs(); unsigned char* ws = A->ws; LANE_TID();
            pg8::Gemm g{(const bf16*)(ws + WS_H), (const bf16*)(ws + WS_WOUT) + (size_t)l * DM * DM, MT, DM, DM}; pg8::StaticOrder S; S.init(MT, DM, G, (int)blockIdx.x);
            pg8::EpiResGate E{l == 0 ? A->in[0] : (const float*)nullptr, (const bf16*)A->out, (bf16*)A->out, DM, (const float*)(ws + WS_MOD) + (size_t)l * NB * MODP + 2 * DM, MODP};
            pg8::gemm_phase<pg8::EpiResGate, pg8::StaticOrder, true, true>(lds, g, S, E, wave_o);
        }
        SEAM(pb + 4);
        REP(2) if (EN(1) && IN(pb + 5)) { KArgs A = kargs(); unsigned char* ws = A->ws; LANE_TID();
            norm_mod_phase((const float*)nullptr, (const bf16*)A->out, A->in[5] + l * DM, (const float*)(ws + WS_MOD) + (size_t)l * NB * MODP, 3 * DM, 4 * DM, (bf16*)(ws + WS_H), gw_o, ngw, lane_o); }
        SEAM(pb + 5);
        REP(4) if (EN(7) && IN(pb + 6)) { KArgs A = kargs(); unsigned char* ws = A->ws; LANE_TID();
            pg8::Gemm g{(const bf16*)(ws + WS_H), (const bf16*)(ws + WS_WF1) + (size_t)l * NF1 * DM, MT, NF1, DM}; pg8::StaticOrder S; S.init(MT, NF1, G, (int)blockIdx.x);
            pg8::EpiSwiGLU E{(bf16*)(ws + WS_PROJ), DFF};
            pg8::gemm_phase<pg8::EpiSwiGLU, pg8::StaticOrder, true, true>(lds, g, S, E, wave_o);
        }
        SEAM(pb + 6);
        if (EN(8) && IN(pb + 7)) { KArgs A = kargs(); unsigned char* ws = A->ws; LANE_TID();
            pg8::Gemm g{(const bf16*)(ws + WS_PROJ), (const bf16*)(ws + WS_WF2) + (size_t)l * DM * DFF, MT, DM, DFF}; pg8::StaticOrder S; S.init(MT, DM, G, (int)blockIdx.x);
            pg8::EpiResGate E{(const float*)nullptr, (const bf16*)A->out, l + 1 < NL ? (bf16*)A->out : (bf16*)(ws + WS_XFIN), DM, (const float*)(ws + WS_MOD) + (size_t)l * NB * MODP + 5 * DM, MODP};
            pg8::gemm_phase<pg8::EpiResGate, pg8::StaticOrder, true, true>(lds, g, S, E, wave_o);
        }
        SEAM(pb + 7);
    }
    if (EN(9) && IN(N_PHASES - 1)) { KArgs A = kargs(); int gw_o = gw; asm volatile("" : "+s"(gw_o)); final_norm_phase((const bf16*)(A->ws + WS_XFIN), A->out, A->in[24], gw_o, ngw, lane_id_opq()); }
#undef IN
#undef SEAM
}

extern "C" void kernel_launch(void* const* d_in, const int* in_sizes, int n_in, void* d_out, int out_size, void* d_ws, size_t ws_size, hipStream_t stream) {
    static int grid = 0;
    if (grid == 0) {
        if (n_in != 25 || in_sizes[0] != MT * DM || out_size != MT * DM || ws_size < WS_END) { fprintf(stderr, "kernel_launch: shape/workspace mismatch (n_in %d, in0 %d, out %d, ws %zu)\n", n_in, n_in > 0 ? in_sizes[0] : -1, out_size, ws_size); grid = -1; return; }
        int dev = 0, cus = 0, per_cu = 0;
        if (hipGetDevice(&dev) != hipSuccess || hipDeviceGetAttribute(&cus, hipDeviceAttributeMultiprocessorCount, dev) != hipSuccess) { grid = -1; return; }
        if (hipFuncSetAttribute((const void*)mk_fwd, hipFuncAttributeMaxDynamicSharedMemorySize, LDS_BYTES) != hipSuccess) { fprintf(stderr, "kernel_launch: hipFuncSetAttribute failed\n"); grid = -1; return; }
        if (hipOccupancyMaxActiveBlocksPerMultiprocessor(&per_cu, (const void*)mk_fwd, NWAVES * 64, LDS_BYTES) != hipSuccess || per_cu < 1) { fprintf(stderr, "kernel_launch: occupancy query says %d\n", per_cu); }
        (void)hipGetLastError();
        grid = cus;
    }
    if (grid < 0) return;
    if (hipMemsetAsync((char*)d_ws + WS_CTL, 0, CTL_ZERO_BYTES, stream) != hipSuccess) return;
    Args a{};
    for (int i = 0; i < 25; ++i) a.in[i] = (const float*)d_in[i];
    a.out = (float*)d_out; a.ws = (unsigned char*)d_ws;
#if MK_PER_PHASE
    for (int p = 0; p < N_PHASES; ++p) { a.ph_lo = p; a.ph_hi = p + 1; a.li = 0; hipLaunchKernelGGL(mk_fwd, dim3(grid), dim3(NWAVES * 64), LDS_BYTES, stream, a); }
#else
    a.ph_lo = 0; a.ph_hi = N_PHASES; a.li = 0;
    hipLaunchKernelGGL(mk_fwd, dim3(grid), dim3(NWAVES * 64), LDS_BYTES, stream, a);
#endif
}
```

```cpp
#include <hip/hip_runtime.h>
#include <cstdio>
#include <cstdint>
__device__ __forceinline__ int lane_id_opq() { int l = (int)__builtin_amdgcn_mbcnt_hi(~0u, __builtin_amdgcn_mbcnt_lo(~0u, 0u)); asm volatile("" : "+v"(l)); return l; }

namespace pg8 {
#define PG8_LAS __attribute__((address_space(3)))
typedef unsigned short bf16_t;
typedef short bf16x8 __attribute__((ext_vector_type(8)));
typedef float f32x4 __attribute__((ext_vector_type(4)));
typedef unsigned u32x4 __attribute__((ext_vector_type(4)));
constexpr int BM = 256, BK = 64, HALF = 128, HTB = HALF * BK * 2  , STAGE_BYTES = 8 * HTB, NXCD = 8, WGM = 8;

__host__ __device__ __forceinline__ int lds_byte(int r, int c) { const int st = (r >> 4) * 2 + (c >> 5), rr = r & 15, cc = c & 31, ob = rr * 64 + cc * 2; return st * 1024 + (ob ^ (((ob >> 9) & 1) << 5)); }
__host__ __device__ __forceinline__ void stage_rc(int b, int& R, int& C) { const int st = b / 1024, sb = b % 1024, swz = sb ^ (((sb >> 9) & 1) << 5); R = (st >> 1) * 16 + swz / 64; C = (st & 1) * 32 + (swz % 64) / 2; }
__host__ __device__ __forceinline__ int perm32(int rho) { const int n = rho >> 4, i = rho & 15; return 8 * (i >> 2) + 4 * n + (i & 3); }

struct Unit { int pm, pn; };
struct Gemm { const bf16_t* A; const bf16_t* Bt; int M, N, K; };

struct StaticOrder {
    int nM, nN, nwg, G, c;
    __host__ __device__ void init(int M, int N, int G_, int c_) { nM = M / BM; nN = N / BM; nwg = nM * nN; G = G_; c = c_; }
    __host__ __device__ bool next(int i, Unit& u) const {
        const long L = (long)i * G + c; if (L >= nwg) return false;
        int wgid = (int)L; { const int q = nwg / NXCD, r = nwg % NXCD, xcd = wgid % NXCD, off = wgid / NXCD; wgid = (xcd < r ? xcd * (q + 1) : r * (q + 1) + (xcd - r) * q) + off; }
        const int nig = WGM * nN, gid = wgid / nig, fm = gid * WGM, gsz = (nM - fm) < WGM ? (nM - fm) : WGM;
        u.pm = fm + ((wgid % nig) % gsz); u.pn = (wgid % nig) / gsz; return true;
    }
    __device__ __forceinline__ void a_ready(const Unit&) const {}
    __device__ __forceinline__ void done(const Unit&) const {}
};

__device__ __forceinline__ unsigned cvt_pk_bf16(float lo, float hi) { unsigned r; asm volatile("v_cvt_pk_bf16_f32 %0, %1, %2" : "=v"(r) : "v"(lo), "v"(hi)); return r; }
typedef float f32x2 __attribute__((ext_vector_type(2)));

typedef float f32x2e __attribute__((ext_vector_type(2)));
typedef __bf16 bf16x2e __attribute__((ext_vector_type(2)));
__device__ __forceinline__ unsigned cvt_pk(float lo, float hi) { const f32x2e v = {lo, hi}; return __builtin_bit_cast(unsigned, __builtin_convertvector(v, bf16x2e)); }
__device__ __forceinline__ float silu_f(float x) { return x * __builtin_amdgcn_rcpf(1.0f + __expf(-x)); }
struct EpiBf16Plain {
    static constexpr bool PERM = true, AFTER_DRAIN = false;
    bf16_t* O; int ldc;
    __device__ __forceinline__ void operator()(const f32x4 (&acc)[2][2][4][2], const Unit& u, int wr, int wc, int fr, int fq) const {
        const int row0 = u.pm * BM + wr * 64 + fr, col0 = u.pn * BM + wc * 32 + 8 * fq;
#pragma unroll
        for (int ai = 0; ai < 2; ++ai)
#pragma unroll
            for (int m = 0; m < 4; ++m) { bf16_t* rowp = O + (size_t)(row0 + ai * HALF + m * 16) * ldc + col0;
#pragma unroll
                for (int bj = 0; bj < 2; ++bj) { const f32x4 v0 = acc[ai][bj][m][0], v1 = acc[ai][bj][m][1];
                    u32x4 w; w.x = cvt_pk(v0[0], v0[1]); w.y = cvt_pk(v0[2], v0[3]); w.z = cvt_pk(v1[0], v1[1]); w.w = cvt_pk(v1[2], v1[3]);
                    *(u32x4*)(rowp + bj * HALF) = w; } }
    }
};
struct EpiSwiGLU {
    static constexpr bool PERM = true, AFTER_DRAIN = false;
    bf16_t* O; int ldc;
    __device__ __forceinline__ void operator()(const f32x4 (&acc)[2][2][4][2], const Unit& u, int wr, int wc, int fr, int fq) const {
        const int row0 = u.pm * BM + wr * 64 + fr, col0 = u.pn * HALF + wc * 32 + 8 * fq;
#pragma unroll
        for (int ai = 0; ai < 2; ++ai)
#pragma unroll
            for (int m = 0; m < 4; ++m) { bf16_t* rowp = O + (size_t)(row0 + ai * HALF + m * 16) * ldc + col0;
                const f32x4 g0 = acc[ai][0][m][0], g1 = acc[ai][0][m][1], u0 = acc[ai][1][m][0], u1 = acc[ai][1][m][1];
                u32x4 w; w.x = cvt_pk(silu_f(g0[0]) * u0[0], silu_f(g0[1]) * u0[1]); w.y = cvt_pk(silu_f(g0[2]) * u0[2], silu_f(g0[3]) * u0[3]);
                w.z = cvt_pk(silu_f(g1[0]) * u1[0], silu_f(g1[1]) * u1[1]); w.w = cvt_pk(silu_f(g1[2]) * u1[2], silu_f(g1[3]) * u1[3]);
                *(u32x4*)rowp = w; }
    }
};
struct EpiResGate {
    static constexpr bool PERM = false, AFTER_DRAIN = false;
    const float* xin32; const bf16_t* xsin; bf16_t* xs; int ldc; const float* gate; int gpitch;
    __device__ __forceinline__ void operator()(const f32x4 (&acc)[2][2][4][2], const Unit& u, int wr, int wc, int fr, int fq) const {
        typedef unsigned u32x2 __attribute__((ext_vector_type(2)));
        const int row0 = u.pm * BM + wr * 64 + fr, col0 = u.pn * BM + wc * 32 + 4 * fq;
        const float* gp = gate + (size_t)(u.pm >> 3) * gpitch + col0;
        f32x4 gv[2][2];
#pragma unroll
        for (int bj = 0; bj < 2; ++bj)
#pragma unroll
            for (int n = 0; n < 2; ++n) gv[bj][n] = *(const f32x4*)(gp + bj * HALF + n * 16);
#pragma unroll
        for (int ai = 0; ai < 2; ++ai)
#pragma unroll
            for (int m = 0; m < 4; ++m) { const size_t off = (size_t)(row0 + ai * HALF + m * 16) * ldc + col0;
#pragma unroll
                for (int bj = 0; bj < 2; ++bj)
#pragma unroll
                    for (int n = 0; n < 2; ++n) { f32x4 xi;
                        if (xin32) xi = *(const f32x4*)(xin32 + off + bj * HALF + n * 16);
                        else { const u32x2 w = *(const u32x2*)(xsin + off + bj * HALF + n * 16); xi = (f32x4){__uint_as_float(w.x << 16), __uint_as_float(w.x & 0xffff0000u), __uint_as_float(w.y << 16), __uint_as_float(w.y & 0xffff0000u)}; }
                        const f32x4 xo = xi + gv[bj][n] * acc[ai][bj][m][n];
                        u32x2 o; o.x = cvt_pk(xo[0], xo[1]); o.y = cvt_pk(xo[2], xo[3]); *(u32x2*)(xs + off + bj * HALF + n * 16) = o; }
                asm volatile("" ::: "memory"); }
    }
};

template <class Epi, class Sched, bool ALIGN_EPI = false, bool SP2 = false>
__device__ __forceinline__ void gemm_phase(PG8_LAS unsigned char* lds, const Gemm g, const Sched& S, const Epi& E, const int wid_in) {
    const int wid = wid_in, lane = lane_id_opq(), tid = wid * 64 + lane, wr = wid >> 2, wc = wid & 3, fr = lane & 15, fq = lane >> 4;
    const int K = g.K, nt = K / BK;
    unsigned voffA[2], voffB[2];
#pragma unroll
    for (int i = 0; i < 2; ++i) { int R, C; stage_rc(tid * 16 + i * 8192, R, C); const int Rb = Epi::PERM ? ((R & ~31) + perm32(R & 31)) : R;
        voffA[i] = (unsigned)(R * K + C) * 2u; voffB[i] = (unsigned)(Rb * K + C) * 2u; }
    const size_t kstep = (size_t)(BK * 2);
    const size_t hstep = (size_t)HALF * K * 2;
    const size_t tstep = 2 * hstep;
    const unsigned ldsw = (unsigned)wid * 1024u;
    const int aoff = lds_byte(wr * 64 + fr, fq * 8), boff = lds_byte(wc * 32 + fr, fq * 8);
#define PG8_SA(b, h) (((b) * 2 + (h)) * HTB)
#define PG8_SB(b, h) ((4 + (b) * 2 + (h)) * HTB)
#define PG8_STAGE(bufoff, gbase, voff) do { _Pragma("unroll") for (int _i = 0; _i < 2; ++_i) \
        __builtin_amdgcn_global_load_lds((const unsigned*)((const char*)(gbase) + (voff)[_i]), (PG8_LAS unsigned*)(lds + (bufoff) + ldsw + _i * 8192), 16, 0, 0); } while (0)
#define PG8_LDA(dst, b, h) do { _Pragma("unroll") for (int m = 0; m < 4; ++m) _Pragma("unroll") for (int k = 0; k < 2; ++k) dst[m][k] = *(const PG8_LAS bf16x8*)(lds + PG8_SA(b, h) + aoff + m * 2048 + k * 1024); } while (0)
#define PG8_LDB(dst, b, h) do { _Pragma("unroll") for (int n = 0; n < 2; ++n) _Pragma("unroll") for (int k = 0; k < 2; ++k) dst[n][k] = *(const PG8_LAS bf16x8*)(lds + PG8_SB(b, h) + boff + n * 2048 + k * 1024); } while (0)
#define PG8_MMA(ai, bj, At, Bt) do { __builtin_amdgcn_s_setprio(1); _Pragma("unroll") for (int m = 0; m < 4; ++m) _Pragma("unroll") for (int n = 0; n < 2; ++n) _Pragma("unroll") for (int k = 0; k < 2; ++k) \
        acc[ai][bj][m][n] = __builtin_amdgcn_mfma_f32_16x16x32_bf16(Bt[n][k], At[m][k], acc[ai][bj][m][n], 0, 0, 0); __builtin_amdgcn_s_setprio(0); } while (0)
#define PG8_WAIT_V(n) asm volatile("s_waitcnt vmcnt(" #n ")" ::: "memory")
#define PG8_WAIT_L(n) asm volatile("s_waitcnt lgkmcnt(" #n ")" ::: "memory")
#define PG8_BAR __builtin_amdgcn_s_barrier()
#define PG8_SCHED __builtin_amdgcn_sched_barrier(0)
    Unit cur, nxt; int ui = 0;
    if (!S.next(0, cur)) return;
    f32x4 acc[2][2][4][2];
#pragma unroll
    for (int a = 0; a < 2; ++a)
#pragma unroll
        for (int b = 0; b < 2; ++b)
#pragma unroll
            for (int m = 0; m < 4; ++m)
#pragma unroll
                for (int n = 0; n < 2; ++n) acc[a][b][m][n] = (f32x4){0.f, 0.f, 0.f, 0.f};
    bf16x8 At[4][2], B0[2][2], B1[2][2];
    const char* cA = (const char*)g.A + (size_t)cur.pm * tstep; const char* cB = (const char*)g.Bt + (size_t)cur.pn * tstep;
    S.a_ready(cur);
    if constexpr (SP2) {
        PG8_STAGE(PG8_SB(0, 0), cB, voffB); PG8_STAGE(PG8_SB(0, 1), cB + hstep, voffB); PG8_STAGE(PG8_SA(0, 0), cA, voffA); PG8_STAGE(PG8_SA(0, 1), cA + hstep, voffA);
        if (wr == 1) PG8_BAR;
        PG8_WAIT_V(2); PG8_BAR;
        PG8_STAGE(PG8_SB(1, 0), cB + kstep, voffB); PG8_STAGE(PG8_SA(1, 0), cA + kstep, voffA); PG8_STAGE(PG8_SB(1, 1), cB + hstep + kstep, voffB);
        PG8_WAIT_V(6); PG8_BAR;
    } else {
        PG8_STAGE(PG8_SB(0, 0), cB, voffB); PG8_STAGE(PG8_SA(0, 0), cA, voffA); PG8_STAGE(PG8_SB(0, 1), cB + hstep, voffB); PG8_STAGE(PG8_SA(0, 1), cA + hstep, voffA);
        if (wr == 1) PG8_BAR;
        PG8_WAIT_V(4); PG8_BAR;
        PG8_STAGE(PG8_SB(1, 0), cB + kstep, voffB); PG8_STAGE(PG8_SA(1, 0), cA + kstep, voffA); PG8_STAGE(PG8_SB(1, 1), cB + hstep + kstep, voffB);
        PG8_WAIT_V(6); PG8_BAR;
    }
    for (;;) {
        const bool has_next = S.next(ui + 1, nxt);
        const char* nA = has_next ? (const char*)g.A + (size_t)nxt.pm * tstep : cA; const char* nB = has_next ? (const char*)g.Bt + (size_t)nxt.pn * tstep : cB;
        for (int t = 0; t < nt; t += 2) {
            const bool last = (t == nt - 2);
            const char* a1 = cA + (size_t)(t + 1) * kstep;
            const char* a2 = last ? nA : cA + (size_t)(t + 2) * kstep; const char* b2 = last ? nB : cB + (size_t)(t + 2) * kstep;
            const char* a3 = a2 + kstep; const char* b3 = b2 + kstep;
            if (last && has_next) S.a_ready(nxt);
            if constexpr (SP2) {
            PG8_LDB(B0, 0, 0); PG8_LDB(B1, 0, 1); PG8_SCHED; PG8_LDA(At, 0, 0); PG8_STAGE(PG8_SA(1, 1), a1 + hstep, voffA);
            PG8_WAIT_V(8); PG8_WAIT_L(0); PG8_BAR; PG8_MMA(0, 0, At, B0); PG8_MMA(0, 1, At, B1); PG8_BAR; PG8_SCHED;
            PG8_LDA(At, 0, 1); PG8_STAGE(PG8_SB(0, 0), b2, voffB); PG8_STAGE(PG8_SB(0, 1), b2 + hstep, voffB); PG8_STAGE(PG8_SA(0, 0), a2, voffA);
            PG8_WAIT_V(8); PG8_WAIT_L(0); PG8_BAR; PG8_MMA(1, 0, At, B0); PG8_MMA(1, 1, At, B1); PG8_BAR; PG8_SCHED;
            PG8_LDB(B0, 1, 0); PG8_LDB(B1, 1, 1); PG8_SCHED; PG8_LDA(At, 1, 0); PG8_STAGE(PG8_SA(0, 1), a2 + hstep, voffA);
            PG8_WAIT_V(8); PG8_WAIT_L(0); PG8_BAR; PG8_MMA(0, 0, At, B0); PG8_MMA(0, 1, At, B1); PG8_BAR; PG8_SCHED;
            PG8_LDA(At, 1, 1); PG8_STAGE(PG8_SB(1, 0), b3, voffB); PG8_STAGE(PG8_SB(1, 1), b3 + hstep, voffB); PG8_STAGE(PG8_SA(1, 0), a3, voffA);
            PG8_WAIT_V(8); PG8_WAIT_L(0); PG8_BAR; PG8_MMA(1, 0, At, B0); PG8_MMA(1, 1, At, B1); PG8_BAR; PG8_SCHED;
            } else {
            PG8_LDB(B0, 0, 0); PG8_SCHED; PG8_LDA(At, 0, 0); PG8_STAGE(PG8_SA(1, 1), a1 + hstep, voffA);
            PG8_WAIT_L(8); PG8_BAR; PG8_WAIT_L(0); PG8_MMA(0, 0, At, B0); PG8_BAR; PG8_SCHED;
            PG8_LDB(B1, 0, 1); PG8_STAGE(PG8_SB(0, 0), b2, voffB);
            PG8_BAR; PG8_WAIT_L(0); PG8_MMA(0, 1, At, B1); PG8_BAR;
            PG8_LDA(At, 0, 1); PG8_STAGE(PG8_SA(0, 0), a2, voffA);
            PG8_BAR; PG8_WAIT_L(0); PG8_MMA(1, 0, At, B0); PG8_BAR; PG8_SCHED;
            PG8_STAGE(PG8_SB(0, 1), b2 + hstep, voffB);
            PG8_WAIT_V(6); PG8_BAR; PG8_MMA(1, 1, At, B1); PG8_BAR;
            PG8_LDB(B0, 1, 0); PG8_SCHED; PG8_LDA(At, 1, 0); PG8_STAGE(PG8_SA(0, 1), a2 + hstep, voffA);
            PG8_WAIT_L(8); PG8_BAR; PG8_WAIT_L(0); PG8_MMA(0, 0, At, B0); PG8_BAR; PG8_SCHED;
            PG8_LDB(B1, 1, 1); PG8_STAGE(PG8_SB(1, 0), b3, voffB);
            PG8_BAR; PG8_WAIT_L(0); PG8_MMA(0, 1, At, B1); PG8_BAR;
            PG8_LDA(At, 1, 1); PG8_STAGE(PG8_SA(1, 0), a3, voffA);
            PG8_BAR; PG8_WAIT_L(0); PG8_MMA(1, 0, At, B0); PG8_BAR; PG8_SCHED;
            PG8_STAGE(PG8_SB(1, 1), b3 + hstep, voffB);
            PG8_WAIT_V(6); PG8_BAR; PG8_MMA(1, 1, At, B1); PG8_BAR;
            }
        }
        if constexpr (ALIGN_EPI) { if (wr == 0) PG8_BAR; }
        if constexpr (!Epi::AFTER_DRAIN) { E(acc, cur, wr, wc, fr, fq); S.done(cur); }
        if (!has_next) break;
#pragma unroll
        for (int a = 0; a < 2; ++a)
#pragma unroll
            for (int b = 0; b < 2; ++b)
#pragma unroll
                for (int m = 0; m < 4; ++m)
#pragma unroll
                    for (int n = 0; n < 2; ++n) acc[a][b][m][n] = (f32x4){0.f, 0.f, 0.f, 0.f};
        cur = nxt; cA = nA; cB = nB; ++ui;
        if constexpr (ALIGN_EPI) { if (wr == 1) PG8_BAR; }
    }
    PG8_WAIT_V(0);
    if constexpr (!ALIGN_EPI) { if (wr == 0) PG8_BAR; }
    PG8_BAR;
    if constexpr (Epi::AFTER_DRAIN) { E.fused(acc, cur, wr, wc, fr, fq, lds, wid, lane); S.done(cur); }
#undef PG8_SA
#undef PG8_SB
#undef PG8_STAGE
#undef PG8_LDA
#undef PG8_LDB
#undef PG8_MMA
#undef PG8_WAIT_V
#undef PG8_WAIT_L
#undef PG8_BAR
#undef PG8_SCHED
}
}

#ifndef MK_PER_PHASE
#define MK_PER_PHASE 0
#endif
constexpr int NWAVES = 8;
constexpr int DM = 1024, NB = 32, SEQ = 2048, NL = 4, MT = NB * SEQ;
constexpr int D_IN = 3976, NPI = 4096, DFF = 2816, NF1 = 2 * DFF;
constexpr int RW_B = 1024, ML_B = 2432;
constexpr int RWKV_IN = 1408;
constexpr float RMS_EPS = 1e-6f, GN_EPS = 1e-5f;
constexpr int MODP = 6 * DM;
constexpr size_t MiB = 1u << 20;
constexpr size_t WS_CTL = 0, CTL_ZERO_BYTES = 1 * MiB;
constexpr size_t WS_HS = 116 * MiB;
constexpr int CW_FLAG = 16384;
constexpr size_t WS_WL = 5 * MiB;
constexpr size_t WS_MOD = 1 * MiB;
constexpr size_t WS_WIN = 8 * MiB, WS_WOUT = 40 * MiB, WS_WF1 = 48 * MiB, WS_WF2 = 92 * MiB;
constexpr size_t WS_H = 128 * MiB;
constexpr size_t WS_PROJ = 256 * MiB;
constexpr size_t WS_XFIN = (256 + 352) * MiB;
constexpr size_t WS_DEC = 768 * MiB, WS_AA = 864 * MiB, WS_GG = 912 * MiB;
constexpr size_t WS_END = 960 * MiB;
constexpr int CW_BAR = 4096;
constexpr int N_PHASES = 2 + 8 * NL;
static_assert((CW_BAR + (MK_PER_PHASE ? 1 : 1) * 3456) * 4 <= (int)CTL_ZERO_BYTES, "ctl");
constexpr int RING_BYTES = 131072, LDS_BYTES = 163840, LDSCTL_OFF = LDS_BYTES - 1024, MISC_OFF = LDSCTL_OFF + 320;

#define GAS __attribute__((address_space(1)))
#define LAS __attribute__((address_space(3)))
typedef unsigned short bf16;
typedef unsigned v4u __attribute__((ext_vector_type(4)));
typedef unsigned v2u __attribute__((ext_vector_type(2)));
typedef float f32x4 __attribute__((ext_vector_type(4)));
#define LDS_WAIT() asm volatile("s_waitcnt lgkmcnt(0)" ::: "memory")
typedef float f32x2c __attribute__((ext_vector_type(2)));
typedef __bf16 bf16x2c __attribute__((ext_vector_type(2)));
__device__ __forceinline__ unsigned f2bf(float f) { return (__builtin_bit_cast(unsigned, f) + 0x8000u) >> 16; }
__device__ __forceinline__ unsigned pk2(float lo, float hi) { return __builtin_amdgcn_perm(__builtin_bit_cast(unsigned, hi) + 0x8000u, __builtin_bit_cast(unsigned, lo) + 0x8000u, 0x07060302u); }
__device__ __forceinline__ float bf2f(bf16 v) { return __uint_as_float(((unsigned)v) << 16); }
template <int CTRL, int ROWMASK> __device__ __forceinline__ float dppf(float v) { return __builtin_bit_cast(float, __builtin_amdgcn_update_dpp(0, __builtin_bit_cast(int, v), CTRL, ROWMASK, 0xf, false)); }
__device__ __forceinline__ float sum16(float v) { v += dppf<0xB1, 0xf>(v); v += dppf<0x4E, 0xf>(v); v += dppf<0x141, 0xf>(v); v += dppf<0x140, 0xf>(v); return v; }
__device__ __forceinline__ float wave_sum(float v) { v = sum16(v); v += dppf<0x142, 0xa>(v); v += dppf<0x143, 0xc>(v); return __builtin_bit_cast(float, __builtin_amdgcn_readlane(__builtin_bit_cast(int, v), 63)); }
template <int CTRL, int ROWMASK> __device__ __forceinline__ float dppo(float v, float old) { return __builtin_bit_cast(float, __builtin_amdgcn_update_dpp(__builtin_bit_cast(int, old), __builtin_bit_cast(int, v), CTRL, ROWMASK, 0xf, false)); }
__device__ __forceinline__ float wave_prefix_sum(float v) { v += dppo<0x111, 0xf>(v, 0.f); v += dppo<0x112, 0xf>(v, 0.f); v += dppo<0x114, 0xf>(v, 0.f); v += dppo<0x118, 0xf>(v, 0.f); v += dppo<0x142, 0xa>(v, 0.f); v += dppo<0x143, 0xc>(v, 0.f); return v; }
__device__ __forceinline__ float wave_prefix_max(float v) { const float ni = -__builtin_inff(); v = fmaxf(v, dppo<0x111, 0xf>(v, ni)); v = fmaxf(v, dppo<0x112, 0xf>(v, ni)); v = fmaxf(v, dppo<0x114, 0xf>(v, ni)); v = fmaxf(v, dppo<0x118, 0xf>(v, ni));
    v = fmaxf(v, dppo<0x142, 0xa>(v, ni)); v = fmaxf(v, dppo<0x143, 0xc>(v, ni)); return v; }
__device__ __forceinline__ float flogsigmoid(float x) { return fminf(x, 0.f) - __logf(1.0f + __expf(-fabsf(x))); }
__device__ __forceinline__ float fexp(float x) { return __expf(x); }
__device__ __forceinline__ float fsigmoid(float x) { return __builtin_amdgcn_rcpf(1.0f + __expf(-x)); }
__device__ __forceinline__ float sigmoid_f(float x) { return 1.0f / (1.0f + expf(-x)); }
__device__ __forceinline__ float logsigmoid_f(float x) { return fminf(x, 0.f) - log1pf(expf(-fabsf(x))); }
template <class T> __device__ __forceinline__ T* opq(T* p) { asm volatile("" : "+s"(p)); return p; }

#define XB_TMO      128
#define XB_XCNT(j)  (256  + 64 * (j))
#define XB_XSUB(j)  (1280 + 64 * (j))
#define XB_XGEN(j)  (2304 + 64 * (j))
#define XB_TOP      3328
#define XB_TOPGEN   3392
#define XCD_BAR_WORDS 3456
#define XB_SPIN_CAP (1u << 22)

__device__ __forceinline__ unsigned xb_ld(unsigned* p)              { return __hip_atomic_load(p, __ATOMIC_RELAXED, __HIP_MEMORY_SCOPE_AGENT); }
__device__ __forceinline__ unsigned xb_add(unsigned* p, unsigned v) { return __hip_atomic_fetch_add(p, v, __ATOMIC_RELAXED, __HIP_MEMORY_SCOPE_AGENT); }
__device__ __forceinline__ unsigned xb_xcc_id() { return (unsigned)__builtin_amdgcn_s_getreg((3 << 11) | 20) & 0xFu; }
#define XB_SPIN(cond, bar) do { unsigned _sp = 0; while (cond) { __builtin_amdgcn_s_sleep(1); \
    if ((++_sp & 255u) == 0u) { if (xb_ld(&(bar)[XB_TMO])) break; if (_sp > XB_SPIN_CAP) { atomicAdd(&(bar)[XB_TMO], 1u); break; } } } } while (0)

struct XcdBarrier {
    unsigned* bar; unsigned x; unsigned w0;
    volatile LAS unsigned* st;
};

__device__ __forceinline__ XcdBarrier xcd_barrier_post(unsigned* bar, volatile LAS unsigned* st) {
    XcdBarrier b; b.bar = bar; b.x = xb_xcc_id(); b.st = st; b.w0 = (__builtin_amdgcn_readfirstlane((int)threadIdx.x >> 6) == 0) ? 1u : 0u;
    if (threadIdx.x == 0) (void)xb_add(&bar[XB_XCNT(b.x)], 1u);
    return b;
}
__device__ __forceinline__ void xcd_barrier_complete(unsigned* bar, unsigned x, unsigned& nloc, unsigned& nx) {
    const unsigned G = gridDim.x * gridDim.y * gridDim.z;
    unsigned sum, cnt, mine, sp = 0u;
    for (;;) {
        sum = 0u; cnt = 0u; mine = 0u;
#pragma unroll
        for (unsigned j = 0; j < 16; ++j) { const unsigned c = xb_ld(&bar[XB_XCNT(j)]); sum += c; cnt += (c > 0u) ? 1u : 0u; mine = (j == x) ? c : mine; }
        if (sum == G) break;
        __builtin_amdgcn_s_sleep(1);
        if ((++sp & 255u) == 0u) { if (xb_ld(&bar[XB_TMO])) break; if (sp > XB_SPIN_CAP) { atomicAdd(&bar[XB_TMO], 1u); break; } }
    }
    nloc = mine > 0u ? mine : 1u; nx = cnt > 0u ? cnt : 1u;
}

__device__ __forceinline__ void xcd_barrier(const XcdBarrier& b) {
    asm volatile("s_waitcnt vmcnt(0)" ::: "memory");
    __syncthreads();
    if (b.w0 != 0u && lane_id_opq() == 0) {
        unsigned* bar = b.bar;
        __builtin_amdgcn_s_waitcnt(0);
        unsigned nloc = b.st[0], nx = b.st[1];
        if (nloc == 0u) { xcd_barrier_complete(bar, b.x, nloc, nx); b.st[0] = nloc; b.st[1] = nx; }
        const unsigned old = xb_add(&bar[XB_XSUB(b.x)], 1u);
        const unsigned gen = old / nloc;
        if (old + 1u == (gen + 1u) * nloc) {
            __builtin_amdgcn_fence(__ATOMIC_RELEASE, "agent");
            asm volatile("s_waitcnt vmcnt(0)" ::: "memory");
            const unsigned og = xb_add(&bar[XB_TOP], 1u);
            const unsigned tg = og / nx;
            if (og + 1u == (tg + 1u) * nx) xb_add(&bar[XB_TOPGEN], 1u);
            else XB_SPIN(xb_ld(&bar[XB_TOPGEN]) == tg, bar);
            __builtin_amdgcn_fence(__ATOMIC_ACQUIRE, "agent");
            xb_add(&bar[XB_XGEN(b.x)], 1u);
            asm volatile("s_waitcnt vmcnt(0)" ::: "memory");
        } else {
            XB_SPIN(xb_ld(&bar[XB_XGEN(b.x)]) == gen, bar);
            __builtin_amdgcn_fence(__ATOMIC_ACQUIRE, "agent");
            asm volatile("s_waitcnt vmcnt(0)" ::: "memory");
        }
    }
    __syncthreads();
}


__device__ __forceinline__ void b32_gemv(const float* Wcol  , bool ok, int N, LAS float* vT, float (&res)[4], int wave, int lane) {
    float acc[32];
#pragma unroll
    for (int b = 0; b < 32; ++b) acc[b] = 0.f;
    const float* wp = Wcol + (size_t)(128 * wave) * N; const LAS float* vp = vT + 128 * wave * 32;
#pragma unroll 1
    for (int kk = 0; kk < 128; kk += 8) {
        float w[8];
#pragma unroll
        for (int u = 0; u < 8; ++u) w[u] = ok ? wp[(size_t)u * N] : 0.f;
        wp += (size_t)8 * N;
#pragma unroll
        for (int u = 0; u < 8; ++u) {
#pragma unroll
            for (int b4 = 0; b4 < 8; ++b4) { const f32x4 cv = *(const LAS f32x4*)(vp + u * 32 + 4 * b4);
                acc[4 * b4] += cv.x * w[u]; acc[4 * b4 + 1] += cv.y * w[u]; acc[4 * b4 + 2] += cv.z * w[u]; acc[4 * b4 + 3] += cv.w * w[u]; }
            asm volatile("" ::: "memory"); }
        vp += 8 * 32;
    }
    __syncthreads();
#pragma unroll
    for (int b = 0; b < 32; ++b) vT[(wave * 32 + b) * 64 + lane] = acc[b];
    __syncthreads();
#pragma unroll
    for (int q = 0; q < 4; ++q) { float s = 0.f;
#pragma unroll
        for (int w2 = 0; w2 < 8; ++w2) s += vT[(w2 * 32 + 4 * wave + q) * 64 + lane];
        res[q] = s; }
    __syncthreads();
}
__device__ __forceinline__ void p0_mod(const float* c, const float* ada_w, const float* ada_b, float* mod, LAS unsigned char* lds, int tid, int lane, int wave) {
    LAS float* condT = (LAS float*)lds;
    for (int item = blockIdx.x; item < NL * 96; item += gridDim.x) {
        __syncthreads();
        for (int e = tid; e < NB * DM; e += NWAVES * 64) { const int k = e >> 5, b = e & 31; const float v = c[b * DM + k]; condT[e] = v / (1.0f + expf(-v)); }
        __syncthreads();
        const int l = item / 96, g = item % 96, n = g * 64 + lane;
        float res[4]; b32_gemv(ada_w + (size_t)l * DM * MODP + n, true, MODP, condT, res, wave, lane);
        const float bb = ada_b[l * MODP + n]; float* o = mod + ((size_t)l * NB + wave * 4) * MODP + n;
        o[0] = res[0] + bb; o[MODP] = res[1] + bb; o[2 * MODP] = res[2] + bb; o[3 * MODP] = res[3] + bb;
    }
    __syncthreads();
}
template <int MODE>
__device__ __forceinline__ void transpose_item(const float* W, int K, int N, int nblk, bf16* WT, int ldw, LAS float* scr, int item, int lane) {
    const int kb = item / nblk, nb = item % nblk, k0 = 64 * kb, n0 = 32 * nb;
    const int nn = n0 + (lane & 31); const bool ok = nn < N;
#pragma unroll 8
    for (int i = 0; i < 32; ++i) { const int kk = 2 * i + (lane >> 5); scr[kk * 33 + (lane & 31)] = ok ? W[(size_t)(k0 + kk) * N + nn] : 0.f; }
    LDS_WAIT();
    const int c = lane & 7;
#pragma unroll
    for (int j = 0; j < 4; ++j) { const int n = (lane >> 3) + 8 * j; const LAS float* s = scr + (8 * c) * 33 + n;
        v4u o; o.x = pk2(s[0 * 33], s[1 * 33]); o.y = pk2(s[2 * 33], s[3 * 33]); o.z = pk2(s[4 * 33], s[5 * 33]); o.w = pk2(s[6 * 33], s[7 * 33]);
        int row = n0 + n;
        if (MODE == 1) { const int up = row >= DFF ? 1 : 0, jj = row - up * DFF; row = (jj >> 7) * 256 + up * 128 + (jj & 127); }
        *(v4u*)(WT + (size_t)row * ldw + k0 + 8 * c) = o; }
    LDS_WAIT();
}
__device__ __forceinline__ void p0_weights(const float* w_in, const float* w_out, const float* f1, const float* f2, const float* lw2, const float* la2, const float* lg2, unsigned char* ws, LAS unsigned char* lds, int gw, int ngw, int wave, int lane) {
    LAS float* scr = (LAS float*)(lds + wave * 16384);
    constexpr int I_IN = (DM / 64) * (NPI / 32), I_OUT = (DM / 64) * (DM / 32), I_F1 = (DM / 64) * (NF1 / 32), I_F2 = (DFF / 64) * (DM / 32), I_L = I_IN + I_OUT + I_F1 + I_F2 + 48;
    for (int it = gw; it < NL * I_L; it += ngw) {
        const int l = it / I_L; int r = it % I_L;
        if (r < I_IN) { transpose_item<0>(w_in + (size_t)l * DM * D_IN, DM, D_IN, NPI / 32, (bf16*)(ws + WS_WIN) + (size_t)l * NPI * DM, DM, scr, r, lane); continue; } r -= I_IN;
        if (r < I_OUT) { transpose_item<0>(w_out + (size_t)l * DM * DM, DM, DM, DM / 32, (bf16*)(ws + WS_WOUT) + (size_t)l * DM * DM, DM, scr, r, lane); continue; } r -= I_OUT;
        if (r < I_F1) { transpose_item<1>(f1 + (size_t)l * DM * NF1, DM, NF1, NF1 / 32, (bf16*)(ws + WS_WF1) + (size_t)l * NF1 * DM, DM, scr, r, lane); continue; } r -= I_F1;
        if (r < I_F2) { transpose_item<0>(f2 + (size_t)l * DFF * DM, DFF, DM, DM / 32, (bf16*)(ws + WS_WF2) + (size_t)l * DM * DFF, DFF, scr, r, lane); continue; } r -= I_F2;
        bf16* wl = (bf16*)(ws + WS_WL) + (size_t)l * 384 * 256;
        if (r < 12) { transpose_item<0>(lw2 + (size_t)l * 64 * 384, 64, 384, 12, wl, 256, scr, r, lane); continue; } r -= 12;
        if (r < 12) { transpose_item<0>(la2 + (size_t)l * 64 * 384, 64, 384, 12, wl + 64, 256, scr, r, lane); continue; } r -= 12;
        transpose_item<0>(lg2 + (size_t)l * 128 * 384, 128, 384, 12, wl + 128, 256, scr, r, lane);
    }
}
__device__ __forceinline__ void norm_mod_phase(const float* xin32, const bf16* xs, const float* gain, const float* modl, int sh_off, int sc_off, bf16* out, int gw, int ngw, int lane) {
    for (int ci = gw; ci < MT / 32; ci += ngw) {
        const int b = ci >> 6; const float* mb = modl + (size_t)b * MODP;
        f32x4 gs[4], sh[4];
#pragma unroll
        for (int j = 0; j < 4; ++j) { const int col = 4 * lane + 256 * j; const f32x4 g = *(const f32x4*)(gain + col), s = *(const f32x4*)(mb + sc_off + col); gs[j] = g * (s + 1.0f); sh[j] = *(const f32x4*)(mb + sh_off + col); }
        for (int r = 0; r < 32; ++r) {
            const size_t row = (size_t)ci * 32 + r;
            f32x4 v[4]; float ss = 0.f;
            if (xin32) { const f32x4* xr = (const f32x4*)(xin32 + row * DM) + lane;
#pragma unroll
                for (int j = 0; j < 4; ++j) v[j] = xr[64 * j];
            } else { const v2u* xr = (const v2u*)(xs + row * DM) + lane;
#pragma unroll
                for (int j = 0; j < 4; ++j) { const v2u w = xr[64 * j]; v[j] = (f32x4){__uint_as_float(w.x << 16), __uint_as_float(w.x & 0xffff0000u), __uint_as_float(w.y << 16), __uint_as_float(w.y & 0xffff0000u)}; } }
#pragma unroll
            for (int j = 0; j < 4; ++j) ss += (v[j].x * v[j].x + v[j].y * v[j].y) + (v[j].z * v[j].z + v[j].w * v[j].w);
            const float rstd = 1.0f / sqrtf(wave_sum(ss) * (1.0f / DM) + RMS_EPS);
            v2u* o8 = (v2u*)(out + row * DM) + lane;
#pragma unroll
            for (int j = 0; j < 4; ++j) { const f32x4 y = v[j] * rstd * gs[j] + sh[j]; v2u w; w.x = pk2(y.x, y.y); w.y = pk2(y.z, y.w); o8[64 * j] = w; }
        }
    }
}
__device__ __forceinline__ void final_norm_phase(const bf16* xs, float* out, const float* gain, int gw, int ngw, int lane) {
    f32x4 g[4];
#pragma unroll
    for (int j = 0; j < 4; ++j) g[j] = *(const f32x4*)(gain + 4 * lane + 256 * j);
    for (int row = gw; row < MT; row += ngw) {
        const v2u* xr = (const v2u*)(xs + (size_t)row * DM) + lane; f32x4 v[4]; float ss = 0.f;
#pragma unroll
        for (int j = 0; j < 4; ++j) { const v2u w = xr[64 * j]; v[j] = (f32x4){__uint_as_float(w.x << 16), __uint_as_float(w.x & 0xffff0000u), __uint_as_float(w.y << 16), __uint_as_float(w.y & 0xffff0000u)};
            ss += (v[j].x * v[j].x + v[j].y * v[j].y) + (v[j].z * v[j].z + v[j].w * v[j].w); }
        const float rstd = 1.0f / sqrtf(wave_sum(ss) * (1.0f / DM) + RMS_EPS);
        f32x4* o = (f32x4*)(out + (size_t)row * DM) + lane;
#pragma unroll
        for (int j = 0; j < 4; ++j) o[64 * j] = v[j] * rstd * g[j];
    }
}
#define WG_BAR() do { asm volatile("s_waitcnt vmcnt(0) lgkmcnt(0)" ::: "memory"); __builtin_amdgcn_s_barrier(); asm volatile("" ::: "memory"); } while (0)
#define WG_BAR_L() do { asm volatile("s_waitcnt lgkmcnt(0)" ::: "memory"); __builtin_amdgcn_s_barrier(); asm volatile("" ::: "memory"); } while (0)
typedef short bf16x8p __attribute__((ext_vector_type(8)));
__device__ __forceinline__ void rwkv_prep_mfma(const bf16* proj, const float* mu, const float* w0, const float* a0, const bf16* WL, float* DEC, bf16* AA, bf16* GG, LAS unsigned char* lds, int wave) {
    constexpr int AP = 264;
    LAS bf16* act = (LAS bf16*)lds;
#pragma unroll 1
    for (int item = blockIdx.x; item < MT / 64; item += gridDim.x) {
        const int lane = lane_id_opq(), tid = wave * 64 + lane, q4 = lane >> 4, lc = lane & 15;
        const size_t m0 = (size_t)item * 64; const int t0 = (int)(m0 % SEQ);
        { const int tt = tid >> 3, cg = tid & 7; const bf16* p = proj + (m0 + tt) * NPI + RW_B + 1152 + 32 * cg; const bool hp = (t0 + tt) > 0; const float* mup = mu + 1152 + 32 * cg;
#pragma unroll
          for (int v = 0; v < 4; ++v) { const v4u cur = *(const v4u*)(p + 8 * v); v4u prv = (v4u){0u, 0u, 0u, 0u}; if (hp) prv = *(const v4u*)(p - NPI + 8 * v);
              const f32x4 m0v = *(const f32x4*)(mup + 8 * v), m1v = *(const f32x4*)(mup + 8 * v + 4);
              float x[8];
#pragma unroll
              for (int e = 0; e < 4; ++e) { const unsigned cw = cur[e], pw = prv[e]; const float c0 = __uint_as_float(cw << 16), c1 = __uint_as_float(cw & 0xffff0000u), p0 = __uint_as_float(pw << 16), p1 = __uint_as_float(pw & 0xffff0000u);
                  const float mu0 = e < 2 ? m0v[2 * e] : m1v[2 * e - 4], mu1 = e < 2 ? m0v[2 * e + 1] : m1v[2 * e - 3];
                  x[2 * e] = c0 + (p0 - c0) * mu0; x[2 * e + 1] = c1 + (p1 - c1) * mu1; }
              if (cg < 2) {
#pragma unroll
                  for (int e = 0; e < 8; ++e) x[e] = 2.0f * fsigmoid(2.0f * x[e]) - 1.0f;
              } else if (cg >= 4) {
#pragma unroll
                  for (int e = 0; e < 8; ++e) x[e] = fsigmoid(x[e]);
              }
              v4u o; o.x = pk2(x[0], x[1]); o.y = pk2(x[2], x[3]); o.z = pk2(x[4], x[5]); o.w = pk2(x[6], x[7]);
              *(LAS v4u*)(act + tt * AP + 32 * cg + 8 * v) = o; } }
        WG_BAR_L();
        const LAS bf16* afr = act + lc * AP + 8 * q4;
        const bf16* bfr = WL + (size_t)(48 * wave + lc) * 256 + 8 * q4;
        { f32x4 acc[4][3];
#pragma unroll
          for (int mt = 0; mt < 4; ++mt)
#pragma unroll
              for (int nt = 0; nt < 3; ++nt) acc[mt][nt] = (f32x4){0.f, 0.f, 0.f, 0.f};
#pragma unroll
          for (int ks = 0; ks < 2; ++ks) { bf16x8p bq[3];
#pragma unroll
              for (int nt = 0; nt < 3; ++nt) bq[nt] = *(const bf16x8p*)(bfr + 16 * nt * 256 + 32 * ks);
#pragma unroll
              for (int mt = 0; mt < 4; ++mt) { const bf16x8p aq = *(const LAS bf16x8p*)(afr + 16 * mt * AP + 32 * ks);
#pragma unroll
                  for (int nt = 0; nt < 3; ++nt) acc[mt][nt] = __builtin_amdgcn_mfma_f32_16x16x32_bf16(aq, bq[nt], acc[mt][nt], 0, 0, 0); } }
#pragma unroll
          for (int nt = 0; nt < 3; ++nt) { const int n = 48 * wave + 16 * nt + lc; const float w0n = w0[n]; float carry = 0.f;
#pragma unroll
              for (int mt = 0; mt < 4; ++mt) { float pr[4];
#pragma unroll
                  for (int r = 0; r < 4; ++r) { const float ld = -0.60653066f * fsigmoid(w0n + acc[mt][nt][r]); pr[r] = r ? pr[r - 1] + ld : ld; }
                  const float tot = pr[3]; float s1 = tot; { const float u = __shfl_up(s1, 16); if (q4 >= 1) s1 += u; } { const float u = __shfl_up(s1, 32); if (q4 >= 2) s1 += u; }
                  const float excl = carry + (s1 - tot), tile_tot = __shfl(s1, 48 + lc);
                  float* dp = DEC + (m0 + 16 * mt + 4 * q4) * 384 + n;
#pragma unroll
                  for (int r = 0; r < 4; ++r) dp[r * 384] = excl + pr[r];
                  carry += tile_tot; } } }
        { f32x4 acc[4][3];
#pragma unroll
          for (int mt = 0; mt < 4; ++mt)
#pragma unroll
              for (int nt = 0; nt < 3; ++nt) acc[mt][nt] = (f32x4){0.f, 0.f, 0.f, 0.f};
#pragma unroll
          for (int ks = 0; ks < 2; ++ks) { bf16x8p bq[3];
#pragma unroll
              for (int nt = 0; nt < 3; ++nt) bq[nt] = *(const bf16x8p*)(bfr + 16 * nt * 256 + 64 + 32 * ks);
#pragma unroll
              for (int mt = 0; mt < 4; ++mt) { const bf16x8p aq = *(const LAS bf16x8p*)(afr + 16 * mt * AP + 64 + 32 * ks);
#pragma unroll
                  for (int nt = 0; nt < 3; ++nt) acc[mt][nt] = __builtin_amdgcn_mfma_f32_16x16x32_bf16(aq, bq[nt], acc[mt][nt], 0, 0, 0); } }
#pragma unroll
          for (int nt = 0; nt < 3; ++nt) { const int n = 48 * wave + 16 * nt + lc; const float a0n = a0[n];
#pragma unroll
              for (int mt = 0; mt < 4; ++mt) { bf16* dp = AA + (m0 + 16 * mt + 4 * q4) * 384 + n;
#pragma unroll
                  for (int r = 0; r < 4; ++r) dp[r * 384] = (bf16)f2bf(fsigmoid(a0n + acc[mt][nt][r])); } } }
        { f32x4 acc[4][3];
#pragma unroll
          for (int mt = 0; mt < 4; ++mt)
#pragma unroll
              for (int nt = 0; nt < 3; ++nt) acc[mt][nt] = (f32x4){0.f, 0.f, 0.f, 0.f};
#pragma unroll
          for (int ks = 0; ks < 4; ++ks) { bf16x8p bq[3];
#pragma unroll
              for (int nt = 0; nt < 3; ++nt) bq[nt] = *(const bf16x8p*)(bfr + 16 * nt * 256 + 128 + 32 * ks);
#pragma unroll
              for (int mt = 0; mt < 4; ++mt) { const bf16x8p aq = *(const LAS bf16x8p*)(afr + 16 * mt * AP + 128 + 32 * ks);
#pragma unroll
                  for (int nt = 0; nt < 3; ++nt) acc[mt][nt] = __builtin_amdgcn_mfma_f32_16x16x32_bf16(aq, bq[nt], acc[mt][nt], 0, 0, 0); } }
#pragma unroll
          for (int nt = 0; nt < 3; ++nt) { const int n = 48 * wave + 16 * nt + lc;
#pragma unroll
              for (int mt = 0; mt < 4; ++mt) { bf16* dp = GG + (m0 + 16 * mt + 4 * q4) * 384 + n;
#pragma unroll
                  for (int r = 0; r < 4; ++r) dp[r * 384] = (bf16)f2bf(acc[mt][nt][r]); } } }
        WG_BAR_L();
    }
}
typedef short bf16x8_t __attribute__((ext_vector_type(8)));
template <int KS>
__device__ __forceinline__ f32x4 mm_tile(const LAS bf16* A, const LAS bf16* B, f32x4 acc) {
#pragma unroll
    for (int ks = 0; ks < KS; ++ks) {
        const bf16x8_t a = *(const LAS bf16x8_t*)(A + ks * 32), b = *(const LAS bf16x8_t*)(B + ks * 32);
        acc = __builtin_amdgcn_mfma_f32_16x16x32_bf16(a, b, acc, 0, 0, 0);
    }
    return acc;
}
__device__ __forceinline__ unsigned short f2bf16(float f) { return (unsigned short)f2bf(f); }
constexpr int LP = 72;
constexpr int LPM = 104;

__device__ __forceinline__ void ret_unit(int b, int h, const bf16* proj, const float* gn, bf16* mixed, LAS unsigned char* lds, int wave, int lane0) {
    LAS bf16* Qs = (LAS bf16*)lds; LAS bf16* Ks = Qs + 64 * LP; LAS bf16* Kdt = Ks + 64 * LP; LAS bf16* Vt = Kdt + 64 * LP; LAS bf16* Ps = Vt + 64 * LP; LAS bf16* Stt = Ps + 64 * LP; LAS bf16* Gs = Stt + 64 * LP;
    const int lane = lane0, q4 = lane >> 4, lc = lane & 15;
    const float inv = powf(10000.0f, -(float)(2 * (lane & 31)) / 64.0f);
    float cs[8], sn[8];
#pragma unroll
    for (int i = 0; i < 8; ++i) __sincosf((float)(8 * wave + i) * inv, &sn[i], &cs[i]);
    float c64, s64; sincosf(64.0f * inv, &s64, &c64);
    const float lg2 = log2f(1.0f - exp2f(-5.0f - (float)h));
    float kdec[8];
#pragma unroll
    for (int i = 0; i < 8; ++i) kdec[i] = exp2f((float)(63 - (8 * wave + i)) * lg2);
    const float cd = exp2f(64.0f * lg2);
    f32x4 st[4];
#pragma unroll
    for (int i = 0; i < 4; ++i) st[i] = (f32x4){0.f, 0.f, 0.f, 0.f};
    for (int i = wave * 64 + lane; i < 64 * LP / 2; i += 512) ((LAS unsigned*)Stt)[i] = 0u;
    const size_t m0 = (size_t)b * SEQ;
    const bf16* P0 = proj + m0 * NPI + h * 64;
    unsigned short rq[8], rk[8], rv[8], rg[8];
#pragma unroll
    for (int i = 0; i < 8; ++i) { const bf16* p = P0 + (size_t)(8 * wave + i) * NPI; rq[i] = p[lane]; rk[i] = p[256 + lane]; rv[i] = p[512 + lane]; rg[i] = p[768 + lane]; }
    float gain4[4];
#pragma unroll
    for (int ct = 0; ct < 4; ++ct) gain4[ct] = gn[h * 64 + 16 * ct + lc];
#pragma unroll 1
    for (int c = 0; c < SEQ / 64; ++c) {
        const int lane = lane_id_opq(), q4 = lane >> 4, lc = lane & 15, o72 = lc * LP + 8 * q4;
        { unsigned short kd[8];
#pragma unroll
          for (int i = 0; i < 8; ++i) { const int tt = 8 * wave + i;
              const float q = bf2f(rq[i]), k = bf2f(rk[i]); const float qp = __shfl_xor(q, 32), kp = __shfl_xor(k, 32);
              const float qr = lane < 32 ? q * cs[i] - qp * sn[i] : qp * sn[i] + q * cs[i];
              const float kr = (lane < 32 ? k * cs[i] - kp * sn[i] : kp * sn[i] + k * cs[i]) * 0.125f;
              Qs[tt * LP + lane] = f2bf16(qr); Ks[tt * LP + lane] = f2bf16(kr); Gs[tt * LP + lane] = rg[i]; kd[i] = f2bf16(kr * kdec[i]);
              const float cn = cs[i] * c64 - sn[i] * s64, snn = sn[i] * c64 + cs[i] * s64; cs[i] = cn; sn[i] = snn; }
          v4u w; w.x = kd[0] | ((unsigned)kd[1] << 16); w.y = kd[2] | ((unsigned)kd[3] << 16); w.z = kd[4] | ((unsigned)kd[5] << 16); w.w = kd[6] | ((unsigned)kd[7] << 16);
          *(LAS v4u*)(Kdt + lane * LP + 8 * wave) = w;
          w.x = rv[0] | ((unsigned)rv[1] << 16); w.y = rv[2] | ((unsigned)rv[3] << 16); w.z = rv[4] | ((unsigned)rv[5] << 16); w.w = rv[6] | ((unsigned)rv[7] << 16);
          *(LAS v4u*)(Vt + lane * LP + 8 * wave) = w; }
        WG_BAR_L();
        if (c + 1 < SEQ / 64) {
#pragma unroll
            for (int i = 0; i < 8; ++i) { const bf16* p = P0 + (size_t)(64 * (c + 1) + 8 * wave + i) * NPI; rq[i] = p[lane]; rk[i] = p[256 + lane]; rv[i] = p[512 + lane]; rg[i] = p[768 + lane]; } }
        { const int rt = wave >> 1;
#pragma unroll
          for (int u = 0; u < 2; ++u) { const int ct = 2 * (wave & 1) + u;
              f32x4 s = (f32x4){0.f, 0.f, 0.f, 0.f};
              if (ct <= rt) s = mm_tile<2>(Qs + 16 * rt * LP + o72, Ks + 16 * ct * LP + o72, s);
#pragma unroll
              for (int r = 0; r < 4; ++r) { const int l = 16 * rt + 4 * q4 + r, m = 16 * ct + lc; const float val = (l >= m) ? s[r] * __builtin_amdgcn_exp2f((float)(l - m) * lg2) : 0.f; Ps[l * LP + m] = f2bf16(val); } } }
        f32x4 inter[4];
        if (wave < 4) {
#pragma unroll
            for (int ct = 0; ct < 4; ++ct) inter[ct] = mm_tile<2>(Qs + 16 * wave * LP + o72, Stt + 16 * ct * LP + o72, (f32x4){0.f, 0.f, 0.f, 0.f}); }
        WG_BAR_L();
        if (wave < 4) {
            f32x4 y[4];
#pragma unroll
            for (int ct = 0; ct < 4; ++ct) y[ct] = mm_tile<2>(Ps + 16 * wave * LP + o72, Vt + 16 * ct * LP + o72, (f32x4){0.f, 0.f, 0.f, 0.f});
#pragma unroll
            for (int r = 0; r < 4; ++r) { const int l = 16 * wave + 4 * q4 + r; const float qd = __builtin_amdgcn_exp2f((float)(l + 1) * lg2);
                float s = 0.f;
#pragma unroll
                for (int ct = 0; ct < 4; ++ct) { y[ct][r] += qd * inter[ct][r]; s += y[ct][r]; }
                const float mean = sum16(s) * (1.0f / 64.0f); float qv = 0.f;
#pragma unroll
                for (int ct = 0; ct < 4; ++ct) { const float dd = y[ct][r] - mean; qv += dd * dd; }
                const float rstd = __builtin_amdgcn_rsqf(sum16(qv) * (1.0f / 64.0f) + GN_EPS);
                bf16* orow = mixed + (m0 + 64 * c + l) * DM + h * 64 + lc;
#pragma unroll
                for (int ct = 0; ct < 4; ++ct) { const float g = bf2f(Gs[l * LP + 16 * ct + lc]); orow[16 * ct] = f2bf16((y[ct][r] - mean) * rstd * gain4[ct] * (g * fsigmoid(g))); } }
        } else {
            const int dt = wave - 4;
#pragma unroll
            for (int ct = 0; ct < 4; ++ct) { st[ct] = mm_tile<2>(Kdt + 16 * dt * LP + o72, Vt + 16 * ct * LP + o72, st[ct] * cd);
                v2u w; w.x = pk2(st[ct][0], st[ct][1]); w.y = pk2(st[ct][2], st[ct][3]);
                *(LAS v2u*)(Stt + (16 * ct + lc) * LP + 16 * dt + 4 * q4) = w; }
        }
        WG_BAR_L();
    }
}

__device__ __forceinline__ void mlstm_unit(int b, int h, const bf16* proj, const float* conv_w, const float* conv_b, const float* i_b, const float* f_b, const float* gn, bf16* mixed,
                                           LAS unsigned char* lds, int wave, int lane0) {
    LAS bf16* Qs = (LAS bf16*)lds; LAS bf16* Ks = Qs + 64 * LPM; LAS bf16* Kdt = Ks + 64 * LPM; LAS bf16* Vt = Kdt + 96 * LP; LAS bf16* Ps = Vt + 112 * LP; LAS bf16* Stt = Ps + 64 * LP; LAS bf16* Os = Stt + 112 * LPM;
    LAS float* ev = (LAS float*)(Os + 64 * LPM); LAS float* pmv = ev + 64; LAS float* flv = pmv + 64;
    const int lane = lane0, lc = lane & 15;
    float wq0[4], wq1[4], wk0[4], wk1[4], bq0, bq1, bk0, bk1;
    { const int cq0 = h * 96 + lane, cq1 = h * 96 + 64 + (lane & 31), ck0 = 384 + cq0, ck1 = 384 + cq1;
#pragma unroll
    for (int j = 0; j < 4; ++j) { wq0[j] = conv_w[j * 768 + cq0]; wq1[j] = conv_w[j * 768 + cq1]; wk0[j] = conv_w[j * 768 + ck0]; wk1[j] = conv_w[j * 768 + ck1]; }
    bq0 = conv_b[cq0]; bq1 = conv_b[cq1]; bk0 = conv_b[ck0]; bk1 = conv_b[ck1]; }
    const float ib = i_b[h], fb = f_b[h];
    const float ksc = 0.10206207261596577f;
    f32x4 st[11];
#pragma unroll
    for (int i = 0; i < 11; ++i) st[i] = (f32x4){0.f, 0.f, 0.f, 0.f};
    for (int i = wave * 64 + lane; i < 112 * LPM / 2; i += 512) ((LAS unsigned*)Stt)[i] = 0u;
    for (int i = wave * 64 + lane; i < 16 * LP / 2; i += 512) ((LAS unsigned*)(Vt + 96 * LP))[i] = (i < LP / 2) ? 0x3f803f80u : 0u;
    float mprev = 0.f;
    const size_t m0 = (size_t)b * SEQ;
    const bf16* PB = proj + m0 * NPI + ML_B;
    float gain6[6];
#pragma unroll
    for (int ct = 0; ct < 6; ++ct) gain6[ct] = gn[640 + h * 96 + 16 * ct + lc];
    unsigned xq[11], xk[11], vv[8], gg;
#define ML_LOAD(cc) do { const int tb_ = 64 * (cc) + 8 * wave; \
        _Pragma("unroll") for (int i = 0; i < 11; ++i) { const int t_ = tb_ - 3 + i; const bool ok_ = t_ >= 0; const bf16* p_ = PB + (size_t)(ok_ ? t_ : 0) * NPI; \
            const unsigned a0_ = ok_ ? p_[cq0] : 0u, a1_ = (ok_ && has1) ? p_[cq1] : 0u, b0_ = ok_ ? p_[ck0] : 0u, b1_ = (ok_ && has1) ? p_[ck1] : 0u; xq[i] = a0_ | (a1_ << 16); xk[i] = b0_ | (b1_ << 16); } \
        _Pragma("unroll") for (int i = 0; i < 8; ++i) { const bf16* p_ = PB + (size_t)(tb_ + i) * NPI + 768 + h * 96; const unsigned a0_ = p_[d0], a1_ = has1 ? p_[d1] : 0u; vv[i] = a0_ | (a1_ << 16); } \
        { const bf16* p_ = PB + (size_t)(64 * (cc) + lane) * NPI; const unsigned a0_ = p_[1536 + h], a1_ = p_[1540 + h]; gg = a0_ | (a1_ << 16); } } while (0)
    { const int d0 = lane, d1 = 64 + (lane & 31); const bool has1 = lane < 32; const int cq0 = h * 96 + d0, cq1 = h * 96 + d1, ck0 = 384 + cq0, ck1 = 384 + cq1; ML_LOAD(0); }
#pragma unroll 1
    for (int c = 0; c < SEQ / 64; ++c) {
        const int lane = lane_id_opq(), q4 = lane >> 4, lc = lane & 15, o72 = lc * LP + 8 * q4, o104 = lc * LPM + 8 * q4;
        const int d0 = lane, d1 = 64 + (lane & 31); const bool has1 = lane < 32;
        const int cq0 = h * 96 + d0, cq1 = h * 96 + d1, ck0 = 384 + cq0, ck1 = 384 + cq1;
        const int tb = 64 * c + 8 * wave;
        float pm63, carry, ev_l; const float mold = mprev;
        { const float ic = __uint_as_float(gg << 16) + ib, lf = flogsigmoid(__uint_as_float(gg & 0xffff0000u) + fb);
          const float bc = wave_prefix_sum(lf), e = ic - bc; const float pm = fmaxf(wave_prefix_max(e), mprev);
          pm63 = __builtin_bit_cast(float, __builtin_amdgcn_readlane(__builtin_bit_cast(int, pm), 63)); carry = fexp(mprev - pm63); ev_l = e;
          if (wave == 0) { ev[lane] = e; pmv[lane] = pm; flv[lane] = fexp(-(bc + pm)); }
          mprev = __builtin_bit_cast(float, __builtin_amdgcn_readlane(__builtin_bit_cast(int, bc), 63)) + pm63; }
        { unsigned short kd0[8], kd1[8];
#pragma unroll
          for (int i = 0; i < 8; ++i) { const int tt = 8 * wave + i;
#define LO_(w) __uint_as_float((w) << 16)
#define HI_(w) __uint_as_float((w) & 0xffff0000u)
              float q0 = bq0 + LO_(xq[i]) * wq0[0] + LO_(xq[i + 1]) * wq0[1] + LO_(xq[i + 2]) * wq0[2] + LO_(xq[i + 3]) * wq0[3];
              float k0 = bk0 + LO_(xk[i]) * wk0[0] + LO_(xk[i + 1]) * wk0[1] + LO_(xk[i + 2]) * wk0[2] + LO_(xk[i + 3]) * wk0[3];
              float q1 = bq1 + HI_(xq[i]) * wq1[0] + HI_(xq[i + 1]) * wq1[1] + HI_(xq[i + 2]) * wq1[2] + HI_(xq[i + 3]) * wq1[3];
              float k1 = bk1 + HI_(xk[i]) * wk1[0] + HI_(xk[i + 1]) * wk1[1] + HI_(xk[i + 2]) * wk1[2] + HI_(xk[i + 3]) * wk1[3];
#undef LO_
#undef HI_
              q0 = q0 * fsigmoid(q0); k0 = k0 * fsigmoid(k0) * ksc; q1 = q1 * fsigmoid(q1); k1 = k1 * fsigmoid(k1) * ksc;
              const float wsi = fexp(__builtin_bit_cast(float, __builtin_amdgcn_readlane(__builtin_bit_cast(int, ev_l), tt)) - pm63);
              Qs[tt * LPM + d0] = f2bf16(q0); Ks[tt * LPM + d0] = f2bf16(k0); kd0[i] = f2bf16(k0 * wsi); kd1[i] = f2bf16(k1 * wsi);
              if (has1) { Qs[tt * LPM + d1] = f2bf16(q1); Ks[tt * LPM + d1] = f2bf16(k1); } }
          v4u w; w.x = kd0[0] | ((unsigned)kd0[1] << 16); w.y = kd0[2] | ((unsigned)kd0[3] << 16); w.z = kd0[4] | ((unsigned)kd0[5] << 16); w.w = kd0[6] | ((unsigned)kd0[7] << 16);
          *(LAS v4u*)(Kdt + d0 * LP + 8 * wave) = w;
          if (has1) { w.x = kd1[0] | ((unsigned)kd1[1] << 16); w.y = kd1[2] | ((unsigned)kd1[3] << 16); w.z = kd1[4] | ((unsigned)kd1[5] << 16); w.w = kd1[6] | ((unsigned)kd1[7] << 16);
              *(LAS v4u*)(Kdt + d1 * LP + 8 * wave) = w; }
          w.x = (vv[0] & 0xffffu) | (vv[1] << 16); w.y = (vv[2] & 0xffffu) | (vv[3] << 16); w.z = (vv[4] & 0xffffu) | (vv[5] << 16); w.w = (vv[6] & 0xffffu) | (vv[7] << 16);
          *(LAS v4u*)(Vt + d0 * LP + 8 * wave) = w;
          if (has1) { w.x = (vv[0] >> 16) | (vv[1] & 0xffff0000u); w.y = (vv[2] >> 16) | (vv[3] & 0xffff0000u); w.z = (vv[4] >> 16) | (vv[5] & 0xffff0000u); w.w = (vv[6] >> 16) | (vv[7] & 0xffff0000u);
              *(LAS v4u*)(Vt + d1 * LP + 8 * wave) = w; } }
        WG_BAR_L();
        unsigned og[8];
#pragma unroll
        for (int i = 0; i < 8; ++i) { const bf16* p = PB + (size_t)(tb + i) * NPI + 1152 + h * 96; const unsigned a0_ = p[d0], a1_ = has1 ? p[d1] : 0u; og[i] = a0_ | (a1_ << 16); }
        if (c + 1 < SEQ / 64) ML_LOAD(c + 1);
        { const int rt = wave >> 1;
#pragma unroll
          for (int u = 0; u < 2; ++u) { const int ct = 2 * (wave & 1) + u;
              f32x4 s = (f32x4){0.f, 0.f, 0.f, 0.f};
              if (ct <= rt) s = mm_tile<3>(Qs + 16 * rt * LPM + o104, Ks + 16 * ct * LPM + o104, s);
              const float em = ev[16 * ct + lc];
#pragma unroll
              for (int r = 0; r < 4; ++r) { const int l = 16 * rt + 4 * q4 + r, m = 16 * ct + lc; const float val = (l >= m) ? s[r] * fexp(em - pmv[l]) : 0.f; Ps[l * LP + m] = f2bf16(val); } } }
        f32x4 inter[7];
        if (wave < 4) {
#pragma unroll
            for (int ct = 0; ct < 7; ++ct) inter[ct] = mm_tile<3>(Qs + 16 * wave * LPM + o104, Stt + 16 * ct * LPM + o104, (f32x4){0.f, 0.f, 0.f, 0.f}); }
#pragma unroll
        for (int i = 0; i < 8; ++i) { Os[(8 * wave + i) * LPM + d0] = (unsigned short)(og[i] & 0xffffu); if (has1) Os[(8 * wave + i) * LPM + d1] = (unsigned short)(og[i] >> 16); }
        WG_BAR_L();
        if (wave < 4) {
            f32x4 y[7];
#pragma unroll
            for (int ct = 0; ct < 7; ++ct) y[ct] = mm_tile<2>(Ps + 16 * wave * LP + o72, Vt + 16 * ct * LP + o72, (f32x4){0.f, 0.f, 0.f, 0.f});
#pragma unroll
            for (int r = 0; r < 4; ++r) { const int l = 16 * wave + 4 * q4 + r; const float iw = fexp(mold - pmv[l]);
#pragma unroll
                for (int ct = 0; ct < 7; ++ct) y[ct][r] += iw * inter[ct][r];
                const float den = __shfl(y[6][r], lane & 48);
                const float dn = __builtin_amdgcn_rcpf(fmaxf(fabsf(den), flv[l]));
                float s = 0.f;
#pragma unroll
                for (int ct = 0; ct < 6; ++ct) { y[ct][r] *= dn; s += y[ct][r]; }
                const float mean = sum16(s) * (1.0f / 96.0f); float qv = 0.f;
#pragma unroll
                for (int ct = 0; ct < 6; ++ct) { const float dd = y[ct][r] - mean; qv += dd * dd; }
                const float rstd = __builtin_amdgcn_rsqf(sum16(qv) * (1.0f / 96.0f) + GN_EPS);
                bf16* orow = mixed + (m0 + 64 * c + l) * DM + 640 + h * 96 + lc;
#pragma unroll
                for (int ct = 0; ct < 6; ++ct) { const float o = bf2f(Os[l * LPM + 16 * ct + lc]); orow[16 * ct] = f2bf16((y[ct][r] - mean) * rstd * gain6[ct] * fsigmoid(o)); } }
        } else {
#pragma unroll
            for (int i = 0; i < 11; ++i) { const int t = (wave - 4) + 4 * i;
                if (t < 42) { const int dt = t / 7, et = t % 7;
                    st[i] = mm_tile<2>(Kdt + 16 * dt * LP + o72, Vt + 16 * et * LP + o72, st[i] * carry);
                    v2u w; w.x = pk2(st[i][0], st[i][1]); w.y = pk2(st[i][2], st[i][3]);
                    *(LAS v2u*)(Stt + (16 * et + lc) * LPM + 16 * dt + 4 * q4) = w; } }
        }
        WG_BAR_L();
    }
#undef ML_LOAD
}
#ifndef RW_DBG
#define RW_DBG 0xFF
#endif
__device__ __forceinline__ void rwkv_unit(int b, int h, const bf16* proj, const float* CUM, const bf16* AA, const bf16* GG, const float* mu, const float* k_k, const float* k_a, const float* r_k,
                                          const float* gn, bf16* mixed, LAS unsigned char* lds, int wave, int lane0,
                                          int cb, int ce, const float* hs_in, unsigned* flag_in, float* hs_out, unsigned* flag_out) {
    constexpr int SLOT = 64 * LP;
    LAS bf16* KH = (LAS bf16*)lds; LAS bf16* BH = KH + SLOT; LAS bf16* KT = BH + SLOT; LAS bf16* RT = KT + SLOT; LAS bf16* KHgt = RT + SLOT; LAS bf16* BHgtn = KHgt + SLOT;
    LAS bf16* Vt = BHgtn + SLOT; LAS bf16* AkT = Vt + SLOT; LAS bf16* BbTn = AkT + SLOT; LAS bf16* BkT = BbTn + SLOT; LAS bf16* S0b = BkT + SLOT; LAS bf16* Loffb = S0b + SLOT; LAS bf16* Vr = Loffb + SLOT; LAS bf16* Gr = Vr + SLOT;
    LAS float* RHS = (LAS float*)KH; LAS bf16* Ut = KT;
    LAS float* LTd = (LAS float*)(Gr + SLOT);
    LAS float* XS = LTd + 64 * 20;
    LAS float* GCv = XS + 16 * 64; LAS float* bonv = GCv + 64;
    float mu_r, mu_k, mu_v, kkc, kac, rkc;
    { const int c0 = h * 64 + lane0; mu_r = mu[c0]; mu_k = mu[384 + c0]; mu_v = mu[768 + c0]; kkc = k_k[c0]; kac = k_a[c0]; rkc = r_k[c0]; }
    for (int i = wave * 64 + lane0; i < 5 * SLOT / 2; i += 512) ((LAS unsigned*)AkT)[i] = 0u;
    float gain4[4];
#pragma unroll
    for (int ct = 0; ct < 4; ++ct) gain4[ct] = gn[256 + h * 64 + 16 * ct + (lane0 & 15)];
    f32x4 sacc[4];
#pragma unroll
    for (int i = 0; i < 4; ++i) sacc[i] = (f32x4){0.f, 0.f, 0.f, 0.f};
    if (hs_in) {
        if (wave == 0) { unsigned spins = 0u;
            while (__hip_atomic_load(flag_in, __ATOMIC_RELAXED, __HIP_MEMORY_SCOPE_AGENT) == 0u) { __builtin_amdgcn_s_sleep(4); if (++spins > (1u << 22)) break; }
            __builtin_amdgcn_fence(__ATOMIC_ACQUIRE, "agent"); asm volatile("s_waitcnt vmcnt(0)" ::: "memory"); }
        WG_BAR();
        if (wave < 4) {
#pragma unroll
            for (int jt = 0; jt < 4; ++jt) {
#pragma unroll
                for (int r = 0; r < 4; ++r) { sacc[jt][r] = hs_in[(wave * 4 + jt) * 256 + r * 64 + lane0];
                    S0b[(16 * wave + 4 * (lane0 >> 4) + r) * LP + 16 * jt + (lane0 & 15)] = f2bf16(sacc[jt][r]); } } }
    }
    const size_t m0 = (size_t)b * SEQ;
    const bf16* PU = proj + m0 * NPI + RW_B + h * 64;
    const float* CU = CUM + m0 * 384 + h * 64; const bf16* AU = AA + m0 * 384 + h * 64; const bf16* GU = GG + m0 * 384 + h * 64;
    unsigned short rr[9], rk[9], rv[9], ra[8], rg[8]; float rc[9], rc63;
#define RWKV_LOAD(cc) do { const int tb_ = 64 * (cc) + 8 * wave; \
        _Pragma("unroll") for (int i = 0; i < 9; ++i) { const int t_ = tb_ - 1 + i; const bool ok_ = t_ >= 0; const bf16* p_ = PU + (size_t)(ok_ ? t_ : 0) * NPI; \
            rr[i] = ok_ ? p_[lane] : (unsigned short)0; rk[i] = ok_ ? p_[384 + lane] : (unsigned short)0; rv[i] = ok_ ? p_[768 + lane] : (unsigned short)0; \
            rc[i] = (i > 0 || wave > 0) ? CU[(size_t)(ok_ ? t_ : 0) * 384 + lane] : 0.f; if (i > 0) { ra[i - 1] = AU[(size_t)t_ * 384 + lane]; rg[i - 1] = GU[(size_t)t_ * 384 + lane]; } } \
        rc63 = CU[(size_t)(64 * (cc) + 63) * 384 + lane]; } while (0)
    { const int lane = lane0; RWKV_LOAD(cb); }
#pragma unroll 1
    for (int c = cb; c < ce; ++c) {
        const int lane = lane_id_opq(), q4 = lane >> 4, lc = lane & 15, o72 = lc * LP + 8 * q4;
        if (RW_DBG & 1) { unsigned short khg[8], bhg[8]; const float gc63 = fexp(rc63); float ecp = fexp(rc[0]);
#pragma unroll
          for (int i = 0; i < 8; ++i) { const int tt = 8 * wave + i;
              const float cr = bf2f(rr[i + 1]), ck = bf2f(rk[i + 1]);
              const float r = cr + (bf2f(rr[i]) - cr) * mu_r, k = ck + (bf2f(rk[i]) - ck) * mu_k, a = bf2f(ra[i]);
              float kk = k * kkc; kk = kk * __builtin_amdgcn_rsqf(fmaxf(wave_sum(kk * kk), 1e-24f));
              const float kmod = k * (1.0f + (a - 1.0f) * kac), beta = kk * a;
              const float bon = wave_sum(r * kmod * rkc); if (lane == 0) bonv[tt] = bon;
              const float cm = rc[i + 1], cp = rc[i];
              const float em = fexp(-cm), eg = gc63 * em, ec = __builtin_amdgcn_rcpf(em);
              KH[tt * LP + lane] = f2bf16(kmod * em); BH[tt * LP + lane] = f2bf16(beta * em); KT[tt * LP + lane] = f2bf16(kk * ecp); RT[tt * LP + lane] = f2bf16(r * ec); ecp = ec;
              khg[i] = f2bf16(kmod * eg); bhg[i] = f2bf16(-beta * eg); }
          v4u w; w.x = khg[0] | ((unsigned)khg[1] << 16); w.y = khg[2] | ((unsigned)khg[3] << 16); w.z = khg[4] | ((unsigned)khg[5] << 16); w.w = khg[6] | ((unsigned)khg[7] << 16);
          *(LAS v4u*)(KHgt + lane * LP + 8 * wave) = w;
          w.x = bhg[0] | ((unsigned)bhg[1] << 16); w.y = bhg[2] | ((unsigned)bhg[3] << 16); w.z = bhg[4] | ((unsigned)bhg[5] << 16); w.w = bhg[6] | ((unsigned)bhg[7] << 16);
          *(LAS v4u*)(BHgtn + lane * LP + 8 * wave) = w;
          unsigned short vs[8];
#pragma unroll
          for (int i = 0; i < 8; ++i) { const float cv = bf2f(rv[i + 1]); vs[i] = f2bf16(cv + (bf2f(rv[i]) - cv) * mu_v); Vr[(8 * wave + i) * LP + lane] = vs[i]; Gr[(8 * wave + i) * LP + lane] = rg[i]; }
          w.x = vs[0] | ((unsigned)vs[1] << 16); w.y = vs[2] | ((unsigned)vs[3] << 16); w.z = vs[4] | ((unsigned)vs[5] << 16); w.w = vs[6] | ((unsigned)vs[7] << 16);
          *(LAS v4u*)(Vt + lane * LP + 8 * wave) = w;
          if (wave == 0) GCv[lane] = gc63; }
        WG_BAR_L();
#pragma unroll
        for (int u2 = 0; u2 < 2; ++u2) { const int idx = 2 * wave + u2, rt = idx >> 2, ct = idx & 3;
            if (ct <= rt) {
                const int s = 16 * ct + lc; const LAS bf16* kt = KT + 16 * rt * LP + o72; const LAS bf16* rtp = RT + 16 * rt * LP + o72; const LAS bf16* bh = BH + 16 * ct * LP + o72; const LAS bf16* kh = KH + 16 * ct * LP + o72;
                const f32x4 z = (f32x4){0.f, 0.f, 0.f, 0.f};
                const f32x4 g0 = mm_tile<2>(kt, bh, z), g1 = mm_tile<2>(kt, kh, z), g2 = mm_tile<2>(rtp, bh, z), g3 = mm_tile<2>(rtp, kh, z);
#pragma unroll
                for (int r = 0; r < 4; ++r) { const int t = 16 * rt + 4 * q4 + r;
                    if (ct < rt) Loffb[t * LP + s] = f2bf16(g0[r]); else LTd[s * 20 + (t - 16 * rt)] = (s < t) ? g0[r] : 0.f;
                    AkT[t * LP + s] = f2bf16((s < t) ? g1[r] : 0.f);
                    BbTn[t * LP + s] = f2bf16((s <= t) ? -g2[r] : 0.f);
                    BkT[t * LP + s] = f2bf16((s <= t) ? g3[r] : 0.f); } } }
        WG_BAR_L();
#pragma unroll
        for (int u = 0; u < ((RW_DBG & 4) ? 2 : 0); ++u) { const int rt = wave >> 1, ct = 2 * (wave & 1) + u;
            f32x4 g = mm_tile<2>(KT + 16 * rt * LP + o72, S0b + 16 * ct * LP + o72, (f32x4){0.f, 0.f, 0.f, 0.f});
            g = mm_tile<2>(AkT + 16 * rt * LP + o72, Vt + 16 * ct * LP + o72, g);
#pragma unroll
            for (int r = 0; r < 4; ++r) RHS[(16 * rt + 4 * q4 + r) * 64 + 16 * ct + lc] = g[r]; }
        WG_BAR_L();
        f32x4 y[4];
        if ((RW_DBG & 8) && wave == 0) {
#pragma unroll
            for (int a = 0; a < 4; ++a) {
                if (a > 0) {
#pragma unroll
                    for (int it = 0; it < 4; ++it) { f32x4 cr = (f32x4){0.f, 0.f, 0.f, 0.f};
                        if (a == 3) cr = mm_tile<2>(Loffb + 16 * a * LP + o72, Ut + 16 * it * LP + o72, cr); else cr = mm_tile<1>(Loffb + 16 * a * LP + o72, Ut + 16 * it * LP + o72, cr);
#pragma unroll
                        for (int r = 0; r < 4; ++r) XS[(4 * q4 + r) * 64 + 16 * it + lc] = cr[r]; }
                    asm volatile("s_waitcnt lgkmcnt(0)" ::: "memory");
                }
                float acc[16];
#pragma unroll
                for (int t = 0; t < 16; ++t) acc[t] = RHS[(16 * a + t) * 64 + lane] - (a > 0 ? XS[t * 64 + lane] : 0.f);
                const LAS float* Ld = LTd + 16 * a * 20; asm volatile("" : "+v"(Ld));
#pragma unroll
                for (int s2 = 0; s2 < 15; ++s2) { const float us = acc[s2];
#pragma unroll
                    for (int t4 = (s2 + 1) / 4; t4 < 4; ++t4) { const f32x4 l4 = *(const LAS f32x4*)(Ld + s2 * 20 + 4 * t4);
                        acc[4 * t4] -= l4.x * us; acc[4 * t4 + 1] -= l4.y * us; acc[4 * t4 + 2] -= l4.z * us; acc[4 * t4 + 3] -= l4.w * us; }
                    if (s2 == 3 || s2 == 7) asm volatile("" : "+v"(Ld) : "v"(acc[s2 + 1])); }
                v4u w; w.x = pk2(acc[0], acc[1]); w.y = pk2(acc[2], acc[3]); w.z = pk2(acc[4], acc[5]); w.w = pk2(acc[6], acc[7]);
                *(LAS v4u*)(Ut + lane * LP + 16 * a) = w;
                w.x = pk2(acc[8], acc[9]); w.y = pk2(acc[10], acc[11]); w.z = pk2(acc[12], acc[13]); w.w = pk2(acc[14], acc[15]);
                *(LAS v4u*)(Ut + lane * LP + 16 * a + 8) = w;
                asm volatile("s_waitcnt lgkmcnt(0)" ::: "memory");
            }
        }
        if (c + 1 < ce) RWKV_LOAD(c + 1);
        if (wave >= 4) {
#pragma unroll
            for (int ct = 0; ct < 4; ++ct) { y[ct] = mm_tile<2>(RT + 16 * (wave - 4) * LP + o72, S0b + 16 * ct * LP + o72, (f32x4){0.f, 0.f, 0.f, 0.f}); y[ct] = mm_tile<2>(BkT + 16 * (wave - 4) * LP + o72, Vt + 16 * ct * LP + o72, y[ct]); }
        } else {
#pragma unroll
            for (int jt = 0; jt < 4; ++jt) { const float gc = GCv[16 * jt + lc]; sacc[jt] = mm_tile<2>(Vt + 16 * wave * LP + o72, KHgt + 16 * jt * LP + o72, sacc[jt] * gc); }
        }
        WG_BAR_L();
        if (wave >= 4) {
#pragma unroll
            for (int ct = 0; ct < 4; ++ct) y[ct] = mm_tile<2>(BbTn + 16 * (wave - 4) * LP + o72, Ut + 16 * ct * LP + o72, y[ct]);
#pragma unroll
            for (int r = 0; r < 4; ++r) { const int t = 16 * (wave - 4) + 4 * q4 + r; const size_t row = m0 + 64 * c + t;
                float s = 0.f;
#pragma unroll
                for (int ct = 0; ct < 4; ++ct) s += y[ct][r];
                const float mean = sum16(s) * (1.0f / 64.0f); float qv = 0.f;
#pragma unroll
                for (int ct = 0; ct < 4; ++ct) { const float dd = y[ct][r] - mean; qv += dd * dd; }
                const float rstd = __builtin_amdgcn_rsqf(sum16(qv) * (1.0f / 64.0f) + GN_EPS);
                const float bon = bonv[t]; bf16* orow = mixed + row * DM + 256 + h * 64 + lc;
#pragma unroll
                for (int ct = 0; ct < 4; ++ct) orow[16 * ct] = f2bf16(((y[ct][r] - mean) * rstd * gain4[ct] + bon * bf2f(Vr[t * LP + 16 * ct + lc])) * bf2f(Gr[t * LP + 16 * ct + lc])); }
        } else {
#pragma unroll
            for (int jt = 0; jt < 4; ++jt) { sacc[jt] = mm_tile<2>(Ut + 16 * wave * LP + o72, BHgtn + 16 * jt * LP + o72, sacc[jt]);
#pragma unroll
                for (int r = 0; r < 4; ++r) S0b[(16 * wave + 4 * q4 + r) * LP + 16 * jt + lc] = f2bf16(sacc[jt][r]); }
        }
        WG_BAR_L();
    }
    if (hs_out) {
        if (wave < 4) {
#pragma unroll
            for (int jt = 0; jt < 4; ++jt)
#pragma unroll
                for (int r = 0; r < 4; ++r) __hip_atomic_store(hs_out + (wave * 4 + jt) * 256 + r * 64 + lane0, sacc[jt][r], __ATOMIC_RELAXED, __HIP_MEMORY_SCOPE_AGENT);
        }
        WG_BAR();
        if (wave == 0 && lane0 == 0) __hip_atomic_store(flag_out, 1u, __ATOMIC_RELAXED, __HIP_MEMORY_SCOPE_AGENT);
    }
#undef RWKV_LOAD
}

struct Args { const float* in[25]; float* out; unsigned char* ws; int ph_lo, ph_hi, li, pad; };
typedef const __attribute__((address_space(4))) Args* KArgs;
__device__ __forceinline__ KArgs kargs() { KArgs p = (KArgs)__builtin_amdgcn_kernarg_segment_ptr(); asm volatile("" : "+s"(p)); return p; }
#ifndef DBG_MASK
#define DBG_MASK 0xFFFF
#endif
#define EN(bit) ((DBG_MASK >> (bit)) & 1)
#ifndef PROBE_DUP
#define PROBE_DUP 0
#endif
#define REP(bit) for (int rep_ = 0; rep_ < (((PROBE_DUP >> (bit)) & 1) ? 2 : 1); ++rep_)
__global__ void __launch_bounds__(NWAVES * 64, 2) mk_fwd(Args args_unused) {
    extern __shared__ __attribute__((aligned(16))) unsigned char lds_raw[];
    LAS unsigned char* lds = (LAS unsigned char*)lds_raw;
    volatile LAS unsigned* MISC = (volatile LAS unsigned*)(lds + MISC_OFF);
    const int wave = __builtin_amdgcn_readfirstlane((int)threadIdx.x >> 6);
    const int G = gridDim.x, gw = blockIdx.x * NWAVES + wave, ngw = G * NWAVES;
    for (int u = threadIdx.x; u < (LDS_BYTES - LDSCTL_OFF) / 4; u += NWAVES * 64) ((LAS unsigned*)(lds + LDSCTL_OFF))[u] = 0u;
    __syncthreads();
    XcdBarrier bar; int lo, hi;
    { KArgs A = kargs(); bar = xcd_barrier_post((unsigned*)(A->ws + WS_CTL) + CW_BAR + (MK_PER_PHASE ? 0 : A->li) * XCD_BAR_WORDS, MISC + 8); lo = A->ph_lo; hi = A->ph_hi; }
#define IN(k) (lo <= (k) && (k) < hi)
#define SEAM(k) do { if (IN(k) && IN((k) + 1)) xcd_barrier(bar); } while (0)
#define LANE_TID() int wave_o = wave, gw_o = gw; asm volatile("" : "+s"(wave_o), "+s"(gw_o)); (void)gw_o; const int lane_o = lane_id_opq(), tid_o = wave_o * 64 + lane_o; (void)tid_o

    if (EN(0) && IN(0)) {
        KArgs A = kargs(); unsigned char* ws = A->ws; LANE_TID();
        p0_mod(A->in[1], A->in[2], A->in[3], (float*)(ws + WS_MOD), lds, tid_o, lane_o, wave_o);
        p0_weights(A->in[6], A->in[21], A->in[22], A->in[23], A->in[10], A->in[12], A->in[13], ws, lds, gw_o, ngw, wave_o, lane_o);
    }
    SEAM(0);
#pragma unroll 1
    for (int l = 0; l < NL; ++l) {
        const int pb = 1 + 8 * l;
        REP(2) if (EN(1) && IN(pb + 0)) { KArgs A = kargs(); unsigned char* ws = A->ws; LANE_TID();
            norm_mod_phase(l == 0 ? A->in[0] : (const float*)nullptr, (const bf16*)A->out, A->in[4] + l * DM, (const float*)(ws + WS_MOD) + (size_t)l * NB * MODP, 0, DM, (bf16*)(ws + WS_H), gw_o, ngw, lane_o); }
        SEAM(pb + 0);
        REP(3) if (EN(2) && IN(pb + 1)) { KArgs A = kargs(); unsigned char* ws = A->ws; LANE_TID();
            pg8::Gemm g{(const bf16*)(ws + WS_H), (const bf16*)(ws + WS_WIN) + (size_t)l * NPI * DM, MT, NPI, DM}; pg8::StaticOrder S; S.init(MT, NPI, G, (int)blockIdx.x);
            pg8::EpiBf16Plain E{(bf16*)(ws + WS_PROJ), NPI};
            pg8::gemm_phase<pg8::EpiBf16Plain, pg8::StaticOrder, true, true>(lds, g, S, E, wave_o);
        }
        SEAM(pb + 1);
        REP(1) if (EN(3) && IN(pb + 2)) { KArgs A = kargs(); unsigned char* ws = A->ws; LANE_TID();
            rwkv_prep_mfma((const bf16*)(ws + WS_PROJ), A->in[8] + l * RWKV_IN, A->in[9] + l * 384, A->in[11] + l * 384, (const bf16*)(ws + WS_WL) + (size_t)l * 384 * 256,
                           (float*)(ws + WS_DEC), (bf16*)(ws + WS_AA), (bf16*)(ws + WS_GG), lds, wave_o); }
        SEAM(pb + 2);
        REP(0) if (EN(4) && IN(pb + 3)) { KArgs A = kargs(); unsigned char* ws = A->ws; LANE_TID();
            const float* gn = A->in[7] + l * DM; const bf16* PROJ = (const bf16*)(ws + WS_PROJ); bf16* Hb = (bf16*)(ws + WS_H);
            int u = (int)blockIdx.x; asm volatile("" : "+s"(u));
            float* HS = (float*)(ws + WS_HS) + (size_t)l * 64 * 4096; unsigned* FL = (unsigned*)(ws + WS_CTL) + CW_FLAG + l * 64 * 64;
            const float* DECp = (const float*)(ws + WS_DEC); const bf16* AAp = (const bf16*)(ws + WS_AA); const bf16* GGp = (const bf16*)(ws + WS_GG);
            if (u < 128) {
                mlstm_unit(u >> 2, u & 3, PROJ, A->in[17] + (size_t)l * 4 * 768, A->in[18] + l * 768, A->in[19] + l * 4, A->in[20] + l * 4, gn, Hb, lds, wave_o, lane_o);
            } else {
                const int v0 = u - 128, k = v0 & 63; const bool dgrp = v0 >= 64;
#pragma unroll 1
                for (int rep = 0; rep < 2; ++rep) { const bool half = (rep == 0) == dgrp; const int q = half ? 128 + k : v0;
                    const int cb = (half && !dgrp) ? 16 : 0, ce = (half && dgrp) ? 16 : 32;
                    rwkv_unit(q / 6, q % 6, PROJ, DECp, AAp, GGp, A->in[8] + l * RWKV_IN, A->in[14] + l * 384, A->in[15] + l * 384, A->in[16] + l * 384, gn, Hb, lds, wave_o, lane_o,
                              cb, ce, (half && !dgrp) ? HS + (size_t)k * 4096 : nullptr, (half && !dgrp) ? FL + k * 64 : nullptr, (half && dgrp) ? HS + (size_t)k * 4096 : nullptr, (half && dgrp) ? FL + k * 64 : nullptr); }
                ret_unit(v0 >> 2, v0 & 3, PROJ, gn, Hb, lds, wave_o, lane_o);
            }
        }
        SEAM(pb + 3);
        if (EN(6) && IN(pb + 4)) { KArgs A = kargs(); unsigned char* ws = A->ws; LANE_TID();
            pg8::Gemm g{(const bf16*)(ws + WS_H), (const bf16*)(ws + WS_WOUT) + (size_t)l * DM * DM, MT, DM, DM}; pg8::StaticOrder S; S.init(MT, DM, G, (int)blockIdx.x);
            pg8::EpiResGate E{l == 0 ? A->in[0] : (const float*)nullptr, (const bf16*)A->out, (bf16*)A->out, DM, (const float*)(ws + WS_MOD) + (size_t)l * NB * MODP + 2 * DM, MODP};
            pg8::gemm_phase<pg8::EpiResGate, pg8::StaticOrder, true, true>(lds, g, S, E, wave_o);
        }
        SEAM(pb + 4);
        REP(2) if (EN(1) && IN(pb + 5)) { KArgs A = kargs(); unsigned char* ws = A->ws; LANE_TID();
            norm_mod_phase((const float*)nullptr, (const bf16*)A->out, A->in[5] + l * DM, (const float*)(ws + WS_MOD) + (size_t)l * NB * MODP, 3 * DM, 4 * DM, (bf16*)(ws + WS_H), gw_o, ngw, lane_o); }
        SEAM(pb + 5);
        REP(4) if (EN(7) && IN(pb + 6)) { KArgs A = kargs(); unsigned char* ws = A->ws; LANE_TID();
            pg8::Gemm g{(const bf16*)(ws + WS_H), (const bf16*)(ws + WS_WF1) + (size_t)l * NF1 * DM, MT, NF1, DM}; pg8::StaticOrder S; S.init(MT, NF1, G, (int)blockIdx.x);
            pg8::EpiSwiGLU E{(bf16*)(ws + WS_PROJ), DFF};
            pg8::gemm_phase<pg8::EpiSwiGLU, pg8::StaticOrder, true, true>(lds, g, S, E, wave_o);
        }
        SEAM(pb + 6);
        if (EN(8) && IN(pb + 7)) { KArgs A = kargs(); unsigned char* ws = A->ws; LANE_TID();
            pg8::Gemm g{(const bf16*)(ws + WS_PROJ), (const bf16*)(ws + WS_WF2) + (size_t)l * DM * DFF, MT, DM, DFF}; pg8::StaticOrder S; S.init(MT, DM, G, (int)blockIdx.x);
            pg8::EpiResGate E{(const float*)nullptr, (const bf16*)A->out, l + 1 < NL ? (bf16*)A->out : (bf16*)(ws + WS_XFIN), DM, (const float*)(ws + WS_MOD) + (size_t)l * NB * MODP + 5 * DM, MODP};
            pg8::gemm_phase<pg8::EpiResGate, pg8::StaticOrder, true, true>(lds, g, S, E, wave_o);
        }
        SEAM(pb + 7);
    }
    if (EN(9) && IN(N_PHASES - 1)) { KArgs A = kargs(); int gw_o = gw; asm volatile("" : "+s"(gw_o)); final_norm_phase((const bf16*)(A->ws + WS_XFIN), A->out, A->in[24], gw_o, ngw, lane_id_opq()); }
#undef IN
#undef SEAM
}

extern "C" void kernel_launch(void* const* d_in, const int* in_sizes, int n_in, void* d_out, int out_size, void* d_ws, size_t ws_size, hipStream_t stream) {
    static int grid = 0;
    if (grid == 0) {
        if (n_in != 25 || in_sizes[0] != MT * DM || out_size != MT * DM || ws_size < WS_END) { fprintf(stderr, "kernel_launch: shape/workspace mismatch (n_in %d, in0 %d, out %d, ws %zu)\n", n_in, n_in > 0 ? in_sizes[0] : -1, out_size, ws_size); grid = -1; return; }
        int dev = 0, cus = 0, per_cu = 0;
        if (hipGetDevice(&dev) != hipSuccess || hipDeviceGetAttribute(&cus, hipDeviceAttributeMultiprocessorCount, dev) != hipSuccess) { grid = -1; return; }
        if (hipFuncSetAttribute((const void*)mk_fwd, hipFuncAttributeMaxDynamicSharedMemorySize, LDS_BYTES) != hipSuccess) { fprintf(stderr, "kernel_launch: hipFuncSetAttribute failed\n"); grid = -1; return; }
        if (hipOccupancyMaxActiveBlocksPerMultiprocessor(&per_cu, (const void*)mk_fwd, NWAVES * 64, LDS_BYTES) != hipSuccess || per_cu < 1) { fprintf(stderr, "kernel_launch: occupancy query says %d\n", per_cu); }
        (void)hipGetLastError();
        grid = cus;
    }
    if (grid < 0) return;
    if (hipMemsetAsync((char*)d_ws + WS_CTL, 0, CTL_ZERO_BYTES, stream) != hipSuccess) return;
    Args a{};
    for (int i = 0; i < 25; ++i) a.in[i] = (const float*)d_in[i];
    a.out = (float*)d_out; a.ws = (unsigned char*)d_ws;
#if MK_PER_PHASE
    for (int p = 0; p < N_PHASES; ++p) { a.ph_lo = p; a.ph_hi = p + 1; a.li = 0; hipLaunchKernelGGL(mk_fwd, dim3(grid), dim3(NWAVES * 64), LDS_BYTES, stream, a); }
#else
    a.ph_lo = 0; a.ph_hi = N_PHASES; a.li = 0;
    hipLaunchKernelGGL(mk_fwd, dim3(grid), dim3(NWAVES * 64), LDS_BYTES, stream, a);
#endif
}
```

```cpp
#include <hip/hip_runtime.h>
#include <cstdio>
#include <cstdint>
__device__ __forceinline__ int lane_id_opq() { int l = (int)__builtin_amdgcn_mbcnt_hi(~0u, __builtin_amdgcn_mbcnt_lo(~0u, 0u)); asm volatile("" : "+v"(l)); return l; }

namespace pg8 {
#define PG8_LAS __attribute__((address_space(3)))
typedef unsigned short bf16_t;
typedef short bf16x8 __attribute__((ext_vector_type(8)));
typedef float f32x4 __attribute__((ext_vector_type(4)));
typedef unsigned u32x4 __attribute__((ext_vector_type(4)));
constexpr int BM = 256, BK = 64, HALF = 128, HTB = HALF * BK * 2  , STAGE_BYTES = 8 * HTB, NXCD = 8, WGM = 8;

__host__ __device__ __forceinline__ int lds_byte(int r, int c) { const int st = (r >> 4) * 2 + (c >> 5), rr = r & 15, cc = c & 31, ob = rr * 64 + cc * 2; return st * 1024 + (ob ^ (((ob >> 9) & 1) << 5)); }
__host__ __device__ __forceinline__ void stage_rc(int b, int& R, int& C) { const int st = b / 1024, sb = b % 1024, swz = sb ^ (((sb >> 9) & 1) << 5); R = (st >> 1) * 16 + swz / 64; C = (st & 1) * 32 + (swz % 64) / 2; }
__host__ __device__ __forceinline__ int perm32(int rho) { const int n = rho >> 4, i = rho & 15; return 8 * (i >> 2) + 4 * n + (i & 3); }

struct Unit { int pm, pn; };
struct Gemm { const bf16_t* A; const bf16_t* Bt; int M, N, K; };

struct StaticOrder {
    int nM, nN, nwg, G, c;
    __host__ __device__ void init(int M, int N, int G_, int c_) { nM = M / BM; nN = N / BM; nwg = nM * nN; G = G_; c = c_; }
    __host__ __device__ bool next(int i, Unit& u) const {
        const long L = (long)i * G + c; if (L >= nwg) return false;
        int wgid = (int)L; { const int q = nwg / NXCD, r = nwg % NXCD, xcd = wgid % NXCD, off = wgid / NXCD; wgid = (xcd < r ? xcd * (q + 1) : r * (q + 1) + (xcd - r) * q) + off; }
        const int nig = WGM * nN, gid = wgid / nig, fm = gid * WGM, gsz = (nM - fm) < WGM ? (nM - fm) : WGM;
        u.pm = fm + ((wgid % nig) % gsz); u.pn = (wgid % nig) / gsz; return true;
    }
    __device__ __forceinline__ void a_ready(const Unit&) const {}
    __device__ __forceinline__ void done(const Unit&) const {}
};

__device__ __forceinline__ unsigned cvt_pk_bf16(float lo, float hi) { unsigned r; asm volatile("v_cvt_pk_bf16_f32 %0, %1, %2" : "=v"(r) : "v"(lo), "v"(hi)); return r; }
typedef float f32x2 __attribute__((ext_vector_type(2)));

typedef float f32x2e __attribute__((ext_vector_type(2)));
typedef __bf16 bf16x2e __attribute__((ext_vector_type(2)));
__device__ __forceinline__ unsigned cvt_pk(float lo, float hi) { const f32x2e v = {lo, hi}; return __builtin_bit_cast(unsigned, __builtin_convertvector(v, bf16x2e)); }
__device__ __forceinline__ float silu_f(float x) { return x * __builtin_amdgcn_rcpf(1.0f + __expf(-x)); }
struct EpiBf16Plain {
    static constexpr bool PERM = true, AFTER_DRAIN = false;
    bf16_t* O; int ldc;
    __device__ __forceinline__ void operator()(const f32x4 (&acc)[2][2][4][2], const Unit& u, int wr, int wc, int fr, int fq) const {
        const int row0 = u.pm * BM + wr * 64 + fr, col0 = u.pn * BM + wc * 32 + 8 * fq;
#pragma unroll
        for (int ai = 0; ai < 2; ++ai)
#pragma unroll
            for (int m = 0; m < 4; ++m) { bf16_t* rowp = O + (size_t)(row0 + ai * HALF + m * 16) * ldc + col0;
#pragma unroll
                for (int bj = 0; bj < 2; ++bj) { const f32x4 v0 = acc[ai][bj][m][0], v1 = acc[ai][bj][m][1];
                    u32x4 w; w.x = cvt_pk(v0[0], v0[1]); w.y = cvt_pk(v0[2], v0[3]); w.z = cvt_pk(v1[0], v1[1]); w.w = cvt_pk(v1[2], v1[3]);
                    *(u32x4*)(rowp + bj * HALF) = w; } }
    }
};
struct EpiSwiGLU {
    static constexpr bool PERM = true, AFTER_DRAIN = false;
    bf16_t* O; int ldc;
    __device__ __forceinline__ void operator()(const f32x4 (&acc)[2][2][4][2], const Unit& u, int wr, int wc, int fr, int fq) const {
        const int row0 = u.pm * BM + wr * 64 + fr, col0 = u.pn * HALF + wc * 32 + 8 * fq;
#pragma unroll
        for (int ai = 0; ai < 2; ++ai)
#pragma unroll
            for (int m = 0; m < 4; ++m) { bf16_t* rowp = O + (size_t)(row0 + ai * HALF + m * 16) * ldc + col0;
                const f32x4 g0 = acc[ai][0][m][0], g1 = acc[ai][0][m][1], u0 = acc[ai][1][m][0], u1 = acc[ai][1][m][1];
                u32x4 w; w.x = cvt_pk(silu_f(g0[0]) * u0[0], silu_f(g0[1]) * u0[1]); w.y = cvt_pk(silu_f(g0[2]) * u0[2], silu_f(g0[3]) * u0[3]);
                w.z = cvt_pk(silu_f(g1[0]) * u1[0], silu_f(g1[1]) * u1[1]); w.w = cvt_pk(silu_f(g1[2]) * u1[2], silu_f(g1[3]) * u1[3]);
                *(u32x4*)rowp = w; }
    }
};
struct EpiResGate {
    static constexpr bool PERM = false, AFTER_DRAIN = false;
    const float* xin32; const bf16_t* xsin; bf16_t* xs; int ldc; const float* gate; int gpitch;
    __device__ __forceinline__ void operator()(const f32x4 (&acc)[2][2][4][2], const Unit& u, int wr, int wc, int fr, int fq) const {
        typedef unsigned u32x2 __attribute__((ext_vector_type(2)));
        const int row0 = u.pm * BM + wr * 64 + fr, col0 = u.pn * BM + wc * 32 + 4 * fq;
        const float* gp = gate + (size_t)(u.pm >> 3) * gpitch + col0;
        f32x4 gv[2][2];
#pragma unroll
        for (int bj = 0; bj < 2; ++bj)
#pragma unroll
            for (int n = 0; n < 2; ++n) gv[bj][n] = *(const f32x4*)(gp + bj * HALF + n * 16);
#pragma unroll
        for (int ai = 0; ai < 2; ++ai)
#pragma unroll
            for (int m = 0; m < 4; ++m) { const size_t off = (size_t)(row0 + ai * HALF + m * 16) * ldc + col0;
#pragma unroll
                for (int bj = 0; bj < 2; ++bj)
#pragma unroll
                    for (int n = 0; n < 2; ++n) { f32x4 xi;
                        if (xin32) xi = *(const f32x4*)(xin32 + off + bj * HALF + n * 16);
                        else { const u32x2 w = *(const u32x2*)(xsin + off + bj * HALF + n * 16); xi = (f32x4){__uint_as_float(w.x << 16), __uint_as_float(w.x & 0xffff0000u), __uint_as_float(w.y << 16), __uint_as_float(w.y & 0xffff0000u)}; }
                        const f32x4 xo = xi + gv[bj][n] * acc[ai][bj][m][n];
                        u32x2 o; o.x = cvt_pk(xo[0], xo[1]); o.y = cvt_pk(xo[2], xo[3]); *(u32x2*)(xs + off + bj * HALF + n * 16) = o; }
                if (m == 3) asm volatile("" ::: "memory"); }
    }
};

template <class Epi, class Sched, bool ALIGN_EPI = false, bool SP2 = false>
__device__ __forceinline__ void gemm_phase(PG8_LAS unsigned char* lds, const Gemm g, const Sched& S, const Epi& E, const int wid_in) {
    const int wid = wid_in, lane = lane_id_opq(), tid = wid * 64 + lane, wr = wid >> 2, wc = wid & 3, fr = lane & 15, fq = lane >> 4;
    const int K = g.K, nt = K / BK;
    unsigned voffA[2], voffB[2];
#pragma unroll
    for (int i = 0; i < 2; ++i) { int R, C; stage_rc(tid * 16 + i * 8192, R, C); const int Rb = Epi::PERM ? ((R & ~31) + perm32(R & 31)) : R;
        voffA[i] = (unsigned)(R * K + C) * 2u; voffB[i] = (unsigned)(Rb * K + C) * 2u; }
    const size_t kstep = (size_t)(BK * 2);
    const size_t hstep = (size_t)HALF * K * 2;
    const size_t tstep = 2 * hstep;
    const unsigned ldsw = (unsigned)wid * 1024u;
    const int aoff = lds_byte(wr * 64 + fr, fq * 8), boff = lds_byte(wc * 32 + fr, fq * 8);
#define PG8_SA(b, h) (((b) * 2 + (h)) * HTB)
#define PG8_SB(b, h) ((4 + (b) * 2 + (h)) * HTB)
#define PG8_STAGE(bufoff, gbase, voff) do { _Pragma("unroll") for (int _i = 0; _i < 2; ++_i) \
        __builtin_amdgcn_global_load_lds((const unsigned*)((const char*)(gbase) + (voff)[_i]), (PG8_LAS unsigned*)(lds + (bufoff) + ldsw + _i * 8192), 16, 0, 0); } while (0)
#define PG8_LDA(dst, b, h) do { _Pragma("unroll") for (int m = 0; m < 4; ++m) _Pragma("unroll") for (int k = 0; k < 2; ++k) dst[m][k] = *(const PG8_LAS bf16x8*)(lds + PG8_SA(b, h) + aoff + m * 2048 + k * 1024); } while (0)
#define PG8_LDB(dst, b, h) do { _Pragma("unroll") for (int n = 0; n < 2; ++n) _Pragma("unroll") for (int k = 0; k < 2; ++k) dst[n][k] = *(const PG8_LAS bf16x8*)(lds + PG8_SB(b, h) + boff + n * 2048 + k * 1024); } while (0)
#define PG8_MMA(ai, bj, At, Bt) do { __builtin_amdgcn_s_setprio(1); _Pragma("unroll") for (int m = 0; m < 4; ++m) _Pragma("unroll") for (int n = 0; n < 2; ++n) _Pragma("unroll") for (int k = 0; k < 2; ++k) \
        acc[ai][bj][m][n] = __builtin_amdgcn_mfma_f32_16x16x32_bf16(Bt[n][k], At[m][k], acc[ai][bj][m][n], 0, 0, 0); __builtin_amdgcn_s_setprio(0); } while (0)
#define PG8_WAIT_V(n) asm volatile("s_waitcnt vmcnt(" #n ")" ::: "memory")
#define PG8_WAIT_L(n) asm volatile("s_waitcnt lgkmcnt(" #n ")" ::: "memory")
#define PG8_BAR __builtin_amdgcn_s_barrier()
#define PG8_SCHED __builtin_amdgcn_sched_barrier(0)
    Unit cur, nxt; int ui = 0;
    if (!S.next(0, cur)) return;
    f32x4 acc[2][2][4][2];
#pragma unroll
    for (int a = 0; a < 2; ++a)
#pragma unroll
        for (int b = 0; b < 2; ++b)
#pragma unroll
            for (int m = 0; m < 4; ++m)
#pragma unroll
                for (int n = 0; n < 2; ++n) acc[a][b][m][n] = (f32x4){0.f, 0.f, 0.f, 0.f};
    bf16x8 At[4][2], B0[2][2], B1[2][2];
    const char* cA = (const char*)g.A + (size_t)cur.pm * tstep; const char* cB = (const char*)g.Bt + (size_t)cur.pn * tstep;
    S.a_ready(cur);
    if constexpr (SP2) {
        PG8_STAGE(PG8_SB(0, 0), cB, voffB); PG8_STAGE(PG8_SB(0, 1), cB + hstep, voffB); PG8_STAGE(PG8_SA(0, 0), cA, voffA); PG8_STAGE(PG8_SA(0, 1), cA + hstep, voffA);
        if (wr == 1) PG8_BAR;
        PG8_WAIT_V(2); PG8_BAR;
        PG8_STAGE(PG8_SB(1, 0), cB + kstep, voffB); PG8_STAGE(PG8_SA(1, 0), cA + kstep, voffA); PG8_STAGE(PG8_SB(1, 1), cB + hstep + kstep, voffB);
        PG8_WAIT_V(6); PG8_BAR;
    } else {
        PG8_STAGE(PG8_SB(0, 0), cB, voffB); PG8_STAGE(PG8_SA(0, 0), cA, voffA); PG8_STAGE(PG8_SB(0, 1), cB + hstep, voffB); PG8_STAGE(PG8_SA(0, 1), cA + hstep, voffA);
        if (wr == 1) PG8_BAR;
        PG8_WAIT_V(4); PG8_BAR;
        PG8_STAGE(PG8_SB(1, 0), cB + kstep, voffB); PG8_STAGE(PG8_SA(1, 0), cA + kstep, voffA); PG8_STAGE(PG8_SB(1, 1), cB + hstep + kstep, voffB);
        PG8_WAIT_V(6); PG8_BAR;
    }
    for (;;) {
        const bool has_next = S.next(ui + 1, nxt);
        const char* nA = has_next ? (const char*)g.A + (size_t)nxt.pm * tstep : cA; const char* nB = has_next ? (const char*)g.Bt + (size_t)nxt.pn * tstep : cB;
        for (int t = 0; t < nt; t += 2) {
            const bool last = (t == nt - 2);
            const char* a1 = cA + (size_t)(t + 1) * kstep;
            const char* a2 = last ? nA : cA + (size_t)(t + 2) * kstep; const char* b2 = last ? nB : cB + (size_t)(t + 2) * kstep;
            const char* a3 = a2 + kstep; const char* b3 = b2 + kstep;
            if (last && has_next) S.a_ready(nxt);
            if constexpr (SP2) {
            PG8_LDB(B0, 0, 0); PG8_LDB(B1, 0, 1); PG8_SCHED; PG8_LDA(At, 0, 0); PG8_STAGE(PG8_SA(1, 1), a1 + hstep, voffA);
            PG8_WAIT_V(8); PG8_WAIT_L(0); PG8_BAR; PG8_MMA(0, 0, At, B0); PG8_MMA(0, 1, At, B1); PG8_BAR; PG8_SCHED;
            PG8_LDA(At, 0, 1); PG8_STAGE(PG8_SB(0, 0), b2, voffB); PG8_STAGE(PG8_SB(0, 1), b2 + hstep, voffB); PG8_STAGE(PG8_SA(0, 0), a2, voffA);
            PG8_WAIT_V(8); PG8_WAIT_L(0); PG8_BAR; PG8_MMA(1, 0, At, B0); PG8_MMA(1, 1, At, B1); PG8_BAR; PG8_SCHED;
            PG8_LDB(B0, 1, 0); PG8_LDB(B1, 1, 1); PG8_SCHED; PG8_LDA(At, 1, 0); PG8_STAGE(PG8_SA(0, 1), a2 + hstep, voffA);
            PG8_WAIT_V(8); PG8_WAIT_L(0); PG8_BAR; PG8_MMA(0, 0, At, B0); PG8_MMA(0, 1, At, B1); PG8_BAR; PG8_SCHED;
            PG8_LDA(At, 1, 1); PG8_STAGE(PG8_SB(1, 0), b3, voffB); PG8_STAGE(PG8_SB(1, 1), b3 + hstep, voffB); PG8_STAGE(PG8_SA(1, 0), a3, voffA);
            PG8_WAIT_V(8); PG8_WAIT_L(0); PG8_BAR; PG8_MMA(1, 0, At, B0); PG8_MMA(1, 1, At, B1); PG8_BAR; PG8_SCHED;
            } else {
            PG8_LDB(B0, 0, 0); PG8_SCHED; PG8_LDA(At, 0, 0); PG8_STAGE(PG8_SA(1, 1), a1 + hstep, voffA);
            PG8_WAIT_L(8); PG8_BAR; PG8_WAIT_L(0); PG8_MMA(0, 0, At, B0); PG8_BAR; PG8_SCHED;
            PG8_LDB(B1, 0, 1); PG8_STAGE(PG8_SB(0, 0), b2, voffB);
            PG8_BAR; PG8_WAIT_L(0); PG8_MMA(0, 1, At, B1); PG8_BAR;
            PG8_LDA(At, 0, 1); PG8_STAGE(PG8_SA(0, 0), a2, voffA);
            PG8_BAR; PG8_WAIT_L(0); PG8_MMA(1, 0, At, B0); PG8_BAR; PG8_SCHED;
            PG8_STAGE(PG8_SB(0, 1), b2 + hstep, voffB);
            PG8_WAIT_V(6); PG8_BAR; PG8_MMA(1, 1, At, B1); PG8_BAR;
            PG8_LDB(B0, 1, 0); PG8_SCHED; PG8_LDA(At, 1, 0); PG8_STAGE(PG8_SA(0, 1), a2 + hstep, voffA);
            PG8_WAIT_L(8); PG8_BAR; PG8_WAIT_L(0); PG8_MMA(0, 0, At, B0); PG8_BAR; PG8_SCHED;
            PG8_LDB(B1, 1, 1); PG8_STAGE(PG8_SB(1, 0), b3, voffB);
            PG8_BAR; PG8_WAIT_L(0); PG8_MMA(0, 1, At, B1); PG8_BAR;
            PG8_LDA(At, 1, 1); PG8_STAGE(PG8_SA(1, 0), a3, voffA);
            PG8_BAR; PG8_WAIT_L(0); PG8_MMA(1, 0, At, B0); PG8_BAR; PG8_SCHED;
            PG8_STAGE(PG8_SB(1, 1), b3 + hstep, voffB);
            PG8_WAIT_V(6); PG8_BAR; PG8_MMA(1, 1, At, B1); PG8_BAR;
            }
        }
        if constexpr (ALIGN_EPI) { if (wr == 0) PG8_BAR; }
        if constexpr (!Epi::AFTER_DRAIN) { E(acc, cur, wr, wc, fr, fq); S.done(cur); }
        if (!has_next) break;
#pragma unroll
        for (int a = 0; a < 2; ++a)
#pragma unroll
            for (int b = 0; b < 2; ++b)
#pragma unroll
                for (int m = 0; m < 4; ++m)
#pragma unroll
                    for (int n = 0; n < 2; ++n) acc[a][b][m][n] = (f32x4){0.f, 0.f, 0.f, 0.f};
        cur = nxt; cA = nA; cB = nB; ++ui;
        if constexpr (ALIGN_EPI) { if (wr == 1) PG8_BAR; }
    }
    PG8_WAIT_V(0);
    if constexpr (!ALIGN_EPI) { if (wr == 0) PG8_BAR; }
    PG8_BAR;
    if constexpr (Epi::AFTER_DRAIN) { E.fused(acc, cur, wr, wc, fr, fq, lds, wid, lane); S.done(cur); }
#undef PG8_SA
#undef PG8_SB
#undef PG8_STAGE
#undef PG8_LDA
#undef PG8_LDB
#undef PG8_MMA
#undef PG8_WAIT_V
#undef PG8_WAIT_L
#undef PG8_BAR
#undef PG8_SCHED
}
}

#ifndef MK_PER_PHASE
#define MK_PER_PHASE 0
#endif
constexpr int NWAVES = 8;
constexpr int DM = 1024, NB = 32, SEQ = 2048, NL = 4, MT = NB * SEQ;
constexpr int D_IN = 3976, NPI = 4096, DFF = 2816, NF1 = 2 * DFF;
constexpr int RW_B = 1024, ML_B = 2432;
constexpr int RWKV_IN = 1408;
constexpr float RMS_EPS = 1e-6f, GN_EPS = 1e-5f;
constexpr int MODP = 6 * DM;
constexpr size_t MiB = 1u << 20;
constexpr size_t WS_CTL = 0, CTL_ZERO_BYTES = 1 * MiB;
constexpr size_t WS_HS = 116 * MiB;
constexpr int CW_FLAG = 16384;
constexpr size_t WS_WL = 5 * MiB;
constexpr size_t WS_MOD = 1 * MiB;
constexpr size_t WS_WIN = 8 * MiB, WS_WOUT = 40 * MiB, WS_WF1 = 48 * MiB, WS_WF2 = 92 * MiB;
constexpr size_t WS_H = 128 * MiB;
constexpr size_t WS_PROJ = 256 * MiB;
constexpr size_t WS_XFIN = (256 + 352) * MiB;
constexpr size_t WS_DEC = 768 * MiB, WS_AA = 864 * MiB, WS_GG = 912 * MiB;
constexpr size_t WS_END = 960 * MiB;
constexpr int CW_BAR = 4096;
constexpr int N_PHASES = 2 + 8 * NL;
static_assert((CW_BAR + (MK_PER_PHASE ? 1 : 1) * 3456) * 4 <= (int)CTL_ZERO_BYTES, "ctl");
constexpr int RING_BYTES = 131072, LDS_BYTES = 163840, LDSCTL_OFF = LDS_BYTES - 1024, MISC_OFF = LDSCTL_OFF + 320;

#define GAS __attribute__((address_space(1)))
#define LAS __attribute__((address_space(3)))
typedef unsigned short bf16;
typedef unsigned v4u __attribute__((ext_vector_type(4)));
typedef unsigned v2u __attribute__((ext_vector_type(2)));
typedef float f32x4 __attribute__((ext_vector_type(4)));
#define LDS_WAIT() asm volatile("s_waitcnt lgkmcnt(0)" ::: "memory")
typedef float f32x2c __attribute__((ext_vector_type(2)));
typedef __bf16 bf16x2c __attribute__((ext_vector_type(2)));
__device__ __forceinline__ unsigned f2bf(float f) { return (__builtin_bit_cast(unsigned, f) + 0x8000u) >> 16; }
__device__ __forceinline__ unsigned pk2(float lo, float hi) { return __builtin_amdgcn_perm(__builtin_bit_cast(unsigned, hi) + 0x8000u, __builtin_bit_cast(unsigned, lo) + 0x8000u, 0x07060302u); }
__device__ __forceinline__ float bf2f(bf16 v) { return __uint_as_float(((unsigned)v) << 16); }
template <int CTRL, int ROWMASK> __device__ __forceinline__ float dppf(float v) { return __builtin_bit_cast(float, __builtin_amdgcn_update_dpp(0, __builtin_bit_cast(int, v), CTRL, ROWMASK, 0xf, false)); }
__device__ __forceinline__ float sum16(float v) { v += dppf<0xB1, 0xf>(v); v += dppf<0x4E, 0xf>(v); v += dppf<0x141, 0xf>(v); v += dppf<0x140, 0xf>(v); return v; }
__device__ __forceinline__ float wave_sum(float v) { v = sum16(v); v += dppf<0x142, 0xa>(v); v += dppf<0x143, 0xc>(v); return __builtin_bit_cast(float, __builtin_amdgcn_readlane(__builtin_bit_cast(int, v), 63)); }
template <int CTRL, int ROWMASK> __device__ __forceinline__ float dppo(float v, float old) { return __builtin_bit_cast(float, __builtin_amdgcn_update_dpp(__builtin_bit_cast(int, old), __builtin_bit_cast(int, v), CTRL, ROWMASK, 0xf, false)); }
__device__ __forceinline__ float wave_prefix_sum(float v) { v += dppo<0x111, 0xf>(v, 0.f); v += dppo<0x112, 0xf>(v, 0.f); v += dppo<0x114, 0xf>(v, 0.f); v += dppo<0x118, 0xf>(v, 0.f); v += dppo<0x142, 0xa>(v, 0.f); v += dppo<0x143, 0xc>(v, 0.f); return v; }
__device__ __forceinline__ float wave_prefix_max(float v) { const float ni = -__builtin_inff(); v = fmaxf(v, dppo<0x111, 0xf>(v, ni)); v = fmaxf(v, dppo<0x112, 0xf>(v, ni)); v = fmaxf(v, dppo<0x114, 0xf>(v, ni)); v = fmaxf(v, dppo<0x118, 0xf>(v, ni));
    v = fmaxf(v, dppo<0x142, 0xa>(v, ni)); v = fmaxf(v, dppo<0x143, 0xc>(v, ni)); return v; }
__device__ __forceinline__ float flogsigmoid(float x) { return fminf(x, 0.f) - __logf(1.0f + __expf(-fabsf(x))); }
__device__ __forceinline__ float fexp(float x) { return __expf(x); }
__device__ __forceinline__ float fsigmoid(float x) { return __builtin_amdgcn_rcpf(1.0f + __expf(-x)); }
__device__ __forceinline__ float sigmoid_f(float x) { return 1.0f / (1.0f + expf(-x)); }
__device__ __forceinline__ float logsigmoid_f(float x) { return fminf(x, 0.f) - log1pf(expf(-fabsf(x))); }
template <class T> __device__ __forceinline__ T* opq(T* p) { asm volatile("" : "+s"(p)); return p; }

#define XB_TMO      128
#define XB_XCNT(j)  (256  + 64 * (j))
#define XB_XSUB(j)  (1280 + 64 * (j))
#define XB_XGEN(j)  (2304 + 64 * (j))
#define XB_TOP      3328
#define XB_TOPGEN   3392
#define XCD_BAR_WORDS 3456
#define XB_SPIN_CAP (1u << 22)

__device__ __forceinline__ unsigned xb_ld(unsigned* p)              { return __hip_atomic_load(p, __ATOMIC_RELAXED, __HIP_MEMORY_SCOPE_AGENT); }
__device__ __forceinline__ unsigned xb_add(unsigned* p, unsigned v) { return __hip_atomic_fetch_add(p, v, __ATOMIC_RELAXED, __HIP_MEMORY_SCOPE_AGENT); }
__device__ __forceinline__ unsigned xb_xcc_id() { return (unsigned)__builtin_amdgcn_s_getreg((3 << 11) | 20) & 0xFu; }
#define XB_SPIN(cond, bar) do { unsigned _sp = 0; while (cond) { __builtin_amdgcn_s_sleep(1); \
    if ((++_sp & 255u) == 0u) { if (xb_ld(&(bar)[XB_TMO])) break; if (_sp > XB_SPIN_CAP) { atomicAdd(&(bar)[XB_TMO], 1u); break; } } } } while (0)

struct XcdBarrier {
    unsigned* bar; unsigned x; unsigned w0;
    volatile LAS unsigned* st;
};

__device__ __forceinline__ XcdBarrier xcd_barrier_post(unsigned* bar, volatile LAS unsigned* st) {
    XcdBarrier b; b.bar = bar; b.x = xb_xcc_id(); b.st = st; b.w0 = (__builtin_amdgcn_readfirstlane((int)threadIdx.x >> 6) == 0) ? 1u : 0u;
    if (threadIdx.x == 0) (void)xb_add(&bar[XB_XCNT(b.x)], 1u);
    return b;
}
__device__ __forceinline__ void xcd_barrier_complete(unsigned* bar, unsigned x, unsigned& nloc, unsigned& nx) {
    const unsigned G = gridDim.x * gridDim.y * gridDim.z;
    unsigned sum, cnt, mine, sp = 0u;
    for (;;) {
        sum = 0u; cnt = 0u; mine = 0u;
#pragma unroll
        for (unsigned j = 0; j < 16; ++j) { const unsigned c = xb_ld(&bar[XB_XCNT(j)]); sum += c; cnt += (c > 0u) ? 1u : 0u; mine = (j == x) ? c : mine; }
        if (sum == G) break;
        __builtin_amdgcn_s_sleep(1);
        if ((++sp & 255u) == 0u) { if (xb_ld(&bar[XB_TMO])) break; if (sp > XB_SPIN_CAP) { atomicAdd(&bar[XB_TMO], 1u); break; } }
    }
    nloc = mine > 0u ? mine : 1u; nx = cnt > 0u ? cnt : 1u;
}

__device__ __forceinline__ void xcd_barrier(const XcdBarrier& b) {
    asm volatile("s_waitcnt vmcnt(0)" ::: "memory");
    __syncthreads();
    if (b.w0 != 0u && lane_id_opq() == 0) {
        unsigned* bar = b.bar;
        __builtin_amdgcn_s_waitcnt(0);
        unsigned nloc = b.st[0], nx = b.st[1];
        if (nloc == 0u) { xcd_barrier_complete(bar, b.x, nloc, nx); b.st[0] = nloc; b.st[1] = nx; }
        const unsigned old = xb_add(&bar[XB_XSUB(b.x)], 1u);
        const unsigned gen = old / nloc;
        if (old + 1u == (gen + 1u) * nloc) {
            __builtin_amdgcn_fence(__ATOMIC_RELEASE, "agent");
            asm volatile("s_waitcnt vmcnt(0)" ::: "memory");
            const unsigned og = xb_add(&bar[XB_TOP], 1u);
            const unsigned tg = og / nx;
            if (og + 1u == (tg + 1u) * nx) xb_add(&bar[XB_TOPGEN], 1u);
            else XB_SPIN(xb_ld(&bar[XB_TOPGEN]) == tg, bar);
            __builtin_amdgcn_fence(__ATOMIC_ACQUIRE, "agent");
            xb_add(&bar[XB_XGEN(b.x)], 1u);
            asm volatile("s_waitcnt vmcnt(0)" ::: "memory");
        } else {
            XB_SPIN(xb_ld(&bar[XB_XGEN(b.x)]) == gen, bar);
            __builtin_amdgcn_fence(__ATOMIC_ACQUIRE, "agent");
            asm volatile("s_waitcnt vmcnt(0)" ::: "memory");
        }
    }
    __syncthreads();
}


__device__ __forceinline__ void b32_gemv(const float* Wcol  , bool ok, int N, LAS float* vT, float (&res)[4], int wave, int lane) {
    float acc[32];
#pragma unroll
    for (int b = 0; b < 32; ++b) acc[b] = 0.f;
    const float* wp = Wcol + (size_t)(128 * wave) * N; const LAS float* vp = vT + 128 * wave * 32;
#pragma unroll 1
    for (int kk = 0; kk < 128; kk += 8) {
        float w[8];
#pragma unroll
        for (int u = 0; u < 8; ++u) w[u] = ok ? wp[(size_t)u * N] : 0.f;
        wp += (size_t)8 * N;
#pragma unroll
        for (int u = 0; u < 8; ++u) {
#pragma unroll
            for (int b4 = 0; b4 < 8; ++b4) { const f32x4 cv = *(const LAS f32x4*)(vp + u * 32 + 4 * b4);
                acc[4 * b4] += cv.x * w[u]; acc[4 * b4 + 1] += cv.y * w[u]; acc[4 * b4 + 2] += cv.z * w[u]; acc[4 * b4 + 3] += cv.w * w[u]; }
            asm volatile("" ::: "memory"); }
        vp += 8 * 32;
    }
    __syncthreads();
#pragma unroll
    for (int b = 0; b < 32; ++b) vT[(wave * 32 + b) * 64 + lane] = acc[b];
    __syncthreads();
#pragma unroll
    for (int q = 0; q < 4; ++q) { float s = 0.f;
#pragma unroll
        for (int w2 = 0; w2 < 8; ++w2) s += vT[(w2 * 32 + 4 * wave + q) * 64 + lane];
        res[q] = s; }
    __syncthreads();
}
__device__ __forceinline__ void p0_mod(const float* c, const float* ada_w, const float* ada_b, float* mod, LAS unsigned char* lds, int tid, int lane, int wave) {
    LAS float* condT = (LAS float*)lds;
    for (int item = blockIdx.x; item < NL * 96; item += gridDim.x) {
        __syncthreads();
        for (int e = tid; e < NB * DM; e += NWAVES * 64) { const int k = e >> 5, b = e & 31; const float v = c[b * DM + k]; condT[e] = v / (1.0f + expf(-v)); }
        __syncthreads();
        const int l = item / 96, g = item % 96, n = g * 64 + lane;
        float res[4]; b32_gemv(ada_w + (size_t)l * DM * MODP + n, true, MODP, condT, res, wave, lane);
        const float bb = ada_b[l * MODP + n]; float* o = mod + ((size_t)l * NB + wave * 4) * MODP + n;
        o[0] = res[0] + bb; o[MODP] = res[1] + bb; o[2 * MODP] = res[2] + bb; o[3 * MODP] = res[3] + bb;
    }
    __syncthreads();
}
template <int MODE>
__device__ __forceinline__ void transpose_item(const float* W, int K, int N, int nblk, bf16* WT, int ldw, LAS float* scr, int item, int lane) {
    const int kb = item / nblk, nb = item % nblk, k0 = 64 * kb, n0 = 32 * nb;
    const int nq = lane & 7, nn = n0 + 4 * nq; const bool ok = nn < N;
#pragma unroll
    for (int i = 0; i < 8; ++i) { const int kk = 8 * i + (lane >> 3); f32x4 v = (f32x4){0.f, 0.f, 0.f, 0.f}; if (ok) v = *(const f32x4*)(W + (size_t)(k0 + kk) * N + nn);
        LAS float* d = scr + kk * 33 + 4 * nq; d[0] = v.x; d[1] = v.y; d[2] = v.z; d[3] = v.w; }
    LDS_WAIT();
    const int c = lane & 7;
#pragma unroll
    for (int j = 0; j < 4; ++j) { const int n = (lane >> 3) + 8 * j; const LAS float* s = scr + (8 * c) * 33 + n;
        v4u o; o.x = pk2(s[0 * 33], s[1 * 33]); o.y = pk2(s[2 * 33], s[3 * 33]); o.z = pk2(s[4 * 33], s[5 * 33]); o.w = pk2(s[6 * 33], s[7 * 33]);
        int row = n0 + n;
        if (MODE == 1) { const int up = row >= DFF ? 1 : 0, jj = row - up * DFF; row = (jj >> 7) * 256 + up * 128 + (jj & 127); }
        *(v4u*)(WT + (size_t)row * ldw + k0 + 8 * c) = o; }
    LDS_WAIT();
}
__device__ __forceinline__ void p0_weights(const float* w_in, const float* w_out, const float* f1, const float* f2, const float* lw2, const float* la2, const float* lg2, unsigned char* ws, LAS unsigned char* lds, int gw, int ngw, int wave, int lane) {
    LAS float* scr = (LAS float*)(lds + wave * 16384);
    constexpr int I_IN = (DM / 64) * (NPI / 32), I_OUT = (DM / 64) * (DM / 32), I_F1 = (DM / 64) * (NF1 / 32), I_F2 = (DFF / 64) * (DM / 32), I_L = I_IN + I_OUT + I_F1 + I_F2 + 48;
    for (int it = gw; it < NL * I_L; it += ngw) {
        const int l = it / I_L; int r = it % I_L;
        if (r < I_IN) { transpose_item<0>(w_in + (size_t)l * DM * D_IN, DM, D_IN, NPI / 32, (bf16*)(ws + WS_WIN) + (size_t)l * NPI * DM, DM, scr, r, lane); continue; } r -= I_IN;
        if (r < I_OUT) { transpose_item<0>(w_out + (size_t)l * DM * DM, DM, DM, DM / 32, (bf16*)(ws + WS_WOUT) + (size_t)l * DM * DM, DM, scr, r, lane); continue; } r -= I_OUT;
        if (r < I_F1) { transpose_item<1>(f1 + (size_t)l * DM * NF1, DM, NF1, NF1 / 32, (bf16*)(ws + WS_WF1) + (size_t)l * NF1 * DM, DM, scr, r, lane); continue; } r -= I_F1;
        if (r < I_F2) { transpose_item<0>(f2 + (size_t)l * DFF * DM, DFF, DM, DM / 32, (bf16*)(ws + WS_WF2) + (size_t)l * DM * DFF, DFF, scr, r, lane); continue; } r -= I_F2;
        bf16* wl = (bf16*)(ws + WS_WL) + (size_t)l * 384 * 256;
        if (r < 12) { transpose_item<0>(lw2 + (size_t)l * 64 * 384, 64, 384, 12, wl, 256, scr, r, lane); continue; } r -= 12;
        if (r < 12) { transpose_item<0>(la2 + (size_t)l * 64 * 384, 64, 384, 12, wl + 64, 256, scr, r, lane); continue; } r -= 12;
        transpose_item<0>(lg2 + (size_t)l * 128 * 384, 128, 384, 12, wl + 128, 256, scr, r, lane);
    }
}
__device__ __forceinline__ void norm_mod_phase(const float* xin32, const bf16* xs, const float* gain, const float* modl, int sh_off, int sc_off, bf16* out, int gw, int ngw, int lane) {
    for (int ci = gw; ci < MT / 32; ci += ngw) {
        const int b = ci >> 6; const float* mb = modl + (size_t)b * MODP;
        f32x4 gs[4], sh[4];
#pragma unroll
        for (int j = 0; j < 4; ++j) { const int col = 4 * lane + 256 * j; const f32x4 g = *(const f32x4*)(gain + col), s = *(const f32x4*)(mb + sc_off + col); gs[j] = g * (s + 1.0f); sh[j] = *(const f32x4*)(mb + sh_off + col); }
        for (int r = 0; r < 32; ++r) {
            const size_t row = (size_t)ci * 32 + r;
            f32x4 v[4]; float ss = 0.f;
            if (xin32) { const f32x4* xr = (const f32x4*)(xin32 + row * DM) + lane;
#pragma unroll
                for (int j = 0; j < 4; ++j) v[j] = xr[64 * j];
            } else { const v2u* xr = (const v2u*)(xs + row * DM) + lane;
#pragma unroll
                for (int j = 0; j < 4; ++j) { const v2u w = xr[64 * j]; v[j] = (f32x4){__uint_as_float(w.x << 16), __uint_as_float(w.x & 0xffff0000u), __uint_as_float(w.y << 16), __uint_as_float(w.y & 0xffff0000u)}; } }
#pragma unroll
            for (int j = 0; j < 4; ++j) ss += (v[j].x * v[j].x + v[j].y * v[j].y) + (v[j].z * v[j].z + v[j].w * v[j].w);
            const float rstd = 1.0f / sqrtf(wave_sum(ss) * (1.0f / DM) + RMS_EPS);
            v2u* o8 = (v2u*)(out + row * DM) + lane;
#pragma unroll
            for (int j = 0; j < 4; ++j) { const f32x4 y = v[j] * rstd * gs[j] + sh[j]; v2u w; w.x = pk2(y.x, y.y); w.y = pk2(y.z, y.w); o8[64 * j] = w; }
        }
    }
}
__device__ __forceinline__ void final_norm_phase(const bf16* xs, float* out, const float* gain, int gw, int ngw, int lane) {
    f32x4 g[4];
#pragma unroll
    for (int j = 0; j < 4; ++j) g[j] = *(const f32x4*)(gain + 4 * lane + 256 * j);
    for (int row = gw; row < MT; row += ngw) {
        const v2u* xr = (const v2u*)(xs + (size_t)row * DM) + lane; f32x4 v[4]; float ss = 0.f;
#pragma unroll
        for (int j = 0; j < 4; ++j) { const v2u w = xr[64 * j]; v[j] = (f32x4){__uint_as_float(w.x << 16), __uint_as_float(w.x & 0xffff0000u), __uint_as_float(w.y << 16), __uint_as_float(w.y & 0xffff0000u)};
            ss += (v[j].x * v[j].x + v[j].y * v[j].y) + (v[j].z * v[j].z + v[j].w * v[j].w); }
        const float rstd = 1.0f / sqrtf(wave_sum(ss) * (1.0f / DM) + RMS_EPS);
        f32x4* o = (f32x4*)(out + (size_t)row * DM) + lane;
#pragma unroll
        for (int j = 0; j < 4; ++j) o[64 * j] = v[j] * rstd * g[j];
    }
}
#define WG_BAR() do { asm volatile("s_waitcnt vmcnt(0) lgkmcnt(0)" ::: "memory"); __builtin_amdgcn_s_barrier(); asm volatile("" ::: "memory"); } while (0)
#define WG_BAR_L() do { asm volatile("s_waitcnt lgkmcnt(0)" ::: "memory"); __builtin_amdgcn_s_barrier(); asm volatile("" ::: "memory"); } while (0)
typedef short bf16x8p __attribute__((ext_vector_type(8)));
__device__ __forceinline__ void rwkv_prep_mfma(const bf16* proj, const float* mu, const float* w0, const float* a0, const bf16* WL, float* DEC, bf16* AA, bf16* GG, LAS unsigned char* lds, int wave) {
    constexpr int AP = 264;
    LAS bf16* act = (LAS bf16*)lds;
#pragma unroll 1
    for (int item = blockIdx.x; item < MT / 64; item += gridDim.x) {
        const int lane = lane_id_opq(), tid = wave * 64 + lane, q4 = lane >> 4, lc = lane & 15;
        const size_t m0 = (size_t)item * 64; const int t0 = (int)(m0 % SEQ);
        { const int tt = tid >> 3, cg = tid & 7; const bf16* p = proj + (m0 + tt) * NPI + RW_B + 1152 + 32 * cg; const bool hp = (t0 + tt) > 0; const float* mup = mu + 1152 + 32 * cg;
#pragma unroll
          for (int v = 0; v < 4; ++v) { const v4u cur = *(const v4u*)(p + 8 * v); v4u prv = (v4u){0u, 0u, 0u, 0u}; if (hp) prv = *(const v4u*)(p - NPI + 8 * v);
              const f32x4 m0v = *(const f32x4*)(mup + 8 * v), m1v = *(const f32x4*)(mup + 8 * v + 4);
              float x[8];
#pragma unroll
              for (int e = 0; e < 4; ++e) { const unsigned cw = cur[e], pw = prv[e]; const float c0 = __uint_as_float(cw << 16), c1 = __uint_as_float(cw & 0xffff0000u), p0 = __uint_as_float(pw << 16), p1 = __uint_as_float(pw & 0xffff0000u);
                  const float mu0 = e < 2 ? m0v[2 * e] : m1v[2 * e - 4], mu1 = e < 2 ? m0v[2 * e + 1] : m1v[2 * e - 3];
                  x[2 * e] = c0 + (p0 - c0) * mu0; x[2 * e + 1] = c1 + (p1 - c1) * mu1; }
              if (cg < 2) {
#pragma unroll
                  for (int e = 0; e < 8; ++e) x[e] = 2.0f * fsigmoid(2.0f * x[e]) - 1.0f;
              } else if (cg >= 4) {
#pragma unroll
                  for (int e = 0; e < 8; ++e) x[e] = fsigmoid(x[e]);
              }
              v4u o; o.x = pk2(x[0], x[1]); o.y = pk2(x[2], x[3]); o.z = pk2(x[4], x[5]); o.w = pk2(x[6], x[7]);
              *(LAS v4u*)(act + tt * AP + 32 * cg + 8 * v) = o; } }
        WG_BAR_L();
        const LAS bf16* afr = act + lc * AP + 8 * q4;
        const bf16* bfr = WL + (size_t)(48 * wave + lc) * 256 + 8 * q4;
        { f32x4 acc[4][3];
#pragma unroll
          for (int mt = 0; mt < 4; ++mt)
#pragma unroll
              for (int nt = 0; nt < 3; ++nt) acc[mt][nt] = (f32x4){0.f, 0.f, 0.f, 0.f};
#pragma unroll
          for (int ks = 0; ks < 2; ++ks) { bf16x8p bq[3];
#pragma unroll
              for (int nt = 0; nt < 3; ++nt) bq[nt] = *(const bf16x8p*)(bfr + 16 * nt * 256 + 32 * ks);
#pragma unroll
              for (int mt = 0; mt < 4; ++mt) { const bf16x8p aq = *(const LAS bf16x8p*)(afr + 16 * mt * AP + 32 * ks);
#pragma unroll
                  for (int nt = 0; nt < 3; ++nt) acc[mt][nt] = __builtin_amdgcn_mfma_f32_16x16x32_bf16(aq, bq[nt], acc[mt][nt], 0, 0, 0); } }
#pragma unroll
          for (int nt = 0; nt < 3; ++nt) { const int n = 48 * wave + 16 * nt + lc; const float w0n = w0[n]; float carry = 0.f;
#pragma unroll
              for (int mt = 0; mt < 4; ++mt) { float pr[4];
#pragma unroll
                  for (int r = 0; r < 4; ++r) { const float ld = -0.60653066f * fsigmoid(w0n + acc[mt][nt][r]); pr[r] = r ? pr[r - 1] + ld : ld; }
                  const float tot = pr[3]; float s1 = tot; { const float u = __shfl_up(s1, 16); if (q4 >= 1) s1 += u; } { const float u = __shfl_up(s1, 32); if (q4 >= 2) s1 += u; }
                  const float excl = carry + (s1 - tot), tile_tot = __shfl(s1, 48 + lc);
                  float* dp = DEC + (m0 + 16 * mt + 4 * q4) * 384 + n;
#pragma unroll
                  for (int r = 0; r < 4; ++r) dp[r * 384] = excl + pr[r];
                  carry += tile_tot; } } }
        { f32x4 acc[4][3];
#pragma unroll
          for (int mt = 0; mt < 4; ++mt)
#pragma unroll
              for (int nt = 0; nt < 3; ++nt) acc[mt][nt] = (f32x4){0.f, 0.f, 0.f, 0.f};
#pragma unroll
          for (int ks = 0; ks < 2; ++ks) { bf16x8p bq[3];
#pragma unroll
              for (int nt = 0; nt < 3; ++nt) bq[nt] = *(const bf16x8p*)(bfr + 16 * nt * 256 + 64 + 32 * ks);
#pragma unroll
              for (int mt = 0; mt < 4; ++mt) { const bf16x8p aq = *(const LAS bf16x8p*)(afr + 16 * mt * AP + 64 + 32 * ks);
#pragma unroll
                  for (int nt = 0; nt < 3; ++nt) acc[mt][nt] = __builtin_amdgcn_mfma_f32_16x16x32_bf16(aq, bq[nt], acc[mt][nt], 0, 0, 0); } }
#pragma unroll
          for (int nt = 0; nt < 3; ++nt) { const int n = 48 * wave + 16 * nt + lc; const float a0n = a0[n];
#pragma unroll
              for (int mt = 0; mt < 4; ++mt) { bf16* dp = AA + (m0 + 16 * mt + 4 * q4) * 384 + n;
#pragma unroll
                  for (int r = 0; r < 4; ++r) dp[r * 384] = (bf16)f2bf(fsigmoid(a0n + acc[mt][nt][r])); } } }
        { f32x4 acc[4][3];
#pragma unroll
          for (int mt = 0; mt < 4; ++mt)
#pragma unroll
              for (int nt = 0; nt < 3; ++nt) acc[mt][nt] = (f32x4){0.f, 0.f, 0.f, 0.f};
#pragma unroll
          for (int ks = 0; ks < 4; ++ks) { bf16x8p bq[3];
#pragma unroll
              for (int nt = 0; nt < 3; ++nt) bq[nt] = *(const bf16x8p*)(bfr + 16 * nt * 256 + 128 + 32 * ks);
#pragma unroll
              for (int mt = 0; mt < 4; ++mt) { const bf16x8p aq = *(const LAS bf16x8p*)(afr + 16 * mt * AP + 128 + 32 * ks);
#pragma unroll
                  for (int nt = 0; nt < 3; ++nt) acc[mt][nt] = __builtin_amdgcn_mfma_f32_16x16x32_bf16(aq, bq[nt], acc[mt][nt], 0, 0, 0); } }
#pragma unroll
          for (int nt = 0; nt < 3; ++nt) { const int n = 48 * wave + 16 * nt + lc;
#pragma unroll
              for (int mt = 0; mt < 4; ++mt) { bf16* dp = GG + (m0 + 16 * mt + 4 * q4) * 384 + n;
#pragma unroll
                  for (int r = 0; r < 4; ++r) dp[r * 384] = (bf16)f2bf(acc[mt][nt][r]); } } }
        WG_BAR_L();
    }
}
typedef short bf16x8_t __attribute__((ext_vector_type(8)));
template <int KS>
__device__ __forceinline__ f32x4 mm_tile(const LAS bf16* A, const LAS bf16* B, f32x4 acc) {
#pragma unroll
    for (int ks = 0; ks < KS; ++ks) {
        const bf16x8_t a = *(const LAS bf16x8_t*)(A + ks * 32), b = *(const LAS bf16x8_t*)(B + ks * 32);
        acc = __builtin_amdgcn_mfma_f32_16x16x32_bf16(a, b, acc, 0, 0, 0);
    }
    return acc;
}
__device__ __forceinline__ unsigned short f2bf16(float f) { return (unsigned short)f2bf(f); }
constexpr int LP = 72;
constexpr int LPM = 104;

__device__ __forceinline__ void ret_unit(int b, int h, const bf16* proj, const float* gn, bf16* mixed, LAS unsigned char* lds, int wave, int lane0) {
    LAS bf16* Qs = (LAS bf16*)lds; LAS bf16* Ks = Qs + 64 * LP; LAS bf16* Kdt = Ks + 64 * LP; LAS bf16* Vt = Kdt + 64 * LP; LAS bf16* Ps = Vt + 64 * LP; LAS bf16* Stt = Ps + 64 * LP; LAS bf16* Gs = Stt + 64 * LP;
    const int lane = lane0, q4 = lane >> 4, lc = lane & 15;
    const float inv = powf(10000.0f, -(float)(2 * (lane & 31)) / 64.0f);
    float cs[8], sn[8];
#pragma unroll
    for (int i = 0; i < 8; ++i) __sincosf((float)(8 * wave + i) * inv, &sn[i], &cs[i]);
    float c64, s64; sincosf(64.0f * inv, &s64, &c64);
    const float lg2 = log2f(1.0f - exp2f(-5.0f - (float)h));
    float kdec[8];
#pragma unroll
    for (int i = 0; i < 8; ++i) kdec[i] = exp2f((float)(63 - (8 * wave + i)) * lg2);
    const float cd = exp2f(64.0f * lg2);
    f32x4 st[4];
#pragma unroll
    for (int i = 0; i < 4; ++i) st[i] = (f32x4){0.f, 0.f, 0.f, 0.f};
    for (int i = wave * 64 + lane; i < 64 * LP / 2; i += 512) ((LAS unsigned*)Stt)[i] = 0u;
    const size_t m0 = (size_t)b * SEQ;
    const bf16* P0 = proj + m0 * NPI + h * 64;
    unsigned short rq[8], rk[8], rv[8], rg[8];
#pragma unroll
    for (int i = 0; i < 8; ++i) { const bf16* p = P0 + (size_t)(8 * wave + i) * NPI; rq[i] = p[lane]; rk[i] = p[256 + lane]; rv[i] = p[512 + lane]; rg[i] = p[768 + lane]; }
    float gain4[4];
#pragma unroll
    for (int ct = 0; ct < 4; ++ct) gain4[ct] = gn[h * 64 + 16 * ct + lc];
#pragma unroll 1
    for (int c = 0; c < SEQ / 64; ++c) {
        const int lane = lane_id_opq(), q4 = lane >> 4, lc = lane & 15, o72 = lc * LP + 8 * q4;
        { unsigned short kd[8];
#pragma unroll
          for (int i = 0; i < 8; ++i) { const int tt = 8 * wave + i;
              const float q = bf2f(rq[i]), k = bf2f(rk[i]); const float qp = __shfl_xor(q, 32), kp = __shfl_xor(k, 32);
              const float qr = lane < 32 ? q * cs[i] - qp * sn[i] : qp * sn[i] + q * cs[i];
              const float kr = (lane < 32 ? k * cs[i] - kp * sn[i] : kp * sn[i] + k * cs[i]) * 0.125f;
              Qs[tt * LP + lane] = f2bf16(qr); Ks[tt * LP + lane] = f2bf16(kr); Gs[tt * LP + lane] = rg[i]; kd[i] = f2bf16(kr * kdec[i]);
              const float cn = cs[i] * c64 - sn[i] * s64, snn = sn[i] * c64 + cs[i] * s64; cs[i] = cn; sn[i] = snn; }
          v4u w; w.x = kd[0] | ((unsigned)kd[1] << 16); w.y = kd[2] | ((unsigned)kd[3] << 16); w.z = kd[4] | ((unsigned)kd[5] << 16); w.w = kd[6] | ((unsigned)kd[7] << 16);
          *(LAS v4u*)(Kdt + lane * LP + 8 * wave) = w;
          w.x = rv[0] | ((unsigned)rv[1] << 16); w.y = rv[2] | ((unsigned)rv[3] << 16); w.z = rv[4] | ((unsigned)rv[5] << 16); w.w = rv[6] | ((unsigned)rv[7] << 16);
          *(LAS v4u*)(Vt + lane * LP + 8 * wave) = w; }
        WG_BAR_L();
        if (c + 1 < SEQ / 64) {
#pragma unroll
            for (int i = 0; i < 8; ++i) { const bf16* p = P0 + (size_t)(64 * (c + 1) + 8 * wave + i) * NPI; rq[i] = p[lane]; rk[i] = p[256 + lane]; rv[i] = p[512 + lane]; rg[i] = p[768 + lane]; } }
        { const int rt = wave >> 1;
#pragma unroll
          for (int u = 0; u < 2; ++u) { const int ct = 2 * (wave & 1) + u;
              f32x4 s = (f32x4){0.f, 0.f, 0.f, 0.f};
              if (ct <= rt) s = mm_tile<2>(Qs + 16 * rt * LP + o72, Ks + 16 * ct * LP + o72, s);
#pragma unroll
              for (int r = 0; r < 4; ++r) { const int l = 16 * rt + 4 * q4 + r, m = 16 * ct + lc; const float val = (l >= m) ? s[r] * __builtin_amdgcn_exp2f((float)(l - m) * lg2) : 0.f; Ps[l * LP + m] = f2bf16(val); } } }
        f32x4 inter[4];
        if (wave < 4) {
#pragma unroll
            for (int ct = 0; ct < 4; ++ct) inter[ct] = mm_tile<2>(Qs + 16 * wave * LP + o72, Stt + 16 * ct * LP + o72, (f32x4){0.f, 0.f, 0.f, 0.f}); }
        WG_BAR_L();
        if (wave < 4) {
            f32x4 y[4];
#pragma unroll
            for (int ct = 0; ct < 4; ++ct) y[ct] = mm_tile<2>(Ps + 16 * wave * LP + o72, Vt + 16 * ct * LP + o72, (f32x4){0.f, 0.f, 0.f, 0.f});
#pragma unroll
            for (int r = 0; r < 4; ++r) { const int l = 16 * wave + 4 * q4 + r; const float qd = __builtin_amdgcn_exp2f((float)(l + 1) * lg2);
                float s = 0.f;
#pragma unroll
                for (int ct = 0; ct < 4; ++ct) { y[ct][r] += qd * inter[ct][r]; s += y[ct][r]; }
                const float mean = sum16(s) * (1.0f / 64.0f); float qv = 0.f;
#pragma unroll
                for (int ct = 0; ct < 4; ++ct) { const float dd = y[ct][r] - mean; qv += dd * dd; }
                const float rstd = __builtin_amdgcn_rsqf(sum16(qv) * (1.0f / 64.0f) + GN_EPS);
                bf16* orow = mixed + (m0 + 64 * c + l) * DM + h * 64 + lc;
#pragma unroll
                for (int ct = 0; ct < 4; ++ct) { const float g = bf2f(Gs[l * LP + 16 * ct + lc]); orow[16 * ct] = f2bf16((y[ct][r] - mean) * rstd * gain4[ct] * (g * fsigmoid(g))); } }
        } else {
            const int dt = wave - 4;
#pragma unroll
            for (int ct = 0; ct < 4; ++ct) { st[ct] = mm_tile<2>(Kdt + 16 * dt * LP + o72, Vt + 16 * ct * LP + o72, st[ct] * cd);
                v2u w; w.x = pk2(st[ct][0], st[ct][1]); w.y = pk2(st[ct][2], st[ct][3]);
                *(LAS v2u*)(Stt + (16 * ct + lc) * LP + 16 * dt + 4 * q4) = w; }
        }
        WG_BAR_L();
    }
}

__device__ __forceinline__ void mlstm_unit(int b, int h, const bf16* proj, const float* conv_w, const float* conv_b, const float* i_b, const float* f_b, const float* gn, bf16* mixed,
                                           LAS unsigned char* lds, int wave, int lane0) {
    LAS bf16* Qs = (LAS bf16*)lds; LAS bf16* Ks = Qs + 64 * LPM; LAS bf16* Kdt = Ks + 64 * LPM; LAS bf16* Vt = Kdt + 96 * LP; LAS bf16* Ps = Vt + 112 * LP; LAS bf16* Stt = Ps + 64 * LP; LAS bf16* Os = Stt + 112 * LPM;
    LAS float* ev = (LAS float*)(Os + 64 * LPM); LAS float* pmv = ev + 64; LAS float* flv = pmv + 64;
    const int lane = lane0, lc = lane & 15;
    float wq0[4], wq1[4], wk0[4], wk1[4], bq0, bq1, bk0, bk1;
    { const int cq0 = h * 96 + lane, cq1 = h * 96 + 64 + (lane & 31), ck0 = 384 + cq0, ck1 = 384 + cq1;
#pragma unroll
    for (int j = 0; j < 4; ++j) { wq0[j] = conv_w[j * 768 + cq0]; wq1[j] = conv_w[j * 768 + cq1]; wk0[j] = conv_w[j * 768 + ck0]; wk1[j] = conv_w[j * 768 + ck1]; }
    bq0 = conv_b[cq0]; bq1 = conv_b[cq1]; bk0 = conv_b[ck0]; bk1 = conv_b[ck1]; }
    const float ib = i_b[h], fb = f_b[h];
    const float ksc = 0.10206207261596577f;
    f32x4 st[11];
#pragma unroll
    for (int i = 0; i < 11; ++i) st[i] = (f32x4){0.f, 0.f, 0.f, 0.f};
    for (int i = wave * 64 + lane; i < 112 * LPM / 2; i += 512) ((LAS unsigned*)Stt)[i] = 0u;
    for (int i = wave * 64 + lane; i < 16 * LP / 2; i += 512) ((LAS unsigned*)(Vt + 96 * LP))[i] = (i < LP / 2) ? 0x3f803f80u : 0u;
    float mprev = 0.f;
    const size_t m0 = (size_t)b * SEQ;
    const bf16* PB = proj + m0 * NPI + ML_B;
    float gain6[6];
#pragma unroll
    for (int ct = 0; ct < 6; ++ct) gain6[ct] = gn[640 + h * 96 + 16 * ct + lc];
    unsigned xq[11], xk[11], vv[8], gg;
#define ML_LOAD(cc) do { const int tb_ = 64 * (cc) + 8 * wave; \
        _Pragma("unroll") for (int i = 0; i < 11; ++i) { const int t_ = tb_ - 3 + i; const bool ok_ = t_ >= 0; const bf16* p_ = PB + (size_t)(ok_ ? t_ : 0) * NPI; \
            const unsigned a0_ = ok_ ? p_[cq0] : 0u, a1_ = (ok_ && has1) ? p_[cq1] : 0u, b0_ = ok_ ? p_[ck0] : 0u, b1_ = (ok_ && has1) ? p_[ck1] : 0u; xq[i] = a0_ | (a1_ << 16); xk[i] = b0_ | (b1_ << 16); } \
        _Pragma("unroll") for (int i = 0; i < 8; ++i) { const bf16* p_ = PB + (size_t)(tb_ + i) * NPI + 768 + h * 96; const unsigned a0_ = p_[d0], a1_ = has1 ? p_[d1] : 0u; vv[i] = a0_ | (a1_ << 16); } \
        { const bf16* p_ = PB + (size_t)(64 * (cc) + lane) * NPI; const unsigned a0_ = p_[1536 + h], a1_ = p_[1540 + h]; gg = a0_ | (a1_ << 16); } } while (0)
    { const int d0 = lane, d1 = 64 + (lane & 31); const bool has1 = lane < 32; const int cq0 = h * 96 + d0, cq1 = h * 96 + d1, ck0 = 384 + cq0, ck1 = 384 + cq1; ML_LOAD(0); }
#pragma unroll 1
    for (int c = 0; c < SEQ / 64; ++c) {
        const int lane = lane_id_opq(), q4 = lane >> 4, lc = lane & 15, o72 = lc * LP + 8 * q4, o104 = lc * LPM + 8 * q4;
        const int d0 = lane, d1 = 64 + (lane & 31); const bool has1 = lane < 32;
        const int cq0 = h * 96 + d0, cq1 = h * 96 + d1, ck0 = 384 + cq0, ck1 = 384 + cq1;
        const int tb = 64 * c + 8 * wave;
        float pm63, carry, ev_l; const float mold = mprev;
        { const float ic = __uint_as_float(gg << 16) + ib, lf = flogsigmoid(__uint_as_float(gg & 0xffff0000u) + fb);
          const float bc = wave_prefix_sum(lf), e = ic - bc; const float pm = fmaxf(wave_prefix_max(e), mprev);
          pm63 = __builtin_bit_cast(float, __builtin_amdgcn_readlane(__builtin_bit_cast(int, pm), 63)); carry = fexp(mprev - pm63); ev_l = e;
          if (wave == 0) { ev[lane] = e; pmv[lane] = pm; flv[lane] = fexp(-(bc + pm)); }
          mprev = __builtin_bit_cast(float, __builtin_amdgcn_readlane(__builtin_bit_cast(int, bc), 63)) + pm63; }
        { unsigned short kd0[8], kd1[8];
#pragma unroll
          for (int i = 0; i < 8; ++i) { const int tt = 8 * wave + i;
#define LO_(w) __uint_as_float((w) << 16)
#define HI_(w) __uint_as_float((w) & 0xffff0000u)
              float q0 = bq0 + LO_(xq[i]) * wq0[0] + LO_(xq[i + 1]) * wq0[1] + LO_(xq[i + 2]) * wq0[2] + LO_(xq[i + 3]) * wq0[3];
              float k0 = bk0 + LO_(xk[i]) * wk0[0] + LO_(xk[i + 1]) * wk0[1] + LO_(xk[i + 2]) * wk0[2] + LO_(xk[i + 3]) * wk0[3];
              float q1 = bq1 + HI_(xq[i]) * wq1[0] + HI_(xq[i + 1]) * wq1[1] + HI_(xq[i + 2]) * wq1[2] + HI_(xq[i + 3]) * wq1[3];
              float k1 = bk1 + HI_(xk[i]) * wk1[0] + HI_(xk[i + 1]) * wk1[1] + HI_(xk[i + 2]) * wk1[2] + HI_(xk[i + 3]) * wk1[3];
#undef LO_
#undef HI_
              q0 = q0 * fsigmoid(q0); k0 = k0 * fsigmoid(k0) * ksc; q1 = q1 * fsigmoid(q1); k1 = k1 * fsigmoid(k1) * ksc;
              const float wsi = fexp(__builtin_bit_cast(float, __builtin_amdgcn_readlane(__builtin_bit_cast(int, ev_l), tt)) - pm63);
              Qs[tt * LPM + d0] = f2bf16(q0); Ks[tt * LPM + d0] = f2bf16(k0); kd0[i] = f2bf16(k0 * wsi); kd1[i] = f2bf16(k1 * wsi);
              if (has1) { Qs[tt * LPM + d1] = f2bf16(q1); Ks[tt * LPM + d1] = f2bf16(k1); } }
          v4u w; w.x = kd0[0] | ((unsigned)kd0[1] << 16); w.y = kd0[2] | ((unsigned)kd0[3] << 16); w.z = kd0[4] | ((unsigned)kd0[5] << 16); w.w = kd0[6] | ((unsigned)kd0[7] << 16);
          *(LAS v4u*)(Kdt + d0 * LP + 8 * wave) = w;
          if (has1) { w.x = kd1[0] | ((unsigned)kd1[1] << 16); w.y = kd1[2] | ((unsigned)kd1[3] << 16); w.z = kd1[4] | ((unsigned)kd1[5] << 16); w.w = kd1[6] | ((unsigned)kd1[7] << 16);
              *(LAS v4u*)(Kdt + d1 * LP + 8 * wave) = w; }
          w.x = (vv[0] & 0xffffu) | (vv[1] << 16); w.y = (vv[2] & 0xffffu) | (vv[3] << 16); w.z = (vv[4] & 0xffffu) | (vv[5] << 16); w.w = (vv[6] & 0xffffu) | (vv[7] << 16);
          *(LAS v4u*)(Vt + d0 * LP + 8 * wave) = w;
          if (has1) { w.x = (vv[0] >> 16) | (vv[1] & 0xffff0000u); w.y = (vv[2] >> 16) | (vv[3] & 0xffff0000u); w.z = (vv[4] >> 16) | (vv[5] & 0xffff0000u); w.w = (vv[6] >> 16) | (vv[7] & 0xffff0000u);
              *(LAS v4u*)(Vt + d1 * LP + 8 * wave) = w; } }
        WG_BAR_L();
        unsigned og[8];
#pragma unroll
        for (int i = 0; i < 8; ++i) { const bf16* p = PB + (size_t)(tb + i) * NPI + 1152 + h * 96; const unsigned a0_ = p[d0], a1_ = has1 ? p[d1] : 0u; og[i] = a0_ | (a1_ << 16); }
        if (c + 1 < SEQ / 64) ML_LOAD(c + 1);
        { const int rt = wave >> 1;
#pragma unroll
          for (int u = 0; u < 2; ++u) { const int ct = 2 * (wave & 1) + u;
              f32x4 s = (f32x4){0.f, 0.f, 0.f, 0.f};
              if (ct <= rt) s = mm_tile<3>(Qs + 16 * rt * LPM + o104, Ks + 16 * ct * LPM + o104, s);
              const float em = ev[16 * ct + lc];
#pragma unroll
              for (int r = 0; r < 4; ++r) { const int l = 16 * rt + 4 * q4 + r, m = 16 * ct + lc; const float val = (l >= m) ? s[r] * fexp(em - pmv[l]) : 0.f; Ps[l * LP + m] = f2bf16(val); } } }
        f32x4 inter[7];
        if (wave < 4) {
#pragma unroll
            for (int ct = 0; ct < 7; ++ct) inter[ct] = mm_tile<3>(Qs + 16 * wave * LPM + o104, Stt + 16 * ct * LPM + o104, (f32x4){0.f, 0.f, 0.f, 0.f}); }
#pragma unroll
        for (int i = 0; i < 8; ++i) { Os[(8 * wave + i) * LPM + d0] = (unsigned short)(og[i] & 0xffffu); if (has1) Os[(8 * wave + i) * LPM + d1] = (unsigned short)(og[i] >> 16); }
        WG_BAR_L();
        if (wave < 4) {
            f32x4 y[7];
#pragma unroll
            for (int ct = 0; ct < 7; ++ct) y[ct] = mm_tile<2>(Ps + 16 * wave * LP + o72, Vt + 16 * ct * LP + o72, (f32x4){0.f, 0.f, 0.f, 0.f});
#pragma unroll
            for (int r = 0; r < 4; ++r) { const int l = 16 * wave + 4 * q4 + r; const float iw = fexp(mold - pmv[l]);
#pragma unroll
                for (int ct = 0; ct < 7; ++ct) y[ct][r] += iw * inter[ct][r];
                const float den = __shfl(y[6][r], lane & 48);
                const float dn = __builtin_amdgcn_rcpf(fmaxf(fabsf(den), flv[l]));
                float s = 0.f;
#pragma unroll
                for (int ct = 0; ct < 6; ++ct) { y[ct][r] *= dn; s += y[ct][r]; }
                const float mean = sum16(s) * (1.0f / 96.0f); float qv = 0.f;
#pragma unroll
                for (int ct = 0; ct < 6; ++ct) { const float dd = y[ct][r] - mean; qv += dd * dd; }
                const float rstd = __builtin_amdgcn_rsqf(sum16(qv) * (1.0f / 96.0f) + GN_EPS);
                bf16* orow = mixed + (m0 + 64 * c + l) * DM + 640 + h * 96 + lc;
#pragma unroll
                for (int ct = 0; ct < 6; ++ct) { const float o = bf2f(Os[l * LPM + 16 * ct + lc]); orow[16 * ct] = f2bf16((y[ct][r] - mean) * rstd * gain6[ct] * fsigmoid(o)); } }
        } else {
#pragma unroll
            for (int i = 0; i < 11; ++i) { const int t = (wave - 4) + 4 * i;
                if (t < 42) { const int dt = t / 7, et = t % 7;
                    st[i] = mm_tile<2>(Kdt + 16 * dt * LP + o72, Vt + 16 * et * LP + o72, st[i] * carry);
                    v2u w; w.x = pk2(st[i][0], st[i][1]); w.y = pk2(st[i][2], st[i][3]);
                    *(LAS v2u*)(Stt + (16 * et + lc) * LPM + 16 * dt + 4 * q4) = w; } }
        }
        WG_BAR_L();
    }
#undef ML_LOAD
}
#ifndef RW_DBG
#define RW_DBG 0xFF
#endif
__device__ __forceinline__ void rwkv_unit(int b, int h, const bf16* proj, const float* CUM, const bf16* AA, const bf16* GG, const float* mu, const float* k_k, const float* k_a, const float* r_k,
                                          const float* gn, bf16* mixed, LAS unsigned char* lds, int wave, int lane0,
                                          int cb, int ce, const float* hs_in, unsigned* flag_in, float* hs_out, unsigned* flag_out) {
    constexpr int SLOT = 64 * LP;
    LAS bf16* KH = (LAS bf16*)lds; LAS bf16* BH = KH + SLOT; LAS bf16* KT = BH + SLOT; LAS bf16* RT = KT + SLOT; LAS bf16* KHgt = RT + SLOT; LAS bf16* BHgtn = KHgt + SLOT;
    LAS bf16* Vt = BHgtn + SLOT; LAS bf16* AkT = Vt + SLOT; LAS bf16* BbTn = AkT + SLOT; LAS bf16* BkT = BbTn + SLOT; LAS bf16* S0b = BkT + SLOT; LAS bf16* Loffb = S0b + SLOT; LAS bf16* Vr = Loffb + SLOT; LAS bf16* Gr = Vr + SLOT;
    LAS float* RHS = (LAS float*)KH; LAS bf16* Ut = KT;
    LAS float* LTd = (LAS float*)(Gr + SLOT);
    LAS float* XS = LTd + 64 * 20;
    LAS float* GCv = XS + 16 * 64; LAS float* bonv = GCv + 64;
    float mu_r, mu_k, mu_v, kkc, kac, rkc;
    { const int c0 = h * 64 + lane0; mu_r = mu[c0]; mu_k = mu[384 + c0]; mu_v = mu[768 + c0]; kkc = k_k[c0]; kac = k_a[c0]; rkc = r_k[c0]; }
    for (int i = wave * 64 + lane0; i < 5 * SLOT / 2; i += 512) ((LAS unsigned*)AkT)[i] = 0u;
    float gain4[4];
#pragma unroll
    for (int ct = 0; ct < 4; ++ct) gain4[ct] = gn[256 + h * 64 + 16 * ct + (lane0 & 15)];
    f32x4 sacc[4];
#pragma unroll
    for (int i = 0; i < 4; ++i) sacc[i] = (f32x4){0.f, 0.f, 0.f, 0.f};
    if (hs_in) {
        if (wave == 0) { unsigned spins = 0u;
            while (__hip_atomic_load(flag_in, __ATOMIC_RELAXED, __HIP_MEMORY_SCOPE_AGENT) == 0u) { __builtin_amdgcn_s_sleep(4); if (++spins > (1u << 22)) break; }
            __builtin_amdgcn_fence(__ATOMIC_ACQUIRE, "agent"); asm volatile("s_waitcnt vmcnt(0)" ::: "memory"); }
        WG_BAR();
        if (wave < 4) {
#pragma unroll
            for (int jt = 0; jt < 4; ++jt) {
#pragma unroll
                for (int r = 0; r < 4; ++r) { sacc[jt][r] = hs_in[(wave * 4 + jt) * 256 + r * 64 + lane0];
                    S0b[(16 * wave + 4 * (lane0 >> 4) + r) * LP + 16 * jt + (lane0 & 15)] = f2bf16(sacc[jt][r]); } } }
    }
    const size_t m0 = (size_t)b * SEQ;
    const bf16* PU = proj + m0 * NPI + RW_B + h * 64;
    const float* CU = CUM + m0 * 384 + h * 64; const bf16* AU = AA + m0 * 384 + h * 64; const bf16* GU = GG + m0 * 384 + h * 64;
    unsigned short rr[9], rk[9], rv[9], ra[8], rg[8]; float rc[9], rc63;
#define RWKV_LOAD(cc) do { const int tb_ = 64 * (cc) + 8 * wave; \
        _Pragma("unroll") for (int i = 0; i < 9; ++i) { const int t_ = tb_ - 1 + i; const bool ok_ = t_ >= 0; const bf16* p_ = PU + (size_t)(ok_ ? t_ : 0) * NPI; \
            rr[i] = ok_ ? p_[lane] : (unsigned short)0; rk[i] = ok_ ? p_[384 + lane] : (unsigned short)0; rv[i] = ok_ ? p_[768 + lane] : (unsigned short)0; \
            rc[i] = (i > 0 || wave > 0) ? CU[(size_t)(ok_ ? t_ : 0) * 384 + lane] : 0.f; if (i > 0) { ra[i - 1] = AU[(size_t)t_ * 384 + lane]; rg[i - 1] = GU[(size_t)t_ * 384 + lane]; } } \
        rc63 = CU[(size_t)(64 * (cc) + 63) * 384 + lane]; } while (0)
    { const int lane = lane0; RWKV_LOAD(cb); }
#pragma unroll 1
    for (int c = cb; c < ce; ++c) {
        const int lane = lane_id_opq(), q4 = lane >> 4, lc = lane & 15, o72 = lc * LP + 8 * q4;
        if (RW_DBG & 1) { unsigned short khg[8], bhg[8]; const float gc63 = fexp(rc63); float ecp = fexp(rc[0]);
#pragma unroll
          for (int i = 0; i < 8; ++i) { const int tt = 8 * wave + i;
              const float cr = bf2f(rr[i + 1]), ck = bf2f(rk[i + 1]);
              const float r = cr + (bf2f(rr[i]) - cr) * mu_r, k = ck + (bf2f(rk[i]) - ck) * mu_k, a = bf2f(ra[i]);
              float kk = k * kkc; kk = kk * __builtin_amdgcn_rsqf(fmaxf(wave_sum(kk * kk), 1e-24f));
              const float kmod = k * (1.0f + (a - 1.0f) * kac), beta = kk * a;
              const float bon = wave_sum(r * kmod * rkc); if (lane == 0) bonv[tt] = bon;
              const float cm = rc[i + 1], cp = rc[i];
              const float em = fexp(-cm), eg = gc63 * em, ec = __builtin_amdgcn_rcpf(em);
              KH[tt * LP + lane] = f2bf16(kmod * em); BH[tt * LP + lane] = f2bf16(beta * em); KT[tt * LP + lane] = f2bf16(kk * ecp); RT[tt * LP + lane] = f2bf16(r * ec); ecp = ec;
              khg[i] = f2bf16(kmod * eg); bhg[i] = f2bf16(-beta * eg); }
          v4u w; w.x = khg[0] | ((unsigned)khg[1] << 16); w.y = khg[2] | ((unsigned)khg[3] << 16); w.z = khg[4] | ((unsigned)khg[5] << 16); w.w = khg[6] | ((unsigned)khg[7] << 16);
          *(LAS v4u*)(KHgt + lane * LP + 8 * wave) = w;
          w.x = bhg[0] | ((unsigned)bhg[1] << 16); w.y = bhg[2] | ((unsigned)bhg[3] << 16); w.z = bhg[4] | ((unsigned)bhg[5] << 16); w.w = bhg[6] | ((unsigned)bhg[7] << 16);
          *(LAS v4u*)(BHgtn + lane * LP + 8 * wave) = w;
          unsigned short vs[8];
#pragma unroll
          for (int i = 0; i < 8; ++i) { const float cv = bf2f(rv[i + 1]); vs[i] = f2bf16(cv + (bf2f(rv[i]) - cv) * mu_v); Vr[(8 * wave + i) * LP + lane] = vs[i]; Gr[(8 * wave + i) * LP + lane] = rg[i]; }
          w.x = vs[0] | ((unsigned)vs[1] << 16); w.y = vs[2] | ((unsigned)vs[3] << 16); w.z = vs[4] | ((unsigned)vs[5] << 16); w.w = vs[6] | ((unsigned)vs[7] << 16);
          *(LAS v4u*)(Vt + lane * LP + 8 * wave) = w;
          if (wave == 0) GCv[lane] = gc63; }
        WG_BAR_L();
#pragma unroll
        for (int u2 = 0; u2 < 2; ++u2) { const int idx = 2 * wave + u2, rt = idx >> 2, ct = idx & 3;
            if (ct <= rt) {
                const int s = 16 * ct + lc; const LAS bf16* kt = KT + 16 * rt * LP + o72; const LAS bf16* rtp = RT + 16 * rt * LP + o72; const LAS bf16* bh = BH + 16 * ct * LP + o72; const LAS bf16* kh = KH + 16 * ct * LP + o72;
                const f32x4 z = (f32x4){0.f, 0.f, 0.f, 0.f};
                const f32x4 g0 = mm_tile<2>(kt, bh, z), g1 = mm_tile<2>(kt, kh, z), g2 = mm_tile<2>(rtp, bh, z), g3 = mm_tile<2>(rtp, kh, z);
#pragma unroll
                for (int r = 0; r < 4; ++r) { const int t = 16 * rt + 4 * q4 + r;
                    if (ct < rt) Loffb[t * LP + s] = f2bf16(g0[r]); else LTd[s * 20 + (t - 16 * rt)] = (s < t) ? g0[r] : 0.f;
                    AkT[t * LP + s] = f2bf16((s < t) ? g1[r] : 0.f);
                    BbTn[t * LP + s] = f2bf16((s <= t) ? -g2[r] : 0.f);
                    BkT[t * LP + s] = f2bf16((s <= t) ? g3[r] : 0.f); } } }
        WG_BAR_L();
#pragma unroll
        for (int u = 0; u < ((RW_DBG & 4) ? 2 : 0); ++u) { const int rt = wave >> 1, ct = 2 * (wave & 1) + u;
            f32x4 g = mm_tile<2>(KT + 16 * rt * LP + o72, S0b + 16 * ct * LP + o72, (f32x4){0.f, 0.f, 0.f, 0.f});
            g = mm_tile<2>(AkT + 16 * rt * LP + o72, Vt + 16 * ct * LP + o72, g);
#pragma unroll
            for (int r = 0; r < 4; ++r) RHS[(16 * rt + 4 * q4 + r) * 64 + 16 * ct + lc] = g[r]; }
        WG_BAR_L();
        f32x4 y[4];
        if ((RW_DBG & 8) && wave == 0) {
#pragma unroll
            for (int a = 0; a < 4; ++a) {
                if (a > 0) {
#pragma unroll
                    for (int it = 0; it < 4; ++it) { f32x4 cr = (f32x4){0.f, 0.f, 0.f, 0.f};
                        if (a == 3) cr = mm_tile<2>(Loffb + 16 * a * LP + o72, Ut + 16 * it * LP + o72, cr); else cr = mm_tile<1>(Loffb + 16 * a * LP + o72, Ut + 16 * it * LP + o72, cr);
#pragma unroll
                        for (int r = 0; r < 4; ++r) XS[(4 * q4 + r) * 64 + 16 * it + lc] = cr[r]; }
                    asm volatile("s_waitcnt lgkmcnt(0)" ::: "memory");
                }
                float acc[16];
#pragma unroll
                for (int t = 0; t < 16; ++t) acc[t] = RHS[(16 * a + t) * 64 + lane] - (a > 0 ? XS[t * 64 + lane] : 0.f);
                const LAS float* Ld = LTd + 16 * a * 20; asm volatile("" : "+v"(Ld));
#pragma unroll
                for (int s2 = 0; s2 < 15; ++s2) { const float us = acc[s2];
#pragma unroll
                    for (int t4 = (s2 + 1) / 4; t4 < 4; ++t4) { const f32x4 l4 = *(const LAS f32x4*)(Ld + s2 * 20 + 4 * t4);
                        acc[4 * t4] -= l4.x * us; acc[4 * t4 + 1] -= l4.y * us; acc[4 * t4 + 2] -= l4.z * us; acc[4 * t4 + 3] -= l4.w * us; }
                    if (s2 == 5) asm volatile("" : "+v"(Ld) : "v"(acc[s2 + 1])); }
                v4u w; w.x = pk2(acc[0], acc[1]); w.y = pk2(acc[2], acc[3]); w.z = pk2(acc[4], acc[5]); w.w = pk2(acc[6], acc[7]);
                *(LAS v4u*)(Ut + lane * LP + 16 * a) = w;
                w.x = pk2(acc[8], acc[9]); w.y = pk2(acc[10], acc[11]); w.z = pk2(acc[12], acc[13]); w.w = pk2(acc[14], acc[15]);
                *(LAS v4u*)(Ut + lane * LP + 16 * a + 8) = w;
                asm volatile("s_waitcnt lgkmcnt(0)" ::: "memory");
            }
        }
        if (c + 1 < ce) RWKV_LOAD(c + 1);
        if (wave >= 4) {
#pragma unroll
            for (int ct = 0; ct < 4; ++ct) { y[ct] = mm_tile<2>(RT + 16 * (wave - 4) * LP + o72, S0b + 16 * ct * LP + o72, (f32x4){0.f, 0.f, 0.f, 0.f}); y[ct] = mm_tile<2>(BkT + 16 * (wave - 4) * LP + o72, Vt + 16 * ct * LP + o72, y[ct]); }
        } else {
#pragma unroll
            for (int jt = 0; jt < 4; ++jt) { const float gc = GCv[16 * jt + lc]; sacc[jt] = mm_tile<2>(Vt + 16 * wave * LP + o72, KHgt + 16 * jt * LP + o72, sacc[jt] * gc); }
        }
        WG_BAR_L();
        if (wave >= 4) {
#pragma unroll
            for (int ct = 0; ct < 4; ++ct) y[ct] = mm_tile<2>(BbTn + 16 * (wave - 4) * LP + o72, Ut + 16 * ct * LP + o72, y[ct]);
#pragma unroll
            for (int r = 0; r < 4; ++r) { const int t = 16 * (wave - 4) + 4 * q4 + r; const size_t row = m0 + 64 * c + t;
                float s = 0.f;
#pragma unroll
                for (int ct = 0; ct < 4; ++ct) s += y[ct][r];
                const float mean = sum16(s) * (1.0f / 64.0f); float qv = 0.f;
#pragma unroll
                for (int ct = 0; ct < 4; ++ct) { const float dd = y[ct][r] - mean; qv += dd * dd; }
                const float rstd = __builtin_amdgcn_rsqf(sum16(qv) * (1.0f / 64.0f) + GN_EPS);
                const float bon = bonv[t]; bf16* orow = mixed + row * DM + 256 + h * 64 + lc;
#pragma unroll
                for (int ct = 0; ct < 4; ++ct) orow[16 * ct] = f2bf16(((y[ct][r] - mean) * rstd * gain4[ct] + bon * bf2f(Vr[t * LP + 16 * ct + lc])) * bf2f(Gr[t * LP + 16 * ct + lc])); }
        } else {
#pragma unroll
            for (int jt = 0; jt < 4; ++jt) { sacc[jt] = mm_tile<2>(Ut + 16 * wave * LP + o72, BHgtn + 16 * jt * LP + o72, sacc[jt]);
#pragma unroll
                for (int r = 0; r < 4; ++r) S0b[(16 * wave + 4 * q4 + r) * LP + 16 * jt + lc] = f2bf16(sacc[jt][r]); }
        }
        WG_BAR_L();
    }
    if (hs_out) {
        if (wave < 4) {
#pragma unroll
            for (int jt = 0; jt < 4; ++jt)
#pragma unroll
                for (int r = 0; r < 4; ++r) __hip_atomic_store(hs_out + (wave * 4 + jt) * 256 + r * 64 + lane0, sacc[jt][r], __ATOMIC_RELAXED, __HIP_MEMORY_SCOPE_AGENT);
        }
        WG_BAR();
        if (wave == 0 && lane0 == 0) __hip_atomic_store(flag_out, 1u, __ATOMIC_RELAXED, __HIP_MEMORY_SCOPE_AGENT);
    }
#undef RWKV_LOAD
}

struct Args { const float* in[25]; float* out; unsigned char* ws; int ph_lo, ph_hi, li, pad; };
typedef const __attribute__((address_space(4))) Args* KArgs;
__device__ __forceinline__ KArgs kargs() { KArgs p = (KArgs)__builtin_amdgcn_kernarg_segment_ptr(); asm volatile("" : "+s"(p)); return p; }
#ifndef DBG_MASK
#define DBG_MASK 0xFFFF
#endif
#define EN(bit) ((DBG_MASK >> (bit)) & 1)
#ifndef PROBE_DUP
#define PROBE_DUP 0
#endif
#define REP(bit) for (int rep_ = 0; rep_ < (((PROBE_DUP >> (bit)) & 1) ? 2 : 1); ++rep_)
__global__ void __launch_bounds__(NWAVES * 64, 2) mk_fwd(Args args_unused) {
    extern __shared__ __attribute__((aligned(16))) unsigned char lds_raw[];
    LAS unsigned char* lds = (LAS unsigned char*)lds_raw;
    volatile LAS unsigned* MISC = (volatile LAS unsigned*)(lds + MISC_OFF);
    const int wave = __builtin_amdgcn_readfirstlane((int)threadIdx.x >> 6);
    const int G = gridDim.x, gw = blockIdx.x * NWAVES + wave, ngw = G * NWAVES;
    for (int u = threadIdx.x; u < (LDS_BYTES - LDSCTL_OFF) / 4; u += NWAVES * 64) ((LAS unsigned*)(lds + LDSCTL_OFF))[u] = 0u;
    __syncthreads();
    XcdBarrier bar; int lo, hi;
    { KArgs A = kargs(); bar = xcd_barrier_post((unsigned*)(A->ws + WS_CTL) + CW_BAR + (MK_PER_PHASE ? 0 : A->li) * XCD_BAR_WORDS, MISC + 8); lo = A->ph_lo; hi = A->ph_hi; }
#define IN(k) (lo <= (k) && (k) < hi)
#define SEAM(k) do { if (IN(k) && IN((k) + 1)) xcd_barrier(bar); } while (0)
#define LANE_TID() int wave_o = wave, gw_o = gw; asm volatile("" : "+s"(wave_o), "+s"(gw_o)); (void)gw_o; const int lane_o = lane_id_opq(), tid_o = wave_o * 64 + lane_o; (void)tid_o

    REP(5) if (EN(0) && IN(0)) {
        KArgs A = kargs(); unsigned char* ws = A->ws; LANE_TID();
        p0_mod(A->in[1], A->in[2], A->in[3], (float*)(ws + WS_MOD), lds, tid_o, lane_o, wave_o);
        p0_weights(A->in[6], A->in[21], A->in[22], A->in[23], A->in[10], A->in[12], A->in[13], ws, lds, gw_o, ngw, wave_o, lane_o);
    }
    SEAM(0);
#pragma unroll 1
    for (int l = 0; l < NL; ++l) {
        const int pb = 1 + 8 * l;
        REP(2) if (EN(1) && IN(pb + 0)) { KArgs A = kargs(); unsigned char* ws = A->ws; LANE_TID();
            norm_mod_phase(l == 0 ? A->in[0] : (const float*)nullptr, (const bf16*)A->out, A->in[4] + l * DM, (const float*)(ws + WS_MOD) + (size_t)l * NB * MODP, 0, DM, (bf16*)(ws + WS_H), gw_o, ngw, lane_o); }
        SEAM(pb + 0);
        REP(3) if (EN(2) && IN(pb + 1)) { KArgs A = kargs(); unsigned char* ws = A->ws; LANE_TID();
            pg8::Gemm g{(const bf16*)(ws + WS_H), (const bf16*)(ws + WS_WIN) + (size_t)l * NPI * DM, MT, NPI, DM}; pg8::StaticOrder S; S.init(MT, NPI, G, (int)blockIdx.x);
            pg8::EpiBf16Plain E{(bf16*)(ws + WS_PROJ), NPI};
            pg8::gemm_phase<pg8::EpiBf16Plain, pg8::StaticOrder, true, true>(lds, g, S, E, wave_o);
        }
        SEAM(pb + 1);
        REP(1) if (EN(3) && IN(pb + 2)) { KArgs A = kargs(); unsigned char* ws = A->ws; LANE_TID();
            rwkv_prep_mfma((const bf16*)(ws + WS_PROJ), A->in[8] + l * RWKV_IN, A->in[9] + l * 384, A->in[11] + l * 384, (const bf16*)(ws + WS_WL) + (size_t)l * 384 * 256,
                           (float*)(ws + WS_DEC), (bf16*)(ws + WS_AA), (bf16*)(ws + WS_GG), lds, wave_o); }
        SEAM(pb + 2);
        REP(0) if (EN(4) && IN(pb + 3)) { KArgs A = kargs(); unsigned char* ws = A->ws; LANE_TID();
            const float* gn = A->in[7] + l * DM; const bf16* PROJ = (const bf16*)(ws + WS_PROJ); bf16* Hb = (bf16*)(ws + WS_H);
            int u = (int)blockIdx.x; asm volatile("" : "+s"(u));
            float* HS = (float*)(ws + WS_HS) + (size_t)l * 64 * 4096; unsigned* FL = (unsigned*)(ws + WS_CTL) + CW_FLAG + l * 64 * 64;
            const float* DECp = (const float*)(ws + WS_DEC); const bf16* AAp = (const bf16*)(ws + WS_AA); const bf16* GGp = (const bf16*)(ws + WS_GG);
            if (u < 128) {
                mlstm_unit(u >> 2, u & 3, PROJ, A->in[17] + (size_t)l * 4 * 768, A->in[18] + l * 768, A->in[19] + l * 4, A->in[20] + l * 4, gn, Hb, lds, wave_o, lane_o);
            } else {
                const int v0 = u - 128, k = v0 & 63; const bool dgrp = v0 >= 64;
#pragma unroll 1
                for (int rep = 0; rep < 2; ++rep) { const bool half = (rep == 0) == dgrp; const int q = half ? 128 + k : v0;
                    const int cb = (half && !dgrp) ? 16 : 0, ce = (half && dgrp) ? 16 : 32;
                    rwkv_unit(q / 6, q % 6, PROJ, DECp, AAp, GGp, A->in[8] + l * RWKV_IN, A->in[14] + l * 384, A->in[15] + l * 384, A->in[16] + l * 384, gn, Hb, lds, wave_o, lane_o,
                              cb, ce, (half && !dgrp) ? HS + (size_t)k * 4096 : nullptr, (half && !dgrp) ? FL + k * 64 : nullptr, (half && dgrp) ? HS + (size_t)k * 4096 : nullptr, (half && dgrp) ? FL + k * 64 : nullptr); }
                ret_unit(v0 >> 2, v0 & 3, PROJ, gn, Hb, lds, wave_o, lane_o);
            }
#ifndef PROBE_UNIT
#define PROBE_UNIT 0
#endif
            if (PROBE_UNIT == 1 && u < 192) rwkv_unit(u / 6, u % 6, PROJ, DECp, AAp, GGp, A->in[8] + l * RWKV_IN, A->in[14] + l * 384, A->in[15] + l * 384, A->in[16] + l * 384, gn, Hb, lds, wave_o, lane_o, 0, 32, nullptr, nullptr, nullptr, nullptr);
            if (PROBE_UNIT == 2 && u < 128) mlstm_unit(u >> 2, u & 3, PROJ, A->in[17] + (size_t)l * 4 * 768, A->in[18] + l * 768, A->in[19] + l * 4, A->in[20] + l * 4, gn, Hb, lds, wave_o, lane_o);
            if (PROBE_UNIT == 3 && u < 128) ret_unit(u >> 2, u & 3, PROJ, gn, Hb, lds, wave_o, lane_o);
        }
        SEAM(pb + 3);
        if (EN(6) && IN(pb + 4)) { KArgs A = kargs(); unsigned char* ws = A->ws; LANE_TID();
            pg8::Gemm g{(const bf16*)(ws + WS_H), (const bf16*)(ws + WS_WOUT) + (size_t)l * DM * DM, MT, DM, DM}; pg8::StaticOrder S; S.init(MT, DM, G, (int)blockIdx.x);
            pg8::EpiResGate E{l == 0 ? A->in[0] : (const float*)nullptr, (const bf16*)A->out, (bf16*)A->out, DM, (const float*)(ws + WS_MOD) + (size_t)l * NB * MODP + 2 * DM, MODP};
            pg8::gemm_phase<pg8::EpiResGate, pg8::StaticOrder, true, true>(lds, g, S, E, wave_o);
        }
        SEAM(pb + 4);
        REP(2) if (EN(1) && IN(pb + 5)) { KArgs A = kargs(); unsigned char* ws = A->ws; LANE_TID();
            norm_mod_phase((const float*)nullptr, (const bf16*)A->out, A->in[5] + l * DM, (const float*)(ws + WS_MOD) + (size_t)l * NB * MODP, 3 * DM, 4 * DM, (bf16*)(ws + WS_H), gw_o, ngw, lane_o); }
        SEAM(pb + 5);
        REP(4) if (EN(7) && IN(pb + 6)) { KArgs A = kargs(); unsigned char* ws = A->ws; LANE_TID();
            pg8::Gemm g{(const bf16*)(ws + WS_H), (const bf16*)(ws + WS_WF1) + (size_t)l * NF1 * DM, MT, NF1, DM}; pg8::StaticOrder S; S.init(MT, NF1, G, (int)blockIdx.x);
            pg8::EpiSwiGLU E{(bf16*)(ws + WS_PROJ), DFF};
            pg8::gemm_phase<pg8::EpiSwiGLU, pg8::StaticOrder, true, true>(lds, g, S, E, wave_o);
        }
        SEAM(pb + 6);
        if (EN(8) && IN(pb + 7)) { KArgs A = kargs(); unsigned char* ws = A->ws; LANE_TID();
            pg8::Gemm g{(const bf16*)(ws + WS_PROJ), (const bf16*)(ws + WS_WF2) + (size_t)l * DM * DFF, MT, DM, DFF}; pg8::StaticOrder S; S.init(MT, DM, G, (int)blockIdx.x);
            pg8::EpiResGate E{(const float*)nullptr, (const bf16*)A->out, l + 1 < NL ? (bf16*)A->out : (bf16*)(ws + WS_XFIN), DM, (const float*)(ws + WS_MOD) + (size_t)l * NB * MODP + 5 * DM, MODP};
            pg8::gemm_phase<pg8::EpiResGate, pg8::StaticOrder, true, true>(lds, g, S, E, wave_o);
        }
        SEAM(pb + 7);
    }
    if (EN(9) && IN(N_PHASES - 1)) { KArgs A = kargs(); int gw_o = gw; asm volatile("" : "+s"(gw_o)); final_norm_phase((const bf16*)(A->ws + WS_XFIN), A->out, A->in[24], gw_o, ngw, lane_id_opq()); }
#undef IN
#undef SEAM
}

extern "C" void kernel_launch(void* const* d_in, const int* in_sizes, int n_in, void* d_out, int out_size, void* d_ws, size_t ws_size, hipStream_t stream) {
    static int grid = 0;
    if (grid == 0) {
        if (n_in != 25 || in_sizes[0] != MT * DM || out_size != MT * DM || ws_size < WS_END) { fprintf(stderr, "kernel_launch: shape/workspace mismatch (n_in %d, in0 %d, out %d, ws %zu)\n", n_in, n_in > 0 ? in_sizes[0] : -1, out_size, ws_size); grid = -1; return; }
        int dev = 0, cus = 0, per_cu = 0;
        if (hipGetDevice(&dev) != hipSuccess || hipDeviceGetAttribute(&cus, hipDeviceAttributeMultiprocessorCount, dev) != hipSuccess) { grid = -1; return; }
        if (hipFuncSetAttribute((const void*)mk_fwd, hipFuncAttributeMaxDynamicSharedMemorySize, LDS_BYTES) != hipSuccess) { fprintf(stderr, "kernel_launch: hipFuncSetAttribute failed\n"); grid = -1; return; }
        if (hipOccupancyMaxActiveBlocksPerMultiprocessor(&per_cu, (const void*)mk_fwd, NWAVES * 64, LDS_BYTES) != hipSuccess || per_cu < 1) { fprintf(stderr, "kernel_launch: occupancy query says %d\n", per_cu); }
        (void)hipGetLastError();
        grid = cus;
    }
    if (grid < 0) return;
    if (hipMemsetAsync((char*)d_ws + WS_CTL, 0, CTL_ZERO_BYTES, stream) != hipSuccess) return;
    Args a{};
    for (int i = 0; i < 25; ++i) a.in[i] = (const float*)d_in[i];
    a.out = (float*)d_out; a.ws = (unsigned char*)d_ws;
#if MK_PER_PHASE
    for (int p = 0; p < N_PHASES; ++p) { a.ph_lo = p; a.ph_hi = p + 1; a.li = 0; hipLaunchKernelGGL(mk_fwd, dim3(grid), dim3(NWAVES * 64), LDS_BYTES, stream, a); }
#else
    a.ph_lo = 0; a.ph_hi = N_PHASES; a.li = 0;
    hipLaunchKernelGGL(mk_fwd, dim3(grid), dim3(NWAVES * 64), LDS_BYTES, stream, a);
#endif
}
```

```cpp
#include <hip/hip_runtime.h>
#include <cstdio>
#include <cstdint>
__device__ __forceinline__ int lane_id_opq() { int l = (int)__builtin_amdgcn_mbcnt_hi(~0u, __builtin_amdgcn_mbcnt_lo(~0u, 0u)); asm volatile("" : "+v"(l)); return l; }

namespace pg8 {
#define PG8_LAS __attribute__((address_space(3)))
typedef unsigned short bf16_t;
typedef short bf16x8 __attribute__((ext_vector_type(8)));
typedef float f32x4 __attribute__((ext_vector_type(4)));
typedef unsigned u32x4 __attribute__((ext_vector_type(4)));
constexpr int BM = 256, BK = 64, HALF = 128, HTB = HALF * BK * 2  , STAGE_BYTES = 8 * HTB, NXCD = 8, WGM = 8;

__host__ __device__ __forceinline__ int lds_byte(int r, int c) { const int st = (r >> 4) * 2 + (c >> 5), rr = r & 15, cc = c & 31, ob = rr * 64 + cc * 2; return st * 1024 + (ob ^ (((ob >> 9) & 1) << 5)); }
__host__ __device__ __forceinline__ void stage_rc(int b, int& R, int& C) { const int st = b / 1024, sb = b % 1024, swz = sb ^ (((sb >> 9) & 1) << 5); R = (st >> 1) * 16 + swz / 64; C = (st & 1) * 32 + (swz % 64) / 2; }
__host__ __device__ __forceinline__ int perm32(int rho) { const int n = rho >> 4, i = rho & 15; return 8 * (i >> 2) + 4 * n + (i & 3); }

struct Unit { int pm, pn; };
struct Gemm { const bf16_t* A; const bf16_t* Bt; int M, N, K; };

struct StaticOrder {
    int nM, nN, nwg, G, c;
    __host__ __device__ void init(int M, int N, int G_, int c_) { nM = M / BM; nN = N / BM; nwg = nM * nN; G = G_; c = c_; }
    __host__ __device__ bool next(int i, Unit& u) const {
        const long L = (long)i * G + c; if (L >= nwg) return false;
        int wgid = (int)L; { const int q = nwg / NXCD, r = nwg % NXCD, xcd = wgid % NXCD, off = wgid / NXCD; wgid = (xcd < r ? xcd * (q + 1) : r * (q + 1) + (xcd - r) * q) + off; }
        const int nig = WGM * nN, gid = wgid / nig, fm = gid * WGM, gsz = (nM - fm) < WGM ? (nM - fm) : WGM;
        u.pm = fm + ((wgid % nig) % gsz); u.pn = (wgid % nig) / gsz; return true;
    }
    __device__ __forceinline__ void a_ready(const Unit&) const {}
    __device__ __forceinline__ void done(const Unit&) const {}
};

__device__ __forceinline__ unsigned cvt_pk_bf16(float lo, float hi) { unsigned r; asm volatile("v_cvt_pk_bf16_f32 %0, %1, %2" : "=v"(r) : "v"(lo), "v"(hi)); return r; }
typedef float f32x2 __attribute__((ext_vector_type(2)));

typedef float f32x2e __attribute__((ext_vector_type(2)));
typedef __bf16 bf16x2e __attribute__((ext_vector_type(2)));
__device__ __forceinline__ unsigned cvt_pk(float lo, float hi) { const f32x2e v = {lo, hi}; return __builtin_bit_cast(unsigned, __builtin_convertvector(v, bf16x2e)); }
__device__ __forceinline__ float silu_f(float x) { return x * __builtin_amdgcn_rcpf(1.0f + __expf(-x)); }
struct EpiBf16Plain {
    static constexpr bool PERM = true, AFTER_DRAIN = false;
    bf16_t* O; int ldc;
    __device__ __forceinline__ void operator()(const f32x4 (&acc)[2][2][4][2], const Unit& u, int wr, int wc, int fr, int fq) const {
        const int row0 = u.pm * BM + wr * 64 + fr, col0 = u.pn * BM + wc * 32 + 8 * fq;
#pragma unroll
        for (int ai = 0; ai < 2; ++ai)
#pragma unroll
            for (int m = 0; m < 4; ++m) { bf16_t* rowp = O + (size_t)(row0 + ai * HALF + m * 16) * ldc + col0;
#pragma unroll
                for (int bj = 0; bj < 2; ++bj) { const f32x4 v0 = acc[ai][bj][m][0], v1 = acc[ai][bj][m][1];
                    u32x4 w; w.x = cvt_pk(v0[0], v0[1]); w.y = cvt_pk(v0[2], v0[3]); w.z = cvt_pk(v1[0], v1[1]); w.w = cvt_pk(v1[2], v1[3]);
                    *(u32x4*)(rowp + bj * HALF) = w; } }
    }
};
struct EpiSwiGLU {
    static constexpr bool PERM = true, AFTER_DRAIN = false;
    bf16_t* O; int ldc;
    __device__ __forceinline__ void operator()(const f32x4 (&acc)[2][2][4][2], const Unit& u, int wr, int wc, int fr, int fq) const {
        const int row0 = u.pm * BM + wr * 64 + fr, col0 = u.pn * HALF + wc * 32 + 8 * fq;
#pragma unroll
        for (int ai = 0; ai < 2; ++ai)
#pragma unroll
            for (int m = 0; m < 4; ++m) { bf16_t* rowp = O + (size_t)(row0 + ai * HALF + m * 16) * ldc + col0;
                const f32x4 g0 = acc[ai][0][m][0], g1 = acc[ai][0][m][1], u0 = acc[ai][1][m][0], u1 = acc[ai][1][m][1];
                u32x4 w; w.x = cvt_pk(silu_f(g0[0]) * u0[0], silu_f(g0[1]) * u0[1]); w.y = cvt_pk(silu_f(g0[2]) * u0[2], silu_f(g0[3]) * u0[3]);
                w.z = cvt_pk(silu_f(g1[0]) * u1[0], silu_f(g1[1]) * u1[1]); w.w = cvt_pk(silu_f(g1[2]) * u1[2], silu_f(g1[3]) * u1[3]);
                *(u32x4*)rowp = w; }
    }
};
struct EpiResGate {
    static constexpr bool PERM = false, AFTER_DRAIN = false;
    const float* xin32; const bf16_t* xsin; bf16_t* xs; int ldc; const float* gate; int gpitch;
    __device__ __forceinline__ void operator()(const f32x4 (&acc)[2][2][4][2], const Unit& u, int wr, int wc, int fr, int fq) const {
        typedef unsigned u32x2 __attribute__((ext_vector_type(2)));
        const int row0 = u.pm * BM + wr * 64 + fr, col0 = u.pn * BM + wc * 32 + 4 * fq;
        const float* gp = gate + (size_t)(u.pm >> 3) * gpitch + col0;
        f32x4 gv[2][2];
#pragma unroll
        for (int bj = 0; bj < 2; ++bj)
#pragma unroll
            for (int n = 0; n < 2; ++n) gv[bj][n] = *(const f32x4*)(gp + bj * HALF + n * 16);
#pragma unroll
        for (int ai = 0; ai < 2; ++ai)
#pragma unroll
            for (int m = 0; m < 4; ++m) { const size_t off = (size_t)(row0 + ai * HALF + m * 16) * ldc + col0;
#pragma unroll
                for (int bj = 0; bj < 2; ++bj)
#pragma unroll
                    for (int n = 0; n < 2; ++n) { f32x4 xi;
                        if (xin32) xi = *(const f32x4*)(xin32 + off + bj * HALF + n * 16);
                        else { const u32x2 w = *(const u32x2*)(xsin + off + bj * HALF + n * 16); xi = (f32x4){__uint_as_float(w.x << 16), __uint_as_float(w.x & 0xffff0000u), __uint_as_float(w.y << 16), __uint_as_float(w.y & 0xffff0000u)}; }
                        const f32x4 xo = xi + gv[bj][n] * acc[ai][bj][m][n];
                        u32x2 o; o.x = cvt_pk(xo[0], xo[1]); o.y = cvt_pk(xo[2], xo[3]); *(u32x2*)(xs + off + bj * HALF + n * 16) = o; }
                if (m == 3) asm volatile("" ::: "memory"); }
    }
};

template <class Epi, class Sched, bool ALIGN_EPI = false, bool SP2 = false>
__device__ __forceinline__ void gemm_phase(PG8_LAS unsigned char* lds, const Gemm g, const Sched& S, const Epi& E, const int wid_in) {
    const int wid = wid_in, lane = lane_id_opq(), tid = wid * 64 + lane, wr = wid >> 2, wc = wid & 3, fr = lane & 15, fq = lane >> 4;
    const int K = g.K, nt = K / BK;
    unsigned voffA[2], voffB[2];
#pragma unroll
    for (int i = 0; i < 2; ++i) { int R, C; stage_rc(tid * 16 + i * 8192, R, C); const int Rb = Epi::PERM ? ((R & ~31) + perm32(R & 31)) : R;
        voffA[i] = (unsigned)(R * K + C) * 2u; voffB[i] = (unsigned)(Rb * K + C) * 2u; }
    const size_t kstep = (size_t)(BK * 2);
    const size_t hstep = (size_t)HALF * K * 2;
    const size_t tstep = 2 * hstep;
    const unsigned ldsw = (unsigned)wid * 1024u;
    const int aoff = lds_byte(wr * 64 + fr, fq * 8), boff = lds_byte(wc * 32 + fr, fq * 8);
#define PG8_SA(b, h) (((b) * 2 + (h)) * HTB)
#define PG8_SB(b, h) ((4 + (b) * 2 + (h)) * HTB)
#define PG8_STAGE(bufoff, gbase, voff) do { _Pragma("unroll") for (int _i = 0; _i < 2; ++_i) \
        __builtin_amdgcn_global_load_lds((const unsigned*)((const char*)(gbase) + (voff)[_i]), (PG8_LAS unsigned*)(lds + (bufoff) + ldsw + _i * 8192), 16, 0, 0); } while (0)
#define PG8_LDA(dst, b, h) do { _Pragma("unroll") for (int m = 0; m < 4; ++m) _Pragma("unroll") for (int k = 0; k < 2; ++k) dst[m][k] = *(const PG8_LAS bf16x8*)(lds + PG8_SA(b, h) + aoff + m * 2048 + k * 1024); } while (0)
#define PG8_LDB(dst, b, h) do { _Pragma("unroll") for (int n = 0; n < 2; ++n) _Pragma("unroll") for (int k = 0; k < 2; ++k) dst[n][k] = *(const PG8_LAS bf16x8*)(lds + PG8_SB(b, h) + boff + n * 2048 + k * 1024); } while (0)
#define PG8_MMA(ai, bj, At, Bt) do { __builtin_amdgcn_s_setprio(1); _Pragma("unroll") for (int m = 0; m < 4; ++m) _Pragma("unroll") for (int n = 0; n < 2; ++n) _Pragma("unroll") for (int k = 0; k < 2; ++k) \
        acc[ai][bj][m][n] = __builtin_amdgcn_mfma_f32_16x16x32_bf16(Bt[n][k], At[m][k], acc[ai][bj][m][n], 0, 0, 0); __builtin_amdgcn_s_setprio(0); } while (0)
#define PG8_WAIT_V(n) asm volatile("s_waitcnt vmcnt(" #n ")" ::: "memory")
#define PG8_WAIT_L(n) asm volatile("s_waitcnt lgkmcnt(" #n ")" ::: "memory")
#define PG8_BAR __builtin_amdgcn_s_barrier()
#define PG8_SCHED __builtin_amdgcn_sched_barrier(0)
    Unit cur, nxt; int ui = 0;
    if (!S.next(0, cur)) return;
    f32x4 acc[2][2][4][2];
#pragma unroll
    for (int a = 0; a < 2; ++a)
#pragma unroll
        for (int b = 0; b < 2; ++b)
#pragma unroll
            for (int m = 0; m < 4; ++m)
#pragma unroll
                for (int n = 0; n < 2; ++n) acc[a][b][m][n] = (f32x4){0.f, 0.f, 0.f, 0.f};
    bf16x8 At[4][2], B0[2][2], B1[2][2];
    const char* cA = (const char*)g.A + (size_t)cur.pm * tstep; const char* cB = (const char*)g.Bt + (size_t)cur.pn * tstep;
    S.a_ready(cur);
    if constexpr (SP2) {
        PG8_STAGE(PG8_SB(0, 0), cB, voffB); PG8_STAGE(PG8_SB(0, 1), cB + hstep, voffB); PG8_STAGE(PG8_SA(0, 0), cA, voffA); PG8_STAGE(PG8_SA(0, 1), cA + hstep, voffA);
        if (wr == 1) PG8_BAR;
        PG8_WAIT_V(2); PG8_BAR;
        PG8_STAGE(PG8_SB(1, 0), cB + kstep, voffB); PG8_STAGE(PG8_SA(1, 0), cA + kstep, voffA); PG8_STAGE(PG8_SB(1, 1), cB + hstep + kstep, voffB);
        PG8_WAIT_V(6); PG8_BAR;
    } else {
        PG8_STAGE(PG8_SB(0, 0), cB, voffB); PG8_STAGE(PG8_SA(0, 0), cA, voffA); PG8_STAGE(PG8_SB(0, 1), cB + hstep, voffB); PG8_STAGE(PG8_SA(0, 1), cA + hstep, voffA);
        if (wr == 1) PG8_BAR;
        PG8_WAIT_V(4); PG8_BAR;
        PG8_STAGE(PG8_SB(1, 0), cB + kstep, voffB); PG8_STAGE(PG8_SA(1, 0), cA + kstep, voffA); PG8_STAGE(PG8_SB(1, 1), cB + hstep + kstep, voffB);
        PG8_WAIT_V(6); PG8_BAR;
    }
    for (;;) {
        const bool has_next = S.next(ui + 1, nxt);
        const char* nA = has_next ? (const char*)g.A + (size_t)nxt.pm * tstep : cA; const char* nB = has_next ? (const char*)g.Bt + (size_t)nxt.pn * tstep : cB;
        for (int t = 0; t < nt; t += 2) {
            const bool last = (t == nt - 2);
            const char* a1 = cA + (size_t)(t + 1) * kstep;
            const char* a2 = last ? nA : cA + (size_t)(t + 2) * kstep; const char* b2 = last ? nB : cB + (size_t)(t + 2) * kstep;
            const char* a3 = a2 + kstep; const char* b3 = b2 + kstep;
            if (last && has_next) S.a_ready(nxt);
            if constexpr (SP2) {
            PG8_LDB(B0, 0, 0); PG8_LDB(B1, 0, 1); PG8_SCHED; PG8_LDA(At, 0, 0); PG8_STAGE(PG8_SA(1, 1), a1 + hstep, voffA);
            PG8_WAIT_V(8); PG8_WAIT_L(0); PG8_BAR; PG8_MMA(0, 0, At, B0); PG8_MMA(0, 1, At, B1); PG8_BAR; PG8_SCHED;
            PG8_LDA(At, 0, 1); PG8_STAGE(PG8_SB(0, 0), b2, voffB); PG8_STAGE(PG8_SB(0, 1), b2 + hstep, voffB); PG8_STAGE(PG8_SA(0, 0), a2, voffA);
            PG8_WAIT_V(8); PG8_WAIT_L(0); PG8_BAR; PG8_MMA(1, 0, At, B0); PG8_MMA(1, 1, At, B1); PG8_BAR; PG8_SCHED;
            PG8_LDB(B0, 1, 0); PG8_LDB(B1, 1, 1); PG8_SCHED; PG8_LDA(At, 1, 0); PG8_STAGE(PG8_SA(0, 1), a2 + hstep, voffA);
            PG8_WAIT_V(8); PG8_WAIT_L(0); PG8_BAR; PG8_MMA(0, 0, At, B0); PG8_MMA(0, 1, At, B1); PG8_BAR; PG8_SCHED;
            PG8_LDA(At, 1, 1); PG8_STAGE(PG8_SB(1, 0), b3, voffB); PG8_STAGE(PG8_SB(1, 1), b3 + hstep, voffB); PG8_STAGE(PG8_SA(1, 0), a3, voffA);
            PG8_WAIT_V(8); PG8_WAIT_L(0); PG8_BAR; PG8_MMA(1, 0, At, B0); PG8_MMA(1, 1, At, B1); PG8_BAR; PG8_SCHED;
            } else {
            PG8_LDB(B0, 0, 0); PG8_SCHED; PG8_LDA(At, 0, 0); PG8_STAGE(PG8_SA(1, 1), a1 + hstep, voffA);
            PG8_WAIT_L(8); PG8_BAR; PG8_WAIT_L(0); PG8_MMA(0, 0, At, B0); PG8_BAR; PG8_SCHED;
            PG8_LDB(B1, 0, 1); PG8_STAGE(PG8_SB(0, 0), b2, voffB);
            PG8_BAR; PG8_WAIT_L(0); PG8_MMA(0, 1, At, B1); PG8_BAR;
            PG8_LDA(At, 0, 1); PG8_STAGE(PG8_SA(0, 0), a2, voffA);
            PG8_BAR; PG8_WAIT_L(0); PG8_MMA(1, 0, At, B0); PG8_BAR; PG8_SCHED;
            PG8_STAGE(PG8_SB(0, 1), b2 + hstep, voffB);
            PG8_WAIT_V(6); PG8_BAR; PG8_MMA(1, 1, At, B1); PG8_BAR;
            PG8_LDB(B0, 1, 0); PG8_SCHED; PG8_LDA(At, 1, 0); PG8_STAGE(PG8_SA(0, 1), a2 + hstep, voffA);
            PG8_WAIT_L(8); PG8_BAR; PG8_WAIT_L(0); PG8_MMA(0, 0, At, B0); PG8_BAR; PG8_SCHED;
            PG8_LDB(B1, 1, 1); PG8_STAGE(PG8_SB(1, 0), b3, voffB);
            PG8_BAR; PG8_WAIT_L(0); PG8_MMA(0, 1, At, B1); PG8_BAR;
            PG8_LDA(At, 1, 1); PG8_STAGE(PG8_SA(1, 0), a3, voffA);
            PG8_BAR; PG8_WAIT_L(0); PG8_MMA(1, 0, At, B0); PG8_BAR; PG8_SCHED;
            PG8_STAGE(PG8_SB(1, 1), b3 + hstep, voffB);
            PG8_WAIT_V(6); PG8_BAR; PG8_MMA(1, 1, At, B1); PG8_BAR;
            }
        }
        if constexpr (ALIGN_EPI) { if (wr == 0) PG8_BAR; }
        if constexpr (!Epi::AFTER_DRAIN) { E(acc, cur, wr, wc, fr, fq); S.done(cur); }
        if (!has_next) break;
#pragma unroll
        for (int a = 0; a < 2; ++a)
#pragma unroll
            for (int b = 0; b < 2; ++b)
#pragma unroll
                for (int m = 0; m < 4; ++m)
#pragma unroll
                    for (int n = 0; n < 2; ++n) acc[a][b][m][n] = (f32x4){0.f, 0.f, 0.f, 0.f};
        cur = nxt; cA = nA; cB = nB; ++ui;
        if constexpr (ALIGN_EPI) { if (wr == 1) PG8_BAR; }
    }
    PG8_WAIT_V(0);
    if constexpr (!ALIGN_EPI) { if (wr == 0) PG8_BAR; }
    PG8_BAR;
    if constexpr (Epi::AFTER_DRAIN) { E.fused(acc, cur, wr, wc, fr, fq, lds, wid, lane); S.done(cur); }
#undef PG8_SA
#undef PG8_SB
#undef PG8_STAGE
#undef PG8_LDA
#undef PG8_LDB
#undef PG8_MMA
#undef PG8_WAIT_V
#undef PG8_WAIT_L
#undef PG8_BAR
#undef PG8_SCHED
}
}

#ifndef MK_PER_PHASE
#define MK_PER_PHASE 0
#endif
constexpr int NWAVES = 8;
constexpr int DM = 1024, NB = 32, SEQ = 2048, NL = 4, MT = NB * SEQ;
constexpr int D_IN = 3976, NPI = 4096, DFF = 2816, NF1 = 2 * DFF;
constexpr int RW_B = 1024, ML_B = 2432;
constexpr int RWKV_IN = 1408;
constexpr float RMS_EPS = 1e-6f, GN_EPS = 1e-5f;
constexpr int MODP = 6 * DM;
constexpr size_t MiB = 1u << 20;
constexpr size_t WS_CTL = 0, CTL_ZERO_BYTES = 1 * MiB;
constexpr size_t WS_HS = 116 * MiB;
constexpr int CW_PCNT = 32768, PCNT_BANK = 256 * 64;
constexpr int CW_FLAG = 16384;
constexpr size_t WS_WL = 5 * MiB;
constexpr size_t WS_MOD = 1 * MiB;
constexpr size_t WS_WIN = 8 * MiB, WS_WOUT = 40 * MiB, WS_WF1 = 48 * MiB, WS_WF2 = 92 * MiB;
constexpr size_t WS_H = 128 * MiB;
constexpr size_t WS_PROJ = 256 * MiB;
constexpr size_t WS_XFIN = (256 + 352) * MiB;
constexpr size_t WS_DEC = 768 * MiB, WS_AA = 864 * MiB, WS_GG = 912 * MiB;
constexpr size_t WS_END = 960 * MiB;
constexpr int CW_BAR = 4096;
constexpr int N_PHASES = 3 + 6 * NL;
static_assert((CW_BAR + (MK_PER_PHASE ? 1 : 1) * 3456) * 4 <= (int)CTL_ZERO_BYTES, "ctl");
constexpr int RING_BYTES = 131072, LDS_BYTES = 163840, LDSCTL_OFF = LDS_BYTES - 1024, MISC_OFF = LDSCTL_OFF + 320;

#define GAS __attribute__((address_space(1)))
#define LAS __attribute__((address_space(3)))
typedef unsigned short bf16;
typedef unsigned v4u __attribute__((ext_vector_type(4)));
typedef unsigned v2u __attribute__((ext_vector_type(2)));
typedef float f32x4 __attribute__((ext_vector_type(4)));
#define LDS_WAIT() asm volatile("s_waitcnt lgkmcnt(0)" ::: "memory")
typedef float f32x2c __attribute__((ext_vector_type(2)));
typedef __bf16 bf16x2c __attribute__((ext_vector_type(2)));
__device__ __forceinline__ unsigned f2bf(float f) { return (__builtin_bit_cast(unsigned, f) + 0x8000u) >> 16; }
__device__ __forceinline__ unsigned pk2(float lo, float hi) { return __builtin_amdgcn_perm(__builtin_bit_cast(unsigned, hi) + 0x8000u, __builtin_bit_cast(unsigned, lo) + 0x8000u, 0x07060302u); }
__device__ __forceinline__ float bf2f(bf16 v) { return __uint_as_float(((unsigned)v) << 16); }
template <int CTRL, int ROWMASK> __device__ __forceinline__ float dppf(float v) { return __builtin_bit_cast(float, __builtin_amdgcn_update_dpp(0, __builtin_bit_cast(int, v), CTRL, ROWMASK, 0xf, false)); }
__device__ __forceinline__ float sum16(float v) { v += dppf<0xB1, 0xf>(v); v += dppf<0x4E, 0xf>(v); v += dppf<0x141, 0xf>(v); v += dppf<0x140, 0xf>(v); return v; }
__device__ __forceinline__ float wave_sum(float v) { v = sum16(v); v += dppf<0x142, 0xa>(v); v += dppf<0x143, 0xc>(v); return __builtin_bit_cast(float, __builtin_amdgcn_readlane(__builtin_bit_cast(int, v), 63)); }
template <int CTRL, int ROWMASK> __device__ __forceinline__ float dppo(float v, float old) { return __builtin_bit_cast(float, __builtin_amdgcn_update_dpp(__builtin_bit_cast(int, old), __builtin_bit_cast(int, v), CTRL, ROWMASK, 0xf, false)); }
__device__ __forceinline__ float wave_prefix_sum(float v) { v += dppo<0x111, 0xf>(v, 0.f); v += dppo<0x112, 0xf>(v, 0.f); v += dppo<0x114, 0xf>(v, 0.f); v += dppo<0x118, 0xf>(v, 0.f); v += dppo<0x142, 0xa>(v, 0.f); v += dppo<0x143, 0xc>(v, 0.f); return v; }
__device__ __forceinline__ float wave_prefix_max(float v) { const float ni = -__builtin_inff(); v = fmaxf(v, dppo<0x111, 0xf>(v, ni)); v = fmaxf(v, dppo<0x112, 0xf>(v, ni)); v = fmaxf(v, dppo<0x114, 0xf>(v, ni)); v = fmaxf(v, dppo<0x118, 0xf>(v, ni));
    v = fmaxf(v, dppo<0x142, 0xa>(v, ni)); v = fmaxf(v, dppo<0x143, 0xc>(v, ni)); return v; }
__device__ __forceinline__ float flogsigmoid(float x) { return fminf(x, 0.f) - __logf(1.0f + __expf(-fabsf(x))); }
__device__ __forceinline__ float fexp(float x) { return __expf(x); }
__device__ __forceinline__ float fsigmoid(float x) { return __builtin_amdgcn_rcpf(1.0f + __expf(-x)); }
__device__ __forceinline__ float sigmoid_f(float x) { return 1.0f / (1.0f + expf(-x)); }
__device__ __forceinline__ float logsigmoid_f(float x) { return fminf(x, 0.f) - log1pf(expf(-fabsf(x))); }
template <class T> __device__ __forceinline__ T* opq(T* p) { asm volatile("" : "+s"(p)); return p; }

#define XB_TMO      128
#define XB_XCNT(j)  (256  + 64 * (j))
#define XB_XSUB(j)  (1280 + 64 * (j))
#define XB_XGEN(j)  (2304 + 64 * (j))
#define XB_TOP      3328
#define XB_TOPGEN   3392
#define XCD_BAR_WORDS 3456
#define XB_SPIN_CAP (1u << 22)

__device__ __forceinline__ unsigned xb_ld(unsigned* p)              { return __hip_atomic_load(p, __ATOMIC_RELAXED, __HIP_MEMORY_SCOPE_AGENT); }
__device__ __forceinline__ unsigned xb_add(unsigned* p, unsigned v) { return __hip_atomic_fetch_add(p, v, __ATOMIC_RELAXED, __HIP_MEMORY_SCOPE_AGENT); }
__device__ __forceinline__ unsigned xb_xcc_id() { return (unsigned)__builtin_amdgcn_s_getreg((3 << 11) | 20) & 0xFu; }
#define XB_SPIN(cond, bar) do { unsigned _sp = 0; while (cond) { __builtin_amdgcn_s_sleep(1); \
    if ((++_sp & 255u) == 0u) { if (xb_ld(&(bar)[XB_TMO])) break; if (_sp > XB_SPIN_CAP) { atomicAdd(&(bar)[XB_TMO], 1u); break; } } } } while (0)

struct XcdBarrier {
    unsigned* bar; unsigned x; unsigned w0;
    volatile LAS unsigned* st;
};

__device__ __forceinline__ XcdBarrier xcd_barrier_post(unsigned* bar, volatile LAS unsigned* st) {
    XcdBarrier b; b.bar = bar; b.x = xb_xcc_id(); b.st = st; b.w0 = (__builtin_amdgcn_readfirstlane((int)threadIdx.x >> 6) == 0) ? 1u : 0u;
    if (threadIdx.x == 0) (void)xb_add(&bar[XB_XCNT(b.x)], 1u);
    return b;
}
__device__ __forceinline__ void xcd_barrier_complete(unsigned* bar, unsigned x, unsigned& nloc, unsigned& nx) {
    const unsigned G = gridDim.x * gridDim.y * gridDim.z;
    unsigned sum, cnt, mine, sp = 0u;
    for (;;) {
        sum = 0u; cnt = 0u; mine = 0u;
#pragma unroll
        for (unsigned j = 0; j < 16; ++j) { const unsigned c = xb_ld(&bar[XB_XCNT(j)]); sum += c; cnt += (c > 0u) ? 1u : 0u; mine = (j == x) ? c : mine; }
        if (sum == G) break;
        __builtin_amdgcn_s_sleep(1);
        if ((++sp & 255u) == 0u) { if (xb_ld(&bar[XB_TMO])) break; if (sp > XB_SPIN_CAP) { atomicAdd(&bar[XB_TMO], 1u); break; } }
    }
    nloc = mine > 0u ? mine : 1u; nx = cnt > 0u ? cnt : 1u;
}

__device__ __forceinline__ void xcd_barrier(const XcdBarrier& b) {
    asm volatile("s_waitcnt vmcnt(0)" ::: "memory");
    __syncthreads();
    if (b.w0 != 0u && lane_id_opq() == 0) {
        unsigned* bar = b.bar;
        __builtin_amdgcn_s_waitcnt(0);
        unsigned nloc = b.st[0], nx = b.st[1];
        if (nloc == 0u) { xcd_barrier_complete(bar, b.x, nloc, nx); b.st[0] = nloc; b.st[1] = nx; }
        const unsigned old = xb_add(&bar[XB_XSUB(b.x)], 1u);
        const unsigned gen = old / nloc;
        if (old + 1u == (gen + 1u) * nloc) {
            __builtin_amdgcn_fence(__ATOMIC_RELEASE, "agent");
            asm volatile("s_waitcnt vmcnt(0)" ::: "memory");
            const unsigned og = xb_add(&bar[XB_TOP], 1u);
            const unsigned tg = og / nx;
            if (og + 1u == (tg + 1u) * nx) xb_add(&bar[XB_TOPGEN], 1u);
            else XB_SPIN(xb_ld(&bar[XB_TOPGEN]) == tg, bar);
            __builtin_amdgcn_fence(__ATOMIC_ACQUIRE, "agent");
            xb_add(&bar[XB_XGEN(b.x)], 1u);
            asm volatile("s_waitcnt vmcnt(0)" ::: "memory");
        } else {
            XB_SPIN(xb_ld(&bar[XB_XGEN(b.x)]) == gen, bar);
            __builtin_amdgcn_fence(__ATOMIC_ACQUIRE, "agent");
            asm volatile("s_waitcnt vmcnt(0)" ::: "memory");
        }
    }
    __syncthreads();
}


__device__ __forceinline__ void b32_gemv(const float* Wcol  , bool ok, int N, LAS float* vT, float (&res)[4], int wave, int lane) {
    float acc[32];
#pragma unroll
    for (int b = 0; b < 32; ++b) acc[b] = 0.f;
    const float* wp = Wcol + (size_t)(128 * wave) * N; const LAS float* vp = vT + 128 * wave * 32;
#pragma unroll 1
    for (int kk = 0; kk < 128; kk += 8) {
        float w[8];
#pragma unroll
        for (int u = 0; u < 8; ++u) w[u] = ok ? wp[(size_t)u * N] : 0.f;
        wp += (size_t)8 * N;
#pragma unroll
        for (int u = 0; u < 8; ++u) {
#pragma unroll
            for (int b4 = 0; b4 < 8; ++b4) { const f32x4 cv = *(const LAS f32x4*)(vp + u * 32 + 4 * b4);
                acc[4 * b4] += cv.x * w[u]; acc[4 * b4 + 1] += cv.y * w[u]; acc[4 * b4 + 2] += cv.z * w[u]; acc[4 * b4 + 3] += cv.w * w[u]; }
            asm volatile("" ::: "memory"); }
        vp += 8 * 32;
    }
    __syncthreads();
#pragma unroll
    for (int b = 0; b < 32; ++b) vT[(wave * 32 + b) * 64 + lane] = acc[b];
    __syncthreads();
#pragma unroll
    for (int q = 0; q < 4; ++q) { float s = 0.f;
#pragma unroll
        for (int w2 = 0; w2 < 8; ++w2) s += vT[(w2 * 32 + 4 * wave + q) * 64 + lane];
        res[q] = s; }
    __syncthreads();
}
__device__ __forceinline__ void p0_mod(const float* c, const float* ada_w, const float* ada_b, float* mod, LAS unsigned char* lds, int tid, int lane, int wave) {
    LAS float* condT = (LAS float*)lds;
    for (int item = blockIdx.x; item < NL * 96; item += gridDim.x) {
        __syncthreads();
        for (int e = tid; e < NB * DM; e += NWAVES * 64) { const int k = e >> 5, b = e & 31; const float v = c[b * DM + k]; condT[e] = v / (1.0f + expf(-v)); }
        __syncthreads();
        const int l = item / 96, g = item % 96, n = g * 64 + lane;
        float res[4]; b32_gemv(ada_w + (size_t)l * DM * MODP + n, true, MODP, condT, res, wave, lane);
        const float bb = ada_b[l * MODP + n]; float* o = mod + ((size_t)l * NB + wave * 4) * MODP + n;
        o[0] = res[0] + bb; o[MODP] = res[1] + bb; o[2 * MODP] = res[2] + bb; o[3 * MODP] = res[3] + bb;
    }
    __syncthreads();
}
template <int MODE>
__device__ __forceinline__ void transpose_item(const float* W, int K, int N, int nblk, bf16* WT, int ldw, LAS float* scr, int item, int lane) {
    const int kb = item / nblk, nb = item % nblk, k0 = 64 * kb, n0 = 32 * nb;
    const int nq = lane & 7, nn = n0 + 4 * nq; const bool ok = nn < N;
#pragma unroll
    for (int i = 0; i < 8; ++i) { const int kk = 8 * i + (lane >> 3); f32x4 v = (f32x4){0.f, 0.f, 0.f, 0.f}; if (ok) v = *(const f32x4*)(W + (size_t)(k0 + kk) * N + nn);
        LAS float* d = scr + kk * 33 + 4 * nq; d[0] = v.x; d[1] = v.y; d[2] = v.z; d[3] = v.w; }
    LDS_WAIT();
    const int c = lane & 7;
#pragma unroll
    for (int j = 0; j < 4; ++j) { const int n = (lane >> 3) + 8 * j; const LAS float* s = scr + (8 * c) * 33 + n;
        v4u o; o.x = pk2(s[0 * 33], s[1 * 33]); o.y = pk2(s[2 * 33], s[3 * 33]); o.z = pk2(s[4 * 33], s[5 * 33]); o.w = pk2(s[6 * 33], s[7 * 33]);
        int row = n0 + n;
        if (MODE == 1) { const int up = row >= DFF ? 1 : 0, jj = row - up * DFF; row = (jj >> 7) * 256 + up * 128 + (jj & 127); }
        *(v4u*)(WT + (size_t)row * ldw + k0 + 8 * c) = o; }
    LDS_WAIT();
}
__device__ __forceinline__ void p0_weights(const float* w_in, const float* w_out, const float* f1, const float* f2, const float* lw2, const float* la2, const float* lg2, unsigned char* ws, LAS unsigned char* lds, int gw, int ngw, int wave, int lane) {
    LAS float* scr = (LAS float*)(lds + wave * 16384);
    constexpr int I_IN = (DM / 64) * (NPI / 32), I_OUT = (DM / 64) * (DM / 32), I_F1 = (DM / 64) * (NF1 / 32), I_F2 = (DFF / 64) * (DM / 32), I_L = I_IN + I_OUT + I_F1 + I_F2 + 48;
    for (int it = gw; it < NL * I_L; it += ngw) {
        const int l = it / I_L; int r = it % I_L;
        if (r < I_IN) { transpose_item<0>(w_in + (size_t)l * DM * D_IN, DM, D_IN, NPI / 32, (bf16*)(ws + WS_WIN) + (size_t)l * NPI * DM, DM, scr, r, lane); continue; } r -= I_IN;
        if (r < I_OUT) { transpose_item<0>(w_out + (size_t)l * DM * DM, DM, DM, DM / 32, (bf16*)(ws + WS_WOUT) + (size_t)l * DM * DM, DM, scr, r, lane); continue; } r -= I_OUT;
        if (r < I_F1) { transpose_item<1>(f1 + (size_t)l * DM * NF1, DM, NF1, NF1 / 32, (bf16*)(ws + WS_WF1) + (size_t)l * NF1 * DM, DM, scr, r, lane); continue; } r -= I_F1;
        if (r < I_F2) { transpose_item<0>(f2 + (size_t)l * DFF * DM, DFF, DM, DM / 32, (bf16*)(ws + WS_WF2) + (size_t)l * DM * DFF, DFF, scr, r, lane); continue; } r -= I_F2;
        bf16* wl = (bf16*)(ws + WS_WL) + (size_t)l * 384 * 256;
        if (r < 12) { transpose_item<0>(lw2 + (size_t)l * 64 * 384, 64, 384, 12, wl, 256, scr, r, lane); continue; } r -= 12;
        if (r < 12) { transpose_item<0>(la2 + (size_t)l * 64 * 384, 64, 384, 12, wl + 64, 256, scr, r, lane); continue; } r -= 12;
        transpose_item<0>(lg2 + (size_t)l * 128 * 384, 128, 384, 12, wl + 128, 256, scr, r, lane);
    }
}
__device__ __forceinline__ void norm_mod_phase(const float* xin32, const bf16* xs, const float* gain, const float* modl, int sh_off, int sc_off, bf16* out, int gw, int ngw, int lane) {
    for (int ci = gw; ci < MT / 32; ci += ngw) {
        const int b = ci >> 6; const float* mb = modl + (size_t)b * MODP;
        f32x4 gs[4], sh[4];
#pragma unroll
        for (int j = 0; j < 4; ++j) { const int col = 4 * lane + 256 * j; const f32x4 g = *(const f32x4*)(gain + col), s = *(const f32x4*)(mb + sc_off + col); gs[j] = g * (s + 1.0f); sh[j] = *(const f32x4*)(mb + sh_off + col); }
        for (int r = 0; r < 32; ++r) {
            const size_t row = (size_t)ci * 32 + r;
            f32x4 v[4]; float ss = 0.f;
            if (xin32) { const f32x4* xr = (const f32x4*)(xin32 + row * DM) + lane;
#pragma unroll
                for (int j = 0; j < 4; ++j) v[j] = xr[64 * j];
            } else { const v2u* xr = (const v2u*)(xs + row * DM) + lane;
#pragma unroll
                for (int j = 0; j < 4; ++j) { const v2u w = xr[64 * j]; v[j] = (f32x4){__uint_as_float(w.x << 16), __uint_as_float(w.x & 0xffff0000u), __uint_as_float(w.y << 16), __uint_as_float(w.y & 0xffff0000u)}; } }
#pragma unroll
            for (int j = 0; j < 4; ++j) ss += (v[j].x * v[j].x + v[j].y * v[j].y) + (v[j].z * v[j].z + v[j].w * v[j].w);
            const float rstd = 1.0f / sqrtf(wave_sum(ss) * (1.0f / DM) + RMS_EPS);
            v2u* o8 = (v2u*)(out + row * DM) + lane;
#pragma unroll
            for (int j = 0; j < 4; ++j) { const f32x4 y = v[j] * rstd * gs[j] + sh[j]; v2u w; w.x = pk2(y.x, y.y); w.y = pk2(y.z, y.w); o8[64 * j] = w; }
        }
    }
}
__device__ __forceinline__ void final_norm_phase(const bf16* xs, float* out, const float* gain, int gw, int ngw, int lane) {
    f32x4 g[4];
#pragma unroll
    for (int j = 0; j < 4; ++j) g[j] = *(const f32x4*)(gain + 4 * lane + 256 * j);
    for (int row = gw; row < MT; row += ngw) {
        const v2u* xr = (const v2u*)(xs + (size_t)row * DM) + lane; f32x4 v[4]; float ss = 0.f;
#pragma unroll
        for (int j = 0; j < 4; ++j) { const v2u w = xr[64 * j]; v[j] = (f32x4){__uint_as_float(w.x << 16), __uint_as_float(w.x & 0xffff0000u), __uint_as_float(w.y << 16), __uint_as_float(w.y & 0xffff0000u)};
            ss += (v[j].x * v[j].x + v[j].y * v[j].y) + (v[j].z * v[j].z + v[j].w * v[j].w); }
        const float rstd = 1.0f / sqrtf(wave_sum(ss) * (1.0f / DM) + RMS_EPS);
        f32x4* o = (f32x4*)(out + (size_t)row * DM) + lane;
#pragma unroll
        for (int j = 0; j < 4; ++j) o[64 * j] = v[j] * rstd * g[j];
    }
}
__device__ __forceinline__ void panel_norm_rows(const bf16* xs, const float* gain, const float* modb, int sh_off, int sc_off, bf16* out, int pm, int wave, int lane) {
    f32x4 gs[4], sh[4];
#pragma unroll
    for (int j = 0; j < 4; ++j) { const int col = 4 * lane + 256 * j; const f32x4 g = *(const f32x4*)(gain + col), s = *(const f32x4*)(modb + sc_off + col); gs[j] = g * (s + 1.0f); sh[j] = *(const f32x4*)(modb + sh_off + col); }
#pragma unroll 1
    for (int r = 0; r < 32; r += 2) {
        const size_t row = (size_t)pm * 256 + wave * 32 + r;
        const v2u* xr = (const v2u*)(xs + row * DM) + lane; v2u w0[4], w1[4];
#pragma unroll
        for (int j = 0; j < 4; ++j) { w0[j] = xr[64 * j]; w1[j] = xr[64 * j + DM / 4]; }
#pragma unroll
        for (int q = 0; q < 2; ++q) { f32x4 v[4]; float ss = 0.f;
#pragma unroll
            for (int j = 0; j < 4; ++j) { const v2u w = q ? w1[j] : w0[j]; v[j] = (f32x4){__uint_as_float(w.x << 16), __uint_as_float(w.x & 0xffff0000u), __uint_as_float(w.y << 16), __uint_as_float(w.y & 0xffff0000u)};
                ss += (v[j].x * v[j].x + v[j].y * v[j].y) + (v[j].z * v[j].z + v[j].w * v[j].w); }
            const float rstd = __builtin_amdgcn_rsqf(wave_sum(ss) * (1.0f / DM) + RMS_EPS);
            v2u* o8 = (v2u*)(out + (row + q) * DM) + lane;
#pragma unroll
            for (int j = 0; j < 4; ++j) { const f32x4 y = v[j] * rstd * gs[j] + sh[j]; v2u w; w.x = pk2(y.x, y.y); w.y = pk2(y.z, y.w); o8[64 * j] = w; } }
    }
}
template <class Sched>
__device__ __forceinline__ void fused_panel_norm(const Sched& S, unsigned* cnt, const bf16* xs, const float* gain, const float* modl, int sh_off, int sc_off, bf16* out, int wave, int lane) {
    pg8::Unit u[4]; bool has[4];
#pragma unroll
    for (int i = 0; i < 4; ++i) has[i] = S.next(i, u[i]);
    if (wave == 0 && lane == 0) {
        __builtin_amdgcn_fence(__ATOMIC_RELEASE, "agent"); asm volatile("s_waitcnt vmcnt(0)" ::: "memory");
#pragma unroll
        for (int i = 0; i < 4; ++i) if (has[i]) __hip_atomic_fetch_add(cnt + 64 * u[i].pm, 1u, __ATOMIC_RELAXED, __HIP_MEMORY_SCOPE_AGENT);
    }
#pragma unroll
    for (int i = 0; i < 4; ++i) {
        if (!has[i] || u[i].pn != ((u[i].pm >> 3) & 3)) continue;
        if (wave == 0) { unsigned spins = 0u;
            while (__hip_atomic_load(cnt + 64 * u[i].pm, __ATOMIC_RELAXED, __HIP_MEMORY_SCOPE_AGENT) < 4u) { __builtin_amdgcn_s_sleep(2); if (++spins > (1u << 22)) break; }
            __builtin_amdgcn_fence(__ATOMIC_ACQUIRE, "agent"); asm volatile("s_waitcnt vmcnt(0)" ::: "memory"); }
        __syncthreads();
        panel_norm_rows(xs, gain, modl + (size_t)(u[i].pm >> 3) * MODP, sh_off, sc_off, out, u[i].pm, wave, lane);
    }
}
#define WG_BAR() do { asm volatile("s_waitcnt vmcnt(0) lgkmcnt(0)" ::: "memory"); __builtin_amdgcn_s_barrier(); asm volatile("" ::: "memory"); } while (0)
#define WG_BAR_L() do { asm volatile("s_waitcnt lgkmcnt(0)" ::: "memory"); __builtin_amdgcn_s_barrier(); asm volatile("" ::: "memory"); } while (0)
typedef short bf16x8p __attribute__((ext_vector_type(8)));
__device__ __forceinline__ void rwkv_prep_mfma(const bf16* proj, const float* mu, const float* w0, const float* a0, const bf16* WL, float* DEC, bf16* AA, bf16* GG, LAS unsigned char* lds, int wave) {
    constexpr int AP = 264;
    LAS bf16* act = (LAS bf16*)lds;
#pragma unroll 1
    for (int item = blockIdx.x; item < MT / 64; item += gridDim.x) {
        const int lane = lane_id_opq(), tid = wave * 64 + lane, q4 = lane >> 4, lc = lane & 15;
        const size_t m0 = (size_t)item * 64; const int t0 = (int)(m0 % SEQ);
        { const int tt = tid >> 3, cg = tid & 7; const bf16* p = proj + (m0 + tt) * NPI + RW_B + 1152 + 32 * cg; const bool hp = (t0 + tt) > 0; const float* mup = mu + 1152 + 32 * cg;
#pragma unroll
          for (int v = 0; v < 4; ++v) { const v4u cur = *(const v4u*)(p + 8 * v); v4u prv = (v4u){0u, 0u, 0u, 0u}; if (hp) prv = *(const v4u*)(p - NPI + 8 * v);
              const f32x4 m0v = *(const f32x4*)(mup + 8 * v), m1v = *(const f32x4*)(mup + 8 * v + 4);
              float x[8];
#pragma unroll
              for (int e = 0; e < 4; ++e) { const unsigned cw = cur[e], pw = prv[e]; const float c0 = __uint_as_float(cw << 16), c1 = __uint_as_float(cw & 0xffff0000u), p0 = __uint_as_float(pw << 16), p1 = __uint_as_float(pw & 0xffff0000u);
                  const float mu0 = e < 2 ? m0v[2 * e] : m1v[2 * e - 4], mu1 = e < 2 ? m0v[2 * e + 1] : m1v[2 * e - 3];
                  x[2 * e] = c0 + (p0 - c0) * mu0; x[2 * e + 1] = c1 + (p1 - c1) * mu1; }
              if (cg < 2) {
#pragma unroll
                  for (int e = 0; e < 8; ++e) x[e] = 2.0f * fsigmoid(2.0f * x[e]) - 1.0f;
              } else if (cg >= 4) {
#pragma unroll
                  for (int e = 0; e < 8; ++e) x[e] = fsigmoid(x[e]);
              }
              v4u o; o.x = pk2(x[0], x[1]); o.y = pk2(x[2], x[3]); o.z = pk2(x[4], x[5]); o.w = pk2(x[6], x[7]);
              *(LAS v4u*)(act + tt * AP + 32 * cg + 8 * v) = o; } }
        WG_BAR_L();
        const LAS bf16* afr = act + lc * AP + 8 * q4;
        const bf16* bfr = WL + (size_t)(48 * wave + lc) * 256 + 8 * q4;
        { f32x4 acc[4][3];
#pragma unroll
          for (int mt = 0; mt < 4; ++mt)
#pragma unroll
              for (int nt = 0; nt < 3; ++nt) acc[mt][nt] = (f32x4){0.f, 0.f, 0.f, 0.f};
#pragma unroll
          for (int ks = 0; ks < 2; ++ks) { bf16x8p bq[3];
#pragma unroll
              for (int nt = 0; nt < 3; ++nt) bq[nt] = *(const bf16x8p*)(bfr + 16 * nt * 256 + 32 * ks);
#pragma unroll
              for (int mt = 0; mt < 4; ++mt) { const bf16x8p aq = *(const LAS bf16x8p*)(afr + 16 * mt * AP + 32 * ks);
#pragma unroll
                  for (int nt = 0; nt < 3; ++nt) acc[mt][nt] = __builtin_amdgcn_mfma_f32_16x16x32_bf16(aq, bq[nt], acc[mt][nt], 0, 0, 0); } }
#pragma unroll
          for (int nt = 0; nt < 3; ++nt) { const int n = 48 * wave + 16 * nt + lc; const float w0n = w0[n]; float carry = 0.f;
#pragma unroll
              for (int mt = 0; mt < 4; ++mt) { float pr[4];
#pragma unroll
                  for (int r = 0; r < 4; ++r) { const float ld = -0.60653066f * fsigmoid(w0n + acc[mt][nt][r]); pr[r] = r ? pr[r - 1] + ld : ld; }
                  const float tot = pr[3]; float s1 = tot; { const float u = __shfl_up(s1, 16); if (q4 >= 1) s1 += u; } { const float u = __shfl_up(s1, 32); if (q4 >= 2) s1 += u; }
                  const float excl = carry + (s1 - tot), tile_tot = __shfl(s1, 48 + lc);
                  float* dp = DEC + (m0 + 16 * mt + 4 * q4) * 384 + n;
#pragma unroll
                  for (int r = 0; r < 4; ++r) dp[r * 384] = excl + pr[r];
                  carry += tile_tot; } } }
        { f32x4 acc[4][3];
#pragma unroll
          for (int mt = 0; mt < 4; ++mt)
#pragma unroll
              for (int nt = 0; nt < 3; ++nt) acc[mt][nt] = (f32x4){0.f, 0.f, 0.f, 0.f};
#pragma unroll
          for (int ks = 0; ks < 2; ++ks) { bf16x8p bq[3];
#pragma unroll
              for (int nt = 0; nt < 3; ++nt) bq[nt] = *(const bf16x8p*)(bfr + 16 * nt * 256 + 64 + 32 * ks);
#pragma unroll
              for (int mt = 0; mt < 4; ++mt) { const bf16x8p aq = *(const LAS bf16x8p*)(afr + 16 * mt * AP + 64 + 32 * ks);
#pragma unroll
                  for (int nt = 0; nt < 3; ++nt) acc[mt][nt] = __builtin_amdgcn_mfma_f32_16x16x32_bf16(aq, bq[nt], acc[mt][nt], 0, 0, 0); } }
#pragma unroll
          for (int nt = 0; nt < 3; ++nt) { const int n = 48 * wave + 16 * nt + lc; const float a0n = a0[n];
#pragma unroll
              for (int mt = 0; mt < 4; ++mt) { bf16* dp = AA + (m0 + 16 * mt + 4 * q4) * 384 + n;
#pragma unroll
                  for (int r = 0; r < 4; ++r) dp[r * 384] = (bf16)f2bf(fsigmoid(a0n + acc[mt][nt][r])); } } }
        { f32x4 acc[4][3];
#pragma unroll
          for (int mt = 0; mt < 4; ++mt)
#pragma unroll
              for (int nt = 0; nt < 3; ++nt) acc[mt][nt] = (f32x4){0.f, 0.f, 0.f, 0.f};
#pragma unroll
          for (int ks = 0; ks < 4; ++ks) { bf16x8p bq[3];
#pragma unroll
              for (int nt = 0; nt < 3; ++nt) bq[nt] = *(const bf16x8p*)(bfr + 16 * nt * 256 + 128 + 32 * ks);
#pragma unroll
              for (int mt = 0; mt < 4; ++mt) { const bf16x8p aq = *(const LAS bf16x8p*)(afr + 16 * mt * AP + 128 + 32 * ks);
#pragma unroll
                  for (int nt = 0; nt < 3; ++nt) acc[mt][nt] = __builtin_amdgcn_mfma_f32_16x16x32_bf16(aq, bq[nt], acc[mt][nt], 0, 0, 0); } }
#pragma unroll
          for (int nt = 0; nt < 3; ++nt) { const int n = 48 * wave + 16 * nt + lc;
#pragma unroll
              for (int mt = 0; mt < 4; ++mt) { bf16* dp = GG + (m0 + 16 * mt + 4 * q4) * 384 + n;
#pragma unroll
                  for (int r = 0; r < 4; ++r) dp[r * 384] = (bf16)f2bf(acc[mt][nt][r]); } } }
        WG_BAR_L();
    }
}
typedef short bf16x8_t __attribute__((ext_vector_type(8)));
template <int KS>
__device__ __forceinline__ f32x4 mm_tile(const LAS bf16* A, const LAS bf16* B, f32x4 acc) {
#pragma unroll
    for (int ks = 0; ks < KS; ++ks) {
        const bf16x8_t a = *(const LAS bf16x8_t*)(A + ks * 32), b = *(const LAS bf16x8_t*)(B + ks * 32);
        acc = __builtin_amdgcn_mfma_f32_16x16x32_bf16(a, b, acc, 0, 0, 0);
    }
    return acc;
}
__device__ __forceinline__ unsigned short f2bf16(float f) { return (unsigned short)f2bf(f); }
constexpr int LP = 72;
constexpr int LPM = 104;

__device__ __forceinline__ void ret_unit(int b, int h, const bf16* proj, const float* gn, bf16* mixed, LAS unsigned char* lds, int wave, int lane0) {
    LAS bf16* Qs = (LAS bf16*)lds; LAS bf16* Ks = Qs + 64 * LP; LAS bf16* Kdt = Ks + 64 * LP; LAS bf16* Vt = Kdt + 64 * LP; LAS bf16* Ps = Vt + 64 * LP; LAS bf16* Stt = Ps + 64 * LP; LAS bf16* Gs = Stt + 64 * LP;
    const int lane = lane0, q4 = lane >> 4, lc = lane & 15;
    const float inv = powf(10000.0f, -(float)(2 * (lane & 31)) / 64.0f);
    float cs[8], sn[8];
#pragma unroll
    for (int i = 0; i < 8; ++i) __sincosf((float)(8 * wave + i) * inv, &sn[i], &cs[i]);
    float c64, s64; sincosf(64.0f * inv, &s64, &c64);
    const float lg2 = log2f(1.0f - exp2f(-5.0f - (float)h));
    float kdec[8];
#pragma unroll
    for (int i = 0; i < 8; ++i) kdec[i] = exp2f((float)(63 - (8 * wave + i)) * lg2);
    const float cd = exp2f(64.0f * lg2);
    f32x4 st[4];
#pragma unroll
    for (int i = 0; i < 4; ++i) st[i] = (f32x4){0.f, 0.f, 0.f, 0.f};
    for (int i = wave * 64 + lane; i < 64 * LP / 2; i += 512) ((LAS unsigned*)Stt)[i] = 0u;
    const size_t m0 = (size_t)b * SEQ;
    const bf16* P0 = proj + m0 * NPI + h * 64;
    unsigned short rq[8], rk[8], rv[8], rg[8];
#pragma unroll
    for (int i = 0; i < 8; ++i) { const bf16* p = P0 + (size_t)(8 * wave + i) * NPI; rq[i] = p[lane]; rk[i] = p[256 + lane]; rv[i] = p[512 + lane]; rg[i] = p[768 + lane]; }
    float gain4[4];
#pragma unroll
    for (int ct = 0; ct < 4; ++ct) gain4[ct] = gn[h * 64 + 16 * ct + lc];
#pragma unroll 1
    for (int c = 0; c < SEQ / 64; ++c) {
        const int lane = lane_id_opq(), q4 = lane >> 4, lc = lane & 15, o72 = lc * LP + 8 * q4;
        { unsigned short kd[8];
#pragma unroll
          for (int i = 0; i < 8; ++i) { const int tt = 8 * wave + i;
              const float q = bf2f(rq[i]), k = bf2f(rk[i]); const float qp = __shfl_xor(q, 32), kp = __shfl_xor(k, 32);
              const float qr = lane < 32 ? q * cs[i] - qp * sn[i] : qp * sn[i] + q * cs[i];
              const float kr = (lane < 32 ? k * cs[i] - kp * sn[i] : kp * sn[i] + k * cs[i]) * 0.125f;
              Qs[tt * LP + lane] = f2bf16(qr); Ks[tt * LP + lane] = f2bf16(kr); Gs[tt * LP + lane] = rg[i]; kd[i] = f2bf16(kr * kdec[i]);
              const float cn = cs[i] * c64 - sn[i] * s64, snn = sn[i] * c64 + cs[i] * s64; cs[i] = cn; sn[i] = snn; }
          v4u w; w.x = kd[0] | ((unsigned)kd[1] << 16); w.y = kd[2] | ((unsigned)kd[3] << 16); w.z = kd[4] | ((unsigned)kd[5] << 16); w.w = kd[6] | ((unsigned)kd[7] << 16);
          *(LAS v4u*)(Kdt + lane * LP + 8 * wave) = w;
          w.x = rv[0] | ((unsigned)rv[1] << 16); w.y = rv[2] | ((unsigned)rv[3] << 16); w.z = rv[4] | ((unsigned)rv[5] << 16); w.w = rv[6] | ((unsigned)rv[7] << 16);
          *(LAS v4u*)(Vt + lane * LP + 8 * wave) = w; }
        WG_BAR_L();
        if (c + 1 < SEQ / 64) {
#pragma unroll
            for (int i = 0; i < 8; ++i) { const bf16* p = P0 + (size_t)(64 * (c + 1) + 8 * wave + i) * NPI; rq[i] = p[lane]; rk[i] = p[256 + lane]; rv[i] = p[512 + lane]; rg[i] = p[768 + lane]; } }
        { const int rt = wave >> 1;
#pragma unroll
          for (int u = 0; u < 2; ++u) { const int ct = 2 * (wave & 1) + u;
              f32x4 s = (f32x4){0.f, 0.f, 0.f, 0.f};
              if (ct <= rt) s = mm_tile<2>(Qs + 16 * rt * LP + o72, Ks + 16 * ct * LP + o72, s);
#pragma unroll
              for (int r = 0; r < 4; ++r) { const int l = 16 * rt + 4 * q4 + r, m = 16 * ct + lc; const float val = (l >= m) ? s[r] * __builtin_amdgcn_exp2f((float)(l - m) * lg2) : 0.f; Ps[l * LP + m] = f2bf16(val); } } }
        f32x4 inter[4];
        if (wave < 4) {
#pragma unroll
            for (int ct = 0; ct < 4; ++ct) inter[ct] = mm_tile<2>(Qs + 16 * wave * LP + o72, Stt + 16 * ct * LP + o72, (f32x4){0.f, 0.f, 0.f, 0.f}); }
        WG_BAR_L();
        if (wave < 4) {
            f32x4 y[4];
#pragma unroll
            for (int ct = 0; ct < 4; ++ct) y[ct] = mm_tile<2>(Ps + 16 * wave * LP + o72, Vt + 16 * ct * LP + o72, (f32x4){0.f, 0.f, 0.f, 0.f});
#pragma unroll
            for (int r = 0; r < 4; ++r) { const int l = 16 * wave + 4 * q4 + r; const float qd = __builtin_amdgcn_exp2f((float)(l + 1) * lg2);
                float s = 0.f;
#pragma unroll
                for (int ct = 0; ct < 4; ++ct) { y[ct][r] += qd * inter[ct][r]; s += y[ct][r]; }
                const float mean = sum16(s) * (1.0f / 64.0f); float qv = 0.f;
#pragma unroll
                for (int ct = 0; ct < 4; ++ct) { const float dd = y[ct][r] - mean; qv += dd * dd; }
                const float rstd = __builtin_amdgcn_rsqf(sum16(qv) * (1.0f / 64.0f) + GN_EPS);
                bf16* orow = mixed + (m0 + 64 * c + l) * DM + h * 64 + lc;
#pragma unroll
                for (int ct = 0; ct < 4; ++ct) { const float g = bf2f(Gs[l * LP + 16 * ct + lc]); orow[16 * ct] = f2bf16((y[ct][r] - mean) * rstd * gain4[ct] * (g * fsigmoid(g))); } }
        } else {
            const int dt = wave - 4;
#pragma unroll
            for (int ct = 0; ct < 4; ++ct) { st[ct] = mm_tile<2>(Kdt + 16 * dt * LP + o72, Vt + 16 * ct * LP + o72, st[ct] * cd);
                v2u w; w.x = pk2(st[ct][0], st[ct][1]); w.y = pk2(st[ct][2], st[ct][3]);
                *(LAS v2u*)(Stt + (16 * ct + lc) * LP + 16 * dt + 4 * q4) = w; }
        }
        WG_BAR_L();
    }
}

__device__ __forceinline__ void mlstm_unit(int b, int h, const bf16* proj, const float* conv_w, const float* conv_b, const float* i_b, const float* f_b, const float* gn, bf16* mixed,
                                           LAS unsigned char* lds, int wave, int lane0) {
    LAS bf16* Qs = (LAS bf16*)lds; LAS bf16* Ks = Qs + 64 * LPM; LAS bf16* Kdt = Ks + 64 * LPM; LAS bf16* Vt = Kdt + 96 * LP; LAS bf16* Ps = Vt + 112 * LP; LAS bf16* Stt = Ps + 64 * LP; LAS bf16* Os = Stt + 112 * LPM;
    LAS float* ev = (LAS float*)(Os + 64 * LPM); LAS float* pmv = ev + 64; LAS float* flv = pmv + 64;
    const int lane = lane0, lc = lane & 15;
    float wq0[4], wq1[4], wk0[4], wk1[4], bq0, bq1, bk0, bk1;
    { const int cq0 = h * 96 + lane, cq1 = h * 96 + 64 + (lane & 31), ck0 = 384 + cq0, ck1 = 384 + cq1;
#pragma unroll
    for (int j = 0; j < 4; ++j) { wq0[j] = conv_w[j * 768 + cq0]; wq1[j] = conv_w[j * 768 + cq1]; wk0[j] = conv_w[j * 768 + ck0]; wk1[j] = conv_w[j * 768 + ck1]; }
    bq0 = conv_b[cq0]; bq1 = conv_b[cq1]; bk0 = conv_b[ck0]; bk1 = conv_b[ck1]; }
    const float ib = i_b[h], fb = f_b[h];
    const float ksc = 0.10206207261596577f;
    f32x4 st[11];
#pragma unroll
    for (int i = 0; i < 11; ++i) st[i] = (f32x4){0.f, 0.f, 0.f, 0.f};
    for (int i = wave * 64 + lane; i < 112 * LPM / 2; i += 512) ((LAS unsigned*)Stt)[i] = 0u;
    for (int i = wave * 64 + lane; i < 16 * LP / 2; i += 512) ((LAS unsigned*)(Vt + 96 * LP))[i] = (i < LP / 2) ? 0x3f803f80u : 0u;
    float mprev = 0.f;
    const size_t m0 = (size_t)b * SEQ;
    const bf16* PB = proj + m0 * NPI + ML_B;
    float gain6[6];
#pragma unroll
    for (int ct = 0; ct < 6; ++ct) gain6[ct] = gn[640 + h * 96 + 16 * ct + lc];
    unsigned xq[11], xk[11], vv[8], gg;
#define ML_LOAD(cc) do { const int tb_ = 64 * (cc) + 8 * wave; \
        _Pragma("unroll") for (int i = 0; i < 11; ++i) { const int t_ = tb_ - 3 + i; const bool ok_ = t_ >= 0; const bf16* p_ = PB + (size_t)(ok_ ? t_ : 0) * NPI; \
            const unsigned a0_ = ok_ ? p_[cq0] : 0u, a1_ = (ok_ && has1) ? p_[cq1] : 0u, b0_ = ok_ ? p_[ck0] : 0u, b1_ = (ok_ && has1) ? p_[ck1] : 0u; xq[i] = a0_ | (a1_ << 16); xk[i] = b0_ | (b1_ << 16); } \
        _Pragma("unroll") for (int i = 0; i < 8; ++i) { const bf16* p_ = PB + (size_t)(tb_ + i) * NPI + 768 + h * 96; const unsigned a0_ = p_[d0], a1_ = has1 ? p_[d1] : 0u; vv[i] = a0_ | (a1_ << 16); } \
        { const bf16* p_ = PB + (size_t)(64 * (cc) + lane) * NPI; const unsigned a0_ = p_[1536 + h], a1_ = p_[1540 + h]; gg = a0_ | (a1_ << 16); } } while (0)
    { const int d0 = lane, d1 = 64 + (lane & 31); const bool has1 = lane < 32; const int cq0 = h * 96 + d0, cq1 = h * 96 + d1, ck0 = 384 + cq0, ck1 = 384 + cq1; ML_LOAD(0); }
#pragma unroll 1
    for (int c = 0; c < SEQ / 64; ++c) {
        const int lane = lane_id_opq(), q4 = lane >> 4, lc = lane & 15, o72 = lc * LP + 8 * q4, o104 = lc * LPM + 8 * q4;
        const int d0 = lane, d1 = 64 + (lane & 31); const bool has1 = lane < 32;
        const int cq0 = h * 96 + d0, cq1 = h * 96 + d1, ck0 = 384 + cq0, ck1 = 384 + cq1;
        const int tb = 64 * c + 8 * wave;
        float pm63, carry, ev_l; const float mold = mprev;
        { const float ic = __uint_as_float(gg << 16) + ib, lf = flogsigmoid(__uint_as_float(gg & 0xffff0000u) + fb);
          const float bc = wave_prefix_sum(lf), e = ic - bc; const float pm = fmaxf(wave_prefix_max(e), mprev);
          pm63 = __builtin_bit_cast(float, __builtin_amdgcn_readlane(__builtin_bit_cast(int, pm), 63)); carry = fexp(mprev - pm63); ev_l = e;
          if (wave == 0) { ev[lane] = e; pmv[lane] = pm; flv[lane] = fexp(-(bc + pm)); }
          mprev = __builtin_bit_cast(float, __builtin_amdgcn_readlane(__builtin_bit_cast(int, bc), 63)) + pm63; }
        { unsigned short kd0[8], kd1[8];
#pragma unroll
          for (int i = 0; i < 8; ++i) { const int tt = 8 * wave + i;
#define LO_(w) __uint_as_float((w) << 16)
#define HI_(w) __uint_as_float((w) & 0xffff0000u)
              float q0 = bq0 + LO_(xq[i]) * wq0[0] + LO_(xq[i + 1]) * wq0[1] + LO_(xq[i + 2]) * wq0[2] + LO_(xq[i + 3]) * wq0[3];
              float k0 = bk0 + LO_(xk[i]) * wk0[0] + LO_(xk[i + 1]) * wk0[1] + LO_(xk[i + 2]) * wk0[2] + LO_(xk[i + 3]) * wk0[3];
              float q1 = bq1 + HI_(xq[i]) * wq1[0] + HI_(xq[i + 1]) * wq1[1] + HI_(xq[i + 2]) * wq1[2] + HI_(xq[i + 3]) * wq1[3];
              float k1 = bk1 + HI_(xk[i]) * wk1[0] + HI_(xk[i + 1]) * wk1[1] + HI_(xk[i + 2]) * wk1[2] + HI_(xk[i + 3]) * wk1[3];
#undef LO_
#undef HI_
              q0 = q0 * fsigmoid(q0); k0 = k0 * fsigmoid(k0) * ksc; q1 = q1 * fsigmoid(q1); k1 = k1 * fsigmoid(k1) * ksc;
              const float wsi = fexp(__builtin_bit_cast(float, __builtin_amdgcn_readlane(__builtin_bit_cast(int, ev_l), tt)) - pm63);
              Qs[tt * LPM + d0] = f2bf16(q0); Ks[tt * LPM + d0] = f2bf16(k0); kd0[i] = f2bf16(k0 * wsi); kd1[i] = f2bf16(k1 * wsi);
              if (has1) { Qs[tt * LPM + d1] = f2bf16(q1); Ks[tt * LPM + d1] = f2bf16(k1); } }
          v4u w; w.x = kd0[0] | ((unsigned)kd0[1] << 16); w.y = kd0[2] | ((unsigned)kd0[3] << 16); w.z = kd0[4] | ((unsigned)kd0[5] << 16); w.w = kd0[6] | ((unsigned)kd0[7] << 16);
          *(LAS v4u*)(Kdt + d0 * LP + 8 * wave) = w;
          if (has1) { w.x = kd1[0] | ((unsigned)kd1[1] << 16); w.y = kd1[2] | ((unsigned)kd1[3] << 16); w.z = kd1[4] | ((unsigned)kd1[5] << 16); w.w = kd1[6] | ((unsigned)kd1[7] << 16);
              *(LAS v4u*)(Kdt + d1 * LP + 8 * wave) = w; }
          w.x = (vv[0] & 0xffffu) | (vv[1] << 16); w.y = (vv[2] & 0xffffu) | (vv[3] << 16); w.z = (vv[4] & 0xffffu) | (vv[5] << 16); w.w = (vv[6] & 0xffffu) | (vv[7] << 16);
          *(LAS v4u*)(Vt + d0 * LP + 8 * wave) = w;
          if (has1) { w.x = (vv[0] >> 16) | (vv[1] & 0xffff0000u); w.y = (vv[2] >> 16) | (vv[3] & 0xffff0000u); w.z = (vv[4] >> 16) | (vv[5] & 0xffff0000u); w.w = (vv[6] >> 16) | (vv[7] & 0xffff0000u);
              *(LAS v4u*)(Vt + d1 * LP + 8 * wave) = w; } }
        WG_BAR_L();
        unsigned og[8];
#pragma unroll
        for (int i = 0; i < 8; ++i) { const bf16* p = PB + (size_t)(tb + i) * NPI + 1152 + h * 96; const unsigned a0_ = p[d0], a1_ = has1 ? p[d1] : 0u; og[i] = a0_ | (a1_ << 16); }
        if (c + 1 < SEQ / 64) ML_LOAD(c + 1);
        { const int rt = wave >> 1;
#pragma unroll
          for (int u = 0; u < 2; ++u) { const int ct = 2 * (wave & 1) + u;
              f32x4 s = (f32x4){0.f, 0.f, 0.f, 0.f};
              if (ct <= rt) s = mm_tile<3>(Qs + 16 * rt * LPM + o104, Ks + 16 * ct * LPM + o104, s);
              const float em = ev[16 * ct + lc];
#pragma unroll
              for (int r = 0; r < 4; ++r) { const int l = 16 * rt + 4 * q4 + r, m = 16 * ct + lc; const float val = (l >= m) ? s[r] * fexp(em - pmv[l]) : 0.f; Ps[l * LP + m] = f2bf16(val); } } }
        f32x4 inter[7];
        if (wave < 4) {
#pragma unroll
            for (int ct = 0; ct < 7; ++ct) inter[ct] = mm_tile<3>(Qs + 16 * wave * LPM + o104, Stt + 16 * ct * LPM + o104, (f32x4){0.f, 0.f, 0.f, 0.f}); }
#pragma unroll
        for (int i = 0; i < 8; ++i) { Os[(8 * wave + i) * LPM + d0] = (unsigned short)(og[i] & 0xffffu); if (has1) Os[(8 * wave + i) * LPM + d1] = (unsigned short)(og[i] >> 16); }
        WG_BAR_L();
        if (wave < 4) {
            f32x4 y[7];
#pragma unroll
            for (int ct = 0; ct < 7; ++ct) y[ct] = mm_tile<2>(Ps + 16 * wave * LP + o72, Vt + 16 * ct * LP + o72, (f32x4){0.f, 0.f, 0.f, 0.f});
#pragma unroll
            for (int r = 0; r < 4; ++r) { const int l = 16 * wave + 4 * q4 + r; const float iw = fexp(mold - pmv[l]);
#pragma unroll
                for (int ct = 0; ct < 7; ++ct) y[ct][r] += iw * inter[ct][r];
                const float den = __shfl(y[6][r], lane & 48);
                const float dn = __builtin_amdgcn_rcpf(fmaxf(fabsf(den), flv[l]));
                float s = 0.f;
#pragma unroll
                for (int ct = 0; ct < 6; ++ct) { y[ct][r] *= dn; s += y[ct][r]; }
                const float mean = sum16(s) * (1.0f / 96.0f); float qv = 0.f;
#pragma unroll
                for (int ct = 0; ct < 6; ++ct) { const float dd = y[ct][r] - mean; qv += dd * dd; }
                const float rstd = __builtin_amdgcn_rsqf(sum16(qv) * (1.0f / 96.0f) + GN_EPS);
                bf16* orow = mixed + (m0 + 64 * c + l) * DM + 640 + h * 96 + lc;
#pragma unroll
                for (int ct = 0; ct < 6; ++ct) { const float o = bf2f(Os[l * LPM + 16 * ct + lc]); orow[16 * ct] = f2bf16((y[ct][r] - mean) * rstd * gain6[ct] * fsigmoid(o)); } }
        } else {
#pragma unroll
            for (int i = 0; i < 11; ++i) { const int t = (wave - 4) + 4 * i;
                if (t < 42) { const int dt = t / 7, et = t % 7;
                    st[i] = mm_tile<2>(Kdt + 16 * dt * LP + o72, Vt + 16 * et * LP + o72, st[i] * carry);
                    v2u w; w.x = pk2(st[i][0], st[i][1]); w.y = pk2(st[i][2], st[i][3]);
                    *(LAS v2u*)(Stt + (16 * et + lc) * LPM + 16 * dt + 4 * q4) = w; } }
        }
        WG_BAR_L();
    }
#undef ML_LOAD
}
#ifndef RW_DBG
#define RW_DBG 0xFF
#endif
__device__ __forceinline__ void rwkv_unit(int b, int h, const bf16* proj, const float* CUM, const bf16* AA, const bf16* GG, const float* mu, const float* k_k, const float* k_a, const float* r_k,
                                          const float* gn, bf16* mixed, LAS unsigned char* lds, int wave, int lane0,
                                          int cb, int ce, const float* hs_in, unsigned* flag_in, float* hs_out, unsigned* flag_out) {
    constexpr int SLOT = 64 * LP;
    LAS bf16* KH = (LAS bf16*)lds; LAS bf16* BH = KH + SLOT; LAS bf16* KT = BH + SLOT; LAS bf16* RT = KT + SLOT; LAS bf16* KHgt = RT + SLOT; LAS bf16* BHgtn = KHgt + SLOT;
    LAS bf16* Vt = BHgtn + SLOT; LAS bf16* AkT = Vt + SLOT; LAS bf16* BbTn = AkT + SLOT; LAS bf16* BkT = BbTn + SLOT; LAS bf16* S0b = BkT + SLOT; LAS bf16* Loffb = S0b + SLOT; LAS bf16* Vr = Loffb + SLOT; LAS bf16* Gr = Vr + SLOT;
    LAS float* RHS = (LAS float*)KH; LAS bf16* Ut = KT;
    LAS float* LTd = (LAS float*)(Gr + SLOT);
    LAS float* XS = LTd + 64 * 20;
    LAS float* GCv = XS + 16 * 64; LAS float* bonv = GCv + 64;
    float mu_r, mu_k, mu_v, kkc, kac, rkc;
    { const int c0 = h * 64 + lane0; mu_r = mu[c0]; mu_k = mu[384 + c0]; mu_v = mu[768 + c0]; kkc = k_k[c0]; kac = k_a[c0]; rkc = r_k[c0]; }
    for (int i = wave * 64 + lane0; i < 5 * SLOT / 2; i += 512) ((LAS unsigned*)AkT)[i] = 0u;
    float gain4[4];
#pragma unroll
    for (int ct = 0; ct < 4; ++ct) gain4[ct] = gn[256 + h * 64 + 16 * ct + (lane0 & 15)];
    f32x4 sacc[4];
#pragma unroll
    for (int i = 0; i < 4; ++i) sacc[i] = (f32x4){0.f, 0.f, 0.f, 0.f};
    if (hs_in) {
        if (wave == 0) { unsigned spins = 0u;
            while (__hip_atomic_load(flag_in, __ATOMIC_RELAXED, __HIP_MEMORY_SCOPE_AGENT) == 0u) { __builtin_amdgcn_s_sleep(4); if (++spins > (1u << 22)) break; }
            __builtin_amdgcn_fence(__ATOMIC_ACQUIRE, "agent"); asm volatile("s_waitcnt vmcnt(0)" ::: "memory"); }
        WG_BAR();
        if (wave < 4) {
#pragma unroll
            for (int jt = 0; jt < 4; ++jt) {
#pragma unroll
                for (int r = 0; r < 4; ++r) { sacc[jt][r] = hs_in[(wave * 4 + jt) * 256 + r * 64 + lane0];
                    S0b[(16 * wave + 4 * (lane0 >> 4) + r) * LP + 16 * jt + (lane0 & 15)] = f2bf16(sacc[jt][r]); } } }
    }
    const size_t m0 = (size_t)b * SEQ;
    const bf16* PU = proj + m0 * NPI + RW_B + h * 64;
    const float* CU = CUM + m0 * 384 + h * 64; const bf16* AU = AA + m0 * 384 + h * 64; const bf16* GU = GG + m0 * 384 + h * 64;
    unsigned short rr[9], rk[9], rv[9], ra[8], rg[8]; float rc[9], rc63;
#define RWKV_LOAD(cc) do { const int tb_ = 64 * (cc) + 8 * wave; \
        _Pragma("unroll") for (int i = 0; i < 9; ++i) { const int t_ = tb_ - 1 + i; const bool ok_ = t_ >= 0; const bf16* p_ = PU + (size_t)(ok_ ? t_ : 0) * NPI; \
            rr[i] = ok_ ? p_[lane] : (unsigned short)0; rk[i] = ok_ ? p_[384 + lane] : (unsigned short)0; rv[i] = ok_ ? p_[768 + lane] : (unsigned short)0; \
            rc[i] = (i > 0 || wave > 0) ? CU[(size_t)(ok_ ? t_ : 0) * 384 + lane] : 0.f; if (i > 0) { ra[i - 1] = AU[(size_t)t_ * 384 + lane]; rg[i - 1] = GU[(size_t)t_ * 384 + lane]; } } \
        rc63 = CU[(size_t)(64 * (cc) + 63) * 384 + lane]; } while (0)
    { const int lane = lane0; RWKV_LOAD(cb); }
#pragma unroll 1
    for (int c = cb; c < ce; ++c) {
        const int lane = lane_id_opq(), q4 = lane >> 4, lc = lane & 15, o72 = lc * LP + 8 * q4;
        if (RW_DBG & 1) { unsigned short khg[8], bhg[8]; const float gc63 = fexp(rc63); float ecp = fexp(rc[0]);
#pragma unroll
          for (int i = 0; i < 8; ++i) { const int tt = 8 * wave + i;
              const float cr = bf2f(rr[i + 1]), ck = bf2f(rk[i + 1]);
              const float r = cr + (bf2f(rr[i]) - cr) * mu_r, k = ck + (bf2f(rk[i]) - ck) * mu_k, a = bf2f(ra[i]);
              float kk = k * kkc; kk = kk * __builtin_amdgcn_rsqf(fmaxf(wave_sum(kk * kk), 1e-24f));
              const float kmod = k * (1.0f + (a - 1.0f) * kac), beta = kk * a;
              const float bon = wave_sum(r * kmod * rkc); if (lane == 0) bonv[tt] = bon;
              const float cm = rc[i + 1], cp = rc[i];
              const float em = fexp(-cm), eg = gc63 * em, ec = __builtin_amdgcn_rcpf(em);
              KH[tt * LP + lane] = f2bf16(kmod * em); BH[tt * LP + lane] = f2bf16(beta * em); KT[tt * LP + lane] = f2bf16(kk * ecp); RT[tt * LP + lane] = f2bf16(r * ec); ecp = ec;
              khg[i] = f2bf16(kmod * eg); bhg[i] = f2bf16(-beta * eg); }
          v4u w; w.x = khg[0] | ((unsigned)khg[1] << 16); w.y = khg[2] | ((unsigned)khg[3] << 16); w.z = khg[4] | ((unsigned)khg[5] << 16); w.w = khg[6] | ((unsigned)khg[7] << 16);
          *(LAS v4u*)(KHgt + lane * LP + 8 * wave) = w;
          w.x = bhg[0] | ((unsigned)bhg[1] << 16); w.y = bhg[2] | ((unsigned)bhg[3] << 16); w.z = bhg[4] | ((unsigned)bhg[5] << 16); w.w = bhg[6] | ((unsigned)bhg[7] << 16);
          *(LAS v4u*)(BHgtn + lane * LP + 8 * wave) = w;
          unsigned short vs[8];
#pragma unroll
          for (int i = 0; i < 8; ++i) { const float cv = bf2f(rv[i + 1]); vs[i] = f2bf16(cv + (bf2f(rv[i]) - cv) * mu_v); Vr[(8 * wave + i) * LP + lane] = vs[i]; Gr[(8 * wave + i) * LP + lane] = rg[i]; }
          w.x = vs[0] | ((unsigned)vs[1] << 16); w.y = vs[2] | ((unsigned)vs[3] << 16); w.z = vs[4] | ((unsigned)vs[5] << 16); w.w = vs[6] | ((unsigned)vs[7] << 16);
          *(LAS v4u*)(Vt + lane * LP + 8 * wave) = w;
          if (wave == 0) GCv[lane] = gc63; }
        WG_BAR_L();
#pragma unroll
        for (int u2 = 0; u2 < 2; ++u2) { const int idx = 2 * wave + u2, rt = idx >> 2, ct = idx & 3;
            if (ct <= rt) {
                const int s = 16 * ct + lc; const LAS bf16* kt = KT + 16 * rt * LP + o72; const LAS bf16* rtp = RT + 16 * rt * LP + o72; const LAS bf16* bh = BH + 16 * ct * LP + o72; const LAS bf16* kh = KH + 16 * ct * LP + o72;
                const f32x4 z = (f32x4){0.f, 0.f, 0.f, 0.f};
                const f32x4 g0 = mm_tile<2>(kt, bh, z), g1 = mm_tile<2>(kt, kh, z), g2 = mm_tile<2>(rtp, bh, z), g3 = mm_tile<2>(rtp, kh, z);
#pragma unroll
                for (int r = 0; r < 4; ++r) { const int t = 16 * rt + 4 * q4 + r;
                    if (ct < rt) Loffb[t * LP + s] = f2bf16(g0[r]); else LTd[s * 20 + (t - 16 * rt)] = (s < t) ? g0[r] : 0.f;
                    AkT[t * LP + s] = f2bf16((s < t) ? g1[r] : 0.f);
                    BbTn[t * LP + s] = f2bf16((s <= t) ? -g2[r] : 0.f);
                    BkT[t * LP + s] = f2bf16((s <= t) ? g3[r] : 0.f); } } }
        WG_BAR_L();
#pragma unroll
        for (int u = 0; u < ((RW_DBG & 4) ? 2 : 0); ++u) { const int rt = wave >> 1, ct = 2 * (wave & 1) + u;
            f32x4 g = mm_tile<2>(KT + 16 * rt * LP + o72, S0b + 16 * ct * LP + o72, (f32x4){0.f, 0.f, 0.f, 0.f});
            g = mm_tile<2>(AkT + 16 * rt * LP + o72, Vt + 16 * ct * LP + o72, g);
#pragma unroll
            for (int r = 0; r < 4; ++r) RHS[(16 * rt + 4 * q4 + r) * 64 + 16 * ct + lc] = g[r]; }
        WG_BAR_L();
        f32x4 y[4];
        if ((RW_DBG & 8) && wave == 0) {
#pragma unroll
            for (int a = 0; a < 4; ++a) {
                if (a > 0) {
#pragma unroll
                    for (int it = 0; it < 4; ++it) { f32x4 cr = (f32x4){0.f, 0.f, 0.f, 0.f};
                        if (a == 3) cr = mm_tile<2>(Loffb + 16 * a * LP + o72, Ut + 16 * it * LP + o72, cr); else cr = mm_tile<1>(Loffb + 16 * a * LP + o72, Ut + 16 * it * LP + o72, cr);
#pragma unroll
                        for (int r = 0; r < 4; ++r) XS[(4 * q4 + r) * 64 + 16 * it + lc] = cr[r]; }
                    asm volatile("s_waitcnt lgkmcnt(0)" ::: "memory");
                }
                float acc[16];
#pragma unroll
                for (int t = 0; t < 16; ++t) acc[t] = RHS[(16 * a + t) * 64 + lane] - (a > 0 ? XS[t * 64 + lane] : 0.f);
                const LAS float* Ld = LTd + 16 * a * 20; asm volatile("" : "+v"(Ld));
#pragma unroll
                for (int s2 = 0; s2 < 15; ++s2) { const float us = acc[s2];
#pragma unroll
                    for (int t4 = (s2 + 1) / 4; t4 < 4; ++t4) { const f32x4 l4 = *(const LAS f32x4*)(Ld + s2 * 20 + 4 * t4);
                        acc[4 * t4] -= l4.x * us; acc[4 * t4 + 1] -= l4.y * us; acc[4 * t4 + 2] -= l4.z * us; acc[4 * t4 + 3] -= l4.w * us; }
                    if (s2 == 5) asm volatile("" : "+v"(Ld) : "v"(acc[s2 + 1])); }
                v4u w; w.x = pk2(acc[0], acc[1]); w.y = pk2(acc[2], acc[3]); w.z = pk2(acc[4], acc[5]); w.w = pk2(acc[6], acc[7]);
                *(LAS v4u*)(Ut + lane * LP + 16 * a) = w;
                w.x = pk2(acc[8], acc[9]); w.y = pk2(acc[10], acc[11]); w.z = pk2(acc[12], acc[13]); w.w = pk2(acc[14], acc[15]);
                *(LAS v4u*)(Ut + lane * LP + 16 * a + 8) = w;
                asm volatile("s_waitcnt lgkmcnt(0)" ::: "memory");
            }
        }
        if (c + 1 < ce) RWKV_LOAD(c + 1);
        if (wave >= 4) {
#pragma unroll
            for (int ct = 0; ct < 4; ++ct) { y[ct] = mm_tile<2>(RT + 16 * (wave - 4) * LP + o72, S0b + 16 * ct * LP + o72, (f32x4){0.f, 0.f, 0.f, 0.f}); y[ct] = mm_tile<2>(BkT + 16 * (wave - 4) * LP + o72, Vt + 16 * ct * LP + o72, y[ct]); }
        } else {
#pragma unroll
            for (int jt = 0; jt < 4; ++jt) { const float gc = GCv[16 * jt + lc]; sacc[jt] = mm_tile<2>(Vt + 16 * wave * LP + o72, KHgt + 16 * jt * LP + o72, sacc[jt] * gc); }
        }
        WG_BAR_L();
        if (wave >= 4) {
#pragma unroll
            for (int ct = 0; ct < 4; ++ct) y[ct] = mm_tile<2>(BbTn + 16 * (wave - 4) * LP + o72, Ut + 16 * ct * LP + o72, y[ct]);
#pragma unroll
            for (int r = 0; r < 4; ++r) { const int t = 16 * (wave - 4) + 4 * q4 + r; const size_t row = m0 + 64 * c + t;
                float s = 0.f;
#pragma unroll
                for (int ct = 0; ct < 4; ++ct) s += y[ct][r];
                const float mean = sum16(s) * (1.0f / 64.0f); float qv = 0.f;
#pragma unroll
                for (int ct = 0; ct < 4; ++ct) { const float dd = y[ct][r] - mean; qv += dd * dd; }
                const float rstd = __builtin_amdgcn_rsqf(sum16(qv) * (1.0f / 64.0f) + GN_EPS);
                const float bon = bonv[t]; bf16* orow = mixed + row * DM + 256 + h * 64 + lc;
#pragma unroll
                for (int ct = 0; ct < 4; ++ct) orow[16 * ct] = f2bf16(((y[ct][r] - mean) * rstd * gain4[ct] + bon * bf2f(Vr[t * LP + 16 * ct + lc])) * bf2f(Gr[t * LP + 16 * ct + lc])); }
        } else {
#pragma unroll
            for (int jt = 0; jt < 4; ++jt) { sacc[jt] = mm_tile<2>(Ut + 16 * wave * LP + o72, BHgtn + 16 * jt * LP + o72, sacc[jt]);
#pragma unroll
                for (int r = 0; r < 4; ++r) S0b[(16 * wave + 4 * q4 + r) * LP + 16 * jt + lc] = f2bf16(sacc[jt][r]); }
        }
        WG_BAR_L();
    }
    if (hs_out) {
        if (wave < 4) {
#pragma unroll
            for (int jt = 0; jt < 4; ++jt)
#pragma unroll
                for (int r = 0; r < 4; ++r) __hip_atomic_store(hs_out + (wave * 4 + jt) * 256 + r * 64 + lane0, sacc[jt][r], __ATOMIC_RELAXED, __HIP_MEMORY_SCOPE_AGENT);
        }
        WG_BAR();
        if (wave == 0 && lane0 == 0) __hip_atomic_store(flag_out, 1u, __ATOMIC_RELAXED, __HIP_MEMORY_SCOPE_AGENT);
    }
#undef RWKV_LOAD
}

struct Args { const float* in[25]; float* out; unsigned char* ws; int ph_lo, ph_hi, li, pad; };
typedef const __attribute__((address_space(4))) Args* KArgs;
__device__ __forceinline__ KArgs kargs() { KArgs p = (KArgs)__builtin_amdgcn_kernarg_segment_ptr(); asm volatile("" : "+s"(p)); return p; }
#ifndef DBG_MASK
#define DBG_MASK 0xFFFF
#endif
#define EN(bit) ((DBG_MASK >> (bit)) & 1)
#ifndef PROBE_DUP
#define PROBE_DUP 0
#endif
#define REP(bit) for (int rep_ = 0; rep_ < (((PROBE_DUP >> (bit)) & 1) ? 2 : 1); ++rep_)
__global__ void __launch_bounds__(NWAVES * 64, 2) mk_fwd(Args args_unused) {
    extern __shared__ __attribute__((aligned(16))) unsigned char lds_raw[];
    LAS unsigned char* lds = (LAS unsigned char*)lds_raw;
    volatile LAS unsigned* MISC = (volatile LAS unsigned*)(lds + MISC_OFF);
    const int wave = __builtin_amdgcn_readfirstlane((int)threadIdx.x >> 6);
    const int G = gridDim.x, gw = blockIdx.x * NWAVES + wave, ngw = G * NWAVES;
    for (int u = threadIdx.x; u < (LDS_BYTES - LDSCTL_OFF) / 4; u += NWAVES * 64) ((LAS unsigned*)(lds + LDSCTL_OFF))[u] = 0u;
    __syncthreads();
    XcdBarrier bar; int lo, hi;
    { KArgs A = kargs(); bar = xcd_barrier_post((unsigned*)(A->ws + WS_CTL) + CW_BAR + (MK_PER_PHASE ? 0 : A->li) * XCD_BAR_WORDS, MISC + 8); lo = A->ph_lo; hi = A->ph_hi; }
#define IN(k) (lo <= (k) && (k) < hi)
#define SEAM(k) do { if (IN(k) && IN((k) + 1)) xcd_barrier(bar); } while (0)
#define LANE_TID() int wave_o = wave, gw_o = gw; asm volatile("" : "+s"(wave_o), "+s"(gw_o)); (void)gw_o; const int lane_o = lane_id_opq(), tid_o = wave_o * 64 + lane_o; (void)tid_o

    REP(5) if (EN(0) && IN(0)) {
        KArgs A = kargs(); unsigned char* ws = A->ws; LANE_TID();
        p0_mod(A->in[1], A->in[2], A->in[3], (float*)(ws + WS_MOD), lds, tid_o, lane_o, wave_o);
        p0_weights(A->in[6], A->in[21], A->in[22], A->in[23], A->in[10], A->in[12], A->in[13], ws, lds, gw_o, ngw, wave_o, lane_o);
    }
    SEAM(0);
    if (EN(1) && IN(1)) { KArgs A = kargs(); unsigned char* ws = A->ws; LANE_TID();
        norm_mod_phase(A->in[0], (const bf16*)nullptr, A->in[4], (const float*)(ws + WS_MOD), 0, DM, (bf16*)(ws + WS_H), gw_o, ngw, lane_o); }
    SEAM(1);
#pragma unroll 1
    for (int l = 0; l < NL; ++l) {
        const int pb = 2 + 6 * l;
        REP(3) if (EN(2) && IN(pb + 0)) { KArgs A = kargs(); unsigned char* ws = A->ws; LANE_TID();
            pg8::Gemm g{(const bf16*)(ws + WS_H), (const bf16*)(ws + WS_WIN) + (size_t)l * NPI * DM, MT, NPI, DM}; pg8::StaticOrder S; S.init(MT, NPI, G, (int)blockIdx.x);
            pg8::EpiBf16Plain E{(bf16*)(ws + WS_PROJ), NPI};
            pg8::gemm_phase<pg8::EpiBf16Plain, pg8::StaticOrder, true, true>(lds, g, S, E, wave_o);
        }
        SEAM(pb + 0);
        REP(1) if (EN(3) && IN(pb + 1)) { KArgs A = kargs(); unsigned char* ws = A->ws; LANE_TID();
            rwkv_prep_mfma((const bf16*)(ws + WS_PROJ), A->in[8] + l * RWKV_IN, A->in[9] + l * 384, A->in[11] + l * 384, (const bf16*)(ws + WS_WL) + (size_t)l * 384 * 256,
                           (float*)(ws + WS_DEC), (bf16*)(ws + WS_AA), (bf16*)(ws + WS_GG), lds, wave_o); }
        SEAM(pb + 1);
        REP(0) if (EN(4) && IN(pb + 2)) { KArgs A = kargs(); unsigned char* ws = A->ws; LANE_TID();
            const float* gn = A->in[7] + l * DM; const bf16* PROJ = (const bf16*)(ws + WS_PROJ); bf16* Hb = (bf16*)(ws + WS_H);
            int u = (int)blockIdx.x; asm volatile("" : "+s"(u));
            float* HS = (float*)(ws + WS_HS) + (size_t)l * 64 * 4096; unsigned* FL = (unsigned*)(ws + WS_CTL) + CW_FLAG + l * 64 * 64;
            const float* DECp = (const float*)(ws + WS_DEC); const bf16* AAp = (const bf16*)(ws + WS_AA); const bf16* GGp = (const bf16*)(ws + WS_GG);
            if (u < 128) {
                mlstm_unit(u >> 2, u & 3, PROJ, A->in[17] + (size_t)l * 4 * 768, A->in[18] + l * 768, A->in[19] + l * 4, A->in[20] + l * 4, gn, Hb, lds, wave_o, lane_o);
            } else {
                const int v0 = u - 128, k = v0 & 63; const bool dgrp = v0 >= 64;
#pragma unroll 1
                for (int rep = 0; rep < 2; ++rep) { const bool half = (rep == 0) == dgrp; const int q = half ? 128 + k : v0;
                    const int cb = (half && !dgrp) ? 16 : 0, ce = (half && dgrp) ? 16 : 32;
                    rwkv_unit(q / 6, q % 6, PROJ, DECp, AAp, GGp, A->in[8] + l * RWKV_IN, A->in[14] + l * 384, A->in[15] + l * 384, A->in[16] + l * 384, gn, Hb, lds, wave_o, lane_o,
                              cb, ce, (half && !dgrp) ? HS + (size_t)k * 4096 : nullptr, (half && !dgrp) ? FL + k * 64 : nullptr, (half && dgrp) ? HS + (size_t)k * 4096 : nullptr, (half && dgrp) ? FL + k * 64 : nullptr); }
                ret_unit(v0 >> 2, v0 & 3, PROJ, gn, Hb, lds, wave_o, lane_o);
            }
#ifndef PROBE_UNIT
#define PROBE_UNIT 0
#endif
            if (PROBE_UNIT == 1 && u < 192) rwkv_unit(u / 6, u % 6, PROJ, DECp, AAp, GGp, A->in[8] + l * RWKV_IN, A->in[14] + l * 384, A->in[15] + l * 384, A->in[16] + l * 384, gn, Hb, lds, wave_o, lane_o, 0, 32, nullptr, nullptr, nullptr, nullptr);
            if (PROBE_UNIT == 2 && u < 128) mlstm_unit(u >> 2, u & 3, PROJ, A->in[17] + (size_t)l * 4 * 768, A->in[18] + l * 768, A->in[19] + l * 4, A->in[20] + l * 4, gn, Hb, lds, wave_o, lane_o);
            if (PROBE_UNIT == 3 && u < 128) ret_unit(u >> 2, u & 3, PROJ, gn, Hb, lds, wave_o, lane_o);
        }
        SEAM(pb + 2);
        if (EN(6) && IN(pb + 3)) { KArgs A = kargs(); unsigned char* ws = A->ws; LANE_TID();
            pg8::Gemm g{(const bf16*)(ws + WS_H), (const bf16*)(ws + WS_WOUT) + (size_t)l * DM * DM, MT, DM, DM}; pg8::StaticOrder S; S.init(MT, DM, G, (int)blockIdx.x);
            const float* modl = (const float*)(ws + WS_MOD) + (size_t)l * NB * MODP;
            pg8::EpiResGate E{l == 0 ? A->in[0] : (const float*)nullptr, (const bf16*)A->out, (bf16*)A->out, DM, modl + 2 * DM, MODP};
            pg8::gemm_phase<pg8::EpiResGate, pg8::StaticOrder, true, true>(lds, g, S, E, wave_o);
            fused_panel_norm(S, (unsigned*)(ws + WS_CTL) + CW_PCNT + (2 * l) * PCNT_BANK, (const bf16*)A->out, A->in[5] + l * DM, modl, 3 * DM, 4 * DM, (bf16*)(ws + WS_H), wave_o, lane_o);
        }
        SEAM(pb + 3);
        REP(4) if (EN(7) && IN(pb + 4)) { KArgs A = kargs(); unsigned char* ws = A->ws; LANE_TID();
            pg8::Gemm g{(const bf16*)(ws + WS_H), (const bf16*)(ws + WS_WF1) + (size_t)l * NF1 * DM, MT, NF1, DM}; pg8::StaticOrder S; S.init(MT, NF1, G, (int)blockIdx.x);
            pg8::EpiSwiGLU E{(bf16*)(ws + WS_PROJ), DFF};
            pg8::gemm_phase<pg8::EpiSwiGLU, pg8::StaticOrder, true, true>(lds, g, S, E, wave_o);
        }
        SEAM(pb + 4);
        if (EN(8) && IN(pb + 5)) { KArgs A = kargs(); unsigned char* ws = A->ws; LANE_TID();
            pg8::Gemm g{(const bf16*)(ws + WS_PROJ), (const bf16*)(ws + WS_WF2) + (size_t)l * DM * DFF, MT, DM, DFF}; pg8::StaticOrder S; S.init(MT, DM, G, (int)blockIdx.x);
            pg8::EpiResGate E{(const float*)nullptr, (const bf16*)A->out, l + 1 < NL ? (bf16*)A->out : (bf16*)(ws + WS_XFIN), DM, (const float*)(ws + WS_MOD) + (size_t)l * NB * MODP + 5 * DM, MODP};
            pg8::gemm_phase<pg8::EpiResGate, pg8::StaticOrder, true, true>(lds, g, S, E, wave_o);
            if (l + 1 < NL) fused_panel_norm(S, (unsigned*)(ws + WS_CTL) + CW_PCNT + (2 * l + 1) * PCNT_BANK, (const bf16*)A->out, A->in[4] + (l + 1) * DM, (const float*)(ws + WS_MOD) + (size_t)(l + 1) * NB * MODP, 0, DM, (bf16*)(ws + WS_H), wave_o, lane_o);
        }
        SEAM(pb + 5);
    }
    if (EN(9) && IN(N_PHASES - 1)) { KArgs A = kargs(); int gw_o = gw; asm volatile("" : "+s"(gw_o)); final_norm_phase((const bf16*)(A->ws + WS_XFIN), A->out, A->in[24], gw_o, ngw, lane_id_opq()); }
#undef IN
#undef SEAM
}

extern "C" void kernel_launch(void* const* d_in, const int* in_sizes, int n_in, void* d_out, int out_size, void* d_ws, size_t ws_size, hipStream_t stream) {
    static int grid = 0;
    if (grid == 0) {
        if (n_in != 25 || in_sizes[0] != MT * DM || out_size != MT * DM || ws_size < WS_END) { fprintf(stderr, "kernel_launch: shape/workspace mismatch (n_in %d, in0 %d, out %d, ws %zu)\n", n_in, n_in > 0 ? in_sizes[0] : -1, out_size, ws_size); grid = -1; return; }
        int dev = 0, cus = 0, per_cu = 0;
        if (hipGetDevice(&dev) != hipSuccess || hipDeviceGetAttribute(&cus, hipDeviceAttributeMultiprocessorCount, dev) != hipSuccess) { grid = -1; return; }
        if (hipFuncSetAttribute((const void*)mk_fwd, hipFuncAttributeMaxDynamicSharedMemorySize, LDS_BYTES) != hipSuccess) { fprintf(stderr, "kernel_launch: hipFuncSetAttribute failed\n"); grid = -1; return; }
        if (hipOccupancyMaxActiveBlocksPerMultiprocessor(&per_cu, (const void*)mk_fwd, NWAVES * 64, LDS_BYTES) != hipSuccess || per_cu < 1) { fprintf(stderr, "kernel_launch: occupancy query says %d\n", per_cu); }
        (void)hipGetLastError();
        grid = cus;
    }
    if (grid < 0) return;
    if (hipMemsetAsync((char*)d_ws + WS_CTL, 0, CTL_ZERO_BYTES, stream) != hipSuccess) return;
    Args a{};
    for (int i = 0; i < 25; ++i) a.in[i] = (const float*)d_in[i];
    a.out = (float*)d_out; a.ws = (unsigned char*)d_ws;
#if MK_PER_PHASE
    for (int p = 0; p < N_PHASES; ++p) { a.ph_lo = p; a.ph_hi = p + 1; a.li = 0; hipLaunchKernelGGL(mk_fwd, dim3(grid), dim3(NWAVES * 64), LDS_BYTES, stream, a); }
#else
    a.ph_lo = 0; a.ph_hi = N_PHASES; a.li = 0;
    hipLaunchKernelGGL(mk_fwd, dim3(grid), dim3(NWAVES * 64), LDS_BYTES, stream, a);
#endif
}
```

```cpp
#include <hip/hip_runtime.h>
#include <cstdio>
#include <cstdint>
#ifndef PROBE_PN
#define PROBE_PN 0
#endif
#ifndef PROBE_RG
#define PROBE_RG 0
#endif
#ifndef PROBE_BAR
#define PROBE_BAR 0
#endif
#ifndef PROBE_SOLVE
#define PROBE_SOLVE 0
#endif
#ifndef PROBE_KL
#define PROBE_KL 0
#endif
#ifndef PROBE_KL_SOLO
#define PROBE_KL_SOLO 0
#endif
#ifndef PROBE_KL_FIRST
#define PROBE_KL_FIRST 0
#endif
#if PROBE_KL
__device__ unsigned long long probe_kl[2];
#endif
#ifndef PROBE_EPI2
#define PROBE_EPI2 0
#endif
__device__ __forceinline__ int lane_id_opq() { int l = (int)__builtin_amdgcn_mbcnt_hi(~0u, __builtin_amdgcn_mbcnt_lo(~0u, 0u)); asm volatile("" : "+v"(l)); return l; }

namespace pg8 {
#define PG8_LAS __attribute__((address_space(3)))
typedef unsigned short bf16_t;
typedef short bf16x8 __attribute__((ext_vector_type(8)));
typedef float f32x4 __attribute__((ext_vector_type(4)));
typedef unsigned u32x4 __attribute__((ext_vector_type(4)));
constexpr int BM = 256, BK = 64, HALF = 128, HTB = HALF * BK * 2  , STAGE_BYTES = 8 * HTB, NXCD = 8, WGM = 8;

__host__ __device__ __forceinline__ int lds_byte(int r, int c) { const int st = (r >> 4) * 2 + (c >> 5), rr = r & 15, cc = c & 31, ob = rr * 64 + cc * 2; return st * 1024 + (ob ^ (((ob >> 9) & 1) << 5)); }
__host__ __device__ __forceinline__ void stage_rc(int b, int& R, int& C) { const int st = b / 1024, sb = b % 1024, swz = sb ^ (((sb >> 9) & 1) << 5); R = (st >> 1) * 16 + swz / 64; C = (st & 1) * 32 + (swz % 64) / 2; }
__host__ __device__ __forceinline__ int perm32(int rho) { const int n = rho >> 4, i = rho & 15; return 8 * (i >> 2) + 4 * n + (i & 3); }

struct Unit { int pm, pn; };
struct Gemm { const bf16_t* A; const bf16_t* Bt; int M, N, K; };

struct StaticOrder {
    int nM, nN, nwg, G, c;
    __host__ __device__ void init(int M, int N, int G_, int c_) { nM = M / BM; nN = N / BM; nwg = nM * nN; G = G_; c = c_; }
    __host__ __device__ bool next(int i, Unit& u) const {
        const long L = (long)i * G + c; if (L >= nwg) return false;
        int wgid = (int)L; { const int q = nwg / NXCD, r = nwg % NXCD, xcd = wgid % NXCD, off = wgid / NXCD; wgid = (xcd < r ? xcd * (q + 1) : r * (q + 1) + (xcd - r) * q) + off; }
        const int nig = WGM * nN, gid = wgid / nig, fm = gid * WGM, gsz = (nM - fm) < WGM ? (nM - fm) : WGM;
        u.pm = fm + ((wgid % nig) % gsz); u.pn = (wgid % nig) / gsz; return true;
    }
    __device__ __forceinline__ void a_ready(const Unit&) const {}
    __device__ __forceinline__ void done(const Unit&) const {}
};

__device__ __forceinline__ unsigned cvt_pk_bf16(float lo, float hi) { unsigned r; asm volatile("v_cvt_pk_bf16_f32 %0, %1, %2" : "=v"(r) : "v"(lo), "v"(hi)); return r; }
typedef float f32x2 __attribute__((ext_vector_type(2)));

typedef float f32x2e __attribute__((ext_vector_type(2)));
typedef __bf16 bf16x2e __attribute__((ext_vector_type(2)));
__device__ __forceinline__ unsigned cvt_pk(float lo, float hi) { const f32x2e v = {lo, hi}; return __builtin_bit_cast(unsigned, __builtin_convertvector(v, bf16x2e)); }
__device__ __forceinline__ float silu_f(float x) { return x * __builtin_amdgcn_rcpf(1.0f + __expf(-x)); }
struct EpiBf16Plain {
    static constexpr bool PERM = true, AFTER_DRAIN = false; static constexpr int NSTORE = 16;
    bf16_t* O; int ldc;
    __device__ __forceinline__ void operator()(const f32x4 (&acc)[2][2][4][2], const Unit& u, int wr, int wc, int fr, int fq) const {
        const int row0 = u.pm * BM + wr * 64 + fr, col0 = u.pn * BM + wc * 32 + 8 * fq;
#pragma unroll
        for (int ai = 0; ai < 2; ++ai)
#pragma unroll
            for (int m = 0; m < 4; ++m) { bf16_t* rowp = O + (size_t)(row0 + ai * HALF + m * 16) * ldc + col0;
#pragma unroll
                for (int bj = 0; bj < 2; ++bj) { const f32x4 v0 = acc[ai][bj][m][0], v1 = acc[ai][bj][m][1];
                    u32x4 w; w.x = cvt_pk(v0[0], v0[1]); w.y = cvt_pk(v0[2], v0[3]); w.z = cvt_pk(v1[0], v1[1]); w.w = cvt_pk(v1[2], v1[3]);
                    *(u32x4*)(rowp + bj * HALF) = w; } }
    }
};
struct EpiSwiGLU {
    static constexpr bool PERM = true, AFTER_DRAIN = false; static constexpr int NSTORE = 8;
    bf16_t* O; int ldc;
    __device__ __forceinline__ void operator()(const f32x4 (&acc)[2][2][4][2], const Unit& u, int wr, int wc, int fr, int fq) const {
        const int row0 = u.pm * BM + wr * 64 + fr, col0 = u.pn * HALF + wc * 32 + 8 * fq;
#pragma unroll
        for (int ai = 0; ai < 2; ++ai)
#pragma unroll
            for (int m = 0; m < 4; ++m) { bf16_t* rowp = O + (size_t)(row0 + ai * HALF + m * 16) * ldc + col0;
                const f32x4 g0 = acc[ai][0][m][0], g1 = acc[ai][0][m][1], u0 = acc[ai][1][m][0], u1 = acc[ai][1][m][1];
                u32x4 w; w.x = cvt_pk(silu_f(g0[0]) * u0[0], silu_f(g0[1]) * u0[1]); w.y = cvt_pk(silu_f(g0[2]) * u0[2], silu_f(g0[3]) * u0[3]);
                w.z = cvt_pk(silu_f(g1[0]) * u1[0], silu_f(g1[1]) * u1[1]); w.w = cvt_pk(silu_f(g1[2]) * u1[2], silu_f(g1[3]) * u1[3]);
                *(u32x4*)rowp = w; }
    }
};
template <bool F32IN>
struct EpiResGate {
    static constexpr bool PERM = false, AFTER_DRAIN = false; static constexpr int NSTORE = 32;
    const float* xin32; const bf16_t* xsin; bf16_t* xs; int ldc; const float* gate; int gpitch;
    __device__ __forceinline__ void operator()(const f32x4 (&acc)[2][2][4][2], const Unit& u, int wr, int wc, int fr, int fq) const {
        typedef unsigned u32x2 __attribute__((ext_vector_type(2)));
        const int row0 = u.pm * BM + wr * 64 + fr, col0 = u.pn * BM + wc * 32 + 4 * fq;
        const float* gp = gate + (size_t)(u.pm >> 3) * gpitch + col0;
        f32x4 gv[2][2];
#pragma unroll
        for (int bj = 0; bj < 2; ++bj)
#pragma unroll
            for (int n = 0; n < 2; ++n) gv[bj][n] = *(const f32x4*)(gp + bj * HALF + n * 16);
        f32x4 xf[2][2][2][2]; u32x2 xb[2][2][2][2];
#define RG_LOAD(buf, ai, mh) do { _Pragma("unroll") for (int mm = 0; mm < 2; ++mm) { const size_t off = (size_t)(row0 + (ai) * HALF + (2 * (mh) + mm) * 16) * ldc + col0; \
            _Pragma("unroll") for (int bj = 0; bj < 2; ++bj) _Pragma("unroll") for (int n = 0; n < 2; ++n) { \
                if constexpr (F32IN) xf[buf][mm][bj][n] = *(const f32x4*)(xin32 + off + bj * HALF + n * 16); else xb[buf][mm][bj][n] = *(const u32x2*)(xsin + off + bj * HALF + n * 16); } } } while (0)
        RG_LOAD(0, 0, 0);
#pragma unroll
        for (int k = 0; k < 4; ++k) { const int ai = k >> 1, mh = k & 1, buf = k & 1;
            if (k < 3) RG_LOAD((k + 1) & 1, (k + 1) >> 1, (k + 1) & 1);
            asm volatile("" ::: "memory");
#pragma unroll
            for (int mm = 0; mm < 2; ++mm) { const int m = 2 * mh + mm; const size_t off = (size_t)(row0 + ai * HALF + m * 16) * ldc + col0;
#pragma unroll
                for (int bj = 0; bj < 2; ++bj)
#pragma unroll
                    for (int n = 0; n < 2; ++n) { f32x4 xi;
                        if constexpr (F32IN) xi = xf[buf][mm][bj][n];
                        else { const u32x2 w = xb[buf][mm][bj][n]; xi = (f32x4){__uint_as_float(w.x << 16), __uint_as_float(w.x & 0xffff0000u), __uint_as_float(w.y << 16), __uint_as_float(w.y & 0xffff0000u)}; }
                        const f32x4 xo = xi + gv[bj][n] * acc[ai][bj][m][n];
                        u32x2 o; o.x = cvt_pk(xo[0], xo[1]); o.y = cvt_pk(xo[2], xo[3]); *(u32x2*)(xs + off + bj * HALF + n * 16) = o; } }
            asm volatile("" ::: "memory"); }
#undef RG_LOAD
    }
};

template <class Epi, class Sched, bool ALIGN_EPI = false, bool SP2 = false>
__device__ __forceinline__ void gemm_phase(PG8_LAS unsigned char* lds, const Gemm g, const Sched& S, const Epi& E, const int wid_in) {
    const int wid = wid_in, lane = lane_id_opq(), tid = wid * 64 + lane, wr = wid >> 2, wc = wid & 3, fr = lane & 15, fq = lane >> 4;
    const int K = g.K, nt = K / BK;
    unsigned voffA[2], voffB[2];
#pragma unroll
    for (int i = 0; i < 2; ++i) { int R, C; stage_rc(tid * 16 + i * 8192, R, C); const int Rb = Epi::PERM ? ((R & ~31) + perm32(R & 31)) : R;
        voffA[i] = (unsigned)(R * K + C) * 2u; voffB[i] = (unsigned)(Rb * K + C) * 2u; }
    const size_t kstep = (size_t)(BK * 2);
    const size_t hstep = (size_t)HALF * K * 2;
    const size_t tstep = 2 * hstep;
    const unsigned ldsw = (unsigned)wid * 1024u;
    const int aoff = lds_byte(wr * 64 + fr, fq * 8), boff = lds_byte(wc * 32 + fr, fq * 8);
#define PG8_SA(b, h) (((b) * 2 + (h)) * HTB)
#define PG8_SB(b, h) ((4 + (b) * 2 + (h)) * HTB)
#define PG8_STAGE(bufoff, gbase, voff) do { _Pragma("unroll") for (int _i = 0; _i < 2; ++_i) \
        __builtin_amdgcn_global_load_lds((const unsigned*)((const char*)(gbase) + (voff)[_i]), (PG8_LAS unsigned*)(lds + (bufoff) + ldsw + _i * 8192), 16, 0, 0); } while (0)
#define PG8_LDA(dst, b, h) do { _Pragma("unroll") for (int m = 0; m < 4; ++m) _Pragma("unroll") for (int k = 0; k < 2; ++k) dst[m][k] = *(const PG8_LAS bf16x8*)(lds + PG8_SA(b, h) + aoff + m * 2048 + k * 1024); } while (0)
#define PG8_LDB(dst, b, h) do { _Pragma("unroll") for (int n = 0; n < 2; ++n) _Pragma("unroll") for (int k = 0; k < 2; ++k) dst[n][k] = *(const PG8_LAS bf16x8*)(lds + PG8_SB(b, h) + boff + n * 2048 + k * 1024); } while (0)
#define PG8_MMA(ai, bj, At, Bt) do { __builtin_amdgcn_s_setprio(1); _Pragma("unroll") for (int m = 0; m < 4; ++m) _Pragma("unroll") for (int n = 0; n < 2; ++n) _Pragma("unroll") for (int k = 0; k < 2; ++k) \
        acc[ai][bj][m][n] = __builtin_amdgcn_mfma_f32_16x16x32_bf16(Bt[n][k], At[m][k], acc[ai][bj][m][n], 0, 0, 0); __builtin_amdgcn_s_setprio(0); } while (0)
#define PG8_WAIT_V(n) asm volatile("s_waitcnt vmcnt(" #n ")" ::: "memory")
#define PG8_WAIT_L(n) asm volatile("s_waitcnt lgkmcnt(" #n ")" ::: "memory")
#define PG8_BAR __builtin_amdgcn_s_barrier()
#define PG8_SCHED __builtin_amdgcn_sched_barrier(0)
    Unit cur, nxt; int ui = 0;
    if (!S.next(0, cur)) return;
    f32x4 acc[2][2][4][2];
#pragma unroll
    for (int a = 0; a < 2; ++a)
#pragma unroll
        for (int b = 0; b < 2; ++b)
#pragma unroll
            for (int m = 0; m < 4; ++m)
#pragma unroll
                for (int n = 0; n < 2; ++n) acc[a][b][m][n] = (f32x4){0.f, 0.f, 0.f, 0.f};
    bf16x8 At[4][2], B0[2][2], B1[2][2];
    const char* cA = (const char*)g.A + (size_t)cur.pm * tstep; const char* cB = (const char*)g.Bt + (size_t)cur.pn * tstep;
    S.a_ready(cur);
    if constexpr (SP2) {
        PG8_STAGE(PG8_SB(0, 0), cB, voffB); PG8_STAGE(PG8_SB(0, 1), cB + hstep, voffB); PG8_STAGE(PG8_SA(0, 0), cA, voffA); PG8_STAGE(PG8_SA(0, 1), cA + hstep, voffA);
        if (wr == 1) PG8_BAR;
        PG8_WAIT_V(2); PG8_BAR;
        PG8_STAGE(PG8_SB(1, 0), cB + kstep, voffB); PG8_STAGE(PG8_SA(1, 0), cA + kstep, voffA); PG8_STAGE(PG8_SB(1, 1), cB + hstep + kstep, voffB);
        PG8_WAIT_V(6); PG8_BAR;
    } else {
        PG8_STAGE(PG8_SB(0, 0), cB, voffB); PG8_STAGE(PG8_SA(0, 0), cA, voffA); PG8_STAGE(PG8_SB(0, 1), cB + hstep, voffB); PG8_STAGE(PG8_SA(0, 1), cA + hstep, voffA);
        if (wr == 1) PG8_BAR;
        PG8_WAIT_V(4); PG8_BAR;
        PG8_STAGE(PG8_SB(1, 0), cB + kstep, voffB); PG8_STAGE(PG8_SA(1, 0), cA + kstep, voffA); PG8_STAGE(PG8_SB(1, 1), cB + hstep + kstep, voffB);
        PG8_WAIT_V(6); PG8_BAR;
    }
    for (;;) {
        const bool has_next = S.next(ui + 1, nxt);
        const char* nA = has_next ? (const char*)g.A + (size_t)nxt.pm * tstep : cA; const char* nB = has_next ? (const char*)g.Bt + (size_t)nxt.pn * tstep : cB;
#if PROBE_KL
        unsigned long long pk_t0 = 0; if (Epi::PERM && Epi::NSTORE == 16 && ui == 2 && blockIdx.x == 0 && wid == 0) pk_t0 = __builtin_readcyclecounter();
#endif
        for (int t = 0; t < nt; t += 2) {
            const bool last = (t == nt - 2);
            const char* a1 = cA + (size_t)(t + 1) * kstep;
            const char* a2 = last ? nA : cA + (size_t)(t + 2) * kstep; const char* b2 = last ? nB : cB + (size_t)(t + 2) * kstep;
            const char* a3 = a2 + kstep; const char* b3 = b2 + kstep;
            if (last && has_next) S.a_ready(nxt);
            if constexpr (SP2) {
            PG8_LDB(B0, 0, 0); PG8_LDB(B1, 0, 1); PG8_SCHED; PG8_LDA(At, 0, 0); PG8_STAGE(PG8_SA(1, 1), a1 + hstep, voffA);
            PG8_WAIT_V(8); PG8_WAIT_L(0); PG8_BAR; PG8_MMA(0, 0, At, B0); PG8_MMA(0, 1, At, B1); PG8_BAR; PG8_SCHED;
            PG8_LDA(At, 0, 1); PG8_STAGE(PG8_SB(0, 0), b2, voffB); PG8_STAGE(PG8_SB(0, 1), b2 + hstep, voffB); PG8_STAGE(PG8_SA(0, 0), a2, voffA);
            PG8_WAIT_V(8); PG8_WAIT_L(0); PG8_BAR; PG8_MMA(1, 0, At, B0); PG8_MMA(1, 1, At, B1); PG8_BAR; PG8_SCHED;
            PG8_LDB(B0, 1, 0); PG8_LDB(B1, 1, 1); PG8_SCHED; PG8_LDA(At, 1, 0); PG8_STAGE(PG8_SA(0, 1), a2 + hstep, voffA);
            PG8_WAIT_V(8); PG8_WAIT_L(0); PG8_BAR; PG8_MMA(0, 0, At, B0); PG8_MMA(0, 1, At, B1); PG8_BAR; PG8_SCHED;
            PG8_LDA(At, 1, 1); PG8_STAGE(PG8_SB(1, 0), b3, voffB); PG8_STAGE(PG8_SB(1, 1), b3 + hstep, voffB); PG8_STAGE(PG8_SA(1, 0), a3, voffA);
            PG8_WAIT_V(8); PG8_WAIT_L(0); PG8_BAR; PG8_MMA(1, 0, At, B0); PG8_MMA(1, 1, At, B1); PG8_BAR; PG8_SCHED;
            } else {
            PG8_LDB(B0, 0, 0); PG8_SCHED; PG8_LDA(At, 0, 0); PG8_STAGE(PG8_SA(1, 1), a1 + hstep, voffA);
            PG8_WAIT_L(8); PG8_BAR; PG8_WAIT_L(0); PG8_MMA(0, 0, At, B0); PG8_BAR; PG8_SCHED;
            PG8_LDB(B1, 0, 1); PG8_STAGE(PG8_SB(0, 0), b2, voffB);
            PG8_BAR; PG8_WAIT_L(0); PG8_MMA(0, 1, At, B1); PG8_BAR;
            PG8_LDA(At, 0, 1); PG8_STAGE(PG8_SA(0, 0), a2, voffA);
            PG8_BAR; PG8_WAIT_L(0); PG8_MMA(1, 0, At, B0); PG8_BAR; PG8_SCHED;
            PG8_STAGE(PG8_SB(0, 1), b2 + hstep, voffB);
            PG8_WAIT_V(6); PG8_BAR; PG8_MMA(1, 1, At, B1); PG8_BAR;
            PG8_LDB(B0, 1, 0); PG8_SCHED; PG8_LDA(At, 1, 0); PG8_STAGE(PG8_SA(0, 1), a2 + hstep, voffA);
            PG8_WAIT_L(8); PG8_BAR; PG8_WAIT_L(0); PG8_MMA(0, 0, At, B0); PG8_BAR; PG8_SCHED;
            PG8_LDB(B1, 1, 1); PG8_STAGE(PG8_SB(1, 0), b3, voffB);
            PG8_BAR; PG8_WAIT_L(0); PG8_MMA(0, 1, At, B1); PG8_BAR;
            PG8_LDA(At, 1, 1); PG8_STAGE(PG8_SA(1, 0), a3, voffA);
            PG8_BAR; PG8_WAIT_L(0); PG8_MMA(1, 0, At, B0); PG8_BAR; PG8_SCHED;
            PG8_STAGE(PG8_SB(1, 1), b3 + hstep, voffB);
            PG8_WAIT_V(6); PG8_BAR; PG8_MMA(1, 1, At, B1); PG8_BAR;
            }
        }
#if PROBE_KL
        unsigned long long pk_t1 = 0; if (Epi::PERM && Epi::NSTORE == 16 && ui == 2 && blockIdx.x == 0 && wid == 0) pk_t1 = __builtin_readcyclecounter();
#endif
        if constexpr (ALIGN_EPI) { if (wr == 0) PG8_BAR; }
        if constexpr (!Epi::AFTER_DRAIN) { E(acc, cur, wr, wc, fr, fq);
#if PROBE_EPI2
            if constexpr (Epi::PERM) { asm volatile("" ::: "memory"); E(acc, cur, wr, wc, fr, fq); }
#endif
            S.done(cur); }
#if PROBE_KL
        if (Epi::PERM && Epi::NSTORE == 16 && ui == 2 && blockIdx.x == 0 && wid == 0) { asm volatile("s_waitcnt vmcnt(0)" ::: "memory"); const unsigned long long pk_t2 = __builtin_readcyclecounter(); if (lane == 0 && (PROBE_KL_FIRST == 0 || probe_kl[0] == 0ull)) { probe_kl[0] = pk_t1 - pk_t0; probe_kl[1] = pk_t2 - pk_t1; } }
#endif
        if (!has_next) break;
#pragma unroll
        for (int a = 0; a < 2; ++a)
#pragma unroll
            for (int b = 0; b < 2; ++b)
#pragma unroll
                for (int m = 0; m < 4; ++m)
#pragma unroll
                    for (int n = 0; n < 2; ++n) acc[a][b][m][n] = (f32x4){0.f, 0.f, 0.f, 0.f};
        cur = nxt; cA = nA; cB = nB; ++ui;
        if constexpr (ALIGN_EPI) { if (wr == 1) PG8_BAR; }
    }
    PG8_WAIT_V(0);
    if constexpr (!ALIGN_EPI) { if (wr == 0) PG8_BAR; }
    PG8_BAR;
    if constexpr (Epi::AFTER_DRAIN) { E.fused(acc, cur, wr, wc, fr, fq, lds, wid, lane); S.done(cur); }
#undef PG8_SA
#undef PG8_SB
#undef PG8_STAGE
#undef PG8_LDA
#undef PG8_LDB
#undef PG8_MMA
#undef PG8_WAIT_V
#undef PG8_WAIT_L
#undef PG8_BAR
#undef PG8_SCHED
}
}

#ifndef MK_PER_PHASE
#define MK_PER_PHASE 0
#endif
constexpr int NWAVES = 8;
constexpr int DM = 1024, NB = 32, SEQ = 2048, NL = 4, MT = NB * SEQ;
constexpr int D_IN = 3976, NPI = 4096, DFF = 2816, NF1 = 2 * DFF;
constexpr int RW_B = 1024, ML_B = 2432;
constexpr int RWKV_IN = 1408;
constexpr float RMS_EPS = 1e-6f, GN_EPS = 1e-5f;
constexpr int MODP = 6 * DM;
constexpr size_t MiB = 1u << 20;
constexpr size_t WS_CTL = 0, CTL_ZERO_BYTES = 1 * MiB;
constexpr size_t WS_HS = 116 * MiB;
constexpr int CW_PCNT = 32768, PCNT_BANK = 256 * 64;
constexpr int CW_FLAG = 16384;
constexpr int SPLIT_H = 6, SPLIT_X = 26, SPLIT_Y = 16;
constexpr size_t WS_WL = 5 * MiB;
constexpr size_t WS_MOD = 1 * MiB;
constexpr size_t WS_WIN = 8 * MiB, WS_WOUT = 40 * MiB, WS_WF1 = 48 * MiB, WS_WF2 = 92 * MiB;
constexpr size_t WS_H = 128 * MiB;
constexpr size_t WS_PROJ = 256 * MiB;
constexpr size_t WS_XFIN = (256 + 352) * MiB;
constexpr size_t WS_DEC = 768 * MiB, WS_AA = 864 * MiB, WS_GG = 912 * MiB;
constexpr size_t WS_END = 960 * MiB;
constexpr int CW_BAR = 4096;
constexpr int N_PHASES = 3 + 6 * NL;
static_assert((CW_BAR + (MK_PER_PHASE ? 1 : 1) * 3456) * 4 <= (int)CTL_ZERO_BYTES, "ctl");
constexpr int RING_BYTES = 131072, LDS_BYTES = 163840, LDSCTL_OFF = LDS_BYTES - 1024, MISC_OFF = LDSCTL_OFF + 320;

#define GAS __attribute__((address_space(1)))
#define LAS __attribute__((address_space(3)))
typedef unsigned short bf16;
typedef unsigned v4u __attribute__((ext_vector_type(4)));
typedef unsigned v2u __attribute__((ext_vector_type(2)));
typedef float f32x4 __attribute__((ext_vector_type(4)));
#define LDS_WAIT() asm volatile("s_waitcnt lgkmcnt(0)" ::: "memory")
typedef float f32x2c __attribute__((ext_vector_type(2)));
typedef __bf16 bf16x2c __attribute__((ext_vector_type(2)));
__device__ __forceinline__ unsigned f2bf(float f) { return (__builtin_bit_cast(unsigned, f) + 0x8000u) >> 16; }
__device__ __forceinline__ unsigned pk2(float lo, float hi) { return __builtin_amdgcn_perm(__builtin_bit_cast(unsigned, hi) + 0x8000u, __builtin_bit_cast(unsigned, lo) + 0x8000u, 0x07060302u); }
__device__ __forceinline__ float bf2f(bf16 v) { return __uint_as_float(((unsigned)v) << 16); }
template <int CTRL, int ROWMASK> __device__ __forceinline__ float dppf(float v) { return __builtin_bit_cast(float, __builtin_amdgcn_update_dpp(0, __builtin_bit_cast(int, v), CTRL, ROWMASK, 0xf, false)); }
__device__ __forceinline__ float sum16(float v) { v += dppf<0xB1, 0xf>(v); v += dppf<0x4E, 0xf>(v); v += dppf<0x141, 0xf>(v); v += dppf<0x140, 0xf>(v); return v; }
__device__ __forceinline__ float wave_sum(float v) { v = sum16(v); v += dppf<0x142, 0xa>(v); v += dppf<0x143, 0xc>(v); return __builtin_bit_cast(float, __builtin_amdgcn_readlane(__builtin_bit_cast(int, v), 63)); }
template <int CTRL, int ROWMASK> __device__ __forceinline__ float dppo(float v, float old) { return __builtin_bit_cast(float, __builtin_amdgcn_update_dpp(__builtin_bit_cast(int, old), __builtin_bit_cast(int, v), CTRL, ROWMASK, 0xf, false)); }
__device__ __forceinline__ float wave_prefix_sum(float v) { v += dppo<0x111, 0xf>(v, 0.f); v += dppo<0x112, 0xf>(v, 0.f); v += dppo<0x114, 0xf>(v, 0.f); v += dppo<0x118, 0xf>(v, 0.f); v += dppo<0x142, 0xa>(v, 0.f); v += dppo<0x143, 0xc>(v, 0.f); return v; }
__device__ __forceinline__ float wave_prefix_max(float v) { const float ni = -__builtin_inff(); v = fmaxf(v, dppo<0x111, 0xf>(v, ni)); v = fmaxf(v, dppo<0x112, 0xf>(v, ni)); v = fmaxf(v, dppo<0x114, 0xf>(v, ni)); v = fmaxf(v, dppo<0x118, 0xf>(v, ni));
    v = fmaxf(v, dppo<0x142, 0xa>(v, ni)); v = fmaxf(v, dppo<0x143, 0xc>(v, ni)); return v; }
__device__ __forceinline__ float flogsigmoid(float x) { return fminf(x, 0.f) - __logf(1.0f + __expf(-fabsf(x))); }
__device__ __forceinline__ float fexp(float x) { return __expf(x); }
__device__ __forceinline__ float fsigmoid(float x) { return __builtin_amdgcn_rcpf(1.0f + __expf(-x)); }
__device__ __forceinline__ float sigmoid_f(float x) { return 1.0f / (1.0f + expf(-x)); }
__device__ __forceinline__ float logsigmoid_f(float x) { return fminf(x, 0.f) - log1pf(expf(-fabsf(x))); }
template <class T> __device__ __forceinline__ T* opq(T* p) { asm volatile("" : "+s"(p)); return p; }

#define XB_TMO      128
#define XB_XCNT(j)  (256  + 64 * (j))
#define XB_XSUB(j)  (1280 + 64 * (j))
#define XB_XGEN(j)  (2304 + 64 * (j))
#define XB_TOP      3328
#define XB_TOPGEN   3392
#define XCD_BAR_WORDS 3456
#define XB_SPIN_CAP (1u << 22)

__device__ __forceinline__ unsigned xb_ld(unsigned* p)              { return __hip_atomic_load(p, __ATOMIC_RELAXED, __HIP_MEMORY_SCOPE_AGENT); }
__device__ __forceinline__ unsigned xb_add(unsigned* p, unsigned v) { return __hip_atomic_fetch_add(p, v, __ATOMIC_RELAXED, __HIP_MEMORY_SCOPE_AGENT); }
__device__ __forceinline__ unsigned xb_xcc_id() { return (unsigned)__builtin_amdgcn_s_getreg((3 << 11) | 20) & 0xFu; }
#define XB_SPIN(cond, bar) do { unsigned _sp = 0; while (cond) { __builtin_amdgcn_s_sleep(1); \
    if ((++_sp & 255u) == 0u) { if (xb_ld(&(bar)[XB_TMO])) break; if (_sp > XB_SPIN_CAP) { atomicAdd(&(bar)[XB_TMO], 1u); break; } } } } while (0)

struct XcdBarrier {
    unsigned* bar; unsigned x; unsigned w0;
    volatile LAS unsigned* st;
};

__device__ __forceinline__ XcdBarrier xcd_barrier_post(unsigned* bar, volatile LAS unsigned* st) {
    XcdBarrier b; b.bar = bar; b.x = xb_xcc_id(); b.st = st; b.w0 = (__builtin_amdgcn_readfirstlane((int)threadIdx.x >> 6) == 0) ? 1u : 0u;
    if (threadIdx.x == 0) (void)xb_add(&bar[XB_XCNT(b.x)], 1u);
    return b;
}
__device__ __forceinline__ void xcd_barrier_complete(unsigned* bar, unsigned x, unsigned& nloc, unsigned& nx) {
    const unsigned G = gridDim.x * gridDim.y * gridDim.z;
    unsigned sum, cnt, mine, sp = 0u;
    for (;;) {
        sum = 0u; cnt = 0u; mine = 0u;
#pragma unroll
        for (unsigned j = 0; j < 16; ++j) { const unsigned c = xb_ld(&bar[XB_XCNT(j)]); sum += c; cnt += (c > 0u) ? 1u : 0u; mine = (j == x) ? c : mine; }
        if (sum == G) break;
        __builtin_amdgcn_s_sleep(1);
        if ((++sp & 255u) == 0u) { if (xb_ld(&bar[XB_TMO])) break; if (sp > XB_SPIN_CAP) { atomicAdd(&bar[XB_TMO], 1u); break; } }
    }
    nloc = mine > 0u ? mine : 1u; nx = cnt > 0u ? cnt : 1u;
}

__device__ __forceinline__ void xcd_barrier(const XcdBarrier& b) {
    asm volatile("s_waitcnt vmcnt(0)" ::: "memory");
    __syncthreads();
    if (b.w0 != 0u && lane_id_opq() == 0) {
        unsigned* bar = b.bar;
        __builtin_amdgcn_s_waitcnt(0);
        unsigned nloc = b.st[0], nx = b.st[1];
        if (nloc == 0u) { xcd_barrier_complete(bar, b.x, nloc, nx); b.st[0] = nloc; b.st[1] = nx; }
        const unsigned old = xb_add(&bar[XB_XSUB(b.x)], 1u);
        const unsigned gen = old / nloc;
        if (old + 1u == (gen + 1u) * nloc) {
            __builtin_amdgcn_fence(__ATOMIC_RELEASE, "agent");
            asm volatile("s_waitcnt vmcnt(0)" ::: "memory");
            const unsigned og = xb_add(&bar[XB_TOP], 1u);
            const unsigned tg = og / nx;
            if (og + 1u == (tg + 1u) * nx) xb_add(&bar[XB_TOPGEN], 1u);
            else XB_SPIN(xb_ld(&bar[XB_TOPGEN]) == tg, bar);
            __builtin_amdgcn_fence(__ATOMIC_ACQUIRE, "agent");
            xb_add(&bar[XB_XGEN(b.x)], 1u);
            asm volatile("s_waitcnt vmcnt(0)" ::: "memory");
        } else {
            XB_SPIN(xb_ld(&bar[XB_XGEN(b.x)]) == gen, bar);
            __builtin_amdgcn_fence(__ATOMIC_ACQUIRE, "agent");
            asm volatile("s_waitcnt vmcnt(0)" ::: "memory");
        }
    }
    __syncthreads();
}


__device__ __forceinline__ void b32_gemv(const float* Wcol  , bool ok, int N, LAS float* vT, float (&res)[4], int wave, int lane) {
    float acc[32];
#pragma unroll
    for (int b = 0; b < 32; ++b) acc[b] = 0.f;
    const float* wp = Wcol + (size_t)(128 * wave) * N; const LAS float* vp = vT + 128 * wave * 32;
#pragma unroll 1
    for (int kk = 0; kk < 128; kk += 8) {
        float w[8];
#pragma unroll
        for (int u = 0; u < 8; ++u) w[u] = ok ? wp[(size_t)u * N] : 0.f;
        wp += (size_t)8 * N;
#pragma unroll
        for (int u = 0; u < 8; ++u) {
#pragma unroll
            for (int b4 = 0; b4 < 8; ++b4) { const f32x4 cv = *(const LAS f32x4*)(vp + u * 32 + 4 * b4);
                acc[4 * b4] += cv.x * w[u]; acc[4 * b4 + 1] += cv.y * w[u]; acc[4 * b4 + 2] += cv.z * w[u]; acc[4 * b4 + 3] += cv.w * w[u]; }
            asm volatile("" ::: "memory"); }
        vp += 8 * 32;
    }
    __syncthreads();
#pragma unroll
    for (int b = 0; b < 32; ++b) vT[(wave * 32 + b) * 64 + lane] = acc[b];
    __syncthreads();
#pragma unroll
    for (int q = 0; q < 4; ++q) { float s = 0.f;
#pragma unroll
        for (int w2 = 0; w2 < 8; ++w2) s += vT[(w2 * 32 + 4 * wave + q) * 64 + lane];
        res[q] = s; }
    __syncthreads();
}
__device__ __forceinline__ void p0_mod(const float* c, const float* ada_w, const float* ada_b, float* mod, LAS unsigned char* lds, int tid, int lane, int wave) {
    LAS float* condT = (LAS float*)lds;
    for (int item = blockIdx.x; item < NL * 96; item += gridDim.x) {
        __syncthreads();
        for (int e = tid; e < NB * DM; e += NWAVES * 64) { const int k = e >> 5, b = e & 31; const float v = c[b * DM + k]; condT[e] = v / (1.0f + expf(-v)); }
        __syncthreads();
        const int l = item / 96, g = item % 96, n = g * 64 + lane;
        float res[4]; b32_gemv(ada_w + (size_t)l * DM * MODP + n, true, MODP, condT, res, wave, lane);
        const float bb = ada_b[l * MODP + n]; float* o = mod + ((size_t)l * NB + wave * 4) * MODP + n;
        o[0] = res[0] + bb; o[MODP] = res[1] + bb; o[2 * MODP] = res[2] + bb; o[3 * MODP] = res[3] + bb;
    }
    __syncthreads();
}
template <int MODE>
__device__ __forceinline__ void transpose_item(const float* W, int K, int N, int nblk, bf16* WT, int ldw, LAS float* scr, int item, int lane) {
    const int kb = item / nblk, nb = item % nblk, k0 = 64 * kb, n0 = 32 * nb;
    const int nq = lane & 7, nn = n0 + 4 * nq; const bool ok = nn < N;
    const float* wp = W + (size_t)(k0 + (lane >> 3)) * N + (ok ? nn : 0); f32x4 vv[8];
#pragma unroll
    for (int i = 0; i < 8; ++i) vv[i] = *(const f32x4*)(wp + (size_t)(8 * i) * N);
#pragma unroll
    for (int i = 0; i < 8; ++i) { const int kk = 8 * i + (lane >> 3); const f32x4 v = ok ? vv[i] : (f32x4){0.f, 0.f, 0.f, 0.f};
        LAS float* d = scr + kk * 33 + 4 * nq; d[0] = v.x; d[1] = v.y; d[2] = v.z; d[3] = v.w; }
    LDS_WAIT();
    const int c = lane & 7;
#pragma unroll
    for (int j = 0; j < 4; ++j) { const int n = (lane >> 3) + 8 * j; const LAS float* s = scr + (8 * c) * 33 + n;
        v4u o; o.x = pk2(s[0 * 33], s[1 * 33]); o.y = pk2(s[2 * 33], s[3 * 33]); o.z = pk2(s[4 * 33], s[5 * 33]); o.w = pk2(s[6 * 33], s[7 * 33]);
        int row = n0 + n;
        if (MODE == 1) { const int up = row >= DFF ? 1 : 0, jj = row - up * DFF; row = (jj >> 7) * 256 + up * 128 + (jj & 127); }
        *(v4u*)(WT + (size_t)row * ldw + k0 + 8 * c) = o; }
    LDS_WAIT();
}
__device__ __forceinline__ void p0_weights(const float* w_in, const float* w_out, const float* f1, const float* f2, const float* lw2, const float* la2, const float* lg2, unsigned char* ws, LAS unsigned char* lds, int gw, int ngw, int wave, int lane) {
    LAS float* scr = (LAS float*)(lds + wave * 16384);
    constexpr int I_IN = (DM / 64) * (NPI / 32), I_OUT = (DM / 64) * (DM / 32), I_F1 = (DM / 64) * (NF1 / 32), I_F2 = (DFF / 64) * (DM / 32), I_L = I_IN + I_OUT + I_F1 + I_F2 + 48;
    for (int it = gw; it < NL * I_L; it += ngw) {
        const int l = it / I_L; int r = it % I_L;
        if (r < I_IN) { transpose_item<0>(w_in + (size_t)l * DM * D_IN, DM, D_IN, NPI / 32, (bf16*)(ws + WS_WIN) + (size_t)l * NPI * DM, DM, scr, r, lane); continue; } r -= I_IN;
        if (r < I_OUT) { transpose_item<0>(w_out + (size_t)l * DM * DM, DM, DM, DM / 32, (bf16*)(ws + WS_WOUT) + (size_t)l * DM * DM, DM, scr, r, lane); continue; } r -= I_OUT;
        if (r < I_F1) { transpose_item<1>(f1 + (size_t)l * DM * NF1, DM, NF1, NF1 / 32, (bf16*)(ws + WS_WF1) + (size_t)l * NF1 * DM, DM, scr, r, lane); continue; } r -= I_F1;
        if (r < I_F2) { transpose_item<0>(f2 + (size_t)l * DFF * DM, DFF, DM, DM / 32, (bf16*)(ws + WS_WF2) + (size_t)l * DM * DFF, DFF, scr, r, lane); continue; } r -= I_F2;
        bf16* wl = (bf16*)(ws + WS_WL) + (size_t)l * 384 * 256;
        if (r < 12) { transpose_item<0>(lw2 + (size_t)l * 64 * 384, 64, 384, 12, wl, 256, scr, r, lane); continue; } r -= 12;
        if (r < 12) { transpose_item<0>(la2 + (size_t)l * 64 * 384, 64, 384, 12, wl + 64, 256, scr, r, lane); continue; } r -= 12;
        transpose_item<0>(lg2 + (size_t)l * 128 * 384, 128, 384, 12, wl + 128, 256, scr, r, lane);
    }
}
__device__ __forceinline__ void norm_mod_phase(const float* xin32, const float* gain, const float* modl, int sh_off, int sc_off, bf16* out, int gw, int ngw, int lane) {
    for (int ci = gw; ci < MT / 32; ci += ngw) {
        const int b = ci >> 6; const float* mb = modl + (size_t)b * MODP;
        f32x4 gs[4], sh[4];
#pragma unroll
        for (int j = 0; j < 4; ++j) { const int col = 4 * lane + 256 * j; const f32x4 g = *(const f32x4*)(gain + col), s = *(const f32x4*)(mb + sc_off + col); gs[j] = g * (s + 1.0f); sh[j] = *(const f32x4*)(mb + sh_off + col); }
#pragma unroll 1
        for (int r = 0; r < 32; r += 4) {
            const size_t row = (size_t)ci * 32 + r; const f32x4* xr = (const f32x4*)(xin32 + row * DM) + lane; f32x4 v[4][4];
#pragma unroll
            for (int q = 0; q < 4; ++q)
#pragma unroll
                for (int j = 0; j < 4; ++j) v[q][j] = xr[q * (DM / 4) + 64 * j];
#pragma unroll
            for (int q = 0; q < 4; ++q) { float ss = 0.f;
#pragma unroll
                for (int j = 0; j < 4; ++j) ss += (v[q][j].x * v[q][j].x + v[q][j].y * v[q][j].y) + (v[q][j].z * v[q][j].z + v[q][j].w * v[q][j].w);
                const float rstd = 1.0f / sqrtf(wave_sum(ss) * (1.0f / DM) + RMS_EPS);
                v2u* o8 = (v2u*)(out + (row + q) * DM) + lane;
#pragma unroll
                for (int j = 0; j < 4; ++j) { const f32x4 y = v[q][j] * rstd * gs[j] + sh[j]; v2u w; w.x = pk2(y.x, y.y); w.y = pk2(y.z, y.w); o8[64 * j] = w; } }
        }
    }
}
__device__ __forceinline__ void final_norm_phase(const bf16* xs, float* out, const float* gain, int gw, int ngw, int lane) {
    f32x4 g[4];
#pragma unroll
    for (int j = 0; j < 4; ++j) g[j] = *(const f32x4*)(gain + 4 * lane + 256 * j);
#pragma unroll 1
    for (int row = 4 * gw; row < MT; row += 4 * ngw) {
        const v2u* xr = (const v2u*)(xs + (size_t)row * DM) + lane; v2u w[4][4];
#pragma unroll
        for (int q = 0; q < 4; ++q)
#pragma unroll
            for (int j = 0; j < 4; ++j) w[q][j] = xr[q * (DM / 4) + 64 * j];
#pragma unroll
        for (int q = 0; q < 4; ++q) { f32x4 v[4]; float ss = 0.f;
#pragma unroll
            for (int j = 0; j < 4; ++j) { const v2u ww = w[q][j]; v[j] = (f32x4){__uint_as_float(ww.x << 16), __uint_as_float(ww.x & 0xffff0000u), __uint_as_float(ww.y << 16), __uint_as_float(ww.y & 0xffff0000u)};
                ss += (v[j].x * v[j].x + v[j].y * v[j].y) + (v[j].z * v[j].z + v[j].w * v[j].w); }
            const float rstd = 1.0f / sqrtf(wave_sum(ss) * (1.0f / DM) + RMS_EPS);
            f32x4* o = (f32x4*)(out + (size_t)(row + q) * DM) + lane;
#pragma unroll
            for (int j = 0; j < 4; ++j) o[64 * j] = v[j] * rstd * g[j]; }
    }
}
__device__ __forceinline__ void panel_norm_rows(const bf16* xs, const float* gain, const float* modb, int sh_off, int sc_off, bf16* out, int pm, int wave, int lane) {
    f32x4 gs[4], sh[4];
#pragma unroll
    for (int j = 0; j < 4; ++j) { const int col = 4 * lane + 256 * j; const f32x4 g = *(const f32x4*)(gain + col), s = *(const f32x4*)(modb + sc_off + col); gs[j] = g * (s + 1.0f); sh[j] = *(const f32x4*)(modb + sh_off + col); }
#pragma unroll 1
    for (int r = 0; r < 32; r += 4) {
        const size_t row = (size_t)pm * 256 + wave * 32 + r;
        const v2u* xr = (const v2u*)(xs + row * DM) + lane; v2u w[4][4];
#pragma unroll
        for (int q = 0; q < 4; ++q)
#pragma unroll
            for (int j = 0; j < 4; ++j) w[q][j] = xr[q * (DM / 4) + 64 * j];
#pragma unroll
        for (int q = 0; q < 4; ++q) { f32x4 v[4]; float ss = 0.f;
#pragma unroll
            for (int j = 0; j < 4; ++j) { const v2u ww = w[q][j]; v[j] = (f32x4){__uint_as_float(ww.x << 16), __uint_as_float(ww.x & 0xffff0000u), __uint_as_float(ww.y << 16), __uint_as_float(ww.y & 0xffff0000u)};
                ss += (v[j].x * v[j].x + v[j].y * v[j].y) + (v[j].z * v[j].z + v[j].w * v[j].w); }
            const float rstd = __builtin_amdgcn_rsqf(wave_sum(ss) * (1.0f / DM) + RMS_EPS);
            v2u* o8 = (v2u*)(out + (row + q) * DM) + lane;
#pragma unroll
            for (int j = 0; j < 4; ++j) { const f32x4 y = v[j] * rstd * gs[j] + sh[j]; v2u ww; ww.x = pk2(y.x, y.y); ww.y = pk2(y.z, y.w); o8[64 * j] = ww; } }
    }
}
template <class Sched>
__device__ __forceinline__ void fused_panel_norm(const Sched& S, unsigned* cnt, const bf16* xs, const float* gain, const float* modl, int sh_off, int sc_off, bf16* out, int wave, int lane) {
    pg8::Unit u[4]; bool has[4];
#pragma unroll
    for (int i = 0; i < 4; ++i) has[i] = S.next(i, u[i]);
    if (wave == 0 && lane == 0) {
        __builtin_amdgcn_fence(__ATOMIC_RELEASE, "agent"); asm volatile("s_waitcnt vmcnt(0)" ::: "memory");
#pragma unroll
        for (int i = 0; i < 4; ++i) if (has[i]) __hip_atomic_fetch_add(cnt + 64 * u[i].pm, 1u, __ATOMIC_RELAXED, __HIP_MEMORY_SCOPE_AGENT);
    }
#pragma unroll
    for (int i = 0; i < 4; ++i) {
        if (!has[i] || u[i].pn != ((u[i].pm >> 3) & 3)) continue;
        if (wave == 0) { unsigned spins = 0u;
            while (__hip_atomic_load(cnt + 64 * u[i].pm, __ATOMIC_RELAXED, __HIP_MEMORY_SCOPE_AGENT) < 4u) { __builtin_amdgcn_s_sleep(2); if (++spins > (1u << 22)) break; }
            __builtin_amdgcn_fence(__ATOMIC_ACQUIRE, "agent"); asm volatile("s_waitcnt vmcnt(0)" ::: "memory"); }
        __syncthreads();
        panel_norm_rows(xs, gain, modl + (size_t)(u[i].pm >> 3) * MODP, sh_off, sc_off, out, u[i].pm, wave, lane);
#if PROBE_PN
        asm volatile("" ::: "memory"); panel_norm_rows(xs, gain, modl + (size_t)(u[i].pm >> 3) * MODP, sh_off, sc_off, out, u[i].pm, wave, lane);
#endif
    }
}
#define WG_BAR() do { asm volatile("s_waitcnt vmcnt(0) lgkmcnt(0)" ::: "memory"); __builtin_amdgcn_s_barrier(); asm volatile("" ::: "memory"); } while (0)
#define WG_BAR_L() do { asm volatile("s_waitcnt lgkmcnt(0)" ::: "memory"); __builtin_amdgcn_s_barrier(); asm volatile("" ::: "memory"); } while (0)
typedef short bf16x8p __attribute__((ext_vector_type(8)));
__device__ __forceinline__ void rwkv_prep_mfma(const bf16* proj, const float* mu, const float* w0, const float* a0, const bf16* WL, float* DEC, bf16* AA, bf16* GG, LAS unsigned char* lds, int wave) {
    constexpr int AP = 264;
    LAS bf16* act = (LAS bf16*)lds;
    bf16x8p bw[2][3], ba[2][3], bg[4][3];
    { const int lane = lane_id_opq(); const bf16* bfr = WL + (size_t)(48 * wave + (lane & 15)) * 256 + 8 * (lane >> 4);
#pragma unroll
      for (int nt = 0; nt < 3; ++nt) {
#pragma unroll
          for (int ks = 0; ks < 2; ++ks) { bw[ks][nt] = *(const bf16x8p*)(bfr + 16 * nt * 256 + 32 * ks); ba[ks][nt] = *(const bf16x8p*)(bfr + 16 * nt * 256 + 64 + 32 * ks); }
#pragma unroll
          for (int ks = 0; ks < 4; ++ks) bg[ks][nt] = *(const bf16x8p*)(bfr + 16 * nt * 256 + 128 + 32 * ks); } }
#pragma unroll 1
    for (int item = blockIdx.x; item < MT / 64; item += gridDim.x) {
        const int lane = lane_id_opq(), tid = wave * 64 + lane, q4 = lane >> 4, lc = lane & 15;
        const size_t m0 = (size_t)item * 64; const int t0 = (int)(m0 % SEQ);
        { const int tt = tid >> 3, cg = tid & 7; const bf16* p = proj + (m0 + tt) * NPI + RW_B + 1152 + 32 * cg; const bool hp = (t0 + tt) > 0; const bf16* pp = hp ? p - NPI : p; const float* mup = mu + 1152 + 32 * cg;
          v4u cur[4], prv[4]; f32x4 m0v[4], m1v[4];
#pragma unroll
          for (int v = 0; v < 4; ++v) { cur[v] = *(const v4u*)(p + 8 * v); prv[v] = *(const v4u*)(pp + 8 * v); m0v[v] = *(const f32x4*)(mup + 8 * v); m1v[v] = *(const f32x4*)(mup + 8 * v + 4); }
#pragma unroll
          for (int v = 0; v < 4; ++v) {
              float x[8];
#pragma unroll
              for (int e = 0; e < 4; ++e) { const unsigned cw = cur[v][e], pw = hp ? prv[v][e] : 0u; const float c0 = __uint_as_float(cw << 16), c1 = __uint_as_float(cw & 0xffff0000u), p0 = __uint_as_float(pw << 16), p1 = __uint_as_float(pw & 0xffff0000u);
                  const float mu0 = e < 2 ? m0v[v][2 * e] : m1v[v][2 * e - 4], mu1 = e < 2 ? m0v[v][2 * e + 1] : m1v[v][2 * e - 3];
                  x[2 * e] = c0 + (p0 - c0) * mu0; x[2 * e + 1] = c1 + (p1 - c1) * mu1; }
              if (cg < 2) {
#pragma unroll
                  for (int e = 0; e < 8; ++e) x[e] = 2.0f * fsigmoid(2.0f * x[e]) - 1.0f;
              } else if (cg >= 4) {
#pragma unroll
                  for (int e = 0; e < 8; ++e) x[e] = fsigmoid(x[e]);
              }
              v4u o; o.x = pk2(x[0], x[1]); o.y = pk2(x[2], x[3]); o.z = pk2(x[4], x[5]); o.w = pk2(x[6], x[7]);
              *(LAS v4u*)(act + tt * AP + 32 * cg + 8 * v) = o; } }
        WG_BAR_L();
        const LAS bf16* afr = act + lc * AP + 8 * q4;
        { f32x4 acc[4][3];
#pragma unroll
          for (int mt = 0; mt < 4; ++mt)
#pragma unroll
              for (int nt = 0; nt < 3; ++nt) acc[mt][nt] = (f32x4){0.f, 0.f, 0.f, 0.f};
#pragma unroll
          for (int ks = 0; ks < 2; ++ks)
#pragma unroll
              for (int mt = 0; mt < 4; ++mt) { const bf16x8p aq = *(const LAS bf16x8p*)(afr + 16 * mt * AP + 32 * ks);
#pragma unroll
                  for (int nt = 0; nt < 3; ++nt) acc[mt][nt] = __builtin_amdgcn_mfma_f32_16x16x32_bf16(aq, bw[ks][nt], acc[mt][nt], 0, 0, 0); }
#pragma unroll
          for (int nt = 0; nt < 3; ++nt) { const int n = 48 * wave + 16 * nt + lc; const float w0n = w0[n]; float carry = 0.f;
#pragma unroll
              for (int mt = 0; mt < 4; ++mt) { float pr[4];
#pragma unroll
                  for (int r = 0; r < 4; ++r) { const float ld = -0.60653066f * fsigmoid(w0n + acc[mt][nt][r]); pr[r] = r ? pr[r - 1] + ld : ld; }
                  const float tot = pr[3]; float s1 = tot; { const float u = __shfl_up(s1, 16); if (q4 >= 1) s1 += u; } { const float u = __shfl_up(s1, 32); if (q4 >= 2) s1 += u; }
                  const float excl = carry + (s1 - tot), tile_tot = __shfl(s1, 48 + lc);
                  float* dp = DEC + (m0 + 16 * mt + 4 * q4) * 384 + n;
#pragma unroll
                  for (int r = 0; r < 4; ++r) dp[r * 384] = excl + pr[r];
                  carry += tile_tot; } } }
        { f32x4 acc[4][3];
#pragma unroll
          for (int mt = 0; mt < 4; ++mt)
#pragma unroll
              for (int nt = 0; nt < 3; ++nt) acc[mt][nt] = (f32x4){0.f, 0.f, 0.f, 0.f};
#pragma unroll
          for (int ks = 0; ks < 2; ++ks)
#pragma unroll
              for (int mt = 0; mt < 4; ++mt) { const bf16x8p aq = *(const LAS bf16x8p*)(afr + 16 * mt * AP + 64 + 32 * ks);
#pragma unroll
                  for (int nt = 0; nt < 3; ++nt) acc[mt][nt] = __builtin_amdgcn_mfma_f32_16x16x32_bf16(ba[ks][nt], aq, acc[mt][nt], 0, 0, 0); }
#pragma unroll
          for (int nt = 0; nt < 3; ++nt) { const int n = 48 * wave + 16 * nt + 4 * q4; const f32x4 a0n = *(const f32x4*)(a0 + n);
#pragma unroll
              for (int mt = 0; mt < 4; ++mt) { v2u w; w.x = pk2(fsigmoid(a0n.x + acc[mt][nt][0]), fsigmoid(a0n.y + acc[mt][nt][1])); w.y = pk2(fsigmoid(a0n.z + acc[mt][nt][2]), fsigmoid(a0n.w + acc[mt][nt][3]));
                  *(v2u*)(AA + (m0 + 16 * mt + lc) * 384 + n) = w; } } }
        { f32x4 acc[4][3];
#pragma unroll
          for (int mt = 0; mt < 4; ++mt)
#pragma unroll
              for (int nt = 0; nt < 3; ++nt) acc[mt][nt] = (f32x4){0.f, 0.f, 0.f, 0.f};
#pragma unroll
          for (int ks = 0; ks < 4; ++ks)
#pragma unroll
              for (int mt = 0; mt < 4; ++mt) { const bf16x8p aq = *(const LAS bf16x8p*)(afr + 16 * mt * AP + 128 + 32 * ks);
#pragma unroll
                  for (int nt = 0; nt < 3; ++nt) acc[mt][nt] = __builtin_amdgcn_mfma_f32_16x16x32_bf16(bg[ks][nt], aq, acc[mt][nt], 0, 0, 0); }
#pragma unroll
          for (int nt = 0; nt < 3; ++nt) { const int n = 48 * wave + 16 * nt + 4 * q4;
#pragma unroll
              for (int mt = 0; mt < 4; ++mt) { v2u w; w.x = pk2(acc[mt][nt][0], acc[mt][nt][1]); w.y = pk2(acc[mt][nt][2], acc[mt][nt][3]);
                  *(v2u*)(GG + (m0 + 16 * mt + lc) * 384 + n) = w; } } }
        WG_BAR_L();
    }
}
typedef short bf16x8_t __attribute__((ext_vector_type(8)));
template <int KS>
__device__ __forceinline__ f32x4 mm_tile(const LAS bf16* A, const LAS bf16* B, f32x4 acc) {
#pragma unroll
    for (int ks = 0; ks < KS; ++ks) {
        const bf16x8_t a = *(const LAS bf16x8_t*)(A + ks * 32), b = *(const LAS bf16x8_t*)(B + ks * 32);
        acc = __builtin_amdgcn_mfma_f32_16x16x32_bf16(a, b, acc, 0, 0, 0);
    }
    return acc;
}
__device__ __forceinline__ unsigned short f2bf16(float f) { return (unsigned short)f2bf(f); }
constexpr int LP = 72;
constexpr int LPM = 104;

__device__ __forceinline__ void ret_unit(int b, int h, const bf16* proj, const float* gn, bf16* mixed, LAS unsigned char* lds, int wave, int lane0) {
    LAS bf16* Qs = (LAS bf16*)lds; LAS bf16* Ks = Qs + 64 * LP; LAS bf16* Kdt = Ks + 64 * LP; LAS bf16* Vt = Kdt + 64 * LP; LAS bf16* Ps = Vt + 64 * LP; LAS bf16* Stt = Ps + 64 * LP; LAS bf16* Gs = Stt + 64 * LP;
    const int lane = lane0, q4 = lane >> 4, lc = lane & 15;
    const float inv = powf(10000.0f, -(float)(2 * (lane & 31)) / 64.0f);
    float cs[8], sn[8];
#pragma unroll
    for (int i = 0; i < 8; ++i) __sincosf((float)(8 * wave + i) * inv, &sn[i], &cs[i]);
    float c64, s64; sincosf(64.0f * inv, &s64, &c64);
    const float lg2 = log2f(1.0f - exp2f(-5.0f - (float)h));
    float kdec[8];
#pragma unroll
    for (int i = 0; i < 8; ++i) kdec[i] = exp2f((float)(63 - (8 * wave + i)) * lg2);
    const float cd = exp2f(64.0f * lg2);
    f32x4 st[4];
#pragma unroll
    for (int i = 0; i < 4; ++i) st[i] = (f32x4){0.f, 0.f, 0.f, 0.f};
    for (int i = wave * 64 + lane; i < 64 * LP / 2; i += 512) ((LAS unsigned*)Stt)[i] = 0u;
    const size_t m0 = (size_t)b * SEQ;
    const bf16* P0 = proj + m0 * NPI + h * 64;
    unsigned short rq[8], rk[8], rv[8], rg[8];
#pragma unroll
    for (int i = 0; i < 8; ++i) { const bf16* p = P0 + (size_t)(8 * wave + i) * NPI; rq[i] = p[lane]; rk[i] = p[256 + lane]; rv[i] = p[512 + lane]; rg[i] = p[768 + lane]; }
    float gain4[4];
#pragma unroll
    for (int ct = 0; ct < 4; ++ct) gain4[ct] = gn[h * 64 + 16 * ct + lc];
    float dmk[2][4], qdk[4];
#pragma unroll
    for (int u = 0; u < 2; ++u)
#pragma unroll
        for (int r = 0; r < 4; ++r) { const int l = 16 * (wave >> 1) + 4 * q4 + r, m = 16 * (2 * (wave & 1) + u) + lc; dmk[u][r] = (l >= m) ? exp2f((float)(l - m) * lg2) : 0.f; }
#pragma unroll
    for (int r = 0; r < 4; ++r) qdk[r] = exp2f((float)(16 * (wave & 3) + 4 * q4 + r + 1) * lg2);
#pragma unroll 1
    for (int c = 0; c < SEQ / 64; ++c) {
        const int lane = lane_id_opq(), q4 = lane >> 4, lc = lane & 15, o72 = lc * LP + 8 * q4;
        { unsigned short kd[8];
#pragma unroll
          for (int i = 0; i < 8; ++i) { const int tt = 8 * wave + i;
              const float q = bf2f(rq[i]), k = bf2f(rk[i]); const float qp = __shfl_xor(q, 32), kp = __shfl_xor(k, 32);
              const float qr = lane < 32 ? q * cs[i] - qp * sn[i] : qp * sn[i] + q * cs[i];
              const float kr = (lane < 32 ? k * cs[i] - kp * sn[i] : kp * sn[i] + k * cs[i]) * 0.125f;
              Qs[tt * LP + lane] = f2bf16(qr); Ks[tt * LP + lane] = f2bf16(kr); Gs[tt * LP + lane] = rg[i]; kd[i] = f2bf16(kr * kdec[i]);
              const float cn = cs[i] * c64 - sn[i] * s64, snn = sn[i] * c64 + cs[i] * s64; cs[i] = cn; sn[i] = snn; }
          v4u w; w.x = kd[0] | ((unsigned)kd[1] << 16); w.y = kd[2] | ((unsigned)kd[3] << 16); w.z = kd[4] | ((unsigned)kd[5] << 16); w.w = kd[6] | ((unsigned)kd[7] << 16);
          *(LAS v4u*)(Kdt + lane * LP + 8 * wave) = w;
          w.x = rv[0] | ((unsigned)rv[1] << 16); w.y = rv[2] | ((unsigned)rv[3] << 16); w.z = rv[4] | ((unsigned)rv[5] << 16); w.w = rv[6] | ((unsigned)rv[7] << 16);
          *(LAS v4u*)(Vt + lane * LP + 8 * wave) = w; }
        WG_BAR_L();
        if (c + 1 < SEQ / 64) {
#pragma unroll
            for (int i = 0; i < 8; ++i) { const bf16* p = P0 + (size_t)(64 * (c + 1) + 8 * wave + i) * NPI; rq[i] = p[lane]; rk[i] = p[256 + lane]; rv[i] = p[512 + lane]; rg[i] = p[768 + lane]; } }
        { const int rt = wave >> 1;
#pragma unroll
          for (int u = 0; u < 2; ++u) { const int ct = 2 * (wave & 1) + u;
              f32x4 s = (f32x4){0.f, 0.f, 0.f, 0.f};
              if (ct <= rt) s = mm_tile<2>(Qs + 16 * rt * LP + o72, Ks + 16 * ct * LP + o72, s);
#pragma unroll
              for (int r = 0; r < 4; ++r) { const int l = 16 * rt + 4 * q4 + r, m = 16 * ct + lc; Ps[l * LP + m] = f2bf16(s[r] * dmk[u][r]); } } }
        f32x4 inter[4];
        if (wave < 4) {
#pragma unroll
            for (int ct = 0; ct < 4; ++ct) inter[ct] = mm_tile<2>(Qs + 16 * wave * LP + o72, Stt + 16 * ct * LP + o72, (f32x4){0.f, 0.f, 0.f, 0.f}); }
        WG_BAR_L();
        if (wave < 4) {
            f32x4 y[4];
#pragma unroll
            for (int ct = 0; ct < 4; ++ct) y[ct] = mm_tile<2>(Ps + 16 * wave * LP + o72, Vt + 16 * ct * LP + o72, (f32x4){0.f, 0.f, 0.f, 0.f});
#pragma unroll
            for (int r = 0; r < 4; ++r) { const int l = 16 * wave + 4 * q4 + r; const float qd = qdk[r];
                float s = 0.f;
#pragma unroll
                for (int ct = 0; ct < 4; ++ct) { y[ct][r] += qd * inter[ct][r]; s += y[ct][r]; }
                const float mean = sum16(s) * (1.0f / 64.0f); float qv = 0.f;
#pragma unroll
                for (int ct = 0; ct < 4; ++ct) { const float dd = y[ct][r] - mean; qv += dd * dd; }
                const float rstd = __builtin_amdgcn_rsqf(sum16(qv) * (1.0f / 64.0f) + GN_EPS);
                bf16* orow = mixed + (m0 + 64 * c + l) * DM + h * 64 + lc;
#pragma unroll
                for (int ct = 0; ct < 4; ++ct) { const float g = bf2f(Gs[l * LP + 16 * ct + lc]); orow[16 * ct] = f2bf16((y[ct][r] - mean) * rstd * gain4[ct] * (g * fsigmoid(g))); } }
        } else {
            const int dt = wave - 4;
#pragma unroll
            for (int ct = 0; ct < 4; ++ct) { st[ct] = mm_tile<2>(Kdt + 16 * dt * LP + o72, Vt + 16 * ct * LP + o72, st[ct] * cd);
                v2u w; w.x = pk2(st[ct][0], st[ct][1]); w.y = pk2(st[ct][2], st[ct][3]);
                *(LAS v2u*)(Stt + (16 * ct + lc) * LP + 16 * dt + 4 * q4) = w; }
        }
        WG_BAR_L();
    }
}

__device__ __forceinline__ void mlstm_unit(int b, int h, const bf16* proj, const float* conv_w, const float* conv_b, const float* i_b, const float* f_b, const float* gn, bf16* mixed,
                                           LAS unsigned char* lds, int wave, int lane0) {
    LAS bf16* Qs = (LAS bf16*)lds; LAS bf16* Ks = Qs + 64 * LPM; LAS bf16* Kdt = Ks + 64 * LPM; LAS bf16* Vt = Kdt + 96 * LP; LAS bf16* Ps = Vt + 112 * LP; LAS bf16* Stt = Ps + 64 * LP; LAS bf16* Os = Stt + 112 * LPM;
    LAS float* ev = (LAS float*)(Os + 64 * LPM); LAS float* pmv = ev + 64; LAS float* flv = pmv + 64;
    const int lane = lane0, lc = lane & 15;
    float wq0[4], wq1[4], wk0[4], wk1[4], bq0, bq1, bk0, bk1;
    { const int cq = h * 96 + (lane < 48 ? 2 * lane : 0), ck = 384 + cq;
#pragma unroll
    for (int j = 0; j < 4; ++j) { wq0[j] = conv_w[j * 768 + cq]; wq1[j] = conv_w[j * 768 + cq + 1]; wk0[j] = conv_w[j * 768 + ck]; wk1[j] = conv_w[j * 768 + ck + 1]; }
    bq0 = conv_b[cq]; bq1 = conv_b[cq + 1]; bk0 = conv_b[ck]; bk1 = conv_b[ck + 1]; }
    const float ib = i_b[h], fb = f_b[h];
    const float ksc = 0.10206207261596577f;
    f32x4 st[11];
#pragma unroll
    for (int i = 0; i < 11; ++i) st[i] = (f32x4){0.f, 0.f, 0.f, 0.f};
    for (int i = wave * 64 + lane; i < 112 * LPM / 2; i += 512) ((LAS unsigned*)Stt)[i] = 0u;
    for (int i = wave * 64 + lane; i < 16 * LP / 2; i += 512) ((LAS unsigned*)(Vt + 96 * LP))[i] = (i < LP / 2) ? 0x3f803f80u : 0u;
    float mprev = 0.f;
    const size_t m0 = (size_t)b * SEQ;
    const bf16* PB = proj + m0 * NPI + ML_B;
    float gain6[6];
#pragma unroll
    for (int ct = 0; ct < 6; ++ct) gain6[ct] = gn[640 + h * 96 + 16 * ct + lc];
    unsigned xq[11], xk[11], vv[8], og[8]; unsigned short gi, gf;
#define ML_LOAD(cc) do { const int tb_ = 64 * (cc) + 8 * wave; \
        _Pragma("unroll") for (int i = 0; i < 11; ++i) { const int t_ = tb_ - 3 + i; const bf16* p_ = PB + (size_t)(t_ < 0 ? 0 : t_) * NPI + cq; xq[i] = *(const unsigned*)p_; xk[i] = *(const unsigned*)(p_ + 384); } \
        _Pragma("unroll") for (int i = 0; i < 8; ++i) { const bf16* p_ = PB + (size_t)(tb_ + i) * NPI + 768 + cq; vv[i] = *(const unsigned*)p_; og[i] = *(const unsigned*)(p_ + 384); } \
        { const bf16* p_ = PB + (size_t)(64 * (cc) + lane) * NPI; gi = p_[1536 + h]; gf = p_[1540 + h]; } } while (0)
    { const int cq = h * 96 + (lane < 48 ? 2 * lane : 0); ML_LOAD(0); }
#pragma unroll 1
    for (int c = 0; c < SEQ / 64; ++c) {
        const int lane = lane_id_opq(), q4 = lane >> 4, lc = lane & 15, o72 = lc * LP + 8 * q4, o104 = lc * LPM + 8 * q4;
        const bool act = lane < 48; const int dd = act ? 2 * lane : 0, cq = h * 96 + dd;
        const int tb = 64 * c + 8 * wave;
        float pm63, carry, ev_l; const float mold = mprev;
        { const float ic = __uint_as_float((unsigned)gi << 16) + ib, lf = flogsigmoid(__uint_as_float((unsigned)gf << 16) + fb);
          const float bc = wave_prefix_sum(lf), e = ic - bc; const float pm = fmaxf(wave_prefix_max(e), mprev);
          pm63 = __builtin_bit_cast(float, __builtin_amdgcn_readlane(__builtin_bit_cast(int, pm), 63)); carry = fexp(mprev - pm63); ev_l = e;
          if (wave == 0) { ev[lane] = e; pmv[lane] = pm; flv[lane] = fexp(-(bc + pm)); }
          mprev = __builtin_bit_cast(float, __builtin_amdgcn_readlane(__builtin_bit_cast(int, bc), 63)) + pm63; }
        { unsigned short kd0[8], kd1[8];
          if (tb == 0) { xq[0] = xq[1] = xq[2] = 0u; xk[0] = xk[1] = xk[2] = 0u; }
#pragma unroll
          for (int i = 0; i < 8; ++i) { const int tt = 8 * wave + i;
#define LO_(w) __uint_as_float((w) << 16)
#define HI_(w) __uint_as_float((w) & 0xffff0000u)
              float q0 = bq0 + LO_(xq[i]) * wq0[0] + LO_(xq[i + 1]) * wq0[1] + LO_(xq[i + 2]) * wq0[2] + LO_(xq[i + 3]) * wq0[3];
              float k0 = bk0 + LO_(xk[i]) * wk0[0] + LO_(xk[i + 1]) * wk0[1] + LO_(xk[i + 2]) * wk0[2] + LO_(xk[i + 3]) * wk0[3];
              float q1 = bq1 + HI_(xq[i]) * wq1[0] + HI_(xq[i + 1]) * wq1[1] + HI_(xq[i + 2]) * wq1[2] + HI_(xq[i + 3]) * wq1[3];
              float k1 = bk1 + HI_(xk[i]) * wk1[0] + HI_(xk[i + 1]) * wk1[1] + HI_(xk[i + 2]) * wk1[2] + HI_(xk[i + 3]) * wk1[3];
#undef LO_
#undef HI_
              q0 = q0 * fsigmoid(q0); k0 = k0 * fsigmoid(k0) * ksc; q1 = q1 * fsigmoid(q1); k1 = k1 * fsigmoid(k1) * ksc;
              const float wsi = fexp(__builtin_bit_cast(float, __builtin_amdgcn_readlane(__builtin_bit_cast(int, ev_l), tt)) - pm63);
              kd0[i] = f2bf16(k0 * wsi); kd1[i] = f2bf16(k1 * wsi);
              if (act) { *(LAS unsigned*)(Qs + tt * LPM + dd) = pk2(q0, q1); *(LAS unsigned*)(Ks + tt * LPM + dd) = pk2(k0, k1); } }
          if (act) {
              v4u w; w.x = kd0[0] | ((unsigned)kd0[1] << 16); w.y = kd0[2] | ((unsigned)kd0[3] << 16); w.z = kd0[4] | ((unsigned)kd0[5] << 16); w.w = kd0[6] | ((unsigned)kd0[7] << 16);
              *(LAS v4u*)(Kdt + dd * LP + 8 * wave) = w;
              w.x = kd1[0] | ((unsigned)kd1[1] << 16); w.y = kd1[2] | ((unsigned)kd1[3] << 16); w.z = kd1[4] | ((unsigned)kd1[5] << 16); w.w = kd1[6] | ((unsigned)kd1[7] << 16);
              *(LAS v4u*)(Kdt + (dd + 1) * LP + 8 * wave) = w;
              w.x = (vv[0] & 0xffffu) | (vv[1] << 16); w.y = (vv[2] & 0xffffu) | (vv[3] << 16); w.z = (vv[4] & 0xffffu) | (vv[5] << 16); w.w = (vv[6] & 0xffffu) | (vv[7] << 16);
              *(LAS v4u*)(Vt + dd * LP + 8 * wave) = w;
              w.x = (vv[0] >> 16) | (vv[1] & 0xffff0000u); w.y = (vv[2] >> 16) | (vv[3] & 0xffff0000u); w.z = (vv[4] >> 16) | (vv[5] & 0xffff0000u); w.w = (vv[6] >> 16) | (vv[7] & 0xffff0000u);
              *(LAS v4u*)(Vt + (dd + 1) * LP + 8 * wave) = w; } }
        WG_BAR_L();
        unsigned ogc[8];
#pragma unroll
        for (int i = 0; i < 8; ++i) ogc[i] = og[i];
        if (c + 1 < SEQ / 64) ML_LOAD(c + 1);
        { const int rt = wave >> 1;
#pragma unroll
          for (int u = 0; u < 2; ++u) { const int ct = 2 * (wave & 1) + u;
              f32x4 s = (f32x4){0.f, 0.f, 0.f, 0.f};
              if (ct <= rt) s = mm_tile<3>(Qs + 16 * rt * LPM + o104, Ks + 16 * ct * LPM + o104, s);
              const float em = ev[16 * ct + lc];
#pragma unroll
              for (int r = 0; r < 4; ++r) { const int l = 16 * rt + 4 * q4 + r, m = 16 * ct + lc; const float val = (l >= m) ? s[r] * fexp(em - pmv[l]) : 0.f; Ps[l * LP + m] = f2bf16(val); } } }
        f32x4 inter[7];
        if (wave < 4) {
#pragma unroll
            for (int ct = 0; ct < 7; ++ct) inter[ct] = mm_tile<3>(Qs + 16 * wave * LPM + o104, Stt + 16 * ct * LPM + o104, (f32x4){0.f, 0.f, 0.f, 0.f}); }
#pragma unroll
        for (int i = 0; i < 8; ++i) if (act) *(LAS unsigned*)(Os + (8 * wave + i) * LPM + dd) = ogc[i];
        WG_BAR_L();
        if (wave < 4) {
            f32x4 y[7];
#pragma unroll
            for (int ct = 0; ct < 7; ++ct) y[ct] = mm_tile<2>(Ps + 16 * wave * LP + o72, Vt + 16 * ct * LP + o72, (f32x4){0.f, 0.f, 0.f, 0.f});
#pragma unroll
            for (int r = 0; r < 4; ++r) { const int l = 16 * wave + 4 * q4 + r; const float iw = fexp(mold - pmv[l]);
#pragma unroll
                for (int ct = 0; ct < 7; ++ct) y[ct][r] += iw * inter[ct][r];
                const float den = __shfl(y[6][r], lane & 48);
                const float dn = __builtin_amdgcn_rcpf(fmaxf(fabsf(den), flv[l]));
                float s = 0.f;
#pragma unroll
                for (int ct = 0; ct < 6; ++ct) { y[ct][r] *= dn; s += y[ct][r]; }
                const float mean = sum16(s) * (1.0f / 96.0f); float qv = 0.f;
#pragma unroll
                for (int ct = 0; ct < 6; ++ct) { const float dd = y[ct][r] - mean; qv += dd * dd; }
                const float rstd = __builtin_amdgcn_rsqf(sum16(qv) * (1.0f / 96.0f) + GN_EPS);
                bf16* orow = mixed + (m0 + 64 * c + l) * DM + 640 + h * 96 + lc;
#pragma unroll
                for (int ct = 0; ct < 6; ++ct) { const float o = bf2f(Os[l * LPM + 16 * ct + lc]); orow[16 * ct] = f2bf16((y[ct][r] - mean) * rstd * gain6[ct] * fsigmoid(o)); } }
        } else {
#pragma unroll
            for (int i = 0; i < 11; ++i) { const int t = (wave - 4) + 4 * i;
                if (t < 42) { const int dt = t / 7, et = t % 7;
                    st[i] = mm_tile<2>(Kdt + 16 * dt * LP + o72, Vt + 16 * et * LP + o72, st[i] * carry);
                    v2u w; w.x = pk2(st[i][0], st[i][1]); w.y = pk2(st[i][2], st[i][3]);
                    *(LAS v2u*)(Stt + (16 * et + lc) * LPM + 16 * dt + 4 * q4) = w; } }
        }
        WG_BAR_L();
    }
#undef ML_LOAD
}
#ifndef RW_DBG
#define RW_DBG 0xFF
#endif
__device__ __forceinline__ void rwkv_unit(int b, int h, const bf16* proj, const float* CUM, const bf16* AA, const bf16* GG, const float* mu, const float* k_k, const float* k_a, const float* r_k,
                                          const float* gn, bf16* mixed, LAS unsigned char* lds, int wave, int lane0,
                                          int cb, int ce, const float* hs_in, unsigned* flag_in, float* hs_out, unsigned* flag_out) {
    constexpr int SLOT = 64 * LP;
    LAS bf16* KH = (LAS bf16*)lds; LAS bf16* BH = KH + SLOT; LAS bf16* KT = BH + SLOT; LAS bf16* RT = KT + SLOT; LAS bf16* KHgt = RT + SLOT; LAS bf16* BHgtn = KHgt + SLOT;
    LAS bf16* Vt = BHgtn + SLOT; LAS bf16* AkT = Vt + SLOT; LAS bf16* BbTn = AkT + SLOT; LAS bf16* BkT = BbTn + SLOT; LAS bf16* S0b = BkT + SLOT; LAS bf16* Loffb = S0b + SLOT; LAS bf16* Vr = Loffb + SLOT; LAS bf16* Gr = Vr + SLOT;
    LAS float* RHS = (LAS float*)KH; LAS bf16* Ut = KT;
    LAS float* LTd = (LAS float*)(Gr + SLOT);
    LAS float* XS = LTd + 64 * 20;
    LAS float* GCv = XS + 16 * 64; LAS float* bonv = GCv + 64;
    LAS float* bonv2 = bonv + 64; LAS bf16* Vr2 = (LAS bf16*)(bonv2 + 64); LAS bf16* Gr2 = Vr2 + SLOT;
    float mu_r, mu_k, mu_v, kkc, kac, rkc;
    { const int c0 = h * 64 + lane0; mu_r = mu[c0]; mu_k = mu[384 + c0]; mu_v = mu[768 + c0]; kkc = k_k[c0]; kac = k_a[c0]; rkc = r_k[c0]; }
    for (int i = wave * 64 + lane0; i < 5 * SLOT / 2; i += 512) ((LAS unsigned*)AkT)[i] = 0u;
    float gain4[4];
#pragma unroll
    for (int ct = 0; ct < 4; ++ct) gain4[ct] = gn[256 + h * 64 + 16 * ct + (lane0 & 15)];
    f32x4 sacc[4];
#pragma unroll
    for (int i = 0; i < 4; ++i) sacc[i] = (f32x4){0.f, 0.f, 0.f, 0.f};
    if (hs_in) {
        if (wave == 0) { unsigned spins = 0u;
            while (__hip_atomic_load(flag_in, __ATOMIC_RELAXED, __HIP_MEMORY_SCOPE_AGENT) == 0u) { __builtin_amdgcn_s_sleep(4); if (++spins > (1u << 22)) break; }
            __builtin_amdgcn_fence(__ATOMIC_ACQUIRE, "agent"); asm volatile("s_waitcnt vmcnt(0)" ::: "memory"); }
        WG_BAR();
        if (wave < 4) {
#pragma unroll
            for (int jt = 0; jt < 4; ++jt) {
#pragma unroll
                for (int r = 0; r < 4; ++r) { sacc[jt][r] = hs_in[(wave * 4 + jt) * 256 + r * 64 + lane0];
                    S0b[(16 * wave + 4 * (lane0 >> 4) + r) * LP + 16 * jt + (lane0 & 15)] = f2bf16(sacc[jt][r]); } } }
    }
    const size_t m0 = (size_t)b * SEQ;
    const bf16* PU = proj + m0 * NPI + RW_B + h * 64;
    const float* CU = CUM + m0 * 384 + h * 64; const bf16* AU = AA + m0 * 384 + h * 64; const bf16* GU = GG + m0 * 384 + h * 64;
    unsigned short rr[9], rk[9], rv[9], ra[8], rg[8]; float rc[9], rc63;
#define RWKV_LOAD(cc) do { const int tb_ = 64 * (cc) + 8 * wave; \
        _Pragma("unroll") for (int i = 0; i < 9; ++i) { const int t_ = tb_ - 1 + i; const bool ok_ = t_ >= 0; const bf16* p_ = PU + (size_t)(ok_ ? t_ : 0) * NPI; \
            rr[i] = ok_ ? p_[lane] : (unsigned short)0; rk[i] = ok_ ? p_[384 + lane] : (unsigned short)0; rv[i] = ok_ ? p_[768 + lane] : (unsigned short)0; \
            rc[i] = (i > 0 || wave > 0) ? CU[(size_t)(ok_ ? t_ : 0) * 384 + lane] : 0.f; if (i > 0) { ra[i - 1] = AU[(size_t)t_ * 384 + lane]; rg[i - 1] = GU[(size_t)t_ * 384 + lane]; } } \
        rc63 = CU[(size_t)(64 * (cc) + 63) * 384 + lane]; } while (0)
    { const int lane = lane0; RWKV_LOAD(cb); }
    f32x4 yp[4];
#pragma unroll
    for (int i = 0; i < 4; ++i) yp[i] = (f32x4){0.f, 0.f, 0.f, 0.f};
#define RW_EPILOGUE(yy, cc, VrB, GrB, bonB, q4_, lc_) do { _Pragma("unroll") for (int r = 0; r < 4; ++r) { const int t = 16 * (wave - 4) + 4 * (q4_) + r; const size_t row = m0 + 64 * (cc) + t; \
            float s_ = 0.f; _Pragma("unroll") for (int ct = 0; ct < 4; ++ct) s_ += yy[ct][r]; \
            const float mean = sum16(s_) * (1.0f / 64.0f); float qv = 0.f; \
            _Pragma("unroll") for (int ct = 0; ct < 4; ++ct) { const float dd = yy[ct][r] - mean; qv += dd * dd; } \
            const float rstd = __builtin_amdgcn_rsqf(sum16(qv) * (1.0f / 64.0f) + GN_EPS); \
            const float bon = (bonB)[t]; bf16* orow = mixed + row * DM + 256 + h * 64 + (lc_); \
            _Pragma("unroll") for (int ct = 0; ct < 4; ++ct) orow[16 * ct] = f2bf16(((yy[ct][r] - mean) * rstd * gain4[ct] + bon * bf2f((VrB)[t * LP + 16 * ct + (lc_)])) * bf2f((GrB)[t * LP + 16 * ct + (lc_)])); } } while (0)
#pragma unroll 1
    for (int c = cb; c < ce; ++c) {
        const int lane = lane_id_opq(), q4 = lane >> 4, lc = lane & 15, o72 = lc * LP + 8 * q4;
        LAS bf16* VrC = (c & 1) ? Vr2 : Vr; LAS bf16* GrC = (c & 1) ? Gr2 : Gr; LAS float* bonC = (c & 1) ? bonv2 : bonv;
        LAS bf16* VrP = (c & 1) ? Vr : Vr2; LAS bf16* GrP = (c & 1) ? Gr : Gr2; LAS float* bonP = (c & 1) ? bonv : bonv2;
        if (RW_DBG & 1) { unsigned short khg[8], bhg[8]; const float gc63 = fexp(rc63); float ecp = fexp(rc[0]);
#pragma unroll
          for (int i = 0; i < 8; ++i) { const int tt = 8 * wave + i;
              const float cr = bf2f(rr[i + 1]), ck = bf2f(rk[i + 1]);
              const float r = cr + (bf2f(rr[i]) - cr) * mu_r, k = ck + (bf2f(rk[i]) - ck) * mu_k, a = bf2f(ra[i]);
              float kk = k * kkc; kk = kk * __builtin_amdgcn_rsqf(fmaxf(wave_sum(kk * kk), 1e-24f));
              const float kmod = k * (1.0f + (a - 1.0f) * kac), beta = kk * a;
              const float bon = wave_sum(r * kmod * rkc); if (lane == 0) bonC[tt] = bon;
              const float cm = rc[i + 1], cp = rc[i];
              const float em = fexp(-cm), eg = gc63 * em, ec = __builtin_amdgcn_rcpf(em);
              KH[tt * LP + lane] = f2bf16(kmod * em); BH[tt * LP + lane] = f2bf16(beta * em); KT[tt * LP + lane] = f2bf16(kk * ecp); RT[tt * LP + lane] = f2bf16(r * ec); ecp = ec;
              khg[i] = f2bf16(kmod * eg); bhg[i] = f2bf16(-beta * eg); }
          v4u w; w.x = khg[0] | ((unsigned)khg[1] << 16); w.y = khg[2] | ((unsigned)khg[3] << 16); w.z = khg[4] | ((unsigned)khg[5] << 16); w.w = khg[6] | ((unsigned)khg[7] << 16);
          *(LAS v4u*)(KHgt + lane * LP + 8 * wave) = w;
          w.x = bhg[0] | ((unsigned)bhg[1] << 16); w.y = bhg[2] | ((unsigned)bhg[3] << 16); w.z = bhg[4] | ((unsigned)bhg[5] << 16); w.w = bhg[6] | ((unsigned)bhg[7] << 16);
          *(LAS v4u*)(BHgtn + lane * LP + 8 * wave) = w;
          unsigned short vs[8];
#pragma unroll
          for (int i = 0; i < 8; ++i) { const float cv = bf2f(rv[i + 1]); vs[i] = f2bf16(cv + (bf2f(rv[i]) - cv) * mu_v); VrC[(8 * wave + i) * LP + lane] = vs[i]; GrC[(8 * wave + i) * LP + lane] = rg[i]; }
          w.x = vs[0] | ((unsigned)vs[1] << 16); w.y = vs[2] | ((unsigned)vs[3] << 16); w.z = vs[4] | ((unsigned)vs[5] << 16); w.w = vs[6] | ((unsigned)vs[7] << 16);
          *(LAS v4u*)(Vt + lane * LP + 8 * wave) = w;
          if (wave == 0) GCv[lane] = gc63; }
        WG_BAR_L();
#pragma unroll
        for (int u2 = 0; u2 < 2; ++u2) { const int idx = 2 * wave + u2, rt = idx >> 2, ct = idx & 3;
            if (ct <= rt) {
                const int s = 16 * ct + lc; const LAS bf16* kt = KT + 16 * rt * LP + o72; const LAS bf16* rtp = RT + 16 * rt * LP + o72; const LAS bf16* bh = BH + 16 * ct * LP + o72; const LAS bf16* kh = KH + 16 * ct * LP + o72;
                const f32x4 z = (f32x4){0.f, 0.f, 0.f, 0.f};
                const f32x4 g0 = mm_tile<2>(kt, bh, z), g1 = mm_tile<2>(kt, kh, z), g2 = mm_tile<2>(rtp, bh, z), g3 = mm_tile<2>(rtp, kh, z);
#pragma unroll
                for (int r = 0; r < 4; ++r) { const int t = 16 * rt + 4 * q4 + r;
                    if (ct < rt) Loffb[t * LP + s] = f2bf16(g0[r]); else LTd[s * 20 + (t - 16 * rt)] = (s < t) ? g0[r] : 0.f;
                    AkT[t * LP + s] = f2bf16((s < t) ? g1[r] : 0.f);
                    BbTn[t * LP + s] = f2bf16((s <= t) ? -g2[r] : 0.f);
                    BkT[t * LP + s] = f2bf16((s <= t) ? g3[r] : 0.f); } } }
        WG_BAR_L();
#pragma unroll
        for (int u = 0; u < ((RW_DBG & 4) ? 2 : 0); ++u) { const int rt = wave >> 1, ct = 2 * (wave & 1) + u;
            f32x4 g = mm_tile<2>(KT + 16 * rt * LP + o72, S0b + 16 * ct * LP + o72, (f32x4){0.f, 0.f, 0.f, 0.f});
            g = mm_tile<2>(AkT + 16 * rt * LP + o72, Vt + 16 * ct * LP + o72, g);
#pragma unroll
            for (int r = 0; r < 4; ++r) RHS[(16 * rt + 4 * q4 + r) * 64 + 16 * ct + lc] = g[r]; }
        WG_BAR_L();
        f32x4 y[4];
        if ((RW_DBG & 8) && wave == 0) {
            __builtin_amdgcn_s_setprio(3);
#pragma unroll
            for (int a = 0; a < 4; ++a) {
                if (a > 0) {
#pragma unroll
                    for (int it = 0; it < 4; ++it) { f32x4 cr = (f32x4){0.f, 0.f, 0.f, 0.f};
                        if (a == 3) cr = mm_tile<2>(Loffb + 16 * a * LP + o72, Ut + 16 * it * LP + o72, cr); else cr = mm_tile<1>(Loffb + 16 * a * LP + o72, Ut + 16 * it * LP + o72, cr);
#pragma unroll
                        for (int r = 0; r < 4; ++r) XS[(4 * q4 + r) * 64 + 16 * it + lc] = cr[r]; }
                    asm volatile("s_waitcnt lgkmcnt(0)" ::: "memory");
                }
                float acc[16];
#pragma unroll
                for (int t = 0; t < 16; ++t) acc[t] = RHS[(16 * a + t) * 64 + lane] - (a > 0 ? XS[t * 64 + lane] : 0.f);
                const LAS float* Ld = LTd + 16 * a * 20; asm volatile("" : "+v"(Ld));
#pragma unroll
                for (int s2 = 0; s2 < 15; ++s2) { const float us = acc[s2];
#pragma unroll
                    for (int t4 = (s2 + 1) / 4; t4 < 4; ++t4) { const f32x4 l4 = *(const LAS f32x4*)(Ld + s2 * 20 + 4 * t4);
                        acc[4 * t4] -= l4.x * us; acc[4 * t4 + 1] -= l4.y * us; acc[4 * t4 + 2] -= l4.z * us; acc[4 * t4 + 3] -= l4.w * us; }
                    if (s2 == 5) asm volatile("" : "+v"(Ld) : "v"(acc[s2 + 1])); }
                v4u w; w.x = pk2(acc[0], acc[1]); w.y = pk2(acc[2], acc[3]); w.z = pk2(acc[4], acc[5]); w.w = pk2(acc[6], acc[7]);
                *(LAS v4u*)(Ut + lane * LP + 16 * a) = w;
                w.x = pk2(acc[8], acc[9]); w.y = pk2(acc[10], acc[11]); w.z = pk2(acc[12], acc[13]); w.w = pk2(acc[14], acc[15]);
                *(LAS v4u*)(Ut + lane * LP + 16 * a + 8) = w;
                asm volatile("s_waitcnt lgkmcnt(0)" ::: "memory");
            }
            __builtin_amdgcn_s_setprio(0);
        }
        if (c + 1 < ce) RWKV_LOAD(c + 1);
        if (wave >= 4) {
#pragma unroll
            for (int ct = 0; ct < 4; ++ct) { y[ct] = mm_tile<2>(RT + 16 * (wave - 4) * LP + o72, S0b + 16 * ct * LP + o72, (f32x4){0.f, 0.f, 0.f, 0.f}); y[ct] = mm_tile<2>(BkT + 16 * (wave - 4) * LP + o72, Vt + 16 * ct * LP + o72, y[ct]); }
            if (c > cb) RW_EPILOGUE(yp, c - 1, VrP, GrP, bonP, q4, lc);
        } else {
#pragma unroll
            for (int jt = 0; jt < 4; ++jt) { const float gc = GCv[16 * jt + lc]; sacc[jt] = mm_tile<2>(Vt + 16 * wave * LP + o72, KHgt + 16 * jt * LP + o72, sacc[jt] * gc); }
        }
        WG_BAR_L();
        if (wave >= 4) {
#pragma unroll
            for (int ct = 0; ct < 4; ++ct) y[ct] = mm_tile<2>(BbTn + 16 * (wave - 4) * LP + o72, Ut + 16 * ct * LP + o72, y[ct]);
#pragma unroll
            for (int ct = 0; ct < 4; ++ct) yp[ct] = y[ct];
        } else {
#pragma unroll
            for (int jt = 0; jt < 4; ++jt) { sacc[jt] = mm_tile<2>(Ut + 16 * wave * LP + o72, BHgtn + 16 * jt * LP + o72, sacc[jt]);
#pragma unroll
                for (int r = 0; r < 4; ++r) S0b[(16 * wave + 4 * q4 + r) * LP + 16 * jt + lc] = f2bf16(sacc[jt][r]); }
        }
        WG_BAR_L();
    }
    if (wave >= 4 && ce > cb) { const int q4 = lane0 >> 4, lc = lane0 & 15; const int cl = ce - 1;
        if (cl & 1) RW_EPILOGUE(yp, cl, Vr2, Gr2, bonv2, q4, lc); else RW_EPILOGUE(yp, cl, Vr, Gr, bonv, q4, lc); }
#undef RW_EPILOGUE
    if (!hs_out) WG_BAR_L();
    if (hs_out) {
        if (wave < 4) {
#pragma unroll
            for (int jt = 0; jt < 4; ++jt)
#pragma unroll
                for (int r = 0; r < 4; ++r) __hip_atomic_store(hs_out + (wave * 4 + jt) * 256 + r * 64 + lane0, sacc[jt][r], __ATOMIC_RELAXED, __HIP_MEMORY_SCOPE_AGENT);
        }
        WG_BAR();
        if (wave == 0 && lane0 == 0) __hip_atomic_store(flag_out, 1u, __ATOMIC_RELAXED, __HIP_MEMORY_SCOPE_AGENT);
    }
#undef RWKV_LOAD
}

struct Args { const float* in[25]; float* out; unsigned char* ws; int ph_lo, ph_hi, li, pad; };
typedef const __attribute__((address_space(4))) Args* KArgs;
__device__ __forceinline__ KArgs kargs() { KArgs p = (KArgs)__builtin_amdgcn_kernarg_segment_ptr(); asm volatile("" : "+s"(p)); return p; }
#ifndef DBG_MASK
#define DBG_MASK 0xFFFF
#endif
#define EN(bit) ((DBG_MASK >> (bit)) & 1)
#ifndef PROBE_SKEW_MODE
#define PROBE_SKEW_MODE 0
#endif
#ifndef PROBE_SKEW
#define PROBE_SKEW 0
#endif
#define SKEW_STAMP(which) do { if (PROBE_SKEW == (which) && l == 2 && wave_o == 0 && lane_id_opq() == 0) { volatile unsigned long long* pp_ = (volatile unsigned long long*)(ws + WS_CTL) + 130000 + blockIdx.x; pp_[0] = __builtin_amdgcn_s_memrealtime(); } } while (0)
#ifndef PROBE_CLK
#define PROBE_CLK 0
#endif
#ifndef PROBE_DUP
#define PROBE_DUP 0
#endif
#define REP(bit) for (int rep_ = 0; rep_ < (((PROBE_DUP >> (bit)) & 1) ? 2 : 1); ++rep_)
__global__ void __launch_bounds__(NWAVES * 64, 2) mk_fwd(Args args_unused) {
    extern __shared__ __attribute__((aligned(16))) unsigned char lds_raw[];
    LAS unsigned char* lds = (LAS unsigned char*)lds_raw;
    volatile LAS unsigned* MISC = (volatile LAS unsigned*)(lds + MISC_OFF);
    const int wave = __builtin_amdgcn_readfirstlane((int)threadIdx.x >> 6);
    const int G = gridDim.x, gw = blockIdx.x * NWAVES + wave, ngw = G * NWAVES;
    for (int u = threadIdx.x; u < (LDS_BYTES - LDSCTL_OFF) / 4; u += NWAVES * 64) ((LAS unsigned*)(lds + LDSCTL_OFF))[u] = 0u;
    __syncthreads();
    XcdBarrier bar; int lo, hi;
    { KArgs A = kargs(); bar = xcd_barrier_post((unsigned*)(A->ws + WS_CTL) + CW_BAR + (MK_PER_PHASE ? 0 : A->li) * XCD_BAR_WORDS, MISC + 8); lo = A->ph_lo; hi = A->ph_hi; }
#define IN(k) (lo <= (k) && (k) < hi)
#if PROBE_BAR
#define SEAM(k) do { if (IN(k) && IN((k) + 1)) { xcd_barrier(bar); xcd_barrier(bar); xcd_barrier(bar); } } while (0)
#else
#define SEAM(k) do { if (IN(k) && IN((k) + 1)) xcd_barrier(bar); } while (0)
#endif
#define LANE_TID() int wave_o = wave, gw_o = gw; asm volatile("" : "+s"(wave_o), "+s"(gw_o)); (void)gw_o; const int lane_o = lane_id_opq(), tid_o = wave_o * 64 + lane_o; (void)tid_o

    REP(5) if (EN(0) && IN(0)) {
        KArgs A = kargs(); unsigned char* ws = A->ws; LANE_TID();
        p0_mod(A->in[1], A->in[2], A->in[3], (float*)(ws + WS_MOD), lds, tid_o, lane_o, wave_o);
        p0_weights(A->in[6], A->in[21], A->in[22], A->in[23], A->in[10], A->in[12], A->in[13], ws, lds, gw_o, ngw, wave_o, lane_o);
    }
    SEAM(0);
    if (EN(1) && IN(1)) { KArgs A = kargs(); unsigned char* ws = A->ws; LANE_TID();
        norm_mod_phase(A->in[0], A->in[4], (const float*)(ws + WS_MOD), 0, DM, (bf16*)(ws + WS_H), gw_o, ngw, lane_o); }
    SEAM(1);
#pragma unroll 1
    for (int l = 0; l < NL; ++l) {
        const int pb = 2 + 6 * l;
        REP(3) if (EN(2) && IN(pb + 0)) { KArgs A = kargs(); unsigned char* ws = A->ws; LANE_TID();
            pg8::Gemm g{(const bf16*)(ws + WS_H), (const bf16*)(ws + WS_WIN) + (size_t)l * NPI * DM, MT, NPI, DM}; pg8::StaticOrder S; S.init(MT, NPI, G, (int)blockIdx.x);
            pg8::EpiBf16Plain E{(bf16*)(ws + WS_PROJ), NPI};
#if PROBE_CLK
            unsigned long long pc0 = 0, pr0 = 0; if (blockIdx.x == 0 && l == 2) { pc0 = __builtin_readcyclecounter(); pr0 = __builtin_amdgcn_s_memrealtime(); }
#endif
            pg8::gemm_phase<pg8::EpiBf16Plain, pg8::StaticOrder, true, true>(lds, g, S, E, wave_o);
            SKEW_STAMP(1);
#if PROBE_CLK
            if (blockIdx.x == 0 && l == 2 && wave_o == 0 && lane_id_opq() == 0) { const unsigned long long dc = __builtin_readcyclecounter() - pc0, dr = __builtin_amdgcn_s_memrealtime() - pr0;
                volatile unsigned long long* pp = (volatile unsigned long long*)(ws + WS_CTL) + 131000; pp[0] = dc; pp[1] = dr; }
#endif
        }
        SEAM(pb + 0);
        REP(1) if (EN(3) && IN(pb + 1)) { KArgs A = kargs(); unsigned char* ws = A->ws; LANE_TID();
            rwkv_prep_mfma((const bf16*)(ws + WS_PROJ), A->in[8] + l * RWKV_IN, A->in[9] + l * 384, A->in[11] + l * 384, (const bf16*)(ws + WS_WL) + (size_t)l * 384 * 256,
                           (float*)(ws + WS_DEC), (bf16*)(ws + WS_AA), (bf16*)(ws + WS_GG), lds, wave_o); SKEW_STAMP(6); }
        SEAM(pb + 1);
        REP(0) if (EN(4) && IN(pb + 2)) { KArgs A = kargs(); unsigned char* ws = A->ws; LANE_TID();
            const float* gn = A->in[7] + l * DM; const bf16* PROJ = (const bf16*)(ws + WS_PROJ); bf16* Hb = (bf16*)(ws + WS_H);
            int u = (int)blockIdx.x; asm volatile("" : "+s"(u));
            float* HS = (float*)(ws + WS_HS) + (size_t)l * 192 * 4096; unsigned* FL = (unsigned*)(ws + WS_CTL) + CW_FLAG + l * 192 * 16;
            const float* DECp = (const float*)(ws + WS_DEC); const bf16* AAp = (const bf16*)(ws + WS_AA); const bf16* GGp = (const bf16*)(ws + WS_GG);
#define RWKV_PIECE(q, cb, ce, hin, hout) rwkv_unit((q) / 6, (q) % 6, PROJ, DECp, AAp, GGp, A->in[8] + l * RWKV_IN, A->in[14] + l * 384, A->in[15] + l * 384, A->in[16] + l * 384, gn, Hb, lds, wave_o, lane_o, cb, ce, \
                (hin) >= 0 ? HS + (size_t)(hin) * 4096 : nullptr, (hin) >= 0 ? FL + (hin) * 16 : nullptr, (hout) >= 0 ? HS + (size_t)(hout) * 4096 : nullptr, (hout) >= 0 ? FL + (hout) * 16 : nullptr)
            if (u < 64 || u >= 128) {
                const int q = u < 64 ? u : u < 192 ? u - 64 : u - 64, ce = u < 64 ? SPLIT_H : u < 192 ? SPLIT_X : SPLIT_Y;
                RWKV_PIECE(q, 0, ce, -1, q); }
            if (u < 128) {
#if PROBE_SKEW == 7 || PROBE_SKEW == 8
                if (l == 2 && wave_o == 0 && lane_id_opq() == 0) { volatile unsigned long long* pp_ = (volatile unsigned long long*)(ws + WS_CTL) + 130000 + 3 * blockIdx.x; pp_[0] = __builtin_amdgcn_s_memrealtime(); }
#endif
                mlstm_unit(u >> 2, u & 3, PROJ, A->in[17] + (size_t)l * 4 * 768, A->in[18] + l * 768, A->in[19] + l * 4, A->in[20] + l * 4, gn, Hb, lds, wave_o, lane_o);
#if PROBE_SKEW == 7 || PROBE_SKEW == 8
                if (l == 2 && wave_o == 0 && lane_id_opq() == 0) { volatile unsigned long long* pp_ = (volatile unsigned long long*)(ws + WS_CTL) + 130000 + 3 * blockIdx.x; pp_[1] = __builtin_amdgcn_s_memrealtime(); }
#endif
                ret_unit(u >> 2, u & 3, PROJ, gn, Hb, lds, wave_o, lane_o);
#if PROBE_SKEW == 7 || PROBE_SKEW == 8
                if (l == 2 && wave_o == 0 && lane_id_opq() == 0) { volatile unsigned long long* pp_ = (volatile unsigned long long*)(ws + WS_CTL) + 130000 + 3 * blockIdx.x; pp_[2] = __builtin_amdgcn_s_memrealtime(); }
#endif
                }
            if (u >= 64) {
                const int q = u < 128 ? u : u < 192 ? u : u - 192, cb = u < 128 ? SPLIT_X : u < 192 ? SPLIT_Y : SPLIT_H;
                RWKV_PIECE(q, cb, 32, q, -1); }
#undef RWKV_PIECE
#ifndef PROBE_UNIT
#define PROBE_UNIT 0
#endif
            if (PROBE_UNIT == 1 && u < 192) rwkv_unit(u / 6, u % 6, PROJ, DECp, AAp, GGp, A->in[8] + l * RWKV_IN, A->in[14] + l * 384, A->in[15] + l * 384, A->in[16] + l * 384, gn, Hb, lds, wave_o, lane_o, 0, 32, nullptr, nullptr, nullptr, nullptr);
            if (PROBE_UNIT == 2 && u < 128) mlstm_unit(u >> 2, u & 3, PROJ, A->in[17] + (size_t)l * 4 * 768, A->in[18] + l * 768, A->in[19] + l * 4, A->in[20] + l * 4, gn, Hb, lds, wave_o, lane_o);
            if (PROBE_UNIT == 3 && u < 128) ret_unit(u >> 2, u & 3, PROJ, gn, Hb, lds, wave_o, lane_o);
            SKEW_STAMP(2);
        }
        SEAM(pb + 2);
        if (EN(6) && IN(pb + 3)) { KArgs A = kargs(); unsigned char* ws = A->ws; LANE_TID();
            pg8::Gemm g{(const bf16*)(ws + WS_H), (const bf16*)(ws + WS_WOUT) + (size_t)l * DM * DM, MT, DM, DM}; pg8::StaticOrder S; S.init(MT, DM, G, (int)blockIdx.x);
            const float* modl = (const float*)(ws + WS_MOD) + (size_t)l * NB * MODP;
#if PROBE_RG
            { pg8::EpiResGate<false> E2{(const float*)nullptr, (const bf16*)A->out, (bf16*)(ws + WS_XFIN), DM, modl + 2 * DM, MODP}; pg8::gemm_phase<pg8::EpiResGate<false>, pg8::StaticOrder, true, true>(lds, g, S, E2, wave_o); }
#endif
            if (l == 0) { pg8::EpiResGate<true> E{A->in[0], (const bf16*)nullptr, (bf16*)A->out, DM, modl + 2 * DM, MODP}; pg8::gemm_phase<pg8::EpiResGate<true>, pg8::StaticOrder, true, true>(lds, g, S, E, wave_o); }
            else { pg8::EpiResGate<false> E{(const float*)nullptr, (const bf16*)A->out, (bf16*)A->out, DM, modl + 2 * DM, MODP}; pg8::gemm_phase<pg8::EpiResGate<false>, pg8::StaticOrder, true, true>(lds, g, S, E, wave_o); }
            fused_panel_norm(S, (unsigned*)(ws + WS_CTL) + CW_PCNT + (2 * l) * PCNT_BANK, (const bf16*)A->out, A->in[5] + l * DM, modl, 3 * DM, 4 * DM, (bf16*)(ws + WS_H), wave_o, lane_o);
            SKEW_STAMP(5);
        }
        SEAM(pb + 3);
        REP(4) if (EN(7) && IN(pb + 4)) { KArgs A = kargs(); unsigned char* ws = A->ws; LANE_TID();
            pg8::Gemm g{(const bf16*)(ws + WS_H), (const bf16*)(ws + WS_WF1) + (size_t)l * NF1 * DM, MT, NF1, DM}; pg8::StaticOrder S; S.init(MT, NF1, G, (int)blockIdx.x);
            pg8::EpiSwiGLU E{(bf16*)(ws + WS_PROJ), DFF};
            pg8::gemm_phase<pg8::EpiSwiGLU, pg8::StaticOrder, true, true>(lds, g, S, E, wave_o);
            SKEW_STAMP(3);
        }
        SEAM(pb + 4);
        if (EN(8) && IN(pb + 5)) { KArgs A = kargs(); unsigned char* ws = A->ws; LANE_TID();
            pg8::Gemm g{(const bf16*)(ws + WS_PROJ), (const bf16*)(ws + WS_WF2) + (size_t)l * DM * DFF, MT, DM, DFF}; pg8::StaticOrder S; S.init(MT, DM, G, (int)blockIdx.x);
#if PROBE_RG
            { pg8::EpiResGate<false> E2{(const float*)nullptr, (const bf16*)A->out, (bf16*)(ws + WS_XFIN), DM, (const float*)(ws + WS_MOD) + (size_t)l * NB * MODP + 5 * DM, MODP}; pg8::gemm_phase<pg8::EpiResGate<false>, pg8::StaticOrder, true, true>(lds, g, S, E2, wave_o); }
#endif
            pg8::EpiResGate<false> E{(const float*)nullptr, (const bf16*)A->out, l + 1 < NL ? (bf16*)A->out : (bf16*)(ws + WS_XFIN), DM, (const float*)(ws + WS_MOD) + (size_t)l * NB * MODP + 5 * DM, MODP};
            pg8::gemm_phase<pg8::EpiResGate<false>, pg8::StaticOrder, true, true>(lds, g, S, E, wave_o);
            if (l + 1 < NL) fused_panel_norm(S, (unsigned*)(ws + WS_CTL) + CW_PCNT + (2 * l + 1) * PCNT_BANK, (const bf16*)A->out, A->in[4] + (l + 1) * DM, (const float*)(ws + WS_MOD) + (size_t)(l + 1) * NB * MODP, 0, DM, (bf16*)(ws + WS_H), wave_o, lane_o);
            SKEW_STAMP(4);
        }
        SEAM(pb + 5);
    }
    if (EN(9) && IN(N_PHASES - 1)) { KArgs A = kargs(); int gw_o = gw; asm volatile("" : "+s"(gw_o)); final_norm_phase((const bf16*)(A->ws + WS_XFIN), A->out, A->in[24], gw_o, ngw, lane_id_opq()); }
#if PROBE_SKEW == 7 || PROBE_SKEW == 8
    if (blockIdx.x == 0 && wave == 0 && lane_id_opq() == 0) { KArgs A = kargs(); volatile unsigned long long* pp = (volatile unsigned long long*)(A->ws + WS_CTL) + 130000;
        unsigned long long s = 0ull;
        for (int i = 0; i < 128; ++i) s += PROBE_SKEW == 7 ? pp[3 * i + 1] - pp[3 * i] : pp[3 * i + 2] - pp[3 * i + 1];
        unsigned long long us = s >> 7; if (us > 60000ull) us = 60000ull;
        const unsigned long long t0 = __builtin_amdgcn_s_memrealtime();
        while (__builtin_amdgcn_s_memrealtime() - t0 < us * 100ull) __builtin_amdgcn_s_sleep(32); }
#elif PROBE_SKEW
    if (blockIdx.x == 0 && wave == 0 && lane_id_opq() == 0) { KArgs A = kargs(); volatile unsigned long long* pp = (volatile unsigned long long*)(A->ws + WS_CTL) + 130000;
        unsigned long long mx = 0ull, sum = 0ull, mn = ~0ull;
        for (int i = 0; i < 256; ++i) { const unsigned long long t = pp[i]; mx = t > mx ? t : mx; mn = t < mn ? t : mn; sum += t - pp[0] + (1ull << 40); }
        const unsigned long long mean = pp[0] + (sum >> 8) - (1ull << 40);
        unsigned long long us = PROBE_SKEW_MODE == 1 ? (mx - mn) : (mx - mean);
        if (PROBE_SKEW_MODE >= 2) { const int lo = 64 * (PROBE_SKEW_MODE - 2), hi = lo + 64; unsigned long long s2 = 0ull;
            for (int i = lo; i < hi; ++i) s2 += mx - pp[i];
            us = s2 / (unsigned long long)(hi - lo); }
        if (us > 30000ull) us = 30000ull;
        const unsigned long long t0 = __builtin_amdgcn_s_memrealtime();
        while (__builtin_amdgcn_s_memrealtime() - t0 < us * 100ull) __builtin_amdgcn_s_sleep(32); }
#endif
#if PROBE_KL_SOLO
    if (blockIdx.x == 0) { xcd_barrier(bar); }
    else { xcd_barrier(bar); }
    if (blockIdx.x == 0) { KArgs A = kargs(); unsigned char* ws = A->ws; LANE_TID();
        { const unsigned long long t0_ = __builtin_amdgcn_s_memrealtime(); while (__builtin_amdgcn_s_memrealtime() - t0_ < 100000ull) __builtin_amdgcn_s_sleep(64); }
        pg8::Gemm g{(const bf16*)(ws + WS_H), (const bf16*)(ws + WS_WIN), MT, NPI, DM}; pg8::StaticOrder S; S.init(MT, NPI, G, 0);
        pg8::EpiBf16Plain E{(bf16*)(ws + WS_PROJ), NPI};
        pg8::gemm_phase<pg8::EpiBf16Plain, pg8::StaticOrder, true, true>(lds, g, S, E, wave_o); }
#endif
#if PROBE_KL
    if (blockIdx.x == 0 && wave == 0 && lane_id_opq() == 0) { unsigned long long us = PROBE_KL == 1 ? probe_kl[0] / 16ull : probe_kl[1] / 4ull; if (us > 30000ull) us = 30000ull;
        const unsigned long long t0 = __builtin_amdgcn_s_memrealtime();
        while (__builtin_amdgcn_s_memrealtime() - t0 < us * 100ull) __builtin_amdgcn_s_sleep(32); }
#endif
#if PROBE_CLK
    if (blockIdx.x == 0 && wave == 0 && lane_id_opq() == 0) { KArgs A = kargs(); volatile unsigned long long* pp = (volatile unsigned long long*)(A->ws + WS_CTL) + 131000; const unsigned long long dc = pp[0], dr = pp[1];
#if PROBE_CLK == 1
        unsigned long long us = dr ? dc * 100ull / dr : 0ull;
#else
        unsigned long long us = dr / 100ull * 10ull;
#endif
        if (us > 20000ull) us = 20000ull;
        const unsigned long long t0 = __builtin_amdgcn_s_memrealtime();
        while (__builtin_amdgcn_s_memrealtime() - t0 < us * 100ull) __builtin_amdgcn_s_sleep(32); }
#endif
#undef IN
#undef SEAM
}

extern "C" void kernel_launch(void* const* d_in, const int* in_sizes, int n_in, void* d_out, int out_size, void* d_ws, size_t ws_size, hipStream_t stream) {
    static int grid = 0;
    if (grid == 0) {
        if (n_in != 25 || in_sizes[0] != MT * DM || out_size != MT * DM || ws_size < WS_END) { fprintf(stderr, "kernel_launch: shape/workspace mismatch (n_in %d, in0 %d, out %d, ws %zu)\n", n_in, n_in > 0 ? in_sizes[0] : -1, out_size, ws_size); grid = -1; return; }
        int dev = 0, cus = 0, per_cu = 0;
        if (hipGetDevice(&dev) != hipSuccess || hipDeviceGetAttribute(&cus, hipDeviceAttributeMultiprocessorCount, dev) != hipSuccess) { grid = -1; return; }
        if (hipFuncSetAttribute((const void*)mk_fwd, hipFuncAttributeMaxDynamicSharedMemorySize, LDS_BYTES) != hipSuccess) { fprintf(stderr, "kernel_launch: hipFuncSetAttribute failed\n"); grid = -1; return; }
        if (hipOccupancyMaxActiveBlocksPerMultiprocessor(&per_cu, (const void*)mk_fwd, NWAVES * 64, LDS_BYTES) != hipSuccess || per_cu < 1) { fprintf(stderr, "kernel_launch: occupancy query says %d\n", per_cu); }
        (void)hipGetLastError();
        grid = cus;
    }
    if (grid < 0) return;
    if (hipMemsetAsync((char*)d_ws + WS_CTL, 0, CTL_ZERO_BYTES, stream) != hipSuccess) return;
    Args a{};
    for (int i = 0; i < 25; ++i) a.in[i] = (const float*)d_in[i];
    a.out = (float*)d_out; a.ws = (unsigned char*)d_ws;
#if MK_PER_PHASE
    for (int p = 0; p < N_PHASES; ++p) { a.ph_lo = p; a.ph_hi = p + 1; a.li = 0; hipLaunchKernelGGL(mk_fwd, dim3(grid), dim3(NWAVES * 64), LDS_BYTES, stream, a); }
#else
    a.ph_lo = 0; a.ph_hi = N_PHASES; a.li = 0;
    hipLaunchKernelGGL(mk_fwd, dim3(grid), dim3(NWAVES * 64), LDS_BYTES, stream, a);
#endif
}
```

```cpp
#include <hip/hip_runtime.h>
#include <cstdio>
#include <cstdint>
#ifndef PROBE_PN
#define PROBE_PN 0
#endif
#ifndef PROBE_RG
#define PROBE_RG 0
#endif
#ifndef PROBE_BAR
#define PROBE_BAR 0
#endif
#ifndef PROBE_SOLVE
#define PROBE_SOLVE 0
#endif
#ifndef PROBE_KL
#define PROBE_KL 0
#endif
#ifndef PROBE_KL_SOLO
#define PROBE_KL_SOLO 0
#endif
#ifndef PROBE_KL_FIRST
#define PROBE_KL_FIRST 0
#endif
#if PROBE_KL
__device__ unsigned long long probe_kl[2];
#endif
#ifndef PROBE_EPI2
#define PROBE_EPI2 0
#endif
__device__ __forceinline__ int lane_id_opq() { int l = (int)__builtin_amdgcn_mbcnt_hi(~0u, __builtin_amdgcn_mbcnt_lo(~0u, 0u)); asm volatile("" : "+v"(l)); return l; }

namespace pg8 {
#define PG8_LAS __attribute__((address_space(3)))
typedef unsigned short bf16_t;
typedef short bf16x8 __attribute__((ext_vector_type(8)));
typedef float f32x4 __attribute__((ext_vector_type(4)));
typedef unsigned u32x4 __attribute__((ext_vector_type(4)));
constexpr int BM = 256, BK = 64, HALF = 128, HTB = HALF * BK * 2  , STAGE_BYTES = 8 * HTB, NXCD = 8, WGM = 8;

__host__ __device__ __forceinline__ int lds_byte(int r, int c) { const int st = (r >> 4) * 2 + (c >> 5), rr = r & 15, cc = c & 31, ob = rr * 64 + cc * 2; return st * 1024 + (ob ^ (((ob >> 9) & 1) << 5)); }
__host__ __device__ __forceinline__ void stage_rc(int b, int& R, int& C) { const int st = b / 1024, sb = b % 1024, swz = sb ^ (((sb >> 9) & 1) << 5); R = (st >> 1) * 16 + swz / 64; C = (st & 1) * 32 + (swz % 64) / 2; }
__host__ __device__ __forceinline__ int perm32(int rho) { const int n = rho >> 4, i = rho & 15; return 8 * (i >> 2) + 4 * n + (i & 3); }

struct Unit { int pm, pn; };
struct Gemm { const bf16_t* A; const bf16_t* Bt; int M, N, K; };

struct StaticOrder {
    int nM, nN, nwg, G, c;
    __host__ __device__ void init(int M, int N, int G_, int c_) { nM = M / BM; nN = N / BM; nwg = nM * nN; G = G_; c = c_; }
    __host__ __device__ bool next(int i, Unit& u) const {
        const long L = (long)i * G + c; if (L >= nwg) return false;
        int wgid = (int)L; { const int q = nwg / NXCD, r = nwg % NXCD, xcd = wgid % NXCD, off = wgid / NXCD; wgid = (xcd < r ? xcd * (q + 1) : r * (q + 1) + (xcd - r) * q) + off; }
        const int nig = WGM * nN, gid = wgid / nig, fm = gid * WGM, gsz = (nM - fm) < WGM ? (nM - fm) : WGM;
        u.pm = fm + ((wgid % nig) % gsz); u.pn = (wgid % nig) / gsz; return true;
    }
    __device__ __forceinline__ void a_ready(const Unit&) const {}
    __device__ __forceinline__ void done(const Unit&) const {}
};

__device__ __forceinline__ unsigned cvt_pk_bf16(float lo, float hi) { unsigned r; asm volatile("v_cvt_pk_bf16_f32 %0, %1, %2" : "=v"(r) : "v"(lo), "v"(hi)); return r; }
typedef float f32x2 __attribute__((ext_vector_type(2)));

typedef float f32x2e __attribute__((ext_vector_type(2)));
typedef __bf16 bf16x2e __attribute__((ext_vector_type(2)));
__device__ __forceinline__ unsigned cvt_pk(float lo, float hi) { const f32x2e v = {lo, hi}; return __builtin_bit_cast(unsigned, __builtin_convertvector(v, bf16x2e)); }
__device__ __forceinline__ float silu_f(float x) { return x * __builtin_amdgcn_rcpf(1.0f + __expf(-x)); }
struct EpiBf16Plain {
    static constexpr bool PERM = true, AFTER_DRAIN = false; static constexpr int NSTORE = 16;
    bf16_t* O; int ldc;
    __device__ __forceinline__ void operator()(const f32x4 (&acc)[2][2][4][2], const Unit& u, int wr, int wc, int fr, int fq) const {
        const int row0 = u.pm * BM + wr * 64 + fr, col0 = u.pn * BM + wc * 32 + 8 * fq;
#pragma unroll
        for (int ai = 0; ai < 2; ++ai)
#pragma unroll
            for (int m = 0; m < 4; ++m) { bf16_t* rowp = O + (size_t)(row0 + ai * HALF + m * 16) * ldc + col0;
#pragma unroll
                for (int bj = 0; bj < 2; ++bj) { const f32x4 v0 = acc[ai][bj][m][0], v1 = acc[ai][bj][m][1];
                    u32x4 w; w.x = cvt_pk(v0[0], v0[1]); w.y = cvt_pk(v0[2], v0[3]); w.z = cvt_pk(v1[0], v1[1]); w.w = cvt_pk(v1[2], v1[3]);
                    *(u32x4*)(rowp + bj * HALF) = w; } }
    }
};
struct EpiSwiGLU {
    static constexpr bool PERM = true, AFTER_DRAIN = false; static constexpr int NSTORE = 8;
    bf16_t* O; int ldc;
    __device__ __forceinline__ void operator()(const f32x4 (&acc)[2][2][4][2], const Unit& u, int wr, int wc, int fr, int fq) const {
        const int row0 = u.pm * BM + wr * 64 + fr, col0 = u.pn * HALF + wc * 32 + 8 * fq;
#pragma unroll
        for (int ai = 0; ai < 2; ++ai)
#pragma unroll
            for (int m = 0; m < 4; ++m) { bf16_t* rowp = O + (size_t)(row0 + ai * HALF + m * 16) * ldc + col0;
                const f32x4 g0 = acc[ai][0][m][0], g1 = acc[ai][0][m][1], u0 = acc[ai][1][m][0], u1 = acc[ai][1][m][1];
                u32x4 w; w.x = cvt_pk(silu_f(g0[0]) * u0[0], silu_f(g0[1]) * u0[1]); w.y = cvt_pk(silu_f(g0[2]) * u0[2], silu_f(g0[3]) * u0[3]);
                w.z = cvt_pk(silu_f(g1[0]) * u1[0], silu_f(g1[1]) * u1[1]); w.w = cvt_pk(silu_f(g1[2]) * u1[2], silu_f(g1[3]) * u1[3]);
                *(u32x4*)rowp = w; }
    }
};
template <bool F32IN>
struct EpiResGate {
    static constexpr bool PERM = false, AFTER_DRAIN = false; static constexpr int NSTORE = 32;
    const float* xin32; const bf16_t* xsin; bf16_t* xs; int ldc; const float* gate; int gpitch;
    __device__ __forceinline__ void operator()(const f32x4 (&acc)[2][2][4][2], const Unit& u, int wr, int wc, int fr, int fq) const {
        typedef unsigned u32x2 __attribute__((ext_vector_type(2)));
        const int row0 = u.pm * BM + wr * 64 + fr, col0 = u.pn * BM + wc * 32 + 4 * fq;
        const float* gp = gate + (size_t)(u.pm >> 3) * gpitch + col0;
        f32x4 gv[2][2];
#pragma unroll
        for (int bj = 0; bj < 2; ++bj)
#pragma unroll
            for (int n = 0; n < 2; ++n) gv[bj][n] = *(const f32x4*)(gp + bj * HALF + n * 16);
        f32x4 xf[2][2][2][2]; u32x2 xb[2][2][2][2];
#define RG_LOAD(buf, ai, mh) do { _Pragma("unroll") for (int mm = 0; mm < 2; ++mm) { const size_t off = (size_t)(row0 + (ai) * HALF + (2 * (mh) + mm) * 16) * ldc + col0; \
            _Pragma("unroll") for (int bj = 0; bj < 2; ++bj) _Pragma("unroll") for (int n = 0; n < 2; ++n) { \
                if constexpr (F32IN) xf[buf][mm][bj][n] = *(const f32x4*)(xin32 + off + bj * HALF + n * 16); else xb[buf][mm][bj][n] = *(const u32x2*)(xsin + off + bj * HALF + n * 16); } } } while (0)
        RG_LOAD(0, 0, 0);
#pragma unroll
        for (int k = 0; k < 4; ++k) { const int ai = k >> 1, mh = k & 1, buf = k & 1;
            if (k < 3) RG_LOAD((k + 1) & 1, (k + 1) >> 1, (k + 1) & 1);
            asm volatile("" ::: "memory");
#pragma unroll
            for (int mm = 0; mm < 2; ++mm) { const int m = 2 * mh + mm; const size_t off = (size_t)(row0 + ai * HALF + m * 16) * ldc + col0;
#pragma unroll
                for (int bj = 0; bj < 2; ++bj)
#pragma unroll
                    for (int n = 0; n < 2; ++n) { f32x4 xi;
                        if constexpr (F32IN) xi = xf[buf][mm][bj][n];
                        else { const u32x2 w = xb[buf][mm][bj][n]; xi = (f32x4){__uint_as_float(w.x << 16), __uint_as_float(w.x & 0xffff0000u), __uint_as_float(w.y << 16), __uint_as_float(w.y & 0xffff0000u)}; }
                        const f32x4 xo = xi + gv[bj][n] * acc[ai][bj][m][n];
                        u32x2 o; o.x = cvt_pk(xo[0], xo[1]); o.y = cvt_pk(xo[2], xo[3]); *(u32x2*)(xs + off + bj * HALF + n * 16) = o; } }
            asm volatile("" ::: "memory"); }
#undef RG_LOAD
    }
};

template <class Epi, class Sched, bool ALIGN_EPI = false, bool SP2 = false>
__device__ __forceinline__ void gemm_phase(PG8_LAS unsigned char* lds, const Gemm g, const Sched& S, const Epi& E, const int wid_in) {
    const int wid = wid_in, lane = lane_id_opq(), tid = wid * 64 + lane, wr = wid >> 2, wc = wid & 3, fr = lane & 15, fq = lane >> 4;
    const int K = g.K, nt = K / BK;
    unsigned voffA[2], voffB[2];
#pragma unroll
    for (int i = 0; i < 2; ++i) { int R, C; stage_rc(tid * 16 + i * 8192, R, C); const int Rb = Epi::PERM ? ((R & ~31) + perm32(R & 31)) : R;
        voffA[i] = (unsigned)(R * K + C) * 2u; voffB[i] = (unsigned)(Rb * K + C) * 2u; }
    const size_t kstep = (size_t)(BK * 2);
    const size_t hstep = (size_t)HALF * K * 2;
    const size_t tstep = 2 * hstep;
    const unsigned ldsw = (unsigned)wid * 1024u;
    const int aoff = lds_byte(wr * 64 + fr, fq * 8), boff = lds_byte(wc * 32 + fr, fq * 8);
#define PG8_SA(b, h) (((b) * 2 + (h)) * HTB)
#define PG8_SB(b, h) ((4 + (b) * 2 + (h)) * HTB)
#define PG8_STAGE(bufoff, gbase, voff) do { _Pragma("unroll") for (int _i = 0; _i < 2; ++_i) \
        __builtin_amdgcn_global_load_lds((const unsigned*)((const char*)(gbase) + (voff)[_i]), (PG8_LAS unsigned*)(lds + (bufoff) + ldsw + _i * 8192), 16, 0, 0); } while (0)
#define PG8_LDA(dst, b, h) do { _Pragma("unroll") for (int m = 0; m < 4; ++m) _Pragma("unroll") for (int k = 0; k < 2; ++k) dst[m][k] = *(const PG8_LAS bf16x8*)(lds + PG8_SA(b, h) + aoff + m * 2048 + k * 1024); } while (0)
#define PG8_LDB(dst, b, h) do { _Pragma("unroll") for (int n = 0; n < 2; ++n) _Pragma("unroll") for (int k = 0; k < 2; ++k) dst[n][k] = *(const PG8_LAS bf16x8*)(lds + PG8_SB(b, h) + boff + n * 2048 + k * 1024); } while (0)
#define PG8_MMA(ai, bj, At, Bt) do { __builtin_amdgcn_s_setprio(1); _Pragma("unroll") for (int m = 0; m < 4; ++m) _Pragma("unroll") for (int n = 0; n < 2; ++n) _Pragma("unroll") for (int k = 0; k < 2; ++k) \
        acc[ai][bj][m][n] = __builtin_amdgcn_mfma_f32_16x16x32_bf16(Bt[n][k], At[m][k], acc[ai][bj][m][n], 0, 0, 0); __builtin_amdgcn_s_setprio(0); } while (0)
#define PG8_WAIT_V(n) asm volatile("s_waitcnt vmcnt(" #n ")" ::: "memory")
#define PG8_WAIT_L(n) asm volatile("s_waitcnt lgkmcnt(" #n ")" ::: "memory")
#define PG8_BAR __builtin_amdgcn_s_barrier()
#define PG8_SCHED __builtin_amdgcn_sched_barrier(0)
    Unit cur, nxt; int ui = 0;
    if (!S.next(0, cur)) return;
    f32x4 acc[2][2][4][2];
#pragma unroll
    for (int a = 0; a < 2; ++a)
#pragma unroll
        for (int b = 0; b < 2; ++b)
#pragma unroll
            for (int m = 0; m < 4; ++m)
#pragma unroll
                for (int n = 0; n < 2; ++n) acc[a][b][m][n] = (f32x4){0.f, 0.f, 0.f, 0.f};
    bf16x8 At[4][2], B0[2][2], B1[2][2];
    const char* cA = (const char*)g.A + (size_t)cur.pm * tstep; const char* cB = (const char*)g.Bt + (size_t)cur.pn * tstep;
    S.a_ready(cur);
    if constexpr (SP2) {
        PG8_STAGE(PG8_SB(0, 0), cB, voffB); PG8_STAGE(PG8_SB(0, 1), cB + hstep, voffB); PG8_STAGE(PG8_SA(0, 0), cA, voffA); PG8_STAGE(PG8_SA(0, 1), cA + hstep, voffA);
        if (wr == 1) PG8_BAR;
        PG8_WAIT_V(2); PG8_BAR;
        PG8_STAGE(PG8_SB(1, 0), cB + kstep, voffB); PG8_STAGE(PG8_SA(1, 0), cA + kstep, voffA); PG8_STAGE(PG8_SB(1, 1), cB + hstep + kstep, voffB);
        PG8_WAIT_V(6); PG8_BAR;
    } else {
        PG8_STAGE(PG8_SB(0, 0), cB, voffB); PG8_STAGE(PG8_SA(0, 0), cA, voffA); PG8_STAGE(PG8_SB(0, 1), cB + hstep, voffB); PG8_STAGE(PG8_SA(0, 1), cA + hstep, voffA);
        if (wr == 1) PG8_BAR;
        PG8_WAIT_V(4); PG8_BAR;
        PG8_STAGE(PG8_SB(1, 0), cB + kstep, voffB); PG8_STAGE(PG8_SA(1, 0), cA + kstep, voffA); PG8_STAGE(PG8_SB(1, 1), cB + hstep + kstep, voffB);
        PG8_WAIT_V(6); PG8_BAR;
    }
    for (;;) {
        const bool has_next = S.next(ui + 1, nxt);
        const char* nA = has_next ? (const char*)g.A + (size_t)nxt.pm * tstep : cA; const char* nB = has_next ? (const char*)g.Bt + (size_t)nxt.pn * tstep : cB;
#if PROBE_KL
        unsigned long long pk_t0 = 0; if (Epi::PERM && Epi::NSTORE == 16 && ui == 2 && blockIdx.x == 0 && wid == 0) pk_t0 = __builtin_readcyclecounter();
#endif
        for (int t = 0; t < nt; t += 2) {
            const bool last = (t == nt - 2);
            const char* a1 = cA + (size_t)(t + 1) * kstep;
            const char* a2 = last ? nA : cA + (size_t)(t + 2) * kstep; const char* b2 = last ? nB : cB + (size_t)(t + 2) * kstep;
            const char* a3 = a2 + kstep; const char* b3 = b2 + kstep;
            if (last && has_next) S.a_ready(nxt);
            if constexpr (SP2) {
            PG8_LDB(B0, 0, 0); PG8_LDB(B1, 0, 1); PG8_SCHED; PG8_LDA(At, 0, 0); PG8_STAGE(PG8_SA(1, 1), a1 + hstep, voffA);
            PG8_WAIT_V(8); PG8_WAIT_L(0); PG8_BAR; PG8_MMA(0, 0, At, B0); PG8_MMA(0, 1, At, B1); PG8_BAR; PG8_SCHED;
            PG8_LDA(At, 0, 1); PG8_STAGE(PG8_SB(0, 0), b2, voffB); PG8_STAGE(PG8_SB(0, 1), b2 + hstep, voffB); PG8_STAGE(PG8_SA(0, 0), a2, voffA);
            PG8_WAIT_V(8); PG8_WAIT_L(0); PG8_BAR; PG8_MMA(1, 0, At, B0); PG8_MMA(1, 1, At, B1); PG8_BAR; PG8_SCHED;
            PG8_LDB(B0, 1, 0); PG8_LDB(B1, 1, 1); PG8_SCHED; PG8_LDA(At, 1, 0); PG8_STAGE(PG8_SA(0, 1), a2 + hstep, voffA);
            PG8_WAIT_V(8); PG8_WAIT_L(0); PG8_BAR; PG8_MMA(0, 0, At, B0); PG8_MMA(0, 1, At, B1); PG8_BAR; PG8_SCHED;
            PG8_LDA(At, 1, 1); PG8_STAGE(PG8_SB(1, 0), b3, voffB); PG8_STAGE(PG8_SB(1, 1), b3 + hstep, voffB); PG8_STAGE(PG8_SA(1, 0), a3, voffA);
            PG8_WAIT_V(8); PG8_WAIT_L(0); PG8_BAR; PG8_MMA(1, 0, At, B0); PG8_MMA(1, 1, At, B1); PG8_BAR; PG8_SCHED;
            } else {
            PG8_LDB(B0, 0, 0); PG8_SCHED; PG8_LDA(At, 0, 0); PG8_STAGE(PG8_SA(1, 1), a1 + hstep, voffA);
            PG8_WAIT_L(8); PG8_BAR; PG8_WAIT_L(0); PG8_MMA(0, 0, At, B0); PG8_BAR; PG8_SCHED;
            PG8_LDB(B1, 0, 1); PG8_STAGE(PG8_SB(0, 0), b2, voffB);
            PG8_BAR; PG8_WAIT_L(0); PG8_MMA(0, 1, At, B1); PG8_BAR;
            PG8_LDA(At, 0, 1); PG8_STAGE(PG8_SA(0, 0), a2, voffA);
            PG8_BAR; PG8_WAIT_L(0); PG8_MMA(1, 0, At, B0); PG8_BAR; PG8_SCHED;
            PG8_STAGE(PG8_SB(0, 1), b2 + hstep, voffB);
            PG8_WAIT_V(6); PG8_BAR; PG8_MMA(1, 1, At, B1); PG8_BAR;
            PG8_LDB(B0, 1, 0); PG8_SCHED; PG8_LDA(At, 1, 0); PG8_STAGE(PG8_SA(0, 1), a2 + hstep, voffA);
            PG8_WAIT_L(8); PG8_BAR; PG8_WAIT_L(0); PG8_MMA(0, 0, At, B0); PG8_BAR; PG8_SCHED;
            PG8_LDB(B1, 1, 1); PG8_STAGE(PG8_SB(1, 0), b3, voffB);
            PG8_BAR; PG8_WAIT_L(0); PG8_MMA(0, 1, At, B1); PG8_BAR;
            PG8_LDA(At, 1, 1); PG8_STAGE(PG8_SA(1, 0), a3, voffA);
            PG8_BAR; PG8_WAIT_L(0); PG8_MMA(1, 0, At, B0); PG8_BAR; PG8_SCHED;
            PG8_STAGE(PG8_SB(1, 1), b3 + hstep, voffB);
            PG8_WAIT_V(6); PG8_BAR; PG8_MMA(1, 1, At, B1); PG8_BAR;
            }
        }
#if PROBE_KL
        unsigned long long pk_t1 = 0; if (Epi::PERM && Epi::NSTORE == 16 && ui == 2 && blockIdx.x == 0 && wid == 0) pk_t1 = __builtin_readcyclecounter();
#endif
        if constexpr (ALIGN_EPI) { if (wr == 0) PG8_BAR; }
        if constexpr (!Epi::AFTER_DRAIN) { E(acc, cur, wr, wc, fr, fq);
#if PROBE_EPI2
            if constexpr (Epi::PERM) { asm volatile("" ::: "memory"); E(acc, cur, wr, wc, fr, fq); }
#endif
            S.done(cur); }
#if PROBE_KL
        if (Epi::PERM && Epi::NSTORE == 16 && ui == 2 && blockIdx.x == 0 && wid == 0) { asm volatile("s_waitcnt vmcnt(0)" ::: "memory"); const unsigned long long pk_t2 = __builtin_readcyclecounter(); if (lane == 0 && (PROBE_KL_FIRST == 0 || probe_kl[0] == 0ull)) { probe_kl[0] = pk_t1 - pk_t0; probe_kl[1] = pk_t2 - pk_t1; } }
#endif
        if (!has_next) break;
#pragma unroll
        for (int a = 0; a < 2; ++a)
#pragma unroll
            for (int b = 0; b < 2; ++b)
#pragma unroll
                for (int m = 0; m < 4; ++m)
#pragma unroll
                    for (int n = 0; n < 2; ++n) acc[a][b][m][n] = (f32x4){0.f, 0.f, 0.f, 0.f};
        cur = nxt; cA = nA; cB = nB; ++ui;
        if constexpr (ALIGN_EPI) { if (wr == 1) PG8_BAR; }
    }
    PG8_WAIT_V(0);
    if constexpr (!ALIGN_EPI) { if (wr == 0) PG8_BAR; }
    PG8_BAR;
    if constexpr (Epi::AFTER_DRAIN) { E.fused(acc, cur, wr, wc, fr, fq, lds, wid, lane); S.done(cur); }
#undef PG8_SA
#undef PG8_SB
#undef PG8_STAGE
#undef PG8_LDA
#undef PG8_LDB
#undef PG8_MMA
#undef PG8_WAIT_V
#undef PG8_WAIT_L
#undef PG8_BAR
#undef PG8_SCHED
}
}

#ifndef MK_PER_PHASE
#define MK_PER_PHASE 0
#endif
constexpr int NWAVES = 8;
constexpr int DM = 1024, NB = 32, SEQ = 2048, NL = 4, MT = NB * SEQ;
constexpr int D_IN = 3976, NPI = 4096, DFF = 2816, NF1 = 2 * DFF;
constexpr int RW_B = 1024, ML_B = 2432;
constexpr int RWKV_IN = 1408;
constexpr float RMS_EPS = 1e-6f, GN_EPS = 1e-5f;
constexpr int MODP = 6 * DM;
constexpr size_t MiB = 1u << 20;
constexpr size_t WS_CTL = 0, CTL_ZERO_BYTES = 1 * MiB;
constexpr size_t WS_HS = 116 * MiB;
constexpr int CW_PCNT = 32768, PCNT_BANK = 256 * 64;
constexpr int CW_FLAG = 16384;
constexpr int SPLIT_H = 5, SPLIT_X = 27, SPLIT_Y = 16;
constexpr size_t WS_WL = 5 * MiB;
constexpr size_t WS_MOD = 1 * MiB;
constexpr size_t WS_WIN = 8 * MiB, WS_WOUT = 40 * MiB, WS_WF1 = 48 * MiB, WS_WF2 = 92 * MiB;
constexpr size_t WS_H = 128 * MiB;
constexpr size_t WS_PROJ = 256 * MiB;
constexpr size_t WS_XFIN = (256 + 352) * MiB;
constexpr size_t WS_DEC = 768 * MiB, WS_AA = 864 * MiB, WS_GG = 912 * MiB;
constexpr size_t WS_END = 960 * MiB;
constexpr int CW_BAR = 4096;
constexpr int N_PHASES = 3 + 6 * NL;
static_assert((CW_BAR + (MK_PER_PHASE ? 1 : 1) * 3456) * 4 <= (int)CTL_ZERO_BYTES, "ctl");
constexpr int RING_BYTES = 131072, LDS_BYTES = 163840, LDSCTL_OFF = LDS_BYTES - 1024, MISC_OFF = LDSCTL_OFF + 320;

#define GAS __attribute__((address_space(1)))
#define LAS __attribute__((address_space(3)))
typedef unsigned short bf16;
typedef unsigned v4u __attribute__((ext_vector_type(4)));
typedef unsigned v2u __attribute__((ext_vector_type(2)));
typedef float f32x4 __attribute__((ext_vector_type(4)));
#define LDS_WAIT() asm volatile("s_waitcnt lgkmcnt(0)" ::: "memory")
typedef float f32x2c __attribute__((ext_vector_type(2)));
typedef __bf16 bf16x2c __attribute__((ext_vector_type(2)));
__device__ __forceinline__ unsigned f2bf(float f) { return (__builtin_bit_cast(unsigned, f) + 0x8000u) >> 16; }
__device__ __forceinline__ unsigned pk2(float lo, float hi) { return __builtin_amdgcn_perm(__builtin_bit_cast(unsigned, hi) + 0x8000u, __builtin_bit_cast(unsigned, lo) + 0x8000u, 0x07060302u); }
__device__ __forceinline__ float bf2f(bf16 v) { return __uint_as_float(((unsigned)v) << 16); }
template <int CTRL, int ROWMASK> __device__ __forceinline__ float dppf(float v) { return __builtin_bit_cast(float, __builtin_amdgcn_update_dpp(0, __builtin_bit_cast(int, v), CTRL, ROWMASK, 0xf, false)); }
__device__ __forceinline__ float sum16(float v) { v += dppf<0xB1, 0xf>(v); v += dppf<0x4E, 0xf>(v); v += dppf<0x141, 0xf>(v); v += dppf<0x140, 0xf>(v); return v; }
__device__ __forceinline__ float wave_sum(float v) { v = sum16(v); v += dppf<0x142, 0xa>(v); v += dppf<0x143, 0xc>(v); return __builtin_bit_cast(float, __builtin_amdgcn_readlane(__builtin_bit_cast(int, v), 63)); }
template <int CTRL, int ROWMASK> __device__ __forceinline__ float dppo(float v, float old) { return __builtin_bit_cast(float, __builtin_amdgcn_update_dpp(__builtin_bit_cast(int, old), __builtin_bit_cast(int, v), CTRL, ROWMASK, 0xf, false)); }
__device__ __forceinline__ float wave_prefix_sum(float v) { v += dppo<0x111, 0xf>(v, 0.f); v += dppo<0x112, 0xf>(v, 0.f); v += dppo<0x114, 0xf>(v, 0.f); v += dppo<0x118, 0xf>(v, 0.f); v += dppo<0x142, 0xa>(v, 0.f); v += dppo<0x143, 0xc>(v, 0.f); return v; }
__device__ __forceinline__ float wave_prefix_max(float v) { const float ni = -__builtin_inff(); v = fmaxf(v, dppo<0x111, 0xf>(v, ni)); v = fmaxf(v, dppo<0x112, 0xf>(v, ni)); v = fmaxf(v, dppo<0x114, 0xf>(v, ni)); v = fmaxf(v, dppo<0x118, 0xf>(v, ni));
    v = fmaxf(v, dppo<0x142, 0xa>(v, ni)); v = fmaxf(v, dppo<0x143, 0xc>(v, ni)); return v; }
__device__ __forceinline__ float flogsigmoid(float x) { return fminf(x, 0.f) - __logf(1.0f + __expf(-fabsf(x))); }
__device__ __forceinline__ float fexp(float x) { return __expf(x); }
__device__ __forceinline__ float fsigmoid(float x) { return __builtin_amdgcn_rcpf(1.0f + __expf(-x)); }
__device__ __forceinline__ float sigmoid_f(float x) { return 1.0f / (1.0f + expf(-x)); }
__device__ __forceinline__ float logsigmoid_f(float x) { return fminf(x, 0.f) - log1pf(expf(-fabsf(x))); }
template <class T> __device__ __forceinline__ T* opq(T* p) { asm volatile("" : "+s"(p)); return p; }

#define XB_TMO      128
#define XB_XCNT(j)  (256  + 64 * (j))
#define XB_XSUB(j)  (1280 + 64 * (j))
#define XB_XGEN(j)  (2304 + 64 * (j))
#define XB_TOP      3328
#define XB_TOPGEN   3392
#define XCD_BAR_WORDS 3456
#define XB_SPIN_CAP (1u << 22)

__device__ __forceinline__ unsigned xb_ld(unsigned* p)              { return __hip_atomic_load(p, __ATOMIC_RELAXED, __HIP_MEMORY_SCOPE_AGENT); }
__device__ __forceinline__ unsigned xb_add(unsigned* p, unsigned v) { return __hip_atomic_fetch_add(p, v, __ATOMIC_RELAXED, __HIP_MEMORY_SCOPE_AGENT); }
__device__ __forceinline__ unsigned xb_xcc_id() { return (unsigned)__builtin_amdgcn_s_getreg((3 << 11) | 20) & 0xFu; }
#define XB_SPIN(cond, bar) do { unsigned _sp = 0; while (cond) { __builtin_amdgcn_s_sleep(1); \
    if ((++_sp & 255u) == 0u) { if (xb_ld(&(bar)[XB_TMO])) break; if (_sp > XB_SPIN_CAP) { atomicAdd(&(bar)[XB_TMO], 1u); break; } } } } while (0)

struct XcdBarrier {
    unsigned* bar; unsigned x; unsigned w0;
    volatile LAS unsigned* st;
};

__device__ __forceinline__ XcdBarrier xcd_barrier_post(unsigned* bar, volatile LAS unsigned* st) {
    XcdBarrier b; b.bar = bar; b.x = xb_xcc_id(); b.st = st; b.w0 = (__builtin_amdgcn_readfirstlane((int)threadIdx.x >> 6) == 0) ? 1u : 0u;
    if (threadIdx.x == 0) (void)xb_add(&bar[XB_XCNT(b.x)], 1u);
    return b;
}
__device__ __forceinline__ void xcd_barrier_complete(unsigned* bar, unsigned x, unsigned& nloc, unsigned& nx) {
    const unsigned G = gridDim.x * gridDim.y * gridDim.z;
    unsigned sum, cnt, mine, sp = 0u;
    for (;;) {
        sum = 0u; cnt = 0u; mine = 0u;
#pragma unroll
        for (unsigned j = 0; j < 16; ++j) { const unsigned c = xb_ld(&bar[XB_XCNT(j)]); sum += c; cnt += (c > 0u) ? 1u : 0u; mine = (j == x) ? c : mine; }
        if (sum == G) break;
        __builtin_amdgcn_s_sleep(1);
        if ((++sp & 255u) == 0u) { if (xb_ld(&bar[XB_TMO])) break; if (sp > XB_SPIN_CAP) { atomicAdd(&bar[XB_TMO], 1u); break; } }
    }
    nloc = mine > 0u ? mine : 1u; nx = cnt > 0u ? cnt : 1u;
}

__device__ __forceinline__ void xcd_barrier(const XcdBarrier& b) {
    asm volatile("s_waitcnt vmcnt(0)" ::: "memory");
    __syncthreads();
    if (b.w0 != 0u && lane_id_opq() == 0) {
        unsigned* bar = b.bar;
        __builtin_amdgcn_s_waitcnt(0);
        unsigned nloc = b.st[0], nx = b.st[1];
        if (nloc == 0u) { xcd_barrier_complete(bar, b.x, nloc, nx); b.st[0] = nloc; b.st[1] = nx; }
        const unsigned old = xb_add(&bar[XB_XSUB(b.x)], 1u);
        const unsigned gen = old / nloc;
        if (old + 1u == (gen + 1u) * nloc) {
            __builtin_amdgcn_fence(__ATOMIC_RELEASE, "agent");
            asm volatile("s_waitcnt vmcnt(0)" ::: "memory");
            const unsigned og = xb_add(&bar[XB_TOP], 1u);
            const unsigned tg = og / nx;
            if (og + 1u == (tg + 1u) * nx) xb_add(&bar[XB_TOPGEN], 1u);
            else XB_SPIN(xb_ld(&bar[XB_TOPGEN]) == tg, bar);
            __builtin_amdgcn_fence(__ATOMIC_ACQUIRE, "agent");
            xb_add(&bar[XB_XGEN(b.x)], 1u);
            asm volatile("s_waitcnt vmcnt(0)" ::: "memory");
        } else {
            XB_SPIN(xb_ld(&bar[XB_XGEN(b.x)]) == gen, bar);
            __builtin_amdgcn_fence(__ATOMIC_ACQUIRE, "agent");
            asm volatile("s_waitcnt vmcnt(0)" ::: "memory");
        }
    }
    __syncthreads();
}


__device__ __forceinline__ void b32_gemv(const float* Wcol  , bool ok, int N, LAS float* vT, float (&res)[4], int wave, int lane) {
    float acc[32];
#pragma unroll
    for (int b = 0; b < 32; ++b) acc[b] = 0.f;
    const float* wp = Wcol + (size_t)(128 * wave) * N; const LAS float* vp = vT + 128 * wave * 32;
#pragma unroll 1
    for (int kk = 0; kk < 128; kk += 8) {
        float w[8];
#pragma unroll
        for (int u = 0; u < 8; ++u) w[u] = ok ? wp[(size_t)u * N] : 0.f;
        wp += (size_t)8 * N;
#pragma unroll
        for (int u = 0; u < 8; ++u) {
#pragma unroll
            for (int b4 = 0; b4 < 8; ++b4) { const f32x4 cv = *(const LAS f32x4*)(vp + u * 32 + 4 * b4);
                acc[4 * b4] += cv.x * w[u]; acc[4 * b4 + 1] += cv.y * w[u]; acc[4 * b4 + 2] += cv.z * w[u]; acc[4 * b4 + 3] += cv.w * w[u]; }
            asm volatile("" ::: "memory"); }
        vp += 8 * 32;
    }
    __syncthreads();
#pragma unroll
    for (int b = 0; b < 32; ++b) vT[(wave * 32 + b) * 64 + lane] = acc[b];
    __syncthreads();
#pragma unroll
    for (int q = 0; q < 4; ++q) { float s = 0.f;
#pragma unroll
        for (int w2 = 0; w2 < 8; ++w2) s += vT[(w2 * 32 + 4 * wave + q) * 64 + lane];
        res[q] = s; }
    __syncthreads();
}
__device__ __forceinline__ void p0_mod(const float* c, const float* ada_w, const float* ada_b, float* mod, LAS unsigned char* lds, int tid, int lane, int wave) {
    LAS float* condT = (LAS float*)lds;
    for (int item = blockIdx.x; item < NL * 96; item += gridDim.x) {
        __syncthreads();
        for (int e = tid; e < NB * DM; e += NWAVES * 64) { const int k = e >> 5, b = e & 31; const float v = c[b * DM + k]; condT[e] = v / (1.0f + expf(-v)); }
        __syncthreads();
        const int l = item / 96, g = item % 96, n = g * 64 + lane;
        float res[4]; b32_gemv(ada_w + (size_t)l * DM * MODP + n, true, MODP, condT, res, wave, lane);
        const float bb = ada_b[l * MODP + n]; float* o = mod + ((size_t)l * NB + wave * 4) * MODP + n;
        o[0] = res[0] + bb; o[MODP] = res[1] + bb; o[2 * MODP] = res[2] + bb; o[3 * MODP] = res[3] + bb;
    }
    __syncthreads();
}
template <int MODE>
__device__ __forceinline__ void transpose_item(const float* W, int K, int N, int nblk, bf16* WT, int ldw, LAS float* scr, int item, int lane) {
    const int kb = item / nblk, nb = item % nblk, k0 = 64 * kb, n0 = 32 * nb;
    const int nq = lane & 7, nn = n0 + 4 * nq; const bool ok = nn < N;
    const float* wp = W + (size_t)(k0 + (lane >> 3)) * N + (ok ? nn : 0); f32x4 vv[8];
#pragma unroll
    for (int i = 0; i < 8; ++i) vv[i] = *(const f32x4*)(wp + (size_t)(8 * i) * N);
#pragma unroll
    for (int i = 0; i < 8; ++i) { const int kk = 8 * i + (lane >> 3); const f32x4 v = ok ? vv[i] : (f32x4){0.f, 0.f, 0.f, 0.f};
        LAS float* d = scr + kk * 33 + 4 * nq; d[0] = v.x; d[1] = v.y; d[2] = v.z; d[3] = v.w; }
    LDS_WAIT();
    const int c = lane & 7;
#pragma unroll
    for (int j = 0; j < 4; ++j) { const int n = (lane >> 3) + 8 * j; const LAS float* s = scr + (8 * c) * 33 + n;
        v4u o; o.x = pk2(s[0 * 33], s[1 * 33]); o.y = pk2(s[2 * 33], s[3 * 33]); o.z = pk2(s[4 * 33], s[5 * 33]); o.w = pk2(s[6 * 33], s[7 * 33]);
        int row = n0 + n;
        if (MODE == 1) { const int up = row >= DFF ? 1 : 0, jj = row - up * DFF; row = (jj >> 7) * 256 + up * 128 + (jj & 127); }
        *(v4u*)(WT + (size_t)row * ldw + k0 + 8 * c) = o; }
    LDS_WAIT();
}
__device__ __forceinline__ void p0_weights(const float* w_in, const float* w_out, const float* f1, const float* f2, const float* lw2, const float* la2, const float* lg2, unsigned char* ws, LAS unsigned char* lds, int gw, int ngw, int wave, int lane) {
    LAS float* scr = (LAS float*)(lds + wave * 16384);
    constexpr int I_IN = (DM / 64) * (NPI / 32), I_OUT = (DM / 64) * (DM / 32), I_F1 = (DM / 64) * (NF1 / 32), I_F2 = (DFF / 64) * (DM / 32), I_L = I_IN + I_OUT + I_F1 + I_F2 + 48;
    for (int it = gw; it < NL * I_L; it += ngw) {
        const int l = it / I_L; int r = it % I_L;
        if (r < I_IN) { transpose_item<0>(w_in + (size_t)l * DM * D_IN, DM, D_IN, NPI / 32, (bf16*)(ws + WS_WIN) + (size_t)l * NPI * DM, DM, scr, r, lane); continue; } r -= I_IN;
        if (r < I_OUT) { transpose_item<0>(w_out + (size_t)l * DM * DM, DM, DM, DM / 32, (bf16*)(ws + WS_WOUT) + (size_t)l * DM * DM, DM, scr, r, lane); continue; } r -= I_OUT;
        if (r < I_F1) { transpose_item<1>(f1 + (size_t)l * DM * NF1, DM, NF1, NF1 / 32, (bf16*)(ws + WS_WF1) + (size_t)l * NF1 * DM, DM, scr, r, lane); continue; } r -= I_F1;
        if (r < I_F2) { transpose_item<0>(f2 + (size_t)l * DFF * DM, DFF, DM, DM / 32, (bf16*)(ws + WS_WF2) + (size_t)l * DM * DFF, DFF, scr, r, lane); continue; } r -= I_F2;
        bf16* wl = (bf16*)(ws + WS_WL) + (size_t)l * 384 * 256;
        if (r < 12) { transpose_item<0>(lw2 + (size_t)l * 64 * 384, 64, 384, 12, wl, 256, scr, r, lane); continue; } r -= 12;
        if (r < 12) { transpose_item<0>(la2 + (size_t)l * 64 * 384, 64, 384, 12, wl + 64, 256, scr, r, lane); continue; } r -= 12;
        transpose_item<0>(lg2 + (size_t)l * 128 * 384, 128, 384, 12, wl + 128, 256, scr, r, lane);
    }
}
__device__ __forceinline__ void norm_mod_phase(const float* xin32, const float* gain, const float* modl, int sh_off, int sc_off, bf16* out, int gw, int ngw, int lane) {
    for (int ci = gw; ci < MT / 32; ci += ngw) {
        const int b = ci >> 6; const float* mb = modl + (size_t)b * MODP;
        f32x4 gs[4], sh[4];
#pragma unroll
        for (int j = 0; j < 4; ++j) { const int col = 4 * lane + 256 * j; const f32x4 g = *(const f32x4*)(gain + col), s = *(const f32x4*)(mb + sc_off + col); gs[j] = g * (s + 1.0f); sh[j] = *(const f32x4*)(mb + sh_off + col); }
#pragma unroll 1
        for (int r = 0; r < 32; r += 4) {
            const size_t row = (size_t)ci * 32 + r; const f32x4* xr = (const f32x4*)(xin32 + row * DM) + lane; f32x4 v[4][4];
#pragma unroll
            for (int q = 0; q < 4; ++q)
#pragma unroll
                for (int j = 0; j < 4; ++j) v[q][j] = xr[q * (DM / 4) + 64 * j];
#pragma unroll
            for (int q = 0; q < 4; ++q) { float ss = 0.f;
#pragma unroll
                for (int j = 0; j < 4; ++j) ss += (v[q][j].x * v[q][j].x + v[q][j].y * v[q][j].y) + (v[q][j].z * v[q][j].z + v[q][j].w * v[q][j].w);
                const float rstd = 1.0f / sqrtf(wave_sum(ss) * (1.0f / DM) + RMS_EPS);
                v2u* o8 = (v2u*)(out + (row + q) * DM) + lane;
#pragma unroll
                for (int j = 0; j < 4; ++j) { const f32x4 y = v[q][j] * rstd * gs[j] + sh[j]; v2u w; w.x = pk2(y.x, y.y); w.y = pk2(y.z, y.w); o8[64 * j] = w; } }
        }
    }
}
__device__ __forceinline__ void final_norm_phase(const bf16* xs, float* out, const float* gain, int gw, int ngw, int lane) {
    f32x4 g[4];
#pragma unroll
    for (int j = 0; j < 4; ++j) g[j] = *(const f32x4*)(gain + 4 * lane + 256 * j);
#pragma unroll 1
    for (int row = 4 * gw; row < MT; row += 4 * ngw) {
        const v2u* xr = (const v2u*)(xs + (size_t)row * DM) + lane; v2u w[4][4];
#pragma unroll
        for (int q = 0; q < 4; ++q)
#pragma unroll
            for (int j = 0; j < 4; ++j) w[q][j] = xr[q * (DM / 4) + 64 * j];
#pragma unroll
        for (int q = 0; q < 4; ++q) { f32x4 v[4]; float ss = 0.f;
#pragma unroll
            for (int j = 0; j < 4; ++j) { const v2u ww = w[q][j]; v[j] = (f32x4){__uint_as_float(ww.x << 16), __uint_as_float(ww.x & 0xffff0000u), __uint_as_float(ww.y << 16), __uint_as_float(ww.y & 0xffff0000u)};
                ss += (v[j].x * v[j].x + v[j].y * v[j].y) + (v[j].z * v[j].z + v[j].w * v[j].w); }
            const float rstd = 1.0f / sqrtf(wave_sum(ss) * (1.0f / DM) + RMS_EPS);
            f32x4* o = (f32x4*)(out + (size_t)(row + q) * DM) + lane;
#pragma unroll
            for (int j = 0; j < 4; ++j) o[64 * j] = v[j] * rstd * g[j]; }
    }
}
__device__ __forceinline__ void panel_norm_rows(const bf16* xs, const float* gain, const float* modb, int sh_off, int sc_off, bf16* out, int pm, int wave, int lane) {
    f32x4 gs[4], sh[4];
#pragma unroll
    for (int j = 0; j < 4; ++j) { const int col = 4 * lane + 256 * j; const f32x4 g = *(const f32x4*)(gain + col), s = *(const f32x4*)(modb + sc_off + col); gs[j] = g * (s + 1.0f); sh[j] = *(const f32x4*)(modb + sh_off + col); }
#pragma unroll 1
    for (int r = 0; r < 32; r += 4) {
        const size_t row = (size_t)pm * 256 + wave * 32 + r;
        const v2u* xr = (const v2u*)(xs + row * DM) + lane; v2u w[4][4];
#pragma unroll
        for (int q = 0; q < 4; ++q)
#pragma unroll
            for (int j = 0; j < 4; ++j) w[q][j] = xr[q * (DM / 4) + 64 * j];
#pragma unroll
        for (int q = 0; q < 4; ++q) { f32x4 v[4]; float ss = 0.f;
#pragma unroll
            for (int j = 0; j < 4; ++j) { const v2u ww = w[q][j]; v[j] = (f32x4){__uint_as_float(ww.x << 16), __uint_as_float(ww.x & 0xffff0000u), __uint_as_float(ww.y << 16), __uint_as_float(ww.y & 0xffff0000u)};
                ss += (v[j].x * v[j].x + v[j].y * v[j].y) + (v[j].z * v[j].z + v[j].w * v[j].w); }
            const float rstd = __builtin_amdgcn_rsqf(wave_sum(ss) * (1.0f / DM) + RMS_EPS);
            v2u* o8 = (v2u*)(out + (row + q) * DM) + lane;
#pragma unroll
            for (int j = 0; j < 4; ++j) { const f32x4 y = v[j] * rstd * gs[j] + sh[j]; v2u ww; ww.x = pk2(y.x, y.y); ww.y = pk2(y.z, y.w); o8[64 * j] = ww; } }
    }
}
template <class Sched>
__device__ __forceinline__ void fused_panel_norm(const Sched& S, unsigned* cnt, const bf16* xs, const float* gain, const float* modl, int sh_off, int sc_off, bf16* out, int wave, int lane) {
    pg8::Unit u[4]; bool has[4];
#pragma unroll
    for (int i = 0; i < 4; ++i) has[i] = S.next(i, u[i]);
    if (wave == 0 && lane == 0) {
        __builtin_amdgcn_fence(__ATOMIC_RELEASE, "agent"); asm volatile("s_waitcnt vmcnt(0)" ::: "memory");
#pragma unroll
        for (int i = 0; i < 4; ++i) if (has[i]) __hip_atomic_fetch_add(cnt + 64 * u[i].pm, 1u, __ATOMIC_RELAXED, __HIP_MEMORY_SCOPE_AGENT);
    }
#pragma unroll
    for (int i = 0; i < 4; ++i) {
        if (!has[i] || u[i].pn != ((u[i].pm >> 3) & 3)) continue;
        if (wave == 0) { unsigned spins = 0u;
            while (__hip_atomic_load(cnt + 64 * u[i].pm, __ATOMIC_RELAXED, __HIP_MEMORY_SCOPE_AGENT) < 4u) { __builtin_amdgcn_s_sleep(2); if (++spins > (1u << 22)) break; }
            __builtin_amdgcn_fence(__ATOMIC_ACQUIRE, "agent"); asm volatile("s_waitcnt vmcnt(0)" ::: "memory"); }
        __syncthreads();
        panel_norm_rows(xs, gain, modl + (size_t)(u[i].pm >> 3) * MODP, sh_off, sc_off, out, u[i].pm, wave, lane);
#if PROBE_PN
        asm volatile("" ::: "memory"); panel_norm_rows(xs, gain, modl + (size_t)(u[i].pm >> 3) * MODP, sh_off, sc_off, out, u[i].pm, wave, lane);
#endif
    }
}
#define WG_BAR() do { asm volatile("s_waitcnt vmcnt(0) lgkmcnt(0)" ::: "memory"); __builtin_amdgcn_s_barrier(); asm volatile("" ::: "memory"); } while (0)
#define WG_BAR_L() do { asm volatile("s_waitcnt lgkmcnt(0)" ::: "memory"); __builtin_amdgcn_s_barrier(); asm volatile("" ::: "memory"); } while (0)
typedef short bf16x8p __attribute__((ext_vector_type(8)));
__device__ __forceinline__ void rwkv_prep_mfma(const bf16* proj, const float* mu, const float* w0, const float* a0, const bf16* WL, float* DEC, bf16* AA, bf16* GG, LAS unsigned char* lds, int wave) {
    constexpr int AP = 264;
    LAS bf16* act = (LAS bf16*)lds;
    bf16x8p bw[2][3], ba[2][3], bg[4][3];
    { const int lane = lane_id_opq(); const bf16* bfr = WL + (size_t)(48 * wave + (lane & 15)) * 256 + 8 * (lane >> 4);
#pragma unroll
      for (int nt = 0; nt < 3; ++nt) {
#pragma unroll
          for (int ks = 0; ks < 2; ++ks) { bw[ks][nt] = *(const bf16x8p*)(bfr + 16 * nt * 256 + 32 * ks); ba[ks][nt] = *(const bf16x8p*)(bfr + 16 * nt * 256 + 64 + 32 * ks); }
#pragma unroll
          for (int ks = 0; ks < 4; ++ks) bg[ks][nt] = *(const bf16x8p*)(bfr + 16 * nt * 256 + 128 + 32 * ks); } }
#pragma unroll 1
    for (int item = blockIdx.x; item < MT / 64; item += gridDim.x) {
        const int lane = lane_id_opq(), tid = wave * 64 + lane, q4 = lane >> 4, lc = lane & 15;
        const size_t m0 = (size_t)item * 64; const int t0 = (int)(m0 % SEQ);
        { const int tt = tid >> 3, cg = tid & 7; const bf16* p = proj + (m0 + tt) * NPI + RW_B + 1152 + 32 * cg; const bool hp = (t0 + tt) > 0; const bf16* pp = hp ? p - NPI : p; const float* mup = mu + 1152 + 32 * cg;
          v4u cur[4], prv[4]; f32x4 m0v[4], m1v[4];
#pragma unroll
          for (int v = 0; v < 4; ++v) { cur[v] = *(const v4u*)(p + 8 * v); prv[v] = *(const v4u*)(pp + 8 * v); m0v[v] = *(const f32x4*)(mup + 8 * v); m1v[v] = *(const f32x4*)(mup + 8 * v + 4); }
#pragma unroll
          for (int v = 0; v < 4; ++v) {
              float x[8];
#pragma unroll
              for (int e = 0; e < 4; ++e) { const unsigned cw = cur[v][e], pw = hp ? prv[v][e] : 0u; const float c0 = __uint_as_float(cw << 16), c1 = __uint_as_float(cw & 0xffff0000u), p0 = __uint_as_float(pw << 16), p1 = __uint_as_float(pw & 0xffff0000u);
                  const float mu0 = e < 2 ? m0v[v][2 * e] : m1v[v][2 * e - 4], mu1 = e < 2 ? m0v[v][2 * e + 1] : m1v[v][2 * e - 3];
                  x[2 * e] = c0 + (p0 - c0) * mu0; x[2 * e + 1] = c1 + (p1 - c1) * mu1; }
              if (cg < 2) {
#pragma unroll
                  for (int e = 0; e < 8; ++e) x[e] = 2.0f * fsigmoid(2.0f * x[e]) - 1.0f;
              } else if (cg >= 4) {
#pragma unroll
                  for (int e = 0; e < 8; ++e) x[e] = fsigmoid(x[e]);
              }
              v4u o; o.x = pk2(x[0], x[1]); o.y = pk2(x[2], x[3]); o.z = pk2(x[4], x[5]); o.w = pk2(x[6], x[7]);
              *(LAS v4u*)(act + tt * AP + 32 * cg + 8 * v) = o; } }
        WG_BAR_L();
        const LAS bf16* afr = act + lc * AP + 8 * q4;
        { f32x4 acc[4][3];
#pragma unroll
          for (int mt = 0; mt < 4; ++mt)
#pragma unroll
              for (int nt = 0; nt < 3; ++nt) acc[mt][nt] = (f32x4){0.f, 0.f, 0.f, 0.f};
#pragma unroll
          for (int ks = 0; ks < 2; ++ks)
#pragma unroll
              for (int mt = 0; mt < 4; ++mt) { const bf16x8p aq = *(const LAS bf16x8p*)(afr + 16 * mt * AP + 32 * ks);
#pragma unroll
                  for (int nt = 0; nt < 3; ++nt) acc[mt][nt] = __builtin_amdgcn_mfma_f32_16x16x32_bf16(aq, bw[ks][nt], acc[mt][nt], 0, 0, 0); }
#pragma unroll
          for (int nt = 0; nt < 3; ++nt) { const int n = 48 * wave + 16 * nt + lc; const float w0n = w0[n]; float carry = 0.f;
#pragma unroll
              for (int mt = 0; mt < 4; ++mt) { float pr[4];
#pragma unroll
                  for (int r = 0; r < 4; ++r) { const float ld = -0.60653066f * fsigmoid(w0n + acc[mt][nt][r]); pr[r] = r ? pr[r - 1] + ld : ld; }
                  const float tot = pr[3]; float s1 = tot; { const float u = __shfl_up(s1, 16); if (q4 >= 1) s1 += u; } { const float u = __shfl_up(s1, 32); if (q4 >= 2) s1 += u; }
                  const float excl = carry + (s1 - tot), tile_tot = __shfl(s1, 48 + lc);
                  float* dp = DEC + (m0 + 16 * mt + 4 * q4) * 384 + n;
#pragma unroll
                  for (int r = 0; r < 4; ++r) dp[r * 384] = excl + pr[r];
                  carry += tile_tot; } } }
        { f32x4 acc[4][3];
#pragma unroll
          for (int mt = 0; mt < 4; ++mt)
#pragma unroll
              for (int nt = 0; nt < 3; ++nt) acc[mt][nt] = (f32x4){0.f, 0.f, 0.f, 0.f};
#pragma unroll
          for (int ks = 0; ks < 2; ++ks)
#pragma unroll
              for (int mt = 0; mt < 4; ++mt) { const bf16x8p aq = *(const LAS bf16x8p*)(afr + 16 * mt * AP + 64 + 32 * ks);
#pragma unroll
                  for (int nt = 0; nt < 3; ++nt) acc[mt][nt] = __builtin_amdgcn_mfma_f32_16x16x32_bf16(ba[ks][nt], aq, acc[mt][nt], 0, 0, 0); }
#pragma unroll
          for (int nt = 0; nt < 3; ++nt) { const int n = 48 * wave + 16 * nt + 4 * q4; const f32x4 a0n = *(const f32x4*)(a0 + n);
#pragma unroll
              for (int mt = 0; mt < 4; ++mt) { v2u w; w.x = pk2(fsigmoid(a0n.x + acc[mt][nt][0]), fsigmoid(a0n.y + acc[mt][nt][1])); w.y = pk2(fsigmoid(a0n.z + acc[mt][nt][2]), fsigmoid(a0n.w + acc[mt][nt][3]));
                  *(v2u*)(AA + (m0 + 16 * mt + lc) * 384 + n) = w; } } }
        { f32x4 acc[4][3];
#pragma unroll
          for (int mt = 0; mt < 4; ++mt)
#pragma unroll
              for (int nt = 0; nt < 3; ++nt) acc[mt][nt] = (f32x4){0.f, 0.f, 0.f, 0.f};
#pragma unroll
          for (int ks = 0; ks < 4; ++ks)
#pragma unroll
              for (int mt = 0; mt < 4; ++mt) { const bf16x8p aq = *(const LAS bf16x8p*)(afr + 16 * mt * AP + 128 + 32 * ks);
#pragma unroll
                  for (int nt = 0; nt < 3; ++nt) acc[mt][nt] = __builtin_amdgcn_mfma_f32_16x16x32_bf16(bg[ks][nt], aq, acc[mt][nt], 0, 0, 0); }
#pragma unroll
          for (int nt = 0; nt < 3; ++nt) { const int n = 48 * wave + 16 * nt + 4 * q4;
#pragma unroll
              for (int mt = 0; mt < 4; ++mt) { v2u w; w.x = pk2(acc[mt][nt][0], acc[mt][nt][1]); w.y = pk2(acc[mt][nt][2], acc[mt][nt][3]);
                  *(v2u*)(GG + (m0 + 16 * mt + lc) * 384 + n) = w; } } }
        WG_BAR_L();
    }
}
typedef short bf16x8_t __attribute__((ext_vector_type(8)));
template <int KS>
__device__ __forceinline__ f32x4 mm_tile(const LAS bf16* A, const LAS bf16* B, f32x4 acc) {
#pragma unroll
    for (int ks = 0; ks < KS; ++ks) {
        const bf16x8_t a = *(const LAS bf16x8_t*)(A + ks * 32), b = *(const LAS bf16x8_t*)(B + ks * 32);
        acc = __builtin_amdgcn_mfma_f32_16x16x32_bf16(a, b, acc, 0, 0, 0);
    }
    return acc;
}
__device__ __forceinline__ unsigned short f2bf16(float f) { return (unsigned short)f2bf(f); }
constexpr int LP = 72;
constexpr int LPM = 104;

__device__ __forceinline__ void ret_unit(int b, int h, const bf16* proj, const float* gn, bf16* mixed, LAS unsigned char* lds, int wave, int lane0) {
    LAS bf16* Qs = (LAS bf16*)lds; LAS bf16* Ks = Qs + 64 * LP; LAS bf16* Kdt = Ks + 64 * LP; LAS bf16* Vt = Kdt + 64 * LP; LAS bf16* Ps = Vt + 64 * LP; LAS bf16* Stt = Ps + 64 * LP; LAS bf16* Gs = Stt + 64 * LP;
    const int lane = lane0, q4 = lane >> 4, lc = lane & 15;
    const float inv = powf(10000.0f, -(float)(2 * (lane & 31)) / 64.0f);
    float cs[8], sn[8];
#pragma unroll
    for (int i = 0; i < 8; ++i) __sincosf((float)(8 * wave + i) * inv, &sn[i], &cs[i]);
    float c64, s64; sincosf(64.0f * inv, &s64, &c64);
    const float lg2 = log2f(1.0f - exp2f(-5.0f - (float)h));
    float kdec[8];
#pragma unroll
    for (int i = 0; i < 8; ++i) kdec[i] = exp2f((float)(63 - (8 * wave + i)) * lg2);
    const float cd = exp2f(64.0f * lg2);
    f32x4 st[4];
#pragma unroll
    for (int i = 0; i < 4; ++i) st[i] = (f32x4){0.f, 0.f, 0.f, 0.f};
    for (int i = wave * 64 + lane; i < 64 * LP / 2; i += 512) ((LAS unsigned*)Stt)[i] = 0u;
    const size_t m0 = (size_t)b * SEQ;
    const bf16* P0 = proj + m0 * NPI + h * 64;
    unsigned short rq[8], rk[8], rv[8], rg[8];
#pragma unroll
    for (int i = 0; i < 8; ++i) { const bf16* p = P0 + (size_t)(8 * wave + i) * NPI; rq[i] = p[lane]; rk[i] = p[256 + lane]; rv[i] = p[512 + lane]; rg[i] = p[768 + lane]; }
    float gain4[4];
#pragma unroll
    for (int ct = 0; ct < 4; ++ct) gain4[ct] = gn[h * 64 + 16 * ct + lc];
    float dmk[2][4], qdk[4];
#pragma unroll
    for (int u = 0; u < 2; ++u)
#pragma unroll
        for (int r = 0; r < 4; ++r) { const int l = 16 * (wave >> 1) + 4 * q4 + r, m = 16 * (2 * (wave & 1) + u) + lc; dmk[u][r] = (l >= m) ? exp2f((float)(l - m) * lg2) : 0.f; }
#pragma unroll
    for (int r = 0; r < 4; ++r) qdk[r] = exp2f((float)(16 * (wave & 3) + 4 * q4 + r + 1) * lg2);
#pragma unroll 1
    for (int c = 0; c < SEQ / 64; ++c) {
        const int lane = lane_id_opq(), q4 = lane >> 4, lc = lane & 15, o72 = lc * LP + 8 * q4;
        { unsigned short kd[8];
#pragma unroll
          for (int i = 0; i < 8; ++i) { const int tt = 8 * wave + i;
              const float q = bf2f(rq[i]), k = bf2f(rk[i]); const float qp = __shfl_xor(q, 32), kp = __shfl_xor(k, 32);
              const float qr = lane < 32 ? q * cs[i] - qp * sn[i] : qp * sn[i] + q * cs[i];
              const float kr = (lane < 32 ? k * cs[i] - kp * sn[i] : kp * sn[i] + k * cs[i]) * 0.125f;
              Qs[tt * LP + lane] = f2bf16(qr); Ks[tt * LP + lane] = f2bf16(kr); Gs[tt * LP + lane] = rg[i]; kd[i] = f2bf16(kr * kdec[i]);
              const float cn = cs[i] * c64 - sn[i] * s64, snn = sn[i] * c64 + cs[i] * s64; cs[i] = cn; sn[i] = snn; }
          v4u w; w.x = kd[0] | ((unsigned)kd[1] << 16); w.y = kd[2] | ((unsigned)kd[3] << 16); w.z = kd[4] | ((unsigned)kd[5] << 16); w.w = kd[6] | ((unsigned)kd[7] << 16);
          *(LAS v4u*)(Kdt + lane * LP + 8 * wave) = w;
          w.x = rv[0] | ((unsigned)rv[1] << 16); w.y = rv[2] | ((unsigned)rv[3] << 16); w.z = rv[4] | ((unsigned)rv[5] << 16); w.w = rv[6] | ((unsigned)rv[7] << 16);
          *(LAS v4u*)(Vt + lane * LP + 8 * wave) = w; }
        WG_BAR_L();
        if (c + 1 < SEQ / 64) {
#pragma unroll
            for (int i = 0; i < 8; ++i) { const bf16* p = P0 + (size_t)(64 * (c + 1) + 8 * wave + i) * NPI; rq[i] = p[lane]; rk[i] = p[256 + lane]; rv[i] = p[512 + lane]; rg[i] = p[768 + lane]; } }
        { const int rt = wave >> 1;
#pragma unroll
          for (int u = 0; u < 2; ++u) { const int ct = 2 * (wave & 1) + u;
              f32x4 s = (f32x4){0.f, 0.f, 0.f, 0.f};
              if (ct <= rt) s = mm_tile<2>(Qs + 16 * rt * LP + o72, Ks + 16 * ct * LP + o72, s);
#pragma unroll
              for (int r = 0; r < 4; ++r) { const int l = 16 * rt + 4 * q4 + r, m = 16 * ct + lc; Ps[l * LP + m] = f2bf16(s[r] * dmk[u][r]); } } }
        f32x4 inter[4];
        if (wave < 4) {
#pragma unroll
            for (int ct = 0; ct < 4; ++ct) inter[ct] = mm_tile<2>(Qs + 16 * wave * LP + o72, Stt + 16 * ct * LP + o72, (f32x4){0.f, 0.f, 0.f, 0.f}); }
        WG_BAR_L();
        if (wave < 4) {
            f32x4 y[4];
#pragma unroll
            for (int ct = 0; ct < 4; ++ct) y[ct] = mm_tile<2>(Ps + 16 * wave * LP + o72, Vt + 16 * ct * LP + o72, (f32x4){0.f, 0.f, 0.f, 0.f});
#pragma unroll
            for (int r = 0; r < 4; ++r) { const int l = 16 * wave + 4 * q4 + r; const float qd = qdk[r];
                float s = 0.f;
#pragma unroll
                for (int ct = 0; ct < 4; ++ct) { y[ct][r] += qd * inter[ct][r]; s += y[ct][r]; }
                const float mean = sum16(s) * (1.0f / 64.0f); float qv = 0.f;
#pragma unroll
                for (int ct = 0; ct < 4; ++ct) { const float dd = y[ct][r] - mean; qv += dd * dd; }
                const float rstd = __builtin_amdgcn_rsqf(sum16(qv) * (1.0f / 64.0f) + GN_EPS);
                bf16* orow = mixed + (m0 + 64 * c + l) * DM + h * 64 + lc;
#pragma unroll
                for (int ct = 0; ct < 4; ++ct) { const float g = bf2f(Gs[l * LP + 16 * ct + lc]); orow[16 * ct] = f2bf16((y[ct][r] - mean) * rstd * gain4[ct] * (g * fsigmoid(g))); } }
        } else {
            const int dt = wave - 4;
#pragma unroll
            for (int ct = 0; ct < 4; ++ct) { st[ct] = mm_tile<2>(Kdt + 16 * dt * LP + o72, Vt + 16 * ct * LP + o72, st[ct] * cd);
                v2u w; w.x = pk2(st[ct][0], st[ct][1]); w.y = pk2(st[ct][2], st[ct][3]);
                *(LAS v2u*)(Stt + (16 * ct + lc) * LP + 16 * dt + 4 * q4) = w; }
        }
        WG_BAR_L();
    }
}

__device__ __forceinline__ void mlstm_unit(int b, int h, const bf16* proj, const float* conv_w, const float* conv_b, const float* i_b, const float* f_b, const float* gn, bf16* mixed,
                                           LAS unsigned char* lds, int wave, int lane0) {
    LAS bf16* Qs = (LAS bf16*)lds; LAS bf16* Ks = Qs + 64 * LPM; LAS bf16* Kdt = Ks + 64 * LPM; LAS bf16* Vt = Kdt + 96 * LP; LAS bf16* Ps = Vt + 112 * LP; LAS bf16* Stt = Ps + 64 * LP; LAS bf16* Os = Stt + 112 * LPM;
    LAS float* ev = (LAS float*)(Os + 64 * LPM); LAS float* pmv = ev + 64; LAS float* flv = pmv + 64;
    const int lane = lane0, lc = lane & 15;
    float wq0[4], wq1[4], wk0[4], wk1[4], bq0, bq1, bk0, bk1;
    { const int cq = h * 96 + (lane < 48 ? 2 * lane : 0), ck = 384 + cq;
#pragma unroll
    for (int j = 0; j < 4; ++j) { wq0[j] = conv_w[j * 768 + cq]; wq1[j] = conv_w[j * 768 + cq + 1]; wk0[j] = conv_w[j * 768 + ck]; wk1[j] = conv_w[j * 768 + ck + 1]; }
    bq0 = conv_b[cq]; bq1 = conv_b[cq + 1]; bk0 = conv_b[ck]; bk1 = conv_b[ck + 1]; }
    const float ib = i_b[h], fb = f_b[h];
    const float ksc = 0.10206207261596577f;
    f32x4 st[11];
#pragma unroll
    for (int i = 0; i < 11; ++i) st[i] = (f32x4){0.f, 0.f, 0.f, 0.f};
    for (int i = wave * 64 + lane; i < 112 * LPM / 2; i += 512) ((LAS unsigned*)Stt)[i] = 0u;
    for (int i = wave * 64 + lane; i < 16 * LP / 2; i += 512) ((LAS unsigned*)(Vt + 96 * LP))[i] = (i < LP / 2) ? 0x3f803f80u : 0u;
    float mprev = 0.f;
    const size_t m0 = (size_t)b * SEQ;
    const bf16* PB = proj + m0 * NPI + ML_B;
    float gain6[6];
#pragma unroll
    for (int ct = 0; ct < 6; ++ct) gain6[ct] = gn[640 + h * 96 + 16 * ct + lc];
    unsigned xq[11], xk[11], vv[8], og[8]; unsigned short gi, gf;
#define ML_LOAD(cc) do { const int tb_ = 64 * (cc) + 8 * wave; \
        _Pragma("unroll") for (int i = 0; i < 11; ++i) { const int t_ = tb_ - 3 + i; const bf16* p_ = PB + (size_t)(t_ < 0 ? 0 : t_) * NPI + cq; xq[i] = *(const unsigned*)p_; xk[i] = *(const unsigned*)(p_ + 384); } \
        _Pragma("unroll") for (int i = 0; i < 8; ++i) { const bf16* p_ = PB + (size_t)(tb_ + i) * NPI + 768 + cq; vv[i] = *(const unsigned*)p_; og[i] = *(const unsigned*)(p_ + 384); } \
        { const bf16* p_ = PB + (size_t)(64 * (cc) + lane) * NPI; gi = p_[1536 + h]; gf = p_[1540 + h]; } } while (0)
    { const int cq = h * 96 + (lane < 48 ? 2 * lane : 0); ML_LOAD(0); }
#pragma unroll 1
    for (int c = 0; c < SEQ / 64; ++c) {
        const int lane = lane_id_opq(), q4 = lane >> 4, lc = lane & 15, o72 = lc * LP + 8 * q4, o104 = lc * LPM + 8 * q4;
        const bool act = lane < 48; const int dd = act ? 2 * lane : 0, cq = h * 96 + dd;
        const int tb = 64 * c + 8 * wave;
        float pm63, carry, ev_l; const float mold = mprev;
        { const float ic = __uint_as_float((unsigned)gi << 16) + ib, lf = flogsigmoid(__uint_as_float((unsigned)gf << 16) + fb);
          const float bc = wave_prefix_sum(lf), e = ic - bc; const float pm = fmaxf(wave_prefix_max(e), mprev);
          pm63 = __builtin_bit_cast(float, __builtin_amdgcn_readlane(__builtin_bit_cast(int, pm), 63)); carry = fexp(mprev - pm63); ev_l = e;
          if (wave == 0) { ev[lane] = e; pmv[lane] = pm; flv[lane] = fexp(-(bc + pm)); }
          mprev = __builtin_bit_cast(float, __builtin_amdgcn_readlane(__builtin_bit_cast(int, bc), 63)) + pm63; }
        { unsigned short kd0[8], kd1[8];
          if (tb == 0) { xq[0] = xq[1] = xq[2] = 0u; xk[0] = xk[1] = xk[2] = 0u; }
#pragma unroll
          for (int i = 0; i < 8; ++i) { const int tt = 8 * wave + i;
#define LO_(w) __uint_as_float((w) << 16)
#define HI_(w) __uint_as_float((w) & 0xffff0000u)
              float q0 = bq0 + LO_(xq[i]) * wq0[0] + LO_(xq[i + 1]) * wq0[1] + LO_(xq[i + 2]) * wq0[2] + LO_(xq[i + 3]) * wq0[3];
              float k0 = bk0 + LO_(xk[i]) * wk0[0] + LO_(xk[i + 1]) * wk0[1] + LO_(xk[i + 2]) * wk0[2] + LO_(xk[i + 3]) * wk0[3];
              float q1 = bq1 + HI_(xq[i]) * wq1[0] + HI_(xq[i + 1]) * wq1[1] + HI_(xq[i + 2]) * wq1[2] + HI_(xq[i + 3]) * wq1[3];
              float k1 = bk1 + HI_(xk[i]) * wk1[0] + HI_(xk[i + 1]) * wk1[1] + HI_(xk[i + 2]) * wk1[2] + HI_(xk[i + 3]) * wk1[3];
#undef LO_
#undef HI_
              q0 = q0 * fsigmoid(q0); k0 = k0 * fsigmoid(k0) * ksc; q1 = q1 * fsigmoid(q1); k1 = k1 * fsigmoid(k1) * ksc;
              const float wsi = fexp(__builtin_bit_cast(float, __builtin_amdgcn_readlane(__builtin_bit_cast(int, ev_l), tt)) - pm63);
              kd0[i] = f2bf16(k0 * wsi); kd1[i] = f2bf16(k1 * wsi);
              if (act) { *(LAS unsigned*)(Qs + tt * LPM + dd) = pk2(q0, q1); *(LAS unsigned*)(Ks + tt * LPM + dd) = pk2(k0, k1); } }
          if (act) {
              v4u w; w.x = kd0[0] | ((unsigned)kd0[1] << 16); w.y = kd0[2] | ((unsigned)kd0[3] << 16); w.z = kd0[4] | ((unsigned)kd0[5] << 16); w.w = kd0[6] | ((unsigned)kd0[7] << 16);
              *(LAS v4u*)(Kdt + dd * LP + 8 * wave) = w;
              w.x = kd1[0] | ((unsigned)kd1[1] << 16); w.y = kd1[2] | ((unsigned)kd1[3] << 16); w.z = kd1[4] | ((unsigned)kd1[5] << 16); w.w = kd1[6] | ((unsigned)kd1[7] << 16);
              *(LAS v4u*)(Kdt + (dd + 1) * LP + 8 * wave) = w;
              w.x = (vv[0] & 0xffffu) | (vv[1] << 16); w.y = (vv[2] & 0xffffu) | (vv[3] << 16); w.z = (vv[4] & 0xffffu) | (vv[5] << 16); w.w = (vv[6] & 0xffffu) | (vv[7] << 16);
              *(LAS v4u*)(Vt + dd * LP + 8 * wave) = w;
              w.x = (vv[0] >> 16) | (vv[1] & 0xffff0000u); w.y = (vv[2] >> 16) | (vv[3] & 0xffff0000u); w.z = (vv[4] >> 16) | (vv[5] & 0xffff0000u); w.w = (vv[6] >> 16) | (vv[7] & 0xffff0000u);
              *(LAS v4u*)(Vt + (dd + 1) * LP + 8 * wave) = w; } }
        WG_BAR_L();
        unsigned ogc[8];
#pragma unroll
        for (int i = 0; i < 8; ++i) ogc[i] = og[i];
        if (c + 1 < SEQ / 64) ML_LOAD(c + 1);
        { const int rt = wave >> 1;
#pragma unroll
          for (int u = 0; u < 2; ++u) { const int ct = 2 * (wave & 1) + u;
              f32x4 s = (f32x4){0.f, 0.f, 0.f, 0.f};
              if (ct <= rt) s = mm_tile<3>(Qs + 16 * rt * LPM + o104, Ks + 16 * ct * LPM + o104, s);
              const float em = ev[16 * ct + lc];
#pragma unroll
              for (int r = 0; r < 4; ++r) { const int l = 16 * rt + 4 * q4 + r, m = 16 * ct + lc; const float val = (l >= m) ? s[r] * fexp(em - pmv[l]) : 0.f; Ps[l * LP + m] = f2bf16(val); } } }
        f32x4 inter[7];
        if (wave < 4) {
#pragma unroll
            for (int ct = 0; ct < 7; ++ct) inter[ct] = mm_tile<3>(Qs + 16 * wave * LPM + o104, Stt + 16 * ct * LPM + o104, (f32x4){0.f, 0.f, 0.f, 0.f}); }
#pragma unroll
        for (int i = 0; i < 8; ++i) if (act) *(LAS unsigned*)(Os + (8 * wave + i) * LPM + dd) = ogc[i];
        WG_BAR_L();
        if (wave < 4) {
            f32x4 y[7];
#pragma unroll
            for (int ct = 0; ct < 7; ++ct) y[ct] = mm_tile<2>(Ps + 16 * wave * LP + o72, Vt + 16 * ct * LP + o72, (f32x4){0.f, 0.f, 0.f, 0.f});
#pragma unroll
            for (int r = 0; r < 4; ++r) { const int l = 16 * wave + 4 * q4 + r; const float iw = fexp(mold - pmv[l]);
#pragma unroll
                for (int ct = 0; ct < 7; ++ct) y[ct][r] += iw * inter[ct][r];
                const float den = __shfl(y[6][r], lane & 48);
                const float dn = __builtin_amdgcn_rcpf(fmaxf(fabsf(den), flv[l]));
                float s = 0.f;
#pragma unroll
                for (int ct = 0; ct < 6; ++ct) { y[ct][r] *= dn; s += y[ct][r]; }
                const float mean = sum16(s) * (1.0f / 96.0f); float qv = 0.f;
#pragma unroll
                for (int ct = 0; ct < 6; ++ct) { const float dd = y[ct][r] - mean; qv += dd * dd; }
                const float rstd = __builtin_amdgcn_rsqf(sum16(qv) * (1.0f / 96.0f) + GN_EPS);
                bf16* orow = mixed + (m0 + 64 * c + l) * DM + 640 + h * 96 + lc;
#pragma unroll
                for (int ct = 0; ct < 6; ++ct) { const float o = bf2f(Os[l * LPM + 16 * ct + lc]); orow[16 * ct] = f2bf16((y[ct][r] - mean) * rstd * gain6[ct] * fsigmoid(o)); } }
        } else {
#pragma unroll
            for (int i = 0; i < 11; ++i) { const int t = (wave - 4) + 4 * i;
                if (t < 42) { const int dt = t / 7, et = t % 7;
                    st[i] = mm_tile<2>(Kdt + 16 * dt * LP + o72, Vt + 16 * et * LP + o72, st[i] * carry);
                    v2u w; w.x = pk2(st[i][0], st[i][1]); w.y = pk2(st[i][2], st[i][3]);
                    *(LAS v2u*)(Stt + (16 * et + lc) * LPM + 16 * dt + 4 * q4) = w; } }
        }
        WG_BAR_L();
    }
#undef ML_LOAD
}
#ifndef RW_DBG
#define RW_DBG 0xFF
#endif
__device__ __forceinline__ void rwkv_unit(int b, int h, const bf16* proj, const float* CUM, const bf16* AA, const bf16* GG, const float* mu, const float* k_k, const float* k_a, const float* r_k,
                                          const float* gn, bf16* mixed, LAS unsigned char* lds, int wave, int lane0,
                                          int cb, int ce, const float* hs_in, unsigned* flag_in, float* hs_out, unsigned* flag_out) {
    constexpr int SLOT = 64 * LP;
    LAS bf16* KH = (LAS bf16*)lds; LAS bf16* BH = KH + SLOT; LAS bf16* KT = BH + SLOT; LAS bf16* RT = KT + SLOT; LAS bf16* KHgt = RT + SLOT; LAS bf16* BHgtn = KHgt + SLOT;
    LAS bf16* Vt = BHgtn + SLOT; LAS bf16* AkT = Vt + SLOT; LAS bf16* BbTn = AkT + SLOT; LAS bf16* BkT = BbTn + SLOT; LAS bf16* S0b = BkT + SLOT; LAS bf16* Loffb = S0b + SLOT; LAS bf16* Vr = Loffb + SLOT; LAS bf16* Gr = Vr + SLOT;
    LAS float* RHS = (LAS float*)KH; LAS bf16* Ut = KT;
    LAS float* LTd = (LAS float*)(Gr + SLOT);
    LAS float* XS = LTd + 64 * 20;
    LAS float* GCv = XS + 16 * 64; LAS float* bonv = GCv + 64;
    LAS float* bonv2 = bonv + 64; LAS bf16* Vr2 = (LAS bf16*)(bonv2 + 64); LAS bf16* Gr2 = Vr2 + SLOT;
    float mu_r, mu_k, mu_v, kkc, kac, rkc;
    { const int c0 = h * 64 + lane0; mu_r = mu[c0]; mu_k = mu[384 + c0]; mu_v = mu[768 + c0]; kkc = k_k[c0]; kac = k_a[c0]; rkc = r_k[c0]; }
    for (int i = wave * 64 + lane0; i < 5 * SLOT / 2; i += 512) ((LAS unsigned*)AkT)[i] = 0u;
    float gain4[4];
#pragma unroll
    for (int ct = 0; ct < 4; ++ct) gain4[ct] = gn[256 + h * 64 + 16 * ct + (lane0 & 15)];
    f32x4 sacc[4];
#pragma unroll
    for (int i = 0; i < 4; ++i) sacc[i] = (f32x4){0.f, 0.f, 0.f, 0.f};
    if (hs_in) {
        if (wave == 0) { unsigned spins = 0u;
            while (__hip_atomic_load(flag_in, __ATOMIC_RELAXED, __HIP_MEMORY_SCOPE_AGENT) == 0u) { __builtin_amdgcn_s_sleep(4); if (++spins > (1u << 22)) break; }
            __builtin_amdgcn_fence(__ATOMIC_ACQUIRE, "agent"); asm volatile("s_waitcnt vmcnt(0)" ::: "memory"); }
        WG_BAR();
        if (wave < 4) {
#pragma unroll
            for (int jt = 0; jt < 4; ++jt) {
#pragma unroll
                for (int r = 0; r < 4; ++r) { sacc[jt][r] = hs_in[(wave * 4 + jt) * 256 + r * 64 + lane0];
                    S0b[(16 * wave + 4 * (lane0 >> 4) + r) * LP + 16 * jt + (lane0 & 15)] = f2bf16(sacc[jt][r]); } } }
    }
    const size_t m0 = (size_t)b * SEQ;
    const bf16* PU = proj + m0 * NPI + RW_B + h * 64;
    const float* CU = CUM + m0 * 384 + h * 64; const bf16* AU = AA + m0 * 384 + h * 64; const bf16* GU = GG + m0 * 384 + h * 64;
    unsigned short rr[9], rk[9], rv[9], ra[8], rg[8]; float rc[9], rc63;
#define RWKV_LOAD(cc) do { const int tb_ = 64 * (cc) + 8 * wave; \
        _Pragma("unroll") for (int i = 0; i < 9; ++i) { const int t_ = tb_ - 1 + i; const bool ok_ = t_ >= 0; const bf16* p_ = PU + (size_t)(ok_ ? t_ : 0) * NPI; \
            rr[i] = ok_ ? p_[lane] : (unsigned short)0; rk[i] = ok_ ? p_[384 + lane] : (unsigned short)0; rv[i] = ok_ ? p_[768 + lane] : (unsigned short)0; \
            rc[i] = (i > 0 || wave > 0) ? CU[(size_t)(ok_ ? t_ : 0) * 384 + lane] : 0.f; if (i > 0) { ra[i - 1] = AU[(size_t)t_ * 384 + lane]; rg[i - 1] = GU[(size_t)t_ * 384 + lane]; } } \
        rc63 = CU[(size_t)(64 * (cc) + 63) * 384 + lane]; } while (0)
    { const int lane = lane0; RWKV_LOAD(cb); }
    f32x4 yp[4];
#pragma unroll
    for (int i = 0; i < 4; ++i) yp[i] = (f32x4){0.f, 0.f, 0.f, 0.f};
#define RW_EPILOGUE(yy, cc, VrB, GrB, bonB, q4_, lc_) do { _Pragma("unroll") for (int r = 0; r < 4; ++r) { const int t = 16 * (wave - 4) + 4 * (q4_) + r; const size_t row = m0 + 64 * (cc) + t; \
            float s_ = 0.f; _Pragma("unroll") for (int ct = 0; ct < 4; ++ct) s_ += yy[ct][r]; \
            const float mean = sum16(s_) * (1.0f / 64.0f); float qv = 0.f; \
            _Pragma("unroll") for (int ct = 0; ct < 4; ++ct) { const float dd = yy[ct][r] - mean; qv += dd * dd; } \
            const float rstd = __builtin_amdgcn_rsqf(sum16(qv) * (1.0f / 64.0f) + GN_EPS); \
            const float bon = (bonB)[t]; bf16* orow = mixed + row * DM + 256 + h * 64 + (lc_); \
            _Pragma("unroll") for (int ct = 0; ct < 4; ++ct) orow[16 * ct] = f2bf16(((yy[ct][r] - mean) * rstd * gain4[ct] + bon * bf2f((VrB)[t * LP + 16 * ct + (lc_)])) * bf2f((GrB)[t * LP + 16 * ct + (lc_)])); } } while (0)
#pragma unroll 1
    for (int c = cb; c < ce; ++c) {
        const int lane = lane_id_opq(), q4 = lane >> 4, lc = lane & 15, o72 = lc * LP + 8 * q4;
        LAS bf16* VrC = (c & 1) ? Vr2 : Vr; LAS bf16* GrC = (c & 1) ? Gr2 : Gr; LAS float* bonC = (c & 1) ? bonv2 : bonv;
        LAS bf16* VrP = (c & 1) ? Vr : Vr2; LAS bf16* GrP = (c & 1) ? Gr : Gr2; LAS float* bonP = (c & 1) ? bonv : bonv2;
        if (RW_DBG & 1) { unsigned short khg[8], bhg[8]; const float gc63 = fexp(rc63); float ecp = fexp(rc[0]);
#pragma unroll
          for (int i = 0; i < 8; ++i) { const int tt = 8 * wave + i;
              const float cr = bf2f(rr[i + 1]), ck = bf2f(rk[i + 1]);
              const float r = cr + (bf2f(rr[i]) - cr) * mu_r, k = ck + (bf2f(rk[i]) - ck) * mu_k, a = bf2f(ra[i]);
              float kk = k * kkc; kk = kk * __builtin_amdgcn_rsqf(fmaxf(wave_sum(kk * kk), 1e-24f));
              const float kmod = k * (1.0f + (a - 1.0f) * kac), beta = kk * a;
              const float bon = wave_sum(r * kmod * rkc); if (lane == 0) bonC[tt] = bon;
              const float cm = rc[i + 1], cp = rc[i];
              const float em = fexp(-cm), eg = gc63 * em, ec = __builtin_amdgcn_rcpf(em);
              KH[tt * LP + lane] = f2bf16(kmod * em); BH[tt * LP + lane] = f2bf16(beta * em); KT[tt * LP + lane] = f2bf16(kk * ecp); RT[tt * LP + lane] = f2bf16(r * ec); ecp = ec;
              khg[i] = f2bf16(kmod * eg); bhg[i] = f2bf16(-beta * eg); }
          v4u w; w.x = khg[0] | ((unsigned)khg[1] << 16); w.y = khg[2] | ((unsigned)khg[3] << 16); w.z = khg[4] | ((unsigned)khg[5] << 16); w.w = khg[6] | ((unsigned)khg[7] << 16);
          *(LAS v4u*)(KHgt + lane * LP + 8 * wave) = w;
          w.x = bhg[0] | ((unsigned)bhg[1] << 16); w.y = bhg[2] | ((unsigned)bhg[3] << 16); w.z = bhg[4] | ((unsigned)bhg[5] << 16); w.w = bhg[6] | ((unsigned)bhg[7] << 16);
          *(LAS v4u*)(BHgtn + lane * LP + 8 * wave) = w;
          unsigned short vs[8];
#pragma unroll
          for (int i = 0; i < 8; ++i) { const float cv = bf2f(rv[i + 1]); vs[i] = f2bf16(cv + (bf2f(rv[i]) - cv) * mu_v); VrC[(8 * wave + i) * LP + lane] = vs[i]; GrC[(8 * wave + i) * LP + lane] = rg[i]; }
          w.x = vs[0] | ((unsigned)vs[1] << 16); w.y = vs[2] | ((unsigned)vs[3] << 16); w.z = vs[4] | ((unsigned)vs[5] << 16); w.w = vs[6] | ((unsigned)vs[7] << 16);
          *(LAS v4u*)(Vt + lane * LP + 8 * wave) = w;
          if (wave == 0) GCv[lane] = gc63; }
        WG_BAR_L();
#pragma unroll
        for (int u2 = 0; u2 < 2; ++u2) { const int idx = 2 * wave + u2, rt = idx >> 2, ct = idx & 3;
            if (ct <= rt) {
                const int s = 16 * ct + lc; const LAS bf16* kt = KT + 16 * rt * LP + o72; const LAS bf16* rtp = RT + 16 * rt * LP + o72; const LAS bf16* bh = BH + 16 * ct * LP + o72; const LAS bf16* kh = KH + 16 * ct * LP + o72;
                const f32x4 z = (f32x4){0.f, 0.f, 0.f, 0.f};
                const f32x4 g0 = mm_tile<2>(kt, bh, z), g1 = mm_tile<2>(kt, kh, z), g2 = mm_tile<2>(rtp, bh, z), g3 = mm_tile<2>(rtp, kh, z);
#pragma unroll
                for (int r = 0; r < 4; ++r) { const int t = 16 * rt + 4 * q4 + r;
                    if (ct < rt) Loffb[t * LP + s] = f2bf16(g0[r]); else LTd[s * 20 + (t - 16 * rt)] = (s < t) ? g0[r] : 0.f;
                    AkT[t * LP + s] = f2bf16((s < t) ? g1[r] : 0.f);
                    BbTn[t * LP + s] = f2bf16((s <= t) ? -g2[r] : 0.f);
                    BkT[t * LP + s] = f2bf16((s <= t) ? g3[r] : 0.f); } } }
        WG_BAR_L();
#pragma unroll
        for (int u = 0; u < ((RW_DBG & 4) ? 2 : 0); ++u) { const int rt = wave >> 1, ct = 2 * (wave & 1) + u;
            f32x4 g = mm_tile<2>(KT + 16 * rt * LP + o72, S0b + 16 * ct * LP + o72, (f32x4){0.f, 0.f, 0.f, 0.f});
            g = mm_tile<2>(AkT + 16 * rt * LP + o72, Vt + 16 * ct * LP + o72, g);
#pragma unroll
            for (int r = 0; r < 4; ++r) RHS[(16 * rt + 4 * q4 + r) * 64 + 16 * ct + lc] = g[r]; }
        WG_BAR_L();
        f32x4 y[4];
        if ((RW_DBG & 8) && wave == 0) {
            __builtin_amdgcn_s_setprio(3);
#pragma unroll
            for (int a = 0; a < 4; ++a) {
                if (a > 0) {
#pragma unroll
                    for (int it = 0; it < 4; ++it) { f32x4 cr = (f32x4){0.f, 0.f, 0.f, 0.f};
                        if (a == 3) cr = mm_tile<2>(Loffb + 16 * a * LP + o72, Ut + 16 * it * LP + o72, cr); else cr = mm_tile<1>(Loffb + 16 * a * LP + o72, Ut + 16 * it * LP + o72, cr);
#pragma unroll
                        for (int r = 0; r < 4; ++r) XS[(4 * q4 + r) * 64 + 16 * it + lc] = cr[r]; }
                    asm volatile("s_waitcnt lgkmcnt(0)" ::: "memory");
                }
                float acc[16];
#pragma unroll
                for (int t = 0; t < 16; ++t) acc[t] = RHS[(16 * a + t) * 64 + lane] - (a > 0 ? XS[t * 64 + lane] : 0.f);
                const LAS float* Ld = LTd + 16 * a * 20; asm volatile("" : "+v"(Ld));
#pragma unroll
                for (int s2 = 0; s2 < 15; ++s2) { const float us = acc[s2];
#pragma unroll
                    for (int t4 = (s2 + 1) / 4; t4 < 4; ++t4) { const f32x4 l4 = *(const LAS f32x4*)(Ld + s2 * 20 + 4 * t4);
                        acc[4 * t4] -= l4.x * us; acc[4 * t4 + 1] -= l4.y * us; acc[4 * t4 + 2] -= l4.z * us; acc[4 * t4 + 3] -= l4.w * us; }
                    if (s2 == 5) asm volatile("" : "+v"(Ld) : "v"(acc[s2 + 1])); }
                v4u w; w.x = pk2(acc[0], acc[1]); w.y = pk2(acc[2], acc[3]); w.z = pk2(acc[4], acc[5]); w.w = pk2(acc[6], acc[7]);
                *(LAS v4u*)(Ut + lane * LP + 16 * a) = w;
                w.x = pk2(acc[8], acc[9]); w.y = pk2(acc[10], acc[11]); w.z = pk2(acc[12], acc[13]); w.w = pk2(acc[14], acc[15]);
                *(LAS v4u*)(Ut + lane * LP + 16 * a + 8) = w;
                asm volatile("s_waitcnt lgkmcnt(0)" ::: "memory");
            }
            __builtin_amdgcn_s_setprio(0);
        }
        if (c + 1 < ce) RWKV_LOAD(c + 1);
        if (wave >= 4) {
#pragma unroll
            for (int ct = 0; ct < 4; ++ct) { y[ct] = mm_tile<2>(RT + 16 * (wave - 4) * LP + o72, S0b + 16 * ct * LP + o72, (f32x4){0.f, 0.f, 0.f, 0.f}); y[ct] = mm_tile<2>(BkT + 16 * (wave - 4) * LP + o72, Vt + 16 * ct * LP + o72, y[ct]); }
            if (c > cb) RW_EPILOGUE(yp, c - 1, VrP, GrP, bonP, q4, lc);
        } else {
#pragma unroll
            for (int jt = 0; jt < 4; ++jt) { const float gc = GCv[16 * jt + lc]; sacc[jt] = mm_tile<2>(Vt + 16 * wave * LP + o72, KHgt + 16 * jt * LP + o72, sacc[jt] * gc); }
        }
        WG_BAR_L();
        if (wave >= 4) {
#pragma unroll
            for (int ct = 0; ct < 4; ++ct) y[ct] = mm_tile<2>(BbTn + 16 * (wave - 4) * LP + o72, Ut + 16 * ct * LP + o72, y[ct]);
#pragma unroll
            for (int ct = 0; ct < 4; ++ct) yp[ct] = y[ct];
        } else {
#pragma unroll
            for (int jt = 0; jt < 4; ++jt) { sacc[jt] = mm_tile<2>(Ut + 16 * wave * LP + o72, BHgtn + 16 * jt * LP + o72, sacc[jt]);
#pragma unroll
                for (int r = 0; r < 4; ++r) S0b[(16 * wave + 4 * q4 + r) * LP + 16 * jt + lc] = f2bf16(sacc[jt][r]); }
        }
        WG_BAR_L();
    }
    if (wave >= 4 && ce > cb) { const int q4 = lane0 >> 4, lc = lane0 & 15; const int cl = ce - 1;
        if (cl & 1) RW_EPILOGUE(yp, cl, Vr2, Gr2, bonv2, q4, lc); else RW_EPILOGUE(yp, cl, Vr, Gr, bonv, q4, lc); }
#undef RW_EPILOGUE
    if (!hs_out) WG_BAR_L();
    if (hs_out) {
        if (wave < 4) {
#pragma unroll
            for (int jt = 0; jt < 4; ++jt)
#pragma unroll
                for (int r = 0; r < 4; ++r) __hip_atomic_store(hs_out + (wave * 4 + jt) * 256 + r * 64 + lane0, sacc[jt][r], __ATOMIC_RELAXED, __HIP_MEMORY_SCOPE_AGENT);
        }
        WG_BAR();
        if (wave == 0 && lane0 == 0) __hip_atomic_store(flag_out, 1u, __ATOMIC_RELAXED, __HIP_MEMORY_SCOPE_AGENT);
    }
#undef RWKV_LOAD
}

struct Args { const float* in[25]; float* out; unsigned char* ws; int ph_lo, ph_hi, li, pad; };
typedef const __attribute__((address_space(4))) Args* KArgs;
__device__ __forceinline__ KArgs kargs() { KArgs p = (KArgs)__builtin_amdgcn_kernarg_segment_ptr(); asm volatile("" : "+s"(p)); return p; }
#ifndef DBG_MASK
#define DBG_MASK 0xFFFF
#endif
#define EN(bit) ((DBG_MASK >> (bit)) & 1)
#ifndef PROBE_SKEW_MODE
#define PROBE_SKEW_MODE 0
#endif
#ifndef PROBE_SKEW
#define PROBE_SKEW 0
#endif
#define SKEW_STAMP(which) do { if (PROBE_SKEW == (which) && l == 2 && wave_o == 0 && lane_id_opq() == 0) { volatile unsigned long long* pp_ = (volatile unsigned long long*)(ws + WS_CTL) + 130000 + blockIdx.x; pp_[0] = __builtin_amdgcn_s_memrealtime(); } } while (0)
#ifndef PROBE_CLK
#define PROBE_CLK 0
#endif
#ifndef PROBE_DUP
#define PROBE_DUP 0
#endif
#define REP(bit) for (int rep_ = 0; rep_ < (((PROBE_DUP >> (bit)) & 1) ? 2 : 1); ++rep_)
__global__ void __launch_bounds__(NWAVES * 64, 2) mk_fwd(Args args_unused) {
    extern __shared__ __attribute__((aligned(16))) unsigned char lds_raw[];
    LAS unsigned char* lds = (LAS unsigned char*)lds_raw;
    volatile LAS unsigned* MISC = (volatile LAS unsigned*)(lds + MISC_OFF);
    const int wave = __builtin_amdgcn_readfirstlane((int)threadIdx.x >> 6);
    const int G = gridDim.x, gw = blockIdx.x * NWAVES + wave, ngw = G * NWAVES;
    for (int u = threadIdx.x; u < (LDS_BYTES - LDSCTL_OFF) / 4; u += NWAVES * 64) ((LAS unsigned*)(lds + LDSCTL_OFF))[u] = 0u;
    __syncthreads();
    XcdBarrier bar; int lo, hi;
    { KArgs A = kargs(); bar = xcd_barrier_post((unsigned*)(A->ws + WS_CTL) + CW_BAR + (MK_PER_PHASE ? 0 : A->li) * XCD_BAR_WORDS, MISC + 8); lo = A->ph_lo; hi = A->ph_hi; }
#define IN(k) (lo <= (k) && (k) < hi)
#if PROBE_BAR
#define SEAM(k) do { if (IN(k) && IN((k) + 1)) { xcd_barrier(bar); xcd_barrier(bar); xcd_barrier(bar); } } while (0)
#else
#define SEAM(k) do { if (IN(k) && IN((k) + 1)) xcd_barrier(bar); } while (0)
#endif
#define LANE_TID() int wave_o = wave, gw_o = gw; asm volatile("" : "+s"(wave_o), "+s"(gw_o)); (void)gw_o; const int lane_o = lane_id_opq(), tid_o = wave_o * 64 + lane_o; (void)tid_o

    REP(5) if (EN(0) && IN(0)) {
        KArgs A = kargs(); unsigned char* ws = A->ws; LANE_TID();
        p0_mod(A->in[1], A->in[2], A->in[3], (float*)(ws + WS_MOD), lds, tid_o, lane_o, wave_o);
        p0_weights(A->in[6], A->in[21], A->in[22], A->in[23], A->in[10], A->in[12], A->in[13], ws, lds, gw_o, ngw, wave_o, lane_o);
    }
    SEAM(0);
    if (EN(1) && IN(1)) { KArgs A = kargs(); unsigned char* ws = A->ws; LANE_TID();
        norm_mod_phase(A->in[0], A->in[4], (const float*)(ws + WS_MOD), 0, DM, (bf16*)(ws + WS_H), gw_o, ngw, lane_o); }
    SEAM(1);
#pragma unroll 1
    for (int l = 0; l < NL; ++l) {
        const int pb = 2 + 6 * l;
        REP(3) if (EN(2) && IN(pb + 0)) { KArgs A = kargs(); unsigned char* ws = A->ws; LANE_TID();
            pg8::Gemm g{(const bf16*)(ws + WS_H), (const bf16*)(ws + WS_WIN) + (size_t)l * NPI * DM, MT, NPI, DM}; pg8::StaticOrder S; S.init(MT, NPI, G, (int)blockIdx.x);
            pg8::EpiBf16Plain E{(bf16*)(ws + WS_PROJ), NPI};
#if PROBE_CLK
            unsigned long long pc0 = 0, pr0 = 0; if (blockIdx.x == 0 && l == 2) { pc0 = __builtin_readcyclecounter(); pr0 = __builtin_amdgcn_s_memrealtime(); }
#endif
            pg8::gemm_phase<pg8::EpiBf16Plain, pg8::StaticOrder, true, true>(lds, g, S, E, wave_o);
            SKEW_STAMP(1);
#if PROBE_CLK
            if (blockIdx.x == 0 && l == 2 && wave_o == 0 && lane_id_opq() == 0) { const unsigned long long dc = __builtin_readcyclecounter() - pc0, dr = __builtin_amdgcn_s_memrealtime() - pr0;
                volatile unsigned long long* pp = (volatile unsigned long long*)(ws + WS_CTL) + 131000; pp[0] = dc; pp[1] = dr; }
#endif
        }
        SEAM(pb + 0);
        REP(1) if (EN(3) && IN(pb + 1)) { KArgs A = kargs(); unsigned char* ws = A->ws; LANE_TID();
            rwkv_prep_mfma((const bf16*)(ws + WS_PROJ), A->in[8] + l * RWKV_IN, A->in[9] + l * 384, A->in[11] + l * 384, (const bf16*)(ws + WS_WL) + (size_t)l * 384 * 256,
                           (float*)(ws + WS_DEC), (bf16*)(ws + WS_AA), (bf16*)(ws + WS_GG), lds, wave_o); SKEW_STAMP(6); }
        SEAM(pb + 1);
        REP(0) if (EN(4) && IN(pb + 2)) { KArgs A = kargs(); unsigned char* ws = A->ws; LANE_TID();
            const float* gn = A->in[7] + l * DM; const bf16* PROJ = (const bf16*)(ws + WS_PROJ); bf16* Hb = (bf16*)(ws + WS_H);
#if PROBE_SKEW == 10
            if (l == 2 && wave_o == 0 && lane_id_opq() == 0) { volatile unsigned long long* pp_ = (volatile unsigned long long*)(ws + WS_CTL) + 130000 + 2 * blockIdx.x; pp_[0] = __builtin_amdgcn_s_memrealtime(); }
#endif
            int u = (int)blockIdx.x; asm volatile("" : "+s"(u));
            float* HS = (float*)(ws + WS_HS) + (size_t)l * 192 * 4096; unsigned* FL = (unsigned*)(ws + WS_CTL) + CW_FLAG + l * 192 * 16;
            const float* DECp = (const float*)(ws + WS_DEC); const bf16* AAp = (const bf16*)(ws + WS_AA); const bf16* GGp = (const bf16*)(ws + WS_GG);
#define RWKV_PIECE(q, cb, ce, hin, hout) rwkv_unit((q) / 6, (q) % 6, PROJ, DECp, AAp, GGp, A->in[8] + l * RWKV_IN, A->in[14] + l * 384, A->in[15] + l * 384, A->in[16] + l * 384, gn, Hb, lds, wave_o, lane_o, cb, ce, \
                (hin) >= 0 ? HS + (size_t)(hin) * 4096 : nullptr, (hin) >= 0 ? FL + (hin) * 16 : nullptr, (hout) >= 0 ? HS + (size_t)(hout) * 4096 : nullptr, (hout) >= 0 ? FL + (hout) * 16 : nullptr)
            if (u < 64 || u >= 128) {
#if PROBE_SKEW == 9
                if (l == 2 && wave_o == 0 && lane_id_opq() == 0) { volatile unsigned long long* pp_ = (volatile unsigned long long*)(ws + WS_CTL) + 130000 + 3 * blockIdx.x; pp_[0] = __builtin_amdgcn_s_memrealtime(); }
#endif
                const int q = u < 64 ? u : u < 192 ? u - 64 : u - 64, ce = u < 64 ? SPLIT_H : u < 192 ? SPLIT_X : SPLIT_Y;
                RWKV_PIECE(q, 0, ce, -1, q);
#if PROBE_SKEW == 9
                if (l == 2 && wave_o == 0 && lane_id_opq() == 0) { volatile unsigned long long* pp_ = (volatile unsigned long long*)(ws + WS_CTL) + 130000 + 3 * blockIdx.x; pp_[1] = __builtin_amdgcn_s_memrealtime(); }
#endif
                }
            if (u < 128) {
#if PROBE_SKEW == 7 || PROBE_SKEW == 8
                if (l == 2 && wave_o == 0 && lane_id_opq() == 0) { volatile unsigned long long* pp_ = (volatile unsigned long long*)(ws + WS_CTL) + 130000 + 3 * blockIdx.x; pp_[0] = __builtin_amdgcn_s_memrealtime(); }
#endif
                mlstm_unit(u >> 2, u & 3, PROJ, A->in[17] + (size_t)l * 4 * 768, A->in[18] + l * 768, A->in[19] + l * 4, A->in[20] + l * 4, gn, Hb, lds, wave_o, lane_o);
#if PROBE_SKEW == 7 || PROBE_SKEW == 8
                if (l == 2 && wave_o == 0 && lane_id_opq() == 0) { volatile unsigned long long* pp_ = (volatile unsigned long long*)(ws + WS_CTL) + 130000 + 3 * blockIdx.x; pp_[1] = __builtin_amdgcn_s_memrealtime(); }
#endif
                ret_unit(u >> 2, u & 3, PROJ, gn, Hb, lds, wave_o, lane_o);
#if PROBE_SKEW == 7 || PROBE_SKEW == 8
                if (l == 2 && wave_o == 0 && lane_id_opq() == 0) { volatile unsigned long long* pp_ = (volatile unsigned long long*)(ws + WS_CTL) + 130000 + 3 * blockIdx.x; pp_[2] = __builtin_amdgcn_s_memrealtime(); }
#endif
                }
            if (u >= 64) {
                const int q = u < 128 ? u : u < 192 ? u : u - 192, cb = u < 128 ? SPLIT_X : u < 192 ? SPLIT_Y : SPLIT_H;
                RWKV_PIECE(q, cb, 32, q, -1); }
#undef RWKV_PIECE
#ifndef PROBE_UNIT
#define PROBE_UNIT 0
#endif
            if (PROBE_UNIT == 1 && u < 192) rwkv_unit(u / 6, u % 6, PROJ, DECp, AAp, GGp, A->in[8] + l * RWKV_IN, A->in[14] + l * 384, A->in[15] + l * 384, A->in[16] + l * 384, gn, Hb, lds, wave_o, lane_o, 0, 32, nullptr, nullptr, nullptr, nullptr);
            if (PROBE_UNIT == 2 && u < 128) mlstm_unit(u >> 2, u & 3, PROJ, A->in[17] + (size_t)l * 4 * 768, A->in[18] + l * 768, A->in[19] + l * 4, A->in[20] + l * 4, gn, Hb, lds, wave_o, lane_o);
            if (PROBE_UNIT == 3 && u < 128) ret_unit(u >> 2, u & 3, PROJ, gn, Hb, lds, wave_o, lane_o);
            SKEW_STAMP(2);
#if PROBE_SKEW == 10
            if (l == 2 && wave_o == 0 && lane_id_opq() == 0) { volatile unsigned long long* pp_ = (volatile unsigned long long*)(ws + WS_CTL) + 130000 + 2 * blockIdx.x; pp_[1] = __builtin_amdgcn_s_memrealtime(); }
#endif
        }
        SEAM(pb + 2);
        if (EN(6) && IN(pb + 3)) { KArgs A = kargs(); unsigned char* ws = A->ws; LANE_TID();
            pg8::Gemm g{(const bf16*)(ws + WS_H), (const bf16*)(ws + WS_WOUT) + (size_t)l * DM * DM, MT, DM, DM}; pg8::StaticOrder S; S.init(MT, DM, G, (int)blockIdx.x);
            const float* modl = (const float*)(ws + WS_MOD) + (size_t)l * NB * MODP;
#if PROBE_RG
            { pg8::EpiResGate<false> E2{(const float*)nullptr, (const bf16*)A->out, (bf16*)(ws + WS_XFIN), DM, modl + 2 * DM, MODP}; pg8::gemm_phase<pg8::EpiResGate<false>, pg8::StaticOrder, true, true>(lds, g, S, E2, wave_o); }
#endif
            if (l == 0) { pg8::EpiResGate<true> E{A->in[0], (const bf16*)nullptr, (bf16*)A->out, DM, modl + 2 * DM, MODP}; pg8::gemm_phase<pg8::EpiResGate<true>, pg8::StaticOrder, true, true>(lds, g, S, E, wave_o); }
            else { pg8::EpiResGate<false> E{(const float*)nullptr, (const bf16*)A->out, (bf16*)A->out, DM, modl + 2 * DM, MODP}; pg8::gemm_phase<pg8::EpiResGate<false>, pg8::StaticOrder, true, true>(lds, g, S, E, wave_o); }
            fused_panel_norm(S, (unsigned*)(ws + WS_CTL) + CW_PCNT + (2 * l) * PCNT_BANK, (const bf16*)A->out, A->in[5] + l * DM, modl, 3 * DM, 4 * DM, (bf16*)(ws + WS_H), wave_o, lane_o);
            SKEW_STAMP(5);
        }
        SEAM(pb + 3);
        REP(4) if (EN(7) && IN(pb + 4)) { KArgs A = kargs(); unsigned char* ws = A->ws; LANE_TID();
            pg8::Gemm g{(const bf16*)(ws + WS_H), (const bf16*)(ws + WS_WF1) + (size_t)l * NF1 * DM, MT, NF1, DM}; pg8::StaticOrder S; S.init(MT, NF1, G, (int)blockIdx.x);
            pg8::EpiSwiGLU E{(bf16*)(ws + WS_PROJ), DFF};
            pg8::gemm_phase<pg8::EpiSwiGLU, pg8::StaticOrder, true, true>(lds, g, S, E, wave_o);
            SKEW_STAMP(3);
        }
        SEAM(pb + 4);
        if (EN(8) && IN(pb + 5)) { KArgs A = kargs(); unsigned char* ws = A->ws; LANE_TID();
            pg8::Gemm g{(const bf16*)(ws + WS_PROJ), (const bf16*)(ws + WS_WF2) + (size_t)l * DM * DFF, MT, DM, DFF}; pg8::StaticOrder S; S.init(MT, DM, G, (int)blockIdx.x);
#if PROBE_RG
            { pg8::EpiResGate<false> E2{(const float*)nullptr, (const bf16*)A->out, (bf16*)(ws + WS_XFIN), DM, (const float*)(ws + WS_MOD) + (size_t)l * NB * MODP + 5 * DM, MODP}; pg8::gemm_phase<pg8::EpiResGate<false>, pg8::StaticOrder, true, true>(lds, g, S, E2, wave_o); }
#endif
            pg8::EpiResGate<false> E{(const float*)nullptr, (const bf16*)A->out, l + 1 < NL ? (bf16*)A->out : (bf16*)(ws + WS_XFIN), DM, (const float*)(ws + WS_MOD) + (size_t)l * NB * MODP + 5 * DM, MODP};
            pg8::gemm_phase<pg8::EpiResGate<false>, pg8::StaticOrder, true, true>(lds, g, S, E, wave_o);
            if (l + 1 < NL) fused_panel_norm(S, (unsigned*)(ws + WS_CTL) + CW_PCNT + (2 * l + 1) * PCNT_BANK, (const bf16*)A->out, A->in[4] + (l + 1) * DM, (const float*)(ws + WS_MOD) + (size_t)(l + 1) * NB * MODP, 0, DM, (bf16*)(ws + WS_H), wave_o, lane_o);
            SKEW_STAMP(4);
        }
        SEAM(pb + 5);
    }
    if (EN(9) && IN(N_PHASES - 1)) { KArgs A = kargs(); int gw_o = gw; asm volatile("" : "+s"(gw_o)); final_norm_phase((const bf16*)(A->ws + WS_XFIN), A->out, A->in[24], gw_o, ngw, lane_id_opq()); }
#if PROBE_SKEW == 10
    if (blockIdx.x == 0 && wave == 0 && lane_id_opq() == 0) { KArgs A = kargs(); volatile unsigned long long* pp = (volatile unsigned long long*)(A->ws + WS_CTL) + 130000;
        unsigned long long mn = ~0ull, mx = 0ull;
        for (int i = 0; i < 256; ++i) { const unsigned long long a_ = pp[2 * i], b_ = pp[2 * i + 1]; mn = a_ < mn ? a_ : mn; mx = b_ > mx ? b_ : mx; }
        unsigned long long us = (mx - mn) / 10ull; if (us > 30000ull) us = 30000ull;
        const unsigned long long t0 = __builtin_amdgcn_s_memrealtime();
        while (__builtin_amdgcn_s_memrealtime() - t0 < us * 100ull) __builtin_amdgcn_s_sleep(32); }
#elif PROBE_SKEW == 9
    if (blockIdx.x == 0 && wave == 0 && lane_id_opq() == 0) { KArgs A = kargs(); volatile unsigned long long* pp = (volatile unsigned long long*)(A->ws + WS_CTL) + 130000;
        unsigned long long s = 0ull;
        for (int i = 128; i < 192; ++i) s += pp[3 * i + 1] - pp[3 * i];
        unsigned long long us = s >> 6; if (us > 60000ull) us = 60000ull;
        const unsigned long long t0 = __builtin_amdgcn_s_memrealtime();
        while (__builtin_amdgcn_s_memrealtime() - t0 < us * 100ull) __builtin_amdgcn_s_sleep(32); }
#endif
#if PROBE_SKEW == 7 || PROBE_SKEW == 8
    if (blockIdx.x == 0 && wave == 0 && lane_id_opq() == 0) { KArgs A = kargs(); volatile unsigned long long* pp = (volatile unsigned long long*)(A->ws + WS_CTL) + 130000;
        unsigned long long s = 0ull;
        for (int i = 0; i < 128; ++i) s += PROBE_SKEW == 7 ? pp[3 * i + 1] - pp[3 * i] : pp[3 * i + 2] - pp[3 * i + 1];
        unsigned long long us = s >> 7; if (us > 60000ull) us = 60000ull;
        const unsigned long long t0 = __builtin_amdgcn_s_memrealtime();
        while (__builtin_amdgcn_s_memrealtime() - t0 < us * 100ull) __builtin_amdgcn_s_sleep(32); }
#elif PROBE_SKEW && PROBE_SKEW < 9
    if (blockIdx.x == 0 && wave == 0 && lane_id_opq() == 0) { KArgs A = kargs(); volatile unsigned long long* pp = (volatile unsigned long long*)(A->ws + WS_CTL) + 130000;
        unsigned long long mx = 0ull, sum = 0ull, mn = ~0ull;
        for (int i = 0; i < 256; ++i) { const unsigned long long t = pp[i]; mx = t > mx ? t : mx; mn = t < mn ? t : mn; sum += t - pp[0] + (1ull << 40); }
        const unsigned long long mean = pp[0] + (sum >> 8) - (1ull << 40);
        unsigned long long us = PROBE_SKEW_MODE == 1 ? (mx - mn) : (mx - mean);
        if (PROBE_SKEW_MODE >= 2) { const int lo = 64 * (PROBE_SKEW_MODE - 2), hi = lo + 64; unsigned long long s2 = 0ull;
            for (int i = lo; i < hi; ++i) s2 += mx - pp[i];
            us = s2 / (unsigned long long)(hi - lo); }
        if (us > 30000ull) us = 30000ull;
        const unsigned long long t0 = __builtin_amdgcn_s_memrealtime();
        while (__builtin_amdgcn_s_memrealtime() - t0 < us * 100ull) __builtin_amdgcn_s_sleep(32); }
#endif
#if PROBE_KL_SOLO
    if (blockIdx.x == 0) { xcd_barrier(bar); }
    else { xcd_barrier(bar); }
    if (blockIdx.x == 0) { KArgs A = kargs(); unsigned char* ws = A->ws; LANE_TID();
        { const unsigned long long t0_ = __builtin_amdgcn_s_memrealtime(); while (__builtin_amdgcn_s_memrealtime() - t0_ < 100000ull) __builtin_amdgcn_s_sleep(64); }
        pg8::Gemm g{(const bf16*)(ws + WS_H), (const bf16*)(ws + WS_WIN), MT, NPI, DM}; pg8::StaticOrder S; S.init(MT, NPI, G, 0);
        pg8::EpiBf16Plain E{(bf16*)(ws + WS_PROJ), NPI};
        pg8::gemm_phase<pg8::EpiBf16Plain, pg8::StaticOrder, true, true>(lds, g, S, E, wave_o); }
#endif
#if PROBE_KL
    if (blockIdx.x == 0 && wave == 0 && lane_id_opq() == 0) { unsigned long long us = PROBE_KL == 1 ? probe_kl[0] / 16ull : probe_kl[1] / 4ull; if (us > 30000ull) us = 30000ull;
        const unsigned long long t0 = __builtin_amdgcn_s_memrealtime();
        while (__builtin_amdgcn_s_memrealtime() - t0 < us * 100ull) __builtin_amdgcn_s_sleep(32); }
#endif
#if PROBE_CLK
    if (blockIdx.x == 0 && wave == 0 && lane_id_opq() == 0) { KArgs A = kargs(); volatile unsigned long long* pp = (volatile unsigned long long*)(A->ws + WS_CTL) + 131000; const unsigned long long dc = pp[0], dr = pp[1];
#if PROBE_CLK == 1
        unsigned long long us = dr ? dc * 100ull / dr : 0ull;
#else
        unsigned long long us = dr / 100ull * 10ull;
#endif
        if (us > 20000ull) us = 20000ull;
        const unsigned long long t0 = __builtin_amdgcn_s_memrealtime();
        while (__builtin_amdgcn_s_memrealtime() - t0 < us * 100ull) __builtin_amdgcn_s_sleep(32); }
#endif
#undef IN
#undef SEAM
}

extern "C" void kernel_launch(void* const* d_in, const int* in_sizes, int n_in, void* d_out, int out_size, void* d_ws, size_t ws_size, hipStream_t stream) {
    static int grid = 0;
    if (grid == 0) {
        if (n_in != 25 || in_sizes[0] != MT * DM || out_size != MT * DM || ws_size < WS_END) { fprintf(stderr, "kernel_launch: shape/workspace mismatch (n_in %d, in0 %d, out %d, ws %zu)\n", n_in, n_in > 0 ? in_sizes[0] : -1, out_size, ws_size); grid = -1; return; }
        int dev = 0, cus = 0, per_cu = 0;
        if (hipGetDevice(&dev) != hipSuccess || hipDeviceGetAttribute(&cus, hipDeviceAttributeMultiprocessorCount, dev) != hipSuccess) { grid = -1; return; }
        if (hipFuncSetAttribute((const void*)mk_fwd, hipFuncAttributeMaxDynamicSharedMemorySize, LDS_BYTES) != hipSuccess) { fprintf(stderr, "kernel_launch: hipFuncSetAttribute failed\n"); grid = -1; return; }
        if (hipOccupancyMaxActiveBlocksPerMultiprocessor(&per_cu, (const void*)mk_fwd, NWAVES * 64, LDS_BYTES) != hipSuccess || per_cu < 1) { fprintf(stderr, "kernel_launch: occupancy query says %d\n", per_cu); }
        (void)hipGetLastError();
        grid = cus;
    }
    if (grid < 0) return;
    if (hipMemsetAsync((char*)d_ws + WS_CTL, 0, CTL_ZERO_BYTES, stream) != hipSuccess) return;
    Args a{};
    for (int i = 0; i < 25; ++i) a.in[i] = (const float*)d_in[i];
    a.out = (float*)d_out; a.ws = (unsigned char*)d_ws;
#if MK_PER_PHASE
    for (int p = 0; p < N_PHASES; ++p) { a.ph_lo = p; a.ph_hi = p + 1; a.li = 0; hipLaunchKernelGGL(mk_fwd, dim3(grid), dim3(NWAVES * 64), LDS_BYTES, stream, a); }
#else
    a.ph_lo = 0; a.ph_hi = N_PHASES; a.li = 0;
    hipLaunchKernelGGL(mk_fwd, dim3(grid), dim3(NWAVES * 64), LDS_BYTES, stream, a);
#endif
}
```

```cpp
#include <hip/hip_runtime.h>
#include <cstdio>
#include <cstdint>
#ifndef PROBE_PN
#define PROBE_PN 0
#endif
#ifndef PROBE_RG
#define PROBE_RG 0
#endif
#ifndef PROBE_BAR
#define PROBE_BAR 0
#endif
#ifndef PROBE_SOLVE
#define PROBE_SOLVE 0
#endif
#ifndef PROBE_KL
#define PROBE_KL 0
#endif
#ifndef PROBE_KL_SOLO
#define PROBE_KL_SOLO 0
#endif
#ifndef PROBE_KL_FIRST
#define PROBE_KL_FIRST 0
#endif
#if PROBE_KL
__device__ unsigned long long probe_kl[2];
#endif
#ifndef PROBE_RWS
#define PROBE_RWS 0
#endif
#if PROBE_RWS
__device__ unsigned long long probe_rw[8];
#endif
#ifndef PROBE_EPI2
#define PROBE_EPI2 0
#endif
__device__ __forceinline__ int lane_id_opq() { int l = (int)__builtin_amdgcn_mbcnt_hi(~0u, __builtin_amdgcn_mbcnt_lo(~0u, 0u)); asm volatile("" : "+v"(l)); return l; }

namespace pg8 {
#define PG8_LAS __attribute__((address_space(3)))
typedef unsigned short bf16_t;
typedef short bf16x8 __attribute__((ext_vector_type(8)));
typedef float f32x4 __attribute__((ext_vector_type(4)));
typedef unsigned u32x4 __attribute__((ext_vector_type(4)));
constexpr int BM = 256, BK = 64, HALF = 128, HTB = HALF * BK * 2  , STAGE_BYTES = 8 * HTB, NXCD = 8, WGM = 8;

__host__ __device__ __forceinline__ int lds_byte(int r, int c) { const int st = (r >> 4) * 2 + (c >> 5), rr = r & 15, cc = c & 31, ob = rr * 64 + cc * 2; return st * 1024 + (ob ^ (((ob >> 9) & 1) << 5)); }
__host__ __device__ __forceinline__ void stage_rc(int b, int& R, int& C) { const int st = b / 1024, sb = b % 1024, swz = sb ^ (((sb >> 9) & 1) << 5); R = (st >> 1) * 16 + swz / 64; C = (st & 1) * 32 + (swz % 64) / 2; }
__host__ __device__ __forceinline__ int perm32(int rho) { const int n = rho >> 4, i = rho & 15; return 8 * (i >> 2) + 4 * n + (i & 3); }

struct Unit { int pm, pn; };
struct Gemm { const bf16_t* A; const bf16_t* Bt; int M, N, K; };

struct StaticOrder {
    int nM, nN, nwg, G, c;
    __host__ __device__ void init(int M, int N, int G_, int c_) { nM = M / BM; nN = N / BM; nwg = nM * nN; G = G_; c = c_; }
    __host__ __device__ bool next(int i, Unit& u) const {
        const long L = (long)i * G + c; if (L >= nwg) return false;
        int wgid = (int)L; { const int q = nwg / NXCD, r = nwg % NXCD, xcd = wgid % NXCD, off = wgid / NXCD; wgid = (xcd < r ? xcd * (q + 1) : r * (q + 1) + (xcd - r) * q) + off; }
        const int nig = WGM * nN, gid = wgid / nig, fm = gid * WGM, gsz = (nM - fm) < WGM ? (nM - fm) : WGM;
        u.pm = fm + ((wgid % nig) % gsz); u.pn = (wgid % nig) / gsz; return true;
    }
    __device__ __forceinline__ void a_ready(const Unit&) const {}
    __device__ __forceinline__ void done(const Unit&) const {}
};

__device__ __forceinline__ unsigned cvt_pk_bf16(float lo, float hi) { unsigned r; asm volatile("v_cvt_pk_bf16_f32 %0, %1, %2" : "=v"(r) : "v"(lo), "v"(hi)); return r; }
typedef float f32x2 __attribute__((ext_vector_type(2)));

typedef float f32x2e __attribute__((ext_vector_type(2)));
typedef __bf16 bf16x2e __attribute__((ext_vector_type(2)));
__device__ __forceinline__ unsigned cvt_pk(float lo, float hi) { const f32x2e v = {lo, hi}; return __builtin_bit_cast(unsigned, __builtin_convertvector(v, bf16x2e)); }
__device__ __forceinline__ float silu_f(float x) { return x * __builtin_amdgcn_rcpf(1.0f + __expf(-x)); }
struct EpiBf16Plain {
    static constexpr bool PERM = true, AFTER_DRAIN = false; static constexpr int NSTORE = 16;
    bf16_t* O; int ldc;
    __device__ __forceinline__ void operator()(const f32x4 (&acc)[2][2][4][2], const Unit& u, int wr, int wc, int fr, int fq) const {
        const int row0 = u.pm * BM + wr * 64 + fr, col0 = u.pn * BM + wc * 32 + 8 * fq;
#pragma unroll
        for (int ai = 0; ai < 2; ++ai)
#pragma unroll
            for (int m = 0; m < 4; ++m) { bf16_t* rowp = O + (size_t)(row0 + ai * HALF + m * 16) * ldc + col0;
#pragma unroll
                for (int bj = 0; bj < 2; ++bj) { const f32x4 v0 = acc[ai][bj][m][0], v1 = acc[ai][bj][m][1];
                    u32x4 w; w.x = cvt_pk(v0[0], v0[1]); w.y = cvt_pk(v0[2], v0[3]); w.z = cvt_pk(v1[0], v1[1]); w.w = cvt_pk(v1[2], v1[3]);
                    *(u32x4*)(rowp + bj * HALF) = w; } }
    }
};
struct EpiSwiGLU {
    static constexpr bool PERM = true, AFTER_DRAIN = false; static constexpr int NSTORE = 8;
    bf16_t* O; int ldc;
    __device__ __forceinline__ void operator()(const f32x4 (&acc)[2][2][4][2], const Unit& u, int wr, int wc, int fr, int fq) const {
        const int row0 = u.pm * BM + wr * 64 + fr, col0 = u.pn * HALF + wc * 32 + 8 * fq;
#pragma unroll
        for (int ai = 0; ai < 2; ++ai)
#pragma unroll
            for (int m = 0; m < 4; ++m) { bf16_t* rowp = O + (size_t)(row0 + ai * HALF + m * 16) * ldc + col0;
                const f32x4 g0 = acc[ai][0][m][0], g1 = acc[ai][0][m][1], u0 = acc[ai][1][m][0], u1 = acc[ai][1][m][1];
                u32x4 w; w.x = cvt_pk(silu_f(g0[0]) * u0[0], silu_f(g0[1]) * u0[1]); w.y = cvt_pk(silu_f(g0[2]) * u0[2], silu_f(g0[3]) * u0[3]);
                w.z = cvt_pk(silu_f(g1[0]) * u1[0], silu_f(g1[1]) * u1[1]); w.w = cvt_pk(silu_f(g1[2]) * u1[2], silu_f(g1[3]) * u1[3]);
                *(u32x4*)rowp = w; }
    }
};
template <bool F32IN>
struct EpiResGate {
    static constexpr bool PERM = false, AFTER_DRAIN = false; static constexpr int NSTORE = 32;
    const float* xin32; const bf16_t* xsin; bf16_t* xs; int ldc; const float* gate; int gpitch;
    __device__ __forceinline__ void operator()(const f32x4 (&acc)[2][2][4][2], const Unit& u, int wr, int wc, int fr, int fq) const {
        typedef unsigned u32x2 __attribute__((ext_vector_type(2)));
        const int row0 = u.pm * BM + wr * 64 + fr, col0 = u.pn * BM + wc * 32 + 4 * fq;
        const float* gp = gate + (size_t)(u.pm >> 3) * gpitch + col0;
        f32x4 gv[2][2];
#pragma unroll
        for (int bj = 0; bj < 2; ++bj)
#pragma unroll
            for (int n = 0; n < 2; ++n) gv[bj][n] = *(const f32x4*)(gp + bj * HALF + n * 16);
        f32x4 xf[2][2][2][2]; u32x2 xb[2][2][2][2];
#define RG_LOAD(buf, ai, mh) do { _Pragma("unroll") for (int mm = 0; mm < 2; ++mm) { const size_t off = (size_t)(row0 + (ai) * HALF + (2 * (mh) + mm) * 16) * ldc + col0; \
            _Pragma("unroll") for (int bj = 0; bj < 2; ++bj) _Pragma("unroll") for (int n = 0; n < 2; ++n) { \
                if constexpr (F32IN) xf[buf][mm][bj][n] = *(const f32x4*)(xin32 + off + bj * HALF + n * 16); else xb[buf][mm][bj][n] = *(const u32x2*)(xsin + off + bj * HALF + n * 16); } } } while (0)
        RG_LOAD(0, 0, 0);
#pragma unroll
        for (int k = 0; k < 4; ++k) { const int ai = k >> 1, mh = k & 1, buf = k & 1;
            if (k < 3) RG_LOAD((k + 1) & 1, (k + 1) >> 1, (k + 1) & 1);
            asm volatile("" ::: "memory");
#pragma unroll
            for (int mm = 0; mm < 2; ++mm) { const int m = 2 * mh + mm; const size_t off = (size_t)(row0 + ai * HALF + m * 16) * ldc + col0;
#pragma unroll
                for (int bj = 0; bj < 2; ++bj)
#pragma unroll
                    for (int n = 0; n < 2; ++n) { f32x4 xi;
                        if constexpr (F32IN) xi = xf[buf][mm][bj][n];
                        else { const u32x2 w = xb[buf][mm][bj][n]; xi = (f32x4){__uint_as_float(w.x << 16), __uint_as_float(w.x & 0xffff0000u), __uint_as_float(w.y << 16), __uint_as_float(w.y & 0xffff0000u)}; }
                        const f32x4 xo = xi + gv[bj][n] * acc[ai][bj][m][n];
                        u32x2 o; o.x = cvt_pk(xo[0], xo[1]); o.y = cvt_pk(xo[2], xo[3]); *(u32x2*)(xs + off + bj * HALF + n * 16) = o; } }
            asm volatile("" ::: "memory"); }
#undef RG_LOAD
    }
};

template <class Epi, class Sched, bool ALIGN_EPI = false, bool SP2 = false>
__device__ __forceinline__ void gemm_phase(PG8_LAS unsigned char* lds, const Gemm g, const Sched& S, const Epi& E, const int wid_in) {
    const int wid = wid_in, lane = lane_id_opq(), tid = wid * 64 + lane, wr = wid >> 2, wc = wid & 3, fr = lane & 15, fq = lane >> 4;
    const int K = g.K, nt = K / BK;
    unsigned voffA[2], voffB[2];
#pragma unroll
    for (int i = 0; i < 2; ++i) { int R, C; stage_rc(tid * 16 + i * 8192, R, C); const int Rb = Epi::PERM ? ((R & ~31) + perm32(R & 31)) : R;
        voffA[i] = (unsigned)(R * K + C) * 2u; voffB[i] = (unsigned)(Rb * K + C) * 2u; }
    const size_t kstep = (size_t)(BK * 2);
    const size_t hstep = (size_t)HALF * K * 2;
    const size_t tstep = 2 * hstep;
    const unsigned ldsw = (unsigned)wid * 1024u;
    const int aoff = lds_byte(wr * 64 + fr, fq * 8), boff = lds_byte(wc * 32 + fr, fq * 8);
#define PG8_SA(b, h) (((b) * 2 + (h)) * HTB)
#define PG8_SB(b, h) ((4 + (b) * 2 + (h)) * HTB)
#define PG8_STAGE(bufoff, gbase, voff) do { _Pragma("unroll") for (int _i = 0; _i < 2; ++_i) \
        __builtin_amdgcn_global_load_lds((const unsigned*)((const char*)(gbase) + (voff)[_i]), (PG8_LAS unsigned*)(lds + (bufoff) + ldsw + _i * 8192), 16, 0, 0); } while (0)
#define PG8_LDA(dst, b, h) do { _Pragma("unroll") for (int m = 0; m < 4; ++m) _Pragma("unroll") for (int k = 0; k < 2; ++k) dst[m][k] = *(const PG8_LAS bf16x8*)(lds + PG8_SA(b, h) + aoff + m * 2048 + k * 1024); } while (0)
#define PG8_LDB(dst, b, h) do { _Pragma("unroll") for (int n = 0; n < 2; ++n) _Pragma("unroll") for (int k = 0; k < 2; ++k) dst[n][k] = *(const PG8_LAS bf16x8*)(lds + PG8_SB(b, h) + boff + n * 2048 + k * 1024); } while (0)
#define PG8_MMA(ai, bj, At, Bt) do { __builtin_amdgcn_s_setprio(1); _Pragma("unroll") for (int m = 0; m < 4; ++m) _Pragma("unroll") for (int n = 0; n < 2; ++n) _Pragma("unroll") for (int k = 0; k < 2; ++k) \
        acc[ai][bj][m][n] = __builtin_amdgcn_mfma_f32_16x16x32_bf16(Bt[n][k], At[m][k], acc[ai][bj][m][n], 0, 0, 0); __builtin_amdgcn_s_setprio(0); } while (0)
#define PG8_WAIT_V(n) asm volatile("s_waitcnt vmcnt(" #n ")" ::: "memory")
#define PG8_WAIT_L(n) asm volatile("s_waitcnt lgkmcnt(" #n ")" ::: "memory")
#define PG8_BAR __builtin_amdgcn_s_barrier()
#define PG8_SCHED __builtin_amdgcn_sched_barrier(0)
    Unit cur, nxt; int ui = 0;
    if (!S.next(0, cur)) return;
    f32x4 acc[2][2][4][2];
#pragma unroll
    for (int a = 0; a < 2; ++a)
#pragma unroll
        for (int b = 0; b < 2; ++b)
#pragma unroll
            for (int m = 0; m < 4; ++m)
#pragma unroll
                for (int n = 0; n < 2; ++n) acc[a][b][m][n] = (f32x4){0.f, 0.f, 0.f, 0.f};
    bf16x8 At[4][2], B0[2][2], B1[2][2];
    const char* cA = (const char*)g.A + (size_t)cur.pm * tstep; const char* cB = (const char*)g.Bt + (size_t)cur.pn * tstep;
    S.a_ready(cur);
    if constexpr (SP2) {
        PG8_STAGE(PG8_SB(0, 0), cB, voffB); PG8_STAGE(PG8_SB(0, 1), cB + hstep, voffB); PG8_STAGE(PG8_SA(0, 0), cA, voffA); PG8_STAGE(PG8_SA(0, 1), cA + hstep, voffA);
        if (wr == 1) PG8_BAR;
        PG8_WAIT_V(2); PG8_BAR;
        PG8_STAGE(PG8_SB(1, 0), cB + kstep, voffB); PG8_STAGE(PG8_SA(1, 0), cA + kstep, voffA); PG8_STAGE(PG8_SB(1, 1), cB + hstep + kstep, voffB);
        PG8_WAIT_V(6); PG8_BAR;
    } else {
        PG8_STAGE(PG8_SB(0, 0), cB, voffB); PG8_STAGE(PG8_SA(0, 0), cA, voffA); PG8_STAGE(PG8_SB(0, 1), cB + hstep, voffB); PG8_STAGE(PG8_SA(0, 1), cA + hstep, voffA);
        if (wr == 1) PG8_BAR;
        PG8_WAIT_V(4); PG8_BAR;
        PG8_STAGE(PG8_SB(1, 0), cB + kstep, voffB); PG8_STAGE(PG8_SA(1, 0), cA + kstep, voffA); PG8_STAGE(PG8_SB(1, 1), cB + hstep + kstep, voffB);
        PG8_WAIT_V(6); PG8_BAR;
    }
    for (;;) {
        const bool has_next = S.next(ui + 1, nxt);
        const char* nA = has_next ? (const char*)g.A + (size_t)nxt.pm * tstep : cA; const char* nB = has_next ? (const char*)g.Bt + (size_t)nxt.pn * tstep : cB;
#if PROBE_KL
        unsigned long long pk_t0 = 0; if (Epi::PERM && Epi::NSTORE == 16 && ui == 2 && blockIdx.x == 0 && wid == 0) pk_t0 = __builtin_readcyclecounter();
#endif
        for (int t = 0; t < nt; t += 2) {
            const bool last = (t == nt - 2);
            const char* a1 = cA + (size_t)(t + 1) * kstep;
            const char* a2 = last ? nA : cA + (size_t)(t + 2) * kstep; const char* b2 = last ? nB : cB + (size_t)(t + 2) * kstep;
            const char* a3 = a2 + kstep; const char* b3 = b2 + kstep;
            if (last && has_next) S.a_ready(nxt);
            if constexpr (SP2) {
            PG8_LDB(B0, 0, 0); PG8_LDB(B1, 0, 1); PG8_SCHED; PG8_LDA(At, 0, 0); PG8_STAGE(PG8_SA(1, 1), a1 + hstep, voffA);
            PG8_WAIT_V(8); PG8_WAIT_L(0); PG8_BAR; PG8_MMA(0, 0, At, B0); PG8_MMA(0, 1, At, B1); PG8_BAR; PG8_SCHED;
            PG8_LDA(At, 0, 1); PG8_STAGE(PG8_SB(0, 0), b2, voffB); PG8_STAGE(PG8_SB(0, 1), b2 + hstep, voffB); PG8_STAGE(PG8_SA(0, 0), a2, voffA);
            PG8_WAIT_V(8); PG8_WAIT_L(0); PG8_BAR; PG8_MMA(1, 0, At, B0); PG8_MMA(1, 1, At, B1); PG8_BAR; PG8_SCHED;
            PG8_LDB(B0, 1, 0); PG8_LDB(B1, 1, 1); PG8_SCHED; PG8_LDA(At, 1, 0); PG8_STAGE(PG8_SA(0, 1), a2 + hstep, voffA);
            PG8_WAIT_V(8); PG8_WAIT_L(0); PG8_BAR; PG8_MMA(0, 0, At, B0); PG8_MMA(0, 1, At, B1); PG8_BAR; PG8_SCHED;
            PG8_LDA(At, 1, 1); PG8_STAGE(PG8_SB(1, 0), b3, voffB); PG8_STAGE(PG8_SB(1, 1), b3 + hstep, voffB); PG8_STAGE(PG8_SA(1, 0), a3, voffA);
            PG8_WAIT_V(8); PG8_WAIT_L(0); PG8_BAR; PG8_MMA(1, 0, At, B0); PG8_MMA(1, 1, At, B1); PG8_BAR; PG8_SCHED;
            } else {
            PG8_LDB(B0, 0, 0); PG8_SCHED; PG8_LDA(At, 0, 0); PG8_STAGE(PG8_SA(1, 1), a1 + hstep, voffA);
            PG8_WAIT_L(8); PG8_BAR; PG8_WAIT_L(0); PG8_MMA(0, 0, At, B0); PG8_BAR; PG8_SCHED;
            PG8_LDB(B1, 0, 1); PG8_STAGE(PG8_SB(0, 0), b2, voffB);
            PG8_BAR; PG8_WAIT_L(0); PG8_MMA(0, 1, At, B1); PG8_BAR;
            PG8_LDA(At, 0, 1); PG8_STAGE(PG8_SA(0, 0), a2, voffA);
            PG8_BAR; PG8_WAIT_L(0); PG8_MMA(1, 0, At, B0); PG8_BAR; PG8_SCHED;
            PG8_STAGE(PG8_SB(0, 1), b2 + hstep, voffB);
            PG8_WAIT_V(6); PG8_BAR; PG8_MMA(1, 1, At, B1); PG8_BAR;
            PG8_LDB(B0, 1, 0); PG8_SCHED; PG8_LDA(At, 1, 0); PG8_STAGE(PG8_SA(0, 1), a2 + hstep, voffA);
            PG8_WAIT_L(8); PG8_BAR; PG8_WAIT_L(0); PG8_MMA(0, 0, At, B0); PG8_BAR; PG8_SCHED;
            PG8_LDB(B1, 1, 1); PG8_STAGE(PG8_SB(1, 0), b3, voffB);
            PG8_BAR; PG8_WAIT_L(0); PG8_MMA(0, 1, At, B1); PG8_BAR;
            PG8_LDA(At, 1, 1); PG8_STAGE(PG8_SA(1, 0), a3, voffA);
            PG8_BAR; PG8_WAIT_L(0); PG8_MMA(1, 0, At, B0); PG8_BAR; PG8_SCHED;
            PG8_STAGE(PG8_SB(1, 1), b3 + hstep, voffB);
            PG8_WAIT_V(6); PG8_BAR; PG8_MMA(1, 1, At, B1); PG8_BAR;
            }
        }
#if PROBE_KL
        unsigned long long pk_t1 = 0; if (Epi::PERM && Epi::NSTORE == 16 && ui == 2 && blockIdx.x == 0 && wid == 0) pk_t1 = __builtin_readcyclecounter();
#endif
        if constexpr (ALIGN_EPI) { if (wr == 0) PG8_BAR; }
        if constexpr (!Epi::AFTER_DRAIN) { E(acc, cur, wr, wc, fr, fq);
#if PROBE_EPI2
            if constexpr (Epi::PERM) { asm volatile("" ::: "memory"); E(acc, cur, wr, wc, fr, fq); }
#endif
            S.done(cur); }
#if PROBE_KL
        if (Epi::PERM && Epi::NSTORE == 16 && ui == 2 && blockIdx.x == 0 && wid == 0) { asm volatile("s_waitcnt vmcnt(0)" ::: "memory"); const unsigned long long pk_t2 = __builtin_readcyclecounter(); if (lane == 0 && (PROBE_KL_FIRST == 0 || probe_kl[0] == 0ull)) { probe_kl[0] = pk_t1 - pk_t0; probe_kl[1] = pk_t2 - pk_t1; } }
#endif
        if (!has_next) break;
#pragma unroll
        for (int a = 0; a < 2; ++a)
#pragma unroll
            for (int b = 0; b < 2; ++b)
#pragma unroll
                for (int m = 0; m < 4; ++m)
#pragma unroll
                    for (int n = 0; n < 2; ++n) acc[a][b][m][n] = (f32x4){0.f, 0.f, 0.f, 0.f};
        cur = nxt; cA = nA; cB = nB; ++ui;
        if constexpr (ALIGN_EPI) { if (wr == 1) PG8_BAR; }
    }
    PG8_WAIT_V(0);
    if constexpr (!ALIGN_EPI) { if (wr == 0) PG8_BAR; }
    PG8_BAR;
    if constexpr (Epi::AFTER_DRAIN) { E.fused(acc, cur, wr, wc, fr, fq, lds, wid, lane); S.done(cur); }
#undef PG8_SA
#undef PG8_SB
#undef PG8_STAGE
#undef PG8_LDA
#undef PG8_LDB
#undef PG8_MMA
#undef PG8_WAIT_V
#undef PG8_WAIT_L
#undef PG8_BAR
#undef PG8_SCHED
}
}

#ifndef MK_PER_PHASE
#define MK_PER_PHASE 0
#endif
constexpr int NWAVES = 8;
constexpr int DM = 1024, NB = 32, SEQ = 2048, NL = 4, MT = NB * SEQ;
constexpr int D_IN = 3976, NPI = 4096, DFF = 2816, NF1 = 2 * DFF;
constexpr int RW_B = 1024, ML_B = 2432;
constexpr int RWKV_IN = 1408;
constexpr float RMS_EPS = 1e-6f, GN_EPS = 1e-5f;
constexpr int MODP = 6 * DM;
constexpr size_t MiB = 1u << 20;
constexpr size_t WS_CTL = 0, CTL_ZERO_BYTES = 1 * MiB;
constexpr size_t WS_HS = 116 * MiB;
constexpr int CW_PCNT = 32768, PCNT_BANK = 256 * 64;
constexpr int CW_FLAG = 16384;
constexpr int SPLIT_H = 5, SPLIT_X = 27, SPLIT_Y = 16;
constexpr size_t WS_WL = 5 * MiB;
constexpr size_t WS_MOD = 1 * MiB;
constexpr size_t WS_WIN = 8 * MiB, WS_WOUT = 40 * MiB, WS_WF1 = 48 * MiB, WS_WF2 = 92 * MiB;
constexpr size_t WS_H = 128 * MiB;
constexpr size_t WS_PROJ = 256 * MiB;
constexpr size_t WS_XFIN = (256 + 352) * MiB;
constexpr size_t WS_DEC = 768 * MiB, WS_AA = 864 * MiB, WS_GG = 912 * MiB;
constexpr size_t WS_END = 960 * MiB;
constexpr int CW_BAR = 4096;
constexpr int N_PHASES = 3 + 6 * NL;
static_assert((CW_BAR + (MK_PER_PHASE ? 1 : 1) * 3456) * 4 <= (int)CTL_ZERO_BYTES, "ctl");
constexpr int RING_BYTES = 131072, LDS_BYTES = 163840, LDSCTL_OFF = LDS_BYTES - 1024, MISC_OFF = LDSCTL_OFF + 320;

#define GAS __attribute__((address_space(1)))
#define LAS __attribute__((address_space(3)))
typedef unsigned short bf16;
typedef unsigned v4u __attribute__((ext_vector_type(4)));
typedef unsigned v2u __attribute__((ext_vector_type(2)));
typedef float f32x4 __attribute__((ext_vector_type(4)));
#define LDS_WAIT() asm volatile("s_waitcnt lgkmcnt(0)" ::: "memory")
typedef float f32x2c __attribute__((ext_vector_type(2)));
typedef __bf16 bf16x2c __attribute__((ext_vector_type(2)));
__device__ __forceinline__ unsigned f2bf(float f) { return (__builtin_bit_cast(unsigned, f) + 0x8000u) >> 16; }
__device__ __forceinline__ unsigned pk2(float lo, float hi) { return __builtin_amdgcn_perm(__builtin_bit_cast(unsigned, hi) + 0x8000u, __builtin_bit_cast(unsigned, lo) + 0x8000u, 0x07060302u); }
__device__ __forceinline__ float bf2f(bf16 v) { return __uint_as_float(((unsigned)v) << 16); }
template <int CTRL, int ROWMASK> __device__ __forceinline__ float dppf(float v) { return __builtin_bit_cast(float, __builtin_amdgcn_update_dpp(0, __builtin_bit_cast(int, v), CTRL, ROWMASK, 0xf, false)); }
__device__ __forceinline__ float sum16(float v) { v += dppf<0xB1, 0xf>(v); v += dppf<0x4E, 0xf>(v); v += dppf<0x141, 0xf>(v); v += dppf<0x140, 0xf>(v); return v; }
__device__ __forceinline__ float wave_sum(float v) { v = sum16(v); v += dppf<0x142, 0xa>(v); v += dppf<0x143, 0xc>(v); return __builtin_bit_cast(float, __builtin_amdgcn_readlane(__builtin_bit_cast(int, v), 63)); }
template <int CTRL, int ROWMASK> __device__ __forceinline__ float dppo(float v, float old) { return __builtin_bit_cast(float, __builtin_amdgcn_update_dpp(__builtin_bit_cast(int, old), __builtin_bit_cast(int, v), CTRL, ROWMASK, 0xf, false)); }
__device__ __forceinline__ float wave_prefix_sum(float v) { v += dppo<0x111, 0xf>(v, 0.f); v += dppo<0x112, 0xf>(v, 0.f); v += dppo<0x114, 0xf>(v, 0.f); v += dppo<0x118, 0xf>(v, 0.f); v += dppo<0x142, 0xa>(v, 0.f); v += dppo<0x143, 0xc>(v, 0.f); return v; }
__device__ __forceinline__ float wave_prefix_max(float v) { const float ni = -__builtin_inff(); v = fmaxf(v, dppo<0x111, 0xf>(v, ni)); v = fmaxf(v, dppo<0x112, 0xf>(v, ni)); v = fmaxf(v, dppo<0x114, 0xf>(v, ni)); v = fmaxf(v, dppo<0x118, 0xf>(v, ni));
    v = fmaxf(v, dppo<0x142, 0xa>(v, ni)); v = fmaxf(v, dppo<0x143, 0xc>(v, ni)); return v; }
__device__ __forceinline__ float flogsigmoid(float x) { return fminf(x, 0.f) - __logf(1.0f + __expf(-fabsf(x))); }
__device__ __forceinline__ float fexp(float x) { return __expf(x); }
__device__ __forceinline__ float fsigmoid(float x) { return __builtin_amdgcn_rcpf(1.0f + __expf(-x)); }
__device__ __forceinline__ float sigmoid_f(float x) { return 1.0f / (1.0f + expf(-x)); }
__device__ __forceinline__ float logsigmoid_f(float x) { return fminf(x, 0.f) - log1pf(expf(-fabsf(x))); }
template <class T> __device__ __forceinline__ T* opq(T* p) { asm volatile("" : "+s"(p)); return p; }

#define XB_TMO      128
#define XB_XCNT(j)  (256  + 64 * (j))
#define XB_XSUB(j)  (1280 + 64 * (j))
#define XB_XGEN(j)  (2304 + 64 * (j))
#define XB_TOP      3328
#define XB_TOPGEN   3392
#define XCD_BAR_WORDS 3456
#define XB_SPIN_CAP (1u << 22)

__device__ __forceinline__ unsigned xb_ld(unsigned* p)              { return __hip_atomic_load(p, __ATOMIC_RELAXED, __HIP_MEMORY_SCOPE_AGENT); }
__device__ __forceinline__ unsigned xb_add(unsigned* p, unsigned v) { return __hip_atomic_fetch_add(p, v, __ATOMIC_RELAXED, __HIP_MEMORY_SCOPE_AGENT); }
__device__ __forceinline__ unsigned xb_xcc_id() { return (unsigned)__builtin_amdgcn_s_getreg((3 << 11) | 20) & 0xFu; }
#define XB_SPIN(cond, bar) do { unsigned _sp = 0; while (cond) { __builtin_amdgcn_s_sleep(1); \
    if ((++_sp & 255u) == 0u) { if (xb_ld(&(bar)[XB_TMO])) break; if (_sp > XB_SPIN_CAP) { atomicAdd(&(bar)[XB_TMO], 1u); break; } } } } while (0)

struct XcdBarrier {
    unsigned* bar; unsigned x; unsigned w0;
    volatile LAS unsigned* st;
};

__device__ __forceinline__ XcdBarrier xcd_barrier_post(unsigned* bar, volatile LAS unsigned* st) {
    XcdBarrier b; b.bar = bar; b.x = xb_xcc_id(); b.st = st; b.w0 = (__builtin_amdgcn_readfirstlane((int)threadIdx.x >> 6) == 0) ? 1u : 0u;
    if (threadIdx.x == 0) (void)xb_add(&bar[XB_XCNT(b.x)], 1u);
    return b;
}
__device__ __forceinline__ void xcd_barrier_complete(unsigned* bar, unsigned x, unsigned& nloc, unsigned& nx) {
    const unsigned G = gridDim.x * gridDim.y * gridDim.z;
    unsigned sum, cnt, mine, sp = 0u;
    for (;;) {
        sum = 0u; cnt = 0u; mine = 0u;
#pragma unroll
        for (unsigned j = 0; j < 16; ++j) { const unsigned c = xb_ld(&bar[XB_XCNT(j)]); sum += c; cnt += (c > 0u) ? 1u : 0u; mine = (j == x) ? c : mine; }
        if (sum == G) break;
        __builtin_amdgcn_s_sleep(1);
        if ((++sp & 255u) == 0u) { if (xb_ld(&bar[XB_TMO])) break; if (sp > XB_SPIN_CAP) { atomicAdd(&bar[XB_TMO], 1u); break; } }
    }
    nloc = mine > 0u ? mine : 1u; nx = cnt > 0u ? cnt : 1u;
}

__device__ __forceinline__ void xcd_barrier(const XcdBarrier& b) {
    asm volatile("s_waitcnt vmcnt(0)" ::: "memory");
    __syncthreads();
    if (b.w0 != 0u && lane_id_opq() == 0) {
        unsigned* bar = b.bar;
        __builtin_amdgcn_s_waitcnt(0);
        unsigned nloc = b.st[0], nx = b.st[1];
        if (nloc == 0u) { xcd_barrier_complete(bar, b.x, nloc, nx); b.st[0] = nloc; b.st[1] = nx; }
        const unsigned old = xb_add(&bar[XB_XSUB(b.x)], 1u);
        const unsigned gen = old / nloc;
        if (old + 1u == (gen + 1u) * nloc) {
            __builtin_amdgcn_fence(__ATOMIC_RELEASE, "agent");
            asm volatile("s_waitcnt vmcnt(0)" ::: "memory");
            const unsigned og = xb_add(&bar[XB_TOP], 1u);
            const unsigned tg = og / nx;
            if (og + 1u == (tg + 1u) * nx) xb_add(&bar[XB_TOPGEN], 1u);
            else XB_SPIN(xb_ld(&bar[XB_TOPGEN]) == tg, bar);
            __builtin_amdgcn_fence(__ATOMIC_ACQUIRE, "agent");
            xb_add(&bar[XB_XGEN(b.x)], 1u);
            asm volatile("s_waitcnt vmcnt(0)" ::: "memory");
        } else {
            XB_SPIN(xb_ld(&bar[XB_XGEN(b.x)]) == gen, bar);
            __builtin_amdgcn_fence(__ATOMIC_ACQUIRE, "agent");
            asm volatile("s_waitcnt vmcnt(0)" ::: "memory");
        }
    }
    __syncthreads();
}


__device__ __forceinline__ void b32_gemv(const float* Wcol  , bool ok, int N, LAS float* vT, float (&res)[4], int wave, int lane) {
    float acc[32];
#pragma unroll
    for (int b = 0; b < 32; ++b) acc[b] = 0.f;
    const float* wp = Wcol + (size_t)(128 * wave) * N; const LAS float* vp = vT + 128 * wave * 32;
#pragma unroll 1
    for (int kk = 0; kk < 128; kk += 8) {
        float w[8];
#pragma unroll
        for (int u = 0; u < 8; ++u) w[u] = ok ? wp[(size_t)u * N] : 0.f;
        wp += (size_t)8 * N;
#pragma unroll
        for (int u = 0; u < 8; ++u) {
#pragma unroll
            for (int b4 = 0; b4 < 8; ++b4) { const f32x4 cv = *(const LAS f32x4*)(vp + u * 32 + 4 * b4);
                acc[4 * b4] += cv.x * w[u]; acc[4 * b4 + 1] += cv.y * w[u]; acc[4 * b4 + 2] += cv.z * w[u]; acc[4 * b4 + 3] += cv.w * w[u]; }
            asm volatile("" ::: "memory"); }
        vp += 8 * 32;
    }
    __syncthreads();
#pragma unroll
    for (int b = 0; b < 32; ++b) vT[(wave * 32 + b) * 64 + lane] = acc[b];
    __syncthreads();
#pragma unroll
    for (int q = 0; q < 4; ++q) { float s = 0.f;
#pragma unroll
        for (int w2 = 0; w2 < 8; ++w2) s += vT[(w2 * 32 + 4 * wave + q) * 64 + lane];
        res[q] = s; }
    __syncthreads();
}
__device__ __forceinline__ void p0_mod(const float* c, const float* ada_w, const float* ada_b, float* mod, LAS unsigned char* lds, int tid, int lane, int wave) {
    LAS float* condT = (LAS float*)lds;
    for (int item = blockIdx.x; item < NL * 96; item += gridDim.x) {
        __syncthreads();
        for (int e = tid; e < NB * DM; e += NWAVES * 64) { const int k = e >> 5, b = e & 31; const float v = c[b * DM + k]; condT[e] = v / (1.0f + expf(-v)); }
        __syncthreads();
        const int l = item / 96, g = item % 96, n = g * 64 + lane;
        float res[4]; b32_gemv(ada_w + (size_t)l * DM * MODP + n, true, MODP, condT, res, wave, lane);
        const float bb = ada_b[l * MODP + n]; float* o = mod + ((size_t)l * NB + wave * 4) * MODP + n;
        o[0] = res[0] + bb; o[MODP] = res[1] + bb; o[2 * MODP] = res[2] + bb; o[3 * MODP] = res[3] + bb;
    }
    __syncthreads();
}
template <int MODE>
__device__ __forceinline__ void transpose_item(const float* W, int K, int N, int nblk, bf16* WT, int ldw, LAS float* scr, int item, int lane) {
    const int kb = item / nblk, nb = item % nblk, k0 = 64 * kb, n0 = 32 * nb;
    const int nq = lane & 7, nn = n0 + 4 * nq; const bool ok = nn < N;
    const float* wp = W + (size_t)(k0 + (lane >> 3)) * N + (ok ? nn : 0); f32x4 vv[8];
#pragma unroll
    for (int i = 0; i < 8; ++i) vv[i] = *(const f32x4*)(wp + (size_t)(8 * i) * N);
#pragma unroll
    for (int i = 0; i < 8; ++i) { const int kk = 8 * i + (lane >> 3); const f32x4 v = ok ? vv[i] : (f32x4){0.f, 0.f, 0.f, 0.f};
        LAS float* d = scr + kk * 33 + 4 * nq; d[0] = v.x; d[1] = v.y; d[2] = v.z; d[3] = v.w; }
    LDS_WAIT();
    const int c = lane & 7;
#pragma unroll
    for (int j = 0; j < 4; ++j) { const int n = (lane >> 3) + 8 * j; const LAS float* s = scr + (8 * c) * 33 + n;
        v4u o; o.x = pk2(s[0 * 33], s[1 * 33]); o.y = pk2(s[2 * 33], s[3 * 33]); o.z = pk2(s[4 * 33], s[5 * 33]); o.w = pk2(s[6 * 33], s[7 * 33]);
        int row = n0 + n;
        if (MODE == 1) { const int up = row >= DFF ? 1 : 0, jj = row - up * DFF; row = (jj >> 7) * 256 + up * 128 + (jj & 127); }
        *(v4u*)(WT + (size_t)row * ldw + k0 + 8 * c) = o; }
    LDS_WAIT();
}
__device__ __forceinline__ void p0_weights(const float* w_in, const float* w_out, const float* f1, const float* f2, const float* lw2, const float* la2, const float* lg2, unsigned char* ws, LAS unsigned char* lds, int gw, int ngw, int wave, int lane) {
    LAS float* scr = (LAS float*)(lds + wave * 16384);
    constexpr int I_IN = (DM / 64) * (NPI / 32), I_OUT = (DM / 64) * (DM / 32), I_F1 = (DM / 64) * (NF1 / 32), I_F2 = (DFF / 64) * (DM / 32), I_L = I_IN + I_OUT + I_F1 + I_F2 + 48;
    for (int it = gw; it < NL * I_L; it += ngw) {
        const int l = it / I_L; int r = it % I_L;
        if (r < I_IN) { transpose_item<0>(w_in + (size_t)l * DM * D_IN, DM, D_IN, NPI / 32, (bf16*)(ws + WS_WIN) + (size_t)l * NPI * DM, DM, scr, r, lane); continue; } r -= I_IN;
        if (r < I_OUT) { transpose_item<0>(w_out + (size_t)l * DM * DM, DM, DM, DM / 32, (bf16*)(ws + WS_WOUT) + (size_t)l * DM * DM, DM, scr, r, lane); continue; } r -= I_OUT;
        if (r < I_F1) { transpose_item<1>(f1 + (size_t)l * DM * NF1, DM, NF1, NF1 / 32, (bf16*)(ws + WS_WF1) + (size_t)l * NF1 * DM, DM, scr, r, lane); continue; } r -= I_F1;
        if (r < I_F2) { transpose_item<0>(f2 + (size_t)l * DFF * DM, DFF, DM, DM / 32, (bf16*)(ws + WS_WF2) + (size_t)l * DM * DFF, DFF, scr, r, lane); continue; } r -= I_F2;
        bf16* wl = (bf16*)(ws + WS_WL) + (size_t)l * 384 * 256;
        if (r < 12) { transpose_item<0>(lw2 + (size_t)l * 64 * 384, 64, 384, 12, wl, 256, scr, r, lane); continue; } r -= 12;
        if (r < 12) { transpose_item<0>(la2 + (size_t)l * 64 * 384, 64, 384, 12, wl + 64, 256, scr, r, lane); continue; } r -= 12;
        transpose_item<0>(lg2 + (size_t)l * 128 * 384, 128, 384, 12, wl + 128, 256, scr, r, lane);
    }
}
__device__ __forceinline__ void norm_mod_phase(const float* xin32, const float* gain, const float* modl, int sh_off, int sc_off, bf16* out, int gw, int ngw, int lane) {
    for (int ci = gw; ci < MT / 32; ci += ngw) {
        const int b = ci >> 6; const float* mb = modl + (size_t)b * MODP;
        f32x4 gs[4], sh[4];
#pragma unroll
        for (int j = 0; j < 4; ++j) { const int col = 4 * lane + 256 * j; const f32x4 g = *(const f32x4*)(gain + col), s = *(const f32x4*)(mb + sc_off + col); gs[j] = g * (s + 1.0f); sh[j] = *(const f32x4*)(mb + sh_off + col); }
#pragma unroll 1
        for (int r = 0; r < 32; r += 4) {
            const size_t row = (size_t)ci * 32 + r; const f32x4* xr = (const f32x4*)(xin32 + row * DM) + lane; f32x4 v[4][4];
#pragma unroll
            for (int q = 0; q < 4; ++q)
#pragma unroll
                for (int j = 0; j < 4; ++j) v[q][j] = xr[q * (DM / 4) + 64 * j];
#pragma unroll
            for (int q = 0; q < 4; ++q) { float ss = 0.f;
#pragma unroll
                for (int j = 0; j < 4; ++j) ss += (v[q][j].x * v[q][j].x + v[q][j].y * v[q][j].y) + (v[q][j].z * v[q][j].z + v[q][j].w * v[q][j].w);
                const float rstd = 1.0f / sqrtf(wave_sum(ss) * (1.0f / DM) + RMS_EPS);
                v2u* o8 = (v2u*)(out + (row + q) * DM) + lane;
#pragma unroll
                for (int j = 0; j < 4; ++j) { const f32x4 y = v[q][j] * rstd * gs[j] + sh[j]; v2u w; w.x = pk2(y.x, y.y); w.y = pk2(y.z, y.w); o8[64 * j] = w; } }
        }
    }
}
__device__ __forceinline__ void final_norm_phase(const bf16* xs, float* out, const float* gain, int gw, int ngw, int lane) {
    f32x4 g[4];
#pragma unroll
    for (int j = 0; j < 4; ++j) g[j] = *(const f32x4*)(gain + 4 * lane + 256 * j);
#pragma unroll 1
    for (int row = 4 * gw; row < MT; row += 4 * ngw) {
        const v2u* xr = (const v2u*)(xs + (size_t)row * DM) + lane; v2u w[4][4];
#pragma unroll
        for (int q = 0; q < 4; ++q)
#pragma unroll
            for (int j = 0; j < 4; ++j) w[q][j] = xr[q * (DM / 4) + 64 * j];
#pragma unroll
        for (int q = 0; q < 4; ++q) { f32x4 v[4]; float ss = 0.f;
#pragma unroll
            for (int j = 0; j < 4; ++j) { const v2u ww = w[q][j]; v[j] = (f32x4){__uint_as_float(ww.x << 16), __uint_as_float(ww.x & 0xffff0000u), __uint_as_float(ww.y << 16), __uint_as_float(ww.y & 0xffff0000u)};
                ss += (v[j].x * v[j].x + v[j].y * v[j].y) + (v[j].z * v[j].z + v[j].w * v[j].w); }
            const float rstd = 1.0f / sqrtf(wave_sum(ss) * (1.0f / DM) + RMS_EPS);
            f32x4* o = (f32x4*)(out + (size_t)(row + q) * DM) + lane;
#pragma unroll
            for (int j = 0; j < 4; ++j) o[64 * j] = v[j] * rstd * g[j]; }
    }
}
__device__ __forceinline__ void panel_norm_rows(const bf16* xs, const float* gain, const float* modb, int sh_off, int sc_off, bf16* out, int pm, int wave, int lane) {
    f32x4 gs[4], sh[4];
#pragma unroll
    for (int j = 0; j < 4; ++j) { const int col = 4 * lane + 256 * j; const f32x4 g = *(const f32x4*)(gain + col), s = *(const f32x4*)(modb + sc_off + col); gs[j] = g * (s + 1.0f); sh[j] = *(const f32x4*)(modb + sh_off + col); }
#pragma unroll 1
    for (int r = 0; r < 32; r += 4) {
        const size_t row = (size_t)pm * 256 + wave * 32 + r;
        const v2u* xr = (const v2u*)(xs + row * DM) + lane; v2u w[4][4];
#pragma unroll
        for (int q = 0; q < 4; ++q)
#pragma unroll
            for (int j = 0; j < 4; ++j) w[q][j] = xr[q * (DM / 4) + 64 * j];
#pragma unroll
        for (int q = 0; q < 4; ++q) { f32x4 v[4]; float ss = 0.f;
#pragma unroll
            for (int j = 0; j < 4; ++j) { const v2u ww = w[q][j]; v[j] = (f32x4){__uint_as_float(ww.x << 16), __uint_as_float(ww.x & 0xffff0000u), __uint_as_float(ww.y << 16), __uint_as_float(ww.y & 0xffff0000u)};
                ss += (v[j].x * v[j].x + v[j].y * v[j].y) + (v[j].z * v[j].z + v[j].w * v[j].w); }
            const float rstd = __builtin_amdgcn_rsqf(wave_sum(ss) * (1.0f / DM) + RMS_EPS);
            v2u* o8 = (v2u*)(out + (row + q) * DM) + lane;
#pragma unroll
            for (int j = 0; j < 4; ++j) { const f32x4 y = v[j] * rstd * gs[j] + sh[j]; v2u ww; ww.x = pk2(y.x, y.y); ww.y = pk2(y.z, y.w); o8[64 * j] = ww; } }
    }
}
template <class Sched>
__device__ __forceinline__ void fused_panel_norm(const Sched& S, unsigned* cnt, const bf16* xs, const float* gain, const float* modl, int sh_off, int sc_off, bf16* out, int wave, int lane) {
    pg8::Unit u[4]; bool has[4];
#pragma unroll
    for (int i = 0; i < 4; ++i) has[i] = S.next(i, u[i]);
    if (wave == 0 && lane == 0) {
        __builtin_amdgcn_fence(__ATOMIC_RELEASE, "agent"); asm volatile("s_waitcnt vmcnt(0)" ::: "memory");
#pragma unroll
        for (int i = 0; i < 4; ++i) if (has[i]) __hip_atomic_fetch_add(cnt + 64 * u[i].pm, 1u, __ATOMIC_RELAXED, __HIP_MEMORY_SCOPE_AGENT);
    }
#pragma unroll
    for (int i = 0; i < 4; ++i) {
        if (!has[i] || u[i].pn != ((u[i].pm >> 3) & 3)) continue;
        if (wave == 0) { unsigned spins = 0u;
            while (__hip_atomic_load(cnt + 64 * u[i].pm, __ATOMIC_RELAXED, __HIP_MEMORY_SCOPE_AGENT) < 4u) { __builtin_amdgcn_s_sleep(2); if (++spins > (1u << 22)) break; }
            __builtin_amdgcn_fence(__ATOMIC_ACQUIRE, "agent"); asm volatile("s_waitcnt vmcnt(0)" ::: "memory"); }
        __syncthreads();
        panel_norm_rows(xs, gain, modl + (size_t)(u[i].pm >> 3) * MODP, sh_off, sc_off, out, u[i].pm, wave, lane);
#if PROBE_PN
        asm volatile("" ::: "memory"); panel_norm_rows(xs, gain, modl + (size_t)(u[i].pm >> 3) * MODP, sh_off, sc_off, out, u[i].pm, wave, lane);
#endif
    }
}
#define WG_BAR() do { asm volatile("s_waitcnt vmcnt(0) lgkmcnt(0)" ::: "memory"); __builtin_amdgcn_s_barrier(); asm volatile("" ::: "memory"); } while (0)
#define WG_BAR_L() do { asm volatile("s_waitcnt lgkmcnt(0)" ::: "memory"); __builtin_amdgcn_s_barrier(); asm volatile("" ::: "memory"); } while (0)
typedef short bf16x8p __attribute__((ext_vector_type(8)));
__device__ __forceinline__ void rwkv_prep_mfma(const bf16* proj, const float* mu, const float* w0, const float* a0, const bf16* WL, float* DEC, bf16* AA, bf16* GG, LAS unsigned char* lds, int wave) {
    constexpr int AP = 264;
    LAS bf16* act = (LAS bf16*)lds;
    bf16x8p bw[2][3], ba[2][3], bg[4][3];
    { const int lane = lane_id_opq(); const bf16* bfr = WL + (size_t)(48 * wave + (lane & 15)) * 256 + 8 * (lane >> 4);
#pragma unroll
      for (int nt = 0; nt < 3; ++nt) {
#pragma unroll
          for (int ks = 0; ks < 2; ++ks) { bw[ks][nt] = *(const bf16x8p*)(bfr + 16 * nt * 256 + 32 * ks); ba[ks][nt] = *(const bf16x8p*)(bfr + 16 * nt * 256 + 64 + 32 * ks); }
#pragma unroll
          for (int ks = 0; ks < 4; ++ks) bg[ks][nt] = *(const bf16x8p*)(bfr + 16 * nt * 256 + 128 + 32 * ks); } }
#pragma unroll 1
    for (int item = blockIdx.x; item < MT / 64; item += gridDim.x) {
        const int lane = lane_id_opq(), tid = wave * 64 + lane, q4 = lane >> 4, lc = lane & 15;
        const size_t m0 = (size_t)item * 64; const int t0 = (int)(m0 % SEQ);
        { const int tt = tid >> 3, cg = tid & 7; const bf16* p = proj + (m0 + tt) * NPI + RW_B + 1152 + 32 * cg; const bool hp = (t0 + tt) > 0; const bf16* pp = hp ? p - NPI : p; const float* mup = mu + 1152 + 32 * cg;
          v4u cur[4], prv[4]; f32x4 m0v[4], m1v[4];
#pragma unroll
          for (int v = 0; v < 4; ++v) { cur[v] = *(const v4u*)(p + 8 * v); prv[v] = *(const v4u*)(pp + 8 * v); m0v[v] = *(const f32x4*)(mup + 8 * v); m1v[v] = *(const f32x4*)(mup + 8 * v + 4); }
#pragma unroll
          for (int v = 0; v < 4; ++v) {
              float x[8];
#pragma unroll
              for (int e = 0; e < 4; ++e) { const unsigned cw = cur[v][e], pw = hp ? prv[v][e] : 0u; const float c0 = __uint_as_float(cw << 16), c1 = __uint_as_float(cw & 0xffff0000u), p0 = __uint_as_float(pw << 16), p1 = __uint_as_float(pw & 0xffff0000u);
                  const float mu0 = e < 2 ? m0v[v][2 * e] : m1v[v][2 * e - 4], mu1 = e < 2 ? m0v[v][2 * e + 1] : m1v[v][2 * e - 3];
                  x[2 * e] = c0 + (p0 - c0) * mu0; x[2 * e + 1] = c1 + (p1 - c1) * mu1; }
              if (cg < 2) {
#pragma unroll
                  for (int e = 0; e < 8; ++e) x[e] = 2.0f * fsigmoid(2.0f * x[e]) - 1.0f;
              } else if (cg >= 4) {
#pragma unroll
                  for (int e = 0; e < 8; ++e) x[e] = fsigmoid(x[e]);
              }
              v4u o; o.x = pk2(x[0], x[1]); o.y = pk2(x[2], x[3]); o.z = pk2(x[4], x[5]); o.w = pk2(x[6], x[7]);
              *(LAS v4u*)(act + tt * AP + 32 * cg + 8 * v) = o; } }
        WG_BAR_L();
        const LAS bf16* afr = act + lc * AP + 8 * q4;
        { f32x4 acc[4][3];
#pragma unroll
          for (int mt = 0; mt < 4; ++mt)
#pragma unroll
              for (int nt = 0; nt < 3; ++nt) acc[mt][nt] = (f32x4){0.f, 0.f, 0.f, 0.f};
#pragma unroll
          for (int ks = 0; ks < 2; ++ks)
#pragma unroll
              for (int mt = 0; mt < 4; ++mt) { const bf16x8p aq = *(const LAS bf16x8p*)(afr + 16 * mt * AP + 32 * ks);
#pragma unroll
                  for (int nt = 0; nt < 3; ++nt) acc[mt][nt] = __builtin_amdgcn_mfma_f32_16x16x32_bf16(aq, bw[ks][nt], acc[mt][nt], 0, 0, 0); }
#pragma unroll
          for (int nt = 0; nt < 3; ++nt) { const int n = 48 * wave + 16 * nt + lc; const float w0n = w0[n]; float carry = 0.f;
#pragma unroll
              for (int mt = 0; mt < 4; ++mt) { float pr[4];
#pragma unroll
                  for (int r = 0; r < 4; ++r) { const float ld = -0.60653066f * fsigmoid(w0n + acc[mt][nt][r]); pr[r] = r ? pr[r - 1] + ld : ld; }
                  const float tot = pr[3]; float s1 = tot; { const float u = __shfl_up(s1, 16); if (q4 >= 1) s1 += u; } { const float u = __shfl_up(s1, 32); if (q4 >= 2) s1 += u; }
                  const float excl = carry + (s1 - tot), tile_tot = __shfl(s1, 48 + lc);
                  float* dp = DEC + (m0 + 16 * mt + 4 * q4) * 384 + n;
#pragma unroll
                  for (int r = 0; r < 4; ++r) dp[r * 384] = excl + pr[r];
                  carry += tile_tot; } } }
        { f32x4 acc[4][3];
#pragma unroll
          for (int mt = 0; mt < 4; ++mt)
#pragma unroll
              for (int nt = 0; nt < 3; ++nt) acc[mt][nt] = (f32x4){0.f, 0.f, 0.f, 0.f};
#pragma unroll
          for (int ks = 0; ks < 2; ++ks)
#pragma unroll
              for (int mt = 0; mt < 4; ++mt) { const bf16x8p aq = *(const LAS bf16x8p*)(afr + 16 * mt * AP + 64 + 32 * ks);
#pragma unroll
                  for (int nt = 0; nt < 3; ++nt) acc[mt][nt] = __builtin_amdgcn_mfma_f32_16x16x32_bf16(ba[ks][nt], aq, acc[mt][nt], 0, 0, 0); }
#pragma unroll
          for (int nt = 0; nt < 3; ++nt) { const int n = 48 * wave + 16 * nt + 4 * q4; const f32x4 a0n = *(const f32x4*)(a0 + n);
#pragma unroll
              for (int mt = 0; mt < 4; ++mt) { v2u w; w.x = pk2(fsigmoid(a0n.x + acc[mt][nt][0]), fsigmoid(a0n.y + acc[mt][nt][1])); w.y = pk2(fsigmoid(a0n.z + acc[mt][nt][2]), fsigmoid(a0n.w + acc[mt][nt][3]));
                  *(v2u*)(AA + (m0 + 16 * mt + lc) * 384 + n) = w; } } }
        { f32x4 acc[4][3];
#pragma unroll
          for (int mt = 0; mt < 4; ++mt)
#pragma unroll
              for (int nt = 0; nt < 3; ++nt) acc[mt][nt] = (f32x4){0.f, 0.f, 0.f, 0.f};
#pragma unroll
          for (int ks = 0; ks < 4; ++ks)
#pragma unroll
              for (int mt = 0; mt < 4; ++mt) { const bf16x8p aq = *(const LAS bf16x8p*)(afr + 16 * mt * AP + 128 + 32 * ks);
#pragma unroll
                  for (int nt = 0; nt < 3; ++nt) acc[mt][nt] = __builtin_amdgcn_mfma_f32_16x16x32_bf16(bg[ks][nt], aq, acc[mt][nt], 0, 0, 0); }
#pragma unroll
          for (int nt = 0; nt < 3; ++nt) { const int n = 48 * wave + 16 * nt + 4 * q4;
#pragma unroll
              for (int mt = 0; mt < 4; ++mt) { v2u w; w.x = pk2(acc[mt][nt][0], acc[mt][nt][1]); w.y = pk2(acc[mt][nt][2], acc[mt][nt][3]);
                  *(v2u*)(GG + (m0 + 16 * mt + lc) * 384 + n) = w; } } }
        WG_BAR_L();
    }
}
typedef short bf16x8_t __attribute__((ext_vector_type(8)));
template <int KS>
__device__ __forceinline__ f32x4 mm_tile(const LAS bf16* A, const LAS bf16* B, f32x4 acc) {
#pragma unroll
    for (int ks = 0; ks < KS; ++ks) {
        const bf16x8_t a = *(const LAS bf16x8_t*)(A + ks * 32), b = *(const LAS bf16x8_t*)(B + ks * 32);
        acc = __builtin_amdgcn_mfma_f32_16x16x32_bf16(a, b, acc, 0, 0, 0);
    }
    return acc;
}
__device__ __forceinline__ unsigned short f2bf16(float f) { return (unsigned short)f2bf(f); }
constexpr int LP = 72;
constexpr int LPM = 104;

__device__ __forceinline__ void ret_unit(int b, int h, const bf16* proj, const float* gn, bf16* mixed, LAS unsigned char* lds, int wave, int lane0) {
    LAS bf16* Qs = (LAS bf16*)lds; LAS bf16* Ks = Qs + 64 * LP; LAS bf16* Kdt = Ks + 64 * LP; LAS bf16* Vt = Kdt + 64 * LP; LAS bf16* Ps = Vt + 64 * LP; LAS bf16* Stt = Ps + 64 * LP; LAS bf16* Gs = Stt + 64 * LP;
    const int lane = lane0, q4 = lane >> 4, lc = lane & 15;
    const float inv = powf(10000.0f, -(float)(2 * (lane & 31)) / 64.0f);
    float cs[8], sn[8];
#pragma unroll
    for (int i = 0; i < 8; ++i) __sincosf((float)(8 * wave + i) * inv, &sn[i], &cs[i]);
    float c64, s64; sincosf(64.0f * inv, &s64, &c64);
    const float lg2 = log2f(1.0f - exp2f(-5.0f - (float)h));
    float kdec[8];
#pragma unroll
    for (int i = 0; i < 8; ++i) kdec[i] = exp2f((float)(63 - (8 * wave + i)) * lg2);
    const float cd = exp2f(64.0f * lg2);
    f32x4 st[4];
#pragma unroll
    for (int i = 0; i < 4; ++i) st[i] = (f32x4){0.f, 0.f, 0.f, 0.f};
    for (int i = wave * 64 + lane; i < 64 * LP / 2; i += 512) ((LAS unsigned*)Stt)[i] = 0u;
    const size_t m0 = (size_t)b * SEQ;
    const bf16* P0 = proj + m0 * NPI + h * 64;
    unsigned short rq[8], rk[8], rv[8], rg[8];
#pragma unroll
    for (int i = 0; i < 8; ++i) { const bf16* p = P0 + (size_t)(8 * wave + i) * NPI; rq[i] = p[lane]; rk[i] = p[256 + lane]; rv[i] = p[512 + lane]; rg[i] = p[768 + lane]; }
    float gain4[4];
#pragma unroll
    for (int ct = 0; ct < 4; ++ct) gain4[ct] = gn[h * 64 + 16 * ct + lc];
    float dmk[2][4], qdk[4];
#pragma unroll
    for (int u = 0; u < 2; ++u)
#pragma unroll
        for (int r = 0; r < 4; ++r) { const int l = 16 * (wave >> 1) + 4 * q4 + r, m = 16 * (2 * (wave & 1) + u) + lc; dmk[u][r] = (l >= m) ? exp2f((float)(l - m) * lg2) : 0.f; }
#pragma unroll
    for (int r = 0; r < 4; ++r) qdk[r] = exp2f((float)(16 * (wave & 3) + 4 * q4 + r + 1) * lg2);
#pragma unroll 1
    for (int c = 0; c < SEQ / 64; ++c) {
        const int lane = lane_id_opq(), q4 = lane >> 4, lc = lane & 15, o72 = lc * LP + 8 * q4;
        { unsigned short kd[8];
#pragma unroll
          for (int i = 0; i < 8; ++i) { const int tt = 8 * wave + i;
              const float q = bf2f(rq[i]), k = bf2f(rk[i]); const float qp = __shfl_xor(q, 32), kp = __shfl_xor(k, 32);
              const float qr = lane < 32 ? q * cs[i] - qp * sn[i] : qp * sn[i] + q * cs[i];
              const float kr = (lane < 32 ? k * cs[i] - kp * sn[i] : kp * sn[i] + k * cs[i]) * 0.125f;
              Qs[tt * LP + lane] = f2bf16(qr); Ks[tt * LP + lane] = f2bf16(kr); Gs[tt * LP + lane] = rg[i]; kd[i] = f2bf16(kr * kdec[i]);
              const float cn = cs[i] * c64 - sn[i] * s64, snn = sn[i] * c64 + cs[i] * s64; cs[i] = cn; sn[i] = snn; }
          v4u w; w.x = kd[0] | ((unsigned)kd[1] << 16); w.y = kd[2] | ((unsigned)kd[3] << 16); w.z = kd[4] | ((unsigned)kd[5] << 16); w.w = kd[6] | ((unsigned)kd[7] << 16);
          *(LAS v4u*)(Kdt + lane * LP + 8 * wave) = w;
          w.x = rv[0] | ((unsigned)rv[1] << 16); w.y = rv[2] | ((unsigned)rv[3] << 16); w.z = rv[4] | ((unsigned)rv[5] << 16); w.w = rv[6] | ((unsigned)rv[7] << 16);
          *(LAS v4u*)(Vt + lane * LP + 8 * wave) = w; }
        WG_BAR_L();
        if (c + 1 < SEQ / 64) {
#pragma unroll
            for (int i = 0; i < 8; ++i) { const bf16* p = P0 + (size_t)(64 * (c + 1) + 8 * wave + i) * NPI; rq[i] = p[lane]; rk[i] = p[256 + lane]; rv[i] = p[512 + lane]; rg[i] = p[768 + lane]; } }
        { const int rt = wave >> 1;
#pragma unroll
          for (int u = 0; u < 2; ++u) { const int ct = 2 * (wave & 1) + u;
              f32x4 s = (f32x4){0.f, 0.f, 0.f, 0.f};
              if (ct <= rt) s = mm_tile<2>(Qs + 16 * rt * LP + o72, Ks + 16 * ct * LP + o72, s);
#pragma unroll
              for (int r = 0; r < 4; ++r) { const int l = 16 * rt + 4 * q4 + r, m = 16 * ct + lc; Ps[l * LP + m] = f2bf16(s[r] * dmk[u][r]); } } }
        f32x4 inter[4];
        if (wave < 4) {
#pragma unroll
            for (int ct = 0; ct < 4; ++ct) inter[ct] = mm_tile<2>(Qs + 16 * wave * LP + o72, Stt + 16 * ct * LP + o72, (f32x4){0.f, 0.f, 0.f, 0.f}); }
        WG_BAR_L();
        if (wave < 4) {
            f32x4 y[4];
#pragma unroll
            for (int ct = 0; ct < 4; ++ct) y[ct] = mm_tile<2>(Ps + 16 * wave * LP + o72, Vt + 16 * ct * LP + o72, (f32x4){0.f, 0.f, 0.f, 0.f});
#pragma unroll
            for (int r = 0; r < 4; ++r) { const int l = 16 * wave + 4 * q4 + r; const float qd = qdk[r];
                float s = 0.f;
#pragma unroll
                for (int ct = 0; ct < 4; ++ct) { y[ct][r] += qd * inter[ct][r]; s += y[ct][r]; }
                const float mean = sum16(s) * (1.0f / 64.0f); float qv = 0.f;
#pragma unroll
                for (int ct = 0; ct < 4; ++ct) { const float dd = y[ct][r] - mean; qv += dd * dd; }
                const float rstd = __builtin_amdgcn_rsqf(sum16(qv) * (1.0f / 64.0f) + GN_EPS);
                bf16* orow = mixed + (m0 + 64 * c + l) * DM + h * 64 + lc;
#pragma unroll
                for (int ct = 0; ct < 4; ++ct) { const float g = bf2f(Gs[l * LP + 16 * ct + lc]); orow[16 * ct] = f2bf16((y[ct][r] - mean) * rstd * gain4[ct] * (g * fsigmoid(g))); } }
        } else {
            const int dt = wave - 4;
#pragma unroll
            for (int ct = 0; ct < 4; ++ct) { st[ct] = mm_tile<2>(Kdt + 16 * dt * LP + o72, Vt + 16 * ct * LP + o72, st[ct] * cd);
                v2u w; w.x = pk2(st[ct][0], st[ct][1]); w.y = pk2(st[ct][2], st[ct][3]);
                *(LAS v2u*)(Stt + (16 * ct + lc) * LP + 16 * dt + 4 * q4) = w; }
        }
        WG_BAR_L();
    }
}

__device__ __forceinline__ void mlstm_unit(int b, int h, const bf16* proj, const float* conv_w, const float* conv_b, const float* i_b, const float* f_b, const float* gn, bf16* mixed,
                                           LAS unsigned char* lds, int wave, int lane0) {
    LAS bf16* Qs = (LAS bf16*)lds; LAS bf16* Ks = Qs + 64 * LPM; LAS bf16* Kdt = Ks + 64 * LPM; LAS bf16* Vt = Kdt + 96 * LP; LAS bf16* Ps = Vt + 112 * LP; LAS bf16* Stt = Ps + 64 * LP; LAS bf16* Os = Stt + 112 * LPM;
    LAS float* ev = (LAS float*)(Os + 64 * LPM); LAS float* pmv = ev + 64; LAS float* flv = pmv + 64;
    const int lane = lane0, lc = lane & 15;
    float wq0[4], wq1[4], wk0[4], wk1[4], bq0, bq1, bk0, bk1;
    { const int cq = h * 96 + (lane < 48 ? 2 * lane : 0), ck = 384 + cq;
#pragma unroll
    for (int j = 0; j < 4; ++j) { wq0[j] = conv_w[j * 768 + cq]; wq1[j] = conv_w[j * 768 + cq + 1]; wk0[j] = conv_w[j * 768 + ck]; wk1[j] = conv_w[j * 768 + ck + 1]; }
    bq0 = conv_b[cq]; bq1 = conv_b[cq + 1]; bk0 = conv_b[ck]; bk1 = conv_b[ck + 1]; }
    const float ib = i_b[h], fb = f_b[h];
    const float ksc = 0.10206207261596577f;
    f32x4 st[11];
#pragma unroll
    for (int i = 0; i < 11; ++i) st[i] = (f32x4){0.f, 0.f, 0.f, 0.f};
    for (int i = wave * 64 + lane; i < 112 * LPM / 2; i += 512) ((LAS unsigned*)Stt)[i] = 0u;
    for (int i = wave * 64 + lane; i < 16 * LP / 2; i += 512) ((LAS unsigned*)(Vt + 96 * LP))[i] = (i < LP / 2) ? 0x3f803f80u : 0u;
    float mprev = 0.f;
    const size_t m0 = (size_t)b * SEQ;
    const bf16* PB = proj + m0 * NPI + ML_B;
    float gain6[6];
#pragma unroll
    for (int ct = 0; ct < 6; ++ct) gain6[ct] = gn[640 + h * 96 + 16 * ct + lc];
    unsigned xq[11], xk[11], vv[8], og[8]; unsigned short gi, gf;
#define ML_LOAD(cc) do { const int tb_ = 64 * (cc) + 8 * wave; \
        _Pragma("unroll") for (int i = 0; i < 11; ++i) { const int t_ = tb_ - 3 + i; const bf16* p_ = PB + (size_t)(t_ < 0 ? 0 : t_) * NPI + cq; xq[i] = *(const unsigned*)p_; xk[i] = *(const unsigned*)(p_ + 384); } \
        _Pragma("unroll") for (int i = 0; i < 8; ++i) { const bf16* p_ = PB + (size_t)(tb_ + i) * NPI + 768 + cq; vv[i] = *(const unsigned*)p_; og[i] = *(const unsigned*)(p_ + 384); } \
        { const bf16* p_ = PB + (size_t)(64 * (cc) + lane) * NPI; gi = p_[1536 + h]; gf = p_[1540 + h]; } } while (0)
    { const int cq = h * 96 + (lane < 48 ? 2 * lane : 0); ML_LOAD(0); }
#pragma unroll 1
    for (int c = 0; c < SEQ / 64; ++c) {
        const int lane = lane_id_opq(), q4 = lane >> 4, lc = lane & 15, o72 = lc * LP + 8 * q4, o104 = lc * LPM + 8 * q4;
        const bool act = lane < 48; const int dd = act ? 2 * lane : 0, cq = h * 96 + dd;
        const int tb = 64 * c + 8 * wave;
        float pm63, carry, ev_l; const float mold = mprev;
        { const float ic = __uint_as_float((unsigned)gi << 16) + ib, lf = flogsigmoid(__uint_as_float((unsigned)gf << 16) + fb);
          const float bc = wave_prefix_sum(lf), e = ic - bc; const float pm = fmaxf(wave_prefix_max(e), mprev);
          pm63 = __builtin_bit_cast(float, __builtin_amdgcn_readlane(__builtin_bit_cast(int, pm), 63)); carry = fexp(mprev - pm63); ev_l = e;
          if (wave == 0) { ev[lane] = e; pmv[lane] = pm; flv[lane] = fexp(-(bc + pm)); }
          mprev = __builtin_bit_cast(float, __builtin_amdgcn_readlane(__builtin_bit_cast(int, bc), 63)) + pm63; }
        { unsigned short kd0[8], kd1[8];
          if (tb == 0) { xq[0] = xq[1] = xq[2] = 0u; xk[0] = xk[1] = xk[2] = 0u; }
#pragma unroll
          for (int i = 0; i < 8; ++i) { const int tt = 8 * wave + i;
#define LO_(w) __uint_as_float((w) << 16)
#define HI_(w) __uint_as_float((w) & 0xffff0000u)
              float q0 = bq0 + LO_(xq[i]) * wq0[0] + LO_(xq[i + 1]) * wq0[1] + LO_(xq[i + 2]) * wq0[2] + LO_(xq[i + 3]) * wq0[3];
              float k0 = bk0 + LO_(xk[i]) * wk0[0] + LO_(xk[i + 1]) * wk0[1] + LO_(xk[i + 2]) * wk0[2] + LO_(xk[i + 3]) * wk0[3];
              float q1 = bq1 + HI_(xq[i]) * wq1[0] + HI_(xq[i + 1]) * wq1[1] + HI_(xq[i + 2]) * wq1[2] + HI_(xq[i + 3]) * wq1[3];
              float k1 = bk1 + HI_(xk[i]) * wk1[0] + HI_(xk[i + 1]) * wk1[1] + HI_(xk[i + 2]) * wk1[2] + HI_(xk[i + 3]) * wk1[3];
#undef LO_
#undef HI_
              q0 = q0 * fsigmoid(q0); k0 = k0 * fsigmoid(k0) * ksc; q1 = q1 * fsigmoid(q1); k1 = k1 * fsigmoid(k1) * ksc;
              const float wsi = fexp(__builtin_bit_cast(float, __builtin_amdgcn_readlane(__builtin_bit_cast(int, ev_l), tt)) - pm63);
              kd0[i] = f2bf16(k0 * wsi); kd1[i] = f2bf16(k1 * wsi);
              if (act) { *(LAS unsigned*)(Qs + tt * LPM + dd) = pk2(q0, q1); *(LAS unsigned*)(Ks + tt * LPM + dd) = pk2(k0, k1); } }
          if (act) {
              v4u w; w.x = kd0[0] | ((unsigned)kd0[1] << 16); w.y = kd0[2] | ((unsigned)kd0[3] << 16); w.z = kd0[4] | ((unsigned)kd0[5] << 16); w.w = kd0[6] | ((unsigned)kd0[7] << 16);
              *(LAS v4u*)(Kdt + dd * LP + 8 * wave) = w;
              w.x = kd1[0] | ((unsigned)kd1[1] << 16); w.y = kd1[2] | ((unsigned)kd1[3] << 16); w.z = kd1[4] | ((unsigned)kd1[5] << 16); w.w = kd1[6] | ((unsigned)kd1[7] << 16);
              *(LAS v4u*)(Kdt + (dd + 1) * LP + 8 * wave) = w;
              w.x = (vv[0] & 0xffffu) | (vv[1] << 16); w.y = (vv[2] & 0xffffu) | (vv[3] << 16); w.z = (vv[4] & 0xffffu) | (vv[5] << 16); w.w = (vv[6] & 0xffffu) | (vv[7] << 16);
              *(LAS v4u*)(Vt + dd * LP + 8 * wave) = w;
              w.x = (vv[0] >> 16) | (vv[1] & 0xffff0000u); w.y = (vv[2] >> 16) | (vv[3] & 0xffff0000u); w.z = (vv[4] >> 16) | (vv[5] & 0xffff0000u); w.w = (vv[6] >> 16) | (vv[7] & 0xffff0000u);
              *(LAS v4u*)(Vt + (dd + 1) * LP + 8 * wave) = w; } }
        WG_BAR_L();
        unsigned ogc[8];
#pragma unroll
        for (int i = 0; i < 8; ++i) ogc[i] = og[i];
        if (c + 1 < SEQ / 64) ML_LOAD(c + 1);
        { const int rt = wave >> 1;
#pragma unroll
          for (int u = 0; u < 2; ++u) { const int ct = 2 * (wave & 1) + u;
              f32x4 s = (f32x4){0.f, 0.f, 0.f, 0.f};
              if (ct <= rt) s = mm_tile<3>(Qs + 16 * rt * LPM + o104, Ks + 16 * ct * LPM + o104, s);
              const float em = ev[16 * ct + lc];
#pragma unroll
              for (int r = 0; r < 4; ++r) { const int l = 16 * rt + 4 * q4 + r, m = 16 * ct + lc; const float val = (l >= m) ? s[r] * fexp(em - pmv[l]) : 0.f; Ps[l * LP + m] = f2bf16(val); } } }
        f32x4 inter[7];
        if (wave < 4) {
#pragma unroll
            for (int ct = 0; ct < 7; ++ct) inter[ct] = mm_tile<3>(Qs + 16 * wave * LPM + o104, Stt + 16 * ct * LPM + o104, (f32x4){0.f, 0.f, 0.f, 0.f}); }
#pragma unroll
        for (int i = 0; i < 8; ++i) if (act) *(LAS unsigned*)(Os + (8 * wave + i) * LPM + dd) = ogc[i];
        WG_BAR_L();
        if (wave < 4) {
            f32x4 y[7];
#pragma unroll
            for (int ct = 0; ct < 7; ++ct) y[ct] = mm_tile<2>(Ps + 16 * wave * LP + o72, Vt + 16 * ct * LP + o72, (f32x4){0.f, 0.f, 0.f, 0.f});
#pragma unroll
            for (int r = 0; r < 4; ++r) { const int l = 16 * wave + 4 * q4 + r; const float iw = fexp(mold - pmv[l]);
#pragma unroll
                for (int ct = 0; ct < 7; ++ct) y[ct][r] += iw * inter[ct][r];
                const float den = __shfl(y[6][r], lane & 48);
                const float dn = __builtin_amdgcn_rcpf(fmaxf(fabsf(den), flv[l]));
                float s = 0.f;
#pragma unroll
                for (int ct = 0; ct < 6; ++ct) { y[ct][r] *= dn; s += y[ct][r]; }
                const float mean = sum16(s) * (1.0f / 96.0f); float qv = 0.f;
#pragma unroll
                for (int ct = 0; ct < 6; ++ct) { const float dd = y[ct][r] - mean; qv += dd * dd; }
                const float rstd = __builtin_amdgcn_rsqf(sum16(qv) * (1.0f / 96.0f) + GN_EPS);
                bf16* orow = mixed + (m0 + 64 * c + l) * DM + 640 + h * 96 + lc;
#pragma unroll
                for (int ct = 0; ct < 6; ++ct) { const float o = bf2f(Os[l * LPM + 16 * ct + lc]); orow[16 * ct] = f2bf16((y[ct][r] - mean) * rstd * gain6[ct] * fsigmoid(o)); } }
        } else {
#pragma unroll
            for (int i = 0; i < 11; ++i) { const int t = (wave - 4) + 4 * i;
                if (t < 42) { const int dt = t / 7, et = t % 7;
                    st[i] = mm_tile<2>(Kdt + 16 * dt * LP + o72, Vt + 16 * et * LP + o72, st[i] * carry);
                    v2u w; w.x = pk2(st[i][0], st[i][1]); w.y = pk2(st[i][2], st[i][3]);
                    *(LAS v2u*)(Stt + (16 * et + lc) * LPM + 16 * dt + 4 * q4) = w; } }
        }
        WG_BAR_L();
    }
#undef ML_LOAD
}
#ifndef RW_DBG
#define RW_DBG 0xFF
#endif
__device__ __forceinline__ void rwkv_unit(int b, int h, const bf16* proj, const float* CUM, const bf16* AA, const bf16* GG, const float* mu, const float* k_k, const float* k_a, const float* r_k,
                                          const float* gn, bf16* mixed, LAS unsigned char* lds, int wave, int lane0,
                                          int cb, int ce, const float* hs_in, unsigned* flag_in, float* hs_out, unsigned* flag_out) {
    constexpr int SLOT = 64 * LP;
    LAS bf16* KH = (LAS bf16*)lds; LAS bf16* BH = KH + SLOT; LAS bf16* KT = BH + SLOT; LAS bf16* RT = KT + SLOT; LAS bf16* KHgt = RT + SLOT; LAS bf16* BHgtn = KHgt + SLOT;
    LAS bf16* Vt = BHgtn + SLOT; LAS bf16* AkT = Vt + SLOT; LAS bf16* BbTn = AkT + SLOT; LAS bf16* BkT = BbTn + SLOT; LAS bf16* S0b = BkT + SLOT; LAS bf16* Loffb = S0b + SLOT; LAS bf16* Vr = Loffb + SLOT; LAS bf16* Gr = Vr + SLOT;
    LAS float* RHS = (LAS float*)KH; LAS bf16* Ut = KT;
    LAS float* LTd = (LAS float*)(Gr + SLOT);
    LAS float* XS = LTd + 64 * 20;
    LAS float* GCv = XS + 16 * 64; LAS float* bonv = GCv + 64;
    LAS float* bonv2 = bonv + 64; LAS float* bonv3 = bonv2 + 64; LAS bf16* Vr2 = (LAS bf16*)(bonv3 + 64); LAS bf16* Gr2 = Vr2 + SLOT;
    float mu_r, mu_k, mu_v, kkc, kac, rkc;
    { const int c0 = h * 64 + lane0; mu_r = mu[c0]; mu_k = mu[384 + c0]; mu_v = mu[768 + c0]; kkc = k_k[c0]; kac = k_a[c0]; rkc = r_k[c0]; }
    for (int i = wave * 64 + lane0; i < 5 * SLOT / 2; i += 512) ((LAS unsigned*)AkT)[i] = 0u;
    float gain4[4];
#pragma unroll
    for (int ct = 0; ct < 4; ++ct) gain4[ct] = gn[256 + h * 64 + 16 * ct + (lane0 & 15)];
    f32x4 sacc[4];
#pragma unroll
    for (int i = 0; i < 4; ++i) sacc[i] = (f32x4){0.f, 0.f, 0.f, 0.f};
    if (hs_in) {
        if (wave == 0) { unsigned spins = 0u;
            while (__hip_atomic_load(flag_in, __ATOMIC_RELAXED, __HIP_MEMORY_SCOPE_AGENT) == 0u) { __builtin_amdgcn_s_sleep(4); if (++spins > (1u << 22)) break; }
            __builtin_amdgcn_fence(__ATOMIC_ACQUIRE, "agent"); asm volatile("s_waitcnt vmcnt(0)" ::: "memory"); }
        WG_BAR();
        if (wave < 4) {
#pragma unroll
            for (int jt = 0; jt < 4; ++jt) {
#pragma unroll
                for (int r = 0; r < 4; ++r) { sacc[jt][r] = hs_in[(wave * 4 + jt) * 256 + r * 64 + lane0];
                    S0b[(16 * wave + 4 * (lane0 >> 4) + r) * LP + 16 * jt + (lane0 & 15)] = f2bf16(sacc[jt][r]); } } }
    }
    const size_t m0 = (size_t)b * SEQ;
    const bf16* PU = proj + m0 * NPI + RW_B + h * 64;
    const float* CU = CUM + m0 * 384 + h * 64; const bf16* AU = AA + m0 * 384 + h * 64; const bf16* GU = GG + m0 * 384 + h * 64;
    const bool own = wave != 0 && wave != 4; const int T2 = wave < 4 ? 2 * wave : 32 + 2 * (wave - 4);
    unsigned short rr[9], rk[9], rv[9], ra[8], rg[8]; float rc[9], rc63;
    unsigned short qr[3], qk[3], qv[3], qa[2], qg[2]; float qc[3], qc63;
    unsigned o_kb[8], o_tr[8], o_vg[8]; v4u o_khg, o_bhg, o_vs;
#pragma unroll
    for (int i = 0; i < 8; ++i) { o_kb[i] = 0u; o_tr[i] = 0u; o_vg[i] = 0u; }
    o_khg = (v4u){0u, 0u, 0u, 0u}; o_bhg = o_khg; o_vs = o_khg;
#define RWKV_LOAD(cc) do { const int tb_ = 64 * (cc) + 8 * wave; \
        _Pragma("unroll") for (int i = 0; i < 9; ++i) { const int t_ = tb_ - 1 + i; const bf16* p_ = PU + (size_t)t_ * NPI; \
            rr[i] = p_[lane]; rk[i] = p_[384 + lane]; rv[i] = p_[768 + lane]; \
            rc[i] = CU[(size_t)t_ * 384 + lane]; if (i > 0) { ra[i - 1] = AU[(size_t)t_ * 384 + lane]; rg[i - 1] = GU[(size_t)t_ * 384 + lane]; } } \
        rc63 = CU[(size_t)(64 * (cc) + 63) * 384 + lane]; } while (0)
#define RWKV_LOAD2(cc) do { const int t0_ = 64 * (cc) + T2; \
        _Pragma("unroll") for (int i = 0; i < 3; ++i) { const int t_ = t0_ - 1 + i; const bool ok_ = t_ >= 0; const bf16* p_ = PU + (size_t)(ok_ ? t_ : 0) * NPI; \
            qr[i] = ok_ ? p_[lane] : (unsigned short)0; qk[i] = ok_ ? p_[384 + lane] : (unsigned short)0; qv[i] = ok_ ? p_[768 + lane] : (unsigned short)0; \
            qc[i] = (i > 0 || T2 > 0) ? CU[(size_t)(ok_ ? t_ : 0) * 384 + lane] : 0.f; if (i > 0) { qa[i - 1] = AU[(size_t)t_ * 384 + lane]; qg[i - 1] = GU[(size_t)t_ * 384 + lane]; } } \
        qc63 = CU[(size_t)(64 * (cc) + 63) * 384 + lane]; } while (0)
#define RW_TOK(RP, RC, KP, KC, AC, CM, ECP, f_kh, f_bh, f_kt, f_rt, f_khg, f_bhg, f_bon) do { \
        const float cr_ = bf2f(RC), ck_ = bf2f(KC); \
        const float r_ = cr_ + (bf2f(RP) - cr_) * mu_r, k_ = ck_ + (bf2f(KP) - ck_) * mu_k, a_ = bf2f(AC); \
        float kk_ = k_ * kkc; kk_ = kk_ * __builtin_amdgcn_rsqf(fmaxf(wave_sum(kk_ * kk_), 1e-24f));       \
        const float kmod_ = k_ * (1.0f + (a_ - 1.0f) * kac), beta_ = kk_ * a_; \
        f_bon = wave_sum(r_ * kmod_ * rkc); \
        const float em_ = fexp(-(CM)), eg_ = gc63 * em_, ec_ = __builtin_amdgcn_rcpf(em_);     \
        f_kh = kmod_ * em_; f_bh = beta_ * em_; f_kt = kk_ * (ECP); f_rt = r_ * ec_; f_khg = kmod_ * eg_; f_bhg = -beta_ * eg_; (ECP) = ec_; } while (0)
    { const int lane = lane0; if (own) RWKV_LOAD(cb); }
    f32x4 yp[4];
#pragma unroll
    for (int i = 0; i < 4; ++i) yp[i] = (f32x4){0.f, 0.f, 0.f, 0.f};
#define RW_EPILOGUE(yy, cc, VrB, GrB, bonB, q4_, lc_) do { _Pragma("unroll") for (int r = 0; r < 4; ++r) { const int t = 16 * (wave - 4) + 4 * (q4_) + r; const size_t row = m0 + 64 * (cc) + t; \
            float s_ = 0.f; _Pragma("unroll") for (int ct = 0; ct < 4; ++ct) s_ += yy[ct][r]; \
            const float mean = sum16(s_) * (1.0f / 64.0f); float qv = 0.f; \
            _Pragma("unroll") for (int ct = 0; ct < 4; ++ct) { const float dd = yy[ct][r] - mean; qv += dd * dd; } \
            const float rstd = __builtin_amdgcn_rsqf(sum16(qv) * (1.0f / 64.0f) + GN_EPS); \
            const float bon = (bonB)[t]; bf16* orow = mixed + row * DM + 256 + h * 64 + (lc_); \
            _Pragma("unroll") for (int ct = 0; ct < 4; ++ct) orow[16 * ct] = f2bf16(((yy[ct][r] - mean) * rstd * gain4[ct] + bon * bf2f((VrB)[t * LP + 16 * ct + (lc_)])) * bf2f((GrB)[t * LP + 16 * ct + (lc_)])); } } while (0)
#pragma unroll 1
    for (int c = cb - 1; c < ce; ++c) {
        const bool live = c >= cb;
        const int lane = lane_id_opq(), q4 = lane >> 4, lc = lane & 15, o72 = lc * LP + 8 * q4;
        LAS bf16* VrC = (c & 1) ? Vr2 : Vr; LAS bf16* GrC = (c & 1) ? Gr2 : Gr; LAS float* bonC = bonv + 64 * ((c + 3) % 3);
        LAS bf16* VrP = (c & 1) ? Vr : Vr2; LAS bf16* GrP = (c & 1) ? Gr : Gr2; LAS float* bonP = bonv + 64 * ((c + 2) % 3); LAS float* bonN = bonv + 64 * ((c + 4) % 3);
        if (live) {
        if (RW_DBG & 1) {
          if (own) {
#pragma unroll
              for (int i = 0; i < 8; ++i) { const int tt = 8 * wave + i;
                  KH[tt * LP + lane] = (unsigned short)(o_kb[i] & 0xffffu); BH[tt * LP + lane] = (unsigned short)(o_kb[i] >> 16); KT[tt * LP + lane] = (unsigned short)(o_tr[i] & 0xffffu); RT[tt * LP + lane] = (unsigned short)(o_tr[i] >> 16);
                  VrC[tt * LP + lane] = (unsigned short)(o_vg[i] & 0xffffu); GrC[tt * LP + lane] = (unsigned short)(o_vg[i] >> 16); }
              *(LAS v4u*)(KHgt + lane * LP + 8 * wave) = o_khg; *(LAS v4u*)(BHgtn + lane * LP + 8 * wave) = o_bhg; *(LAS v4u*)(Vt + lane * LP + 8 * wave) = o_vs; }
          { const float gc63 = fexp(qc63); float ecp = fexp(qc[0]); unsigned short khg2[2], bhg2[2], vs2[2];
#pragma unroll
            for (int i = 0; i < 2; ++i) { const int tt = T2 + i; float f_kh, f_bh, f_kt, f_rt, f_khg, f_bhg, bon;
                RW_TOK(qr[i], qr[i + 1], qk[i], qk[i + 1], qa[i], qc[i + 1], ecp, f_kh, f_bh, f_kt, f_rt, f_khg, f_bhg, bon);
                KH[tt * LP + lane] = f2bf16(f_kh); BH[tt * LP + lane] = f2bf16(f_bh); KT[tt * LP + lane] = f2bf16(f_kt); RT[tt * LP + lane] = f2bf16(f_rt); if (lane == 0) bonC[tt] = bon;
                khg2[i] = f2bf16(f_khg); bhg2[i] = f2bf16(f_bhg);
                const float cv = bf2f(qv[i + 1]); vs2[i] = f2bf16(cv + (bf2f(qv[i]) - cv) * mu_v); VrC[tt * LP + lane] = vs2[i]; GrC[tt * LP + lane] = qg[i]; }
            *(LAS unsigned*)(KHgt + lane * LP + T2) = khg2[0] | ((unsigned)khg2[1] << 16); *(LAS unsigned*)(BHgtn + lane * LP + T2) = bhg2[0] | ((unsigned)bhg2[1] << 16); *(LAS unsigned*)(Vt + lane * LP + T2) = vs2[0] | ((unsigned)vs2[1] << 16);
            if (wave == 0) GCv[lane] = gc63; } }
        if (own && c + 1 < ce) RWKV_LOAD(c + 1);
        WG_BAR_L();
#pragma unroll
        for (int u2 = 0; u2 < 2; ++u2) { const int idx = 2 * wave + u2, rt = idx >> 2, ct = idx & 3;
            if (ct <= rt) {
                const int s = 16 * ct + lc; const LAS bf16* kt = KT + 16 * rt * LP + o72; const LAS bf16* rtp = RT + 16 * rt * LP + o72; const LAS bf16* bh = BH + 16 * ct * LP + o72; const LAS bf16* kh = KH + 16 * ct * LP + o72;
                const f32x4 z = (f32x4){0.f, 0.f, 0.f, 0.f};
                const f32x4 g0 = mm_tile<2>(kt, bh, z), g1 = mm_tile<2>(kt, kh, z), g2 = mm_tile<2>(rtp, bh, z), g3 = mm_tile<2>(rtp, kh, z);
#pragma unroll
                for (int r = 0; r < 4; ++r) { const int t = 16 * rt + 4 * q4 + r;
                    if (ct < rt) Loffb[t * LP + s] = f2bf16(g0[r]); else LTd[s * 20 + (t - 16 * rt)] = (s < t) ? g0[r] : 0.f;
                    AkT[t * LP + s] = f2bf16((s < t) ? g1[r] : 0.f);
                    BbTn[t * LP + s] = f2bf16((s <= t) ? -g2[r] : 0.f);
                    BkT[t * LP + s] = f2bf16((s <= t) ? g3[r] : 0.f); } } }
        WG_BAR_L();
#pragma unroll
        for (int u = 0; u < ((RW_DBG & 4) ? 2 : 0); ++u) { const int rt = wave >> 1, ct = 2 * (wave & 1) + u;
            f32x4 g = mm_tile<2>(KT + 16 * rt * LP + o72, S0b + 16 * ct * LP + o72, (f32x4){0.f, 0.f, 0.f, 0.f});
            g = mm_tile<2>(AkT + 16 * rt * LP + o72, Vt + 16 * ct * LP + o72, g);
#pragma unroll
            for (int r = 0; r < 4; ++r) RHS[(16 * rt + 4 * q4 + r) * 64 + 16 * ct + lc] = g[r]; }
        WG_BAR_L();
        }
        f32x4 y[4];
        if (wave == 0) {
#define RW_KILL(x) asm volatile("" : "=v"(x))
#pragma unroll
            for (int i = 0; i < 9; ++i) { RW_KILL(rr[i]); RW_KILL(rk[i]); RW_KILL(rv[i]); RW_KILL(rc[i]); }
#pragma unroll
            for (int i = 0; i < 8; ++i) { RW_KILL(ra[i]); RW_KILL(rg[i]); RW_KILL(o_kb[i]); RW_KILL(o_tr[i]); RW_KILL(o_vg[i]); }
#pragma unroll
            for (int i = 0; i < 3; ++i) { RW_KILL(qr[i]); RW_KILL(qk[i]); RW_KILL(qv[i]); RW_KILL(qc[i]); }
            RW_KILL(qa[0]); RW_KILL(qa[1]); RW_KILL(qg[0]); RW_KILL(qg[1]); RW_KILL(rc63); RW_KILL(qc63); RW_KILL(o_khg); RW_KILL(o_bhg); RW_KILL(o_vs);
#undef RW_KILL
            if (live && (RW_DBG & 8)) {
            __builtin_amdgcn_s_setprio(3);
#pragma unroll
            for (int a = 0; a < 4; ++a) {
                if (a > 0) {
#pragma unroll
                    for (int it = 0; it < 4; ++it) { f32x4 cr = (f32x4){0.f, 0.f, 0.f, 0.f};
                        if (a == 3) cr = mm_tile<2>(Loffb + 16 * a * LP + o72, Ut + 16 * it * LP + o72, cr); else cr = mm_tile<1>(Loffb + 16 * a * LP + o72, Ut + 16 * it * LP + o72, cr);
#pragma unroll
                        for (int r = 0; r < 4; ++r) XS[(4 * q4 + r) * 64 + 16 * it + lc] = cr[r]; }
                    asm volatile("s_waitcnt lgkmcnt(0)" ::: "memory");
                }
                typedef float f32x2s __attribute__((ext_vector_type(2)));
                f32x2s acc2[8];
#pragma unroll
                for (int t = 0; t < 8; ++t) { acc2[t].x = RHS[(16 * a + 2 * t) * 64 + lane] - (a > 0 ? XS[(2 * t) * 64 + lane] : 0.f); acc2[t].y = RHS[(16 * a + 2 * t + 1) * 64 + lane] - (a > 0 ? XS[(2 * t + 1) * 64 + lane] : 0.f); }
                const LAS float* Ld = LTd + 16 * a * 20; asm volatile("" : "+v"(Ld));
                f32x4 cq[8];
#define RW_LD(slot, s2, t4) cq[slot] = *(const volatile LAS f32x4*)(Ld + (s2) * 20 + 4 * (t4))
#define RW_FM(d, u, c, S) asm volatile("v_pk_fma_f32 %0, %1, %2, %0 op_sel:[" #S ",0,0] op_sel_hi:[" #S ",1,1] neg_lo:[1,0,0] neg_hi:[1,0,0]" : "+v"(d) : "v"(u), "v"(c))
#define RW_IT(slot, s2, t4, S) do { const f32x2s c0_ = __builtin_shufflevector(cq[slot], cq[slot], 0, 1), c1_ = __builtin_shufflevector(cq[slot], cq[slot], 2, 3); RW_FM(acc2[2 * (t4)], acc2[(s2) >> 1], c0_, S); RW_FM(acc2[2 * (t4) + 1], acc2[(s2) >> 1], c1_, S); } while (0)
                RW_LD(0, 0, 0);
                RW_LD(1, 0, 1);
                RW_LD(2, 0, 2);
                RW_LD(3, 0, 3);
                RW_LD(4, 1, 0);
                RW_LD(5, 1, 1);
                RW_LD(6, 1, 2);
                RW_LD(7, 1, 3);
                RW_IT(0, 0, 0, 0); RW_LD(0, 2, 0); RW_IT(1, 0, 1, 0); RW_LD(1, 2, 1); RW_IT(2, 0, 2, 0); RW_LD(2, 2, 2); RW_IT(3, 0, 3, 0); RW_LD(3, 2, 3);
                RW_IT(4, 1, 0, 1); RW_LD(4, 3, 1); RW_IT(5, 1, 1, 1); RW_LD(5, 3, 2); RW_IT(6, 1, 2, 1); RW_LD(6, 3, 3); RW_IT(7, 1, 3, 1); RW_LD(7, 4, 1);
                RW_IT(0, 2, 0, 0); RW_LD(0, 4, 2); RW_IT(1, 2, 1, 0); RW_LD(1, 4, 3); RW_IT(2, 2, 2, 0); RW_LD(2, 5, 1); RW_IT(3, 2, 3, 0); RW_LD(3, 5, 2);
                RW_IT(4, 3, 1, 1); RW_LD(4, 5, 3); RW_IT(5, 3, 2, 1); RW_LD(5, 6, 1); RW_IT(6, 3, 3, 1); RW_LD(6, 6, 2); RW_IT(7, 4, 1, 0); RW_LD(7, 6, 3);
                RW_IT(0, 4, 2, 0); RW_LD(0, 7, 2); RW_IT(1, 4, 3, 0); RW_LD(1, 7, 3); RW_IT(2, 5, 1, 1); RW_LD(2, 8, 2); RW_IT(3, 5, 2, 1); RW_LD(3, 8, 3);
                RW_IT(4, 5, 3, 1); RW_LD(4, 9, 2); RW_IT(5, 6, 1, 0); RW_LD(5, 9, 3); RW_IT(6, 6, 2, 0); RW_LD(6, 10, 2); RW_IT(7, 6, 3, 0); RW_LD(7, 10, 3);
                RW_IT(0, 7, 2, 1); RW_LD(0, 11, 3); RW_IT(1, 7, 3, 1); RW_LD(1, 12, 3); RW_IT(2, 8, 2, 0); RW_LD(2, 13, 3); RW_IT(3, 8, 3, 0); RW_LD(3, 14, 3);
                RW_IT(4, 9, 2, 1); RW_IT(5, 9, 3, 1); RW_IT(6, 10, 2, 0); RW_IT(7, 10, 3, 0);
                RW_IT(0, 11, 3, 1); RW_IT(1, 12, 3, 0); RW_IT(2, 13, 3, 1); RW_IT(3, 14, 3, 0);
#undef RW_LD
#undef RW_FM
#undef RW_IT
                v4u w; w.x = pk2(acc2[0].x, acc2[0].y); w.y = pk2(acc2[1].x, acc2[1].y); w.z = pk2(acc2[2].x, acc2[2].y); w.w = pk2(acc2[3].x, acc2[3].y);
                *(LAS v4u*)(Ut + lane * LP + 16 * a) = w;
                w.x = pk2(acc2[4].x, acc2[4].y); w.y = pk2(acc2[5].x, acc2[5].y); w.z = pk2(acc2[6].x, acc2[6].y); w.w = pk2(acc2[7].x, acc2[7].y);
                *(LAS v4u*)(Ut + lane * LP + 16 * a + 8) = w;
                asm volatile("s_waitcnt lgkmcnt(0)" ::: "memory");
            }
            __builtin_amdgcn_s_setprio(0);
        } } else if (own && c + 1 < ce) {
            const float gc63 = fexp(rc63); float ecp = fexp(rc[0]); unsigned short khg[8], bhg[8], vs[8];
#pragma unroll
            for (int i = 0; i < 8; ++i) { float f_kh, f_bh, f_kt, f_rt, f_khg, f_bhg, bon;
                RW_TOK(rr[i], rr[i + 1], rk[i], rk[i + 1], ra[i], rc[i + 1], ecp, f_kh, f_bh, f_kt, f_rt, f_khg, f_bhg, bon); if (lane == 0) bonN[8 * wave + i] = bon;
                o_kb[i] = pk2(f_kh, f_bh); o_tr[i] = pk2(f_kt, f_rt); khg[i] = f2bf16(f_khg); bhg[i] = f2bf16(f_bhg);
                const float cv = bf2f(rv[i + 1]); vs[i] = f2bf16(cv + (bf2f(rv[i]) - cv) * mu_v); o_vg[i] = (unsigned)vs[i] | ((unsigned)rg[i] << 16); }
            o_khg.x = khg[0] | ((unsigned)khg[1] << 16); o_khg.y = khg[2] | ((unsigned)khg[3] << 16); o_khg.z = khg[4] | ((unsigned)khg[5] << 16); o_khg.w = khg[6] | ((unsigned)khg[7] << 16);
            o_bhg.x = bhg[0] | ((unsigned)bhg[1] << 16); o_bhg.y = bhg[2] | ((unsigned)bhg[3] << 16); o_bhg.z = bhg[4] | ((unsigned)bhg[5] << 16); o_bhg.w = bhg[6] | ((unsigned)bhg[7] << 16);
            o_vs.x = vs[0] | ((unsigned)vs[1] << 16); o_vs.y = vs[2] | ((unsigned)vs[3] << 16); o_vs.z = vs[4] | ((unsigned)vs[5] << 16); o_vs.w = vs[6] | ((unsigned)vs[7] << 16);
        }
        if (c + 1 < ce) RWKV_LOAD2(c + 1);
        if (live) {
        if (wave >= 4) {
#pragma unroll
            for (int ct = 0; ct < 4; ++ct) { y[ct] = mm_tile<2>(RT + 16 * (wave - 4) * LP + o72, S0b + 16 * ct * LP + o72, (f32x4){0.f, 0.f, 0.f, 0.f}); y[ct] = mm_tile<2>(BkT + 16 * (wave - 4) * LP + o72, Vt + 16 * ct * LP + o72, y[ct]); }
            if (c > cb) RW_EPILOGUE(yp, c - 1, VrP, GrP, bonP, q4, lc);
        } else {
#pragma unroll
            for (int jt = 0; jt < 4; ++jt) { const float gc = GCv[16 * jt + lc]; sacc[jt] = mm_tile<2>(Vt + 16 * wave * LP + o72, KHgt + 16 * jt * LP + o72, sacc[jt] * gc); }
        }
        WG_BAR_L();
        if (wave >= 4) {
#pragma unroll
            for (int ct = 0; ct < 4; ++ct) y[ct] = mm_tile<2>(BbTn + 16 * (wave - 4) * LP + o72, Ut + 16 * ct * LP + o72, y[ct]);
#pragma unroll
            for (int ct = 0; ct < 4; ++ct) yp[ct] = y[ct];
        } else {
#pragma unroll
            for (int jt = 0; jt < 4; ++jt) { sacc[jt] = mm_tile<2>(Ut + 16 * wave * LP + o72, BHgtn + 16 * jt * LP + o72, sacc[jt]);
#pragma unroll
                for (int r = 0; r < 4; ++r) S0b[(16 * wave + 4 * q4 + r) * LP + 16 * jt + lc] = f2bf16(sacc[jt][r]); }
        }
        WG_BAR_L();
        }
    }
    if (wave >= 4 && ce > cb) { const int q4 = lane0 >> 4, lc = lane0 & 15; const int cl = ce - 1;
        LAS float* bonL = bonv + 64 * (cl % 3);
        if (cl & 1) RW_EPILOGUE(yp, cl, Vr2, Gr2, bonL, q4, lc); else RW_EPILOGUE(yp, cl, Vr, Gr, bonL, q4, lc); }
#undef RW_EPILOGUE
    if (!hs_out) WG_BAR_L();
    if (hs_out) {
        if (wave < 4) {
#pragma unroll
            for (int jt = 0; jt < 4; ++jt)
#pragma unroll
                for (int r = 0; r < 4; ++r) __hip_atomic_store(hs_out + (wave * 4 + jt) * 256 + r * 64 + lane0, sacc[jt][r], __ATOMIC_RELAXED, __HIP_MEMORY_SCOPE_AGENT);
        }
        WG_BAR();
        if (wave == 0 && lane0 == 0) __hip_atomic_store(flag_out, 1u, __ATOMIC_RELAXED, __HIP_MEMORY_SCOPE_AGENT);
    }
#undef RWKV_LOAD
#undef RWKV_LOAD2
#undef RW_TOK
}

struct Args { const float* in[25]; float* out; unsigned char* ws; int ph_lo, ph_hi, li, pad; };
typedef const __attribute__((address_space(4))) Args* KArgs;
__device__ __forceinline__ KArgs kargs() { KArgs p = (KArgs)__builtin_amdgcn_kernarg_segment_ptr(); asm volatile("" : "+s"(p)); return p; }
#ifndef DBG_MASK
#define DBG_MASK 0xFFFF
#endif
#define EN(bit) ((DBG_MASK >> (bit)) & 1)
#ifndef PROBE_SKEW_MODE
#define PROBE_SKEW_MODE 0
#endif
#ifndef PROBE_SKEW
#define PROBE_SKEW 0
#endif
#define SKEW_STAMP(which) do { if (PROBE_SKEW == (which) && l == 2 && wave_o == 0 && lane_id_opq() == 0) { volatile unsigned long long* pp_ = (volatile unsigned long long*)(ws + WS_CTL) + 130000 + blockIdx.x; pp_[0] = __builtin_amdgcn_s_memrealtime(); } } while (0)
#ifndef PROBE_CLK
#define PROBE_CLK 0
#endif
#ifndef PROBE_DUP
#define PROBE_DUP 0
#endif
#define REP(bit) for (int rep_ = 0; rep_ < (((PROBE_DUP >> (bit)) & 1) ? 2 : 1); ++rep_)
__global__ void __launch_bounds__(NWAVES * 64, 2) mk_fwd(Args args_unused) {
    extern __shared__ __attribute__((aligned(16))) unsigned char lds_raw[];
    LAS unsigned char* lds = (LAS unsigned char*)lds_raw;
    volatile LAS unsigned* MISC = (volatile LAS unsigned*)(lds + MISC_OFF);
    const int wave = __builtin_amdgcn_readfirstlane((int)threadIdx.x >> 6);
    const int G = gridDim.x, gw = blockIdx.x * NWAVES + wave, ngw = G * NWAVES;
    for (int u = threadIdx.x; u < (LDS_BYTES - LDSCTL_OFF) / 4; u += NWAVES * 64) ((LAS unsigned*)(lds + LDSCTL_OFF))[u] = 0u;
    __syncthreads();
    XcdBarrier bar; int lo, hi;
    { KArgs A = kargs(); bar = xcd_barrier_post((unsigned*)(A->ws + WS_CTL) + CW_BAR + (MK_PER_PHASE ? 0 : A->li) * XCD_BAR_WORDS, MISC + 8); lo = A->ph_lo; hi = A->ph_hi; }
#define IN(k) (lo <= (k) && (k) < hi)
#if PROBE_BAR
#define SEAM(k) do { if (IN(k) && IN((k) + 1)) { xcd_barrier(bar); xcd_barrier(bar); xcd_barrier(bar); } } while (0)
#else
#define SEAM(k) do { if (IN(k) && IN((k) + 1)) xcd_barrier(bar); } while (0)
#endif
#define LANE_TID() int wave_o = wave, gw_o = gw; asm volatile("" : "+s"(wave_o), "+s"(gw_o)); (void)gw_o; const int lane_o = lane_id_opq(), tid_o = wave_o * 64 + lane_o; (void)tid_o

    REP(5) if (EN(0) && IN(0)) {
        KArgs A = kargs(); unsigned char* ws = A->ws; LANE_TID();
        p0_mod(A->in[1], A->in[2], A->in[3], (float*)(ws + WS_MOD), lds, tid_o, lane_o, wave_o);
        p0_weights(A->in[6], A->in[21], A->in[22], A->in[23], A->in[10], A->in[12], A->in[13], ws, lds, gw_o, ngw, wave_o, lane_o);
    }
    SEAM(0);
    if (EN(1) && IN(1)) { KArgs A = kargs(); unsigned char* ws = A->ws; LANE_TID();
        norm_mod_phase(A->in[0], A->in[4], (const float*)(ws + WS_MOD), 0, DM, (bf16*)(ws + WS_H), gw_o, ngw, lane_o); }
    SEAM(1);
#pragma unroll 1
    for (int l = 0; l < NL; ++l) {
        const int pb = 2 + 6 * l;
        REP(3) if (EN(2) && IN(pb + 0)) { KArgs A = kargs(); unsigned char* ws = A->ws; LANE_TID();
            pg8::Gemm g{(const bf16*)(ws + WS_H), (const bf16*)(ws + WS_WIN) + (size_t)l * NPI * DM, MT, NPI, DM}; pg8::StaticOrder S; S.init(MT, NPI, G, (int)blockIdx.x);
            pg8::EpiBf16Plain E{(bf16*)(ws + WS_PROJ), NPI};
#if PROBE_CLK
            unsigned long long pc0 = 0, pr0 = 0; if (blockIdx.x == 0 && l == 2) { pc0 = __builtin_readcyclecounter(); pr0 = __builtin_amdgcn_s_memrealtime(); }
#endif
            pg8::gemm_phase<pg8::EpiBf16Plain, pg8::StaticOrder, true, true>(lds, g, S, E, wave_o);
            SKEW_STAMP(1);
#if PROBE_CLK
            if (blockIdx.x == 0 && l == 2 && wave_o == 0 && lane_id_opq() == 0) { const unsigned long long dc = __builtin_readcyclecounter() - pc0, dr = __builtin_amdgcn_s_memrealtime() - pr0;
                volatile unsigned long long* pp = (volatile unsigned long long*)(ws + WS_CTL) + 131000; pp[0] = dc; pp[1] = dr; }
#endif
        }
        SEAM(pb + 0);
        REP(1) if (EN(3) && IN(pb + 1)) { KArgs A = kargs(); unsigned char* ws = A->ws; LANE_TID();
            rwkv_prep_mfma((const bf16*)(ws + WS_PROJ), A->in[8] + l * RWKV_IN, A->in[9] + l * 384, A->in[11] + l * 384, (const bf16*)(ws + WS_WL) + (size_t)l * 384 * 256,
                           (float*)(ws + WS_DEC), (bf16*)(ws + WS_AA), (bf16*)(ws + WS_GG), lds, wave_o); SKEW_STAMP(6); }
        SEAM(pb + 1);
        REP(0) if (EN(4) && IN(pb + 2)) { KArgs A = kargs(); unsigned char* ws = A->ws; LANE_TID();
            const float* gn = A->in[7] + l * DM; const bf16* PROJ = (const bf16*)(ws + WS_PROJ); bf16* Hb = (bf16*)(ws + WS_H);
#if PROBE_SKEW == 10
            if (l == 2 && wave_o == 0 && lane_id_opq() == 0) { volatile unsigned long long* pp_ = (volatile unsigned long long*)(ws + WS_CTL) + 130000 + 2 * blockIdx.x; pp_[0] = __builtin_amdgcn_s_memrealtime(); }
#endif
            int u = (int)blockIdx.x; asm volatile("" : "+s"(u));
            float* HS = (float*)(ws + WS_HS) + (size_t)l * 192 * 4096; unsigned* FL = (unsigned*)(ws + WS_CTL) + CW_FLAG + l * 192 * 16;
            const float* DECp = (const float*)(ws + WS_DEC); const bf16* AAp = (const bf16*)(ws + WS_AA); const bf16* GGp = (const bf16*)(ws + WS_GG);
#define RWKV_PIECE(q, cb, ce, hin, hout) rwkv_unit((q) / 6, (q) % 6, PROJ, DECp, AAp, GGp, A->in[8] + l * RWKV_IN, A->in[14] + l * 384, A->in[15] + l * 384, A->in[16] + l * 384, gn, Hb, lds, wave_o, lane_o, cb, ce, \
                (hin) >= 0 ? HS + (size_t)(hin) * 4096 : nullptr, (hin) >= 0 ? FL + (hin) * 16 : nullptr, (hout) >= 0 ? HS + (size_t)(hout) * 4096 : nullptr, (hout) >= 0 ? FL + (hout) * 16 : nullptr)
            if (u < 64 || u >= 128) {
#if PROBE_SKEW == 9
                if (l == 2 && wave_o == 0 && lane_id_opq() == 0) { volatile unsigned long long* pp_ = (volatile unsigned long long*)(ws + WS_CTL) + 130000 + 3 * blockIdx.x; pp_[0] = __builtin_amdgcn_s_memrealtime(); }
#endif
                const int q = u < 64 ? u : u < 192 ? u - 64 : u - 64, ce = u < 64 ? SPLIT_H : u < 192 ? SPLIT_X : SPLIT_Y;
                RWKV_PIECE(q, 0, ce, -1, q);
#if PROBE_SKEW == 9
                if (l == 2 && wave_o == 0 && lane_id_opq() == 0) { volatile unsigned long long* pp_ = (volatile unsigned long long*)(ws + WS_CTL) + 130000 + 3 * blockIdx.x; pp_[1] = __builtin_amdgcn_s_memrealtime(); }
#endif
                }
            if (u < 128) {
#if PROBE_SKEW == 7 || PROBE_SKEW == 8
                if (l == 2 && wave_o == 0 && lane_id_opq() == 0) { volatile unsigned long long* pp_ = (volatile unsigned long long*)(ws + WS_CTL) + 130000 + 3 * blockIdx.x; pp_[0] = __builtin_amdgcn_s_memrealtime(); }
#endif
                mlstm_unit(u >> 2, u & 3, PROJ, A->in[17] + (size_t)l * 4 * 768, A->in[18] + l * 768, A->in[19] + l * 4, A->in[20] + l * 4, gn, Hb, lds, wave_o, lane_o);
#if PROBE_SKEW == 7 || PROBE_SKEW == 8
                if (l == 2 && wave_o == 0 && lane_id_opq() == 0) { volatile unsigned long long* pp_ = (volatile unsigned long long*)(ws + WS_CTL) + 130000 + 3 * blockIdx.x; pp_[1] = __builtin_amdgcn_s_memrealtime(); }
#endif
                ret_unit(u >> 2, u & 3, PROJ, gn, Hb, lds, wave_o, lane_o);
#if PROBE_SKEW == 7 || PROBE_SKEW == 8
                if (l == 2 && wave_o == 0 && lane_id_opq() == 0) { volatile unsigned long long* pp_ = (volatile unsigned long long*)(ws + WS_CTL) + 130000 + 3 * blockIdx.x; pp_[2] = __builtin_amdgcn_s_memrealtime(); }
#endif
                }
            if (u >= 64) {
                const int q = u < 128 ? u : u < 192 ? u : u - 192, cb = u < 128 ? SPLIT_X : u < 192 ? SPLIT_Y : SPLIT_H;
                RWKV_PIECE(q, cb, 32, q, -1); }
#undef RWKV_PIECE
#ifndef PROBE_UNIT
#define PROBE_UNIT 0
#endif
            if (PROBE_UNIT == 1 && u < 192) rwkv_unit(u / 6, u % 6, PROJ, DECp, AAp, GGp, A->in[8] + l * RWKV_IN, A->in[14] + l * 384, A->in[15] + l * 384, A->in[16] + l * 384, gn, Hb, lds, wave_o, lane_o, 0, 32, nullptr, nullptr, nullptr, nullptr);
            if (PROBE_UNIT == 2 && u < 128) mlstm_unit(u >> 2, u & 3, PROJ, A->in[17] + (size_t)l * 4 * 768, A->in[18] + l * 768, A->in[19] + l * 4, A->in[20] + l * 4, gn, Hb, lds, wave_o, lane_o);
            if (PROBE_UNIT == 3 && u < 128) ret_unit(u >> 2, u & 3, PROJ, gn, Hb, lds, wave_o, lane_o);
            SKEW_STAMP(2);
#if PROBE_SKEW == 10
            if (l == 2 && wave_o == 0 && lane_id_opq() == 0) { volatile unsigned long long* pp_ = (volatile unsigned long long*)(ws + WS_CTL) + 130000 + 2 * blockIdx.x; pp_[1] = __builtin_amdgcn_s_memrealtime(); }
#endif
        }
        SEAM(pb + 2);
        if (EN(6) && IN(pb + 3)) { KArgs A = kargs(); unsigned char* ws = A->ws; LANE_TID();
            pg8::Gemm g{(const bf16*)(ws + WS_H), (const bf16*)(ws + WS_WOUT) + (size_t)l * DM * DM, MT, DM, DM}; pg8::StaticOrder S; S.init(MT, DM, G, (int)blockIdx.x);
            const float* modl = (const float*)(ws + WS_MOD) + (size_t)l * NB * MODP;
#if PROBE_RG
            { pg8::EpiResGate<false> E2{(const float*)nullptr, (const bf16*)A->out, (bf16*)(ws + WS_XFIN), DM, modl + 2 * DM, MODP}; pg8::gemm_phase<pg8::EpiResGate<false>, pg8::StaticOrder, true, true>(lds, g, S, E2, wave_o); }
#endif
            if (l == 0) { pg8::EpiResGate<true> E{A->in[0], (const bf16*)nullptr, (bf16*)A->out, DM, modl + 2 * DM, MODP}; pg8::gemm_phase<pg8::EpiResGate<true>, pg8::StaticOrder, true, true>(lds, g, S, E, wave_o); }
            else { pg8::EpiResGate<false> E{(const float*)nullptr, (const bf16*)A->out, (bf16*)A->out, DM, modl + 2 * DM, MODP}; pg8::gemm_phase<pg8::EpiResGate<false>, pg8::StaticOrder, true, true>(lds, g, S, E, wave_o); }
            fused_panel_norm(S, (unsigned*)(ws + WS_CTL) + CW_PCNT + (2 * l) * PCNT_BANK, (const bf16*)A->out, A->in[5] + l * DM, modl, 3 * DM, 4 * DM, (bf16*)(ws + WS_H), wave_o, lane_o);
            SKEW_STAMP(5);
        }
        SEAM(pb + 3);
        REP(4) if (EN(7) && IN(pb + 4)) { KArgs A = kargs(); unsigned char* ws = A->ws; LANE_TID();
            pg8::Gemm g{(const bf16*)(ws + WS_H), (const bf16*)(ws + WS_WF1) + (size_t)l * NF1 * DM, MT, NF1, DM}; pg8::StaticOrder S; S.init(MT, NF1, G, (int)blockIdx.x);
            pg8::EpiSwiGLU E{(bf16*)(ws + WS_PROJ), DFF};
            pg8::gemm_phase<pg8::EpiSwiGLU, pg8::StaticOrder, true, true>(lds, g, S, E, wave_o);
            SKEW_STAMP(3);
        }
        SEAM(pb + 4);
        if (EN(8) && IN(pb + 5)) { KArgs A = kargs(); unsigned char* ws = A->ws; LANE_TID();
            pg8::Gemm g{(const bf16*)(ws + WS_PROJ), (const bf16*)(ws + WS_WF2) + (size_t)l * DM * DFF, MT, DM, DFF}; pg8::StaticOrder S; S.init(MT, DM, G, (int)blockIdx.x);
#if PROBE_RG
            { pg8::EpiResGate<false> E2{(const float*)nullptr, (const bf16*)A->out, (bf16*)(ws + WS_XFIN), DM, (const float*)(ws + WS_MOD) + (size_t)l * NB * MODP + 5 * DM, MODP}; pg8::gemm_phase<pg8::EpiResGate<false>, pg8::StaticOrder, true, true>(lds, g, S, E2, wave_o); }
#endif
            pg8::EpiResGate<false> E{(const float*)nullptr, (const bf16*)A->out, l + 1 < NL ? (bf16*)A->out : (bf16*)(ws + WS_XFIN), DM, (const float*)(ws + WS_MOD) + (size_t)l * NB * MODP + 5 * DM, MODP};
            pg8::gemm_phase<pg8::EpiResGate<false>, pg8::StaticOrder, true, true>(lds, g, S, E, wave_o);
            if (l + 1 < NL) fused_panel_norm(S, (unsigned*)(ws + WS_CTL) + CW_PCNT + (2 * l + 1) * PCNT_BANK, (const bf16*)A->out, A->in[4] + (l + 1) * DM, (const float*)(ws + WS_MOD) + (size_t)(l + 1) * NB * MODP, 0, DM, (bf16*)(ws + WS_H), wave_o, lane_o);
            SKEW_STAMP(4);
        }
        SEAM(pb + 5);
    }
    if (EN(9) && IN(N_PHASES - 1)) { KArgs A = kargs(); int gw_o = gw; asm volatile("" : "+s"(gw_o)); final_norm_phase((const bf16*)(A->ws + WS_XFIN), A->out, A->in[24], gw_o, ngw, lane_id_opq()); }
#if PROBE_SKEW == 10
    if (blockIdx.x == 0 && wave == 0 && lane_id_opq() == 0) { KArgs A = kargs(); volatile unsigned long long* pp = (volatile unsigned long long*)(A->ws + WS_CTL) + 130000;
        unsigned long long mn = ~0ull, mx = 0ull;
        for (int i = 0; i < 256; ++i) { const unsigned long long a_ = pp[2 * i], b_ = pp[2 * i + 1]; mn = a_ < mn ? a_ : mn; mx = b_ > mx ? b_ : mx; }
        unsigned long long us = (mx - mn) / 10ull; if (us > 30000ull) us = 30000ull;
        const unsigned long long t0 = __builtin_amdgcn_s_memrealtime();
        while (__builtin_amdgcn_s_memrealtime() - t0 < us * 100ull) __builtin_amdgcn_s_sleep(32); }
#elif PROBE_SKEW == 9
    if (blockIdx.x == 0 && wave == 0 && lane_id_opq() == 0) { KArgs A = kargs(); volatile unsigned long long* pp = (volatile unsigned long long*)(A->ws + WS_CTL) + 130000;
        unsigned long long s = 0ull;
        for (int i = 128; i < 192; ++i) s += pp[3 * i + 1] - pp[3 * i];
        unsigned long long us = s >> 6; if (us > 60000ull) us = 60000ull;
        const unsigned long long t0 = __builtin_amdgcn_s_memrealtime();
        while (__builtin_amdgcn_s_memrealtime() - t0 < us * 100ull) __builtin_amdgcn_s_sleep(32); }
#endif
#if PROBE_SKEW == 7 || PROBE_SKEW == 8
    if (blockIdx.x == 0 && wave == 0 && lane_id_opq() == 0) { KArgs A = kargs(); volatile unsigned long long* pp = (volatile unsigned long long*)(A->ws + WS_CTL) + 130000;
        unsigned long long s = 0ull;
        for (int i = 0; i < 128; ++i) s += PROBE_SKEW == 7 ? pp[3 * i + 1] - pp[3 * i] : pp[3 * i + 2] - pp[3 * i + 1];
        unsigned long long us = s >> 7; if (us > 60000ull) us = 60000ull;
        const unsigned long long t0 = __builtin_amdgcn_s_memrealtime();
        while (__builtin_amdgcn_s_memrealtime() - t0 < us * 100ull) __builtin_amdgcn_s_sleep(32); }
#elif PROBE_SKEW && PROBE_SKEW < 9
    if (blockIdx.x == 0 && wave == 0 && lane_id_opq() == 0) { KArgs A = kargs(); volatile unsigned long long* pp = (volatile unsigned long long*)(A->ws + WS_CTL) + 130000;
        unsigned long long mx = 0ull, sum = 0ull, mn = ~0ull;
        for (int i = 0; i < 256; ++i) { const unsigned long long t = pp[i]; mx = t > mx ? t : mx; mn = t < mn ? t : mn; sum += t - pp[0] + (1ull << 40); }
        const unsigned long long mean = pp[0] + (sum >> 8) - (1ull << 40);
        unsigned long long us = PROBE_SKEW_MODE == 1 ? (mx - mn) : (mx - mean);
        if (PROBE_SKEW_MODE >= 2) { const int lo = 64 * (PROBE_SKEW_MODE - 2), hi = lo + 64; unsigned long long s2 = 0ull;
            for (int i = lo; i < hi; ++i) s2 += mx - pp[i];
            us = s2 / (unsigned long long)(hi - lo); }
        if (us > 30000ull) us = 30000ull;
        const unsigned long long t0 = __builtin_amdgcn_s_memrealtime();
        while (__builtin_amdgcn_s_memrealtime() - t0 < us * 100ull) __builtin_amdgcn_s_sleep(32); }
#endif
#if PROBE_KL_SOLO
    if (blockIdx.x == 0) { xcd_barrier(bar); }
    else { xcd_barrier(bar); }
    if (blockIdx.x == 0) { KArgs A = kargs(); unsigned char* ws = A->ws; LANE_TID();
        { const unsigned long long t0_ = __builtin_amdgcn_s_memrealtime(); while (__builtin_amdgcn_s_memrealtime() - t0_ < 100000ull) __builtin_amdgcn_s_sleep(64); }
        pg8::Gemm g{(const bf16*)(ws + WS_H), (const bf16*)(ws + WS_WIN), MT, NPI, DM}; pg8::StaticOrder S; S.init(MT, NPI, G, 0);
        pg8::EpiBf16Plain E{(bf16*)(ws + WS_PROJ), NPI};
        pg8::gemm_phase<pg8::EpiBf16Plain, pg8::StaticOrder, true, true>(lds, g, S, E, wave_o); }
#endif
#if PROBE_RWS
    if (blockIdx.x == 0 && wave == 0 && lane_id_opq() == 0) { unsigned long long us = (PROBE_RWS == 9 ? (probe_rw[5] - probe_rw[0]) / 4ull : PROBE_RWS == 6 ? probe_rw[6] - probe_rw[3] : PROBE_RWS == 7 ? probe_rw[7] - probe_rw[6] : PROBE_RWS == 8 ? probe_rw[4] - probe_rw[7] : probe_rw[PROBE_RWS] - probe_rw[PROBE_RWS - 1]) / 2ull;
        const unsigned long long t0 = __builtin_amdgcn_s_memrealtime();
        while (__builtin_amdgcn_s_memrealtime() - t0 < us * 100ull) __builtin_amdgcn_s_sleep(32); }
#endif
#if PROBE_KL
    if (blockIdx.x == 0 && wave == 0 && lane_id_opq() == 0) { unsigned long long us = PROBE_KL == 1 ? probe_kl[0] / 16ull : probe_kl[1] / 4ull; if (us > 30000ull) us = 30000ull;
        const unsigned long long t0 = __builtin_amdgcn_s_memrealtime();
        while (__builtin_amdgcn_s_memrealtime() - t0 < us * 100ull) __builtin_amdgcn_s_sleep(32); }
#endif
#if PROBE_CLK
    if (blockIdx.x == 0 && wave == 0 && lane_id_opq() == 0) { KArgs A = kargs(); volatile unsigned long long* pp = (volatile unsigned long long*)(A->ws + WS_CTL) + 131000; const unsigned long long dc = pp[0], dr = pp[1];
#if PROBE_CLK == 1
        unsigned long long us = dr ? dc * 100ull / dr : 0ull;
#else
        unsigned long long us = dr / 100ull * 10ull;
#endif
        if (us > 20000ull) us = 20000ull;
        const unsigned long long t0 = __builtin_amdgcn_s_memrealtime();
        while (__builtin_amdgcn_s_memrealtime() - t0 < us * 100ull) __builtin_amdgcn_s_sleep(32); }
#endif
#undef IN
#undef SEAM
}

extern "C" void kernel_launch(void* const* d_in, const int* in_sizes, int n_in, void* d_out, int out_size, void* d_ws, size_t ws_size, hipStream_t stream) {
    static int grid = 0;
    if (grid == 0) {
        if (n_in != 25 || in_sizes[0] != MT * DM || out_size != MT * DM || ws_size < WS_END) { fprintf(stderr, "kernel_launch: shape/workspace mismatch (n_in %d, in0 %d, out %d, ws %zu)\n", n_in, n_in > 0 ? in_sizes[0] : -1, out_size, ws_size); grid = -1; return; }
        int dev = 0, cus = 0, per_cu = 0;
        if (hipGetDevice(&dev) != hipSuccess || hipDeviceGetAttribute(&cus, hipDeviceAttributeMultiprocessorCount, dev) != hipSuccess) { grid = -1; return; }
        if (hipFuncSetAttribute((const void*)mk_fwd, hipFuncAttributeMaxDynamicSharedMemorySize, LDS_BYTES) != hipSuccess) { fprintf(stderr, "kernel_launch: hipFuncSetAttribute failed\n"); grid = -1; return; }
        if (hipOccupancyMaxActiveBlocksPerMultiprocessor(&per_cu, (const void*)mk_fwd, NWAVES * 64, LDS_BYTES) != hipSuccess || per_cu < 1) { fprintf(stderr, "kernel_launch: occupancy query says %d\n", per_cu); }
        (void)hipGetLastError();
        grid = cus;
    }
    if (grid < 0) return;
    if (hipMemsetAsync((char*)d_ws + WS_CTL, 0, CTL_ZERO_BYTES, stream) != hipSuccess) return;
    Args a{};
    for (int i = 0; i < 25; ++i) a.in[i] = (const float*)d_in[i];
    a.out = (float*)d_out; a.ws = (unsigned char*)d_ws;
#if MK_PER_PHASE
    for (int p = 0; p < N_PHASES; ++p) { a.ph_lo = p; a.ph_hi = p + 1; a.li = 0; hipLaunchKernelGGL(mk_fwd, dim3(grid), dim3(NWAVES * 64), LDS_BYTES, stream, a); }
#else
    a.ph_lo = 0; a.ph_hi = N_PHASES; a.li = 0;
    hipLaunchKernelGGL(mk_fwd, dim3(grid), dim3(NWAVES * 64), LDS_BYTES, stream, a);
#endif
}
```

```cpp
#include <hip/hip_runtime.h>
#include <cstdio>
#include <cstdint>
#ifndef PROBE_PN
#define PROBE_PN 0
#endif
#ifndef PROBE_RG
#define PROBE_RG 0
#endif
#ifndef PROBE_BAR
#define PROBE_BAR 0
#endif
#ifndef PROBE_SOLVE
#define PROBE_SOLVE 0
#endif
#ifndef PROBE_KL
#define PROBE_KL 0
#endif
#ifndef PROBE_KL_SOLO
#define PROBE_KL_SOLO 0
#endif
#ifndef PROBE_KL_FIRST
#define PROBE_KL_FIRST 0
#endif
#if PROBE_KL
__device__ unsigned long long probe_kl[2];
#endif
#ifndef PROBE_RWS
#define PROBE_RWS 0
#endif
#if PROBE_RWS
__device__ unsigned long long probe_rw[8];
#endif
#ifndef PROBE_EPI2
#define PROBE_EPI2 0
#endif
__device__ __forceinline__ int lane_id_opq() { int l = (int)__builtin_amdgcn_mbcnt_hi(~0u, __builtin_amdgcn_mbcnt_lo(~0u, 0u)); asm volatile("" : "+v"(l)); return l; }

namespace pg8 {
#define PG8_LAS __attribute__((address_space(3)))
typedef unsigned short bf16_t;
typedef short bf16x8 __attribute__((ext_vector_type(8)));
typedef float f32x4 __attribute__((ext_vector_type(4)));
typedef unsigned u32x4 __attribute__((ext_vector_type(4)));
constexpr int BM = 256, BK = 64, HALF = 128, HTB = HALF * BK * 2  , STAGE_BYTES = 8 * HTB, NXCD = 8, WGM = 8;

__host__ __device__ __forceinline__ int lds_byte(int r, int c) { const int st = (r >> 4) * 2 + (c >> 5), rr = r & 15, cc = c & 31, ob = rr * 64 + cc * 2; return st * 1024 + (ob ^ (((ob >> 9) & 1) << 5)); }
__host__ __device__ __forceinline__ void stage_rc(int b, int& R, int& C) { const int st = b / 1024, sb = b % 1024, swz = sb ^ (((sb >> 9) & 1) << 5); R = (st >> 1) * 16 + swz / 64; C = (st & 1) * 32 + (swz % 64) / 2; }
__host__ __device__ __forceinline__ int perm32(int rho) { const int n = rho >> 4, i = rho & 15; return 8 * (i >> 2) + 4 * n + (i & 3); }

struct Unit { int pm, pn; };
struct Gemm { const bf16_t* A; const bf16_t* Bt; int M, N, K; };

struct StaticOrder {
    int nM, nN, nwg, G, c;
    __host__ __device__ void init(int M, int N, int G_, int c_) { nM = M / BM; nN = N / BM; nwg = nM * nN; G = G_; c = c_; }
    __host__ __device__ bool next(int i, Unit& u) const {
        const long L = (long)i * G + c; if (L >= nwg) return false;
        int wgid = (int)L; { const int q = nwg / NXCD, r = nwg % NXCD, xcd = wgid % NXCD, off = wgid / NXCD; wgid = (xcd < r ? xcd * (q + 1) : r * (q + 1) + (xcd - r) * q) + off; }
        const int nig = WGM * nN, gid = wgid / nig, fm = gid * WGM, gsz = (nM - fm) < WGM ? (nM - fm) : WGM;
        u.pm = fm + ((wgid % nig) % gsz); u.pn = (wgid % nig) / gsz; return true;
    }
    __device__ __forceinline__ void a_ready(const Unit&) const {}
    __device__ __forceinline__ void done(const Unit&) const {}
};

__device__ __forceinline__ unsigned cvt_pk_bf16(float lo, float hi) { unsigned r; asm volatile("v_cvt_pk_bf16_f32 %0, %1, %2" : "=v"(r) : "v"(lo), "v"(hi)); return r; }
typedef float f32x2 __attribute__((ext_vector_type(2)));

typedef float f32x2e __attribute__((ext_vector_type(2)));
typedef __bf16 bf16x2e __attribute__((ext_vector_type(2)));
__device__ __forceinline__ unsigned cvt_pk(float lo, float hi) { const f32x2e v = {lo, hi}; return __builtin_bit_cast(unsigned, __builtin_convertvector(v, bf16x2e)); }
__device__ __forceinline__ float silu_f(float x) { return x * __builtin_amdgcn_rcpf(1.0f + __expf(-x)); }
struct EpiBf16Plain {
    static constexpr bool PERM = true, AFTER_DRAIN = false; static constexpr int NSTORE = 16;
    bf16_t* O; int ldc;
    __device__ __forceinline__ void operator()(const f32x4 (&acc)[2][2][4][2], const Unit& u, int wr, int wc, int fr, int fq) const {
        const int row0 = u.pm * BM + wr * 64 + fr, col0 = u.pn * BM + wc * 32 + 8 * fq;
#pragma unroll
        for (int ai = 0; ai < 2; ++ai)
#pragma unroll
            for (int m = 0; m < 4; ++m) { bf16_t* rowp = O + (size_t)(row0 + ai * HALF + m * 16) * ldc + col0;
#pragma unroll
                for (int bj = 0; bj < 2; ++bj) { const f32x4 v0 = acc[ai][bj][m][0], v1 = acc[ai][bj][m][1];
                    u32x4 w; w.x = cvt_pk(v0[0], v0[1]); w.y = cvt_pk(v0[2], v0[3]); w.z = cvt_pk(v1[0], v1[1]); w.w = cvt_pk(v1[2], v1[3]);
                    *(u32x4*)(rowp + bj * HALF) = w; } }
    }
};
struct EpiSwiGLU {
    static constexpr bool PERM = true, AFTER_DRAIN = false; static constexpr int NSTORE = 8;
    bf16_t* O; int ldc;
    __device__ __forceinline__ void operator()(const f32x4 (&acc)[2][2][4][2], const Unit& u, int wr, int wc, int fr, int fq) const {
        const int row0 = u.pm * BM + wr * 64 + fr, col0 = u.pn * HALF + wc * 32 + 8 * fq;
#pragma unroll
        for (int ai = 0; ai < 2; ++ai)
#pragma unroll
            for (int m = 0; m < 4; ++m) { bf16_t* rowp = O + (size_t)(row0 + ai * HALF + m * 16) * ldc + col0;
                const f32x4 g0 = acc[ai][0][m][0], g1 = acc[ai][0][m][1], u0 = acc[ai][1][m][0], u1 = acc[ai][1][m][1];
                u32x4 w; w.x = cvt_pk(silu_f(g0[0]) * u0[0], silu_f(g0[1]) * u0[1]); w.y = cvt_pk(silu_f(g0[2]) * u0[2], silu_f(g0[3]) * u0[3]);
                w.z = cvt_pk(silu_f(g1[0]) * u1[0], silu_f(g1[1]) * u1[1]); w.w = cvt_pk(silu_f(g1[2]) * u1[2], silu_f(g1[3]) * u1[3]);
                *(u32x4*)rowp = w; }
    }
};
template <bool F32IN>
struct EpiResGate {
    static constexpr bool PERM = false, AFTER_DRAIN = false; static constexpr int NSTORE = 32;
    const float* xin32; const bf16_t* xsin; bf16_t* xs; int ldc; const float* gate; int gpitch;
    __device__ __forceinline__ void operator()(const f32x4 (&acc)[2][2][4][2], const Unit& u, int wr, int wc, int fr, int fq) const {
        typedef unsigned u32x2 __attribute__((ext_vector_type(2)));
        const int row0 = u.pm * BM + wr * 64 + fr, col0 = u.pn * BM + wc * 32 + 4 * fq;
        const float* gp = gate + (size_t)(u.pm >> 3) * gpitch + col0;
        f32x4 gv[2][2];
#pragma unroll
        for (int bj = 0; bj < 2; ++bj)
#pragma unroll
            for (int n = 0; n < 2; ++n) gv[bj][n] = *(const f32x4*)(gp + bj * HALF + n * 16);
        f32x4 xf[2][2][2][2]; u32x2 xb[2][2][2][2];
#define RG_LOAD(buf, ai, mh) do { _Pragma("unroll") for (int mm = 0; mm < 2; ++mm) { const size_t off = (size_t)(row0 + (ai) * HALF + (2 * (mh) + mm) * 16) * ldc + col0; \
            _Pragma("unroll") for (int bj = 0; bj < 2; ++bj) _Pragma("unroll") for (int n = 0; n < 2; ++n) { \
                if constexpr (F32IN) xf[buf][mm][bj][n] = *(const f32x4*)(xin32 + off + bj * HALF + n * 16); else xb[buf][mm][bj][n] = *(const u32x2*)(xsin + off + bj * HALF + n * 16); } } } while (0)
        RG_LOAD(0, 0, 0);
#pragma unroll
        for (int k = 0; k < 4; ++k) { const int ai = k >> 1, mh = k & 1, buf = k & 1;
            if (k < 3) RG_LOAD((k + 1) & 1, (k + 1) >> 1, (k + 1) & 1);
            asm volatile("" ::: "memory");
#pragma unroll
            for (int mm = 0; mm < 2; ++mm) { const int m = 2 * mh + mm; const size_t off = (size_t)(row0 + ai * HALF + m * 16) * ldc + col0;
#pragma unroll
                for (int bj = 0; bj < 2; ++bj)
#pragma unroll
                    for (int n = 0; n < 2; ++n) { f32x4 xi;
                        if constexpr (F32IN) xi = xf[buf][mm][bj][n];
                        else { const u32x2 w = xb[buf][mm][bj][n]; xi = (f32x4){__uint_as_float(w.x << 16), __uint_as_float(w.x & 0xffff0000u), __uint_as_float(w.y << 16), __uint_as_float(w.y & 0xffff0000u)}; }
                        const f32x4 xo = xi + gv[bj][n] * acc[ai][bj][m][n];
                        u32x2 o; o.x = cvt_pk(xo[0], xo[1]); o.y = cvt_pk(xo[2], xo[3]); *(u32x2*)(xs + off + bj * HALF + n * 16) = o; } }
            asm volatile("" ::: "memory"); }
#undef RG_LOAD
    }
};

template <class Epi, class Sched, bool ALIGN_EPI = false, bool SP2 = false>
__device__ __forceinline__ void gemm_phase(PG8_LAS unsigned char* lds, const Gemm g, const Sched& S, const Epi& E, const int wid_in) {
    const int wid = wid_in, lane = lane_id_opq(), tid = wid * 64 + lane, wr = wid >> 2, wc = wid & 3, fr = lane & 15, fq = lane >> 4;
    const int K = g.K, nt = K / BK;
    unsigned voffA[2], voffB[2];
#pragma unroll
    for (int i = 0; i < 2; ++i) { int R, C; stage_rc(tid * 16 + i * 8192, R, C); const int Rb = Epi::PERM ? ((R & ~31) + perm32(R & 31)) : R;
        voffA[i] = (unsigned)(R * K + C) * 2u; voffB[i] = (unsigned)(Rb * K + C) * 2u; }
    const size_t kstep = (size_t)(BK * 2);
    const size_t hstep = (size_t)HALF * K * 2;
    const size_t tstep = 2 * hstep;
    const unsigned ldsw = (unsigned)wid * 1024u;
    const int aoff = lds_byte(wr * 64 + fr, fq * 8), boff = lds_byte(wc * 32 + fr, fq * 8);
#define PG8_SA(b, h) (((b) * 2 + (h)) * HTB)
#define PG8_SB(b, h) ((4 + (b) * 2 + (h)) * HTB)
#define PG8_STAGE(bufoff, gbase, voff) do { _Pragma("unroll") for (int _i = 0; _i < 2; ++_i) \
        __builtin_amdgcn_global_load_lds((const unsigned*)((const char*)(gbase) + (voff)[_i]), (PG8_LAS unsigned*)(lds + (bufoff) + ldsw + _i * 8192), 16, 0, 0); } while (0)
#define PG8_LDA(dst, b, h) do { _Pragma("unroll") for (int m = 0; m < 4; ++m) _Pragma("unroll") for (int k = 0; k < 2; ++k) dst[m][k] = *(const PG8_LAS bf16x8*)(lds + PG8_SA(b, h) + aoff + m * 2048 + k * 1024); } while (0)
#define PG8_LDB(dst, b, h) do { _Pragma("unroll") for (int n = 0; n < 2; ++n) _Pragma("unroll") for (int k = 0; k < 2; ++k) dst[n][k] = *(const PG8_LAS bf16x8*)(lds + PG8_SB(b, h) + boff + n * 2048 + k * 1024); } while (0)
#define PG8_MMA(ai, bj, At, Bt) do { __builtin_amdgcn_s_setprio(1); _Pragma("unroll") for (int m = 0; m < 4; ++m) _Pragma("unroll") for (int n = 0; n < 2; ++n) _Pragma("unroll") for (int k = 0; k < 2; ++k) \
        acc[ai][bj][m][n] = __builtin_amdgcn_mfma_f32_16x16x32_bf16(Bt[n][k], At[m][k], acc[ai][bj][m][n], 0, 0, 0); __builtin_amdgcn_s_setprio(0); } while (0)
#define PG8_WAIT_V(n) asm volatile("s_waitcnt vmcnt(" #n ")" ::: "memory")
#define PG8_WAIT_L(n) asm volatile("s_waitcnt lgkmcnt(" #n ")" ::: "memory")
#define PG8_BAR __builtin_amdgcn_s_barrier()
#define PG8_SCHED __builtin_amdgcn_sched_barrier(0)
    Unit cur, nxt; int ui = 0;
    if (!S.next(0, cur)) return;
    f32x4 acc[2][2][4][2];
#pragma unroll
    for (int a = 0; a < 2; ++a)
#pragma unroll
        for (int b = 0; b < 2; ++b)
#pragma unroll
            for (int m = 0; m < 4; ++m)
#pragma unroll
                for (int n = 0; n < 2; ++n) acc[a][b][m][n] = (f32x4){0.f, 0.f, 0.f, 0.f};
    bf16x8 At[4][2], B0[2][2], B1[2][2];
    const char* cA = (const char*)g.A + (size_t)cur.pm * tstep; const char* cB = (const char*)g.Bt + (size_t)cur.pn * tstep;
    S.a_ready(cur);
    if constexpr (SP2) {
        PG8_STAGE(PG8_SB(0, 0), cB, voffB); PG8_STAGE(PG8_SB(0, 1), cB + hstep, voffB); PG8_STAGE(PG8_SA(0, 0), cA, voffA); PG8_STAGE(PG8_SA(0, 1), cA + hstep, voffA);
        if (wr == 1) PG8_BAR;
        PG8_WAIT_V(2); PG8_BAR;
        PG8_STAGE(PG8_SB(1, 0), cB + kstep, voffB); PG8_STAGE(PG8_SA(1, 0), cA + kstep, voffA); PG8_STAGE(PG8_SB(1, 1), cB + hstep + kstep, voffB);
        PG8_WAIT_V(6); PG8_BAR;
    } else {
        PG8_STAGE(PG8_SB(0, 0), cB, voffB); PG8_STAGE(PG8_SA(0, 0), cA, voffA); PG8_STAGE(PG8_SB(0, 1), cB + hstep, voffB); PG8_STAGE(PG8_SA(0, 1), cA + hstep, voffA);
        if (wr == 1) PG8_BAR;
        PG8_WAIT_V(4); PG8_BAR;
        PG8_STAGE(PG8_SB(1, 0), cB + kstep, voffB); PG8_STAGE(PG8_SA(1, 0), cA + kstep, voffA); PG8_STAGE(PG8_SB(1, 1), cB + hstep + kstep, voffB);
        PG8_WAIT_V(6); PG8_BAR;
    }
    for (;;) {
        const bool has_next = S.next(ui + 1, nxt);
        const char* nA = has_next ? (const char*)g.A + (size_t)nxt.pm * tstep : cA; const char* nB = has_next ? (const char*)g.Bt + (size_t)nxt.pn * tstep : cB;
#if PROBE_KL
        unsigned long long pk_t0 = 0; if (Epi::PERM && Epi::NSTORE == 16 && ui == 2 && blockIdx.x == 0 && wid == 0) pk_t0 = __builtin_readcyclecounter();
#endif
        for (int t = 0; t < nt; t += 2) {
            const bool last = (t == nt - 2);
            const char* a1 = cA + (size_t)(t + 1) * kstep;
            const char* a2 = last ? nA : cA + (size_t)(t + 2) * kstep; const char* b2 = last ? nB : cB + (size_t)(t + 2) * kstep;
            const char* a3 = a2 + kstep; const char* b3 = b2 + kstep;
            if (last && has_next) S.a_ready(nxt);
            if constexpr (SP2) {
            PG8_LDB(B0, 0, 0); PG8_LDB(B1, 0, 1); PG8_SCHED; PG8_LDA(At, 0, 0); PG8_STAGE(PG8_SA(1, 1), a1 + hstep, voffA);
            PG8_WAIT_V(8); PG8_WAIT_L(0); PG8_BAR; PG8_MMA(0, 0, At, B0); PG8_MMA(0, 1, At, B1); PG8_BAR; PG8_SCHED;
            PG8_LDA(At, 0, 1); PG8_STAGE(PG8_SB(0, 0), b2, voffB); PG8_STAGE(PG8_SB(0, 1), b2 + hstep, voffB); PG8_STAGE(PG8_SA(0, 0), a2, voffA);
            PG8_WAIT_V(8); PG8_WAIT_L(0); PG8_BAR; PG8_MMA(1, 0, At, B0); PG8_MMA(1, 1, At, B1); PG8_BAR; PG8_SCHED;
            PG8_LDB(B0, 1, 0); PG8_LDB(B1, 1, 1); PG8_SCHED; PG8_LDA(At, 1, 0); PG8_STAGE(PG8_SA(0, 1), a2 + hstep, voffA);
            PG8_WAIT_V(8); PG8_WAIT_L(0); PG8_BAR; PG8_MMA(0, 0, At, B0); PG8_MMA(0, 1, At, B1); PG8_BAR; PG8_SCHED;
            PG8_LDA(At, 1, 1); PG8_STAGE(PG8_SB(1, 0), b3, voffB); PG8_STAGE(PG8_SB(1, 1), b3 + hstep, voffB); PG8_STAGE(PG8_SA(1, 0), a3, voffA);
            PG8_WAIT_V(8); PG8_WAIT_L(0); PG8_BAR; PG8_MMA(1, 0, At, B0); PG8_MMA(1, 1, At, B1); PG8_BAR; PG8_SCHED;
            } else {
            PG8_LDB(B0, 0, 0); PG8_SCHED; PG8_LDA(At, 0, 0); PG8_STAGE(PG8_SA(1, 1), a1 + hstep, voffA);
            PG8_WAIT_L(8); PG8_BAR; PG8_WAIT_L(0); PG8_MMA(0, 0, At, B0); PG8_BAR; PG8_SCHED;
            PG8_LDB(B1, 0, 1); PG8_STAGE(PG8_SB(0, 0), b2, voffB);
            PG8_BAR; PG8_WAIT_L(0); PG8_MMA(0, 1, At, B1); PG8_BAR;
            PG8_LDA(At, 0, 1); PG8_STAGE(PG8_SA(0, 0), a2, voffA);
            PG8_BAR; PG8_WAIT_L(0); PG8_MMA(1, 0, At, B0); PG8_BAR; PG8_SCHED;
            PG8_STAGE(PG8_SB(0, 1), b2 + hstep, voffB);
            PG8_WAIT_V(6); PG8_BAR; PG8_MMA(1, 1, At, B1); PG8_BAR;
            PG8_LDB(B0, 1, 0); PG8_SCHED; PG8_LDA(At, 1, 0); PG8_STAGE(PG8_SA(0, 1), a2 + hstep, voffA);
            PG8_WAIT_L(8); PG8_BAR; PG8_WAIT_L(0); PG8_MMA(0, 0, At, B0); PG8_BAR; PG8_SCHED;
            PG8_LDB(B1, 1, 1); PG8_STAGE(PG8_SB(1, 0), b3, voffB);
            PG8_BAR; PG8_WAIT_L(0); PG8_MMA(0, 1, At, B1); PG8_BAR;
            PG8_LDA(At, 1, 1); PG8_STAGE(PG8_SA(1, 0), a3, voffA);
            PG8_BAR; PG8_WAIT_L(0); PG8_MMA(1, 0, At, B0); PG8_BAR; PG8_SCHED;
            PG8_STAGE(PG8_SB(1, 1), b3 + hstep, voffB);
            PG8_WAIT_V(6); PG8_BAR; PG8_MMA(1, 1, At, B1); PG8_BAR;
            }
        }
#if PROBE_KL
        unsigned long long pk_t1 = 0; if (Epi::PERM && Epi::NSTORE == 16 && ui == 2 && blockIdx.x == 0 && wid == 0) pk_t1 = __builtin_readcyclecounter();
#endif
        if constexpr (ALIGN_EPI) { if (wr == 0) PG8_BAR; }
        if constexpr (!Epi::AFTER_DRAIN) { E(acc, cur, wr, wc, fr, fq);
#if PROBE_EPI2
            if constexpr (Epi::PERM) { asm volatile("" ::: "memory"); E(acc, cur, wr, wc, fr, fq); }
#endif
            S.done(cur); }
#if PROBE_KL
        if (Epi::PERM && Epi::NSTORE == 16 && ui == 2 && blockIdx.x == 0 && wid == 0) { asm volatile("s_waitcnt vmcnt(0)" ::: "memory"); const unsigned long long pk_t2 = __builtin_readcyclecounter(); if (lane == 0 && (PROBE_KL_FIRST == 0 || probe_kl[0] == 0ull)) { probe_kl[0] = pk_t1 - pk_t0; probe_kl[1] = pk_t2 - pk_t1; } }
#endif
        if (!has_next) break;
#pragma unroll
        for (int a = 0; a < 2; ++a)
#pragma unroll
            for (int b = 0; b < 2; ++b)
#pragma unroll
                for (int m = 0; m < 4; ++m)
#pragma unroll
                    for (int n = 0; n < 2; ++n) acc[a][b][m][n] = (f32x4){0.f, 0.f, 0.f, 0.f};
        cur = nxt; cA = nA; cB = nB; ++ui;
        if constexpr (ALIGN_EPI) { if (wr == 1) PG8_BAR; }
    }
    PG8_WAIT_V(0);
    if constexpr (!ALIGN_EPI) { if (wr == 0) PG8_BAR; }
    PG8_BAR;
    if constexpr (Epi::AFTER_DRAIN) { E.fused(acc, cur, wr, wc, fr, fq, lds, wid, lane); S.done(cur); }
#undef PG8_SA
#undef PG8_SB
#undef PG8_STAGE
#undef PG8_LDA
#undef PG8_LDB
#undef PG8_MMA
#undef PG8_WAIT_V
#undef PG8_WAIT_L
#undef PG8_BAR
#undef PG8_SCHED
}
}

#ifndef MK_PER_PHASE
#define MK_PER_PHASE 0
#endif
constexpr int NWAVES = 8;
constexpr int DM = 1024, NB = 32, SEQ = 2048, NL = 4, MT = NB * SEQ;
constexpr int D_IN = 3976, NPI = 4096, DFF = 2816, NF1 = 2 * DFF;
constexpr int RW_B = 1024, ML_B = 2432;
constexpr int RWKV_IN = 1408;
constexpr float RMS_EPS = 1e-6f, GN_EPS = 1e-5f;
constexpr int MODP = 6 * DM;
constexpr size_t MiB = 1u << 20;
constexpr size_t WS_CTL = 0, CTL_ZERO_BYTES = 1 * MiB;
constexpr size_t WS_HS = 116 * MiB;
constexpr int CW_PCNT = 32768, PCNT_BANK = 256 * 64;
constexpr int CW_FLAG = 16384;
constexpr int SPLIT_H = 4, SPLIT_X = 28, SPLIT_Y = 16;
constexpr size_t WS_WL = 5 * MiB;
constexpr size_t WS_MOD = 1 * MiB;
constexpr size_t WS_WIN = 8 * MiB, WS_WOUT = 40 * MiB, WS_WF1 = 48 * MiB, WS_WF2 = 92 * MiB;
constexpr size_t WS_H = 128 * MiB;
constexpr size_t WS_PROJ = 256 * MiB;
constexpr size_t WS_XFIN = (256 + 352) * MiB;
constexpr size_t WS_DEC = 768 * MiB, WS_AA = 864 * MiB, WS_GG = 912 * MiB;
constexpr size_t WS_END = 960 * MiB;
constexpr int CW_BAR = 4096;
constexpr int N_PHASES = 3 + 6 * NL;
static_assert((CW_BAR + (MK_PER_PHASE ? 1 : 1) * 3456) * 4 <= (int)CTL_ZERO_BYTES, "ctl");
constexpr int RING_BYTES = 131072, LDS_BYTES = 163840, LDSCTL_OFF = LDS_BYTES - 1024, MISC_OFF = LDSCTL_OFF + 320;

#define GAS __attribute__((address_space(1)))
#define LAS __attribute__((address_space(3)))
typedef unsigned short bf16;
typedef unsigned v4u __attribute__((ext_vector_type(4)));
typedef unsigned v2u __attribute__((ext_vector_type(2)));
typedef float f32x4 __attribute__((ext_vector_type(4)));
#define LDS_WAIT() asm volatile("s_waitcnt lgkmcnt(0)" ::: "memory")
typedef float f32x2c __attribute__((ext_vector_type(2)));
typedef __bf16 bf16x2c __attribute__((ext_vector_type(2)));
__device__ __forceinline__ unsigned f2bf(float f) { return (__builtin_bit_cast(unsigned, f) + 0x8000u) >> 16; }
__device__ __forceinline__ unsigned pk2(float lo, float hi) { return __builtin_amdgcn_perm(__builtin_bit_cast(unsigned, hi) + 0x8000u, __builtin_bit_cast(unsigned, lo) + 0x8000u, 0x07060302u); }
__device__ __forceinline__ float bf2f(bf16 v) { return __uint_as_float(((unsigned)v) << 16); }
template <int CTRL, int ROWMASK> __device__ __forceinline__ float dppf(float v) { return __builtin_bit_cast(float, __builtin_amdgcn_update_dpp(0, __builtin_bit_cast(int, v), CTRL, ROWMASK, 0xf, false)); }
__device__ __forceinline__ float sum16(float v) { v += dppf<0xB1, 0xf>(v); v += dppf<0x4E, 0xf>(v); v += dppf<0x141, 0xf>(v); v += dppf<0x140, 0xf>(v); return v; }
__device__ __forceinline__ float wave_sum(float v) { v = sum16(v); v += dppf<0x142, 0xa>(v); v += dppf<0x143, 0xc>(v); return __builtin_bit_cast(float, __builtin_amdgcn_readlane(__builtin_bit_cast(int, v), 63)); }
template <int CTRL, int ROWMASK> __device__ __forceinline__ float dppo(float v, float old) { return __builtin_bit_cast(float, __builtin_amdgcn_update_dpp(__builtin_bit_cast(int, old), __builtin_bit_cast(int, v), CTRL, ROWMASK, 0xf, false)); }
__device__ __forceinline__ float wave_prefix_sum(float v) { v += dppo<0x111, 0xf>(v, 0.f); v += dppo<0x112, 0xf>(v, 0.f); v += dppo<0x114, 0xf>(v, 0.f); v += dppo<0x118, 0xf>(v, 0.f); v += dppo<0x142, 0xa>(v, 0.f); v += dppo<0x143, 0xc>(v, 0.f); return v; }
__device__ __forceinline__ float wave_prefix_max(float v) { const float ni = -__builtin_inff(); v = fmaxf(v, dppo<0x111, 0xf>(v, ni)); v = fmaxf(v, dppo<0x112, 0xf>(v, ni)); v = fmaxf(v, dppo<0x114, 0xf>(v, ni)); v = fmaxf(v, dppo<0x118, 0xf>(v, ni));
    v = fmaxf(v, dppo<0x142, 0xa>(v, ni)); v = fmaxf(v, dppo<0x143, 0xc>(v, ni)); return v; }
__device__ __forceinline__ float flogsigmoid(float x) { return fminf(x, 0.f) - __logf(1.0f + __expf(-fabsf(x))); }
__device__ __forceinline__ float fexp(float x) { return __expf(x); }
__device__ __forceinline__ float fsigmoid(float x) { return __builtin_amdgcn_rcpf(1.0f + __expf(-x)); }
__device__ __forceinline__ float sigmoid_f(float x) { return 1.0f / (1.0f + expf(-x)); }
__device__ __forceinline__ float logsigmoid_f(float x) { return fminf(x, 0.f) - log1pf(expf(-fabsf(x))); }
template <class T> __device__ __forceinline__ T* opq(T* p) { asm volatile("" : "+s"(p)); return p; }

#define XB_TMO      128
#define XB_XCNT(j)  (256  + 64 * (j))
#define XB_XSUB(j)  (1280 + 64 * (j))
#define XB_XGEN(j)  (2304 + 64 * (j))
#define XB_TOP      3328
#define XB_TOPGEN   3392
#define XCD_BAR_WORDS 3456
#define XB_SPIN_CAP (1u << 22)

__device__ __forceinline__ unsigned xb_ld(unsigned* p)              { return __hip_atomic_load(p, __ATOMIC_RELAXED, __HIP_MEMORY_SCOPE_AGENT); }
__device__ __forceinline__ unsigned xb_add(unsigned* p, unsigned v) { return __hip_atomic_fetch_add(p, v, __ATOMIC_RELAXED, __HIP_MEMORY_SCOPE_AGENT); }
__device__ __forceinline__ unsigned xb_xcc_id() { return (unsigned)__builtin_amdgcn_s_getreg((3 << 11) | 20) & 0xFu; }
#define XB_SPIN(cond, bar) do { unsigned _sp = 0; while (cond) { __builtin_amdgcn_s_sleep(1); \
    if ((++_sp & 255u) == 0u) { if (xb_ld(&(bar)[XB_TMO])) break; if (_sp > XB_SPIN_CAP) { atomicAdd(&(bar)[XB_TMO], 1u); break; } } } } while (0)

struct XcdBarrier {
    unsigned* bar; unsigned x; unsigned w0;
    volatile LAS unsigned* st;
};

__device__ __forceinline__ XcdBarrier xcd_barrier_post(unsigned* bar, volatile LAS unsigned* st) {
    XcdBarrier b; b.bar = bar; b.x = xb_xcc_id(); b.st = st; b.w0 = (__builtin_amdgcn_readfirstlane((int)threadIdx.x >> 6) == 0) ? 1u : 0u;
    if (threadIdx.x == 0) (void)xb_add(&bar[XB_XCNT(b.x)], 1u);
    return b;
}
__device__ __forceinline__ void xcd_barrier_complete(unsigned* bar, unsigned x, unsigned& nloc, unsigned& nx) {
    const unsigned G = gridDim.x * gridDim.y * gridDim.z;
    unsigned sum, cnt, mine, sp = 0u;
    for (;;) {
        sum = 0u; cnt = 0u; mine = 0u;
#pragma unroll
        for (unsigned j = 0; j < 16; ++j) { const unsigned c = xb_ld(&bar[XB_XCNT(j)]); sum += c; cnt += (c > 0u) ? 1u : 0u; mine = (j == x) ? c : mine; }
        if (sum == G) break;
        __builtin_amdgcn_s_sleep(1);
        if ((++sp & 255u) == 0u) { if (xb_ld(&bar[XB_TMO])) break; if (sp > XB_SPIN_CAP) { atomicAdd(&bar[XB_TMO], 1u); break; } }
    }
    nloc = mine > 0u ? mine : 1u; nx = cnt > 0u ? cnt : 1u;
}

__device__ __forceinline__ void xcd_barrier(const XcdBarrier& b) {
    asm volatile("s_waitcnt vmcnt(0)" ::: "memory");
    __syncthreads();
    if (b.w0 != 0u && lane_id_opq() == 0) {
        unsigned* bar = b.bar;
        __builtin_amdgcn_s_waitcnt(0);
        unsigned nloc = b.st[0], nx = b.st[1];
        if (nloc == 0u) { xcd_barrier_complete(bar, b.x, nloc, nx); b.st[0] = nloc; b.st[1] = nx; }
        const unsigned old = xb_add(&bar[XB_XSUB(b.x)], 1u);
        const unsigned gen = old / nloc;
        if (old + 1u == (gen + 1u) * nloc) {
            __builtin_amdgcn_fence(__ATOMIC_RELEASE, "agent");
            asm volatile("s_waitcnt vmcnt(0)" ::: "memory");
            const unsigned og = xb_add(&bar[XB_TOP], 1u);
            const unsigned tg = og / nx;
            if (og + 1u == (tg + 1u) * nx) xb_add(&bar[XB_TOPGEN], 1u);
            else XB_SPIN(xb_ld(&bar[XB_TOPGEN]) == tg, bar);
            __builtin_amdgcn_fence(__ATOMIC_ACQUIRE, "agent");
            xb_add(&bar[XB_XGEN(b.x)], 1u);
            asm volatile("s_waitcnt vmcnt(0)" ::: "memory");
        } else {
            XB_SPIN(xb_ld(&bar[XB_XGEN(b.x)]) == gen, bar);
            __builtin_amdgcn_fence(__ATOMIC_ACQUIRE, "agent");
            asm volatile("s_waitcnt vmcnt(0)" ::: "memory");
        }
    }
    __syncthreads();
}


__device__ __forceinline__ void b32_gemv(const float* Wcol  , bool ok, int N, LAS float* vT, float (&res)[4], int wave, int lane) {
    float acc[32];
#pragma unroll
    for (int b = 0; b < 32; ++b) acc[b] = 0.f;
    const float* wp = Wcol + (size_t)(128 * wave) * N; const LAS float* vp = vT + 128 * wave * 32;
#pragma unroll 1
    for (int kk = 0; kk < 128; kk += 8) {
        float w[8];
#pragma unroll
        for (int u = 0; u < 8; ++u) w[u] = ok ? wp[(size_t)u * N] : 0.f;
        wp += (size_t)8 * N;
#pragma unroll
        for (int u = 0; u < 8; ++u) {
#pragma unroll
            for (int b4 = 0; b4 < 8; ++b4) { const f32x4 cv = *(const LAS f32x4*)(vp + u * 32 + 4 * b4);
                acc[4 * b4] += cv.x * w[u]; acc[4 * b4 + 1] += cv.y * w[u]; acc[4 * b4 + 2] += cv.z * w[u]; acc[4 * b4 + 3] += cv.w * w[u]; }
            asm volatile("" ::: "memory"); }
        vp += 8 * 32;
    }
    __syncthreads();
#pragma unroll
    for (int b = 0; b < 32; ++b) vT[(wave * 32 + b) * 64 + lane] = acc[b];
    __syncthreads();
#pragma unroll
    for (int q = 0; q < 4; ++q) { float s = 0.f;
#pragma unroll
        for (int w2 = 0; w2 < 8; ++w2) s += vT[(w2 * 32 + 4 * wave + q) * 64 + lane];
        res[q] = s; }
    __syncthreads();
}
__device__ __forceinline__ void p0_mod(const float* c, const float* ada_w, const float* ada_b, float* mod, LAS unsigned char* lds, int tid, int lane, int wave) {
    LAS float* condT = (LAS float*)lds;
    for (int item = blockIdx.x; item < NL * 96; item += gridDim.x) {
        __syncthreads();
        for (int e = tid; e < NB * DM; e += NWAVES * 64) { const int k = e >> 5, b = e & 31; const float v = c[b * DM + k]; condT[e] = v / (1.0f + expf(-v)); }
        __syncthreads();
        const int l = item / 96, g = item % 96, n = g * 64 + lane;
        float res[4]; b32_gemv(ada_w + (size_t)l * DM * MODP + n, true, MODP, condT, res, wave, lane);
        const float bb = ada_b[l * MODP + n]; float* o = mod + ((size_t)l * NB + wave * 4) * MODP + n;
        o[0] = res[0] + bb; o[MODP] = res[1] + bb; o[2 * MODP] = res[2] + bb; o[3 * MODP] = res[3] + bb;
    }
    __syncthreads();
}
template <int MODE>
__device__ __forceinline__ void transpose_item(const float* W, int K, int N, int nblk, bf16* WT, int ldw, LAS float* scr, int item, int lane) {
    const int kb = item / nblk, nb = item % nblk, k0 = 64 * kb, n0 = 32 * nb;
    const int nq = lane & 7, nn = n0 + 4 * nq; const bool ok = nn < N;
    const float* wp = W + (size_t)(k0 + (lane >> 3)) * N + (ok ? nn : 0); f32x4 vv[8];
#pragma unroll
    for (int i = 0; i < 8; ++i) vv[i] = *(const f32x4*)(wp + (size_t)(8 * i) * N);
#pragma unroll
    for (int i = 0; i < 8; ++i) { const int kk = 8 * i + (lane >> 3); const f32x4 v = ok ? vv[i] : (f32x4){0.f, 0.f, 0.f, 0.f};
        LAS float* d = scr + kk * 33 + 4 * nq; d[0] = v.x; d[1] = v.y; d[2] = v.z; d[3] = v.w; }
    LDS_WAIT();
    const int c = lane & 7;
#pragma unroll
    for (int j = 0; j < 4; ++j) { const int n = (lane >> 3) + 8 * j; const LAS float* s = scr + (8 * c) * 33 + n;
        v4u o; o.x = pk2(s[0 * 33], s[1 * 33]); o.y = pk2(s[2 * 33], s[3 * 33]); o.z = pk2(s[4 * 33], s[5 * 33]); o.w = pk2(s[6 * 33], s[7 * 33]);
        int row = n0 + n;
        if (MODE == 1) { const int up = row >= DFF ? 1 : 0, jj = row - up * DFF; row = (jj >> 7) * 256 + up * 128 + (jj & 127); }
        *(v4u*)(WT + (size_t)row * ldw + k0 + 8 * c) = o; }
    LDS_WAIT();
}
__device__ __forceinline__ void p0_weights(const float* w_in, const float* w_out, const float* f1, const float* f2, const float* lw2, const float* la2, const float* lg2, unsigned char* ws, LAS unsigned char* lds, int gw, int ngw, int wave, int lane) {
    LAS float* scr = (LAS float*)(lds + wave * 16384);
    constexpr int I_IN = (DM / 64) * (NPI / 32), I_OUT = (DM / 64) * (DM / 32), I_F1 = (DM / 64) * (NF1 / 32), I_F2 = (DFF / 64) * (DM / 32), I_L = I_IN + I_OUT + I_F1 + I_F2 + 48;
    for (int it = gw; it < NL * I_L; it += ngw) {
        const int l = it / I_L; int r = it % I_L;
        if (r < I_IN) { transpose_item<0>(w_in + (size_t)l * DM * D_IN, DM, D_IN, NPI / 32, (bf16*)(ws + WS_WIN) + (size_t)l * NPI * DM, DM, scr, r, lane); continue; } r -= I_IN;
        if (r < I_OUT) { transpose_item<0>(w_out + (size_t)l * DM * DM, DM, DM, DM / 32, (bf16*)(ws + WS_WOUT) + (size_t)l * DM * DM, DM, scr, r, lane); continue; } r -= I_OUT;
        if (r < I_F1) { transpose_item<1>(f1 + (size_t)l * DM * NF1, DM, NF1, NF1 / 32, (bf16*)(ws + WS_WF1) + (size_t)l * NF1 * DM, DM, scr, r, lane); continue; } r -= I_F1;
        if (r < I_F2) { transpose_item<0>(f2 + (size_t)l * DFF * DM, DFF, DM, DM / 32, (bf16*)(ws + WS_WF2) + (size_t)l * DM * DFF, DFF, scr, r, lane); continue; } r -= I_F2;
        bf16* wl = (bf16*)(ws + WS_WL) + (size_t)l * 384 * 256;
        if (r < 12) { transpose_item<0>(lw2 + (size_t)l * 64 * 384, 64, 384, 12, wl, 256, scr, r, lane); continue; } r -= 12;
        if (r < 12) { transpose_item<0>(la2 + (size_t)l * 64 * 384, 64, 384, 12, wl + 64, 256, scr, r, lane); continue; } r -= 12;
        transpose_item<0>(lg2 + (size_t)l * 128 * 384, 128, 384, 12, wl + 128, 256, scr, r, lane);
    }
}
__device__ __forceinline__ void norm_mod_phase(const float* xin32, const float* gain, const float* modl, int sh_off, int sc_off, bf16* out, int gw, int ngw, int lane) {
    for (int ci = gw; ci < MT / 32; ci += ngw) {
        const int b = ci >> 6; const float* mb = modl + (size_t)b * MODP;
        f32x4 gs[4], sh[4];
#pragma unroll
        for (int j = 0; j < 4; ++j) { const int col = 4 * lane + 256 * j; const f32x4 g = *(const f32x4*)(gain + col), s = *(const f32x4*)(mb + sc_off + col); gs[j] = g * (s + 1.0f); sh[j] = *(const f32x4*)(mb + sh_off + col); }
#pragma unroll 1
        for (int r = 0; r < 32; r += 4) {
            const size_t row = (size_t)ci * 32 + r; const f32x4* xr = (const f32x4*)(xin32 + row * DM) + lane; f32x4 v[4][4];
#pragma unroll
            for (int q = 0; q < 4; ++q)
#pragma unroll
                for (int j = 0; j < 4; ++j) v[q][j] = xr[q * (DM / 4) + 64 * j];
#pragma unroll
            for (int q = 0; q < 4; ++q) { float ss = 0.f;
#pragma unroll
                for (int j = 0; j < 4; ++j) ss += (v[q][j].x * v[q][j].x + v[q][j].y * v[q][j].y) + (v[q][j].z * v[q][j].z + v[q][j].w * v[q][j].w);
                const float rstd = 1.0f / sqrtf(wave_sum(ss) * (1.0f / DM) + RMS_EPS);
                v2u* o8 = (v2u*)(out + (row + q) * DM) + lane;
#pragma unroll
                for (int j = 0; j < 4; ++j) { const f32x4 y = v[q][j] * rstd * gs[j] + sh[j]; v2u w; w.x = pk2(y.x, y.y); w.y = pk2(y.z, y.w); o8[64 * j] = w; } }
        }
    }
}
__device__ __forceinline__ void final_norm_phase(const bf16* xs, float* out, const float* gain, int gw, int ngw, int lane) {
    f32x4 g[4];
#pragma unroll
    for (int j = 0; j < 4; ++j) g[j] = *(const f32x4*)(gain + 4 * lane + 256 * j);
#pragma unroll 1
    for (int row = 4 * gw; row < MT; row += 4 * ngw) {
        const v2u* xr = (const v2u*)(xs + (size_t)row * DM) + lane; v2u w[4][4];
#pragma unroll
        for (int q = 0; q < 4; ++q)
#pragma unroll
            for (int j = 0; j < 4; ++j) w[q][j] = xr[q * (DM / 4) + 64 * j];
#pragma unroll
        for (int q = 0; q < 4; ++q) { f32x4 v[4]; float ss = 0.f;
#pragma unroll
            for (int j = 0; j < 4; ++j) { const v2u ww = w[q][j]; v[j] = (f32x4){__uint_as_float(ww.x << 16), __uint_as_float(ww.x & 0xffff0000u), __uint_as_float(ww.y << 16), __uint_as_float(ww.y & 0xffff0000u)};
                ss += (v[j].x * v[j].x + v[j].y * v[j].y) + (v[j].z * v[j].z + v[j].w * v[j].w); }
            const float rstd = 1.0f / sqrtf(wave_sum(ss) * (1.0f / DM) + RMS_EPS);
            f32x4* o = (f32x4*)(out + (size_t)(row + q) * DM) + lane;
#pragma unroll
            for (int j = 0; j < 4; ++j) o[64 * j] = v[j] * rstd * g[j]; }
    }
}
__device__ __forceinline__ void panel_norm_rows(const bf16* xs, const float* gain, const float* modb, int sh_off, int sc_off, bf16* out, int pm, int wave, int lane) {
    f32x4 gs[4], sh[4];
#pragma unroll
    for (int j = 0; j < 4; ++j) { const int col = 4 * lane + 256 * j; const f32x4 g = *(const f32x4*)(gain + col), s = *(const f32x4*)(modb + sc_off + col); gs[j] = g * (s + 1.0f); sh[j] = *(const f32x4*)(modb + sh_off + col); }
#pragma unroll 1
    for (int r = 0; r < 32; r += 4) {
        const size_t row = (size_t)pm * 256 + wave * 32 + r;
        const v2u* xr = (const v2u*)(xs + row * DM) + lane; v2u w[4][4];
#pragma unroll
        for (int q = 0; q < 4; ++q)
#pragma unroll
            for (int j = 0; j < 4; ++j) w[q][j] = xr[q * (DM / 4) + 64 * j];
#pragma unroll
        for (int q = 0; q < 4; ++q) { f32x4 v[4]; float ss = 0.f;
#pragma unroll
            for (int j = 0; j < 4; ++j) { const v2u ww = w[q][j]; v[j] = (f32x4){__uint_as_float(ww.x << 16), __uint_as_float(ww.x & 0xffff0000u), __uint_as_float(ww.y << 16), __uint_as_float(ww.y & 0xffff0000u)};
                ss += (v[j].x * v[j].x + v[j].y * v[j].y) + (v[j].z * v[j].z + v[j].w * v[j].w); }
            const float rstd = __builtin_amdgcn_rsqf(wave_sum(ss) * (1.0f / DM) + RMS_EPS);
            v2u* o8 = (v2u*)(out + (row + q) * DM) + lane;
#pragma unroll
            for (int j = 0; j < 4; ++j) { const f32x4 y = v[j] * rstd * gs[j] + sh[j]; v2u ww; ww.x = pk2(y.x, y.y); ww.y = pk2(y.z, y.w); o8[64 * j] = ww; } }
    }
}
template <class Sched>
__device__ __forceinline__ void fused_panel_norm(const Sched& S, unsigned* cnt, const bf16* xs, const float* gain, const float* modl, int sh_off, int sc_off, bf16* out, int wave, int lane) {
    pg8::Unit u[4]; bool has[4];
#pragma unroll
    for (int i = 0; i < 4; ++i) has[i] = S.next(i, u[i]);
    if (wave == 0 && lane == 0) {
        __builtin_amdgcn_fence(__ATOMIC_RELEASE, "agent"); asm volatile("s_waitcnt vmcnt(0)" ::: "memory");
#pragma unroll
        for (int i = 0; i < 4; ++i) if (has[i]) __hip_atomic_fetch_add(cnt + 64 * u[i].pm, 1u, __ATOMIC_RELAXED, __HIP_MEMORY_SCOPE_AGENT);
    }
#pragma unroll
    for (int i = 0; i < 4; ++i) {
        if (!has[i] || u[i].pn != ((u[i].pm >> 3) & 3)) continue;
        if (wave == 0) { unsigned spins = 0u;
            while (__hip_atomic_load(cnt + 64 * u[i].pm, __ATOMIC_RELAXED, __HIP_MEMORY_SCOPE_AGENT) < 4u) { __builtin_amdgcn_s_sleep(2); if (++spins > (1u << 22)) break; }
            __builtin_amdgcn_fence(__ATOMIC_ACQUIRE, "agent"); asm volatile("s_waitcnt vmcnt(0)" ::: "memory"); }
        __syncthreads();
        panel_norm_rows(xs, gain, modl + (size_t)(u[i].pm >> 3) * MODP, sh_off, sc_off, out, u[i].pm, wave, lane);
#if PROBE_PN
        asm volatile("" ::: "memory"); panel_norm_rows(xs, gain, modl + (size_t)(u[i].pm >> 3) * MODP, sh_off, sc_off, out, u[i].pm, wave, lane);
#endif
    }
}
#define WG_BAR() do { asm volatile("s_waitcnt vmcnt(0) lgkmcnt(0)" ::: "memory"); __builtin_amdgcn_s_barrier(); asm volatile("" ::: "memory"); } while (0)
#define WG_BAR_L() do { asm volatile("s_waitcnt lgkmcnt(0)" ::: "memory"); __builtin_amdgcn_s_barrier(); asm volatile("" ::: "memory"); } while (0)
typedef short bf16x8p __attribute__((ext_vector_type(8)));
__device__ __forceinline__ void rwkv_prep_mfma(const bf16* proj, const float* mu, const float* w0, const float* a0, const bf16* WL, float* DEC, bf16* AA, bf16* GG, LAS unsigned char* lds, int wave) {
    constexpr int AP = 264;
    LAS bf16* act = (LAS bf16*)lds;
    bf16x8p bw[2][3], ba[2][3], bg[4][3];
    { const int lane = lane_id_opq(); const bf16* bfr = WL + (size_t)(48 * wave + (lane & 15)) * 256 + 8 * (lane >> 4);
#pragma unroll
      for (int nt = 0; nt < 3; ++nt) {
#pragma unroll
          for (int ks = 0; ks < 2; ++ks) { bw[ks][nt] = *(const bf16x8p*)(bfr + 16 * nt * 256 + 32 * ks); ba[ks][nt] = *(const bf16x8p*)(bfr + 16 * nt * 256 + 64 + 32 * ks); }
#pragma unroll
          for (int ks = 0; ks < 4; ++ks) bg[ks][nt] = *(const bf16x8p*)(bfr + 16 * nt * 256 + 128 + 32 * ks); } }
#pragma unroll 1
    for (int item = blockIdx.x; item < MT / 64; item += gridDim.x) {
        const int lane = lane_id_opq(), tid = wave * 64 + lane, q4 = lane >> 4, lc = lane & 15;
        const size_t m0 = (size_t)item * 64; const int t0 = (int)(m0 % SEQ);
        { const int tt = tid >> 3, cg = tid & 7; const bf16* p = proj + (m0 + tt) * NPI + RW_B + 1152 + 32 * cg; const bool hp = (t0 + tt) > 0; const bf16* pp = hp ? p - NPI : p; const float* mup = mu + 1152 + 32 * cg;
          v4u cur[4], prv[4]; f32x4 m0v[4], m1v[4];
#pragma unroll
          for (int v = 0; v < 4; ++v) { cur[v] = *(const v4u*)(p + 8 * v); prv[v] = *(const v4u*)(pp + 8 * v); m0v[v] = *(const f32x4*)(mup + 8 * v); m1v[v] = *(const f32x4*)(mup + 8 * v + 4); }
#pragma unroll
          for (int v = 0; v < 4; ++v) {
              float x[8];
#pragma unroll
              for (int e = 0; e < 4; ++e) { const unsigned cw = cur[v][e], pw = hp ? prv[v][e] : 0u; const float c0 = __uint_as_float(cw << 16), c1 = __uint_as_float(cw & 0xffff0000u), p0 = __uint_as_float(pw << 16), p1 = __uint_as_float(pw & 0xffff0000u);
                  const float mu0 = e < 2 ? m0v[v][2 * e] : m1v[v][2 * e - 4], mu1 = e < 2 ? m0v[v][2 * e + 1] : m1v[v][2 * e - 3];
                  x[2 * e] = c0 + (p0 - c0) * mu0; x[2 * e + 1] = c1 + (p1 - c1) * mu1; }
              if (cg < 2) {
#pragma unroll
                  for (int e = 0; e < 8; ++e) x[e] = 2.0f * fsigmoid(2.0f * x[e]) - 1.0f;
              } else if (cg >= 4) {
#pragma unroll
                  for (int e = 0; e < 8; ++e) x[e] = fsigmoid(x[e]);
              }
              v4u o; o.x = pk2(x[0], x[1]); o.y = pk2(x[2], x[3]); o.z = pk2(x[4], x[5]); o.w = pk2(x[6], x[7]);
              *(LAS v4u*)(act + tt * AP + 32 * cg + 8 * v) = o; } }
        WG_BAR_L();
        const LAS bf16* afr = act + lc * AP + 8 * q4;
        { f32x4 acc[4][3];
#pragma unroll
          for (int mt = 0; mt < 4; ++mt)
#pragma unroll
              for (int nt = 0; nt < 3; ++nt) acc[mt][nt] = (f32x4){0.f, 0.f, 0.f, 0.f};
#pragma unroll
          for (int ks = 0; ks < 2; ++ks)
#pragma unroll
              for (int mt = 0; mt < 4; ++mt) { const bf16x8p aq = *(const LAS bf16x8p*)(afr + 16 * mt * AP + 32 * ks);
#pragma unroll
                  for (int nt = 0; nt < 3; ++nt) acc[mt][nt] = __builtin_amdgcn_mfma_f32_16x16x32_bf16(aq, bw[ks][nt], acc[mt][nt], 0, 0, 0); }
#pragma unroll
          for (int nt = 0; nt < 3; ++nt) { const int n = 48 * wave + 16 * nt + lc; const float w0n = w0[n]; float carry = 0.f;
#pragma unroll
              for (int mt = 0; mt < 4; ++mt) { float pr[4];
#pragma unroll
                  for (int r = 0; r < 4; ++r) { const float ld = -0.60653066f * fsigmoid(w0n + acc[mt][nt][r]); pr[r] = r ? pr[r - 1] + ld : ld; }
                  const float tot = pr[3]; float s1 = tot; { const float u = __shfl_up(s1, 16); if (q4 >= 1) s1 += u; } { const float u = __shfl_up(s1, 32); if (q4 >= 2) s1 += u; }
                  const float excl = carry + (s1 - tot), tile_tot = __shfl(s1, 48 + lc);
                  float* dp = DEC + (m0 + 16 * mt + 4 * q4) * 384 + n;
#pragma unroll
                  for (int r = 0; r < 4; ++r) dp[r * 384] = excl + pr[r];
                  carry += tile_tot; } } }
        { f32x4 acc[4][3];
#pragma unroll
          for (int mt = 0; mt < 4; ++mt)
#pragma unroll
              for (int nt = 0; nt < 3; ++nt) acc[mt][nt] = (f32x4){0.f, 0.f, 0.f, 0.f};
#pragma unroll
          for (int ks = 0; ks < 2; ++ks)
#pragma unroll
              for (int mt = 0; mt < 4; ++mt) { const bf16x8p aq = *(const LAS bf16x8p*)(afr + 16 * mt * AP + 64 + 32 * ks);
#pragma unroll
                  for (int nt = 0; nt < 3; ++nt) acc[mt][nt] = __builtin_amdgcn_mfma_f32_16x16x32_bf16(ba[ks][nt], aq, acc[mt][nt], 0, 0, 0); }
#pragma unroll
          for (int nt = 0; nt < 3; ++nt) { const int n = 48 * wave + 16 * nt + 4 * q4; const f32x4 a0n = *(const f32x4*)(a0 + n);
#pragma unroll
              for (int mt = 0; mt < 4; ++mt) { v2u w; w.x = pk2(fsigmoid(a0n.x + acc[mt][nt][0]), fsigmoid(a0n.y + acc[mt][nt][1])); w.y = pk2(fsigmoid(a0n.z + acc[mt][nt][2]), fsigmoid(a0n.w + acc[mt][nt][3]));
                  *(v2u*)(AA + (m0 + 16 * mt + lc) * 384 + n) = w; } } }
        { f32x4 acc[4][3];
#pragma unroll
          for (int mt = 0; mt < 4; ++mt)
#pragma unroll
              for (int nt = 0; nt < 3; ++nt) acc[mt][nt] = (f32x4){0.f, 0.f, 0.f, 0.f};
#pragma unroll
          for (int ks = 0; ks < 4; ++ks)
#pragma unroll
              for (int mt = 0; mt < 4; ++mt) { const bf16x8p aq = *(const LAS bf16x8p*)(afr + 16 * mt * AP + 128 + 32 * ks);
#pragma unroll
                  for (int nt = 0; nt < 3; ++nt) acc[mt][nt] = __builtin_amdgcn_mfma_f32_16x16x32_bf16(bg[ks][nt], aq, acc[mt][nt], 0, 0, 0); }
#pragma unroll
          for (int nt = 0; nt < 3; ++nt) { const int n = 48 * wave + 16 * nt + 4 * q4;
#pragma unroll
              for (int mt = 0; mt < 4; ++mt) { v2u w; w.x = pk2(acc[mt][nt][0], acc[mt][nt][1]); w.y = pk2(acc[mt][nt][2], acc[mt][nt][3]);
                  *(v2u*)(GG + (m0 + 16 * mt + lc) * 384 + n) = w; } } }
        WG_BAR_L();
    }
}
typedef short bf16x8_t __attribute__((ext_vector_type(8)));
template <int KS>
__device__ __forceinline__ f32x4 mm_tile(const LAS bf16* A, const LAS bf16* B, f32x4 acc) {
#pragma unroll
    for (int ks = 0; ks < KS; ++ks) {
        const bf16x8_t a = *(const LAS bf16x8_t*)(A + ks * 32), b = *(const LAS bf16x8_t*)(B + ks * 32);
        acc = __builtin_amdgcn_mfma_f32_16x16x32_bf16(a, b, acc, 0, 0, 0);
    }
    return acc;
}
__device__ __forceinline__ unsigned short f2bf16(float f) { return (unsigned short)f2bf(f); }
constexpr int LP = 72;
constexpr int LPM = 104;

__device__ __forceinline__ void ret_unit(int b, int h, const bf16* proj, const float* gn, bf16* mixed, LAS unsigned char* lds, int wave, int lane0) {
    LAS bf16* Qs = (LAS bf16*)lds; LAS bf16* Ks = Qs + 64 * LP; LAS bf16* Kdt = Ks + 64 * LP; LAS bf16* Vt = Kdt + 64 * LP; LAS bf16* Ps = Vt + 64 * LP; LAS bf16* Stt = Ps + 64 * LP; LAS bf16* Gs = Stt + 64 * LP;
    const int lane = lane0, q4 = lane >> 4, lc = lane & 15;
    const int pp0 = lane & 31, th0 = lane >> 5;
    f32x2c inv2; inv2.x = powf(10000.0f, -(float)(2 * ((2 * pp0) & 31)) / 64.0f); inv2.y = powf(10000.0f, -(float)(2 * ((2 * pp0 + 1) & 31)) / 64.0f);
    f32x2c cs[4], sn[4];
#pragma unroll
    for (int i = 0; i < 4; ++i) { const float tf = (float)(8 * wave + 4 * th0 + i); float s0_, c0_, s1_, c1_; __sincosf(tf * inv2.x, &s0_, &c0_); __sincosf(tf * inv2.y, &s1_, &c1_); sn[i] = (f32x2c){s0_, s1_}; cs[i] = (f32x2c){c0_, c1_}; }
    f32x2c c64, s64; { float s0_, c0_, s1_, c1_; sincosf(64.0f * inv2.x, &s0_, &c0_); sincosf(64.0f * inv2.y, &s1_, &c1_); s64 = (f32x2c){s0_, s1_}; c64 = (f32x2c){c0_, c1_}; }
    const float lg2 = log2f(1.0f - exp2f(-5.0f - (float)h));
    float kdec[4];
#pragma unroll
    for (int i = 0; i < 4; ++i) kdec[i] = exp2f((float)(63 - (8 * wave + 4 * th0 + i)) * lg2);
    const float cd = exp2f(64.0f * lg2);
    f32x4 st[4];
#pragma unroll
    for (int i = 0; i < 4; ++i) st[i] = (f32x4){0.f, 0.f, 0.f, 0.f};
    for (int i = wave * 64 + lane; i < 64 * LP / 2; i += 512) ((LAS unsigned*)Stt)[i] = 0u;
    const size_t m0 = (size_t)b * SEQ;
    const bf16* P0 = proj + m0 * NPI + h * 64;
    unsigned uq[4], uk[4], uv[4], ug[4];
#pragma unroll
    for (int i = 0; i < 4; ++i) { const bf16* p = P0 + (size_t)(8 * wave + 4 * th0 + i) * NPI + 2 * pp0; uq[i] = *(const unsigned*)p; uk[i] = *(const unsigned*)(p + 256); uv[i] = *(const unsigned*)(p + 512); ug[i] = *(const unsigned*)(p + 768); }
    float gain4[4];
#pragma unroll
    for (int ct = 0; ct < 4; ++ct) gain4[ct] = gn[h * 64 + 16 * ct + lc];
    float dmk[2][4], qdk[4];
#pragma unroll
    for (int u = 0; u < 2; ++u)
#pragma unroll
        for (int r = 0; r < 4; ++r) { const int l = 16 * (wave >> 1) + 4 * q4 + r, m = 16 * (2 * (wave & 1) + u) + lc; dmk[u][r] = (l >= m) ? exp2f((float)(l - m) * lg2) : 0.f; }
#pragma unroll
    for (int r = 0; r < 4; ++r) qdk[r] = exp2f((float)(16 * (wave & 3) + 4 * q4 + r + 1) * lg2);
#pragma unroll 1
    for (int c = 0; c < SEQ / 64; ++c) {
        const int lane = lane_id_opq(), q4 = lane >> 4, lc = lane & 15, o72 = lc * LP + 8 * q4;
        { const int pp = lane & 31, th = lane >> 5; const float sg = pp < 16 ? -1.0f : 1.0f; f32x2c kd[4];
#define RT_LO2(u) ((f32x2c){__uint_as_float((u) << 16), __uint_as_float((u) & 0xffff0000u)})
#pragma unroll
          for (int i = 0; i < 4; ++i) { const int tt = 8 * wave + 4 * th + i;
              const f32x2c q = RT_LO2(uq[i]), k = RT_LO2(uk[i]); f32x2c qp, kp; qp.x = __shfl_xor(q.x, 16); qp.y = __shfl_xor(q.y, 16); kp.x = __shfl_xor(k.x, 16); kp.y = __shfl_xor(k.y, 16);
              const f32x2c sns = sn[i] * sg;
              const f32x2c qr = q * cs[i] + qp * sns, kr = (k * cs[i] + kp * sns) * 0.125f;
              *(LAS unsigned*)(Qs + tt * LP + 2 * pp) = pk2(qr.x, qr.y); *(LAS unsigned*)(Ks + tt * LP + 2 * pp) = pk2(kr.x, kr.y); *(LAS unsigned*)(Gs + tt * LP + 2 * pp) = ug[i]; kd[i] = kr * kdec[i];
              const f32x2c cn = cs[i] * c64 - sn[i] * s64, snn = sn[i] * c64 + cs[i] * s64; cs[i] = cn; sn[i] = snn; }
#undef RT_LO2
          const int col = 8 * wave + 4 * th;
          *(LAS v2u*)(Kdt + (2 * pp) * LP + col) = (v2u){pk2(kd[0].x, kd[1].x), pk2(kd[2].x, kd[3].x)}; *(LAS v2u*)(Kdt + (2 * pp + 1) * LP + col) = (v2u){pk2(kd[0].y, kd[1].y), pk2(kd[2].y, kd[3].y)};
          *(LAS v2u*)(Vt + (2 * pp) * LP + col) = (v2u){(uv[0] & 0xffffu) | (uv[1] << 16), (uv[2] & 0xffffu) | (uv[3] << 16)};
          *(LAS v2u*)(Vt + (2 * pp + 1) * LP + col) = (v2u){(uv[0] >> 16) | (uv[1] & 0xffff0000u), (uv[2] >> 16) | (uv[3] & 0xffff0000u)}; }
        WG_BAR_L();
        if (c + 1 < SEQ / 64) {
#pragma unroll
            for (int i = 0; i < 4; ++i) { const bf16* p = P0 + (size_t)(64 * (c + 1) + 8 * wave + 4 * (lane >> 5) + i) * NPI + 2 * (lane & 31); uq[i] = *(const unsigned*)p; uk[i] = *(const unsigned*)(p + 256); uv[i] = *(const unsigned*)(p + 512); ug[i] = *(const unsigned*)(p + 768); } }
        { const int rt = wave >> 1;
#pragma unroll
          for (int u = 0; u < 2; ++u) { const int ct = 2 * (wave & 1) + u;
              f32x4 s = (f32x4){0.f, 0.f, 0.f, 0.f};
              if (ct <= rt) s = mm_tile<2>(Qs + 16 * rt * LP + o72, Ks + 16 * ct * LP + o72, s);
#pragma unroll
              for (int r = 0; r < 4; ++r) { const int l = 16 * rt + 4 * q4 + r, m = 16 * ct + lc; Ps[l * LP + m] = f2bf16(s[r] * dmk[u][r]); } } }
        f32x4 inter[4];
        if (wave < 4) {
#pragma unroll
            for (int ct = 0; ct < 4; ++ct) inter[ct] = mm_tile<2>(Qs + 16 * wave * LP + o72, Stt + 16 * ct * LP + o72, (f32x4){0.f, 0.f, 0.f, 0.f}); }
        WG_BAR_L();
        if (wave < 4) {
            f32x4 y[4];
#pragma unroll
            for (int ct = 0; ct < 4; ++ct) y[ct] = mm_tile<2>(Ps + 16 * wave * LP + o72, Vt + 16 * ct * LP + o72, (f32x4){0.f, 0.f, 0.f, 0.f});
            float sm[4], qv4[4], rs4[4];
#pragma unroll
            for (int r = 0; r < 4; ++r) { const float qd = qdk[r]; float s_ = 0.f;
#pragma unroll
                for (int ct = 0; ct < 4; ++ct) { y[ct][r] += qd * inter[ct][r]; s_ += y[ct][r]; }
                sm[r] = s_; }
#define RT_STEP(arr, CTRL) do { float t_[4]; _Pragma("unroll") for (int r = 0; r < 4; ++r) t_[r] = dppf<CTRL, 0xf>(arr[r]); _Pragma("unroll") for (int r = 0; r < 4; ++r) arr[r] += t_[r]; } while (0)
            RT_STEP(sm, 0xB1); RT_STEP(sm, 0x4E); RT_STEP(sm, 0x141); RT_STEP(sm, 0x140);
#pragma unroll
            for (int r = 0; r < 4; ++r) { sm[r] *= (1.0f / 64.0f); float q_ = 0.f;
#pragma unroll
                for (int ct = 0; ct < 4; ++ct) { const float dd = y[ct][r] - sm[r]; q_ += dd * dd; }
                qv4[r] = q_; }
            RT_STEP(qv4, 0xB1); RT_STEP(qv4, 0x4E); RT_STEP(qv4, 0x141); RT_STEP(qv4, 0x140);
#undef RT_STEP
#pragma unroll
            for (int r = 0; r < 4; ++r) rs4[r] = __builtin_amdgcn_rsqf(qv4[r] * (1.0f / 64.0f) + GN_EPS);
#pragma unroll
            for (int r = 0; r < 4; ++r) { const int l = 16 * wave + 4 * q4 + r; const float mean = sm[r], rstd = rs4[r];
                bf16* orow = mixed + (m0 + 64 * c + l) * DM + h * 64 + lc;
#pragma unroll
                for (int ct = 0; ct < 4; ++ct) { const float g = bf2f(Gs[l * LP + 16 * ct + lc]); orow[16 * ct] = f2bf16((y[ct][r] - mean) * rstd * gain4[ct] * (g * fsigmoid(g))); } }
        } else {
            const int dt = wave - 4;
#pragma unroll
            for (int ct = 0; ct < 4; ++ct) { st[ct] = mm_tile<2>(Kdt + 16 * dt * LP + o72, Vt + 16 * ct * LP + o72, st[ct] * cd);
                v2u w; w.x = pk2(st[ct][0], st[ct][1]); w.y = pk2(st[ct][2], st[ct][3]);
                *(LAS v2u*)(Stt + (16 * ct + lc) * LP + 16 * dt + 4 * q4) = w; }
        }
        WG_BAR_L();
    }
}

__device__ __forceinline__ void mlstm_unit(int b, int h, const bf16* proj, const float* conv_w, const float* conv_b, const float* i_b, const float* f_b, const float* gn, bf16* mixed,
                                           LAS unsigned char* lds, int wave, int lane0) {
    LAS bf16* Qs = (LAS bf16*)lds; LAS bf16* Ks = Qs + 64 * LPM; LAS bf16* Kdt = Ks + 64 * LPM; LAS bf16* Vt = Kdt + 96 * LP; LAS bf16* Ps = Vt + 112 * LP; LAS bf16* Stt = Ps + 64 * LP; LAS bf16* Os = Stt + 112 * LPM;
    LAS float* ev = (LAS float*)(Os + 64 * LPM); LAS float* pmv = ev + 64; LAS float* flv = pmv + 64;
    const int lane = lane0, lc = lane & 15;
    float wq0[4], wq1[4], wk0[4], wk1[4], bq0, bq1, bk0, bk1;
    { const int cq = h * 96 + (lane < 48 ? 2 * lane : 0), ck = 384 + cq;
#pragma unroll
    for (int j = 0; j < 4; ++j) { wq0[j] = conv_w[j * 768 + cq]; wq1[j] = conv_w[j * 768 + cq + 1]; wk0[j] = conv_w[j * 768 + ck]; wk1[j] = conv_w[j * 768 + ck + 1]; }
    bq0 = conv_b[cq]; bq1 = conv_b[cq + 1]; bk0 = conv_b[ck]; bk1 = conv_b[ck + 1]; }
    const float ib = i_b[h], fb = f_b[h];
    const float ksc = 0.10206207261596577f;
    f32x4 st[11];
#pragma unroll
    for (int i = 0; i < 11; ++i) st[i] = (f32x4){0.f, 0.f, 0.f, 0.f};
    for (int i = wave * 64 + lane; i < 112 * LPM / 2; i += 512) ((LAS unsigned*)Stt)[i] = 0u;
    for (int i = wave * 64 + lane; i < 16 * LP / 2; i += 512) ((LAS unsigned*)(Vt + 96 * LP))[i] = (i < LP / 2) ? 0x3f803f80u : 0u;
    float mprev = 0.f;
    const size_t m0 = (size_t)b * SEQ;
    const bf16* PB = proj + m0 * NPI + ML_B;
    float gain6[6];
#pragma unroll
    for (int ct = 0; ct < 6; ++ct) gain6[ct] = gn[640 + h * 96 + 16 * ct + lc];
    unsigned xq[11], xk[11], vv[16], og[16]; unsigned short gi, gf;
#define ML_LOAD_A(cc) do { const int tb_ = 64 * (cc) + 8 * wave; \
        _Pragma("unroll") for (int i = 0; i < 11; ++i) { const int t_ = tb_ - 3 + i; const bf16* p_ = PB + (size_t)(t_ < 0 ? 0 : t_) * NPI + cq; xq[i] = *(const unsigned*)p_; xk[i] = *(const unsigned*)(p_ + 384); } } while (0)
#define ML_LOAD_B(cc) do { \
        _Pragma("unroll") for (int g_ = 0; g_ < 2; ++g_) { const int tb_ = 64 * (cc) + 8 * (wave - 4 * g_); \
            _Pragma("unroll") for (int i = 0; i < 8; ++i) { const bf16* p_ = PB + (size_t)(tb_ + i) * NPI + 768 + cq; vv[8 * g_ + i] = *(const unsigned*)p_; og[8 * g_ + i] = *(const unsigned*)(p_ + 384); } } } while (0)
#define ML_LOAD_G(cc) do { const bf16* p_ = PB + (size_t)(64 * (cc) + lane) * NPI; gi = p_[1536 + h]; gf = p_[1540 + h]; } while (0)
#pragma unroll
    for (int i = 0; i < 16; ++i) { vv[i] = 0u; og[i] = 0u; }
    { const int cq = h * 96 + (lane < 48 ? 2 * lane : 0); ML_LOAD_A(0); ML_LOAD_G(0); if (wave >= 4) ML_LOAD_B(0); }
#pragma unroll 1
    for (int c = 0; c < SEQ / 64; ++c) {
        const int lane = lane_id_opq(), q4 = lane >> 4, lc = lane & 15, o72 = lc * LP + 8 * q4, o104 = lc * LPM + 8 * q4;
        const bool act = lane < 48; const int dd = act ? 2 * lane : 0, cq = h * 96 + dd;
        const int tb = 64 * c + 8 * wave;
        float pm63, carry, ev_l; const float mold = mprev;
        { const float ic = __uint_as_float((unsigned)gi << 16) + ib, lf = flogsigmoid(__uint_as_float((unsigned)gf << 16) + fb);
          const float bc = wave_prefix_sum(lf), e = ic - bc; const float pm = fmaxf(wave_prefix_max(e), mprev);
          pm63 = __builtin_bit_cast(float, __builtin_amdgcn_readlane(__builtin_bit_cast(int, pm), 63)); carry = fexp(mprev - pm63); ev_l = e;
          if (wave == 0) { ev[lane] = e; pmv[lane] = pm; flv[lane] = fexp(-(bc + pm)); }
          mprev = __builtin_bit_cast(float, __builtin_amdgcn_readlane(__builtin_bit_cast(int, bc), 63)) + pm63; }
        { unsigned short kd0[8], kd1[8];
          if (tb == 0) { xq[0] = xq[1] = xq[2] = 0u; xk[0] = xk[1] = xk[2] = 0u; }
#pragma unroll
          for (int i = 0; i < 8; ++i) { const int tt = 8 * wave + i;
#define LO_(w) __uint_as_float((w) << 16)
#define HI_(w) __uint_as_float((w) & 0xffff0000u)
              float q0 = bq0 + LO_(xq[i]) * wq0[0] + LO_(xq[i + 1]) * wq0[1] + LO_(xq[i + 2]) * wq0[2] + LO_(xq[i + 3]) * wq0[3];
              float k0 = bk0 + LO_(xk[i]) * wk0[0] + LO_(xk[i + 1]) * wk0[1] + LO_(xk[i + 2]) * wk0[2] + LO_(xk[i + 3]) * wk0[3];
              float q1 = bq1 + HI_(xq[i]) * wq1[0] + HI_(xq[i + 1]) * wq1[1] + HI_(xq[i + 2]) * wq1[2] + HI_(xq[i + 3]) * wq1[3];
              float k1 = bk1 + HI_(xk[i]) * wk1[0] + HI_(xk[i + 1]) * wk1[1] + HI_(xk[i + 2]) * wk1[2] + HI_(xk[i + 3]) * wk1[3];
#undef LO_
#undef HI_
              q0 = q0 * fsigmoid(q0); k0 = k0 * fsigmoid(k0) * ksc; q1 = q1 * fsigmoid(q1); k1 = k1 * fsigmoid(k1) * ksc;
              const float wsi = fexp(__builtin_bit_cast(float, __builtin_amdgcn_readlane(__builtin_bit_cast(int, ev_l), tt)) - pm63);
              kd0[i] = f2bf16(k0 * wsi); kd1[i] = f2bf16(k1 * wsi);
              if (act) { *(LAS unsigned*)(Qs + tt * LPM + dd) = pk2(q0, q1); *(LAS unsigned*)(Ks + tt * LPM + dd) = pk2(k0, k1); } }
          if (act) {
              v4u w; w.x = kd0[0] | ((unsigned)kd0[1] << 16); w.y = kd0[2] | ((unsigned)kd0[3] << 16); w.z = kd0[4] | ((unsigned)kd0[5] << 16); w.w = kd0[6] | ((unsigned)kd0[7] << 16);
              *(LAS v4u*)(Kdt + dd * LP + 8 * wave) = w;
              w.x = kd1[0] | ((unsigned)kd1[1] << 16); w.y = kd1[2] | ((unsigned)kd1[3] << 16); w.z = kd1[4] | ((unsigned)kd1[5] << 16); w.w = kd1[6] | ((unsigned)kd1[7] << 16);
              *(LAS v4u*)(Kdt + (dd + 1) * LP + 8 * wave) = w;
              if (wave >= 4) {
#pragma unroll
                  for (int g = 0; g < 2; ++g) { const int col = 8 * (wave - 4 * g); const unsigned* v8 = vv + 8 * g;
                      w.x = (v8[0] & 0xffffu) | (v8[1] << 16); w.y = (v8[2] & 0xffffu) | (v8[3] << 16); w.z = (v8[4] & 0xffffu) | (v8[5] << 16); w.w = (v8[6] & 0xffffu) | (v8[7] << 16);
                      *(LAS v4u*)(Vt + dd * LP + col) = w;
                      w.x = (v8[0] >> 16) | (v8[1] & 0xffff0000u); w.y = (v8[2] >> 16) | (v8[3] & 0xffff0000u); w.z = (v8[4] >> 16) | (v8[5] & 0xffff0000u); w.w = (v8[6] >> 16) | (v8[7] & 0xffff0000u);
                      *(LAS v4u*)(Vt + (dd + 1) * LP + col) = w;
#pragma unroll
                      for (int i = 0; i < 8; ++i) *(LAS unsigned*)(Os + (col + i) * LPM + dd) = og[8 * g + i]; } } } }
        WG_BAR_L();
        if (c + 1 < SEQ / 64) { ML_LOAD_A(c + 1); ML_LOAD_G(c + 1); }
        { const int rt = wave >> 1;
#pragma unroll
          for (int u = 0; u < 2; ++u) { const int ct = 2 * (wave & 1) + u;
              f32x4 s = (f32x4){0.f, 0.f, 0.f, 0.f};
              if (ct <= rt) s = mm_tile<3>(Qs + 16 * rt * LPM + o104, Ks + 16 * ct * LPM + o104, s);
              const float em = ev[16 * ct + lc];
#pragma unroll
              for (int r = 0; r < 4; ++r) { const int l = 16 * rt + 4 * q4 + r, m = 16 * ct + lc; const float val = (l >= m) ? s[r] * fexp(em - pmv[l]) : 0.f; Ps[l * LP + m] = f2bf16(val); } } }
        f32x4 inter[7];
        if (wave < 4) {
#pragma unroll
            for (int ct = 0; ct < 7; ++ct) inter[ct] = mm_tile<3>(Qs + 16 * wave * LPM + o104, Stt + 16 * ct * LPM + o104, (f32x4){0.f, 0.f, 0.f, 0.f}); }
        WG_BAR_L();
        if (wave >= 4 && c + 1 < SEQ / 64) ML_LOAD_B(c + 1);
        if (wave < 4) {
            f32x4 y[7];
#pragma unroll
            for (int ct = 0; ct < 7; ++ct) y[ct] = mm_tile<2>(Ps + 16 * wave * LP + o72, Vt + 16 * ct * LP + o72, (f32x4){0.f, 0.f, 0.f, 0.f});
#pragma unroll
            for (int r = 0; r < 4; ++r) { const int l = 16 * wave + 4 * q4 + r; const float iw = fexp(mold - pmv[l]);
#pragma unroll
                for (int ct = 0; ct < 7; ++ct) y[ct][r] += iw * inter[ct][r];
                const float den = __shfl(y[6][r], lane & 48);
                const float dn = __builtin_amdgcn_rcpf(fmaxf(fabsf(den), flv[l]));
                float s = 0.f;
#pragma unroll
                for (int ct = 0; ct < 6; ++ct) { y[ct][r] *= dn; s += y[ct][r]; }
                const float mean = sum16(s) * (1.0f / 96.0f); float qv = 0.f;
#pragma unroll
                for (int ct = 0; ct < 6; ++ct) { const float dd = y[ct][r] - mean; qv += dd * dd; }
                const float rstd = __builtin_amdgcn_rsqf(sum16(qv) * (1.0f / 96.0f) + GN_EPS);
                bf16* orow = mixed + (m0 + 64 * c + l) * DM + 640 + h * 96 + lc;
#pragma unroll
                for (int ct = 0; ct < 6; ++ct) { const float o = bf2f(Os[l * LPM + 16 * ct + lc]); orow[16 * ct] = f2bf16((y[ct][r] - mean) * rstd * gain6[ct] * fsigmoid(o)); } }
        } else {
#pragma unroll
            for (int i = 0; i < 11; ++i) { const int t = (wave - 4) + 4 * i;
                if (t < 42) { const int dt = t / 7, et = t % 7;
                    st[i] = mm_tile<2>(Kdt + 16 * dt * LP + o72, Vt + 16 * et * LP + o72, st[i] * carry);
                    v2u w; w.x = pk2(st[i][0], st[i][1]); w.y = pk2(st[i][2], st[i][3]);
                    *(LAS v2u*)(Stt + (16 * et + lc) * LPM + 16 * dt + 4 * q4) = w; } }
        }
        WG_BAR_L();
    }
#undef ML_LOAD_A
#undef ML_LOAD_B
#undef ML_LOAD_G
}
#ifndef RW_DBG
#define RW_DBG 0xFF
#endif
__device__ __forceinline__ void rwkv_unit(int b, int h, const bf16* proj, const float* CUM, const bf16* AA, const bf16* GG, const float* mu, const float* k_k, const float* k_a, const float* r_k,
                                          const float* gn, bf16* mixed, LAS unsigned char* lds, int wave, int lane0,
                                          int cb, int ce, const float* hs_in, unsigned* flag_in, float* hs_out, unsigned* flag_out) {
    constexpr int SLOT = 64 * LP;
    LAS bf16* KH = (LAS bf16*)lds; LAS bf16* BH = KH + SLOT; LAS bf16* KT = BH + SLOT; LAS bf16* RT = KT + SLOT; LAS bf16* KHgt = RT + SLOT; LAS bf16* BHgtn = KHgt + SLOT;
    LAS bf16* Vt = BHgtn + SLOT; LAS bf16* AkT = Vt + SLOT; LAS bf16* BbTn = AkT + SLOT; LAS bf16* BkT = BbTn + SLOT; LAS bf16* S0b = BkT + SLOT; LAS bf16* Loffb = S0b + SLOT; LAS bf16* Vr = Loffb + SLOT; LAS bf16* Gr = Vr + SLOT;
    LAS float* RHS = (LAS float*)KH; LAS bf16* Ut = KT;
    LAS float* LTd = (LAS float*)(Gr + SLOT);
    LAS float* XS = LTd + 64 * 20;
    LAS float* GCv = XS + 16 * 64; LAS float* bonv = GCv + 64;
    LAS float* bonv2 = bonv + 64; LAS float* bonv3 = bonv2 + 64; LAS bf16* Vr2 = (LAS bf16*)(bonv3 + 64); LAS bf16* Gr2 = Vr2 + SLOT;
    const int pp = lane0 & 31, th = lane0 >> 5;
    f32x2c mu_r, mu_k, mu_v, kkc, kac, rkc;
    { const int c0 = h * 64 + 2 * pp; mu_r = *(const f32x2c*)(mu + c0); mu_k = *(const f32x2c*)(mu + 384 + c0); mu_v = *(const f32x2c*)(mu + 768 + c0); kkc = *(const f32x2c*)(k_k + c0); kac = *(const f32x2c*)(k_a + c0); rkc = *(const f32x2c*)(r_k + c0); }
    for (int i = wave * 64 + lane0; i < 5 * SLOT / 2; i += 512) ((LAS unsigned*)AkT)[i] = 0u;
    float gain4[4];
#pragma unroll
    for (int ct = 0; ct < 4; ++ct) gain4[ct] = gn[256 + h * 64 + 16 * ct + (lane0 & 15)];
    f32x4 sacc[4];
#pragma unroll
    for (int i = 0; i < 4; ++i) sacc[i] = (f32x4){0.f, 0.f, 0.f, 0.f};
    if (hs_in) {
        if (wave == 0) { unsigned spins = 0u;
            while (__hip_atomic_load(flag_in, __ATOMIC_RELAXED, __HIP_MEMORY_SCOPE_AGENT) == 0u) { __builtin_amdgcn_s_sleep(4); if (++spins > (1u << 22)) break; }
            __builtin_amdgcn_fence(__ATOMIC_ACQUIRE, "agent"); asm volatile("s_waitcnt vmcnt(0)" ::: "memory"); }
        WG_BAR();
        if (wave < 4) {
#pragma unroll
            for (int jt = 0; jt < 4; ++jt) {
#pragma unroll
                for (int r = 0; r < 4; ++r) { sacc[jt][r] = hs_in[(wave * 4 + jt) * 256 + r * 64 + lane0];
                    S0b[(16 * wave + 4 * (lane0 >> 4) + r) * LP + 16 * jt + (lane0 & 15)] = f2bf16(sacc[jt][r]); } } }
    }
    const size_t m0 = (size_t)b * SEQ;
    const bf16* PU = proj + m0 * NPI + RW_B + h * 64;
    const float* CU = CUM + m0 * 384 + h * 64; const bf16* AU = AA + m0 * 384 + h * 64; const bf16* GU = GG + m0 * 384 + h * 64;
    const bool own = wave != 0 && wave != 4; const int T2 = wave < 4 ? 2 * wave : 32 + 2 * (wave - 4);
    unsigned ur[5], uk[5], uv[5], ua[4], ug[4]; f32x2c uc[5], uc63;
    unsigned qr[2], qk[2], qv[2], qa, qg; f32x2c qc[2], qc63;
    unsigned o_kh[4], o_bh[4], o_kt[4], o_rt[4], o_v[4], o_g[4]; v2u o_khg[2], o_bhg[2], o_vs[2];
#pragma unroll
    for (int i = 0; i < 4; ++i) { o_kh[i] = 0u; o_bh[i] = 0u; o_kt[i] = 0u; o_rt[i] = 0u; o_v[i] = 0u; o_g[i] = 0u; }
#pragma unroll
    for (int i = 0; i < 2; ++i) { o_khg[i] = (v2u){0u, 0u}; o_bhg[i] = o_khg[i]; o_vs[i] = o_khg[i]; }
#define RWKV_LOAD(cc) do { const int tb_ = 64 * (cc) + 8 * wave + 4 * th; \
        _Pragma("unroll") for (int i = 0; i < 5; ++i) { const int t_ = tb_ - 1 + i; const bf16* p_ = PU + (size_t)t_ * NPI + 2 * pp; \
            ur[i] = *(const unsigned*)p_; uk[i] = *(const unsigned*)(p_ + 384); uv[i] = *(const unsigned*)(p_ + 768); \
            uc[i] = *(const f32x2c*)(CU + (size_t)t_ * 384 + 2 * pp); if (i > 0) { ua[i - 1] = *(const unsigned*)(AU + (size_t)t_ * 384 + 2 * pp); ug[i - 1] = *(const unsigned*)(GU + (size_t)t_ * 384 + 2 * pp); } } \
        uc63 = *(const f32x2c*)(CU + (size_t)(64 * (cc) + 63) * 384 + 2 * pp); } while (0)
#define RWKV_LOAD2(cc) do { const int t1_ = 64 * (cc) + T2 + th, t0_ = t1_ > 0 ? t1_ - 1 : 0; const bf16* p0_ = PU + (size_t)t0_ * NPI + 2 * pp; const bf16* p1_ = PU + (size_t)t1_ * NPI + 2 * pp; \
        qr[0] = *(const unsigned*)p0_; qk[0] = *(const unsigned*)(p0_ + 384); qv[0] = *(const unsigned*)(p0_ + 768); qr[1] = *(const unsigned*)p1_; qk[1] = *(const unsigned*)(p1_ + 384); qv[1] = *(const unsigned*)(p1_ + 768); \
        qc[0] = *(const f32x2c*)(CU + (size_t)t0_ * 384 + 2 * pp); qc[1] = *(const f32x2c*)(CU + (size_t)t1_ * 384 + 2 * pp); qa = *(const unsigned*)(AU + (size_t)t1_ * 384 + 2 * pp); qg = *(const unsigned*)(GU + (size_t)t1_ * 384 + 2 * pp); \
        qc63 = *(const f32x2c*)(CU + (size_t)(64 * (cc) + 63) * 384 + 2 * pp); } while (0)
#define RW_LO2(u) ((f32x2c){__uint_as_float((u) << 16), __uint_as_float((u) & 0xffff0000u)})
#define RW_HSUM(x, out) do { float v_ = sum16(x); v_ += dppf<0x142, 0xa>(v_); const float s0_ = __builtin_bit_cast(float, __builtin_amdgcn_readlane(__builtin_bit_cast(int, v_), 31)), s1_ = __builtin_bit_cast(float, __builtin_amdgcn_readlane(__builtin_bit_cast(int, v_), 63)); out = th ? s1_ : s0_; } while (0)
#define RW_TOK(RP, RC, KP, KC, AC, CM, ECP, f_kh, f_bh, f_kt, f_rt, f_khg, f_bhg, f_bon) do { \
        const f32x2c cr_ = RW_LO2(RC), ck_ = RW_LO2(KC); \
        const f32x2c r_ = cr_ + (RW_LO2(RP) - cr_) * mu_r, k_ = ck_ + (RW_LO2(KP) - ck_) * mu_k, a_ = RW_LO2(AC); \
        f32x2c kk_ = k_ * kkc; float ss_; RW_HSUM(kk_.x * kk_.x + kk_.y * kk_.y, ss_); kk_ = kk_ * __builtin_amdgcn_rsqf(fmaxf(ss_, 1e-24f));       \
        const f32x2c kmod_ = k_ * (1.0f + (a_ - 1.0f) * kac), beta_ = kk_ * a_; \
        { const f32x2c rb_ = r_ * kmod_ * rkc; RW_HSUM(rb_.x + rb_.y, f_bon); } \
        f32x2c em_; em_.x = fexp(-(CM).x); em_.y = fexp(-(CM).y); const f32x2c eg_ = gc63 * em_; f32x2c ec_; ec_.x = __builtin_amdgcn_rcpf(em_.x); ec_.y = __builtin_amdgcn_rcpf(em_.y);     \
        f_kh = kmod_ * em_; f_bh = beta_ * em_; f_kt = kk_ * (ECP); f_rt = r_ * ec_; f_khg = kmod_ * eg_; f_bhg = -(beta_ * eg_); (ECP) = ec_; } while (0)
    if (own) RWKV_LOAD(cb);
    f32x4 yp[4];
#pragma unroll
    for (int i = 0; i < 4; ++i) yp[i] = (f32x4){0.f, 0.f, 0.f, 0.f};
#define RW_EPILOGUE(yy, cc, VrB, GrB, bonB, q4_, lc_) do { float sm_[4], qv_[4]; \
        _Pragma("unroll") for (int r = 0; r < 4; ++r) { float s_ = 0.f; _Pragma("unroll") for (int ct = 0; ct < 4; ++ct) s_ += yy[ct][r]; sm_[r] = s_; } \
        RW_ESTEP(sm_, 0xB1); RW_ESTEP(sm_, 0x4E); RW_ESTEP(sm_, 0x141); RW_ESTEP(sm_, 0x140); \
        _Pragma("unroll") for (int r = 0; r < 4; ++r) { sm_[r] *= (1.0f / 64.0f); float q_ = 0.f; _Pragma("unroll") for (int ct = 0; ct < 4; ++ct) { const float dd = yy[ct][r] - sm_[r]; q_ += dd * dd; } qv_[r] = q_; } \
        RW_ESTEP(qv_, 0xB1); RW_ESTEP(qv_, 0x4E); RW_ESTEP(qv_, 0x141); RW_ESTEP(qv_, 0x140); \
        _Pragma("unroll") for (int r = 0; r < 4; ++r) { const int t = 16 * (wave - 4) + 4 * (q4_) + r; const size_t row = m0 + 64 * (cc) + t; \
            const float mean = sm_[r], rstd = __builtin_amdgcn_rsqf(qv_[r] * (1.0f / 64.0f) + GN_EPS); \
            const float bon = (bonB)[t]; bf16* orow = mixed + row * DM + 256 + h * 64 + (lc_); \
            _Pragma("unroll") for (int ct = 0; ct < 4; ++ct) orow[16 * ct] = f2bf16(((yy[ct][r] - mean) * rstd * gain4[ct] + bon * bf2f((VrB)[t * LP + 16 * ct + (lc_)])) * bf2f((GrB)[t * LP + 16 * ct + (lc_)])); } } while (0)
#define RW_ESTEP(arr, CTRL) do { float t_[4]; _Pragma("unroll") for (int r = 0; r < 4; ++r) t_[r] = dppf<CTRL, 0xf>(arr[r]); _Pragma("unroll") for (int r = 0; r < 4; ++r) arr[r] += t_[r]; } while (0)
#pragma unroll 1
    for (int c = cb - 1; c < ce; ++c) {
        const bool live = c >= cb;
        const int lane = lane_id_opq(), q4 = lane >> 4, lc = lane & 15, o72 = lc * LP + 8 * q4, pp = lane & 31, th = lane >> 5;
        LAS bf16* VrC = (c & 1) ? Vr2 : Vr; LAS bf16* GrC = (c & 1) ? Gr2 : Gr; LAS float* bonC = bonv + 64 * ((c + 3) % 3);
        LAS bf16* VrP = (c & 1) ? Vr : Vr2; LAS bf16* GrP = (c & 1) ? Gr : Gr2; LAS float* bonP = bonv + 64 * ((c + 2) % 3); LAS float* bonN = bonv + 64 * ((c + 4) % 3);
        if (live) {
        if (RW_DBG & 1) {
          if (own) {
#pragma unroll
              for (int i = 0; i < 4; ++i) { const int tt = 8 * wave + 4 * th + i;
                  *(LAS unsigned*)(KH + tt * LP + 2 * pp) = o_kh[i]; *(LAS unsigned*)(BH + tt * LP + 2 * pp) = o_bh[i]; *(LAS unsigned*)(KT + tt * LP + 2 * pp) = o_kt[i]; *(LAS unsigned*)(RT + tt * LP + 2 * pp) = o_rt[i];
                  *(LAS unsigned*)(VrC + tt * LP + 2 * pp) = o_v[i]; *(LAS unsigned*)(GrC + tt * LP + 2 * pp) = o_g[i]; }
#pragma unroll
              for (int e = 0; e < 2; ++e) { const int col = 8 * wave + 4 * th;
                  *(LAS v2u*)(KHgt + (2 * pp + e) * LP + col) = o_khg[e]; *(LAS v2u*)(BHgtn + (2 * pp + e) * LP + col) = o_bhg[e]; *(LAS v2u*)(Vt + (2 * pp + e) * LP + col) = o_vs[e]; } }
          { f32x2c gc63; gc63.x = fexp(qc63.x); gc63.y = fexp(qc63.y); const int tt = T2 + th; const bool first = tt == 0;
            const bool nop = (64 * c + tt) == 0;
            f32x2c ecp; ecp.x = first ? 1.0f : fexp(qc[0].x); ecp.y = first ? 1.0f : fexp(qc[0].y);
            f32x2c f_kh, f_bh, f_kt, f_rt, f_khg, f_bhg; float bon;
            const unsigned rp = nop ? 0u : qr[0], kp = nop ? 0u : qk[0], vp = nop ? 0u : qv[0];
            RW_TOK(rp, qr[1], kp, qk[1], qa, qc[1], ecp, f_kh, f_bh, f_kt, f_rt, f_khg, f_bhg, bon);
            *(LAS unsigned*)(KH + tt * LP + 2 * pp) = pk2(f_kh.x, f_kh.y); *(LAS unsigned*)(BH + tt * LP + 2 * pp) = pk2(f_bh.x, f_bh.y); *(LAS unsigned*)(KT + tt * LP + 2 * pp) = pk2(f_kt.x, f_kt.y); *(LAS unsigned*)(RT + tt * LP + 2 * pp) = pk2(f_rt.x, f_rt.y);
            if (pp == 0) bonC[tt] = bon;
            const f32x2c cv = RW_LO2(qv[1]), vsh = cv + (RW_LO2(vp) - cv) * mu_v; *(LAS unsigned*)(VrC + tt * LP + 2 * pp) = pk2(vsh.x, vsh.y); *(LAS unsigned*)(GrC + tt * LP + 2 * pp) = qg;
            KHgt[(2 * pp) * LP + tt] = f2bf16(f_khg.x); KHgt[(2 * pp + 1) * LP + tt] = f2bf16(f_khg.y); BHgtn[(2 * pp) * LP + tt] = f2bf16(f_bhg.x); BHgtn[(2 * pp + 1) * LP + tt] = f2bf16(f_bhg.y);
            Vt[(2 * pp) * LP + tt] = f2bf16(vsh.x); Vt[(2 * pp + 1) * LP + tt] = f2bf16(vsh.y);
            if (wave == 0 && th == 0) *(LAS f32x2c*)(GCv + 2 * pp) = gc63; } }
        if (own && c + 1 < ce) RWKV_LOAD(c + 1);
        WG_BAR_L();
#pragma unroll
        for (int u2 = 0; u2 < 2; ++u2) { const int idx = 2 * wave + u2, rt = idx >> 2, ct = idx & 3;
            if (ct <= rt) {
                const int s = 16 * ct + lc; const LAS bf16* kt = KT + 16 * rt * LP + o72; const LAS bf16* rtp = RT + 16 * rt * LP + o72; const LAS bf16* bh = BH + 16 * ct * LP + o72; const LAS bf16* kh = KH + 16 * ct * LP + o72;
                const f32x4 z = (f32x4){0.f, 0.f, 0.f, 0.f};
                const f32x4 g0 = mm_tile<2>(kt, bh, z), g1 = mm_tile<2>(kt, kh, z), g2 = mm_tile<2>(rtp, bh, z), g3 = mm_tile<2>(rtp, kh, z);
#pragma unroll
                for (int r = 0; r < 4; ++r) { const int t = 16 * rt + 4 * q4 + r;
                    if (ct < rt) Loffb[t * LP + s] = f2bf16(g0[r]); else LTd[s * 20 + (t - 16 * rt)] = (s < t) ? g0[r] : 0.f;
                    AkT[t * LP + s] = f2bf16((s < t) ? g1[r] : 0.f);
                    BbTn[t * LP + s] = f2bf16((s <= t) ? -g2[r] : 0.f);
                    BkT[t * LP + s] = f2bf16((s <= t) ? g3[r] : 0.f); } } }
        WG_BAR_L();
#pragma unroll
        for (int u = 0; u < ((RW_DBG & 4) ? 2 : 0); ++u) { const int rt = wave >> 1, ct = 2 * (wave & 1) + u;
            f32x4 g = mm_tile<2>(KT + 16 * rt * LP + o72, S0b + 16 * ct * LP + o72, (f32x4){0.f, 0.f, 0.f, 0.f});
            g = mm_tile<2>(AkT + 16 * rt * LP + o72, Vt + 16 * ct * LP + o72, g);
#pragma unroll
            for (int r = 0; r < 4; ++r) RHS[(16 * rt + 4 * q4 + r) * 64 + 16 * ct + lc] = g[r]; }
        WG_BAR_L();
        }
        f32x4 y[4];
        if (wave == 0) {
#define RW_KILL(x) asm volatile("" : "=v"(x))
#pragma unroll
            for (int i = 0; i < 5; ++i) { RW_KILL(ur[i]); RW_KILL(uk[i]); RW_KILL(uv[i]); RW_KILL(uc[i]); }
#pragma unroll
            for (int i = 0; i < 4; ++i) { RW_KILL(ua[i]); RW_KILL(ug[i]); RW_KILL(o_kh[i]); RW_KILL(o_bh[i]); RW_KILL(o_kt[i]); RW_KILL(o_rt[i]); RW_KILL(o_v[i]); RW_KILL(o_g[i]); }
#pragma unroll
            for (int i = 0; i < 2; ++i) { RW_KILL(qr[i]); RW_KILL(qk[i]); RW_KILL(qv[i]); RW_KILL(qc[i]); RW_KILL(o_khg[i]); RW_KILL(o_bhg[i]); RW_KILL(o_vs[i]); }
            RW_KILL(qa); RW_KILL(qg); RW_KILL(uc63); RW_KILL(qc63);
#undef RW_KILL
            if (live && (RW_DBG & 8)) {
            __builtin_amdgcn_s_setprio(3);
#pragma unroll
            for (int a = 0; a < 4; ++a) {
                if (a > 0) {
#pragma unroll
                    for (int it = 0; it < 4; ++it) { f32x4 cr = (f32x4){0.f, 0.f, 0.f, 0.f};
                        if (a == 3) cr = mm_tile<2>(Loffb + 16 * a * LP + o72, Ut + 16 * it * LP + o72, cr); else cr = mm_tile<1>(Loffb + 16 * a * LP + o72, Ut + 16 * it * LP + o72, cr);
#pragma unroll
                        for (int r = 0; r < 4; ++r) XS[(4 * q4 + r) * 64 + 16 * it + lc] = cr[r]; }
                    asm volatile("s_waitcnt lgkmcnt(0)" ::: "memory");
                }
                typedef float f32x2s __attribute__((ext_vector_type(2)));
                f32x2s acc2[8];
#pragma unroll
                for (int t = 0; t < 8; ++t) { acc2[t].x = RHS[(16 * a + 2 * t) * 64 + lane] - (a > 0 ? XS[(2 * t) * 64 + lane] : 0.f); acc2[t].y = RHS[(16 * a + 2 * t + 1) * 64 + lane] - (a > 0 ? XS[(2 * t + 1) * 64 + lane] : 0.f); }
                const LAS float* Ld = LTd + 16 * a * 20; asm volatile("" : "+v"(Ld));
                f32x4 cq[8];
#define RW_LD(slot, s2, t4) cq[slot] = *(const volatile LAS f32x4*)(Ld + (s2) * 20 + 4 * (t4))
#define RW_FM(d, u, c, S) asm volatile("v_pk_fma_f32 %0, %1, %2, %0 op_sel:[" #S ",0,0] op_sel_hi:[" #S ",1,1] neg_lo:[1,0,0] neg_hi:[1,0,0]" : "+v"(d) : "v"(u), "v"(c))
#define RW_IT(slot, s2, t4, S) do { const f32x2s c0_ = __builtin_shufflevector(cq[slot], cq[slot], 0, 1), c1_ = __builtin_shufflevector(cq[slot], cq[slot], 2, 3); RW_FM(acc2[2 * (t4)], acc2[(s2) >> 1], c0_, S); RW_FM(acc2[2 * (t4) + 1], acc2[(s2) >> 1], c1_, S); } while (0)
                RW_LD(0, 0, 0);
                RW_LD(1, 0, 1);
                RW_LD(2, 0, 2);
                RW_LD(3, 0, 3);
                RW_LD(4, 1, 0);
                RW_LD(5, 1, 1);
                RW_LD(6, 1, 2);
                RW_LD(7, 1, 3);
                RW_IT(0, 0, 0, 0); RW_LD(0, 2, 0); RW_IT(1, 0, 1, 0); RW_LD(1, 2, 1); RW_IT(2, 0, 2, 0); RW_LD(2, 2, 2); RW_IT(3, 0, 3, 0); RW_LD(3, 2, 3);
                RW_IT(4, 1, 0, 1); RW_LD(4, 3, 1); RW_IT(5, 1, 1, 1); RW_LD(5, 3, 2); RW_IT(6, 1, 2, 1); RW_LD(6, 3, 3); RW_IT(7, 1, 3, 1); RW_LD(7, 4, 1);
                RW_IT(0, 2, 0, 0); RW_LD(0, 4, 2); RW_IT(1, 2, 1, 0); RW_LD(1, 4, 3); RW_IT(2, 2, 2, 0); RW_LD(2, 5, 1); RW_IT(3, 2, 3, 0); RW_LD(3, 5, 2);
                RW_IT(4, 3, 1, 1); RW_LD(4, 5, 3); RW_IT(5, 3, 2, 1); RW_LD(5, 6, 1); RW_IT(6, 3, 3, 1); RW_LD(6, 6, 2); RW_IT(7, 4, 1, 0); RW_LD(7, 6, 3);
                RW_IT(0, 4, 2, 0); RW_LD(0, 7, 2); RW_IT(1, 4, 3, 0); RW_LD(1, 7, 3); RW_IT(2, 5, 1, 1); RW_LD(2, 8, 2); RW_IT(3, 5, 2, 1); RW_LD(3, 8, 3);
                RW_IT(4, 5, 3, 1); RW_LD(4, 9, 2); RW_IT(5, 6, 1, 0); RW_LD(5, 9, 3); RW_IT(6, 6, 2, 0); RW_LD(6, 10, 2); RW_IT(7, 6, 3, 0); RW_LD(7, 10, 3);
                RW_IT(0, 7, 2, 1); RW_LD(0, 11, 3); RW_IT(1, 7, 3, 1); RW_LD(1, 12, 3); RW_IT(2, 8, 2, 0); RW_LD(2, 13, 3); RW_IT(3, 8, 3, 0); RW_LD(3, 14, 3);
                RW_IT(4, 9, 2, 1); RW_IT(5, 9, 3, 1); RW_IT(6, 10, 2, 0); RW_IT(7, 10, 3, 0);
                RW_IT(0, 11, 3, 1); RW_IT(1, 12, 3, 0); RW_IT(2, 13, 3, 1); RW_IT(3, 14, 3, 0);
#undef RW_LD
#undef RW_FM
#undef RW_IT
                v4u w; w.x = pk2(acc2[0].x, acc2[0].y); w.y = pk2(acc2[1].x, acc2[1].y); w.z = pk2(acc2[2].x, acc2[2].y); w.w = pk2(acc2[3].x, acc2[3].y);
                *(LAS v4u*)(Ut + lane * LP + 16 * a) = w;
                w.x = pk2(acc2[4].x, acc2[4].y); w.y = pk2(acc2[5].x, acc2[5].y); w.z = pk2(acc2[6].x, acc2[6].y); w.w = pk2(acc2[7].x, acc2[7].y);
                *(LAS v4u*)(Ut + lane * LP + 16 * a + 8) = w;
                asm volatile("s_waitcnt lgkmcnt(0)" ::: "memory");
            }
            __builtin_amdgcn_s_setprio(0);
        } } else if (own && c + 1 < ce) {
            f32x2c gc63; gc63.x = fexp(uc63.x); gc63.y = fexp(uc63.y); f32x2c ecp; ecp.x = fexp(uc[0].x); ecp.y = fexp(uc[0].y);
            f32x2c g_khg[4], g_bhg[4], g_vs[4];
#pragma unroll
            for (int i = 0; i < 4; ++i) { f32x2c f_kh, f_bh, f_kt, f_rt; float bon;
                RW_TOK(ur[i], ur[i + 1], uk[i], uk[i + 1], ua[i], uc[i + 1], ecp, f_kh, f_bh, f_kt, f_rt, g_khg[i], g_bhg[i], bon); if (pp == 0) bonN[8 * wave + 4 * th + i] = bon;
                o_kh[i] = pk2(f_kh.x, f_kh.y); o_bh[i] = pk2(f_bh.x, f_bh.y); o_kt[i] = pk2(f_kt.x, f_kt.y); o_rt[i] = pk2(f_rt.x, f_rt.y);
                const f32x2c cv = RW_LO2(uv[i + 1]); g_vs[i] = cv + (RW_LO2(uv[i]) - cv) * mu_v; o_v[i] = pk2(g_vs[i].x, g_vs[i].y); o_g[i] = ug[i]; }
            o_khg[0] = (v2u){pk2(g_khg[0].x, g_khg[1].x), pk2(g_khg[2].x, g_khg[3].x)}; o_khg[1] = (v2u){pk2(g_khg[0].y, g_khg[1].y), pk2(g_khg[2].y, g_khg[3].y)};
            o_bhg[0] = (v2u){pk2(g_bhg[0].x, g_bhg[1].x), pk2(g_bhg[2].x, g_bhg[3].x)}; o_bhg[1] = (v2u){pk2(g_bhg[0].y, g_bhg[1].y), pk2(g_bhg[2].y, g_bhg[3].y)};
            o_vs[0] = (v2u){pk2(g_vs[0].x, g_vs[1].x), pk2(g_vs[2].x, g_vs[3].x)}; o_vs[1] = (v2u){pk2(g_vs[0].y, g_vs[1].y), pk2(g_vs[2].y, g_vs[3].y)};
        }
        if (c + 1 < ce) RWKV_LOAD2(c + 1);
        if (live) {
        if (wave >= 4) {
#pragma unroll
            for (int ct = 0; ct < 4; ++ct) { y[ct] = mm_tile<2>(RT + 16 * (wave - 4) * LP + o72, S0b + 16 * ct * LP + o72, (f32x4){0.f, 0.f, 0.f, 0.f}); y[ct] = mm_tile<2>(BkT + 16 * (wave - 4) * LP + o72, Vt + 16 * ct * LP + o72, y[ct]); }
            if (c > cb) RW_EPILOGUE(yp, c - 1, VrP, GrP, bonP, q4, lc);
        } else {
#pragma unroll
            for (int jt = 0; jt < 4; ++jt) { const float gc = GCv[16 * jt + lc]; sacc[jt] = mm_tile<2>(Vt + 16 * wave * LP + o72, KHgt + 16 * jt * LP + o72, sacc[jt] * gc); }
        }
        WG_BAR_L();
        if (wave >= 4) {
#pragma unroll
            for (int ct = 0; ct < 4; ++ct) y[ct] = mm_tile<2>(BbTn + 16 * (wave - 4) * LP + o72, Ut + 16 * ct * LP + o72, y[ct]);
#pragma unroll
            for (int ct = 0; ct < 4; ++ct) yp[ct] = y[ct];
        } else {
#pragma unroll
            for (int jt = 0; jt < 4; ++jt) { sacc[jt] = mm_tile<2>(Ut + 16 * wave * LP + o72, BHgtn + 16 * jt * LP + o72, sacc[jt]);
#pragma unroll
                for (int r = 0; r < 4; ++r) S0b[(16 * wave + 4 * q4 + r) * LP + 16 * jt + lc] = f2bf16(sacc[jt][r]); }
        }
        WG_BAR_L();
        }
    }
    if (wave >= 4 && ce > cb) { const int q4 = lane0 >> 4, lc = lane0 & 15; const int cl = ce - 1;
        LAS float* bonL = bonv + 64 * (cl % 3);
        if (cl & 1) RW_EPILOGUE(yp, cl, Vr2, Gr2, bonL, q4, lc); else RW_EPILOGUE(yp, cl, Vr, Gr, bonL, q4, lc); }
#undef RW_EPILOGUE
#undef RW_ESTEP
    if (!hs_out) WG_BAR_L();
    if (hs_out) {
        if (wave < 4) {
#pragma unroll
            for (int jt = 0; jt < 4; ++jt)
#pragma unroll
                for (int r = 0; r < 4; ++r) __hip_atomic_store(hs_out + (wave * 4 + jt) * 256 + r * 64 + lane0, sacc[jt][r], __ATOMIC_RELAXED, __HIP_MEMORY_SCOPE_AGENT);
        }
        WG_BAR();
        if (wave == 0 && lane0 == 0) __hip_atomic_store(flag_out, 1u, __ATOMIC_RELAXED, __HIP_MEMORY_SCOPE_AGENT);
    }
#undef RWKV_LOAD
#undef RWKV_LOAD2
#undef RW_TOK
#undef RW_LO2
#undef RW_HSUM
}

struct Args { const float* in[25]; float* out; unsigned char* ws; int ph_lo, ph_hi, li, pad; };
typedef const __attribute__((address_space(4))) Args* KArgs;
__device__ __forceinline__ KArgs kargs() { KArgs p = (KArgs)__builtin_amdgcn_kernarg_segment_ptr(); asm volatile("" : "+s"(p)); return p; }
#ifndef DBG_MASK
#define DBG_MASK 0xFFFF
#endif
#define EN(bit) ((DBG_MASK >> (bit)) & 1)
#ifndef PROBE_SKEW_MODE
#define PROBE_SKEW_MODE 0
#endif
#ifndef PROBE_SKEW
#define PROBE_SKEW 0
#endif
#define SKEW_STAMP(which) do { if (PROBE_SKEW == (which) && l == 2 && wave_o == 0 && lane_id_opq() == 0) { volatile unsigned long long* pp_ = (volatile unsigned long long*)(ws + WS_CTL) + 130000 + blockIdx.x; pp_[0] = __builtin_amdgcn_s_memrealtime(); } } while (0)
#ifndef PROBE_CLK
#define PROBE_CLK 0
#endif
#ifndef PROBE_DUP
#define PROBE_DUP 0
#endif
#define REP(bit) for (int rep_ = 0; rep_ < (((PROBE_DUP >> (bit)) & 1) ? 2 : 1); ++rep_)
__global__ void __launch_bounds__(NWAVES * 64, 2) mk_fwd(Args args_unused) {
    extern __shared__ __attribute__((aligned(16))) unsigned char lds_raw[];
    LAS unsigned char* lds = (LAS unsigned char*)lds_raw;
    volatile LAS unsigned* MISC = (volatile LAS unsigned*)(lds + MISC_OFF);
    const int wave = __builtin_amdgcn_readfirstlane((int)threadIdx.x >> 6);
    const int G = gridDim.x, gw = blockIdx.x * NWAVES + wave, ngw = G * NWAVES;
    for (int u = threadIdx.x; u < (LDS_BYTES - LDSCTL_OFF) / 4; u += NWAVES * 64) ((LAS unsigned*)(lds + LDSCTL_OFF))[u] = 0u;
    __syncthreads();
    XcdBarrier bar; int lo, hi;
    { KArgs A = kargs(); bar = xcd_barrier_post((unsigned*)(A->ws + WS_CTL) + CW_BAR + (MK_PER_PHASE ? 0 : A->li) * XCD_BAR_WORDS, MISC + 8); lo = A->ph_lo; hi = A->ph_hi; }
#define IN(k) (lo <= (k) && (k) < hi)
#if PROBE_BAR
#define SEAM(k) do { if (IN(k) && IN((k) + 1)) { xcd_barrier(bar); xcd_barrier(bar); xcd_barrier(bar); } } while (0)
#else
#define SEAM(k) do { if (IN(k) && IN((k) + 1)) xcd_barrier(bar); } while (0)
#endif
#define LANE_TID() int wave_o = wave, gw_o = gw; asm volatile("" : "+s"(wave_o), "+s"(gw_o)); (void)gw_o; const int lane_o = lane_id_opq(), tid_o = wave_o * 64 + lane_o; (void)tid_o

    REP(5) if (EN(0) && IN(0)) {
        KArgs A = kargs(); unsigned char* ws = A->ws; LANE_TID();
        p0_mod(A->in[1], A->in[2], A->in[3], (float*)(ws + WS_MOD), lds, tid_o, lane_o, wave_o);
        p0_weights(A->in[6], A->in[21], A->in[22], A->in[23], A->in[10], A->in[12], A->in[13], ws, lds, gw_o, ngw, wave_o, lane_o);
    }
    SEAM(0);
    if (EN(1) && IN(1)) { KArgs A = kargs(); unsigned char* ws = A->ws; LANE_TID();
        norm_mod_phase(A->in[0], A->in[4], (const float*)(ws + WS_MOD), 0, DM, (bf16*)(ws + WS_H), gw_o, ngw, lane_o); }
    SEAM(1);
#pragma unroll 1
    for (int l = 0; l < NL; ++l) {
        const int pb = 2 + 6 * l;
        REP(3) if (EN(2) && IN(pb + 0)) { KArgs A = kargs(); unsigned char* ws = A->ws; LANE_TID();
            pg8::Gemm g{(const bf16*)(ws + WS_H), (const bf16*)(ws + WS_WIN) + (size_t)l * NPI * DM, MT, NPI, DM}; pg8::StaticOrder S; S.init(MT, NPI, G, (int)blockIdx.x);
            pg8::EpiBf16Plain E{(bf16*)(ws + WS_PROJ), NPI};
#if PROBE_CLK
            unsigned long long pc0 = 0, pr0 = 0; if (blockIdx.x == 0 && l == 2) { pc0 = __builtin_readcyclecounter(); pr0 = __builtin_amdgcn_s_memrealtime(); }
#endif
            pg8::gemm_phase<pg8::EpiBf16Plain, pg8::StaticOrder, true, true>(lds, g, S, E, wave_o);
            SKEW_STAMP(1);
#if PROBE_CLK
            if (blockIdx.x == 0 && l == 2 && wave_o == 0 && lane_id_opq() == 0) { const unsigned long long dc = __builtin_readcyclecounter() - pc0, dr = __builtin_amdgcn_s_memrealtime() - pr0;
                volatile unsigned long long* pp = (volatile unsigned long long*)(ws + WS_CTL) + 131000; pp[0] = dc; pp[1] = dr; }
#endif
        }
        SEAM(pb + 0);
        REP(1) if (EN(3) && IN(pb + 1)) { KArgs A = kargs(); unsigned char* ws = A->ws; LANE_TID();
            rwkv_prep_mfma((const bf16*)(ws + WS_PROJ), A->in[8] + l * RWKV_IN, A->in[9] + l * 384, A->in[11] + l * 384, (const bf16*)(ws + WS_WL) + (size_t)l * 384 * 256,
                           (float*)(ws + WS_DEC), (bf16*)(ws + WS_AA), (bf16*)(ws + WS_GG), lds, wave_o); SKEW_STAMP(6); }
        SEAM(pb + 1);
        REP(0) if (EN(4) && IN(pb + 2)) { KArgs A = kargs(); unsigned char* ws = A->ws; LANE_TID();
            const float* gn = A->in[7] + l * DM; const bf16* PROJ = (const bf16*)(ws + WS_PROJ); bf16* Hb = (bf16*)(ws + WS_H);
#if PROBE_SKEW == 10
            if (l == 2 && wave_o == 0 && lane_id_opq() == 0) { volatile unsigned long long* pp_ = (volatile unsigned long long*)(ws + WS_CTL) + 130000 + 2 * blockIdx.x; pp_[0] = __builtin_amdgcn_s_memrealtime(); }
#endif
            int u = (int)blockIdx.x; asm volatile("" : "+s"(u));
            float* HS = (float*)(ws + WS_HS) + (size_t)l * 192 * 4096; unsigned* FL = (unsigned*)(ws + WS_CTL) + CW_FLAG + l * 192 * 16;
            const float* DECp = (const float*)(ws + WS_DEC); const bf16* AAp = (const bf16*)(ws + WS_AA); const bf16* GGp = (const bf16*)(ws + WS_GG);
#define RWKV_PIECE(q, cb, ce, hin, hout) rwkv_unit((q) / 6, (q) % 6, PROJ, DECp, AAp, GGp, A->in[8] + l * RWKV_IN, A->in[14] + l * 384, A->in[15] + l * 384, A->in[16] + l * 384, gn, Hb, lds, wave_o, lane_o, cb, ce, \
                (hin) >= 0 ? HS + (size_t)(hin) * 4096 : nullptr, (hin) >= 0 ? FL + (hin) * 16 : nullptr, (hout) >= 0 ? HS + (size_t)(hout) * 4096 : nullptr, (hout) >= 0 ? FL + (hout) * 16 : nullptr)
            if (u < 64 || u >= 128) {
#if PROBE_SKEW == 9
                if (l == 2 && wave_o == 0 && lane_id_opq() == 0) { volatile unsigned long long* pp_ = (volatile unsigned long long*)(ws + WS_CTL) + 130000 + 3 * blockIdx.x; pp_[0] = __builtin_amdgcn_s_memrealtime(); }
#endif
                const int q = u < 64 ? u : u < 192 ? u - 64 : u - 64, ce = u < 64 ? SPLIT_H : u < 192 ? SPLIT_X : SPLIT_Y;
                RWKV_PIECE(q, 0, ce, -1, q);
#if PROBE_SKEW == 9
                if (l == 2 && wave_o == 0 && lane_id_opq() == 0) { volatile unsigned long long* pp_ = (volatile unsigned long long*)(ws + WS_CTL) + 130000 + 3 * blockIdx.x; pp_[1] = __builtin_amdgcn_s_memrealtime(); }
#endif
                }
            if (u < 128) {
#if PROBE_SKEW == 7 || PROBE_SKEW == 8
                if (l == 2 && wave_o == 0 && lane_id_opq() == 0) { volatile unsigned long long* pp_ = (volatile unsigned long long*)(ws + WS_CTL) + 130000 + 3 * blockIdx.x; pp_[0] = __builtin_amdgcn_s_memrealtime(); }
#endif
                mlstm_unit(u >> 2, u & 3, PROJ, A->in[17] + (size_t)l * 4 * 768, A->in[18] + l * 768, A->in[19] + l * 4, A->in[20] + l * 4, gn, Hb, lds, wave_o, lane_o);
#if PROBE_SKEW == 7 || PROBE_SKEW == 8
                if (l == 2 && wave_o == 0 && lane_id_opq() == 0) { volatile unsigned long long* pp_ = (volatile unsigned long long*)(ws + WS_CTL) + 130000 + 3 * blockIdx.x; pp_[1] = __builtin_amdgcn_s_memrealtime(); }
#endif
                ret_unit(u >> 2, u & 3, PROJ, gn, Hb, lds, wave_o, lane_o);
#if PROBE_SKEW == 7 || PROBE_SKEW == 8
                if (l == 2 && wave_o == 0 && lane_id_opq() == 0) { volatile unsigned long long* pp_ = (volatile unsigned long long*)(ws + WS_CTL) + 130000 + 3 * blockIdx.x; pp_[2] = __builtin_amdgcn_s_memrealtime(); }
#endif
                }
            if (u >= 64) {
                const int q = u < 128 ? u : u < 192 ? u : u - 192, cb = u < 128 ? SPLIT_X : u < 192 ? SPLIT_Y : SPLIT_H;
                RWKV_PIECE(q, cb, 32, q, -1); }
#undef RWKV_PIECE
#ifndef PROBE_UNIT
#define PROBE_UNIT 0
#endif
            if (PROBE_UNIT == 1 && u < 192) rwkv_unit(u / 6, u % 6, PROJ, DECp, AAp, GGp, A->in[8] + l * RWKV_IN, A->in[14] + l * 384, A->in[15] + l * 384, A->in[16] + l * 384, gn, Hb, lds, wave_o, lane_o, 0, 32, nullptr, nullptr, nullptr, nullptr);
            if (PROBE_UNIT == 2 && u < 128) mlstm_unit(u >> 2, u & 3, PROJ, A->in[17] + (size_t)l * 4 * 768, A->in[18] + l * 768, A->in[19] + l * 4, A->in[20] + l * 4, gn, Hb, lds, wave_o, lane_o);
            if (PROBE_UNIT == 3 && u < 128) ret_unit(u >> 2, u & 3, PROJ, gn, Hb, lds, wave_o, lane_o);
            SKEW_STAMP(2);
#if PROBE_SKEW == 10
            if (l == 2 && wave_o == 0 && lane_id_opq() == 0) { volatile unsigned long long* pp_ = (volatile unsigned long long*)(ws + WS_CTL) + 130000 + 2 * blockIdx.x; pp_[1] = __builtin_amdgcn_s_memrealtime(); }
#endif
        }
        SEAM(pb + 2);
        if (EN(6) && IN(pb + 3)) { KArgs A = kargs(); unsigned char* ws = A->ws; LANE_TID();
            pg8::Gemm g{(const bf16*)(ws + WS_H), (const bf16*)(ws + WS_WOUT) + (size_t)l * DM * DM, MT, DM, DM}; pg8::StaticOrder S; S.init(MT, DM, G, (int)blockIdx.x);
            const float* modl = (const float*)(ws + WS_MOD) + (size_t)l * NB * MODP;
#if PROBE_RG
            { pg8::EpiResGate<false> E2{(const float*)nullptr, (const bf16*)A->out, (bf16*)(ws + WS_XFIN), DM, modl + 2 * DM, MODP}; pg8::gemm_phase<pg8::EpiResGate<false>, pg8::StaticOrder, true, true>(lds, g, S, E2, wave_o); }
#endif
            if (l == 0) { pg8::EpiResGate<true> E{A->in[0], (const bf16*)nullptr, (bf16*)A->out, DM, modl + 2 * DM, MODP}; pg8::gemm_phase<pg8::EpiResGate<true>, pg8::StaticOrder, true, true>(lds, g, S, E, wave_o); }
            else { pg8::EpiResGate<false> E{(const float*)nullptr, (const bf16*)A->out, (bf16*)A->out, DM, modl + 2 * DM, MODP}; pg8::gemm_phase<pg8::EpiResGate<false>, pg8::StaticOrder, true, true>(lds, g, S, E, wave_o); }
            fused_panel_norm(S, (unsigned*)(ws + WS_CTL) + CW_PCNT + (2 * l) * PCNT_BANK, (const bf16*)A->out, A->in[5] + l * DM, modl, 3 * DM, 4 * DM, (bf16*)(ws + WS_H), wave_o, lane_o);
            SKEW_STAMP(5);
        }
        SEAM(pb + 3);
        REP(4) if (EN(7) && IN(pb + 4)) { KArgs A = kargs(); unsigned char* ws = A->ws; LANE_TID();
            pg8::Gemm g{(const bf16*)(ws + WS_H), (const bf16*)(ws + WS_WF1) + (size_t)l * NF1 * DM, MT, NF1, DM}; pg8::StaticOrder S; S.init(MT, NF1, G, (int)blockIdx.x);
            pg8::EpiSwiGLU E{(bf16*)(ws + WS_PROJ), DFF};
            pg8::gemm_phase<pg8::EpiSwiGLU, pg8::StaticOrder, true, true>(lds, g, S, E, wave_o);
            SKEW_STAMP(3);
        }
        SEAM(pb + 4);
        if (EN(8) && IN(pb + 5)) { KArgs A = kargs(); unsigned char* ws = A->ws; LANE_TID();
            pg8::Gemm g{(const bf16*)(ws + WS_PROJ), (const bf16*)(ws + WS_WF2) + (size_t)l * DM * DFF, MT, DM, DFF}; pg8::StaticOrder S; S.init(MT, DM, G, (int)blockIdx.x);
#if PROBE_RG
            { pg8::EpiResGate<false> E2{(const float*)nullptr, (const bf16*)A->out, (bf16*)(ws + WS_XFIN), DM, (const float*)(ws + WS_MOD) + (size_t)l * NB * MODP + 5 * DM, MODP}; pg8::gemm_phase<pg8::EpiResGate<false>, pg8::StaticOrder, true, true>(lds, g, S, E2, wave_o); }
#endif
            pg8::EpiResGate<false> E{(const float*)nullptr, (const bf16*)A->out, l + 1 < NL ? (bf16*)A->out : (bf16*)(ws + WS_XFIN), DM, (const float*)(ws + WS_MOD) + (size_t)l * NB * MODP + 5 * DM, MODP};
            pg8::gemm_phase<pg8::EpiResGate<false>, pg8::StaticOrder, true, true>(lds, g, S, E, wave_o);
            if (l + 1 < NL) fused_panel_norm(S, (unsigned*)(ws + WS_CTL) + CW_PCNT + (2 * l + 1) * PCNT_BANK, (const bf16*)A->out, A->in[4] + (l + 1) * DM, (const float*)(ws + WS_MOD) + (size_t)(l + 1) * NB * MODP, 0, DM, (bf16*)(ws + WS_H), wave_o, lane_o);
            SKEW_STAMP(4);
        }
        SEAM(pb + 5);
    }
    if (EN(9) && IN(N_PHASES - 1)) { KArgs A = kargs(); int gw_o = gw; asm volatile("" : "+s"(gw_o)); final_norm_phase((const bf16*)(A->ws + WS_XFIN), A->out, A->in[24], gw_o, ngw, lane_id_opq()); }
#if PROBE_SKEW == 10
    if (blockIdx.x == 0 && wave == 0 && lane_id_opq() == 0) { KArgs A = kargs(); volatile unsigned long long* pp = (volatile unsigned long long*)(A->ws + WS_CTL) + 130000;
        unsigned long long mn = ~0ull, mx = 0ull;
        for (int i = 0; i < 256; ++i) { const unsigned long long a_ = pp[2 * i], b_ = pp[2 * i + 1]; mn = a_ < mn ? a_ : mn; mx = b_ > mx ? b_ : mx; }
        unsigned long long us = (mx - mn) / 10ull; if (us > 30000ull) us = 30000ull;
        const unsigned long long t0 = __builtin_amdgcn_s_memrealtime();
        while (__builtin_amdgcn_s_memrealtime() - t0 < us * 100ull) __builtin_amdgcn_s_sleep(32); }
#elif PROBE_SKEW == 9
    if (blockIdx.x == 0 && wave == 0 && lane_id_opq() == 0) { KArgs A = kargs(); volatile unsigned long long* pp = (volatile unsigned long long*)(A->ws + WS_CTL) + 130000;
        unsigned long long s = 0ull;
        for (int i = 128; i < 192; ++i) s += pp[3 * i + 1] - pp[3 * i];
        unsigned long long us = s >> 6; if (us > 60000ull) us = 60000ull;
        const unsigned long long t0 = __builtin_amdgcn_s_memrealtime();
        while (__builtin_amdgcn_s_memrealtime() - t0 < us * 100ull) __builtin_amdgcn_s_sleep(32); }
#endif
#if PROBE_SKEW == 7 || PROBE_SKEW == 8
    if (blockIdx.x == 0 && wave == 0 && lane_id_opq() == 0) { KArgs A = kargs(); volatile unsigned long long* pp = (volatile unsigned long long*)(A->ws + WS_CTL) + 130000;
        unsigned long long s = 0ull;
        for (int i = 0; i < 128; ++i) s += PROBE_SKEW == 7 ? pp[3 * i + 1] - pp[3 * i] : pp[3 * i + 2] - pp[3 * i + 1];
        unsigned long long us = s >> 7; if (us > 60000ull) us = 60000ull;
        const unsigned long long t0 = __builtin_amdgcn_s_memrealtime();
        while (__builtin_amdgcn_s_memrealtime() - t0 < us * 100ull) __builtin_amdgcn_s_sleep(32); }
#elif PROBE_SKEW && PROBE_SKEW < 9
    if (blockIdx.x == 0 && wave == 0 && lane_id_opq() == 0) { KArgs A = kargs(); volatile unsigned long long* pp = (volatile unsigned long long*)(A->ws + WS_CTL) + 130000;
        unsigned long long mx = 0ull, sum = 0ull, mn = ~0ull;
        for (int i = 0; i < 256; ++i) { const unsigned long long t = pp[i]; mx = t > mx ? t : mx; mn = t < mn ? t : mn; sum += t - pp[0] + (1ull << 40); }
        const unsigned long long mean = pp[0] + (sum >> 8) - (1ull << 40);
        unsigned long long us = PROBE_SKEW_MODE == 1 ? (mx - mn) : (mx - mean);
        if (PROBE_SKEW_MODE >= 2) { const int lo = 64 * (PROBE_SKEW_MODE - 2), hi = lo + 64; unsigned long long s2 = 0ull;
            for (int i = lo; i < hi; ++i) s2 += mx - pp[i];
            us = s2 / (unsigned long long)(hi - lo); }
        if (us > 30000ull) us = 30000ull;
        const unsigned long long t0 = __builtin_amdgcn_s_memrealtime();
        while (__builtin_amdgcn_s_memrealtime() - t0 < us * 100ull) __builtin_amdgcn_s_sleep(32); }
#endif
#if PROBE_KL_SOLO
    if (blockIdx.x == 0) { xcd_barrier(bar); }
    else { xcd_barrier(bar); }
    if (blockIdx.x == 0) { KArgs A = kargs(); unsigned char* ws = A->ws; LANE_TID();
        { const unsigned long long t0_ = __builtin_amdgcn_s_memrealtime(); while (__builtin_amdgcn_s_memrealtime() - t0_ < 100000ull) __builtin_amdgcn_s_sleep(64); }
        pg8::Gemm g{(const bf16*)(ws + WS_H), (const bf16*)(ws + WS_WIN), MT, NPI, DM}; pg8::StaticOrder S; S.init(MT, NPI, G, 0);
        pg8::EpiBf16Plain E{(bf16*)(ws + WS_PROJ), NPI};
        pg8::gemm_phase<pg8::EpiBf16Plain, pg8::StaticOrder, true, true>(lds, g, S, E, wave_o); }
#endif
#if PROBE_RWS
    if (blockIdx.x == 0 && wave == 0 && lane_id_opq() == 0) { unsigned long long us = (PROBE_RWS == 9 ? (probe_rw[5] - probe_rw[0]) / 4ull : PROBE_RWS == 6 ? probe_rw[6] - probe_rw[3] : PROBE_RWS == 7 ? probe_rw[7] - probe_rw[6] : PROBE_RWS == 8 ? probe_rw[4] - probe_rw[7] : probe_rw[PROBE_RWS] - probe_rw[PROBE_RWS - 1]) / 2ull;
        const unsigned long long t0 = __builtin_amdgcn_s_memrealtime();
        while (__builtin_amdgcn_s_memrealtime() - t0 < us * 100ull) __builtin_amdgcn_s_sleep(32); }
#endif
#if PROBE_KL
    if (blockIdx.x == 0 && wave == 0 && lane_id_opq() == 0) { unsigned long long us = PROBE_KL == 1 ? probe_kl[0] / 16ull : probe_kl[1] / 4ull; if (us > 30000ull) us = 30000ull;
        const unsigned long long t0 = __builtin_amdgcn_s_memrealtime();
        while (__builtin_amdgcn_s_memrealtime() - t0 < us * 100ull) __builtin_amdgcn_s_sleep(32); }
#endif
#if PROBE_CLK
    if (blockIdx.x == 0 && wave == 0 && lane_id_opq() == 0) { KArgs A = kargs(); volatile unsigned long long* pp = (volatile unsigned long long*)(A->ws + WS_CTL) + 131000; const unsigned long long dc = pp[0], dr = pp[1];
#if PROBE_CLK == 1
        unsigned long long us = dr ? dc * 100ull / dr : 0ull;
#else
        unsigned long long us = dr / 100ull * 10ull;
#endif
        if (us > 20000ull) us = 20000ull;
        const unsigned long long t0 = __builtin_amdgcn_s_memrealtime();
        while (__builtin_amdgcn_s_memrealtime() - t0 < us * 100ull) __builtin_amdgcn_s_sleep(32); }
#endif
#undef IN
#undef SEAM
}

extern "C" void kernel_launch(void* const* d_in, const int* in_sizes, int n_in, void* d_out, int out_size, void* d_ws, size_t ws_size, hipStream_t stream) {
    static int grid = 0;
    if (grid == 0) {
        if (n_in != 25 || in_sizes[0] != MT * DM || out_size != MT * DM || ws_size < WS_END) { fprintf(stderr, "kernel_launch: shape/workspace mismatch (n_in %d, in0 %d, out %d, ws %zu)\n", n_in, n_in > 0 ? in_sizes[0] : -1, out_size, ws_size); grid = -1; return; }
        int dev = 0, cus = 0, per_cu = 0;
        if (hipGetDevice(&dev) != hipSuccess || hipDeviceGetAttribute(&cus, hipDeviceAttributeMultiprocessorCount, dev) != hipSuccess) { grid = -1; return; }
        if (hipFuncSetAttribute((const void*)mk_fwd, hipFuncAttributeMaxDynamicSharedMemorySize, LDS_BYTES) != hipSuccess) { fprintf(stderr, "kernel_launch: hipFuncSetAttribute failed\n"); grid = -1; return; }
        if (hipOccupancyMaxActiveBlocksPerMultiprocessor(&per_cu, (const void*)mk_fwd, NWAVES * 64, LDS_BYTES) != hipSuccess || per_cu < 1) { fprintf(stderr, "kernel_launch: occupancy query says %d\n", per_cu); }
        (void)hipGetLastError();
        grid = cus;
    }
    if (grid < 0) return;
    if (hipMemsetAsync((char*)d_ws + WS_CTL, 0, CTL_ZERO_BYTES, stream) != hipSuccess) return;
    Args a{};
    for (int i = 0; i < 25; ++i) a.in[i] = (const float*)d_in[i];
    a.out = (float*)d_out; a.ws = (unsigned char*)d_ws;
#if MK_PER_PHASE
    for (int p = 0; p < N_PHASES; ++p) { a.ph_lo = p; a.ph_hi = p + 1; a.li = 0; hipLaunchKernelGGL(mk_fwd, dim3(grid), dim3(NWAVES * 64), LDS_BYTES, stream, a); }
#else
    a.ph_lo = 0; a.ph_hi = N_PHASES; a.li = 0;
    hipLaunchKernelGGL(mk_fwd, dim3(grid), dim3(NWAVES * 64), LDS_BYTES, stream, a);
#endif
}
```
